# Optimizing an MI355X kernel written in HIP

```python
import math
import jax, jax.numpy as jnp
from jax import lax
import numpy as np

D_MODEL = 1024
BATCH = 2
SEQ = 16384
DEPTH = 2

N_BRANCHES = 4
BRANCH_WIDTH = D_MODEL // N_BRANCHES
DIFF_HEADS = 4
DIFF_V_DIM = BRANCH_WIDTH // DIFF_HEADS
DIFF_QK_DIM = DIFF_V_DIM // 2
Q_BLOCK = 128
POOL_WINDOWS = (2, 4, 8, 16)
POOL_GROUP_WIDTH = BRANCH_WIDTH // 4
SCONV_WIDTH = 3
DELTA_HEADS = 4
DELTA_DK = BRANCH_WIDTH // DELTA_HEADS
DELTA_DV = BRANCH_WIDTH // DELTA_HEADS
DELTA_CONV_WIDTH = 5
DELTA_CHUNK = 64
D_FF = 2816
N_EXPERTS = 8
TOP_K = 2
D_FF_EXPERT = 2816
MOE_BLOCK = 128
N_ADA = 6
EPS = 1e-6

IN_SPLITS = (
    DIFF_HEADS * DIFF_QK_DIM, DIFF_HEADS * DIFF_QK_DIM,
    DIFF_HEADS * DIFF_QK_DIM, DIFF_HEADS * DIFF_QK_DIM,
    DIFF_HEADS * DIFF_V_DIM,
    BRANCH_WIDTH,
    BRANCH_WIDTH, BRANCH_WIDTH, BRANCH_WIDTH,
    DELTA_HEADS * DELTA_DK, DELTA_HEADS * DELTA_DK,
    DELTA_HEADS * DELTA_DV, DELTA_HEADS * DELTA_DV,
    2 * DELTA_HEADS, 2 * DELTA_HEADS,
)
IN_COLS = sum(IN_SPLITS)

kernel_name = "hybrid_bidir_diffattn_pool_conv_deltanet_moe"

F32 = jnp.float32


def rms_norm(x, g):
    xf = x.astype(F32)
    y = xf * lax.rsqrt(jnp.mean(xf * xf, axis=-1, keepdims=True) + EPS)
    return (y * g.astype(F32)).astype(x.dtype)


def l2_normalize(x):
    xf = x.astype(F32)
    return (xf * lax.rsqrt(jnp.sum(xf * xf, axis=-1, keepdims=True) + EPS)).astype(x.dtype)


def centred_depthwise_conv(z, w):
    k = w.shape[0]
    r = k // 2
    s = z.shape[1]
    zp = jnp.pad(z, ((0, 0), (r, r), (0, 0)))
    out = zp[:, 0:s] * w[0]
    for j in range(1, k):
        out = out + zp[:, j:j + s] * w[j]
    return out


def alibi_slopes():
    return jnp.array([2.0 ** (-8.0 * (i + 1) / DIFF_HEADS) for i in range(DIFF_HEADS)], F32)


def diff_attention(q1, q2, k1, k2, v, lam):
    b_, s, h, dv = v.shape
    scale = DIFF_QK_DIM ** -0.5
    slopes = alibi_slopes()
    kpos = jnp.arange(s)

    def block(i):
        start = i * Q_BLOCK
        qa = lax.dynamic_slice_in_dim(q1, start, Q_BLOCK, axis=1)
        qb = lax.dynamic_slice_in_dim(q2, start, Q_BLOCK, axis=1)
        qpos = start + jnp.arange(Q_BLOCK)
        bias = -slopes[:, None, None] * jnp.abs(qpos[:, None] - kpos[None, :]).astype(F32)
        s1 = jnp.einsum('bqhd,bkhd->bhqk', qa, k1).astype(F32) * scale + bias
        s2 = jnp.einsum('bqhd,bkhd->bhqk', qb, k2).astype(F32) * scale + bias
        a = jax.nn.softmax(s1, axis=-1) - lam * jax.nn.softmax(s2, axis=-1)
        return jnp.einsum('bhqk,bkhd->bqhd', a.astype(v.dtype), v)

    out = lax.map(block, jnp.arange(s // Q_BLOCK))
    return jnp.moveaxis(out, 0, 1).reshape(b_, s, h, dv)


def multiscale_pool(p, pool_w, pool_scale):
    b_, s, _ = p.shape
    pf = p.astype(F32)
    cs = jnp.concatenate([jnp.zeros((b_, 1, BRANCH_WIDTH), F32), jnp.cumsum(pf, axis=1)], axis=1)
    t = jnp.arange(s)
    outs = []
    for gi, w in enumerate(POOL_WINDOWS):
        lo = jnp.clip(t - w // 2, 0, s)
        hi = jnp.clip(t + w // 2, 0, s)
        sl = slice(gi * POOL_GROUP_WIDTH, (gi + 1) * POOL_GROUP_WIDTH)
        csg = cs[..., sl]
        mean = (csg[:, hi] - csg[:, lo]) / (hi - lo).astype(F32)[None, :, None]
        outs.append(mean - pf[..., sl])
    m = jnp.stack(outs, axis=2)
    y = jnp.einsum('bsgc,gce->bsge', m, pool_w.astype(F32)).reshape(b_, s, BRANCH_WIDTH)
    return (y * pool_scale.astype(F32)).astype(p.dtype)


def gated_delta_rule(q, k, v, g, beta):
    b_, h, l, dk = q.shape
    dv = v.shape[-1]
    c = DELTA_CHUNK
    n = l // c
    q, k, v = (t.astype(F32).reshape(b_, h, n, c, -1) for t in (q, k, v))
    g = jnp.cumsum(g.astype(F32).reshape(b_, h, n, c), axis=-1)
    beta = beta.astype(F32).reshape(b_, h, n, c)
    lower = jnp.tril(jnp.ones((c, c), bool))
    strict = jnp.tril(jnp.ones((c, c), bool), -1)
    gdiff = g[..., :, None] - g[..., None, :]
    decay = jnp.where(lower, jnp.exp(jnp.where(lower, gdiff, 0.0)), 0.0)
    k_beta = k * beta[..., None]
    m = jnp.where(strict, jnp.einsum('bhnid,bhnjd->bhnij', k_beta, k) * decay, 0.0)
    eye = jnp.eye(c, dtype=F32)
    t_inv = lax.linalg.triangular_solve(eye + m, jnp.broadcast_to(eye, m.shape),
                                        left_side=True, lower=True)
    u = t_inv @ (v * beta[..., None])
    w = t_inv @ (k_beta * jnp.exp(g)[..., None])
    attn = jnp.einsum('bhnid,bhnjd->bhnij', q, k) * decay
    q_g = q * jnp.exp(g)[..., None]
    g_last = g[..., -1]
    k_d = k * jnp.exp(g_last[..., None] - g)[..., None]

    def step(state, xs):
        u_n, w_n, attn_n, qg_n, kd_n, gl_n = xs
        v_new = u_n - w_n @ state
        o = qg_n @ state + attn_n @ v_new
        state = state * jnp.exp(gl_n)[..., None, None] + jnp.swapaxes(kd_n, -1, -2) @ v_new
        return state, o

    xs = tuple(jnp.moveaxis(t, 2, 0) for t in (u, w, attn, q_g, k_d, g_last))
    _, o = lax.scan(step, jnp.zeros((b_, h, dk, dv), F32), xs)
    return jnp.moveaxis(o, 0, 2).reshape(b_, h, l, dv)


def token_mixer(h, w_in, diff_lambda, diff_subln, pool_w, pool_scale, sconv_w,
                delta_conv_w, delta_a_log, delta_dt_bias, delta_norm,
                w_branch, w_merge, b_merge, w_o, lambda_init):
    b_, s, _ = h.shape
    proj = h @ w_in
    cuts = np.cumsum(IN_SPLITS)[:-1].tolist()
    (q1, q2, k1, k2, va, pin, cb, cc, cx,
     dq, dk, dv, dz, dbeta, da) = jnp.split(proj, cuts, axis=-1)

    def heads(t, d):
        return t.reshape(b_, s, -1, d)

    lq1, lk1, lq2, lk2 = (diff_lambda[i].astype(F32) for i in range(4))
    lam = jnp.exp(jnp.sum(lq1 * lk1)) - jnp.exp(jnp.sum(lq2 * lk2)) + lambda_init
    oa = diff_attention(heads(q1, DIFF_QK_DIM), heads(q2, DIFF_QK_DIM),
                        heads(k1, DIFF_QK_DIM), heads(k2, DIFF_QK_DIM),
                        heads(va, DIFF_V_DIM), lam)
    oa = (rms_norm(oa, diff_subln) * (1.0 - lambda_init)).reshape(b_, s, BRANCH_WIDTH)

    ob = multiscale_pool(pin, pool_w, pool_scale)

    oc = cb * centred_depthwise_conv(cc * cx, sconv_w)

    qkv = jax.nn.silu(centred_depthwise_conv(jnp.concatenate([dq, dk, dv], axis=-1), delta_conv_w))
    dq, dk, dv = jnp.split(qkv, [DELTA_HEADS * DELTA_DK, 2 * DELTA_HEADS * DELTA_DK], axis=-1)
    q = l2_normalize(heads(dq, DELTA_DK)) * (DELTA_DK ** -0.5)
    k = l2_normalize(heads(dk, DELTA_DK))
    v = heads(dv, DELTA_DV)
    beta = jax.nn.sigmoid(dbeta.astype(F32)).reshape(b_, s, 2, DELTA_HEADS)
    g = -jnp.exp(delta_a_log.astype(F32)) * jax.nn.softplus(
        da.astype(F32).reshape(b_, s, 2, DELTA_HEADS) + delta_dt_bias.astype(F32))
    qh, kh, vh = (jnp.swapaxes(t, 1, 2) for t in (q, k, v))
    g_f, g_b = jnp.swapaxes(g[:, :, 0], 1, 2), jnp.swapaxes(g[:, :, 1], 1, 2)
    be_f, be_b = jnp.swapaxes(beta[:, :, 0], 1, 2), jnp.swapaxes(beta[:, :, 1], 1, 2)

    def flip(t):
        return jnp.flip(t, axis=2)

    fwd = gated_delta_rule(qh, kh, vh, g_f, be_f)
    bwd = flip(gated_delta_rule(flip(qh), flip(kh), flip(vh), flip(g_b), flip(be_b)))
    od = jnp.swapaxes(fwd + bwd, 1, 2).astype(h.dtype)
    od = (rms_norm(od, delta_norm) * jax.nn.silu(heads(dz, DELTA_DV))).reshape(b_, s, BRANCH_WIDTH)

    merged = None
    for i, o in enumerate((oa, ob, oc, od)):
        gate = jax.nn.sigmoid(h @ w_merge[i] + b_merge[i])
        term = gate * (o.astype(h.dtype) @ w_branch[i])
        merged = term if merged is None else merged + term
    return merged @ w_o


def swiglu(h, w_gate, w_up, w_down):
    return (jax.nn.silu(h @ w_gate) * (h @ w_up)) @ w_down


def moe_swiglu(h, router_w, router_b, w_gate, w_up, w_down):
    b_, s, d = h.shape
    xt = h.reshape(-1, d)
    t = xt.shape[0]
    logits = (xt @ router_w).astype(F32) + router_b.astype(F32)
    probs = jax.nn.softmax(logits, axis=-1)
    top_p, top_e = lax.top_k(probs, TOP_K)
    top_p = top_p / jnp.sum(top_p, axis=-1, keepdims=True)
    a = t * TOP_K
    e_flat = top_e.reshape(-1)
    p_flat = top_p.reshape(-1)
    tok = jnp.arange(a) // TOP_K
    order = jnp.argsort(e_flat)
    e_sorted = e_flat[order]
    counts = jnp.bincount(e_flat, length=N_EXPERTS)
    padded = ((counts + MOE_BLOCK - 1) // MOE_BLOCK) * MOE_BLOCK
    start = jnp.cumsum(counts) - counts
    pend = jnp.cumsum(padded)
    pstart = pend - padded
    dest = pstart[e_sorted] + (jnp.arange(a) - start[e_sorted])
    n_slots = ((a + MOE_BLOCK - 1) // MOE_BLOCK + N_EXPERTS) * MOE_BLOCK
    slot_tok = jnp.zeros((n_slots,), jnp.int32).at[dest].set(tok[order].astype(jnp.int32))
    slot_p = jnp.zeros((n_slots,), F32).at[dest].set(p_flat[order])
    nb = n_slots // MOE_BLOCK
    blk_e = jnp.minimum(jnp.searchsorted(pend, jnp.arange(nb) * MOE_BLOCK, side='right'),
                        N_EXPERTS - 1)

    def run_block(args):
        tk, e = args
        xb = xt[tk]
        return swiglu(xb, w_gate[e], w_up[e], w_down[e])

    y = lax.map(run_block, (slot_tok.reshape(nb, MOE_BLOCK), blk_e)).reshape(n_slots, d)
    y = y * slot_p[:, None].astype(y.dtype)
    out = jnp.zeros_like(xt).at[slot_tok].add(y)
    return out.reshape(b_, s, d)


def setup_inputs(seed: int = 0) -> dict:
    key = jax.random.key(seed)
    ks = iter(jax.random.split(key, 40))
    L = DEPTH
    ND = (DEPTH + 1) // 2
    NM = DEPTH // 2

    def nrm(shape, scale):
        return jax.random.normal(next(ks), shape, F32) * scale

    def gain(shape):
        return 1.0 + nrm(shape, 0.02)

    dt = jnp.exp(jax.random.uniform(next(ks), (L, 2, DELTA_HEADS), F32,
                                    math.log(1e-3), math.log(1e-1)))
    inputs = {
        "x": nrm((BATCH, SEQ, D_MODEL), 1.0),
        "c": nrm((BATCH, D_MODEL), 1.0),
        "ada_w": nrm((L, D_MODEL, N_ADA * D_MODEL), 0.5 * D_MODEL ** -0.5),
        "ada_b": nrm((L, N_ADA * D_MODEL), 0.02),
        "norm_mix_pre": gain((L, D_MODEL)),
        "norm_mix_post": gain((L, D_MODEL)),
        "norm_ffn_pre": gain((L, D_MODEL)),
        "norm_ffn_post": gain((L, D_MODEL)),
        "w_in": nrm((L, D_MODEL, IN_COLS), D_MODEL ** -0.5),
        "diff_lambda": nrm((L, 4, DIFF_QK_DIM), 0.1),
        "diff_subln": gain((L, DIFF_V_DIM)),
        "pool_w": nrm((L, 4, POOL_GROUP_WIDTH, POOL_GROUP_WIDTH), POOL_GROUP_WIDTH ** -0.5),
        "pool_scale": 1.0 + nrm((L, BRANCH_WIDTH), 0.1),
        "sconv_w": nrm((L, SCONV_WIDTH, BRANCH_WIDTH), SCONV_WIDTH ** -0.5),
        "delta_conv_w": nrm((L, DELTA_CONV_WIDTH, DELTA_HEADS * (2 * DELTA_DK + DELTA_DV)),
                            DELTA_CONV_WIDTH ** -0.5),
        "delta_a_log": jnp.log(jax.random.uniform(next(ks), (L, 2, DELTA_HEADS), F32, 1.0, 16.0)),
        "delta_dt_bias": dt + jnp.log(-jnp.expm1(-dt)),
        "delta_norm": gain((L, DELTA_DV)),
        "w_branch": nrm((L, N_BRANCHES, BRANCH_WIDTH, D_MODEL), BRANCH_WIDTH ** -0.5),
        "w_merge": nrm((L, N_BRANCHES, D_MODEL, D_MODEL), D_MODEL ** -0.5),
        "b_merge": nrm((L, N_BRANCHES, D_MODEL), 0.02),
        "w_o": nrm((L, D_MODEL, D_MODEL), D_MODEL ** -0.5),
        "ffn_w_gate": nrm((ND, D_MODEL, D_FF), D_MODEL ** -0.5),
        "ffn_w_up": nrm((ND, D_MODEL, D_FF), D_MODEL ** -0.5),
        "ffn_w_down": nrm((ND, D_FF, D_MODEL), D_FF ** -0.5),
        "router_w": nrm((NM, D_MODEL, N_EXPERTS), D_MODEL ** -0.5),
        "router_b": nrm((NM, N_EXPERTS), 0.01),
        "moe_w_gate": nrm((NM, N_EXPERTS, D_MODEL, D_FF_EXPERT), D_MODEL ** -0.5),
        "moe_w_up": nrm((NM, N_EXPERTS, D_MODEL, D_FF_EXPERT), D_MODEL ** -0.5),
        "moe_w_down": nrm((NM, N_EXPERTS, D_FF_EXPERT, D_MODEL), D_FF_EXPERT ** -0.5),
    }
    return inputs


def reference(x, c, ada_w, ada_b, norm_mix_pre, norm_mix_post, norm_ffn_pre, norm_ffn_post,
              w_in, diff_lambda, diff_subln, pool_w, pool_scale, sconv_w, delta_conv_w,
              delta_a_log, delta_dt_bias, delta_norm, w_branch, w_merge, b_merge, w_o,
              ffn_w_gate, ffn_w_up, ffn_w_down, router_w, router_b,
              moe_w_gate, moe_w_up, moe_w_down):
    cond = jax.nn.silu(c)
    for layer in range(DEPTH):
        mod = cond @ ada_w[layer] + ada_b[layer]
        sh1, sc1, g1, sh2, sc2, g2 = jnp.split(mod[:, None, :], N_ADA, axis=-1)
        lambda_init = 0.8 - 0.6 * math.exp(-0.3 * layer)

        h = rms_norm(x, norm_mix_pre[layer]) * (1.0 + sc1) + sh1
        f = token_mixer(h, w_in[layer], diff_lambda[layer], diff_subln[layer], pool_w[layer],
                        pool_scale[layer], sconv_w[layer], delta_conv_w[layer],
                        delta_a_log[layer], delta_dt_bias[layer], delta_norm[layer],
                        w_branch[layer], w_merge[layer], b_merge[layer], w_o[layer], lambda_init)
        x = x + g1 * rms_norm(f, norm_mix_post[layer])

        h = rms_norm(x, norm_ffn_pre[layer]) * (1.0 + sc2) + sh2
        if layer % 2 == 0:
            j = layer // 2
            f = swiglu(h, ffn_w_gate[j], ffn_w_up[j], ffn_w_down[j])
        else:
            j = layer // 2
            f = moe_swiglu(h, router_w[j], router_b[j], moe_w_gate[j], moe_w_up[j], moe_w_down[j])
        x = x + g2 * rms_norm(f, norm_ffn_post[layer])
    return x
```

```cpp
#define MK_SPLIT 1
#include <hip/hip_runtime.h>
#include <cstdio>
#include <cstdint>

namespace pg8 {
#define PG8_LAS __attribute__((address_space(3)))
typedef unsigned short bf16_t;
typedef short bf16x8 __attribute__((ext_vector_type(8)));
typedef float f32x4 __attribute__((ext_vector_type(4)));
typedef unsigned u32x4 __attribute__((ext_vector_type(4)));
typedef unsigned u32x2 __attribute__((ext_vector_type(2)));
constexpr int BM = 256, BK = 64, HALF = 128, HTB = HALF * BK * 2  , STAGE_BYTES = 8 * HTB;

__host__ __device__ __forceinline__ int lds_byte(int r, int c) { const int st = (r >> 4) * 2 + (c >> 5), rr = r & 15, cc = c & 31, ob = rr * 64 + cc * 2; return st * 1024 + (ob ^ (((ob >> 9) & 1) << 5)); }
__host__ __device__ __forceinline__ void stage_rc(int b, int& R, int& C) { const int st = b / 1024, sb = b % 1024, swz = sb ^ (((sb >> 9) & 1) << 5); R = (st >> 1) * 16 + swz / 64; C = (st & 1) * 32 + (swz % 64) / 2; }
__host__ __device__ __forceinline__ int perm32(int rho) { const int n = rho >> 4, i = rho & 15; return 8 * (i >> 2) + 4 * n + (i & 3); }

struct Unit { int pm, pn, aux, pad; const char* a; const char* b; const int* rows; };

__device__ __forceinline__ unsigned cvt_pk_bf16(float lo, float hi) { unsigned r; asm volatile("v_cvt_pk_bf16_f32 %0, %1, %2" : "=v"(r) : "v"(lo), "v"(hi)); return r; }


template <class Epi, class Sched, int K, int lda, int ldb, bool GATHER = false, bool ALIGN_EPI = true, bool SP2 = true>
__device__ __forceinline__ void gemm_phase(PG8_LAS unsigned char* lds, const int tid, const Sched& S, const Epi& E) {
    const int wid = __builtin_amdgcn_readfirstlane(tid >> 6), lane = tid & 63, wr = wid >> 2, wc = wid & 3, fr = lane & 15, fq = lane >> 4;
    constexpr int nt = K / BK;
    int Rs[2], Cs[2]; unsigned voffB[2];
#pragma unroll
    for (int i = 0; i < 2; ++i) { int R, C; stage_rc(tid * 16 + i * 8192, R, C); const int Rb = Epi::PERM ? ((R & ~31) + perm32(R & 31)) : R; Rs[i] = R; Cs[i] = C; voffB[i] = (unsigned)(Rb * ldb + C) * 2u; }
    const size_t kstep = (size_t)(BK * 2);
    const size_t hstepB = (size_t)HALF * ldb * 2;
    const unsigned ldsw = (unsigned)wid * 1024u;
    const int aoff = lds_byte(wr * 64 + fr, fq * 8), boff = lds_byte(wc * 32 + fr, fq * 8);
#define PG8_SA(b, h) (((b) * 2 + (h)) * HTB)
#define PG8_SB(b, h) ((4 + (b) * 2 + (h)) * HTB)
#define PG8_STAGE(bufoff, gbase, voff) do { _Pragma("unroll") for (int _i = 0; _i < 2; ++_i) \
        __builtin_amdgcn_global_load_lds((const unsigned*)((const char*)(gbase) + (voff)[_i]), (PG8_LAS unsigned*)(lds + (bufoff) + ldsw + _i * 8192), 16, 0, 0); } while (0)
#define PG8_LDA(dst, b, h) do { _Pragma("unroll") for (int m = 0; m < 4; ++m) _Pragma("unroll") for (int k = 0; k < 2; ++k) dst[m][k] = *(const PG8_LAS bf16x8*)(lds + PG8_SA(b, h) + aoff + m * 2048 + k * 1024); } while (0)
#define PG8_LDB(dst, b, h) do { _Pragma("unroll") for (int n = 0; n < 2; ++n) _Pragma("unroll") for (int k = 0; k < 2; ++k) dst[n][k] = *(const PG8_LAS bf16x8*)(lds + PG8_SB(b, h) + boff + n * 2048 + k * 1024); } while (0)
#define PG8_MMA(ai, bj, At, Bt) do { __builtin_amdgcn_s_setprio(1); _Pragma("unroll") for (int m = 0; m < 4; ++m) _Pragma("unroll") for (int n = 0; n < 2; ++n) _Pragma("unroll") for (int k = 0; k < 2; ++k) \
        acc[ai][bj][m][n] = __builtin_amdgcn_mfma_f32_16x16x32_bf16(Bt[n][k], At[m][k], acc[ai][bj][m][n], 0, 0, 0); __builtin_amdgcn_s_setprio(0); } while (0)
#define PG8_WAIT_V(n) asm volatile("s_waitcnt vmcnt(" #n ")" ::: "memory")
#define PG8_WAIT_L(n) asm volatile("s_waitcnt lgkmcnt(" #n ")" ::: "memory")
#define PG8_BAR __builtin_amdgcn_s_barrier()
#define PG8_SCHED __builtin_amdgcn_sched_barrier(0)
    Unit cur, nxt; int ui = 0;
    if (!S.next(0, cur)) return;
    f32x4 acc[2][2][4][2];
#pragma unroll
    for (int a = 0; a < 2; ++a)
#pragma unroll
        for (int b = 0; b < 2; ++b)
#pragma unroll
            for (int m = 0; m < 4; ++m)
#pragma unroll
                for (int n = 0; n < 2; ++n) acc[a][b][m][n] = (f32x4){0.f, 0.f, 0.f, 0.f};
    bf16x8 At[4][2], B0[2][2], B1[2][2];
    unsigned cOff[2][2], nOff[2][2];
#pragma unroll
    for (int hh = 0; hh < 2; ++hh)
#pragma unroll
        for (int i = 0; i < 2; ++i) {
            if constexpr (GATHER) { const int ridx = hh * HALF + Rs[i]; int tk = cur.rows[ridx]; tk = ridx < cur.aux ? tk : 0; cOff[hh][i] = (unsigned)(tk * lda + Cs[i]) * 2u; }
            else cOff[hh][i] = (unsigned)((hh * HALF + Rs[i]) * lda + Cs[i]) * 2u;
            if constexpr (GATHER) nOff[hh][i] = cOff[hh][i]; else nOff[hh][i] = 0u;
        }
    const char* cA = cur.a; const char* cB = cur.b;
    S.a_ready(cur);
    if constexpr (SP2) {
        PG8_STAGE(PG8_SB(0, 0), cB, voffB); PG8_STAGE(PG8_SB(0, 1), cB + hstepB, voffB); PG8_STAGE(PG8_SA(0, 0), cA, cOff[0]); PG8_STAGE(PG8_SA(0, 1), cA, cOff[1]);
        if (wr == 1) PG8_BAR;
        PG8_WAIT_V(2); PG8_BAR;
        PG8_STAGE(PG8_SB(1, 0), cB + kstep, voffB); PG8_STAGE(PG8_SA(1, 0), cA + kstep, cOff[0]); PG8_STAGE(PG8_SB(1, 1), cB + hstepB + kstep, voffB);
        PG8_WAIT_V(6); PG8_BAR;
    } else {
        PG8_STAGE(PG8_SB(0, 0), cB, voffB); PG8_STAGE(PG8_SA(0, 0), cA, cOff[0]); PG8_STAGE(PG8_SB(0, 1), cB + hstepB, voffB); PG8_STAGE(PG8_SA(0, 1), cA, cOff[1]);
        if (wr == 1) PG8_BAR;
        PG8_WAIT_V(4); PG8_BAR;
        PG8_STAGE(PG8_SB(1, 0), cB + kstep, voffB); PG8_STAGE(PG8_SA(1, 0), cA + kstep, cOff[0]); PG8_STAGE(PG8_SB(1, 1), cB + hstepB + kstep, voffB);
        PG8_WAIT_V(6); PG8_BAR;
    }
    for (;;) {
        const bool has_next = S.next(ui + 1, nxt);
        const char* nA = has_next ? nxt.a : cA; const char* nB = has_next ? nxt.b : cB;
        if constexpr (GATHER) {
            if (has_next) {
#pragma unroll
                for (int hh = 0; hh < 2; ++hh)
#pragma unroll
                    for (int i = 0; i < 2; ++i) { const int ridx = hh * HALF + Rs[i]; int tk = nxt.rows[ridx]; tk = ridx < nxt.aux ? tk : 0; nOff[hh][i] = (unsigned)(tk * lda + Cs[i]) * 2u; }
            } else {
#pragma unroll
                for (int hh = 0; hh < 2; ++hh)
#pragma unroll
                    for (int i = 0; i < 2; ++i) nOff[hh][i] = cOff[hh][i];
            }
        }
#pragma unroll 1
        for (int t = 0; t < nt; t += 2) {
            const bool last = (t == nt - 2);
            const char* a1 = cA + (size_t)(t + 1) * kstep;
            const char* a2 = last ? nA : cA + (size_t)(t + 2) * kstep; const char* b2 = last ? nB : cB + (size_t)(t + 2) * kstep;
            const char* a3 = a2 + kstep; const char* b3 = b2 + kstep;
            unsigned o2[2][2];
#pragma unroll
            for (int hh = 0; hh < 2; ++hh)
#pragma unroll
                for (int i = 0; i < 2; ++i) { if constexpr (GATHER) o2[hh][i] = last ? nOff[hh][i] : cOff[hh][i]; else o2[hh][i] = cOff[hh][i]; }
            if (last && has_next) S.a_ready(nxt);
            if constexpr (SP2) {
            PG8_LDB(B0, 0, 0); PG8_LDB(B1, 0, 1); PG8_SCHED; PG8_LDA(At, 0, 0); PG8_STAGE(PG8_SA(1, 1), a1, cOff[1]);
            PG8_WAIT_V(8); PG8_WAIT_L(0); PG8_BAR; PG8_MMA(0, 0, At, B0); PG8_MMA(0, 1, At, B1); PG8_BAR; PG8_SCHED;
            PG8_LDA(At, 0, 1); PG8_STAGE(PG8_SB(0, 0), b2, voffB); PG8_STAGE(PG8_SB(0, 1), b2 + hstepB, voffB); PG8_STAGE(PG8_SA(0, 0), a2, o2[0]);
            PG8_WAIT_V(8); PG8_WAIT_L(0); PG8_BAR; PG8_MMA(1, 0, At, B0); PG8_MMA(1, 1, At, B1); PG8_BAR; PG8_SCHED;
            PG8_LDB(B0, 1, 0); PG8_LDB(B1, 1, 1); PG8_SCHED; PG8_LDA(At, 1, 0); PG8_STAGE(PG8_SA(0, 1), a2, o2[1]);
            PG8_WAIT_V(8); PG8_WAIT_L(0); PG8_BAR; PG8_MMA(0, 0, At, B0); PG8_MMA(0, 1, At, B1); PG8_BAR; PG8_SCHED;
            PG8_LDA(At, 1, 1); PG8_STAGE(PG8_SB(1, 0), b3, voffB); PG8_STAGE(PG8_SB(1, 1), b3 + hstepB, voffB); PG8_STAGE(PG8_SA(1, 0), a3, o2[0]);
            PG8_WAIT_V(8); PG8_WAIT_L(0); PG8_BAR; PG8_MMA(1, 0, At, B0); PG8_MMA(1, 1, At, B1); PG8_BAR; PG8_SCHED;
            } else {
            PG8_LDB(B0, 0, 0); PG8_SCHED; PG8_LDA(At, 0, 0); PG8_STAGE(PG8_SA(1, 1), a1, cOff[1]);
            PG8_WAIT_L(8); PG8_BAR; PG8_WAIT_L(0); PG8_MMA(0, 0, At, B0); PG8_BAR; PG8_SCHED;
            PG8_LDB(B1, 0, 1); PG8_STAGE(PG8_SB(0, 0), b2, voffB);
            PG8_BAR; PG8_WAIT_L(0); PG8_MMA(0, 1, At, B1); PG8_BAR;
            PG8_LDA(At, 0, 1); PG8_STAGE(PG8_SA(0, 0), a2, o2[0]);
            PG8_BAR; PG8_WAIT_L(0); PG8_MMA(1, 0, At, B0); PG8_BAR; PG8_SCHED;
            PG8_STAGE(PG8_SB(0, 1), b2 + hstepB, voffB);
            PG8_WAIT_V(6); PG8_BAR; PG8_MMA(1, 1, At, B1); PG8_BAR;
            PG8_LDB(B0, 1, 0); PG8_SCHED; PG8_LDA(At, 1, 0); PG8_STAGE(PG8_SA(0, 1), a2, o2[1]);
            PG8_WAIT_L(8); PG8_BAR; PG8_WAIT_L(0); PG8_MMA(0, 0, At, B0); PG8_BAR; PG8_SCHED;
            PG8_LDB(B1, 1, 1); PG8_STAGE(PG8_SB(1, 0), b3, voffB);
            PG8_BAR; PG8_WAIT_L(0); PG8_MMA(0, 1, At, B1); PG8_BAR;
            PG8_LDA(At, 1, 1); PG8_STAGE(PG8_SA(1, 0), a3, o2[0]);
            PG8_BAR; PG8_WAIT_L(0); PG8_MMA(1, 0, At, B0); PG8_BAR; PG8_SCHED;
            PG8_STAGE(PG8_SB(1, 1), b3 + hstepB, voffB);
            PG8_WAIT_V(6); PG8_BAR; PG8_MMA(1, 1, At, B1); PG8_BAR;
            }
        }
        if constexpr (ALIGN_EPI) { if (wr == 0) PG8_BAR; }
        E(acc, cur, wr, wc, fr, fq); S.done(cur);
        if (!has_next) break;
#pragma unroll
        for (int a = 0; a < 2; ++a)
#pragma unroll
            for (int b = 0; b < 2; ++b)
#pragma unroll
                for (int m = 0; m < 4; ++m)
#pragma unroll
                    for (int n = 0; n < 2; ++n) acc[a][b][m][n] = (f32x4){0.f, 0.f, 0.f, 0.f};
        cur = nxt; cA = nA; cB = nB; ++ui;
        if constexpr (GATHER) {
#pragma unroll
            for (int hh = 0; hh < 2; ++hh)
#pragma unroll
                for (int i = 0; i < 2; ++i) cOff[hh][i] = nOff[hh][i];
        }
        if constexpr (ALIGN_EPI) { if (wr == 1) PG8_BAR; }
    }
    PG8_WAIT_V(0);
    if constexpr (!ALIGN_EPI) { if (wr == 0) PG8_BAR; }
    PG8_BAR;
#undef PG8_SA
#undef PG8_SB
#undef PG8_STAGE
#undef PG8_LDA
#undef PG8_LDB
#undef PG8_MMA
#undef PG8_WAIT_V
#undef PG8_WAIT_L
#undef PG8_BAR
#undef PG8_SCHED
}
}

constexpr int NWAVES = 8;
constexpr int BATCH = 2, SEQ = 16384, D = 1024, NTOK = BATCH * SEQ;
constexpr int NLAYER = 2;
constexpr int NPROJ = 2816, IN_COLS = 2832;
constexpr int C_Q = 0, C_K = 256, C_V = 512, C_PIN = 768, C_CB = 1024, C_CC = 1280, C_CX = 1536, C_DQ = 1792, C_DK = 2048, C_DV = 2304, C_DZ = 2560;
constexpr int DFF = 2816, NEXP = 8;
constexpr int NCHUNK = SEQ / 64;
constexpr int NINST = BATCH * 4 * 2 * NCHUNK;
constexpr float EPS = 1e-6f;
constexpr float QSCALE = 0.17677669529663687f * 1.4426950408889634f;
constexpr int MOE_PASS_TILES = 132;

constexpr size_t MiB = 1u << 20;
constexpr size_t WS_CTL = 0, CTL_ZERO_BYTES = 1 * MiB;
constexpr size_t SZ_WIN = (size_t)NPROJ * D * 2, SZ_WM = (size_t)4096 * D * 2, SZ_WB = (size_t)4 * 1024 * 256 * 2, SZ_WO = (size_t)D * D * 2;
constexpr size_t SZ_LAYERW = SZ_WIN + SZ_WM + SZ_WB + SZ_WO;
constexpr size_t SZ_WGU = (size_t)2 * DFF * D * 2, SZ_WD = (size_t)D * DFF * 2, SZ_FFNW = SZ_WGU + SZ_WD;
constexpr size_t WS_W = 1 * MiB;
constexpr size_t WS_WFFN = WS_W + 2 * SZ_LAYERW;
static_assert(WS_WFFN + SZ_FFNW <= 53 * MiB, "weights");
constexpr size_t WS_H = 53 * MiB;
constexpr size_t WS_O4 = 117 * MiB;
constexpr size_t WS_F = WS_O4;
constexpr size_t WS_BD = 181 * MiB;
constexpr size_t WS_DEC = 183 * MiB;
constexpr size_t WS_PROJ = 185 * MiB;
constexpr size_t WS_UW = 361 * MiB;
constexpr size_t WS_AB = 425 * MiB;
constexpr size_t WS_ST = 489 * MiB;
constexpr size_t WS_PBUF = 185 * MiB;
constexpr size_t WS_MERGED = 441 * MiB;
constexpr size_t WS_ACT0 = 185 * MiB;
constexpr size_t WS_H2B = 479 * MiB;
constexpr size_t WS_MOEW = 185 * MiB;
constexpr size_t WS_ACT1 = 1 * MiB;
constexpr size_t WS_Y = 317 * MiB;
constexpr size_t WS_ROUTE = 449 * MiB;
constexpr size_t WS_END = 543 * MiB;
static_assert(WS_ACT1 + (size_t)MOE_PASS_TILES * 256 * DFF * 2 <= WS_MOEW, "act1");
static_assert(WS_MOEW + 8 * SZ_FFNW <= WS_Y && WS_Y + (size_t)264 * 256 * D * 2 <= WS_ROUTE && WS_ROUTE + 4 * MiB <= WS_H2B && WS_H2B + 64 * MiB <= WS_END, "moe map");
static_assert(WS_PROJ + (size_t)NTOK * NPROJ * 2 <= WS_UW && WS_ST + (size_t)NINST * 8192 <= WS_END, "mixer map");
constexpr int CW_TMO = 0, CW_CODE = 1;
constexpr int CW_BAR = 4096;
constexpr int CW_MOD = 16384;
constexpr int CW_MOECNT = 65536;
static_assert(CW_MOD + NLAYER * BATCH * 6 * D <= CW_MOECNT && (CW_MOECNT + 8 * 64) * 4 <= (int)CTL_ZERO_BYTES, "ctl");

constexpr int RING_OFF = 0, RING_BYTES = 131072;
constexpr int LDS_BYTES = 160 * 1024;
constexpr int MISC_OFF = LDS_BYTES - 256;

#define GAS __attribute__((address_space(1)))
#define LAS __attribute__((address_space(3)))
typedef unsigned short bf16;
typedef unsigned v4u __attribute__((ext_vector_type(4)));
typedef unsigned v2u __attribute__((ext_vector_type(2)));
typedef float f32x4 __attribute__((ext_vector_type(4)));
typedef float f32x16 __attribute__((ext_vector_type(16)));
typedef short bf16x8 __attribute__((ext_vector_type(8)));
typedef short bf16x4 __attribute__((ext_vector_type(4)));
typedef GAS unsigned gu32;
#define RLX_AGENT __ATOMIC_RELAXED, __HIP_MEMORY_SCOPE_AGENT
#define LDS_WAIT() asm volatile("s_waitcnt lgkmcnt(0)" ::: "memory")
#define VM_WAIT() asm volatile("s_waitcnt vmcnt(0)" ::: "memory")
__device__ __forceinline__ unsigned f2bf(float f) { unsigned u = __builtin_bit_cast(unsigned, f); return (u + 0x7fffu + ((u >> 16) & 1u)) >> 16; }
__device__ __forceinline__ unsigned pk2(float lo, float hi) { return f2bf(lo) | (f2bf(hi) << 16); }
__device__ __forceinline__ float bf2f(unsigned b) { return __builtin_bit_cast(float, b << 16); }
__device__ __forceinline__ float bflo(unsigned w) { return __builtin_bit_cast(float, w << 16); }
__device__ __forceinline__ float bfhi(unsigned w) { return __builtin_bit_cast(float, w & 0xffff0000u); }
__device__ __forceinline__ float fast_exp2(float x) { return __builtin_amdgcn_exp2f(x); }
__device__ __forceinline__ float fast_exp(float x) { return __builtin_amdgcn_exp2f(x * 1.4426950408889634f); }
__device__ __forceinline__ float fast_rcp(float x) { return __builtin_amdgcn_rcpf(x); }
__device__ __forceinline__ float sigmoidf_(float x) { return fast_rcp(1.f + fast_exp(-x)); }
__device__ __forceinline__ float siluf_(float x) { return x * sigmoidf_(x); }
__device__ __forceinline__ float wave_sum(float v) {
#pragma unroll
    for (int o = 1; o < 64; o <<= 1) v += __shfl_xor(v, o);
    return v;
}

#define XB_TMO      128
#define XB_XCNT(j)  (256  + 64 * (j))
#define XB_XSUB(j)  (1280 + 64 * (j))
#define XB_XGEN(j)  (2304 + 64 * (j))
#define XB_TOP      3328
#define XB_TOPGEN   3392
#define XCD_BAR_WORDS 3456
#define XB_SPIN_CAP (1u << 22)
__device__ __forceinline__ unsigned xb_ld(unsigned* p)              { return __hip_atomic_load(p, __ATOMIC_RELAXED, __HIP_MEMORY_SCOPE_AGENT); }
__device__ __forceinline__ unsigned xb_add(unsigned* p, unsigned v) { return __hip_atomic_fetch_add(p, v, __ATOMIC_RELAXED, __HIP_MEMORY_SCOPE_AGENT); }
__device__ __forceinline__ unsigned xb_xcc_id() { return (unsigned)__builtin_amdgcn_s_getreg((3 << 11) | 20) & 0xFu; }
#define XB_SPIN(cond, bar) do { unsigned _sp = 0; while (cond) { __builtin_amdgcn_s_sleep(1); \
    if ((++_sp & 255u) == 0u) { if (xb_ld(&(bar)[XB_TMO])) break; if (_sp > XB_SPIN_CAP) { atomicAdd(&(bar)[XB_TMO], 1u); break; } } } } while (0)
struct XcdBarrier { unsigned* bar; unsigned x; volatile LAS unsigned* st; };
__device__ __forceinline__ XcdBarrier xcd_barrier_post(unsigned* bar, volatile LAS unsigned* st) {
    XcdBarrier b; b.bar = bar; b.x = xb_xcc_id(); b.st = st;
    if (threadIdx.x == 0) (void)xb_add(&bar[XB_XCNT(b.x)], 1u);
    return b;
}
__device__ __forceinline__ void xcd_barrier_complete(unsigned* bar, unsigned x, unsigned& nloc, unsigned& nx) {
    const unsigned G = gridDim.x * gridDim.y * gridDim.z;
    unsigned sum, cnt, mine, sp = 0u;
    for (;;) {
        sum = 0u; cnt = 0u; mine = 0u;
#pragma unroll
        for (unsigned j = 0; j < 16; ++j) { const unsigned c = xb_ld(&bar[XB_XCNT(j)]); sum += c; cnt += (c > 0u) ? 1u : 0u; }
        mine = xb_ld(&bar[XB_XCNT(x)]);
        if (sum == G) break;
        __builtin_amdgcn_s_sleep(1);
        if ((++sp & 255u) == 0u) { if (xb_ld(&bar[XB_TMO])) break; if (sp > XB_SPIN_CAP) { atomicAdd(&bar[XB_TMO], 1u); break; } }
    }
    nloc = mine > 0u ? mine : 1u; nx = cnt > 0u ? cnt : 1u;
}
__device__ __forceinline__ void xcd_barrier(const XcdBarrier& b) {
    asm volatile("s_waitcnt vmcnt(0)" ::: "memory");
    __syncthreads();
    if (threadIdx.x == 0) {
        unsigned* bar = b.bar;
        __builtin_amdgcn_s_waitcnt(0);
        unsigned nloc = b.st[0], nx = b.st[1];
        if (nloc == 0u) { xcd_barrier_complete(bar, b.x, nloc, nx); b.st[0] = nloc; b.st[1] = nx; }
        const unsigned old = xb_add(&bar[XB_XSUB(b.x)], 1u);
        const unsigned gen = old / nloc;
        if (old + 1u == (gen + 1u) * nloc) {
            __builtin_amdgcn_fence(__ATOMIC_RELEASE, "agent");
            asm volatile("s_waitcnt vmcnt(0)" ::: "memory");
            const unsigned og = xb_add(&bar[XB_TOP], 1u);
            const unsigned tg = og / nx;
            if (og + 1u == (tg + 1u) * nx) xb_add(&bar[XB_TOPGEN], 1u);
            else XB_SPIN(xb_ld(&bar[XB_TOPGEN]) == tg, bar);
            __builtin_amdgcn_fence(__ATOMIC_ACQUIRE, "agent");
            xb_add(&bar[XB_XGEN(b.x)], 1u);
            asm volatile("s_waitcnt vmcnt(0)" ::: "memory");
        } else {
            XB_SPIN(xb_ld(&bar[XB_XGEN(b.x)]) == gen, bar);
            __builtin_amdgcn_fence(__ATOMIC_ACQUIRE, "agent");
            asm volatile("s_waitcnt vmcnt(0)" ::: "memory");
        }
    }
    __syncthreads();
}

struct Frame {
    LAS unsigned char* lds;
    volatile LAS unsigned* MISC;
    gu32* ctl;
    int tid, lane, wave;
    int vcu, G;
    unsigned char* ws;
    float* out;
    const float* const* in;
};
enum { I_X = 0, I_C, I_ADAW, I_ADAB, I_NMIXPRE, I_NMIXPOST, I_NFFNPRE, I_NFFNPOST, I_WIN, I_DLAMBDA, I_DSUBLN, I_POOLW, I_POOLSCALE, I_SCONVW, I_DCONVW, I_DALOG, I_DDTBIAS, I_DNORM,
       I_WBRANCH, I_WMERGE, I_BMERGE, I_WO, I_FFNG, I_FFNU, I_FFND, I_ROUTERW, I_ROUTERB, I_MOEG, I_MOEU, I_MOED, N_INPUTS };

__device__ __forceinline__ void cvt_item(const float* W, int ldw, int k0, int n0, bf16* WT, int Kd, int drow0, LAS float* scr, int lane) {
#pragma unroll 8
    for (int i = 0; i < 32; ++i) { const int kk = 2 * i + (lane >> 5); scr[kk * 33 + (lane & 31)] = W[(size_t)(k0 + kk) * ldw + n0 + (lane & 31)]; }
    LDS_WAIT(); asm volatile("" ::: "memory");
    const int c = lane & 7;
#pragma unroll
    for (int j = 0; j < 4; ++j) { const int n = (lane >> 3) + 8 * j; const LAS float* s = scr + (8 * c) * 33 + n;
        v4u o; o.x = pk2(s[0 * 33], s[1 * 33]); o.y = pk2(s[2 * 33], s[3 * 33]); o.z = pk2(s[4 * 33], s[5 * 33]); o.w = pk2(s[6 * 33], s[7 * 33]);
        *(GAS v4u*)(WT + (size_t)(drow0 + n) * Kd + k0 + 8 * c) = o; }
    LDS_WAIT(); asm volatile("" ::: "memory");
}
__device__ __forceinline__ void cvt_ffn_item(const float* wg, const float* wu, const float* wd, bf16* Wgu, bf16* Wd, int r, LAS float* scr, int lane) {
    constexpr int IG = (D / 64) * (DFF / 32);
    if (r < IG) { const int kb = r / (DFF / 32), nb = r % (DFF / 32), n0 = nb * 32; cvt_item(wg, DFF, kb * 64, n0, Wgu, D, 256 * (n0 >> 7) + (n0 & 127), scr, lane); return; } r -= IG;
    if (r < IG) { const int kb = r / (DFF / 32), nb = r % (DFF / 32), n0 = nb * 32; cvt_item(wu, DFF, kb * 64, n0, Wgu, D, 256 * (n0 >> 7) + (n0 & 127) + 128, scr, lane); return; } r -= IG;
    { const int kb = r / (D / 32), nb = r % (D / 32); cvt_item(wd, D, kb * 64, nb * 32, Wd, DFF, nb * 32, scr, lane); }
}
constexpr int FFN_ITEMS = 3 * (D / 64) * (DFF / 32);
__device__ __forceinline__ bf16* w_in_t(unsigned char* ws, int l) { return (bf16*)(ws + WS_W + (size_t)l * SZ_LAYERW); }
__device__ __forceinline__ bf16* w_m_t(unsigned char* ws, int l) { return (bf16*)(ws + WS_W + (size_t)l * SZ_LAYERW + SZ_WIN); }
__device__ __forceinline__ bf16* w_b_t(unsigned char* ws, int l) { return (bf16*)(ws + WS_W + (size_t)l * SZ_LAYERW + SZ_WIN + SZ_WM); }
__device__ __forceinline__ bf16* w_o_t(unsigned char* ws, int l) { return (bf16*)(ws + WS_W + (size_t)l * SZ_LAYERW + SZ_WIN + SZ_WM + SZ_WB); }

__device__ __forceinline__ void p_prologue(Frame& F) {
    LAS float* scr = (LAS float*)(F.lds + RING_OFF + F.wave * 16384);
    const int gw = F.vcu * NWAVES + F.wave, NGW = F.G * NWAVES;
    constexpr int I_IN = (D / 64) * (NPROJ / 32), I_M = (D / 64) * (D / 32), I_B = (256 / 64) * (D / 32);
    constexpr int PER_LAYER = I_IN + 4 * I_M + 4 * I_B + I_M;
    constexpr int NITEMS = NLAYER * PER_LAYER + FFN_ITEMS;
    for (int it = gw; it < NITEMS; it += NGW) {
        int r = it;
        if (r >= NLAYER * PER_LAYER) { r -= NLAYER * PER_LAYER;
            cvt_ffn_item(F.in[I_FFNG], F.in[I_FFNU], F.in[I_FFND], (bf16*)(F.ws + WS_WFFN), (bf16*)(F.ws + WS_WFFN + SZ_WGU), r, scr, F.lane); continue; }
        const int l = r / PER_LAYER; r -= l * PER_LAYER;
        if (r < I_IN) { const int kb = r / (NPROJ / 32), nb = r % (NPROJ / 32); cvt_item(F.in[I_WIN] + (size_t)l * D * IN_COLS, IN_COLS, kb * 64, nb * 32, w_in_t(F.ws, l), D, nb * 32, scr, F.lane); continue; } r -= I_IN;
        if (r < 4 * I_M) { const int i = r / I_M; r -= i * I_M; const int kb = r / (D / 32), nb = r % (D / 32);
            cvt_item(F.in[I_WMERGE] + ((size_t)l * 4 + i) * D * D, D, kb * 64, nb * 32, w_m_t(F.ws, l), D, i * 1024 + nb * 32, scr, F.lane); continue; } r -= 4 * I_M;
        if (r < 4 * I_B) { const int i = r / I_B; r -= i * I_B; const int kb = r / (D / 32), nb = r % (D / 32);
            cvt_item(F.in[I_WBRANCH] + ((size_t)l * 4 + i) * 256 * D, D, kb * 64, nb * 32, w_b_t(F.ws, l) + (size_t)i * 1024 * 256, 256, nb * 32, scr, F.lane); continue; } r -= 4 * I_B;
        { const int kb = r / (D / 32), nb = r % (D / 32); cvt_item(F.in[I_WO] + (size_t)l * D * D, D, kb * 64, nb * 32, w_o_t(F.ws, l), D, nb * 32, scr, F.lane); }
    }
    constexpr int MOD_ITEMS = NLAYER * 24;
    for (int it = gw; it < MOD_ITEMS; it += NGW) {
        const int l = it / 24, nb = it % 24;
        const float* Wp = F.in[I_ADAW] + (size_t)l * D * (6 * D) + nb * 256 + F.lane * 4;
        f32x4 a0 = {0.f, 0.f, 0.f, 0.f}, a1 = {0.f, 0.f, 0.f, 0.f};
#pragma unroll 8
        for (int k = 0; k < D; ++k) { const f32x4 w = *(const GAS f32x4*)(Wp + (size_t)k * (6 * D));
            const float c0 = siluf_(F.in[I_C][k]), c1 = siluf_(F.in[I_C][D + k]); a0 += w * c0; a1 += w * c1; }
        float* m0 = (float*)(F.ctl + CW_MOD) + (size_t)(l * BATCH + 0) * 6 * D + nb * 256 + F.lane * 4;
        *(GAS f32x4*)m0 = a0; *(GAS f32x4*)(m0 + 6 * D) = a1;
    }
}
__device__ __forceinline__ void p_moe_cvt(Frame& F) {
    LAS float* scr = (LAS float*)(F.lds + RING_OFF + F.wave * 16384);
    const int gw = F.vcu * NWAVES + F.wave, NGW = F.G * NWAVES;
    for (int it = gw; it < NEXP * FFN_ITEMS; it += NGW) {
        const int e = it / FFN_ITEMS, r = it % FFN_ITEMS;
        bf16* base = (bf16*)(F.ws + WS_MOEW + (size_t)e * SZ_FFNW);
        cvt_ffn_item(F.in[I_MOEG] + (size_t)e * D * DFF, F.in[I_MOEU] + (size_t)e * D * DFF, F.in[I_MOED] + (size_t)e * DFF * D, base, (bf16*)((unsigned char*)base + SZ_WGU), r, scr, F.lane);
    }
}

struct Row { f32x4 v[4]; };
__device__ __forceinline__ float modv(Frame& F, int l, int b, int idx) { return ((const float*)(F.ctl + CW_MOD))[(size_t)(l * BATCH + b) * 6 * D + idx] + F.in[I_ADAB][l * 6 * D + idx]; }
__device__ __forceinline__ f32x4 modv4(Frame& F, int l, int b, int idx) {
    const f32x4 a = *(const GAS f32x4*)((const float*)(F.ctl + CW_MOD) + (size_t)(l * BATCH + b) * 6 * D + idx), c = *(const GAS f32x4*)(F.in[I_ADAB] + l * 6 * D + idx); return a + c; }
__device__ __forceinline__ float row_rstd(const Row& r) {
    float s = 0.f;
#pragma unroll
    for (int j = 0; j < 4; ++j) s += (r.v[j].x * r.v[j].x + r.v[j].y * r.v[j].y) + (r.v[j].z * r.v[j].z + r.v[j].w * r.v[j].w);
    return 1.f / sqrtf(wave_sum(s) * (1.f / D) + EPS);
}
__device__ __forceinline__ void row_resid(Frame& F, Row& x, const Row& f, const float* gain, int l, int b, int gidx) {
    const float rs = row_rstd(f);
#pragma unroll
    for (int j = 0; j < 4; ++j) { const int c = 4 * F.lane + 256 * j; const f32x4 g = *(const GAS f32x4*)(gain + c), m = modv4(F, l, b, gidx + c); x.v[j] += m * (f.v[j] * rs * g); }
}
__device__ __forceinline__ void row_make_h(Frame& F, Row& h, const Row& x, const float* gain, int l, int b, int shidx, int scidx) {
    const float rs = row_rstd(x);
#pragma unroll
    for (int j = 0; j < 4; ++j) { const int c = 4 * F.lane + 256 * j; const f32x4 g = *(const GAS f32x4*)(gain + c), sc = modv4(F, l, b, scidx + c), sh = modv4(F, l, b, shidx + c);
        h.v[j] = (x.v[j] * rs * g) * (sc + 1.f) + sh; }
}
__device__ __forceinline__ void row_store_bf16(Frame& F, const Row& h, bf16* dst) {
    GAS unsigned long long* o8 = (GAS unsigned long long*)dst + F.lane;
#pragma unroll
    for (int j = 0; j < 4; ++j) o8[64 * j] = (unsigned long long)pk2(h.v[j].x, h.v[j].y) | ((unsigned long long)pk2(h.v[j].z, h.v[j].w) << 32);
}
__device__ __forceinline__ void row_load_f32(Frame& F, Row& r, const float* src) {
    const GAS f32x4* p = (const GAS f32x4*)src + F.lane;
#pragma unroll
    for (int j = 0; j < 4; ++j) r.v[j] = p[64 * j];
}
__device__ __forceinline__ void row_store_f32(Frame& F, const Row& r, float* dst) {
    GAS f32x4* p = (GAS f32x4*)dst + F.lane;
#pragma unroll
    for (int j = 0; j < 4; ++j) p[64 * j] = r.v[j];
}
__device__ __forceinline__ void row_load_bf16(Frame& F, Row& r, const bf16* src) {
    const GAS v2u* p = (const GAS v2u*)src + F.lane;
#pragma unroll
    for (int j = 0; j < 4; ++j) { const v2u w = p[64 * j]; r.v[j] = (f32x4){bflo(w.x), bfhi(w.x), bflo(w.y), bfhi(w.y)}; }
}
template <int NO> __device__ __forceinline__ void row_dots(Frame& F, const Row& h, const LAS float* WT, float (&out)[NO]) {
#pragma unroll
    for (int o = 0; o < NO; ++o) { float s = 0.f;
#pragma unroll
        for (int j = 0; j < 4; ++j) { const f32x4 w = *(const LAS f32x4*)(WT + o * 1024 + 4 * F.lane + 256 * j); s += (h.v[j].x * w.x + h.v[j].y * w.y) + (h.v[j].z * w.z + h.v[j].w * w.w); }
        out[o] = s; if ((o & 3) == 3) __builtin_amdgcn_sched_barrier(0); }
#pragma unroll
    for (int o = 0; o < NO; ++o) { out[o] = wave_sum(out[o]); if ((o & 3) == 3) __builtin_amdgcn_sched_barrier(0); }
}
template <int NO> __device__ __forceinline__ void load_wt(Frame& F, const float* W, int ldw, int col0, LAS float* WT) {
    for (int k = F.tid; k < 1024; k += NWAVES * 64) {
#pragma unroll
        for (int o = 0; o < NO; ++o) WT[o * 1024 + k] = W[(size_t)k * ldw + col0 + o];
    }
    __syncthreads();
}
__device__ __forceinline__ float softplusf_(float x) { return x > 20.f ? x : log1pf(__expf(x)); }
__device__ __forceinline__ void row_bd(Frame& F, const Row& h, const LAS float* W16T, int l, int row) {
    float o16[16]; row_dots<16>(F, h, W16T, o16);
    float mine = 0.f;
#pragma unroll
    for (int o = 0; o < 16; ++o) mine = (F.lane == o) ? o16[o] : mine;
    if (F.lane < 16) {
        float r;
        if (F.lane < 8) r = 1.f / (1.f + __expf(-mine));
        else { const int i = F.lane - 8; r = -__expf(F.in[I_DALOG][l * 8 + i]) * softplusf_(mine + F.in[I_DDTBIAS][l * 8 + i]); }
        ((float*)(F.ws + WS_BD))[(size_t)row * 16 + F.lane] = r;
    }
}
__device__ __forceinline__ void moe_tiles(Frame& F, int (&cnt)[NEXP], int (&tstart)[NEXP + 1]) {
    int acc = 0;
#pragma unroll
    for (int e = 0; e < NEXP; ++e) { cnt[e] = (int)__hip_atomic_load(F.ctl + CW_MOECNT + 64 * e, RLX_AGENT); tstart[e] = acc; acc += (cnt[e] + 255) >> 8; }
    tstart[NEXP] = acc;
}

constexpr int ROW_A = 0, ROW_B = 1, ROW_C = 2;
template <int MODE> __device__ __forceinline__ void p_rows(Frame& F, const int l) {
    const int gw = F.vcu * NWAVES + F.wave, NGW = F.G * NWAVES;
    LAS float* WT = (LAS float*)(F.lds + RING_OFF);
    LAS int* linfo = (LAS int*)(F.lds + RING_OFF + 65536);
    LAS int* lcnt = (LAS int*)(F.lds + RING_OFF + 65536 + 8 * 32 * 16);
    const bool do_h1 = (MODE == ROW_A) || (MODE == ROW_C && l + 1 < NLAYER);
    const int lh = (MODE == ROW_C) ? l + 1 : l;
    const bool router = (MODE == ROW_B) && (l == 1);
    if (do_h1) load_wt<16>(F, F.in[I_WIN] + (size_t)lh * D * IN_COLS, IN_COLS, NPROJ, WT);
    if (router) { if (F.tid < 16) lcnt[F.tid] = 0; load_wt<8>(F, F.in[I_ROUTERW], NEXP, 0, WT); }
    int cnt[NEXP], tstart[NEXP + 1];
    if (MODE == ROW_C && l == 1) moe_tiles(F, cnt, tstart);
    const float* xsrc = (MODE == ROW_A || (MODE == ROW_B && l == 0)) ? F.in[I_X] : F.out;
    int ri = 0;
    for (int m = gw; m < NTOK; m += NGW, ++ri) {
        const int b = m / SEQ;
        Row x; row_load_f32(F, x, xsrc + (size_t)m * D);
        if (MODE == ROW_B) {
            Row f; row_load_bf16(F, f, (const bf16*)(F.ws + WS_F) + (size_t)m * D);
            row_resid(F, x, f, F.in[I_NMIXPOST] + l * D, l, b, 2 * D);
            row_store_f32(F, x, F.out + (size_t)m * D);
            Row h; row_make_h(F, h, x, F.in[I_NFFNPRE] + l * D, l, b, 3 * D, 4 * D);
            row_store_bf16(F, h, (bf16*)(F.ws + (l == 0 ? WS_H : WS_H2B)) + (size_t)m * D);
            if (router) {
                float lg[NEXP]; row_dots<NEXP>(F, h, WT, lg);
                int e0 = 0; float l0 = lg[0] + F.in[I_ROUTERB][0];
#pragma unroll
                for (int e = 0; e < NEXP; ++e) lg[e] += F.in[I_ROUTERB][e];
#pragma unroll
                for (int e = 1; e < NEXP; ++e) if (lg[e] > l0) { l0 = lg[e]; e0 = e; }
                int e1 = -1; float l1 = -3.0e38f;
#pragma unroll
                for (int e = 0; e < NEXP; ++e) if (e != e0 && lg[e] > l1) { l1 = lg[e]; e1 = e; }
                const float q1 = __expf(l1 - l0), p0 = 1.f / (1.f + q1), p1 = q1 * p0;
                if (F.lane == 0) {
                    const int i0 = atomicAdd((int*)&lcnt[e0], 1), i1 = atomicAdd((int*)&lcnt[e1], 1);
                    LAS int* li = linfo + (F.wave * 32 + ri) * 4;
                    li[0] = e0 | (e1 << 8) | (i0 << 16); li[1] = i1; li[2] = __float_as_int(p0); li[3] = __float_as_int(p1);
                }
            }
        } else if (MODE == ROW_C) {
            Row f;
            if (l == 0) row_load_bf16(F, f, (const bf16*)(F.ws + WS_F) + (size_t)m * D);
            else {
                const int* ti = (const int*)(F.ws + WS_ROUTE) + (size_t)m * 8;
                const int e0 = ti[0], i0 = ti[1], e1 = ti[2], i1 = ti[3]; const float p0 = __int_as_float(ti[4]), p1 = __int_as_float(ti[5]);
                int s0 = 0, s1 = 0;
#pragma unroll
                for (int e = 0; e < NEXP; ++e) { s0 = (e == e0) ? tstart[e] * 256 + i0 : s0; s1 = (e == e1) ? tstart[e] * 256 + i1 : s1; }
                Row y0, y1; row_load_bf16(F, y0, (const bf16*)(F.ws + WS_Y) + (size_t)s0 * D); row_load_bf16(F, y1, (const bf16*)(F.ws + WS_Y) + (size_t)s1 * D);
#pragma unroll
                for (int j = 0; j < 4; ++j) f.v[j] = y0.v[j] * p0 + y1.v[j] * p1;
            }
            row_resid(F, x, f, F.in[I_NFFNPOST] + l * D, l, b, 5 * D);
            row_store_f32(F, x, F.out + (size_t)m * D);
        }
        if (do_h1) {
            Row h; row_make_h(F, h, x, F.in[I_NMIXPRE] + lh * D, lh, b, 0, 1 * D);
            row_store_bf16(F, h, (bf16*)(F.ws + WS_H) + (size_t)m * D);
            row_bd(F, h, WT, lh, m);
        }
    }
    if (router) {
        __syncthreads();
        if (F.tid < NEXP) lcnt[8 + F.tid] = (int)__hip_atomic_fetch_add(F.ctl + CW_MOECNT + 64 * F.tid, (unsigned)lcnt[F.tid], RLX_AGENT);
        __syncthreads();
        ri = 0;
        for (int m = gw; m < NTOK; m += NGW, ++ri) {
            if (F.lane == 0) {
                const LAS int* li = linfo + (F.wave * 32 + ri) * 4;
                const int w0 = li[0], e0 = w0 & 255, e1 = (w0 >> 8) & 255, i0 = (w0 >> 16) + lcnt[8 + e0], i1 = li[1] + lcnt[8 + e1];
                int* ti = (int*)(F.ws + WS_ROUTE) + (size_t)m * 8;
                ti[0] = e0; ti[1] = i0; ti[2] = e1; ti[3] = i1; ti[4] = li[2]; ti[5] = li[3];
                int* lists = (int*)(F.ws + WS_ROUTE + 1 * MiB);
                lists[(size_t)e0 * 65536 + i0] = m; lists[(size_t)e1 * 65536 + i1] = m;
            }
        }
    }
    __syncthreads();
}

namespace pg8 {
constexpr int NXCD = 8, WGM = 8;
struct SchedStd {
    int nM, nN, nwg, G, c; const char* A; size_t a_tile; const char* B; size_t b_tile;
    __device__ __forceinline__ void init(int nM_, int nN_, int G_, int c_, const void* A_, size_t a_tile_, const void* B_, size_t b_tile_) { nM = nM_; nN = nN_; nwg = nM * nN; G = G_; c = c_; A = (const char*)A_; a_tile = a_tile_; B = (const char*)B_; b_tile = b_tile_; }
    __device__ __forceinline__ bool next(int i, Unit& u) const {
        const long L = (long)i * G + c; if (L >= nwg) return false;
        int wgid = (int)L; { const int q = nwg / NXCD, r = nwg % NXCD, xcd = wgid % NXCD, off = wgid / NXCD; wgid = (xcd < r ? xcd * (q + 1) : r * (q + 1) + (xcd - r) * q) + off; }
        const int nig = WGM * nN, gid = wgid / nig, fm = gid * WGM, gsz = (nM - fm) < WGM ? (nM - fm) : WGM;
        u.pm = fm + ((wgid % nig) % gsz); u.pn = (wgid % nig) / gsz; u.aux = 0; u.pad = 0; u.a = A + (size_t)u.pm * a_tile; u.b = B + (size_t)u.pn * b_tile; u.rows = nullptr; return true;
    }
    __device__ __forceinline__ void a_ready(const Unit&) const {}
    __device__ __forceinline__ void done(const Unit&) const {}
};
struct SchedBranch {
    SchedStd s; const char* O4; const char* Wb;
    __device__ __forceinline__ bool next(int i, Unit& u) const {
        if (!s.next(i, u)) return false;
        const int br = u.pn >> 2; u.pn &= 3; u.aux = br;
        u.a = O4 + (size_t)u.pm * 256 * 1024 * 2 + (size_t)br * 256 * 2; u.b = Wb + (size_t)br * 1024 * 256 * 2 + (size_t)u.pn * 256 * 256 * 2; return true;
    }
    __device__ __forceinline__ void a_ready(const Unit&) const {}
    __device__ __forceinline__ void done(const Unit&) const {}
};
struct SchedGate {
    int vcu, G; const char* H; const char* Wm;
    __device__ __forceinline__ bool next(int i, Unit& u) const {
        const int tg = vcu + G * (i >> 2); if (tg >= 512) return false;
        u.pm = tg >> 2; u.pn = tg & 3; u.aux = i & 3; u.pad = 0; u.rows = nullptr;
        u.a = H + (size_t)u.pm * 256 * 1024 * 2; u.b = Wm + ((size_t)u.aux * 1024 + (size_t)u.pn * 256) * 1024 * 2; return true;
    }
    __device__ __forceinline__ void a_ready(const Unit&) const {}
    __device__ __forceinline__ void done(const Unit&) const {}
};
struct SchedMoe {
    int c, G, t0, t1, nN; int tstart[9]; int cnt[8];
    const char* A; const int* lists; const char* W; size_t w_tile; bool gather;
    __device__ __forceinline__ bool next(int i, Unit& u) const {
        const long L = (long)i * G + c; const int t = t0 + (int)(L / nN); if (t >= t1) return false;
        int e = 0;
#pragma unroll
        for (int k = 1; k < 8; ++k) e = (t >= tstart[k]) ? k : e;
        int ce = 0;
#pragma unroll
        for (int k = 0; k < 8; ++k) ce = (k == e) ? cnt[k] : ce;
        const int j = t - ((e == 0) ? 0 : 0), jj = t;
        (void)j; (void)jj;
        int ts = 0;
#pragma unroll
        for (int k = 0; k < 8; ++k) ts = (k == e) ? tstart[k] : ts;
        const int tj = t - ts;
        u.pn = (int)(L % nN); u.pad = 0;
        if (gather) { u.pm = t - t0; u.a = A; u.rows = lists + (size_t)e * 65536 + tj * 256; const int nv = ce - tj * 256; u.aux = nv > 256 ? 256 : nv; }
        else { u.pm = t; u.a = A + (size_t)(t - t0) * 256 * DFF_ * 2; u.rows = nullptr; u.aux = 0; }
        u.b = W + (size_t)e * SZ_EXP_ + (size_t)u.pn * w_tile; return true;
    }
    static constexpr size_t DFF_ = 2816; static constexpr size_t SZ_EXP_ = (size_t)2 * 2816 * 1024 * 2 + (size_t)1024 * 2816 * 2;
    __device__ __forceinline__ void a_ready(const Unit&) const {}
    __device__ __forceinline__ void done(const Unit&) const {}
};

struct EpiStore {
    static constexpr bool PERM = true;
    bf16_t* O; int ldc; size_t aux_stride; float scale0;
    __device__ __forceinline__ void operator()(const f32x4 (&acc)[2][2][4][2], const Unit& u, int wr, int wc, int fr, int fq) const {
        const int row0 = u.pm * BM + wr * 64 + fr, col0 = u.pn * BM + wc * 32 + 8 * fq; bf16_t* base = O + (size_t)u.aux * aux_stride;
        const float sc = (u.pn == 0) ? scale0 : 1.f;
#pragma unroll
        for (int ai = 0; ai < 2; ++ai)
#pragma unroll
            for (int m = 0; m < 4; ++m) { bf16_t* rowp = base + (size_t)(row0 + ai * HALF + m * 16) * ldc + col0;
#pragma unroll
                for (int bj = 0; bj < 2; ++bj) { const f32x4 v0 = acc[ai][bj][m][0] * sc, v1 = acc[ai][bj][m][1] * sc;
                    u32x4 w; w.x = cvt_pk_bf16(v0[0], v0[1]); w.y = cvt_pk_bf16(v0[2], v0[3]); w.z = cvt_pk_bf16(v1[0], v1[1]); w.w = cvt_pk_bf16(v1[2], v1[3]);
                    *(u32x4*)(rowp + bj * HALF) = w; } }
    }
};
__device__ __forceinline__ float sigm(float x) { return __builtin_amdgcn_rcpf(1.f + __builtin_amdgcn_exp2f(-1.4426950408889634f * x)); }
struct EpiGate {
    static constexpr bool PERM = true;
    const bf16_t* P; bf16_t* Mg; const float* bias;
    __device__ __forceinline__ void operator()(const f32x4 (&acc)[2][2][4][2], const Unit& u, int wr, int wc, int fr, int fq) const {
        const int row0 = u.pm * BM + wr * 64 + fr, col0 = u.pn * BM + wc * 32 + 8 * fq; const int br = u.aux;
        const bf16_t* Pb = P + (size_t)br * 32768 * 1024; const float* bb = bias + br * 1024 + col0;
        f32x4 bv[2][2];
#pragma unroll
        for (int bj = 0; bj < 2; ++bj)
#pragma unroll
            for (int n = 0; n < 2; ++n) bv[bj][n] = *(const f32x4*)(bb + bj * HALF + 4 * n);
#pragma unroll
        for (int ai = 0; ai < 2; ++ai)
#pragma unroll
            for (int m = 0; m < 4; ++m) { const size_t ro = (size_t)(row0 + ai * HALF + m * 16) * 1024 + col0;
#pragma unroll
                for (int bj = 0; bj < 2; ++bj) {
                    const u32x4 pw = *(const u32x4*)(Pb + ro + bj * HALF);
                    u32x4 mw = {0u, 0u, 0u, 0u}; if (br != 0) mw = *(const u32x4*)(Mg + ro + bj * HALF);
                    float o[8];
#pragma unroll
                    for (int q = 0; q < 4; ++q) {
                        const float g0 = sigm(acc[ai][bj][m][q >> 1][(q & 1) * 2] + bv[bj][q >> 1][(q & 1) * 2]), g1 = sigm(acc[ai][bj][m][q >> 1][(q & 1) * 2 + 1] + bv[bj][q >> 1][(q & 1) * 2 + 1]);
                        o[2 * q] = g0 * __builtin_bit_cast(float, pw[q] << 16) + __builtin_bit_cast(float, mw[q] << 16);
                        o[2 * q + 1] = g1 * __builtin_bit_cast(float, pw[q] & 0xffff0000u) + __builtin_bit_cast(float, mw[q] & 0xffff0000u);
                    }
                    u32x4 w; w.x = cvt_pk_bf16(o[0], o[1]); w.y = cvt_pk_bf16(o[2], o[3]); w.z = cvt_pk_bf16(o[4], o[5]); w.w = cvt_pk_bf16(o[6], o[7]);
                    *(u32x4*)(Mg + ro + bj * HALF) = w; } }
    }
};
struct EpiSwiGLU {
    static constexpr bool PERM = true;
    bf16_t* O; int ldc;
    __device__ __forceinline__ void operator()(const f32x4 (&acc)[2][2][4][2], const Unit& u, int wr, int wc, int fr, int fq) const {
        const int row0 = u.pm * BM + wr * 64 + fr, col0 = u.pn * HALF + wc * 32 + 8 * fq;
#pragma unroll
        for (int ai = 0; ai < 2; ++ai)
#pragma unroll
            for (int m = 0; m < 4; ++m) { bf16_t* rowp = O + (size_t)(row0 + ai * HALF + m * 16) * ldc + col0;
                float o[8];
#pragma unroll
                for (int n = 0; n < 2; ++n)
#pragma unroll
                    for (int q = 0; q < 4; ++q) { const float g = acc[ai][0][m][n][q], up = acc[ai][1][m][n][q]; o[4 * n + q] = g * sigm(g) * up; }
                u32x4 w; w.x = cvt_pk_bf16(o[0], o[1]); w.y = cvt_pk_bf16(o[2], o[3]); w.z = cvt_pk_bf16(o[4], o[5]); w.w = cvt_pk_bf16(o[6], o[7]);
                *(u32x4*)rowp = w; }
    }
};
}

namespace att {
constexpr int KP = 40, VP = 68;
constexpr int K1_OFF = 0, K2_OFF = 64 * KP * 2, VT_OFF = 2 * 64 * KP * 2, BUF_BYTES = VT_OFF + 64 * VP * 2;
constexpr int ATTN_LDS = 2 * BUF_BYTES;
__device__ __forceinline__ unsigned cvtpk(float lo, float hi) { typedef float f2 __attribute__((ext_vector_type(2))); typedef __bf16 b2 __attribute__((ext_vector_type(2))); f2 v = {lo, hi}; b2 b = __builtin_convertvector(v, b2); return __builtin_bit_cast(unsigned, b); }

__device__ __forceinline__ void attn_unit(Frame& F, const int layer, const int b, const int h, const int qb) {
    const int tid = F.tid, lane = F.lane, r32 = lane & 31, hi = lane >> 5, wid = F.wave;
    const bf16* P = (const bf16*)(F.ws + WS_PROJ) + (size_t)b * SEQ * NPROJ;
    LAS unsigned char* L = F.lds + RING_OFF;
    const int q = qb * 256 + wid * 32 + r32;
    const float slope2 = exp2f(-2.f * (float)(h + 1)) * 1.4426950408889634f;
    bf16x8 q1f[2], q2f[2];
#pragma unroll
    for (int ks = 0; ks < 2; ++ks) { q1f[ks] = *(const GAS bf16x8*)(P + (size_t)q * NPROJ + C_Q + 32 * h + 16 * ks + 8 * hi); q2f[ks] = *(const GAS bf16x8*)(P + (size_t)q * NPROJ + C_Q + 128 + 32 * h + 16 * ks + 8 * hi); }
    const int srow = tid >> 3, sch = tid & 7;
    const bf16* ksrc = P + (size_t)srow * NPROJ + (sch < 4 ? C_K + 32 * h + 8 * sch : C_K + 128 + 32 * h + 8 * (sch - 4));
    const bf16* vsrc = P + (size_t)srow * NPROJ + C_V + 64 * h + 8 * sch;
    const int kdst = (sch < 4 ? K1_OFF : K2_OFF) + srow * (KP * 2) + (sch & 3) * 16;
    const int vdst = VT_OFF + (8 * sch) * (VP * 2) + srow * 2;
    v4u kreg = *(const GAS v4u*)ksrc, vreg = *(const GAS v4u*)vsrc;
#define ATT_STAGE_WRITE(buf) do { LAS unsigned char* Bw = L + (buf) * BUF_BYTES; *(LAS v4u*)(Bw + kdst) = kreg; \
        _Pragma("unroll") for (int e = 0; e < 4; ++e) { const unsigned w = vreg[e]; *(LAS unsigned short*)(Bw + vdst + (2 * e) * (VP * 2)) = (unsigned short)(w & 0xffffu); *(LAS unsigned short*)(Bw + vdst + (2 * e + 1) * (VP * 2)) = (unsigned short)(w >> 16); } } while (0)
    ATT_STAGE_WRITE(0);
    __syncthreads();
    float R = 0.f, l1 = 0.f, l2 = 0.f;
    f32x16 O1[2], O2[2];
#pragma unroll
    for (int i = 0; i < 16; ++i) { O1[0][i] = 0.f; O1[1][i] = 0.f; O2[0][i] = 0.f; O2[1][i] = 0.f; }
    const int kfo = r32 * (KP * 2) + hi * 16;
    const int vfo = VT_OFF + r32 * (VP * 2) + hi * 8;
    constexpr int NT = SEQ / 64;
    for (int t = 0; t < NT; ++t) {
        if (t + 1 < NT) { kreg = *(const GAS v4u*)(ksrc + (size_t)(t + 1) * 64 * NPROJ); vreg = *(const GAS v4u*)(vsrc + (size_t)(t + 1) * 64 * NPROJ); }
        const LAS unsigned char* Bf = L + (t & 1) * BUF_BYTES;
        const float dl = (float)(q - t * 64 - 4 * hi);
        f32x16 c0, c1;
#pragma unroll
        for (int r = 0; r < 16; ++r) { const float cc = (float)((r & 3) + 8 * (r >> 2)); c0[r] = __builtin_fmaf(-slope2, __builtin_fabsf(dl - cc), -R); c1[r] = __builtin_fmaf(-slope2, __builtin_fabsf(dl - (cc + 32.f)), -R); }
#pragma unroll
        for (int mp = 0; mp < 2; ++mp) {
            const int koff = mp ? K2_OFF : K1_OFF;
            const bf16x8 qa = mp ? q2f[0] : q1f[0], qbb = mp ? q2f[1] : q1f[1];
            const bf16x8 k00 = *(const LAS bf16x8*)(Bf + koff + kfo), k01 = *(const LAS bf16x8*)(Bf + koff + kfo + 32);
            const bf16x8 k10 = *(const LAS bf16x8*)(Bf + koff + 32 * (KP * 2) + kfo), k11 = *(const LAS bf16x8*)(Bf + koff + 32 * (KP * 2) + kfo + 32);
            f32x16 s0 = __builtin_amdgcn_mfma_f32_32x32x16_bf16(k00, qa, c0, 0, 0, 0); s0 = __builtin_amdgcn_mfma_f32_32x32x16_bf16(k01, qbb, s0, 0, 0, 0);
            f32x16 s1 = __builtin_amdgcn_mfma_f32_32x32x16_bf16(k10, qa, c1, 0, 0, 0); s1 = __builtin_amdgcn_mfma_f32_32x32x16_bf16(k11, qbb, s1, 0, 0, 0);
            float rm = fmaxf(s0[0], s1[0]);
#pragma unroll
            for (int r = 1; r < 16; ++r) rm = fmaxf(rm, fmaxf(s0[r], s1[r]));
            rm = fmaxf(rm, __shfl_xor(rm, 32));
            if (__any(rm > 8.f)) {
                const float dd = fmaxf(rm, 0.f); R += dd;
                const float f = fast_exp2(-dd); l1 *= f; l2 *= f;
#pragma unroll
                for (int r = 0; r < 16; ++r) { s0[r] -= dd; s1[r] -= dd; c0[r] -= dd; c1[r] -= dd; O1[0][r] *= f; O1[1][r] *= f; O2[0][r] *= f; O2[1][r] *= f; }
            }
            float sum = 0.f;
#pragma unroll
            for (int r = 0; r < 16; ++r) { s0[r] = fast_exp2(s0[r]); s1[r] = fast_exp2(s1[r]); sum += s0[r] + s1[r]; }
            if (mp) l2 += sum; else l1 += sum;
            v4u pw[4];
#pragma unroll
            for (int e = 0; e < 4; ++e) { pw[0][e] = cvtpk(s0[2 * e], s0[2 * e + 1]); pw[1][e] = cvtpk(s0[8 + 2 * e], s0[8 + 2 * e + 1]); pw[2][e] = cvtpk(s1[2 * e], s1[2 * e + 1]); pw[3][e] = cvtpk(s1[8 + 2 * e], s1[8 + 2 * e + 1]); }
#pragma unroll
            for (int db = 0; db < 2; ++db) {
                f32x16 o = mp ? O2[db] : O1[db];
#pragma unroll
                for (int ks = 0; ks < 4; ++ks) {
                    const v2u lo = *(const LAS v2u*)(Bf + vfo + db * 32 * (VP * 2) + ks * 32), hi8 = *(const LAS v2u*)(Bf + vfo + db * 32 * (VP * 2) + ks * 32 + 16);
                    const v4u vf = {lo.x, lo.y, hi8.x, hi8.y};
                    o = __builtin_amdgcn_mfma_f32_32x32x16_bf16(__builtin_bit_cast(bf16x8, vf), __builtin_bit_cast(bf16x8, pw[ks]), o, 0, 0, 0);
                }
                if (mp) O2[db] = o; else O1[db] = o;
            }
        }
        if (t + 1 < NT) ATT_STAGE_WRITE((t + 1) & 1);
        __syncthreads();
    }
    l1 += __shfl_xor(l1, 32); l2 += __shfl_xor(l2, 32);
    const float* dlm = F.in[I_DLAMBDA] + layer * 128;
    float a1 = 0.f, a2 = 0.f;
#pragma unroll 8
    for (int i = 0; i < 32; ++i) { a1 += dlm[i] * dlm[32 + i]; a2 += dlm[64 + i] * dlm[96 + i]; }
    const float lam_init = 0.8f - 0.6f * __expf(-0.3f * (float)layer);
    const float lam = __expf(a1) - __expf(a2) + lam_init;
    const float i1 = 1.f / fmaxf(l1, 1e-30f), i2 = lam / fmaxf(l2, 1e-30f);
    float ss = 0.f;
#pragma unroll
    for (int db = 0; db < 2; ++db)
#pragma unroll
        for (int r = 0; r < 16; ++r) { const float v = O1[db][r] * i1 - O2[db][r] * i2; O1[db][r] = v; ss += v * v; }
    ss += __shfl_xor(ss, 32);
    const float rs = (1.f / sqrtf(ss * (1.f / 64.f) + EPS)) * (1.f - lam_init);
    bf16* orow = (bf16*)(F.ws + WS_O4) + ((size_t)b * SEQ + q) * 1024 + 64 * h;
    const float* sg = F.in[I_DSUBLN] + layer * 64;
#pragma unroll
    for (int db = 0; db < 2; ++db)
#pragma unroll
        for (int g4 = 0; g4 < 4; ++g4) {
            const int d0 = 32 * db + 8 * g4 + 4 * hi;
            const float v0 = O1[db][4 * g4] * rs * sg[d0], v1 = O1[db][4 * g4 + 1] * rs * sg[d0 + 1], v2 = O1[db][4 * g4 + 2] * rs * sg[d0 + 2], v3 = O1[db][4 * g4 + 3] * rs * sg[d0 + 3];
            v2u w = {pk2(v0, v1), pk2(v2, v3)};
            *(GAS v2u*)(orow + d0) = w;
        }
    __syncthreads();
#undef ATT_STAGE_WRITE
}
__device__ __forceinline__ void attn_phase(Frame& F, const int layer) {
    for (int i = 0; i < 2; ++i) {
        const int u = F.vcu * 2 + i; if (u >= BATCH * 4 * 64) break;
        attn_unit(F, layer, u >> 8, (u >> 6) & 3, u & 63);
    }
}
}

namespace pc {
constexpr int MPITCH = 72;
__device__ __forceinline__ void poolconv_phase(Frame& F, const int layer) {
    const int lane = F.lane, r32 = lane & 31, hi = lane >> 5, wid = F.wave;
    const bf16* P = (const bf16*)(F.ws + WS_PROJ);
    bf16* O4 = (bf16*)(F.ws + WS_O4);
    LAS unsigned char* mimg = F.lds + RING_OFF + wid * (64 * MPITCH * 2);
    bf16x8 wf[2][4];
    if (wid < 4) {
        const float* W = F.in[I_POOLW] + ((size_t)layer * 4 + wid) * 64 * 64;
#pragma unroll
        for (int nb = 0; nb < 2; ++nb)
#pragma unroll
            for (int ks = 0; ks < 4; ++ks) { v4u t;
#pragma unroll
                for (int jj = 0; jj < 4; ++jj) t[jj] = pk2(W[(16 * ks + 8 * hi + 2 * jj) * 64 + r32 + 32 * nb], W[(16 * ks + 8 * hi + 2 * jj + 1) * 64 + r32 + 32 * nb]);
                wf[nb][ks] = __builtin_bit_cast(bf16x8, t); }
    }
    for (int tile = F.vcu; tile < NTOK / 64; tile += F.G) {
        const int t0 = tile * 64, s0 = t0 % SEQ;
        if (wid < 4) {
            const int g = wid, hw = 1 << g;
            const bf16* src = P + (size_t)t0 * NPROJ + C_PIN + 64 * g + lane;
            float cs[81]; cs[0] = 0.f;
#pragma unroll
            for (int i = 0; i < 80; ++i) { const int s = s0 - 8 + i; float v = 0.f; if (s >= 0 && s < SEQ) v = bf2f(src[(long)(i - 8) * NPROJ]); cs[i + 1] = cs[i] + v; }
#pragma unroll
            for (int i = 0; i < 64; ++i) {
                const int s = s0 + i; int lo = s - hw, hiw = s + hw; lo = lo < 0 ? 0 : lo; hiw = hiw > SEQ ? SEQ : hiw;
                float wsum = 0.f;
                if (g == 0) wsum = cs[i + 8 + 1] - cs[i + 8 - 1]; else if (g == 1) wsum = cs[i + 8 + 2] - cs[i + 8 - 2]; else if (g == 2) wsum = cs[i + 8 + 4] - cs[i + 8 - 4]; else wsum = cs[i + 8 + 8] - cs[i + 8 - 8];
                const float pv = cs[i + 9] - cs[i + 8];
                const float mval = wsum / (float)(hiw - lo) - pv;
                *(LAS unsigned short*)(mimg + i * (MPITCH * 2) + lane * 2) = (unsigned short)f2bf(mval);
            }
            LDS_WAIT();
#pragma unroll
            for (int tb = 0; tb < 2; ++tb) {
                bf16x8 af[4];
#pragma unroll
                for (int ks = 0; ks < 4; ++ks) af[ks] = *(const LAS bf16x8*)(mimg + (r32 + 32 * tb) * (MPITCH * 2) + (16 * ks + 8 * hi) * 2);
#pragma unroll
                for (int nb = 0; nb < 2; ++nb) {
                    f32x16 acc;
#pragma unroll
                    for (int r = 0; r < 16; ++r) acc[r] = 0.f;
#pragma unroll
                    for (int ks = 0; ks < 4; ++ks) acc = __builtin_amdgcn_mfma_f32_32x32x16_bf16(af[ks], wf[nb][ks], acc, 0, 0, 0);
                    const int e = r32 + 32 * nb; const float sc = F.in[I_POOLSCALE][layer * 256 + 64 * g + e];
#pragma unroll
                    for (int r = 0; r < 16; ++r) { const int row = 32 * tb + (r & 3) + 8 * (r >> 2) + 4 * hi;
                        O4[(size_t)(t0 + row) * 1024 + 256 + 64 * g + e] = (bf16)f2bf(acc[r] * sc); }
                }
            }
            LDS_WAIT();
        } else {
            const int ch = 64 * (wid - 4) + lane;
            const float w0 = F.in[I_SCONVW][layer * 768 + ch], w1 = F.in[I_SCONVW][layer * 768 + 256 + ch], w2 = F.in[I_SCONVW][layer * 768 + 512 + ch];
            const bf16* base = P + (size_t)t0 * NPROJ + ch;
            float zm = 0.f, z0 = 0.f, zp = 0.f;
            if (s0 > 0) zm = bf2f(base[-(long)NPROJ + C_CC]) * bf2f(base[-(long)NPROJ + C_CX]);
            z0 = bf2f(base[C_CC]) * bf2f(base[C_CX]);
#pragma unroll 8
            for (int i = 0; i < 64; ++i) {
                zp = 0.f; if (s0 + i + 1 < SEQ) zp = bf2f(base[(long)(i + 1) * NPROJ + C_CC]) * bf2f(base[(long)(i + 1) * NPROJ + C_CX]);
                const float cbv = bf2f(base[(long)i * NPROJ + C_CB]);
                O4[(size_t)(t0 + i) * 1024 + 512 + ch] = (bf16)f2bf(cbv * (w0 * zm + w1 * z0 + w2 * zp));
                zm = z0; z0 = zp;
            }
        }
    }
    __syncthreads();
}
}

namespace dl {
constexpr int MP = 72, MB = 64 * MP * 2;
constexpr int WAVE_LDS = 2 * MB + 2 * MB;
__device__ __forceinline__ int crow(int r, int hi) { return (r & 3) + 8 * (r >> 2) + 4 * hi; }
__device__ __forceinline__ bf16x8 ldfrag(const LAS unsigned char* img, int row, int col) { return *(const LAS bf16x8*)(img + row * (MP * 2) + col * 2); }
__device__ __forceinline__ bf16x8 ldfragp(const LAS unsigned char* img, int row, int col4) {
    const v2u lo = *(const LAS v2u*)(img + row * (MP * 2) + col4 * 2), hi8 = *(const LAS v2u*)(img + row * (MP * 2) + col4 * 2 + 16); const v4u t = {lo.x, lo.y, hi8.x, hi8.y}; return __builtin_bit_cast(bf16x8, t); }
__device__ __forceinline__ bf16x8 cfrag(const f32x16& x, int half) {
    v4u t;
#pragma unroll
    for (int e = 0; e < 4; ++e) t[e] = att::cvtpk(x[8 * half + 2 * e], x[8 * half + 2 * e + 1]);
    return __builtin_bit_cast(bf16x8, t); }
#define MFMA32(a, b, c) __builtin_amdgcn_mfma_f32_32x32x16_bf16((a), (b), (c), 0, 0, 0)
#define SB() __builtin_amdgcn_sched_barrier(0)
#define LAUNDER() do { asm volatile("" : "+v"(lane)); r32 = lane & 31; hi = lane >> 5; } while (0)
__device__ __forceinline__ f32x16 zero16() { f32x16 z;
#pragma unroll
    for (int r = 0; r < 16; ++r) z[r] = 0.f;
    return z; }

#define DL_CONV(colbase, wbase, EMIT) do { \
    const bf16* src_ = P + (size_t)tok0 * NPROJ + (colbase) + lane; \
    const float cw0 = cwp[(wbase) + lane], cw1 = cwp[768 + (wbase) + lane], cw2 = cwp[2 * 768 + (wbase) + lane], cw3 = cwp[3 * 768 + (wbase) + lane], cw4 = cwp[4 * 768 + (wbase) + lane]; \
    float x0 = 0.f, x1 = 0.f, x2 = 0.f, x3 = 0.f, x4 = 0.f; \
    if (s0 >= 2) x1 = bf2f(src_[-2 * (long)NPROJ]); if (s0 >= 1) x2 = bf2f(src_[-1 * (long)NPROJ]); x3 = bf2f(src_[0]); x4 = bf2f(src_[(long)NPROJ]); \
    _Pragma("unroll 4") for (int i = 0; i < 64; ++i) { x0 = x1; x1 = x2; x2 = x3; x3 = x4; x4 = 0.f; if (s0 + i + 2 < SEQ) x4 = bf2f(src_[(long)(i + 2) * NPROJ]); \
        const float cv_ = cw0 * x0 + cw1 * x1 + cw2 * x2 + cw3 * x3 + cw4 * x4; const float val = cv_ * sigmoidf_(cv_); EMIT; } } while (0)

__device__ __forceinline__ void d1_instance(Frame& F, const int layer, const int b, const int h, const int norig, const int dir, LAS unsigned char* W, LAS float* tab) {
    int lane = F.lane, r32, hi; LAUNDER();
    const bf16* P = (const bf16*)(F.ws + WS_PROJ);
    const float* cwp = F.in[I_DCONVW] + (size_t)layer * 5 * 768;
    const int s0 = norig * 64, tok0 = b * SEQ + s0;
    const int npr = dir ? 255 - norig : norig;
    const int inst = ((b * 4 + h) * 2 + dir) * NCHUNK + npr;
    LAS unsigned char* VT = W;
    LAS unsigned char* KT = W + MB;
    LAS unsigned char* KR = W + 2 * MB;
    LAS unsigned char* T2 = W + 3 * MB;
    LAS float* SM = (LAS float*)(W + 2 * MB);
    DL_CONV(C_DK + 64 * h, 256 + 64 * h, { const float ss = wave_sum(val * val); const float kn = val * (1.f / sqrtf(ss + EPS)); const int ip = dir ? 63 - i : i; const unsigned short kb = (unsigned short)f2bf(kn);
        *(LAS unsigned short*)(KR + ip * (MP * 2) + lane * 2) = kb; *(LAS unsigned short*)(KT + lane * (MP * 2) + ip * 2) = kb; });
    DL_CONV(C_DV + 64 * h, 512 + 64 * h, { const int ip = dir ? 63 - i : i; *(LAS unsigned short*)(VT + lane * (MP * 2) + ip * 2) = (unsigned short)f2bf(val); });
    const int mytok = tok0 + (dir ? 63 - lane : lane);
    const float* BD = (const float*)(F.ws + WS_BD) + (size_t)mytok * 16;
    const float beta = BD[dir * 4 + h]; float gc = BD[8 + dir * 4 + h];
#pragma unroll
    for (int o = 1; o < 64; o <<= 1) { const float t = __shfl_up(gc, o); if (lane >= o) gc += t; }
    const float gl = __shfl(gc, 63);
    tab[lane] = gc; tab[64 + lane] = beta; tab[128 + lane] = __expf(gl - gc);
    LDS_WAIT();
    LAUNDER();
    f32x16 kk[2][2];
#pragma unroll
    for (int tb = 0; tb < 2; ++tb)
#pragma unroll
        for (int tn = 0; tn < 2; ++tn) { f32x16 acc = zero16();
#pragma unroll
            for (int ks = 0; ks < 4; ++ks) acc = MFMA32(ldfrag(KR, r32 + 32 * tb, 16 * ks + 8 * hi), ldfrag(KR, r32 + 32 * tn, 16 * ks + 8 * hi), acc);
            kk[tb][tn] = acc; SB(); }
    LDS_WAIT();
#pragma unroll
    for (int tb = 0; tb < 2; ++tb)
#pragma unroll
        for (int tn = 0; tn < 2; ++tn) {
            const int jc = r32 + 32 * tn; const float gcj = tab[jc];
#pragma unroll
            for (int r = 0; r < 16; ++r) { const int ir = 32 * tb + crow(r, hi); const float gci = tab[ir], bi = tab[64 + ir];
                const float mv = (ir > jc) ? bi * kk[tb][tn][r] * __expf(gci - gcj) : 0.f; SM[ir * 64 + jc] = mv; } SB(); }
    LDS_WAIT();
    LAUNDER();
    float T[64];
#pragma unroll
    for (int i = 0; i < 64; ++i) {
        float a = (lane == i) ? 1.f : 0.f;
#pragma unroll
        for (int j4 = 0; j4 < (i + 3) / 4; ++j4) { const f32x4 m4 = *(const LAS f32x4*)(SM + i * 64 + 4 * j4);
#pragma unroll
            for (int e = 0; e < 4; ++e) if (4 * j4 + e < i) a = __builtin_fmaf(-m4[e], T[4 * j4 + e], a); }
        T[i] = a; if ((i & 3) == 3) SB(); }
    LDS_WAIT();
    LAUNDER();
    { const float b1 = beta, b2 = beta * __expf(gc);
#pragma unroll
      for (int i = 0; i < 64; ++i) { *(LAS unsigned short*)(KR + i * (MP * 2) + lane * 2) = (unsigned short)f2bf(T[i] * b1); *(LAS unsigned short*)(T2 + i * (MP * 2) + lane * 2) = (unsigned short)f2bf(T[i] * b2); if ((i & 7) == 7) SB(); } }
    LDS_WAIT();
    LAUNDER();
    f32x16 u[2][2], w[2][2];
#pragma unroll
    for (int tb = 0; tb < 2; ++tb)
#pragma unroll
        for (int tn = 0; tn < 2; ++tn) { f32x16 au = zero16(), aw = zero16();
#pragma unroll
            for (int ks = 0; ks < 4; ++ks) { au = MFMA32(ldfrag(KR, r32 + 32 * tb, 16 * ks + 8 * hi), ldfrag(VT, r32 + 32 * tn, 16 * ks + 8 * hi), au);
                                             aw = MFMA32(ldfrag(T2, r32 + 32 * tb, 16 * ks + 8 * hi), ldfrag(KT, r32 + 32 * tn, 16 * ks + 8 * hi), aw); }
            u[tb][tn] = au; w[tb][tn] = aw; SB(); }
    LAUNDER();
    { unsigned* ud = (unsigned*)(F.ws + WS_UW + (size_t)inst * 16384); bf16* wd = (bf16*)(F.ws + WS_UW + (size_t)inst * 16384 + 8192);
#pragma unroll
      for (int tb = 0; tb < 2; ++tb)
#pragma unroll
          for (int tn = 0; tn < 2; ++tn) {
#pragma unroll
              for (int rp = 0; rp < 8; ++rp) ud[((tb * 2 + tn) * 8 + rp) * 64 + lane] = pk2(u[tb][tn][2 * rp], u[tb][tn][2 * rp + 1]);
#pragma unroll
              for (int r = 0; r < 16; ++r) wd[(32 * tb + crow(r, hi)) * 64 + r32 + 32 * tn] = (bf16)f2bf(w[tb][tn][r]); SB(); } }
    LAUNDER();
#pragma unroll
    for (int tb = 0; tb < 2; ++tb)
#pragma unroll
        for (int r = 0; r < 16; ++r) { const float e = tab[128 + 32 * tb + crow(r, hi)];
#pragma unroll
            for (int tn = 0; tn < 2; ++tn) { u[tb][tn][r] *= e; w[tb][tn][r] *= e; } }
    SB();
    bf16x8 kf[2][4];
#pragma unroll
    for (int tbb = 0; tbb < 2; ++tbb)
#pragma unroll
        for (int s = 0; s < 4; ++s) kf[tbb][s] = ldfragp(KT, r32 + 32 * tbb, 16 * s + 4 * hi);
    LDS_WAIT(); SB();
    LAUNDER();
    LAS unsigned char* AR = VT; LAS unsigned char* BT = KR;
#pragma unroll
    for (int tbb = 0; tbb < 2; ++tbb)
#pragma unroll
        for (int tx = 0; tx < 2; ++tx) { f32x16 aa = zero16(), ab = zero16();
#pragma unroll
            for (int s = 0; s < 4; ++s) { aa = MFMA32(cfrag(w[s >> 1][tx], s & 1), kf[tbb][s], aa); ab = MFMA32(kf[tbb][s], cfrag(u[s >> 1][tx], s & 1), ab); }
#pragma unroll
            for (int g4 = 0; g4 < 4; ++g4) {
                const v2u pa = {pk2(-aa[4 * g4], -aa[4 * g4 + 1]), pk2(-aa[4 * g4 + 2], -aa[4 * g4 + 3])};
                *(LAS v2u*)(AR + (r32 + 32 * tbb) * (MP * 2) + (32 * tx + 8 * g4 + 4 * hi) * 2) = pa;
                const v2u pb = {pk2(ab[4 * g4], ab[4 * g4 + 1]), pk2(ab[4 * g4 + 2], ab[4 * g4 + 3])};
                *(LAS v2u*)(BT + (r32 + 32 * tx) * (MP * 2) + (32 * tbb + 8 * g4 + 4 * hi) * 2) = pb;
            } SB(); }
    LDS_WAIT();
    LAUNDER();
    { unsigned char* ab = F.ws + WS_AB + (size_t)inst * 16384; const int m16 = lane & 15, g = lane >> 4;
#pragma unroll
      for (int rb = 0; rb < 4; ++rb)
#pragma unroll
          for (int ks = 0; ks < 2; ++ks) { const v2u lo = *(const LAS v2u*)(AR + (16 * rb + m16) * (MP * 2) + (32 * ks + 4 * g) * 2), hi8 = *(const LAS v2u*)(AR + (16 * rb + m16) * (MP * 2) + (32 * ks + 16 + 4 * g) * 2);
              const v4u t = {lo.x, lo.y, hi8.x, hi8.y}; *(GAS v4u*)(ab + ((rb * 2 + ks) * 64 + lane) * 16) = t; }
#pragma unroll
      for (int sl = 0; sl < 4; ++sl)
#pragma unroll
          for (int rb = 0; rb < 4; ++rb) { const v2u t = *(const LAS v2u*)(BT + (16 * sl + m16) * (MP * 2) + (16 * rb + 4 * g) * 2); *(GAS v2u*)(ab + 8192 + ((sl * 4 + rb) * 64 + lane) * 8) = t; } }
    if (lane == 0) ((float*)(F.ws + WS_DEC))[inst] = __expf(gl);
    LDS_WAIT();
}
__device__ __forceinline__ void d1_phase(Frame& F, const int layer) {
    if (F.wave < 4) {
        LAS unsigned char* W = F.lds + RING_OFF + F.wave * WAVE_LDS; LAS float* tab = (LAS float*)(F.lds + RING_OFF + 4 * WAVE_LDS + F.wave * 1024);
        const int gw = F.vcu * 4 + F.wave, NGW = F.G * 4;
        for (int it = gw; it < NINST; it += NGW) { const int dir = it & 1, u = it >> 1; d1_instance(F, layer, u >> 10, (u >> 8) & 3, u & 255, dir, W, tab); }
    }
    __syncthreads();
}

typedef float f32x4v __attribute__((ext_vector_type(4)));
__device__ __forceinline__ void d2_phase(Frame& F) {
    if (F.wave == 0 && F.vcu < 64) {
        const int lane = F.lane, n16 = lane & 15, g = lane >> 4, chain = F.vcu >> 2, sl = F.vcu & 3;
        f32x4v S[4];
#pragma unroll
        for (int rb = 0; rb < 4; ++rb) S[rb] = (f32x4v){0.f, 0.f, 0.f, 0.f};
        const unsigned char* abase = F.ws + WS_AB + (size_t)chain * NCHUNK * 16384;
        unsigned char* sbase = F.ws + WS_ST + (size_t)chain * NCHUNK * 8192;
        const float* dec = (const float*)(F.ws + WS_DEC) + chain * NCHUNK;
        v4u af[4][2]; v2u bm[4]; float dcy;
#define D2_LOAD(n) do { const unsigned char* ab_ = abase + (size_t)(n) * 16384; \
        _Pragma("unroll") for (int rb = 0; rb < 4; ++rb) { _Pragma("unroll") for (int ks = 0; ks < 2; ++ks) af[rb][ks] = *(const GAS v4u*)(ab_ + ((rb * 2 + ks) * 64 + lane) * 16); \
            bm[rb] = *(const GAS v2u*)(ab_ + 8192 + ((sl * 4 + rb) * 64 + lane) * 8); } dcy = dec[n]; } while (0)
        D2_LOAD(0);
        for (int n = 0; n < NCHUNK; ++n) {
            unsigned char* st = sbase + (size_t)n * 8192 + (16 * sl + n16) * 128;
#pragma unroll
            for (int rb = 0; rb < 4; ++rb) { const v2u t = {pk2(S[rb][0], S[rb][1]), pk2(S[rb][2], S[rb][3])}; *(GAS v2u*)(st + (16 * rb + 4 * g) * 2) = t; }
            bf16x8 bfr[2];
#pragma unroll
            for (int ks = 0; ks < 2; ++ks) { const v4u t = {att::cvtpk(S[2 * ks][0], S[2 * ks][1]), att::cvtpk(S[2 * ks][2], S[2 * ks][3]), att::cvtpk(S[2 * ks + 1][0], S[2 * ks + 1][1]), att::cvtpk(S[2 * ks + 1][2], S[2 * ks + 1][3])}; bfr[ks] = __builtin_bit_cast(bf16x8, t); }
            v4u caf[4][2]; v2u cbm[4]; const float cd = dcy;
#pragma unroll
            for (int rb = 0; rb < 4; ++rb) { caf[rb][0] = af[rb][0]; caf[rb][1] = af[rb][1]; cbm[rb] = bm[rb]; }
            if (n + 1 < NCHUNK) D2_LOAD(n + 1);
#pragma unroll
            for (int rb = 0; rb < 4; ++rb) {
                f32x4v c = {S[rb][0] * cd + bflo(cbm[rb].x), S[rb][1] * cd + bfhi(cbm[rb].x), S[rb][2] * cd + bflo(cbm[rb].y), S[rb][3] * cd + bfhi(cbm[rb].y)};
                c = __builtin_amdgcn_mfma_f32_16x16x32_bf16(__builtin_bit_cast(bf16x8, caf[rb][0]), bfr[0], c, 0, 0, 0);
                c = __builtin_amdgcn_mfma_f32_16x16x32_bf16(__builtin_bit_cast(bf16x8, caf[rb][1]), bfr[1], c, 0, 0, 0);
                S[rb] = c; }
        }
#undef D2_LOAD
    }
    __syncthreads();
}

__device__ __forceinline__ void d3_unit(Frame& F, const int layer, const int b, const int h, const int norig, LAS unsigned char* W, LAS float* tab) {
    int lane = F.lane, r32, hi; LAUNDER();
    const bf16* P = (const bf16*)(F.ws + WS_PROJ);
    const float* cwp = F.in[I_DCONVW] + (size_t)layer * 5 * 768;
    const int s0 = norig * 64, tok0 = b * SEQ + s0;
    LAS unsigned char* QR = W;
    LAS unsigned char* KR = W + MB;
    LAS unsigned char* ST = W + 2 * MB;
    LAS unsigned char* WR = W + 3 * MB;
    f32x16 of[2][2];
#pragma unroll
    for (int dir = 0; dir < 2; ++dir) {
        const int npr = dir ? 255 - norig : norig;
        const int inst = ((b * 4 + h) * 2 + dir) * NCHUNK + npr;
        DL_CONV(C_DQ + 64 * h, 64 * h, { const float ss = wave_sum(val * val); const float qn = val * (0.125f / sqrtf(ss + EPS)); const int ip = dir ? 63 - i : i; *(LAS unsigned short*)(QR + ip * (MP * 2) + lane * 2) = (unsigned short)f2bf(qn); });
        DL_CONV(C_DK + 64 * h, 256 + 64 * h, { const float ss = wave_sum(val * val); const float kn = val * (1.f / sqrtf(ss + EPS)); const int ip = dir ? 63 - i : i; *(LAS unsigned short*)(KR + ip * (MP * 2) + lane * 2) = (unsigned short)f2bf(kn); });
        const int mytok = tok0 + (dir ? 63 - lane : lane);
        float gc = ((const float*)(F.ws + WS_BD))[(size_t)mytok * 16 + 8 + dir * 4 + h];
#pragma unroll
        for (int o = 1; o < 64; o <<= 1) { const float t = __shfl_up(gc, o); if (lane >= o) gc += t; }
        tab[lane] = gc; tab[64 + lane] = __expf(gc);
        LAUNDER();
        { const unsigned char* sg = F.ws + WS_ST + (size_t)inst * 8192; const unsigned char* wg = F.ws + WS_UW + (size_t)inst * 16384 + 8192;
#pragma unroll
          for (int i = 0; i < 8; ++i) { const int idx = i * 64 + lane, row = idx >> 3, ch = idx & 7; const v4u a = *(const GAS v4u*)(sg + idx * 16), c = *(const GAS v4u*)(wg + idx * 16);
              *(LAS v4u*)(ST + row * (MP * 2) + ch * 16) = a; *(LAS v4u*)(WR + row * (MP * 2) + ch * 16) = c; } }
        LDS_WAIT();
        LAUNDER();
        f32x16 qk[2][2];
#pragma unroll
        for (int tb = 0; tb < 2; ++tb)
#pragma unroll
            for (int tn = 0; tn < 2; ++tn) { f32x16 acc = zero16();
#pragma unroll
                for (int ks = 0; ks < 4; ++ks) acc = MFMA32(ldfrag(QR, r32 + 32 * tb, 16 * ks + 8 * hi), ldfrag(KR, r32 + 32 * tn, 16 * ks + 8 * hi), acc);
                qk[tb][tn] = acc; SB(); }
        LDS_WAIT();
#pragma unroll
        for (int tb = 0; tb < 2; ++tb)
#pragma unroll
            for (int tn = 0; tn < 2; ++tn) { const int jc = r32 + 32 * tn; const float gcj = tab[jc];
#pragma unroll
                for (int r = 0; r < 16; ++r) { const int ir = 32 * tb + crow(r, hi); const float gci = tab[ir];
                    const float av = (ir >= jc) ? qk[tb][tn][r] * __expf(gci - gcj) : 0.f; *(LAS unsigned short*)(KR + ir * (MP * 2) + jc * 2) = (unsigned short)f2bf(av); } SB(); }
        LDS_WAIT();
        LAUNDER();
        const unsigned* ud = (const unsigned*)(F.ws + WS_UW + (size_t)inst * 16384);
#pragma unroll
        for (int tn = 0; tn < 2; ++tn) {
            bf16x8 sf[4];
#pragma unroll
            for (int ks = 0; ks < 4; ++ks) sf[ks] = ldfrag(ST, r32 + 32 * tn, 16 * ks + 8 * hi);
            f32x16 vn[2], o[2];
#pragma unroll
            for (int tb = 0; tb < 2; ++tb) { f32x16 a1 = zero16(), a2 = zero16();
#pragma unroll
                for (int ks = 0; ks < 4; ++ks) { a1 = MFMA32(ldfrag(WR, r32 + 32 * tb, 16 * ks + 8 * hi), sf[ks], a1); a2 = MFMA32(ldfrag(QR, r32 + 32 * tb, 16 * ks + 8 * hi), sf[ks], a2); }
#pragma unroll
                for (int rp = 0; rp < 8; ++rp) { const unsigned uw = ud[((tb * 2 + tn) * 8 + rp) * 64 + lane]; a1[2 * rp] = bflo(uw) - a1[2 * rp]; a1[2 * rp + 1] = bfhi(uw) - a1[2 * rp + 1]; }
#pragma unroll
                for (int r = 0; r < 16; ++r) a2[r] *= tab[64 + 32 * tb + crow(r, hi)];
                vn[tb] = a1; o[tb] = a2; SB(); }
#pragma unroll
            for (int tb = 0; tb < 2; ++tb) { f32x16 acc = o[tb];
#pragma unroll
                for (int s = 0; s < 4; ++s) acc = MFMA32(ldfragp(KR, r32 + 32 * tb, 16 * s + 4 * hi), cfrag(vn[s >> 1], s & 1), acc);
                o[tb] = acc; SB(); }
            if (dir == 0) { of[0][tn] = o[0]; of[1][tn] = o[1]; }
            else {
#pragma unroll
                for (int tb = 0; tb < 2; ++tb)
#pragma unroll
                    for (int r = 0; r < 16; ++r) of[tb][tn][r] += __shfl_xor(o[1 - tb][15 - r], 32);
            }
        }
        LDS_WAIT();
    }
    LAUNDER();
    const float* dn = F.in[I_DNORM] + layer * 64;
#pragma unroll
    for (int tb = 0; tb < 2; ++tb)
#pragma unroll
        for (int r = 0; r < 16; ++r) {
            float ss = of[tb][0][r] * of[tb][0][r] + of[tb][1][r] * of[tb][1][r];
#pragma unroll
            for (int o = 1; o < 32; o <<= 1) ss += __shfl_xor(ss, o);
            const float rs = 1.f / sqrtf(ss * (1.f / 64.f) + EPS);
            const int tok = tok0 + 32 * tb + crow(r, hi);
#pragma unroll
            for (int tn = 0; tn < 2; ++tn) { const int dv = r32 + 32 * tn; const float z = bf2f(P[(size_t)tok * NPROJ + C_DZ + 64 * h + dv]);
                ((bf16*)(F.ws + WS_O4))[(size_t)tok * 1024 + 768 + 64 * h + dv] = (bf16)f2bf(of[tb][tn][r] * rs * dn[dv] * siluf_(z)); }
        }
}
__device__ __forceinline__ void d3_phase(Frame& F, const int layer) {
    if (F.wave < 4) {
        LAS unsigned char* W = F.lds + RING_OFF + F.wave * WAVE_LDS; LAS float* tab = (LAS float*)(F.lds + RING_OFF + 4 * WAVE_LDS + F.wave * 1024);
        const int gw = F.vcu * 4 + F.wave, NGW = F.G * 4;
        for (int u = gw; u < BATCH * 4 * NCHUNK; u += NGW) d3_unit(F, layer, u >> 10, (u >> 8) & 3, u & 255, W, tab);
    }
    __syncthreads();
}
#undef MFMA32
}

#ifndef ONLY_SITE
#define ONLY_SITE -1
#endif
#define SITE(k) (ONLY_SITE < 0 || ONLY_SITE == (k))
#ifndef MK_SPLIT
#define MK_SPLIT 0
#endif
struct Args { const float* in[30]; float* out; unsigned char* ws; int ph_lo, ph_hi; };
constexpr int N_PHASES = 1 + 16 * NLAYER + 1;

#define IN_PH() (pid >= lo && pid < hi)
#define FRESH() do { unsigned char* w_ = args.ws; float* o_ = args.out; int t_ = threadIdx.x; asm volatile("" : "+s"(w_), "+s"(o_), "+v"(t_)); F.ws = w_; F.out = o_; F.ctl = (gu32*)(w_ + WS_CTL); F.tid = t_; F.lane = t_ & 63; } while (0)
#define SEAM() do { if (!MK_SPLIT && pid >= lo && pid + 1 < hi) xcd_barrier(bar); ++pid; } while (0)
#define NOSEAM() do { ++pid; } while (0)

template <int l> __device__ __forceinline__ void layer_phases(Frame& F, const Args& args, const XcdBarrier& bar, const int lo, const int hi, int& pid) {
    LAS unsigned char* ring = F.lds + RING_OFF;

        if (IN_PH() && l == 0 && SITE(1)) { FRESH(); p_rows<ROW_A>(F, 0); }
        SEAM();
        if (IN_PH() && SITE(2)) { FRESH();
            pg8::SchedStd S; S.init(NTOK / 256, NPROJ / 256, F.G, (int)blockIdx.x, F.ws + WS_H, (size_t)256 * D * 2, w_in_t(F.ws, l), (size_t)256 * D * 2);
            pg8::EpiStore E{(bf16*)(F.ws + WS_PROJ), NPROJ, 0, QSCALE};
            pg8::gemm_phase<pg8::EpiStore, pg8::SchedStd, D, D, D>(ring, F.tid, S, E);
        }
        SEAM();
        if (IN_PH() && SITE(3)) { FRESH(); att::attn_phase(F, l); }
        NOSEAM();
        if (IN_PH() && SITE(4)) { FRESH(); pc::poolconv_phase(F, l); }
        NOSEAM();
        if (IN_PH() && SITE(5)) { FRESH(); dl::d1_phase(F, l); }
        SEAM();
        if (IN_PH() && SITE(6)) { FRESH(); dl::d2_phase(F); }
        SEAM();
        if (IN_PH() && SITE(7)) { FRESH(); dl::d3_phase(F, l); }
        SEAM();
        if (IN_PH() && SITE(8)) { FRESH();
            pg8::SchedBranch S; S.s.init(NTOK / 256, 16, F.G, (int)blockIdx.x, nullptr, 0, nullptr, 0); S.O4 = (const char*)(F.ws + WS_O4); S.Wb = (const char*)w_b_t(F.ws, l);
            pg8::EpiStore E{(bf16*)(F.ws + WS_PBUF), 1024, (size_t)NTOK * 1024, 1.f};
            pg8::gemm_phase<pg8::EpiStore, pg8::SchedBranch, 256, 1024, 256>(ring, F.tid, S, E);
        }
        SEAM();
        if (IN_PH() && SITE(9)) { FRESH();
            pg8::SchedGate S{F.vcu, F.G, (const char*)(F.ws + WS_H), (const char*)w_m_t(F.ws, l)};
            pg8::EpiGate E{(const bf16*)(F.ws + WS_PBUF), (bf16*)(F.ws + WS_MERGED), F.in[I_BMERGE] + (size_t)l * 4 * D};
            pg8::gemm_phase<pg8::EpiGate, pg8::SchedGate, D, D, D>(ring, F.tid, S, E);
        }
        SEAM();
        if (IN_PH() && SITE(10)) { FRESH();
            pg8::SchedStd S; S.init(NTOK / 256, D / 256, F.G, (int)blockIdx.x, F.ws + WS_MERGED, (size_t)256 * D * 2, w_o_t(F.ws, l), (size_t)256 * D * 2);
            pg8::EpiStore E{(bf16*)(F.ws + WS_F), D, 0, 1.f};
            pg8::gemm_phase<pg8::EpiStore, pg8::SchedStd, D, D, D>(ring, F.tid, S, E);
        }
        SEAM();
        if (IN_PH() && SITE(11)) { FRESH(); p_rows<ROW_B>(F, l); }
        SEAM();
        if constexpr (l == 0) {
            if (IN_PH() && SITE(12)) { FRESH();
                pg8::SchedStd S; S.init(NTOK / 256, 2 * DFF / 256, F.G, (int)blockIdx.x, F.ws + WS_H, (size_t)256 * D * 2, F.ws + WS_WFFN, (size_t)256 * D * 2);
                pg8::EpiSwiGLU E{(bf16*)(F.ws + WS_ACT0), DFF};
                pg8::gemm_phase<pg8::EpiSwiGLU, pg8::SchedStd, D, D, D>(ring, F.tid, S, E);
            }
            SEAM();
            if (IN_PH() && SITE(13)) { FRESH();
                pg8::SchedStd S; S.init(NTOK / 256, D / 256, F.G, (int)blockIdx.x, F.ws + WS_ACT0, (size_t)256 * DFF * 2, F.ws + WS_WFFN + SZ_WGU, (size_t)256 * DFF * 2);
                pg8::EpiStore E{(bf16*)(F.ws + WS_F), D, 0, 1.f};
                pg8::gemm_phase<pg8::EpiStore, pg8::SchedStd, DFF, DFF, DFF>(ring, F.tid, S, E);
            }
            SEAM();
            if (IN_PH() && SITE(14)) { FRESH(); p_rows<ROW_C>(F, 0); }
            SEAM();
            NOSEAM(); NOSEAM();
        } else {
            if (IN_PH() && SITE(15)) { FRESH(); p_moe_cvt(F); }
            SEAM();
#pragma unroll 1
            for (int pass = 0; pass < 2; ++pass) {
                if (IN_PH() && SITE(16)) { FRESH();
                    pg8::SchedMoe S; S.c = (int)blockIdx.x; S.G = F.G; S.nN = 2 * DFF / 256; moe_tiles(F, S.cnt, S.tstart);
                    S.t0 = pass * MOE_PASS_TILES; S.t1 = S.tstart[8] < (pass + 1) * MOE_PASS_TILES ? S.tstart[8] : (pass + 1) * MOE_PASS_TILES;
                    S.A = (const char*)(F.ws + WS_H2B); S.lists = (const int*)(F.ws + WS_ROUTE + 1 * MiB); S.W = (const char*)(F.ws + WS_MOEW); S.w_tile = (size_t)256 * D * 2; S.gather = true;
                    pg8::EpiSwiGLU E{(bf16*)(F.ws + WS_ACT1), DFF};
                    pg8::gemm_phase<pg8::EpiSwiGLU, pg8::SchedMoe, D, D, D, true>(ring, F.tid, S, E);
                }
                SEAM();
                if (IN_PH() && SITE(17)) { FRESH();
                    pg8::SchedMoe S; S.c = (int)blockIdx.x; S.G = F.G; S.nN = D / 256; moe_tiles(F, S.cnt, S.tstart);
                    S.t0 = pass * MOE_PASS_TILES; S.t1 = S.tstart[8] < (pass + 1) * MOE_PASS_TILES ? S.tstart[8] : (pass + 1) * MOE_PASS_TILES;
                    S.A = (const char*)(F.ws + WS_ACT1); S.lists = nullptr; S.W = (const char*)(F.ws + WS_MOEW + SZ_WGU); S.w_tile = (size_t)256 * DFF * 2; S.gather = false;
                    pg8::EpiStore E{(bf16*)(F.ws + WS_Y), D, 0, 1.f};
                    pg8::gemm_phase<pg8::EpiStore, pg8::SchedMoe, DFF, DFF, DFF>(ring, F.tid, S, E);
                }
                SEAM();
            }
        }
    }

__global__ void __launch_bounds__(NWAVES * 64, 2) fwd_kernel(const Args args) {
    extern __shared__ __attribute__((aligned(16))) unsigned char lds[];
    Frame F;
    F.lds = (LAS unsigned char*)lds;
    F.MISC = (volatile LAS unsigned*)(F.lds + MISC_OFF);
    F.tid = threadIdx.x; F.lane = F.tid & 63; F.wave = __builtin_amdgcn_readfirstlane(F.tid >> 6);
    F.G = gridDim.x; { const int bx = blockIdx.x; F.vcu = (F.G % 8 == 0) ? (bx % 8) * (F.G / 8) + bx / 8 : bx; }
    F.ws = args.ws; F.out = args.out; F.ctl = (gu32*)(args.ws + WS_CTL);
    F.in = args.in;
    if (F.tid < 64) ((LAS unsigned*)(F.lds + MISC_OFF))[F.tid] = 0u;
    __syncthreads();
    XcdBarrier bar; bar.bar = (unsigned*)(F.ctl + CW_BAR); bar.x = 0; bar.st = nullptr;
    if (!MK_SPLIT) bar = xcd_barrier_post((unsigned*)(F.ctl + CW_BAR), F.MISC + 8);
    const int lo = args.ph_lo, hi = args.ph_hi;
    int pid = 0;
    LAS unsigned char* ring = F.lds + RING_OFF;

    if (IN_PH() && SITE(0)) { FRESH(); p_prologue(F); }
    SEAM();
    layer_phases<0>(F, args, bar, lo, hi, pid);
    layer_phases<1>(F, args, bar, lo, hi, pid);
    if (IN_PH() && SITE(18)) { FRESH(); p_rows<ROW_C>(F, 1); }
#undef IN_PH
#undef SEAM
#undef NOSEAM
}

extern "C" void kernel_launch(void* const* d_in, const int* in_sizes, int n_in, void* d_out, int out_size, void* d_ws, size_t ws_size, hipStream_t stream) {
    static int grid = 0;
    if (grid == 0) {
        if (n_in != N_INPUTS || in_sizes[0] != NTOK * D || out_size != NTOK * D || ws_size < WS_END) {
            fprintf(stderr, "kernel_launch: unexpected problem (n_in %d, in0 %d, out %d, ws %zu < %zu); nothing launched\n", n_in, n_in > 0 ? in_sizes[0] : -1, out_size, ws_size, (size_t)WS_END); grid = -1; return; }
        int dev = 0, cus = 0, per_cu = 0;
        if (hipGetDevice(&dev) != hipSuccess || hipDeviceGetAttribute(&cus, hipDeviceAttributeMultiprocessorCount, dev) != hipSuccess) { grid = -1; return; }
        if (hipFuncSetAttribute((const void*)fwd_kernel, hipFuncAttributeMaxDynamicSharedMemorySize, LDS_BYTES) != hipSuccess) { fprintf(stderr, "kernel_launch: hipFuncSetAttribute failed\n"); grid = -1; return; }
        if (hipOccupancyMaxActiveBlocksPerMultiprocessor(&per_cu, (const void*)fwd_kernel, NWAVES * 64, LDS_BYTES) != hipSuccess || per_cu < 1)
            fprintf(stderr, "kernel_launch: note: occupancy query reports %d workgroups per CU\n", per_cu);
        (void)hipGetLastError();
        grid = cus;
    }
    if (grid < 0) return;
    if (hipMemsetAsync((char*)d_ws + WS_CTL, 0, CTL_ZERO_BYTES, stream) != hipSuccess) return;
    Args a{};
    for (int i = 0; i < 30; ++i) a.in[i] = (const float*)d_in[i];
    a.out = (float*)d_out; a.ws = (unsigned char*)d_ws;
#if MK_SPLIT
    for (int p = 0; p < N_PHASES; ++p) { a.ph_lo = p; a.ph_hi = p + 1; hipLaunchKernelGGL(fwd_kernel, dim3(grid), dim3(NWAVES * 64), LDS_BYTES, stream, a); }
#else
    a.ph_lo = 0; a.ph_hi = N_PHASES;
    hipLaunchKernelGGL(fwd_kernel, dim3(grid), dim3(NWAVES * 64), LDS_BYTES, stream, a);
#endif
}
```

```cpp
#include <hip/hip_runtime.h>
#include <cstdio>
#include <cstdint>

namespace pg8 {
#define PG8_LAS __attribute__((address_space(3)))
typedef unsigned short bf16_t;
typedef short bf16x8 __attribute__((ext_vector_type(8)));
typedef float f32x4 __attribute__((ext_vector_type(4)));
typedef unsigned u32x4 __attribute__((ext_vector_type(4)));
typedef unsigned u32x2 __attribute__((ext_vector_type(2)));
constexpr int BM = 256, BK = 64, HALF = 128, HTB = HALF * BK * 2  , STAGE_BYTES = 8 * HTB;

__host__ __device__ __forceinline__ int lds_byte(int r, int c) { const int st = (r >> 4) * 2 + (c >> 5), rr = r & 15, cc = c & 31, ob = rr * 64 + cc * 2; return st * 1024 + (ob ^ (((ob >> 9) & 1) << 5)); }
__host__ __device__ __forceinline__ void stage_rc(int b, int& R, int& C) { const int st = b / 1024, sb = b % 1024, swz = sb ^ (((sb >> 9) & 1) << 5); R = (st >> 1) * 16 + swz / 64; C = (st & 1) * 32 + (swz % 64) / 2; }
__host__ __device__ __forceinline__ int perm32(int rho) { const int n = rho >> 4, i = rho & 15; return 8 * (i >> 2) + 4 * n + (i & 3); }

struct Unit { int pm, pn, aux, pad; const char* a; const char* b; const int* rows; };

__device__ __forceinline__ unsigned cvt_pk_bf16(float lo, float hi) { unsigned r; asm volatile("v_cvt_pk_bf16_f32 %0, %1, %2" : "=v"(r) : "v"(lo), "v"(hi)); return r; }


template <class Epi, class Sched, int K, int lda, int ldb, bool GATHER = false, bool ALIGN_EPI = true, bool SP2 = true>
__device__ __forceinline__ void gemm_phase(PG8_LAS unsigned char* lds, const int tid, const Sched& S, const Epi& E) {
    const int wid = __builtin_amdgcn_readfirstlane(tid >> 6), lane = tid & 63, wr = wid >> 2, wc = wid & 3, fr = lane & 15, fq = lane >> 4;
    constexpr int nt = K / BK;
    int Rs[2], Cs[2]; unsigned voffB[2];
#pragma unroll
    for (int i = 0; i < 2; ++i) { int R, C; stage_rc(tid * 16 + i * 8192, R, C); const int Rb = Epi::PERM ? ((R & ~31) + perm32(R & 31)) : R; Rs[i] = R; Cs[i] = C; voffB[i] = (unsigned)(Rb * ldb + C) * 2u; }
    const size_t kstep = (size_t)(BK * 2);
    const size_t hstepB = (size_t)HALF * ldb * 2;
    const unsigned ldsw = (unsigned)wid * 1024u;
    const int aoff = lds_byte(wr * 64 + fr, fq * 8), boff = lds_byte(wc * 32 + fr, fq * 8);
#define PG8_SA(b, h) (((b) * 2 + (h)) * HTB)
#define PG8_SB(b, h) ((4 + (b) * 2 + (h)) * HTB)
#define PG8_STAGE(bufoff, gbase, voff) do { _Pragma("unroll") for (int _i = 0; _i < 2; ++_i) \
        __builtin_amdgcn_global_load_lds((const unsigned*)((const char*)(gbase) + (voff)[_i]), (PG8_LAS unsigned*)(lds + (bufoff) + ldsw + _i * 8192), 16, 0, 0); } while (0)
#define PG8_LDA(dst, b, h) do { _Pragma("unroll") for (int m = 0; m < 4; ++m) _Pragma("unroll") for (int k = 0; k < 2; ++k) dst[m][k] = *(const PG8_LAS bf16x8*)(lds + PG8_SA(b, h) + aoff + m * 2048 + k * 1024); } while (0)
#define PG8_LDB(dst, b, h) do { _Pragma("unroll") for (int n = 0; n < 2; ++n) _Pragma("unroll") for (int k = 0; k < 2; ++k) dst[n][k] = *(const PG8_LAS bf16x8*)(lds + PG8_SB(b, h) + boff + n * 2048 + k * 1024); } while (0)
#define PG8_MMA(ai, bj, At, Bt) do { __builtin_amdgcn_s_setprio(1); _Pragma("unroll") for (int m = 0; m < 4; ++m) _Pragma("unroll") for (int n = 0; n < 2; ++n) _Pragma("unroll") for (int k = 0; k < 2; ++k) \
        acc[ai][bj][m][n] = __builtin_amdgcn_mfma_f32_16x16x32_bf16(Bt[n][k], At[m][k], acc[ai][bj][m][n], 0, 0, 0); __builtin_amdgcn_s_setprio(0); } while (0)
#define PG8_WAIT_V(n) asm volatile("s_waitcnt vmcnt(" #n ")" ::: "memory")
#define PG8_WAIT_L(n) asm volatile("s_waitcnt lgkmcnt(" #n ")" ::: "memory")
#define PG8_BAR __builtin_amdgcn_s_barrier()
#define PG8_SCHED __builtin_amdgcn_sched_barrier(0)
    Unit cur, nxt; int ui = 0;
    if (!S.next(0, cur)) return;
    f32x4 acc[2][2][4][2];
#pragma unroll
    for (int a = 0; a < 2; ++a)
#pragma unroll
        for (int b = 0; b < 2; ++b)
#pragma unroll
            for (int m = 0; m < 4; ++m)
#pragma unroll
                for (int n = 0; n < 2; ++n) acc[a][b][m][n] = (f32x4){0.f, 0.f, 0.f, 0.f};
    bf16x8 At[4][2], B0[2][2], B1[2][2];
    unsigned cOff[2][2], nOff[2][2];
#pragma unroll
    for (int hh = 0; hh < 2; ++hh)
#pragma unroll
        for (int i = 0; i < 2; ++i) {
            if constexpr (GATHER) { const int ridx = hh * HALF + Rs[i]; int tk = cur.rows[ridx]; tk = ridx < cur.aux ? tk : 0; cOff[hh][i] = (unsigned)(tk * lda + Cs[i]) * 2u; }
            else cOff[hh][i] = (unsigned)((hh * HALF + Rs[i]) * lda + Cs[i]) * 2u;
            if constexpr (GATHER) nOff[hh][i] = cOff[hh][i]; else nOff[hh][i] = 0u;
        }
    const char* cA = cur.a; const char* cB = cur.b;
    S.a_ready(cur);
    if constexpr (SP2) {
        PG8_STAGE(PG8_SB(0, 0), cB, voffB); PG8_STAGE(PG8_SB(0, 1), cB + hstepB, voffB); PG8_STAGE(PG8_SA(0, 0), cA, cOff[0]); PG8_STAGE(PG8_SA(0, 1), cA, cOff[1]);
        if (wr == 1) PG8_BAR;
        PG8_WAIT_V(2); PG8_BAR;
        PG8_STAGE(PG8_SB(1, 0), cB + kstep, voffB); PG8_STAGE(PG8_SA(1, 0), cA + kstep, cOff[0]); PG8_STAGE(PG8_SB(1, 1), cB + hstepB + kstep, voffB);
        PG8_WAIT_V(6); PG8_BAR;
    } else {
        PG8_STAGE(PG8_SB(0, 0), cB, voffB); PG8_STAGE(PG8_SA(0, 0), cA, cOff[0]); PG8_STAGE(PG8_SB(0, 1), cB + hstepB, voffB); PG8_STAGE(PG8_SA(0, 1), cA, cOff[1]);
        if (wr == 1) PG8_BAR;
        PG8_WAIT_V(4); PG8_BAR;
        PG8_STAGE(PG8_SB(1, 0), cB + kstep, voffB); PG8_STAGE(PG8_SA(1, 0), cA + kstep, cOff[0]); PG8_STAGE(PG8_SB(1, 1), cB + hstepB + kstep, voffB);
        PG8_WAIT_V(6); PG8_BAR;
    }
    for (;;) {
        const bool has_next = S.next(ui + 1, nxt);
        const char* nA = has_next ? nxt.a : cA; const char* nB = has_next ? nxt.b : cB;
        if constexpr (GATHER) {
            if (has_next) {
#pragma unroll
                for (int hh = 0; hh < 2; ++hh)
#pragma unroll
                    for (int i = 0; i < 2; ++i) { const int ridx = hh * HALF + Rs[i]; int tk = nxt.rows[ridx]; tk = ridx < nxt.aux ? tk : 0; nOff[hh][i] = (unsigned)(tk * lda + Cs[i]) * 2u; }
            } else {
#pragma unroll
                for (int hh = 0; hh < 2; ++hh)
#pragma unroll
                    for (int i = 0; i < 2; ++i) nOff[hh][i] = cOff[hh][i];
            }
        }
#pragma unroll 1
        for (int t = 0; t < nt; t += 2) {
            const bool last = (t == nt - 2);
            const char* a1 = cA + (size_t)(t + 1) * kstep;
            const char* a2 = last ? nA : cA + (size_t)(t + 2) * kstep; const char* b2 = last ? nB : cB + (size_t)(t + 2) * kstep;
            const char* a3 = a2 + kstep; const char* b3 = b2 + kstep;
            unsigned o2[2][2];
#pragma unroll
            for (int hh = 0; hh < 2; ++hh)
#pragma unroll
                for (int i = 0; i < 2; ++i) { if constexpr (GATHER) o2[hh][i] = last ? nOff[hh][i] : cOff[hh][i]; else o2[hh][i] = cOff[hh][i]; }
            if (last && has_next) S.a_ready(nxt);
            if constexpr (SP2) {
            PG8_LDB(B0, 0, 0); PG8_LDB(B1, 0, 1); PG8_SCHED; PG8_LDA(At, 0, 0); PG8_STAGE(PG8_SA(1, 1), a1, cOff[1]);
            PG8_WAIT_V(8); PG8_WAIT_L(0); PG8_BAR; PG8_MMA(0, 0, At, B0); PG8_MMA(0, 1, At, B1); PG8_BAR; PG8_SCHED;
            PG8_LDA(At, 0, 1); PG8_STAGE(PG8_SB(0, 0), b2, voffB); PG8_STAGE(PG8_SB(0, 1), b2 + hstepB, voffB); PG8_STAGE(PG8_SA(0, 0), a2, o2[0]);
            PG8_WAIT_V(8); PG8_WAIT_L(0); PG8_BAR; PG8_MMA(1, 0, At, B0); PG8_MMA(1, 1, At, B1); PG8_BAR; PG8_SCHED;
            PG8_LDB(B0, 1, 0); PG8_LDB(B1, 1, 1); PG8_SCHED; PG8_LDA(At, 1, 0); PG8_STAGE(PG8_SA(0, 1), a2, o2[1]);
            PG8_WAIT_V(8); PG8_WAIT_L(0); PG8_BAR; PG8_MMA(0, 0, At, B0); PG8_MMA(0, 1, At, B1); PG8_BAR; PG8_SCHED;
            PG8_LDA(At, 1, 1); PG8_STAGE(PG8_SB(1, 0), b3, voffB); PG8_STAGE(PG8_SB(1, 1), b3 + hstepB, voffB); PG8_STAGE(PG8_SA(1, 0), a3, o2[0]);
            PG8_WAIT_V(8); PG8_WAIT_L(0); PG8_BAR; PG8_MMA(1, 0, At, B0); PG8_MMA(1, 1, At, B1); PG8_BAR; PG8_SCHED;
            } else {
            PG8_LDB(B0, 0, 0); PG8_SCHED; PG8_LDA(At, 0, 0); PG8_STAGE(PG8_SA(1, 1), a1, cOff[1]);
            PG8_WAIT_L(8); PG8_BAR; PG8_WAIT_L(0); PG8_MMA(0, 0, At, B0); PG8_BAR; PG8_SCHED;
            PG8_LDB(B1, 0, 1); PG8_STAGE(PG8_SB(0, 0), b2, voffB);
            PG8_BAR; PG8_WAIT_L(0); PG8_MMA(0, 1, At, B1); PG8_BAR;
            PG8_LDA(At, 0, 1); PG8_STAGE(PG8_SA(0, 0), a2, o2[0]);
            PG8_BAR; PG8_WAIT_L(0); PG8_MMA(1, 0, At, B0); PG8_BAR; PG8_SCHED;
            PG8_STAGE(PG8_SB(0, 1), b2 + hstepB, voffB);
            PG8_WAIT_V(6); PG8_BAR; PG8_MMA(1, 1, At, B1); PG8_BAR;
            PG8_LDB(B0, 1, 0); PG8_SCHED; PG8_LDA(At, 1, 0); PG8_STAGE(PG8_SA(0, 1), a2, o2[1]);
            PG8_WAIT_L(8); PG8_BAR; PG8_WAIT_L(0); PG8_MMA(0, 0, At, B0); PG8_BAR; PG8_SCHED;
            PG8_LDB(B1, 1, 1); PG8_STAGE(PG8_SB(1, 0), b3, voffB);
            PG8_BAR; PG8_WAIT_L(0); PG8_MMA(0, 1, At, B1); PG8_BAR;
            PG8_LDA(At, 1, 1); PG8_STAGE(PG8_SA(1, 0), a3, o2[0]);
            PG8_BAR; PG8_WAIT_L(0); PG8_MMA(1, 0, At, B0); PG8_BAR; PG8_SCHED;
            PG8_STAGE(PG8_SB(1, 1), b3 + hstepB, voffB);
            PG8_WAIT_V(6); PG8_BAR; PG8_MMA(1, 1, At, B1); PG8_BAR;
            }
        }
        if constexpr (ALIGN_EPI) { if (wr == 0) PG8_BAR; }
        E(acc, cur, wr, wc, fr, fq); S.done(cur);
        if (!has_next) break;
#pragma unroll
        for (int a = 0; a < 2; ++a)
#pragma unroll
            for (int b = 0; b < 2; ++b)
#pragma unroll
                for (int m = 0; m < 4; ++m)
#pragma unroll
                    for (int n = 0; n < 2; ++n) acc[a][b][m][n] = (f32x4){0.f, 0.f, 0.f, 0.f};
        cur = nxt; cA = nA; cB = nB; ++ui;
        if constexpr (GATHER) {
#pragma unroll
            for (int hh = 0; hh < 2; ++hh)
#pragma unroll
                for (int i = 0; i < 2; ++i) cOff[hh][i] = nOff[hh][i];
        }
        if constexpr (ALIGN_EPI) { if (wr == 1) PG8_BAR; }
    }
    PG8_WAIT_V(0);
    if constexpr (!ALIGN_EPI) { if (wr == 0) PG8_BAR; }
    PG8_BAR;
#undef PG8_SA
#undef PG8_SB
#undef PG8_STAGE
#undef PG8_LDA
#undef PG8_LDB
#undef PG8_MMA
#undef PG8_WAIT_V
#undef PG8_WAIT_L
#undef PG8_BAR
#undef PG8_SCHED
}
}

constexpr int NWAVES = 8;
constexpr int BATCH = 2, SEQ = 16384, D = 1024, NTOK = BATCH * SEQ;
constexpr int NLAYER = 2;
constexpr int NPROJ = 2816, IN_COLS = 2832;
constexpr int C_Q = 0, C_K = 256, C_V = 512, C_PIN = 768, C_CB = 1024, C_CC = 1280, C_CX = 1536, C_DQ = 1792, C_DK = 2048, C_DV = 2304, C_DZ = 2560;
constexpr int DFF = 2816, NEXP = 8;
constexpr int NCHUNK = SEQ / 64;
constexpr int NINST = BATCH * 4 * 2 * NCHUNK;
constexpr float EPS = 1e-6f;
constexpr float QSCALE = 0.17677669529663687f * 1.4426950408889634f;
constexpr int MOE_PASS_TILES = 132;

constexpr size_t MiB = 1u << 20;
constexpr size_t WS_CTL = 0, CTL_ZERO_BYTES = 1 * MiB;
constexpr size_t SZ_WIN = (size_t)NPROJ * D * 2, SZ_WM = (size_t)4096 * D * 2, SZ_WB = (size_t)4 * 1024 * 256 * 2, SZ_WO = (size_t)D * D * 2;
constexpr size_t SZ_LAYERW = SZ_WIN + SZ_WM + SZ_WB + SZ_WO;
constexpr size_t SZ_WGU = (size_t)2 * DFF * D * 2, SZ_WD = (size_t)D * DFF * 2, SZ_FFNW = SZ_WGU + SZ_WD;
constexpr size_t WS_W = 1 * MiB;
constexpr size_t WS_WFFN = WS_W + 2 * SZ_LAYERW;
static_assert(WS_WFFN + SZ_FFNW <= 53 * MiB, "weights");
constexpr size_t WS_H = 53 * MiB;
constexpr size_t WS_O4 = 117 * MiB;
constexpr size_t WS_F = WS_O4;
constexpr size_t WS_BD = 181 * MiB;
constexpr size_t WS_DEC = 183 * MiB;
constexpr size_t WS_PROJ = 185 * MiB;
constexpr size_t WS_UW = 361 * MiB;
constexpr size_t WS_AB = 425 * MiB;
constexpr size_t WS_ST = 489 * MiB;
constexpr size_t WS_PBUF = 185 * MiB;
constexpr size_t WS_MERGED = 441 * MiB;
constexpr size_t WS_ACT0 = 185 * MiB;
constexpr size_t WS_H2B = 479 * MiB;
constexpr size_t WS_MOEW = 185 * MiB;
constexpr size_t WS_ACT1 = 1 * MiB;
constexpr size_t WS_Y = 317 * MiB;
constexpr size_t WS_ROUTE = 449 * MiB;
constexpr size_t WS_END = 543 * MiB;
static_assert(WS_ACT1 + (size_t)MOE_PASS_TILES * 256 * DFF * 2 <= WS_MOEW, "act1");
static_assert(WS_MOEW + 8 * SZ_FFNW <= WS_Y && WS_Y + (size_t)264 * 256 * D * 2 <= WS_ROUTE && WS_ROUTE + 4 * MiB <= WS_H2B && WS_H2B + 64 * MiB <= WS_END, "moe map");
static_assert(WS_PROJ + (size_t)NTOK * NPROJ * 2 <= WS_UW && WS_ST + (size_t)NINST * 8192 <= WS_END, "mixer map");
constexpr int CW_TMO = 0, CW_CODE = 1;
constexpr int CW_BAR = 4096;
constexpr int CW_MOD = 16384;
constexpr int CW_MOECNT = 65536;
static_assert(CW_MOD + NLAYER * BATCH * 6 * D <= CW_MOECNT && (CW_MOECNT + 8 * 64) * 4 <= (int)CTL_ZERO_BYTES, "ctl");

constexpr int RING_OFF = 0, RING_BYTES = 131072;
constexpr int LDS_BYTES = 160 * 1024;
constexpr int MISC_OFF = LDS_BYTES - 256;

#define GAS __attribute__((address_space(1)))
#define LAS __attribute__((address_space(3)))
typedef unsigned short bf16;
typedef unsigned v4u __attribute__((ext_vector_type(4)));
typedef unsigned v2u __attribute__((ext_vector_type(2)));
typedef float f32x4 __attribute__((ext_vector_type(4)));
typedef float f32x16 __attribute__((ext_vector_type(16)));
typedef short bf16x8 __attribute__((ext_vector_type(8)));
typedef short bf16x4 __attribute__((ext_vector_type(4)));
typedef GAS unsigned gu32;
#define RLX_AGENT __ATOMIC_RELAXED, __HIP_MEMORY_SCOPE_AGENT
#define LDS_WAIT() asm volatile("s_waitcnt lgkmcnt(0)" ::: "memory")
#define VM_WAIT() asm volatile("s_waitcnt vmcnt(0)" ::: "memory")
__device__ __forceinline__ unsigned f2bf(float f) { unsigned u = __builtin_bit_cast(unsigned, f); return (u + 0x7fffu + ((u >> 16) & 1u)) >> 16; }
__device__ __forceinline__ unsigned pk2(float lo, float hi) { return f2bf(lo) | (f2bf(hi) << 16); }
__device__ __forceinline__ float bf2f(unsigned b) { return __builtin_bit_cast(float, b << 16); }
__device__ __forceinline__ float bflo(unsigned w) { return __builtin_bit_cast(float, w << 16); }
__device__ __forceinline__ float bfhi(unsigned w) { return __builtin_bit_cast(float, w & 0xffff0000u); }
__device__ __forceinline__ float fast_exp2(float x) { return __builtin_amdgcn_exp2f(x); }
__device__ __forceinline__ float fast_exp(float x) { return __builtin_amdgcn_exp2f(x * 1.4426950408889634f); }
__device__ __forceinline__ float fast_rcp(float x) { return __builtin_amdgcn_rcpf(x); }
__device__ __forceinline__ float sigmoidf_(float x) { return fast_rcp(1.f + fast_exp(-x)); }
__device__ __forceinline__ float siluf_(float x) { return x * sigmoidf_(x); }
__device__ __forceinline__ float wave_sum(float v) {
#pragma unroll
    for (int o = 1; o < 64; o <<= 1) v += __shfl_xor(v, o);
    return v;
}

#define XB_TMO      128
#define XB_XCNT(j)  (256  + 64 * (j))
#define XB_XSUB(j)  (1280 + 64 * (j))
#define XB_XGEN(j)  (2304 + 64 * (j))
#define XB_TOP      3328
#define XB_TOPGEN   3392
#define XCD_BAR_WORDS 3456
#define XB_SPIN_CAP (1u << 22)
__device__ __forceinline__ unsigned xb_ld(unsigned* p)              { return __hip_atomic_load(p, __ATOMIC_RELAXED, __HIP_MEMORY_SCOPE_AGENT); }
__device__ __forceinline__ unsigned xb_add(unsigned* p, unsigned v) { return __hip_atomic_fetch_add(p, v, __ATOMIC_RELAXED, __HIP_MEMORY_SCOPE_AGENT); }
__device__ __forceinline__ unsigned xb_xcc_id() { return (unsigned)__builtin_amdgcn_s_getreg((3 << 11) | 20) & 0xFu; }
#define XB_SPIN(cond, bar) do { unsigned _sp = 0; while (cond) { __builtin_amdgcn_s_sleep(1); \
    if ((++_sp & 255u) == 0u) { if (xb_ld(&(bar)[XB_TMO])) break; if (_sp > XB_SPIN_CAP) { atomicAdd(&(bar)[XB_TMO], 1u); break; } } } } while (0)
struct XcdBarrier { unsigned* bar; unsigned x; volatile LAS unsigned* st; };
__device__ __forceinline__ XcdBarrier xcd_barrier_post(unsigned* bar, volatile LAS unsigned* st) {
    XcdBarrier b; b.bar = bar; b.x = xb_xcc_id(); b.st = st;
    if (threadIdx.x == 0) (void)xb_add(&bar[XB_XCNT(b.x)], 1u);
    return b;
}
__device__ __forceinline__ void xcd_barrier_complete(unsigned* bar, unsigned x, unsigned& nloc, unsigned& nx) {
    const unsigned G = gridDim.x * gridDim.y * gridDim.z;
    unsigned sum, cnt, mine, sp = 0u;
    for (;;) {
        sum = 0u; cnt = 0u; mine = 0u;
#pragma unroll
        for (unsigned j = 0; j < 16; ++j) { const unsigned c = xb_ld(&bar[XB_XCNT(j)]); sum += c; cnt += (c > 0u) ? 1u : 0u; }
        mine = xb_ld(&bar[XB_XCNT(x)]);
        if (sum == G) break;
        __builtin_amdgcn_s_sleep(1);
        if ((++sp & 255u) == 0u) { if (xb_ld(&bar[XB_TMO])) break; if (sp > XB_SPIN_CAP) { atomicAdd(&bar[XB_TMO], 1u); break; } }
    }
    nloc = mine > 0u ? mine : 1u; nx = cnt > 0u ? cnt : 1u;
}
__device__ __forceinline__ void xcd_barrier(const XcdBarrier& b) {
    asm volatile("s_waitcnt vmcnt(0)" ::: "memory");
    __syncthreads();
    if (threadIdx.x == 0) {
        unsigned* bar = b.bar;
        __builtin_amdgcn_s_waitcnt(0);
        unsigned nloc = b.st[0], nx = b.st[1];
        if (nloc == 0u) { xcd_barrier_complete(bar, b.x, nloc, nx); b.st[0] = nloc; b.st[1] = nx; }
        const unsigned old = xb_add(&bar[XB_XSUB(b.x)], 1u);
        const unsigned gen = old / nloc;
        if (old + 1u == (gen + 1u) * nloc) {
            __builtin_amdgcn_fence(__ATOMIC_RELEASE, "agent");
            asm volatile("s_waitcnt vmcnt(0)" ::: "memory");
            const unsigned og = xb_add(&bar[XB_TOP], 1u);
            const unsigned tg = og / nx;
            if (og + 1u == (tg + 1u) * nx) xb_add(&bar[XB_TOPGEN], 1u);
            else XB_SPIN(xb_ld(&bar[XB_TOPGEN]) == tg, bar);
            __builtin_amdgcn_fence(__ATOMIC_ACQUIRE, "agent");
            xb_add(&bar[XB_XGEN(b.x)], 1u);
            asm volatile("s_waitcnt vmcnt(0)" ::: "memory");
        } else {
            XB_SPIN(xb_ld(&bar[XB_XGEN(b.x)]) == gen, bar);
            __builtin_amdgcn_fence(__ATOMIC_ACQUIRE, "agent");
            asm volatile("s_waitcnt vmcnt(0)" ::: "memory");
        }
    }
    __syncthreads();
}

struct Frame {
    LAS unsigned char* lds;
    volatile LAS unsigned* MISC;
    gu32* ctl;
    int tid, lane, wave;
    int vcu, G;
    unsigned char* ws;
    float* out;
    const float* const* in;
};
enum { I_X = 0, I_C, I_ADAW, I_ADAB, I_NMIXPRE, I_NMIXPOST, I_NFFNPRE, I_NFFNPOST, I_WIN, I_DLAMBDA, I_DSUBLN, I_POOLW, I_POOLSCALE, I_SCONVW, I_DCONVW, I_DALOG, I_DDTBIAS, I_DNORM,
       I_WBRANCH, I_WMERGE, I_BMERGE, I_WO, I_FFNG, I_FFNU, I_FFND, I_ROUTERW, I_ROUTERB, I_MOEG, I_MOEU, I_MOED, N_INPUTS };

__device__ __forceinline__ void cvt_item(const float* W, int ldw, int k0, int n0, bf16* WT, int Kd, int drow0, LAS float* scr, int lane) {
#pragma unroll 8
    for (int i = 0; i < 32; ++i) { const int kk = 2 * i + (lane >> 5); scr[kk * 33 + (lane & 31)] = W[(size_t)(k0 + kk) * ldw + n0 + (lane & 31)]; }
    LDS_WAIT(); asm volatile("" ::: "memory");
    const int c = lane & 7;
#pragma unroll
    for (int j = 0; j < 4; ++j) { const int n = (lane >> 3) + 8 * j; const LAS float* s = scr + (8 * c) * 33 + n;
        v4u o; o.x = pk2(s[0 * 33], s[1 * 33]); o.y = pk2(s[2 * 33], s[3 * 33]); o.z = pk2(s[4 * 33], s[5 * 33]); o.w = pk2(s[6 * 33], s[7 * 33]);
        *(GAS v4u*)(WT + (size_t)(drow0 + n) * Kd + k0 + 8 * c) = o; }
    LDS_WAIT(); asm volatile("" ::: "memory");
}
__device__ __forceinline__ void cvt_ffn_item(const float* wg, const float* wu, const float* wd, bf16* Wgu, bf16* Wd, int r, LAS float* scr, int lane) {
    constexpr int IG = (D / 64) * (DFF / 32);
    if (r < IG) { const int kb = r / (DFF / 32), nb = r % (DFF / 32), n0 = nb * 32; cvt_item(wg, DFF, kb * 64, n0, Wgu, D, 256 * (n0 >> 7) + (n0 & 127), scr, lane); return; } r -= IG;
    if (r < IG) { const int kb = r / (DFF / 32), nb = r % (DFF / 32), n0 = nb * 32; cvt_item(wu, DFF, kb * 64, n0, Wgu, D, 256 * (n0 >> 7) + (n0 & 127) + 128, scr, lane); return; } r -= IG;
    { const int kb = r / (D / 32), nb = r % (D / 32); cvt_item(wd, D, kb * 64, nb * 32, Wd, DFF, nb * 32, scr, lane); }
}
constexpr int FFN_ITEMS = 3 * (D / 64) * (DFF / 32);
__device__ __forceinline__ bf16* w_in_t(unsigned char* ws, int l) { return (bf16*)(ws + WS_W + (size_t)l * SZ_LAYERW); }
__device__ __forceinline__ bf16* w_m_t(unsigned char* ws, int l) { return (bf16*)(ws + WS_W + (size_t)l * SZ_LAYERW + SZ_WIN); }
__device__ __forceinline__ bf16* w_b_t(unsigned char* ws, int l) { return (bf16*)(ws + WS_W + (size_t)l * SZ_LAYERW + SZ_WIN + SZ_WM); }
__device__ __forceinline__ bf16* w_o_t(unsigned char* ws, int l) { return (bf16*)(ws + WS_W + (size_t)l * SZ_LAYERW + SZ_WIN + SZ_WM + SZ_WB); }

__device__ __forceinline__ void p_prologue(Frame& F) {
    LAS float* scr = (LAS float*)(F.lds + RING_OFF + F.wave * 16384);
    const int gw = F.vcu * NWAVES + F.wave, NGW = F.G * NWAVES;
    constexpr int I_IN = (D / 64) * (NPROJ / 32), I_M = (D / 64) * (D / 32), I_B = (256 / 64) * (D / 32);
    constexpr int PER_LAYER = I_IN + 4 * I_M + 4 * I_B + I_M;
    constexpr int NITEMS = NLAYER * PER_LAYER + FFN_ITEMS;
    for (int it = gw; it < NITEMS; it += NGW) {
        int r = it;
        if (r >= NLAYER * PER_LAYER) { r -= NLAYER * PER_LAYER;
            cvt_ffn_item(F.in[I_FFNG], F.in[I_FFNU], F.in[I_FFND], (bf16*)(F.ws + WS_WFFN), (bf16*)(F.ws + WS_WFFN + SZ_WGU), r, scr, F.lane); continue; }
        const int l = r / PER_LAYER; r -= l * PER_LAYER;
        if (r < I_IN) { const int kb = r / (NPROJ / 32), nb = r % (NPROJ / 32); cvt_item(F.in[I_WIN] + (size_t)l * D * IN_COLS, IN_COLS, kb * 64, nb * 32, w_in_t(F.ws, l), D, nb * 32, scr, F.lane); continue; } r -= I_IN;
        if (r < 4 * I_M) { const int i = r / I_M; r -= i * I_M; const int kb = r / (D / 32), nb = r % (D / 32);
            cvt_item(F.in[I_WMERGE] + ((size_t)l * 4 + i) * D * D, D, kb * 64, nb * 32, w_m_t(F.ws, l), D, i * 1024 + nb * 32, scr, F.lane); continue; } r -= 4 * I_M;
        if (r < 4 * I_B) { const int i = r / I_B; r -= i * I_B; const int kb = r / (D / 32), nb = r % (D / 32);
            cvt_item(F.in[I_WBRANCH] + ((size_t)l * 4 + i) * 256 * D, D, kb * 64, nb * 32, w_b_t(F.ws, l) + (size_t)i * 1024 * 256, 256, nb * 32, scr, F.lane); continue; } r -= 4 * I_B;
        { const int kb = r / (D / 32), nb = r % (D / 32); cvt_item(F.in[I_WO] + (size_t)l * D * D, D, kb * 64, nb * 32, w_o_t(F.ws, l), D, nb * 32, scr, F.lane); }
    }
    constexpr int MOD_ITEMS = NLAYER * 24;
    for (int it = gw; it < MOD_ITEMS; it += NGW) {
        const int l = it / 24, nb = it % 24;
        const float* Wp = F.in[I_ADAW] + (size_t)l * D * (6 * D) + nb * 256 + F.lane * 4;
        f32x4 a0 = {0.f, 0.f, 0.f, 0.f}, a1 = {0.f, 0.f, 0.f, 0.f};
#pragma unroll 8
        for (int k = 0; k < D; ++k) { const f32x4 w = *(const GAS f32x4*)(Wp + (size_t)k * (6 * D));
            const float c0 = siluf_(F.in[I_C][k]), c1 = siluf_(F.in[I_C][D + k]); a0 += w * c0; a1 += w * c1; }
        float* m0 = (float*)(F.ctl + CW_MOD) + (size_t)(l * BATCH + 0) * 6 * D + nb * 256 + F.lane * 4;
        *(GAS f32x4*)m0 = a0; *(GAS f32x4*)(m0 + 6 * D) = a1;
    }
}
__device__ __forceinline__ void p_moe_cvt(Frame& F) {
    LAS float* scr = (LAS float*)(F.lds + RING_OFF + F.wave * 16384);
    const int gw = F.vcu * NWAVES + F.wave, NGW = F.G * NWAVES;
    for (int it = gw; it < NEXP * FFN_ITEMS; it += NGW) {
        const int e = it / FFN_ITEMS, r = it % FFN_ITEMS;
        bf16* base = (bf16*)(F.ws + WS_MOEW + (size_t)e * SZ_FFNW);
        cvt_ffn_item(F.in[I_MOEG] + (size_t)e * D * DFF, F.in[I_MOEU] + (size_t)e * D * DFF, F.in[I_MOED] + (size_t)e * DFF * D, base, (bf16*)((unsigned char*)base + SZ_WGU), r, scr, F.lane);
    }
}

struct Row { f32x4 v[4]; };
__device__ __forceinline__ float modv(Frame& F, int l, int b, int idx) { return ((const float*)(F.ctl + CW_MOD))[(size_t)(l * BATCH + b) * 6 * D + idx] + F.in[I_ADAB][l * 6 * D + idx]; }
__device__ __forceinline__ f32x4 modv4(Frame& F, int l, int b, int idx) {
    const f32x4 a = *(const GAS f32x4*)((const float*)(F.ctl + CW_MOD) + (size_t)(l * BATCH + b) * 6 * D + idx), c = *(const GAS f32x4*)(F.in[I_ADAB] + l * 6 * D + idx); return a + c; }
__device__ __forceinline__ float row_rstd(const Row& r) {
    float s = 0.f;
#pragma unroll
    for (int j = 0; j < 4; ++j) s += (r.v[j].x * r.v[j].x + r.v[j].y * r.v[j].y) + (r.v[j].z * r.v[j].z + r.v[j].w * r.v[j].w);
    return 1.f / sqrtf(wave_sum(s) * (1.f / D) + EPS);
}
__device__ __forceinline__ void row_resid(Frame& F, Row& x, const Row& f, const float* gain, int l, int b, int gidx) {
    const float rs = row_rstd(f);
#pragma unroll
    for (int j = 0; j < 4; ++j) { const int c = 4 * F.lane + 256 * j; const f32x4 g = *(const GAS f32x4*)(gain + c), m = modv4(F, l, b, gidx + c); x.v[j] += m * (f.v[j] * rs * g); }
}
__device__ __forceinline__ void row_make_h(Frame& F, Row& h, const Row& x, const float* gain, int l, int b, int shidx, int scidx) {
    const float rs = row_rstd(x);
#pragma unroll
    for (int j = 0; j < 4; ++j) { const int c = 4 * F.lane + 256 * j; const f32x4 g = *(const GAS f32x4*)(gain + c), sc = modv4(F, l, b, scidx + c), sh = modv4(F, l, b, shidx + c);
        h.v[j] = (x.v[j] * rs * g) * (sc + 1.f) + sh; }
}
__device__ __forceinline__ void row_store_bf16(Frame& F, const Row& h, bf16* dst) {
    GAS unsigned long long* o8 = (GAS unsigned long long*)dst + F.lane;
#pragma unroll
    for (int j = 0; j < 4; ++j) o8[64 * j] = (unsigned long long)pk2(h.v[j].x, h.v[j].y) | ((unsigned long long)pk2(h.v[j].z, h.v[j].w) << 32);
}
__device__ __forceinline__ void row_load_f32(Frame& F, Row& r, const float* src) {
    const GAS f32x4* p = (const GAS f32x4*)src + F.lane;
#pragma unroll
    for (int j = 0; j < 4; ++j) r.v[j] = p[64 * j];
}
__device__ __forceinline__ void row_store_f32(Frame& F, const Row& r, float* dst) {
    GAS f32x4* p = (GAS f32x4*)dst + F.lane;
#pragma unroll
    for (int j = 0; j < 4; ++j) p[64 * j] = r.v[j];
}
__device__ __forceinline__ void row_load_bf16(Frame& F, Row& r, const bf16* src) {
    const GAS v2u* p = (const GAS v2u*)src + F.lane;
#pragma unroll
    for (int j = 0; j < 4; ++j) { const v2u w = p[64 * j]; r.v[j] = (f32x4){bflo(w.x), bfhi(w.x), bflo(w.y), bfhi(w.y)}; }
}
template <int NO> __device__ __forceinline__ void row_dots(Frame& F, const Row& h, const LAS float* WT, float (&out)[NO]) {
#pragma unroll
    for (int o = 0; o < NO; ++o) { float s = 0.f;
#pragma unroll
        for (int j = 0; j < 4; ++j) { const f32x4 w = *(const LAS f32x4*)(WT + o * 1024 + 4 * F.lane + 256 * j); s += (h.v[j].x * w.x + h.v[j].y * w.y) + (h.v[j].z * w.z + h.v[j].w * w.w); }
        out[o] = s; if ((o & 3) == 3) __builtin_amdgcn_sched_barrier(0); }
#pragma unroll
    for (int o = 0; o < NO; ++o) { out[o] = wave_sum(out[o]); if ((o & 3) == 3) __builtin_amdgcn_sched_barrier(0); }
}
template <int NO> __device__ __forceinline__ void load_wt(Frame& F, const float* W, int ldw, int col0, LAS float* WT) {
    for (int k = F.tid; k < 1024; k += NWAVES * 64) {
#pragma unroll
        for (int o = 0; o < NO; ++o) WT[o * 1024 + k] = W[(size_t)k * ldw + col0 + o];
    }
    __syncthreads();
}
__device__ __forceinline__ float softplusf_(float x) { return x > 20.f ? x : log1pf(__expf(x)); }
__device__ __forceinline__ void row_bd(Frame& F, const Row& h, const LAS float* W16T, int l, int row) {
    float o16[16]; row_dots<16>(F, h, W16T, o16);
    float mine = 0.f;
#pragma unroll
    for (int o = 0; o < 16; ++o) mine = (F.lane == o) ? o16[o] : mine;
    if (F.lane < 16) {
        float r;
        if (F.lane < 8) r = 1.f / (1.f + __expf(-mine));
        else { const int i = F.lane - 8; r = -__expf(F.in[I_DALOG][l * 8 + i]) * softplusf_(mine + F.in[I_DDTBIAS][l * 8 + i]); }
        ((float*)(F.ws + WS_BD))[(size_t)row * 16 + F.lane] = r;
    }
}
__device__ __forceinline__ void moe_tiles(Frame& F, int (&cnt)[NEXP], int (&tstart)[NEXP + 1]) {
    int acc = 0;
#pragma unroll
    for (int e = 0; e < NEXP; ++e) { cnt[e] = (int)__hip_atomic_load(F.ctl + CW_MOECNT + 64 * e, RLX_AGENT); tstart[e] = acc; acc += (cnt[e] + 255) >> 8; }
    tstart[NEXP] = acc;
}

constexpr int ROW_A = 0, ROW_B = 1, ROW_C = 2;
template <int MODE> __device__ __forceinline__ void p_rows(Frame& F, const int l) {
    const int gw = F.vcu * NWAVES + F.wave, NGW = F.G * NWAVES;
    LAS float* WT = (LAS float*)(F.lds + RING_OFF);
    LAS int* linfo = (LAS int*)(F.lds + RING_OFF + 65536);
    LAS int* lcnt = (LAS int*)(F.lds + RING_OFF + 65536 + 8 * 32 * 16);
    const bool do_h1 = (MODE == ROW_A) || (MODE == ROW_C && l + 1 < NLAYER);
    const int lh = (MODE == ROW_C) ? l + 1 : l;
    const bool router = (MODE == ROW_B) && (l == 1);
    if (do_h1) load_wt<16>(F, F.in[I_WIN] + (size_t)lh * D * IN_COLS, IN_COLS, NPROJ, WT);
    if (router) { if (F.tid < 16) lcnt[F.tid] = 0; load_wt<8>(F, F.in[I_ROUTERW], NEXP, 0, WT); }
    int cnt[NEXP], tstart[NEXP + 1];
    if (MODE == ROW_C && l == 1) moe_tiles(F, cnt, tstart);
    const float* xsrc = (MODE == ROW_A || (MODE == ROW_B && l == 0)) ? F.in[I_X] : F.out;
    int ri = 0;
    for (int m = gw; m < NTOK; m += NGW, ++ri) {
        const int b = m / SEQ;
        Row x; row_load_f32(F, x, xsrc + (size_t)m * D);
        if (MODE == ROW_B) {
            Row f; row_load_bf16(F, f, (const bf16*)(F.ws + WS_F) + (size_t)m * D);
            row_resid(F, x, f, F.in[I_NMIXPOST] + l * D, l, b, 2 * D);
            row_store_f32(F, x, F.out + (size_t)m * D);
            Row h; row_make_h(F, h, x, F.in[I_NFFNPRE] + l * D, l, b, 3 * D, 4 * D);
            row_store_bf16(F, h, (bf16*)(F.ws + (l == 0 ? WS_H : WS_H2B)) + (size_t)m * D);
            if (router) {
                float lg[NEXP]; row_dots<NEXP>(F, h, WT, lg);
                int e0 = 0; float l0 = lg[0] + F.in[I_ROUTERB][0];
#pragma unroll
                for (int e = 0; e < NEXP; ++e) lg[e] += F.in[I_ROUTERB][e];
#pragma unroll
                for (int e = 1; e < NEXP; ++e) if (lg[e] > l0) { l0 = lg[e]; e0 = e; }
                int e1 = -1; float l1 = -3.0e38f;
#pragma unroll
                for (int e = 0; e < NEXP; ++e) if (e != e0 && lg[e] > l1) { l1 = lg[e]; e1 = e; }
                const float q1 = __expf(l1 - l0), p0 = 1.f / (1.f + q1), p1 = q1 * p0;
                if (F.lane == 0) {
                    const int i0 = atomicAdd((int*)&lcnt[e0], 1), i1 = atomicAdd((int*)&lcnt[e1], 1);
                    LAS int* li = linfo + (F.wave * 32 + ri) * 4;
                    li[0] = e0 | (e1 << 8) | (i0 << 16); li[1] = i1; li[2] = __float_as_int(p0); li[3] = __float_as_int(p1);
                }
            }
        } else if (MODE == ROW_C) {
            Row f;
            if (l == 0) row_load_bf16(F, f, (const bf16*)(F.ws + WS_F) + (size_t)m * D);
            else {
                const int* ti = (const int*)(F.ws + WS_ROUTE) + (size_t)m * 8;
                const int e0 = ti[0], i0 = ti[1], e1 = ti[2], i1 = ti[3]; const float p0 = __int_as_float(ti[4]), p1 = __int_as_float(ti[5]);
                int s0 = 0, s1 = 0;
#pragma unroll
                for (int e = 0; e < NEXP; ++e) { s0 = (e == e0) ? tstart[e] * 256 + i0 : s0; s1 = (e == e1) ? tstart[e] * 256 + i1 : s1; }
                Row y0, y1; row_load_bf16(F, y0, (const bf16*)(F.ws + WS_Y) + (size_t)s0 * D); row_load_bf16(F, y1, (const bf16*)(F.ws + WS_Y) + (size_t)s1 * D);
#pragma unroll
                for (int j = 0; j < 4; ++j) f.v[j] = y0.v[j] * p0 + y1.v[j] * p1;
            }
            row_resid(F, x, f, F.in[I_NFFNPOST] + l * D, l, b, 5 * D);
            row_store_f32(F, x, F.out + (size_t)m * D);
        }
        if (do_h1) {
            Row h; row_make_h(F, h, x, F.in[I_NMIXPRE] + lh * D, lh, b, 0, 1 * D);
            row_store_bf16(F, h, (bf16*)(F.ws + WS_H) + (size_t)m * D);
            row_bd(F, h, WT, lh, m);
        }
    }
    if (router) {
        __syncthreads();
        if (F.tid < NEXP) lcnt[8 + F.tid] = (int)__hip_atomic_fetch_add(F.ctl + CW_MOECNT + 64 * F.tid, (unsigned)lcnt[F.tid], RLX_AGENT);
        __syncthreads();
        ri = 0;
        for (int m = gw; m < NTOK; m += NGW, ++ri) {
            if (F.lane == 0) {
                const LAS int* li = linfo + (F.wave * 32 + ri) * 4;
                const int w0 = li[0], e0 = w0 & 255, e1 = (w0 >> 8) & 255, i0 = (w0 >> 16) + lcnt[8 + e0], i1 = li[1] + lcnt[8 + e1];
                int* ti = (int*)(F.ws + WS_ROUTE) + (size_t)m * 8;
                ti[0] = e0; ti[1] = i0; ti[2] = e1; ti[3] = i1; ti[4] = li[2]; ti[5] = li[3];
                int* lists = (int*)(F.ws + WS_ROUTE + 1 * MiB);
                lists[(size_t)e0 * 65536 + i0] = m; lists[(size_t)e1 * 65536 + i1] = m;
            }
        }
    }
    __syncthreads();
}

namespace pg8 {
constexpr int NXCD = 8, WGM = 8;
struct SchedStd {
    int nM, nN, nwg, G, c; const char* A; size_t a_tile; const char* B; size_t b_tile;
    __device__ __forceinline__ void init(int nM_, int nN_, int G_, int c_, const void* A_, size_t a_tile_, const void* B_, size_t b_tile_) { nM = nM_; nN = nN_; nwg = nM * nN; G = G_; c = c_; A = (const char*)A_; a_tile = a_tile_; B = (const char*)B_; b_tile = b_tile_; }
    __device__ __forceinline__ bool next(int i, Unit& u) const {
        const long L = (long)i * G + c; if (L >= nwg) return false;
        int wgid = (int)L; { const int q = nwg / NXCD, r = nwg % NXCD, xcd = wgid % NXCD, off = wgid / NXCD; wgid = (xcd < r ? xcd * (q + 1) : r * (q + 1) + (xcd - r) * q) + off; }
        const int nig = WGM * nN, gid = wgid / nig, fm = gid * WGM, gsz = (nM - fm) < WGM ? (nM - fm) : WGM;
        u.pm = fm + ((wgid % nig) % gsz); u.pn = (wgid % nig) / gsz; u.aux = 0; u.pad = 0; u.a = A + (size_t)u.pm * a_tile; u.b = B + (size_t)u.pn * b_tile; u.rows = nullptr; return true;
    }
    __device__ __forceinline__ void a_ready(const Unit&) const {}
    __device__ __forceinline__ void done(const Unit&) const {}
};
struct SchedBranch {
    SchedStd s; const char* O4; const char* Wb;
    __device__ __forceinline__ bool next(int i, Unit& u) const {
        if (!s.next(i, u)) return false;
        const int br = u.pn >> 2; u.pn &= 3; u.aux = br;
        u.a = O4 + (size_t)u.pm * 256 * 1024 * 2 + (size_t)br * 256 * 2; u.b = Wb + (size_t)br * 1024 * 256 * 2 + (size_t)u.pn * 256 * 256 * 2; return true;
    }
    __device__ __forceinline__ void a_ready(const Unit&) const {}
    __device__ __forceinline__ void done(const Unit&) const {}
};
struct SchedGate {
    int vcu, G; const char* H; const char* Wm;
    __device__ __forceinline__ bool next(int i, Unit& u) const {
        const int tg = vcu + G * (i >> 2); if (tg >= 512) return false;
        u.pm = tg >> 2; u.pn = tg & 3; u.aux = i & 3; u.pad = 0; u.rows = nullptr;
        u.a = H + (size_t)u.pm * 256 * 1024 * 2; u.b = Wm + ((size_t)u.aux * 1024 + (size_t)u.pn * 256) * 1024 * 2; return true;
    }
    __device__ __forceinline__ void a_ready(const Unit&) const {}
    __device__ __forceinline__ void done(const Unit&) const {}
};
struct SchedMoe {
    int c, G, t0, t1, nN; int tstart[9]; int cnt[8];
    const char* A; const int* lists; const char* W; size_t w_tile; bool gather;
    __device__ __forceinline__ bool next(int i, Unit& u) const {
        const long L = (long)i * G + c; const int t = t0 + (int)(L / nN); if (t >= t1) return false;
        int e = 0;
#pragma unroll
        for (int k = 1; k < 8; ++k) e = (t >= tstart[k]) ? k : e;
        int ce = 0;
#pragma unroll
        for (int k = 0; k < 8; ++k) ce = (k == e) ? cnt[k] : ce;
        const int j = t - ((e == 0) ? 0 : 0), jj = t;
        (void)j; (void)jj;
        int ts = 0;
#pragma unroll
        for (int k = 0; k < 8; ++k) ts = (k == e) ? tstart[k] : ts;
        const int tj = t - ts;
        u.pn = (int)(L % nN); u.pad = 0;
        if (gather) { u.pm = t - t0; u.a = A; u.rows = lists + (size_t)e * 65536 + tj * 256; const int nv = ce - tj * 256; u.aux = nv > 256 ? 256 : nv; }
        else { u.pm = t; u.a = A + (size_t)(t - t0) * 256 * DFF_ * 2; u.rows = nullptr; u.aux = 0; }
        u.b = W + (size_t)e * SZ_EXP_ + (size_t)u.pn * w_tile; return true;
    }
    static constexpr size_t DFF_ = 2816; static constexpr size_t SZ_EXP_ = (size_t)2 * 2816 * 1024 * 2 + (size_t)1024 * 2816 * 2;
    __device__ __forceinline__ void a_ready(const Unit&) const {}
    __device__ __forceinline__ void done(const Unit&) const {}
};

struct EpiStore {
    static constexpr bool PERM = true;
    bf16_t* O; int ldc; size_t aux_stride; float scale0;
    __device__ __forceinline__ void operator()(const f32x4 (&acc)[2][2][4][2], const Unit& u, int wr, int wc, int fr, int fq) const {
        const int row0 = u.pm * BM + wr * 64 + fr, col0 = u.pn * BM + wc * 32 + 8 * fq; bf16_t* base = O + (size_t)u.aux * aux_stride;
        const float sc = (u.pn == 0) ? scale0 : 1.f;
#pragma unroll
        for (int ai = 0; ai < 2; ++ai)
#pragma unroll
            for (int m = 0; m < 4; ++m) { bf16_t* rowp = base + (size_t)(row0 + ai * HALF + m * 16) * ldc + col0;
#pragma unroll
                for (int bj = 0; bj < 2; ++bj) { const f32x4 v0 = acc[ai][bj][m][0] * sc, v1 = acc[ai][bj][m][1] * sc;
                    u32x4 w; w.x = cvt_pk_bf16(v0[0], v0[1]); w.y = cvt_pk_bf16(v0[2], v0[3]); w.z = cvt_pk_bf16(v1[0], v1[1]); w.w = cvt_pk_bf16(v1[2], v1[3]);
                    *(u32x4*)(rowp + bj * HALF) = w; } }
    }
};
__device__ __forceinline__ float sigm(float x) { return __builtin_amdgcn_rcpf(1.f + __builtin_amdgcn_exp2f(-1.4426950408889634f * x)); }
struct EpiGate {
    static constexpr bool PERM = true;
    const bf16_t* P; bf16_t* Mg; const float* bias;
    __device__ __forceinline__ void operator()(const f32x4 (&acc)[2][2][4][2], const Unit& u, int wr, int wc, int fr, int fq) const {
        const int row0 = u.pm * BM + wr * 64 + fr, col0 = u.pn * BM + wc * 32 + 8 * fq; const int br = u.aux;
        const bf16_t* Pb = P + (size_t)br * 32768 * 1024; const float* bb = bias + br * 1024 + col0;
        f32x4 bv[2][2];
#pragma unroll
        for (int bj = 0; bj < 2; ++bj)
#pragma unroll
            for (int n = 0; n < 2; ++n) bv[bj][n] = *(const f32x4*)(bb + bj * HALF + 4 * n);
#pragma unroll
        for (int ai = 0; ai < 2; ++ai)
#pragma unroll
            for (int m = 0; m < 4; ++m) { const size_t ro = (size_t)(row0 + ai * HALF + m * 16) * 1024 + col0;
#pragma unroll
                for (int bj = 0; bj < 2; ++bj) {
                    const u32x4 pw = *(const u32x4*)(Pb + ro + bj * HALF);
                    u32x4 mw = {0u, 0u, 0u, 0u}; if (br != 0) mw = *(const u32x4*)(Mg + ro + bj * HALF);
                    float o[8];
#pragma unroll
                    for (int q = 0; q < 4; ++q) {
                        const float g0 = sigm(acc[ai][bj][m][q >> 1][(q & 1) * 2] + bv[bj][q >> 1][(q & 1) * 2]), g1 = sigm(acc[ai][bj][m][q >> 1][(q & 1) * 2 + 1] + bv[bj][q >> 1][(q & 1) * 2 + 1]);
                        o[2 * q] = g0 * __builtin_bit_cast(float, pw[q] << 16) + __builtin_bit_cast(float, mw[q] << 16);
                        o[2 * q + 1] = g1 * __builtin_bit_cast(float, pw[q] & 0xffff0000u) + __builtin_bit_cast(float, mw[q] & 0xffff0000u);
                    }
                    u32x4 w; w.x = cvt_pk_bf16(o[0], o[1]); w.y = cvt_pk_bf16(o[2], o[3]); w.z = cvt_pk_bf16(o[4], o[5]); w.w = cvt_pk_bf16(o[6], o[7]);
                    *(u32x4*)(Mg + ro + bj * HALF) = w; } }
    }
};
struct EpiSwiGLU {
    static constexpr bool PERM = true;
    bf16_t* O; int ldc;
    __device__ __forceinline__ void operator()(const f32x4 (&acc)[2][2][4][2], const Unit& u, int wr, int wc, int fr, int fq) const {
        const int row0 = u.pm * BM + wr * 64 + fr, col0 = u.pn * HALF + wc * 32 + 8 * fq;
#pragma unroll
        for (int ai = 0; ai < 2; ++ai)
#pragma unroll
            for (int m = 0; m < 4; ++m) { bf16_t* rowp = O + (size_t)(row0 + ai * HALF + m * 16) * ldc + col0;
                float o[8];
#pragma unroll
                for (int n = 0; n < 2; ++n)
#pragma unroll
                    for (int q = 0; q < 4; ++q) { const float g = acc[ai][0][m][n][q], up = acc[ai][1][m][n][q]; o[4 * n + q] = g * sigm(g) * up; }
                u32x4 w; w.x = cvt_pk_bf16(o[0], o[1]); w.y = cvt_pk_bf16(o[2], o[3]); w.z = cvt_pk_bf16(o[4], o[5]); w.w = cvt_pk_bf16(o[6], o[7]);
                *(u32x4*)rowp = w; }
    }
};
}

namespace att {
constexpr int KP = 40, VP = 68;
constexpr int K1_OFF = 0, K2_OFF = 64 * KP * 2, VT_OFF = 2 * 64 * KP * 2, BUF_BYTES = VT_OFF + 64 * VP * 2;
constexpr int ATTN_LDS = 2 * BUF_BYTES;
__device__ __forceinline__ unsigned cvtpk(float lo, float hi) { typedef float f2 __attribute__((ext_vector_type(2))); typedef __bf16 b2 __attribute__((ext_vector_type(2))); f2 v = {lo, hi}; b2 b = __builtin_convertvector(v, b2); return __builtin_bit_cast(unsigned, b); }

__device__ __forceinline__ void attn_unit(Frame& F, const int layer, const int b, const int h, const int qb) {
    const int tid = F.tid, lane = F.lane, r32 = lane & 31, hi = lane >> 5, wid = F.wave;
    const bf16* P = (const bf16*)(F.ws + WS_PROJ) + (size_t)b * SEQ * NPROJ;
    LAS unsigned char* L = F.lds + RING_OFF;
    const int q = qb * 256 + wid * 32 + r32;
    const float slope2 = exp2f(-2.f * (float)(h + 1)) * 1.4426950408889634f;
    bf16x8 q1f[2], q2f[2];
#pragma unroll
    for (int ks = 0; ks < 2; ++ks) { q1f[ks] = *(const GAS bf16x8*)(P + (size_t)q * NPROJ + C_Q + 32 * h + 16 * ks + 8 * hi); q2f[ks] = *(const GAS bf16x8*)(P + (size_t)q * NPROJ + C_Q + 128 + 32 * h + 16 * ks + 8 * hi); }
    const int srow = tid >> 3, sch = tid & 7;
    const bf16* ksrc = P + (size_t)srow * NPROJ + (sch < 4 ? C_K + 32 * h + 8 * sch : C_K + 128 + 32 * h + 8 * (sch - 4));
    const bf16* vsrc = P + (size_t)srow * NPROJ + C_V + 64 * h + 8 * sch;
    const int kdst = (sch < 4 ? K1_OFF : K2_OFF) + srow * (KP * 2) + (sch & 3) * 16;
    const int vdst = VT_OFF + (8 * sch) * (VP * 2) + srow * 2;
    v4u kreg = *(const GAS v4u*)ksrc, vreg = *(const GAS v4u*)vsrc;
#define ATT_STAGE_WRITE(buf) do { LAS unsigned char* Bw = L + (buf) * BUF_BYTES; *(LAS v4u*)(Bw + kdst) = kreg; \
        _Pragma("unroll") for (int e = 0; e < 4; ++e) { const unsigned w = vreg[e]; *(LAS unsigned short*)(Bw + vdst + (2 * e) * (VP * 2)) = (unsigned short)(w & 0xffffu); *(LAS unsigned short*)(Bw + vdst + (2 * e + 1) * (VP * 2)) = (unsigned short)(w >> 16); } } while (0)
    ATT_STAGE_WRITE(0);
    __syncthreads();
    float R = 0.f, l1 = 0.f, l2 = 0.f;
    f32x16 O1[2], O2[2];
#pragma unroll
    for (int i = 0; i < 16; ++i) { O1[0][i] = 0.f; O1[1][i] = 0.f; O2[0][i] = 0.f; O2[1][i] = 0.f; }
    const int kfo = r32 * (KP * 2) + hi * 16;
    const int vfo = VT_OFF + r32 * (VP * 2) + hi * 8;
    constexpr int NT = SEQ / 64;
    for (int t = 0; t < NT; ++t) {
        if (t + 1 < NT) { kreg = *(const GAS v4u*)(ksrc + (size_t)(t + 1) * 64 * NPROJ); vreg = *(const GAS v4u*)(vsrc + (size_t)(t + 1) * 64 * NPROJ); }
        const LAS unsigned char* Bf = L + (t & 1) * BUF_BYTES;
        const float dl = (float)(q - t * 64 - 4 * hi);
        f32x16 c0, c1;
#pragma unroll
        for (int r = 0; r < 16; ++r) { const float cc = (float)((r & 3) + 8 * (r >> 2)); c0[r] = __builtin_fmaf(-slope2, __builtin_fabsf(dl - cc), -R); c1[r] = __builtin_fmaf(-slope2, __builtin_fabsf(dl - (cc + 32.f)), -R); }
#pragma unroll
        for (int mp = 0; mp < 2; ++mp) {
            const int koff = mp ? K2_OFF : K1_OFF;
            const bf16x8 qa = mp ? q2f[0] : q1f[0], qbb = mp ? q2f[1] : q1f[1];
            const bf16x8 k00 = *(const LAS bf16x8*)(Bf + koff + kfo), k01 = *(const LAS bf16x8*)(Bf + koff + kfo + 32);
            const bf16x8 k10 = *(const LAS bf16x8*)(Bf + koff + 32 * (KP * 2) + kfo), k11 = *(const LAS bf16x8*)(Bf + koff + 32 * (KP * 2) + kfo + 32);
            f32x16 s0 = __builtin_amdgcn_mfma_f32_32x32x16_bf16(k00, qa, c0, 0, 0, 0); s0 = __builtin_amdgcn_mfma_f32_32x32x16_bf16(k01, qbb, s0, 0, 0, 0);
            f32x16 s1 = __builtin_amdgcn_mfma_f32_32x32x16_bf16(k10, qa, c1, 0, 0, 0); s1 = __builtin_amdgcn_mfma_f32_32x32x16_bf16(k11, qbb, s1, 0, 0, 0);
            float rm = fmaxf(s0[0], s1[0]);
#pragma unroll
            for (int r = 1; r < 16; ++r) rm = fmaxf(rm, fmaxf(s0[r], s1[r]));
            rm = fmaxf(rm, __shfl_xor(rm, 32));
            if (__any(rm > 8.f)) {
                const float dd = fmaxf(rm, 0.f); R += dd;
                const float f = fast_exp2(-dd); l1 *= f; l2 *= f;
#pragma unroll
                for (int r = 0; r < 16; ++r) { s0[r] -= dd; s1[r] -= dd; c0[r] -= dd; c1[r] -= dd; O1[0][r] *= f; O1[1][r] *= f; O2[0][r] *= f; O2[1][r] *= f; }
            }
            float sum = 0.f;
#pragma unroll
            for (int r = 0; r < 16; ++r) { s0[r] = fast_exp2(s0[r]); s1[r] = fast_exp2(s1[r]); sum += s0[r] + s1[r]; }
            if (mp) l2 += sum; else l1 += sum;
            v4u pw[4];
#pragma unroll
            for (int e = 0; e < 4; ++e) { pw[0][e] = cvtpk(s0[2 * e], s0[2 * e + 1]); pw[1][e] = cvtpk(s0[8 + 2 * e], s0[8 + 2 * e + 1]); pw[2][e] = cvtpk(s1[2 * e], s1[2 * e + 1]); pw[3][e] = cvtpk(s1[8 + 2 * e], s1[8 + 2 * e + 1]); }
#pragma unroll
            for (int db = 0; db < 2; ++db) {
                f32x16 o = mp ? O2[db] : O1[db];
#pragma unroll
                for (int ks = 0; ks < 4; ++ks) {
                    const v2u lo = *(const LAS v2u*)(Bf + vfo + db * 32 * (VP * 2) + ks * 32), hi8 = *(const LAS v2u*)(Bf + vfo + db * 32 * (VP * 2) + ks * 32 + 16);
                    const v4u vf = {lo.x, lo.y, hi8.x, hi8.y};
                    o = __builtin_amdgcn_mfma_f32_32x32x16_bf16(__builtin_bit_cast(bf16x8, vf), __builtin_bit_cast(bf16x8, pw[ks]), o, 0, 0, 0);
                }
                if (mp) O2[db] = o; else O1[db] = o;
            }
        }
        if (t + 1 < NT) ATT_STAGE_WRITE((t + 1) & 1);
        __syncthreads();
    }
    l1 += __shfl_xor(l1, 32); l2 += __shfl_xor(l2, 32);
    const float* dlm = F.in[I_DLAMBDA] + layer * 128;
    float a1 = 0.f, a2 = 0.f;
#pragma unroll 8
    for (int i = 0; i < 32; ++i) { a1 += dlm[i] * dlm[32 + i]; a2 += dlm[64 + i] * dlm[96 + i]; }
    const float lam_init = 0.8f - 0.6f * __expf(-0.3f * (float)layer);
    const float lam = __expf(a1) - __expf(a2) + lam_init;
    const float i1 = 1.f / fmaxf(l1, 1e-30f), i2 = lam / fmaxf(l2, 1e-30f);
    float ss = 0.f;
#pragma unroll
    for (int db = 0; db < 2; ++db)
#pragma unroll
        for (int r = 0; r < 16; ++r) { const float v = O1[db][r] * i1 - O2[db][r] * i2; O1[db][r] = v; ss += v * v; }
    ss += __shfl_xor(ss, 32);
    const float rs = (1.f / sqrtf(ss * (1.f / 64.f) + EPS)) * (1.f - lam_init);
    bf16* orow = (bf16*)(F.ws + WS_O4) + ((size_t)b * SEQ + q) * 1024 + 64 * h;
    const float* sg = F.in[I_DSUBLN] + layer * 64;
#pragma unroll
    for (int db = 0; db < 2; ++db)
#pragma unroll
        for (int g4 = 0; g4 < 4; ++g4) {
            const int d0 = 32 * db + 8 * g4 + 4 * hi;
            const float v0 = O1[db][4 * g4] * rs * sg[d0], v1 = O1[db][4 * g4 + 1] * rs * sg[d0 + 1], v2 = O1[db][4 * g4 + 2] * rs * sg[d0 + 2], v3 = O1[db][4 * g4 + 3] * rs * sg[d0 + 3];
            v2u w = {pk2(v0, v1), pk2(v2, v3)};
            *(GAS v2u*)(orow + d0) = w;
        }
    __syncthreads();
#undef ATT_STAGE_WRITE
}
__device__ __forceinline__ void attn_phase(Frame& F, const int layer) {
    for (int i = 0; i < 2; ++i) {
        const int u = F.vcu * 2 + i; if (u >= BATCH * 4 * 64) break;
        attn_unit(F, layer, u >> 8, (u >> 6) & 3, u & 63);
    }
}
}

namespace pc {
constexpr int MPITCH = 72;
__device__ __forceinline__ void poolconv_phase(Frame& F, const int layer) {
    const int lane = F.lane, r32 = lane & 31, hi = lane >> 5, wid = F.wave;
    const bf16* P = (const bf16*)(F.ws + WS_PROJ);
    bf16* O4 = (bf16*)(F.ws + WS_O4);
    LAS unsigned char* mimg = F.lds + RING_OFF + wid * (64 * MPITCH * 2);
    bf16x8 wf[2][4];
    if (wid < 4) {
        const float* W = F.in[I_POOLW] + ((size_t)layer * 4 + wid) * 64 * 64;
#pragma unroll
        for (int nb = 0; nb < 2; ++nb)
#pragma unroll
            for (int ks = 0; ks < 4; ++ks) { v4u t;
#pragma unroll
                for (int jj = 0; jj < 4; ++jj) t[jj] = pk2(W[(16 * ks + 8 * hi + 2 * jj) * 64 + r32 + 32 * nb], W[(16 * ks + 8 * hi + 2 * jj + 1) * 64 + r32 + 32 * nb]);
                wf[nb][ks] = __builtin_bit_cast(bf16x8, t); }
    }
    for (int tile = F.vcu; tile < NTOK / 64; tile += F.G) {
        const int t0 = tile * 64, s0 = t0 % SEQ;
        if (wid < 4) {
            const int g = wid, hw = 1 << g;
            const bf16* src = P + (size_t)t0 * NPROJ + C_PIN + 64 * g + lane;
            float cs[81]; cs[0] = 0.f;
#pragma unroll
            for (int i = 0; i < 80; ++i) { const int s = s0 - 8 + i; float v = 0.f; if (s >= 0 && s < SEQ) v = bf2f(src[(long)(i - 8) * NPROJ]); cs[i + 1] = cs[i] + v; }
#pragma unroll
            for (int i = 0; i < 64; ++i) {
                const int s = s0 + i; int lo = s - hw, hiw = s + hw; lo = lo < 0 ? 0 : lo; hiw = hiw > SEQ ? SEQ : hiw;
                float wsum = 0.f;
                if (g == 0) wsum = cs[i + 8 + 1] - cs[i + 8 - 1]; else if (g == 1) wsum = cs[i + 8 + 2] - cs[i + 8 - 2]; else if (g == 2) wsum = cs[i + 8 + 4] - cs[i + 8 - 4]; else wsum = cs[i + 8 + 8] - cs[i + 8 - 8];
                const float pv = cs[i + 9] - cs[i + 8];
                const float mval = wsum / (float)(hiw - lo) - pv;
                *(LAS unsigned short*)(mimg + i * (MPITCH * 2) + lane * 2) = (unsigned short)f2bf(mval);
            }
            LDS_WAIT();
#pragma unroll
            for (int tb = 0; tb < 2; ++tb) {
                bf16x8 af[4];
#pragma unroll
                for (int ks = 0; ks < 4; ++ks) af[ks] = *(const LAS bf16x8*)(mimg + (r32 + 32 * tb) * (MPITCH * 2) + (16 * ks + 8 * hi) * 2);
#pragma unroll
                for (int nb = 0; nb < 2; ++nb) {
                    f32x16 acc;
#pragma unroll
                    for (int r = 0; r < 16; ++r) acc[r] = 0.f;
#pragma unroll
                    for (int ks = 0; ks < 4; ++ks) acc = __builtin_amdgcn_mfma_f32_32x32x16_bf16(af[ks], wf[nb][ks], acc, 0, 0, 0);
                    const int e = r32 + 32 * nb; const float sc = F.in[I_POOLSCALE][layer * 256 + 64 * g + e];
#pragma unroll
                    for (int r = 0; r < 16; ++r) { const int row = 32 * tb + (r & 3) + 8 * (r >> 2) + 4 * hi;
                        O4[(size_t)(t0 + row) * 1024 + 256 + 64 * g + e] = (bf16)f2bf(acc[r] * sc); }
                }
            }
            LDS_WAIT();
        } else {
            const int ch = 64 * (wid - 4) + lane;
            const float w0 = F.in[I_SCONVW][layer * 768 + ch], w1 = F.in[I_SCONVW][layer * 768 + 256 + ch], w2 = F.in[I_SCONVW][layer * 768 + 512 + ch];
            const bf16* base = P + (size_t)t0 * NPROJ + ch;
            float zm = 0.f, z0 = 0.f, zp = 0.f;
            if (s0 > 0) zm = bf2f(base[-(long)NPROJ + C_CC]) * bf2f(base[-(long)NPROJ + C_CX]);
            z0 = bf2f(base[C_CC]) * bf2f(base[C_CX]);
#pragma unroll 8
            for (int i = 0; i < 64; ++i) {
                zp = 0.f; if (s0 + i + 1 < SEQ) zp = bf2f(base[(long)(i + 1) * NPROJ + C_CC]) * bf2f(base[(long)(i + 1) * NPROJ + C_CX]);
                const float cbv = bf2f(base[(long)i * NPROJ + C_CB]);
                O4[(size_t)(t0 + i) * 1024 + 512 + ch] = (bf16)f2bf(cbv * (w0 * zm + w1 * z0 + w2 * zp));
                zm = z0; z0 = zp;
            }
        }
    }
    __syncthreads();
}
}

namespace dl {
constexpr int MP = 72, MB = 64 * MP * 2;
constexpr int WAVE_LDS = 2 * MB + 2 * MB;
__device__ __forceinline__ int crow(int r, int hi) { return (r & 3) + 8 * (r >> 2) + 4 * hi; }
__device__ __forceinline__ bf16x8 ldfrag(const LAS unsigned char* img, int row, int col) { return *(const LAS bf16x8*)(img + row * (MP * 2) + col * 2); }
__device__ __forceinline__ bf16x8 ldfragp(const LAS unsigned char* img, int row, int col4) {
    const v2u lo = *(const LAS v2u*)(img + row * (MP * 2) + col4 * 2), hi8 = *(const LAS v2u*)(img + row * (MP * 2) + col4 * 2 + 16); const v4u t = {lo.x, lo.y, hi8.x, hi8.y}; return __builtin_bit_cast(bf16x8, t); }
__device__ __forceinline__ bf16x8 cfrag(const f32x16& x, int half) {
    v4u t;
#pragma unroll
    for (int e = 0; e < 4; ++e) t[e] = att::cvtpk(x[8 * half + 2 * e], x[8 * half + 2 * e + 1]);
    return __builtin_bit_cast(bf16x8, t); }
#define MFMA32(a, b, c) __builtin_amdgcn_mfma_f32_32x32x16_bf16((a), (b), (c), 0, 0, 0)
#define SB() __builtin_amdgcn_sched_barrier(0)
#define LAUNDER() do { asm volatile("" : "+v"(lane)); r32 = lane & 31; hi = lane >> 5; } while (0)
__device__ __forceinline__ f32x16 zero16() { f32x16 z;
#pragma unroll
    for (int r = 0; r < 16; ++r) z[r] = 0.f;
    return z; }

#define DL_CONV(colbase, wbase, EMIT) do { \
    const bf16* src_ = P + (size_t)tok0 * NPROJ + (colbase) + lane; \
    const float cw0 = cwp[(wbase) + lane], cw1 = cwp[768 + (wbase) + lane], cw2 = cwp[2 * 768 + (wbase) + lane], cw3 = cwp[3 * 768 + (wbase) + lane], cw4 = cwp[4 * 768 + (wbase) + lane]; \
    float x0 = 0.f, x1 = 0.f, x2 = 0.f, x3 = 0.f, x4 = 0.f; \
    if (s0 >= 2) x1 = bf2f(src_[-2 * (long)NPROJ]); if (s0 >= 1) x2 = bf2f(src_[-1 * (long)NPROJ]); x3 = bf2f(src_[0]); x4 = bf2f(src_[(long)NPROJ]); \
    _Pragma("unroll 4") for (int i = 0; i < 64; ++i) { x0 = x1; x1 = x2; x2 = x3; x3 = x4; x4 = 0.f; if (s0 + i + 2 < SEQ) x4 = bf2f(src_[(long)(i + 2) * NPROJ]); \
        const float cv_ = cw0 * x0 + cw1 * x1 + cw2 * x2 + cw3 * x3 + cw4 * x4; const float val = cv_ * sigmoidf_(cv_); EMIT; } } while (0)

__device__ __forceinline__ void d1_instance(Frame& F, const int layer, const int b, const int h, const int norig, const int dir, LAS unsigned char* W, LAS float* tab) {
    int lane = F.lane, r32, hi; LAUNDER();
    const bf16* P = (const bf16*)(F.ws + WS_PROJ);
    const float* cwp = F.in[I_DCONVW] + (size_t)layer * 5 * 768;
    const int s0 = norig * 64, tok0 = b * SEQ + s0;
    const int npr = dir ? 255 - norig : norig;
    const int inst = ((b * 4 + h) * 2 + dir) * NCHUNK + npr;
    LAS unsigned char* VT = W;
    LAS unsigned char* KT = W + MB;
    LAS unsigned char* KR = W + 2 * MB;
    LAS unsigned char* T2 = W + 3 * MB;
    LAS float* SM = (LAS float*)(W + 2 * MB);
    DL_CONV(C_DK + 64 * h, 256 + 64 * h, { const float ss = wave_sum(val * val); const float kn = val * (1.f / sqrtf(ss + EPS)); const int ip = dir ? 63 - i : i; const unsigned short kb = (unsigned short)f2bf(kn);
        *(LAS unsigned short*)(KR + ip * (MP * 2) + lane * 2) = kb; *(LAS unsigned short*)(KT + lane * (MP * 2) + ip * 2) = kb; });
    DL_CONV(C_DV + 64 * h, 512 + 64 * h, { const int ip = dir ? 63 - i : i; *(LAS unsigned short*)(VT + lane * (MP * 2) + ip * 2) = (unsigned short)f2bf(val); });
    const int mytok = tok0 + (dir ? 63 - lane : lane);
    const float* BD = (const float*)(F.ws + WS_BD) + (size_t)mytok * 16;
    const float beta = BD[dir * 4 + h]; float gc = BD[8 + dir * 4 + h];
#pragma unroll
    for (int o = 1; o < 64; o <<= 1) { const float t = __shfl_up(gc, o); if (lane >= o) gc += t; }
    const float gl = __shfl(gc, 63);
    tab[lane] = gc; tab[64 + lane] = beta; tab[128 + lane] = __expf(gl - gc);
    LDS_WAIT();
    LAUNDER();
    f32x16 kk[2][2];
#pragma unroll
    for (int tb = 0; tb < 2; ++tb)
#pragma unroll
        for (int tn = 0; tn < 2; ++tn) { f32x16 acc = zero16();
#pragma unroll
            for (int ks = 0; ks < 4; ++ks) acc = MFMA32(ldfrag(KR, r32 + 32 * tb, 16 * ks + 8 * hi), ldfrag(KR, r32 + 32 * tn, 16 * ks + 8 * hi), acc);
            kk[tb][tn] = acc; SB(); }
    LDS_WAIT();
#pragma unroll
    for (int tb = 0; tb < 2; ++tb)
#pragma unroll
        for (int tn = 0; tn < 2; ++tn) {
            const int jc = r32 + 32 * tn; const float gcj = tab[jc];
#pragma unroll
            for (int r = 0; r < 16; ++r) { const int ir = 32 * tb + crow(r, hi); const float gci = tab[ir], bi = tab[64 + ir];
                const float mv = (ir > jc) ? bi * kk[tb][tn][r] * __expf(gci - gcj) : 0.f; SM[ir * 64 + jc] = mv; } SB(); }
    LDS_WAIT();
    LAUNDER();
    float T[64];
#pragma unroll
    for (int i = 0; i < 64; ++i) {
        float a = (lane == i) ? 1.f : 0.f;
#pragma unroll
        for (int j4 = 0; j4 < (i + 3) / 4; ++j4) { const f32x4 m4 = *(const LAS f32x4*)(SM + i * 64 + 4 * j4);
#pragma unroll
            for (int e = 0; e < 4; ++e) if (4 * j4 + e < i) a = __builtin_fmaf(-m4[e], T[4 * j4 + e], a); }
        T[i] = a; if ((i & 3) == 3) SB(); }
    LDS_WAIT();
    LAUNDER();
    { const float b1 = beta, b2 = beta * __expf(gc);
#pragma unroll
      for (int i = 0; i < 64; ++i) { *(LAS unsigned short*)(KR + i * (MP * 2) + lane * 2) = (unsigned short)f2bf(T[i] * b1); *(LAS unsigned short*)(T2 + i * (MP * 2) + lane * 2) = (unsigned short)f2bf(T[i] * b2); if ((i & 7) == 7) SB(); } }
    LDS_WAIT();
    LAUNDER();
    f32x16 u[2][2], w[2][2];
#pragma unroll
    for (int tb = 0; tb < 2; ++tb)
#pragma unroll
        for (int tn = 0; tn < 2; ++tn) { f32x16 au = zero16(), aw = zero16();
#pragma unroll
            for (int ks = 0; ks < 4; ++ks) { au = MFMA32(ldfrag(KR, r32 + 32 * tb, 16 * ks + 8 * hi), ldfrag(VT, r32 + 32 * tn, 16 * ks + 8 * hi), au);
                                             aw = MFMA32(ldfrag(T2, r32 + 32 * tb, 16 * ks + 8 * hi), ldfrag(KT, r32 + 32 * tn, 16 * ks + 8 * hi), aw); }
            u[tb][tn] = au; w[tb][tn] = aw; SB(); }
    LAUNDER();
    { unsigned* ud = (unsigned*)(F.ws + WS_UW + (size_t)inst * 16384); bf16* wd = (bf16*)(F.ws + WS_UW + (size_t)inst * 16384 + 8192);
#pragma unroll
      for (int tb = 0; tb < 2; ++tb)
#pragma unroll
          for (int tn = 0; tn < 2; ++tn) {
#pragma unroll
              for (int rp = 0; rp < 8; ++rp) ud[((tb * 2 + tn) * 8 + rp) * 64 + lane] = pk2(u[tb][tn][2 * rp], u[tb][tn][2 * rp + 1]);
#pragma unroll
              for (int r = 0; r < 16; ++r) wd[(32 * tb + crow(r, hi)) * 64 + r32 + 32 * tn] = (bf16)f2bf(w[tb][tn][r]); SB(); } }
    LAUNDER();
#pragma unroll
    for (int tb = 0; tb < 2; ++tb)
#pragma unroll
        for (int r = 0; r < 16; ++r) { const float e = tab[128 + 32 * tb + crow(r, hi)];
#pragma unroll
            for (int tn = 0; tn < 2; ++tn) { u[tb][tn][r] *= e; w[tb][tn][r] *= e; } }
    SB();
    bf16x8 kf[2][4];
#pragma unroll
    for (int tbb = 0; tbb < 2; ++tbb)
#pragma unroll
        for (int s = 0; s < 4; ++s) kf[tbb][s] = ldfragp(KT, r32 + 32 * tbb, 16 * s + 4 * hi);
    LDS_WAIT(); SB();
    LAUNDER();
    LAS unsigned char* AR = VT; LAS unsigned char* BT = KR;
#pragma unroll
    for (int tbb = 0; tbb < 2; ++tbb)
#pragma unroll
        for (int tx = 0; tx < 2; ++tx) { f32x16 aa = zero16(), ab = zero16();
#pragma unroll
            for (int s = 0; s < 4; ++s) { aa = MFMA32(cfrag(w[s >> 1][tx], s & 1), kf[tbb][s], aa); ab = MFMA32(kf[tbb][s], cfrag(u[s >> 1][tx], s & 1), ab); }
#pragma unroll
            for (int g4 = 0; g4 < 4; ++g4) {
                const v2u pa = {pk2(-aa[4 * g4], -aa[4 * g4 + 1]), pk2(-aa[4 * g4 + 2], -aa[4 * g4 + 3])};
                *(LAS v2u*)(AR + (r32 + 32 * tbb) * (MP * 2) + (32 * tx + 8 * g4 + 4 * hi) * 2) = pa;
                const v2u pb = {pk2(ab[4 * g4], ab[4 * g4 + 1]), pk2(ab[4 * g4 + 2], ab[4 * g4 + 3])};
                *(LAS v2u*)(BT + (r32 + 32 * tx) * (MP * 2) + (32 * tbb + 8 * g4 + 4 * hi) * 2) = pb;
            } SB(); }
    LDS_WAIT();
    LAUNDER();
    { unsigned char* ab = F.ws + WS_AB + (size_t)inst * 16384; const int m16 = lane & 15, g = lane >> 4;
#pragma unroll
      for (int rb = 0; rb < 4; ++rb)
#pragma unroll
          for (int ks = 0; ks < 2; ++ks) { const v2u lo = *(const LAS v2u*)(AR + (16 * rb + m16) * (MP * 2) + (32 * ks + 4 * g) * 2), hi8 = *(const LAS v2u*)(AR + (16 * rb + m16) * (MP * 2) + (32 * ks + 16 + 4 * g) * 2);
              const v4u t = {lo.x, lo.y, hi8.x, hi8.y}; *(GAS v4u*)(ab + ((rb * 2 + ks) * 64 + lane) * 16) = t; }
#pragma unroll
      for (int sl = 0; sl < 4; ++sl)
#pragma unroll
          for (int rb = 0; rb < 4; ++rb) { const v2u t = *(const LAS v2u*)(BT + (16 * sl + m16) * (MP * 2) + (16 * rb + 4 * g) * 2); *(GAS v2u*)(ab + 8192 + ((sl * 4 + rb) * 64 + lane) * 8) = t; } }
    if (lane == 0) ((float*)(F.ws + WS_DEC))[inst] = __expf(gl);
    LDS_WAIT();
}
__device__ __forceinline__ void d1_phase(Frame& F, const int layer) {
    if (F.wave < 4) {
        LAS unsigned char* W = F.lds + RING_OFF + F.wave * WAVE_LDS; LAS float* tab = (LAS float*)(F.lds + RING_OFF + 4 * WAVE_LDS + F.wave * 1024);
        const int gw = F.vcu * 4 + F.wave, NGW = F.G * 4;
        for (int it = gw; it < NINST; it += NGW) { const int dir = it & 1, u = it >> 1; d1_instance(F, layer, u >> 10, (u >> 8) & 3, u & 255, dir, W, tab); }
    }
    __syncthreads();
}

typedef float f32x4v __attribute__((ext_vector_type(4)));
__device__ __forceinline__ void d2_phase(Frame& F) {
    if (F.wave == 0 && F.vcu < 64) {
        const int lane = F.lane, n16 = lane & 15, g = lane >> 4, chain = F.vcu >> 2, sl = F.vcu & 3;
        f32x4v S[4];
#pragma unroll
        for (int rb = 0; rb < 4; ++rb) S[rb] = (f32x4v){0.f, 0.f, 0.f, 0.f};
        const unsigned char* abase = F.ws + WS_AB + (size_t)chain * NCHUNK * 16384;
        unsigned char* sbase = F.ws + WS_ST + (size_t)chain * NCHUNK * 8192;
        const float* dec = (const float*)(F.ws + WS_DEC) + chain * NCHUNK;
        v4u af[4][2]; v2u bm[4]; float dcy;
#define D2_LOAD(n) do { const unsigned char* ab_ = abase + (size_t)(n) * 16384; \
        _Pragma("unroll") for (int rb = 0; rb < 4; ++rb) { _Pragma("unroll") for (int ks = 0; ks < 2; ++ks) af[rb][ks] = *(const GAS v4u*)(ab_ + ((rb * 2 + ks) * 64 + lane) * 16); \
            bm[rb] = *(const GAS v2u*)(ab_ + 8192 + ((sl * 4 + rb) * 64 + lane) * 8); } dcy = dec[n]; } while (0)
        D2_LOAD(0);
        for (int n = 0; n < NCHUNK; ++n) {
            unsigned char* st = sbase + (size_t)n * 8192 + (16 * sl + n16) * 128;
#pragma unroll
            for (int rb = 0; rb < 4; ++rb) { const v2u t = {pk2(S[rb][0], S[rb][1]), pk2(S[rb][2], S[rb][3])}; *(GAS v2u*)(st + (16 * rb + 4 * g) * 2) = t; }
            bf16x8 bfr[2];
#pragma unroll
            for (int ks = 0; ks < 2; ++ks) { const v4u t = {att::cvtpk(S[2 * ks][0], S[2 * ks][1]), att::cvtpk(S[2 * ks][2], S[2 * ks][3]), att::cvtpk(S[2 * ks + 1][0], S[2 * ks + 1][1]), att::cvtpk(S[2 * ks + 1][2], S[2 * ks + 1][3])}; bfr[ks] = __builtin_bit_cast(bf16x8, t); }
            v4u caf[4][2]; v2u cbm[4]; const float cd = dcy;
#pragma unroll
            for (int rb = 0; rb < 4; ++rb) { caf[rb][0] = af[rb][0]; caf[rb][1] = af[rb][1]; cbm[rb] = bm[rb]; }
            if (n + 1 < NCHUNK) D2_LOAD(n + 1);
#pragma unroll
            for (int rb = 0; rb < 4; ++rb) {
                f32x4v c = {S[rb][0] * cd + bflo(cbm[rb].x), S[rb][1] * cd + bfhi(cbm[rb].x), S[rb][2] * cd + bflo(cbm[rb].y), S[rb][3] * cd + bfhi(cbm[rb].y)};
                c = __builtin_amdgcn_mfma_f32_16x16x32_bf16(__builtin_bit_cast(bf16x8, caf[rb][0]), bfr[0], c, 0, 0, 0);
                c = __builtin_amdgcn_mfma_f32_16x16x32_bf16(__builtin_bit_cast(bf16x8, caf[rb][1]), bfr[1], c, 0, 0, 0);
                S[rb] = c; }
        }
#undef D2_LOAD
    }
    __syncthreads();
}

__device__ __forceinline__ void d3_unit(Frame& F, const int layer, const int b, const int h, const int norig, LAS unsigned char* W, LAS float* tab) {
    int lane = F.lane, r32, hi; LAUNDER();
    const bf16* P = (const bf16*)(F.ws + WS_PROJ);
    const float* cwp = F.in[I_DCONVW] + (size_t)layer * 5 * 768;
    const int s0 = norig * 64, tok0 = b * SEQ + s0;
    LAS unsigned char* QR = W;
    LAS unsigned char* KR = W + MB;
    LAS unsigned char* ST = W + 2 * MB;
    LAS unsigned char* WR = W + 3 * MB;
    f32x16 of[2][2];
#pragma unroll
    for (int dir = 0; dir < 2; ++dir) {
        const int npr = dir ? 255 - norig : norig;
        const int inst = ((b * 4 + h) * 2 + dir) * NCHUNK + npr;
        DL_CONV(C_DQ + 64 * h, 64 * h, { const float ss = wave_sum(val * val); const float qn = val * (0.125f / sqrtf(ss + EPS)); const int ip = dir ? 63 - i : i; *(LAS unsigned short*)(QR + ip * (MP * 2) + lane * 2) = (unsigned short)f2bf(qn); });
        DL_CONV(C_DK + 64 * h, 256 + 64 * h, { const float ss = wave_sum(val * val); const float kn = val * (1.f / sqrtf(ss + EPS)); const int ip = dir ? 63 - i : i; *(LAS unsigned short*)(KR + ip * (MP * 2) + lane * 2) = (unsigned short)f2bf(kn); });
        const int mytok = tok0 + (dir ? 63 - lane : lane);
        float gc = ((const float*)(F.ws + WS_BD))[(size_t)mytok * 16 + 8 + dir * 4 + h];
#pragma unroll
        for (int o = 1; o < 64; o <<= 1) { const float t = __shfl_up(gc, o); if (lane >= o) gc += t; }
        tab[lane] = gc; tab[64 + lane] = __expf(gc);
        LAUNDER();
        { const unsigned char* sg = F.ws + WS_ST + (size_t)inst * 8192; const unsigned char* wg = F.ws + WS_UW + (size_t)inst * 16384 + 8192;
#pragma unroll
          for (int i = 0; i < 8; ++i) { const int idx = i * 64 + lane, row = idx >> 3, ch = idx & 7; const v4u a = *(const GAS v4u*)(sg + idx * 16), c = *(const GAS v4u*)(wg + idx * 16);
              *(LAS v4u*)(ST + row * (MP * 2) + ch * 16) = a; *(LAS v4u*)(WR + row * (MP * 2) + ch * 16) = c; } }
        LDS_WAIT();
        LAUNDER();
        f32x16 qk[2][2];
#pragma unroll
        for (int tb = 0; tb < 2; ++tb)
#pragma unroll
            for (int tn = 0; tn < 2; ++tn) { f32x16 acc = zero16();
#pragma unroll
                for (int ks = 0; ks < 4; ++ks) acc = MFMA32(ldfrag(QR, r32 + 32 * tb, 16 * ks + 8 * hi), ldfrag(KR, r32 + 32 * tn, 16 * ks + 8 * hi), acc);
                qk[tb][tn] = acc; SB(); }
        LDS_WAIT();
#pragma unroll
        for (int tb = 0; tb < 2; ++tb)
#pragma unroll
            for (int tn = 0; tn < 2; ++tn) { const int jc = r32 + 32 * tn; const float gcj = tab[jc];
#pragma unroll
                for (int r = 0; r < 16; ++r) { const int ir = 32 * tb + crow(r, hi); const float gci = tab[ir];
                    const float av = (ir >= jc) ? qk[tb][tn][r] * __expf(gci - gcj) : 0.f; *(LAS unsigned short*)(KR + ir * (MP * 2) + jc * 2) = (unsigned short)f2bf(av); } SB(); }
        LDS_WAIT();
        LAUNDER();
        const unsigned* ud = (const unsigned*)(F.ws + WS_UW + (size_t)inst * 16384);
#pragma unroll
        for (int tn = 0; tn < 2; ++tn) {
            bf16x8 sf[4];
#pragma unroll
            for (int ks = 0; ks < 4; ++ks) sf[ks] = ldfrag(ST, r32 + 32 * tn, 16 * ks + 8 * hi);
            f32x16 vn[2], o[2];
#pragma unroll
            for (int tb = 0; tb < 2; ++tb) { f32x16 a1 = zero16(), a2 = zero16();
#pragma unroll
                for (int ks = 0; ks < 4; ++ks) { a1 = MFMA32(ldfrag(WR, r32 + 32 * tb, 16 * ks + 8 * hi), sf[ks], a1); a2 = MFMA32(ldfrag(QR, r32 + 32 * tb, 16 * ks + 8 * hi), sf[ks], a2); }
#pragma unroll
                for (int rp = 0; rp < 8; ++rp) { const unsigned uw = ud[((tb * 2 + tn) * 8 + rp) * 64 + lane]; a1[2 * rp] = bflo(uw) - a1[2 * rp]; a1[2 * rp + 1] = bfhi(uw) - a1[2 * rp + 1]; }
#pragma unroll
                for (int r = 0; r < 16; ++r) a2[r] *= tab[64 + 32 * tb + crow(r, hi)];
                vn[tb] = a1; o[tb] = a2; SB(); }
#pragma unroll
            for (int tb = 0; tb < 2; ++tb) { f32x16 acc = o[tb];
#pragma unroll
                for (int s = 0; s < 4; ++s) acc = MFMA32(ldfragp(KR, r32 + 32 * tb, 16 * s + 4 * hi), cfrag(vn[s >> 1], s & 1), acc);
                o[tb] = acc; SB(); }
            if (dir == 0) { of[0][tn] = o[0]; of[1][tn] = o[1]; }
            else {
#pragma unroll
                for (int tb = 0; tb < 2; ++tb)
#pragma unroll
                    for (int r = 0; r < 16; ++r) of[tb][tn][r] += __shfl_xor(o[1 - tb][15 - r], 32);
            }
        }
        LDS_WAIT();
    }
    LAUNDER();
    const float* dn = F.in[I_DNORM] + layer * 64;
#pragma unroll
    for (int tb = 0; tb < 2; ++tb)
#pragma unroll
        for (int r = 0; r < 16; ++r) {
            float ss = of[tb][0][r] * of[tb][0][r] + of[tb][1][r] * of[tb][1][r];
#pragma unroll
            for (int o = 1; o < 32; o <<= 1) ss += __shfl_xor(ss, o);
            const float rs = 1.f / sqrtf(ss * (1.f / 64.f) + EPS);
            const int tok = tok0 + 32 * tb + crow(r, hi);
#pragma unroll
            for (int tn = 0; tn < 2; ++tn) { const int dv = r32 + 32 * tn; const float z = bf2f(P[(size_t)tok * NPROJ + C_DZ + 64 * h + dv]);
                ((bf16*)(F.ws + WS_O4))[(size_t)tok * 1024 + 768 + 64 * h + dv] = (bf16)f2bf(of[tb][tn][r] * rs * dn[dv] * siluf_(z)); }
        }
}
__device__ __forceinline__ void d3_phase(Frame& F, const int layer) {
    if (F.wave < 4) {
        LAS unsigned char* W = F.lds + RING_OFF + F.wave * WAVE_LDS; LAS float* tab = (LAS float*)(F.lds + RING_OFF + 4 * WAVE_LDS + F.wave * 1024);
        const int gw = F.vcu * 4 + F.wave, NGW = F.G * 4;
        for (int u = gw; u < BATCH * 4 * NCHUNK; u += NGW) d3_unit(F, layer, u >> 10, (u >> 8) & 3, u & 255, W, tab);
    }
    __syncthreads();
}
#undef MFMA32
}

#ifndef ONLY_SITE
#define ONLY_SITE -1
#endif
#define SITE(k) (ONLY_SITE < 0 || ONLY_SITE == (k))
#ifndef MK_SPLIT
#define MK_SPLIT 0
#endif
struct Args { const float* in[30]; float* out; unsigned char* ws; int ph_lo, ph_hi; };
constexpr int N_PHASES = 1 + 16 * NLAYER + 1;

#define IN_PH() (pid >= lo && pid < hi)
#define FRESH() do { unsigned char* w_ = args.ws; float* o_ = args.out; int t_ = threadIdx.x; asm volatile("" : "+s"(w_), "+s"(o_), "+v"(t_)); F.ws = w_; F.out = o_; F.ctl = (gu32*)(w_ + WS_CTL); F.tid = t_; F.lane = t_ & 63; } while (0)
#define SEAM() do { if (!MK_SPLIT && pid >= lo && pid + 1 < hi) xcd_barrier(bar); ++pid; } while (0)
#define NOSEAM() do { ++pid; } while (0)

template <int l> __device__ __forceinline__ void layer_phases(Frame& F, const Args& args, const XcdBarrier& bar, const int lo, const int hi, int& pid) {
    LAS unsigned char* ring = F.lds + RING_OFF;

        if (IN_PH() && l == 0 && SITE(1)) { FRESH(); p_rows<ROW_A>(F, 0); }
        SEAM();
        if (IN_PH() && SITE(2)) { FRESH();
            pg8::SchedStd S; S.init(NTOK / 256, NPROJ / 256, F.G, (int)blockIdx.x, F.ws + WS_H, (size_t)256 * D * 2, w_in_t(F.ws, l), (size_t)256 * D * 2);
            pg8::EpiStore E{(bf16*)(F.ws + WS_PROJ), NPROJ, 0, QSCALE};
            pg8::gemm_phase<pg8::EpiStore, pg8::SchedStd, D, D, D>(ring, F.tid, S, E);
        }
        SEAM();
        if (IN_PH() && SITE(3)) { FRESH(); att::attn_phase(F, l); }
        NOSEAM();
        if (IN_PH() && SITE(4)) { FRESH(); pc::poolconv_phase(F, l); }
        NOSEAM();
        if (IN_PH() && SITE(5)) { FRESH(); dl::d1_phase(F, l); }
        SEAM();
        if (IN_PH() && SITE(6)) { FRESH(); dl::d2_phase(F); }
        SEAM();
        if (IN_PH() && SITE(7)) { FRESH(); dl::d3_phase(F, l); }
        SEAM();
        if (IN_PH() && SITE(8)) { FRESH();
            pg8::SchedBranch S; S.s.init(NTOK / 256, 16, F.G, (int)blockIdx.x, nullptr, 0, nullptr, 0); S.O4 = (const char*)(F.ws + WS_O4); S.Wb = (const char*)w_b_t(F.ws, l);
            pg8::EpiStore E{(bf16*)(F.ws + WS_PBUF), 1024, (size_t)NTOK * 1024, 1.f};
            pg8::gemm_phase<pg8::EpiStore, pg8::SchedBranch, 256, 1024, 256>(ring, F.tid, S, E);
        }
        SEAM();
        if (IN_PH() && SITE(9)) { FRESH();
            pg8::SchedGate S{F.vcu, F.G, (const char*)(F.ws + WS_H), (const char*)w_m_t(F.ws, l)};
            pg8::EpiGate E{(const bf16*)(F.ws + WS_PBUF), (bf16*)(F.ws + WS_MERGED), F.in[I_BMERGE] + (size_t)l * 4 * D};
            pg8::gemm_phase<pg8::EpiGate, pg8::SchedGate, D, D, D>(ring, F.tid, S, E);
        }
        SEAM();
        if (IN_PH() && SITE(10)) { FRESH();
            pg8::SchedStd S; S.init(NTOK / 256, D / 256, F.G, (int)blockIdx.x, F.ws + WS_MERGED, (size_t)256 * D * 2, w_o_t(F.ws, l), (size_t)256 * D * 2);
            pg8::EpiStore E{(bf16*)(F.ws + WS_F), D, 0, 1.f};
            pg8::gemm_phase<pg8::EpiStore, pg8::SchedStd, D, D, D>(ring, F.tid, S, E);
        }
        SEAM();
        if (IN_PH() && SITE(11)) { FRESH(); p_rows<ROW_B>(F, l); }
        SEAM();
        if constexpr (l == 0) {
            if (IN_PH() && SITE(12)) { FRESH();
                pg8::SchedStd S; S.init(NTOK / 256, 2 * DFF / 256, F.G, (int)blockIdx.x, F.ws + WS_H, (size_t)256 * D * 2, F.ws + WS_WFFN, (size_t)256 * D * 2);
                pg8::EpiSwiGLU E{(bf16*)(F.ws + WS_ACT0), DFF};
                pg8::gemm_phase<pg8::EpiSwiGLU, pg8::SchedStd, D, D, D>(ring, F.tid, S, E);
            }
            SEAM();
            if (IN_PH() && SITE(13)) { FRESH();
                pg8::SchedStd S; S.init(NTOK / 256, D / 256, F.G, (int)blockIdx.x, F.ws + WS_ACT0, (size_t)256 * DFF * 2, F.ws + WS_WFFN + SZ_WGU, (size_t)256 * DFF * 2);
                pg8::EpiStore E{(bf16*)(F.ws + WS_F), D, 0, 1.f};
                pg8::gemm_phase<pg8::EpiStore, pg8::SchedStd, DFF, DFF, DFF>(ring, F.tid, S, E);
            }
            SEAM();
            if (IN_PH() && SITE(14)) { FRESH(); p_rows<ROW_C>(F, 0); }
            SEAM();
            NOSEAM(); NOSEAM();
        } else {
            if (IN_PH() && SITE(15)) { FRESH(); p_moe_cvt(F); }
            SEAM();
#pragma unroll 1
            for (int pass = 0; pass < 2; ++pass) {
                if (IN_PH() && SITE(16)) { FRESH();
                    pg8::SchedMoe S; S.c = (int)blockIdx.x; S.G = F.G; S.nN = 2 * DFF / 256; moe_tiles(F, S.cnt, S.tstart);
                    S.t0 = pass * MOE_PASS_TILES; S.t1 = S.tstart[8] < (pass + 1) * MOE_PASS_TILES ? S.tstart[8] : (pass + 1) * MOE_PASS_TILES;
                    S.A = (const char*)(F.ws + WS_H2B); S.lists = (const int*)(F.ws + WS_ROUTE + 1 * MiB); S.W = (const char*)(F.ws + WS_MOEW); S.w_tile = (size_t)256 * D * 2; S.gather = true;
                    pg8::EpiSwiGLU E{(bf16*)(F.ws + WS_ACT1), DFF};
                    pg8::gemm_phase<pg8::EpiSwiGLU, pg8::SchedMoe, D, D, D, true>(ring, F.tid, S, E);
                }
                SEAM();
                if (IN_PH() && SITE(17)) { FRESH();
                    pg8::SchedMoe S; S.c = (int)blockIdx.x; S.G = F.G; S.nN = D / 256; moe_tiles(F, S.cnt, S.tstart);
                    S.t0 = pass * MOE_PASS_TILES; S.t1 = S.tstart[8] < (pass + 1) * MOE_PASS_TILES ? S.tstart[8] : (pass + 1) * MOE_PASS_TILES;
                    S.A = (const char*)(F.ws + WS_ACT1); S.lists = nullptr; S.W = (const char*)(F.ws + WS_MOEW + SZ_WGU); S.w_tile = (size_t)256 * DFF * 2; S.gather = false;
                    pg8::EpiStore E{(bf16*)(F.ws + WS_Y), D, 0, 1.f};
                    pg8::gemm_phase<pg8::EpiStore, pg8::SchedMoe, DFF, DFF, DFF>(ring, F.tid, S, E);
                }
                SEAM();
            }
        }
    }

__global__ void __launch_bounds__(NWAVES * 64, 2) fwd_kernel(const Args args) {
    extern __shared__ __attribute__((aligned(16))) unsigned char lds[];
    Frame F;
    F.lds = (LAS unsigned char*)lds;
    F.MISC = (volatile LAS unsigned*)(F.lds + MISC_OFF);
    F.tid = threadIdx.x; F.lane = F.tid & 63; F.wave = __builtin_amdgcn_readfirstlane(F.tid >> 6);
    F.G = gridDim.x; { const int bx = blockIdx.x; F.vcu = (F.G % 8 == 0) ? (bx % 8) * (F.G / 8) + bx / 8 : bx; }
    F.ws = args.ws; F.out = args.out; F.ctl = (gu32*)(args.ws + WS_CTL);
    F.in = args.in;
    if (F.tid < 64) ((LAS unsigned*)(F.lds + MISC_OFF))[F.tid] = 0u;
    __syncthreads();
    XcdBarrier bar; bar.bar = (unsigned*)(F.ctl + CW_BAR); bar.x = 0; bar.st = nullptr;
    if (!MK_SPLIT) bar = xcd_barrier_post((unsigned*)(F.ctl + CW_BAR), F.MISC + 8);
    const int lo = args.ph_lo, hi = args.ph_hi;
    int pid = 0;
    LAS unsigned char* ring = F.lds + RING_OFF;

    if (IN_PH() && SITE(0)) { FRESH(); p_prologue(F); }
    SEAM();
    layer_phases<0>(F, args, bar, lo, hi, pid);
    layer_phases<1>(F, args, bar, lo, hi, pid);
    if (IN_PH() && SITE(18)) { FRESH(); p_rows<ROW_C>(F, 1); }
#undef IN_PH
#undef SEAM
#undef NOSEAM
}

extern "C" void kernel_launch(void* const* d_in, const int* in_sizes, int n_in, void* d_out, int out_size, void* d_ws, size_t ws_size, hipStream_t stream) {
    static int grid = 0;
    if (grid == 0) {
        if (n_in != N_INPUTS || in_sizes[0] != NTOK * D || out_size != NTOK * D || ws_size < WS_END) {
            fprintf(stderr, "kernel_launch: unexpected problem (n_in %d, in0 %d, out %d, ws %zu < %zu); nothing launched\n", n_in, n_in > 0 ? in_sizes[0] : -1, out_size, ws_size, (size_t)WS_END); grid = -1; return; }
        int dev = 0, cus = 0, per_cu = 0;
        if (hipGetDevice(&dev) != hipSuccess || hipDeviceGetAttribute(&cus, hipDeviceAttributeMultiprocessorCount, dev) != hipSuccess) { grid = -1; return; }
        if (hipFuncSetAttribute((const void*)fwd_kernel, hipFuncAttributeMaxDynamicSharedMemorySize, LDS_BYTES) != hipSuccess) { fprintf(stderr, "kernel_launch: hipFuncSetAttribute failed\n"); grid = -1; return; }
        if (hipOccupancyMaxActiveBlocksPerMultiprocessor(&per_cu, (const void*)fwd_kernel, NWAVES * 64, LDS_BYTES) != hipSuccess || per_cu < 1)
            fprintf(stderr, "kernel_launch: note: occupancy query reports %d workgroups per CU\n", per_cu);
        (void)hipGetLastError();
        grid = cus;
    }
    if (grid < 0) return;
    if (hipMemsetAsync((char*)d_ws + WS_CTL, 0, CTL_ZERO_BYTES, stream) != hipSuccess) return;
    Args a{};
    for (int i = 0; i < 30; ++i) a.in[i] = (const float*)d_in[i];
    a.out = (float*)d_out; a.ws = (unsigned char*)d_ws;
#if MK_SPLIT
    for (int p = 0; p < N_PHASES; ++p) { a.ph_lo = p; a.ph_hi = p + 1; hipLaunchKernelGGL(fwd_kernel, dim3(grid), dim3(NWAVES * 64), LDS_BYTES, stream, a); }
#else
    a.ph_lo = 0; a.ph_hi = N_PHASES;
    hipLaunchKernelGGL(fwd_kernel, dim3(grid), dim3(NWAVES * 64), LDS_BYTES, stream, a);
#endif
}
```

```cpp
#include <hip/hip_runtime.h>
#include <cstdio>
#include <cstdint>

namespace pg8 {
#define PG8_LAS __attribute__((address_space(3)))
typedef unsigned short bf16_t;
typedef short bf16x8 __attribute__((ext_vector_type(8)));
typedef float f32x4 __attribute__((ext_vector_type(4)));
typedef unsigned u32x4 __attribute__((ext_vector_type(4)));
typedef unsigned u32x2 __attribute__((ext_vector_type(2)));
constexpr int BM = 256, BK = 64, HALF = 128, HTB = HALF * BK * 2  , STAGE_BYTES = 8 * HTB;

__host__ __device__ __forceinline__ int lds_byte(int r, int c) { const int st = (r >> 4) * 2 + (c >> 5), rr = r & 15, cc = c & 31, ob = rr * 64 + cc * 2; return st * 1024 + (ob ^ (((ob >> 9) & 1) << 5)); }
__host__ __device__ __forceinline__ void stage_rc(int b, int& R, int& C) { const int st = b / 1024, sb = b % 1024, swz = sb ^ (((sb >> 9) & 1) << 5); R = (st >> 1) * 16 + swz / 64; C = (st & 1) * 32 + (swz % 64) / 2; }
__host__ __device__ __forceinline__ int perm32(int rho) { const int n = rho >> 4, i = rho & 15; return 8 * (i >> 2) + 4 * n + (i & 3); }

struct Unit { int pm, pn, aux, pad; const char* a; const char* b; const int* rows; };

__device__ __forceinline__ unsigned cvt_pk_bf16(float lo, float hi) { unsigned r; asm volatile("v_cvt_pk_bf16_f32 %0, %1, %2" : "=v"(r) : "v"(lo), "v"(hi)); return r; }


template <class Epi, class Sched, int K, int lda, int ldb, bool GATHER = false, bool ALIGN_EPI = true, bool SP2 = true>
__device__ __forceinline__ void gemm_phase(PG8_LAS unsigned char* lds, const int tid, const Sched& S, const Epi& E) {
    const int wid = __builtin_amdgcn_readfirstlane(tid >> 6), lane = tid & 63, wr = wid >> 2, wc = wid & 3, fr = lane & 15, fq = lane >> 4;
    constexpr int nt = K / BK;
    int Rs[2], Cs[2]; unsigned voffB[2];
#pragma unroll
    for (int i = 0; i < 2; ++i) { int R, C; stage_rc(tid * 16 + i * 8192, R, C); const int Rb = Epi::PERM ? ((R & ~31) + perm32(R & 31)) : R; Rs[i] = R; Cs[i] = C; voffB[i] = (unsigned)(Rb * ldb + C) * 2u; }
    const size_t kstep = (size_t)(BK * 2);
    const size_t hstepB = (size_t)HALF * ldb * 2;
    const unsigned ldsw = (unsigned)wid * 1024u;
    const int aoff = lds_byte(wr * 64 + fr, fq * 8), boff = lds_byte(wc * 32 + fr, fq * 8);
#define PG8_SA(b, h) (((b) * 2 + (h)) * HTB)
#define PG8_SB(b, h) ((4 + (b) * 2 + (h)) * HTB)
#define PG8_STAGE(bufoff, gbase, voff) do { _Pragma("unroll") for (int _i = 0; _i < 2; ++_i) \
        __builtin_amdgcn_global_load_lds((const unsigned*)((const char*)(gbase) + (voff)[_i]), (PG8_LAS unsigned*)(lds + (bufoff) + ldsw + _i * 8192), 16, 0, 0); } while (0)
#define PG8_LDA(dst, b, h) do { _Pragma("unroll") for (int m = 0; m < 4; ++m) _Pragma("unroll") for (int k = 0; k < 2; ++k) dst[m][k] = *(const PG8_LAS bf16x8*)(lds + PG8_SA(b, h) + aoff + m * 2048 + k * 1024); } while (0)
#define PG8_LDB(dst, b, h) do { _Pragma("unroll") for (int n = 0; n < 2; ++n) _Pragma("unroll") for (int k = 0; k < 2; ++k) dst[n][k] = *(const PG8_LAS bf16x8*)(lds + PG8_SB(b, h) + boff + n * 2048 + k * 1024); } while (0)
#define PG8_MMA(ai, bj, At, Bt) do { __builtin_amdgcn_s_setprio(1); _Pragma("unroll") for (int m = 0; m < 4; ++m) _Pragma("unroll") for (int n = 0; n < 2; ++n) _Pragma("unroll") for (int k = 0; k < 2; ++k) \
        acc[ai][bj][m][n] = __builtin_amdgcn_mfma_f32_16x16x32_bf16(Bt[n][k], At[m][k], acc[ai][bj][m][n], 0, 0, 0); __builtin_amdgcn_s_setprio(0); } while (0)
#define PG8_WAIT_V(n) asm volatile("s_waitcnt vmcnt(" #n ")" ::: "memory")
#define PG8_WAIT_L(n) asm volatile("s_waitcnt lgkmcnt(" #n ")" ::: "memory")
#define PG8_BAR __builtin_amdgcn_s_barrier()
#define PG8_SCHED __builtin_amdgcn_sched_barrier(0)
    Unit cur, nxt; int ui = 0;
    if (!S.next(0, cur)) return;
    f32x4 acc[2][2][4][2];
#pragma unroll
    for (int a = 0; a < 2; ++a)
#pragma unroll
        for (int b = 0; b < 2; ++b)
#pragma unroll
            for (int m = 0; m < 4; ++m)
#pragma unroll
                for (int n = 0; n < 2; ++n) acc[a][b][m][n] = (f32x4){0.f, 0.f, 0.f, 0.f};
    bf16x8 At[4][2], B0[2][2], B1[2][2];
    unsigned cOff[2][2], nOff[2][2];
#pragma unroll
    for (int hh = 0; hh < 2; ++hh)
#pragma unroll
        for (int i = 0; i < 2; ++i) {
            if constexpr (GATHER) { const int ridx = hh * HALF + Rs[i]; int tk = cur.rows[ridx]; tk = ridx < cur.aux ? tk : 0; cOff[hh][i] = (unsigned)(tk * lda + Cs[i]) * 2u; }
            else cOff[hh][i] = (unsigned)((hh * HALF + Rs[i]) * lda + Cs[i]) * 2u;
            if constexpr (GATHER) nOff[hh][i] = cOff[hh][i]; else nOff[hh][i] = 0u;
        }
    const char* cA = cur.a; const char* cB = cur.b;
    S.a_ready(cur);
    if constexpr (SP2) {
        PG8_STAGE(PG8_SB(0, 0), cB, voffB); PG8_STAGE(PG8_SB(0, 1), cB + hstepB, voffB); PG8_STAGE(PG8_SA(0, 0), cA, cOff[0]); PG8_STAGE(PG8_SA(0, 1), cA, cOff[1]);
        if (wr == 1) PG8_BAR;
        PG8_WAIT_V(2); PG8_BAR;
        PG8_STAGE(PG8_SB(1, 0), cB + kstep, voffB); PG8_STAGE(PG8_SA(1, 0), cA + kstep, cOff[0]); PG8_STAGE(PG8_SB(1, 1), cB + hstepB + kstep, voffB);
        PG8_WAIT_V(6); PG8_BAR;
    } else {
        PG8_STAGE(PG8_SB(0, 0), cB, voffB); PG8_STAGE(PG8_SA(0, 0), cA, cOff[0]); PG8_STAGE(PG8_SB(0, 1), cB + hstepB, voffB); PG8_STAGE(PG8_SA(0, 1), cA, cOff[1]);
        if (wr == 1) PG8_BAR;
        PG8_WAIT_V(4); PG8_BAR;
        PG8_STAGE(PG8_SB(1, 0), cB + kstep, voffB); PG8_STAGE(PG8_SA(1, 0), cA + kstep, cOff[0]); PG8_STAGE(PG8_SB(1, 1), cB + hstepB + kstep, voffB);
        PG8_WAIT_V(6); PG8_BAR;
    }
    for (;;) {
        const bool has_next = S.next(ui + 1, nxt);
        const char* nA = has_next ? nxt.a : cA; const char* nB = has_next ? nxt.b : cB;
        if constexpr (GATHER) {
            if (has_next) {
#pragma unroll
                for (int hh = 0; hh < 2; ++hh)
#pragma unroll
                    for (int i = 0; i < 2; ++i) { const int ridx = hh * HALF + Rs[i]; int tk = nxt.rows[ridx]; tk = ridx < nxt.aux ? tk : 0; nOff[hh][i] = (unsigned)(tk * lda + Cs[i]) * 2u; }
            } else {
#pragma unroll
                for (int hh = 0; hh < 2; ++hh)
#pragma unroll
                    for (int i = 0; i < 2; ++i) nOff[hh][i] = cOff[hh][i];
            }
        }
#pragma unroll 1
        for (int t = 0; t < nt; t += 2) {
            const bool last = (t == nt - 2);
            const char* a1 = cA + (size_t)(t + 1) * kstep;
            const char* a2 = last ? nA : cA + (size_t)(t + 2) * kstep; const char* b2 = last ? nB : cB + (size_t)(t + 2) * kstep;
            const char* a3 = a2 + kstep; const char* b3 = b2 + kstep;
            unsigned o2[2][2];
#pragma unroll
            for (int hh = 0; hh < 2; ++hh)
#pragma unroll
                for (int i = 0; i < 2; ++i) { if constexpr (GATHER) o2[hh][i] = last ? nOff[hh][i] : cOff[hh][i]; else o2[hh][i] = cOff[hh][i]; }
            if (last && has_next) S.a_ready(nxt);
            if constexpr (SP2) {
            PG8_LDB(B0, 0, 0); PG8_LDB(B1, 0, 1); PG8_SCHED; PG8_LDA(At, 0, 0); PG8_STAGE(PG8_SA(1, 1), a1, cOff[1]);
            PG8_WAIT_V(8); PG8_WAIT_L(0); PG8_BAR; PG8_MMA(0, 0, At, B0); PG8_MMA(0, 1, At, B1); PG8_BAR; PG8_SCHED;
            PG8_LDA(At, 0, 1); PG8_STAGE(PG8_SB(0, 0), b2, voffB); PG8_STAGE(PG8_SB(0, 1), b2 + hstepB, voffB); PG8_STAGE(PG8_SA(0, 0), a2, o2[0]);
            PG8_WAIT_V(8); PG8_WAIT_L(0); PG8_BAR; PG8_MMA(1, 0, At, B0); PG8_MMA(1, 1, At, B1); PG8_BAR; PG8_SCHED;
            PG8_LDB(B0, 1, 0); PG8_LDB(B1, 1, 1); PG8_SCHED; PG8_LDA(At, 1, 0); PG8_STAGE(PG8_SA(0, 1), a2, o2[1]);
            PG8_WAIT_V(8); PG8_WAIT_L(0); PG8_BAR; PG8_MMA(0, 0, At, B0); PG8_MMA(0, 1, At, B1); PG8_BAR; PG8_SCHED;
            PG8_LDA(At, 1, 1); PG8_STAGE(PG8_SB(1, 0), b3, voffB); PG8_STAGE(PG8_SB(1, 1), b3 + hstepB, voffB); PG8_STAGE(PG8_SA(1, 0), a3, o2[0]);
            PG8_WAIT_V(8); PG8_WAIT_L(0); PG8_BAR; PG8_MMA(1, 0, At, B0); PG8_MMA(1, 1, At, B1); PG8_BAR; PG8_SCHED;
            } else {
            PG8_LDB(B0, 0, 0); PG8_SCHED; PG8_LDA(At, 0, 0); PG8_STAGE(PG8_SA(1, 1), a1, cOff[1]);
            PG8_WAIT_L(8); PG8_BAR; PG8_WAIT_L(0); PG8_MMA(0, 0, At, B0); PG8_BAR; PG8_SCHED;
            PG8_LDB(B1, 0, 1); PG8_STAGE(PG8_SB(0, 0), b2, voffB);
            PG8_BAR; PG8_WAIT_L(0); PG8_MMA(0, 1, At, B1); PG8_BAR;
            PG8_LDA(At, 0, 1); PG8_STAGE(PG8_SA(0, 0), a2, o2[0]);
            PG8_BAR; PG8_WAIT_L(0); PG8_MMA(1, 0, At, B0); PG8_BAR; PG8_SCHED;
            PG8_STAGE(PG8_SB(0, 1), b2 + hstepB, voffB);
            PG8_WAIT_V(6); PG8_BAR; PG8_MMA(1, 1, At, B1); PG8_BAR;
            PG8_LDB(B0, 1, 0); PG8_SCHED; PG8_LDA(At, 1, 0); PG8_STAGE(PG8_SA(0, 1), a2, o2[1]);
            PG8_WAIT_L(8); PG8_BAR; PG8_WAIT_L(0); PG8_MMA(0, 0, At, B0); PG8_BAR; PG8_SCHED;
            PG8_LDB(B1, 1, 1); PG8_STAGE(PG8_SB(1, 0), b3, voffB);
            PG8_BAR; PG8_WAIT_L(0); PG8_MMA(0, 1, At, B1); PG8_BAR;
            PG8_LDA(At, 1, 1); PG8_STAGE(PG8_SA(1, 0), a3, o2[0]);
            PG8_BAR; PG8_WAIT_L(0); PG8_MMA(1, 0, At, B0); PG8_BAR; PG8_SCHED;
            PG8_STAGE(PG8_SB(1, 1), b3 + hstepB, voffB);
            PG8_WAIT_V(6); PG8_BAR; PG8_MMA(1, 1, At, B1); PG8_BAR;
            }
        }
        if constexpr (ALIGN_EPI) { if (wr == 0) PG8_BAR; }
        E(acc, cur, wr, wc, fr, fq); S.done(cur);
        if (!has_next) break;
#pragma unroll
        for (int a = 0; a < 2; ++a)
#pragma unroll
            for (int b = 0; b < 2; ++b)
#pragma unroll
                for (int m = 0; m < 4; ++m)
#pragma unroll
                    for (int n = 0; n < 2; ++n) acc[a][b][m][n] = (f32x4){0.f, 0.f, 0.f, 0.f};
        cur = nxt; cA = nA; cB = nB; ++ui;
        if constexpr (GATHER) {
#pragma unroll
            for (int hh = 0; hh < 2; ++hh)
#pragma unroll
                for (int i = 0; i < 2; ++i) cOff[hh][i] = nOff[hh][i];
        }
        if constexpr (ALIGN_EPI) { if (wr == 1) PG8_BAR; }
    }
    PG8_WAIT_V(0);
    if constexpr (!ALIGN_EPI) { if (wr == 0) PG8_BAR; }
    PG8_BAR;
#undef PG8_SA
#undef PG8_SB
#undef PG8_STAGE
#undef PG8_LDA
#undef PG8_LDB
#undef PG8_MMA
#undef PG8_WAIT_V
#undef PG8_WAIT_L
#undef PG8_BAR
#undef PG8_SCHED
}
}

constexpr int NWAVES = 8;
constexpr int BATCH = 2, SEQ = 16384, D = 1024, NTOK = BATCH * SEQ;
constexpr int NLAYER = 2;
constexpr int NPROJ = 2816, IN_COLS = 2832;
constexpr int PJ = 2048;
constexpr int C_PIN = 0, C_CB = 256, C_CC = 512, C_CX = 768, C_DQ = 1024, C_DK = 1280, C_DV = 1536, C_DZ = 1792;
constexpr int DFF = 2816, NEXP = 8;
constexpr int NCHUNK = SEQ / 64;
constexpr int NINST = BATCH * 4 * 2 * NCHUNK;
constexpr float EPS = 1e-6f;
constexpr float QSCALE = 0.17677669529663687f * 1.4426950408889634f;
constexpr int MOE_PASS_TILES = 132;

constexpr size_t MiB = 1u << 20;
constexpr size_t WS_CTL = 0, CTL_ZERO_BYTES = 1 * MiB;
constexpr size_t SZ_WIN = (size_t)NPROJ * D * 2, SZ_WM = (size_t)4096 * D * 2, SZ_WB = (size_t)4 * 1024 * 256 * 2, SZ_WO = (size_t)D * D * 2;
constexpr size_t SZ_LAYERW = SZ_WIN + SZ_WM + SZ_WB + SZ_WO;
constexpr size_t SZ_WGU = (size_t)2 * DFF * D * 2, SZ_WD = (size_t)D * DFF * 2, SZ_FFNW = SZ_WGU + SZ_WD;
constexpr size_t WS_W = 1 * MiB;
constexpr size_t WS_WFFN = WS_W + 2 * SZ_LAYERW;
static_assert(WS_WFFN + SZ_FFNW <= 53 * MiB, "weights");
constexpr size_t WS_H = 53 * MiB;
constexpr size_t WS_O4 = 117 * MiB;
constexpr size_t WS_F = WS_O4;
constexpr size_t WS_BD = 181 * MiB;
constexpr size_t WS_DEC = 183 * MiB;
constexpr size_t WS_PROJ = 185 * MiB;
constexpr size_t WS_QB = 521 * MiB;
constexpr size_t WS_KV = 313 * MiB;
constexpr size_t WS_UW = 361 * MiB;
constexpr size_t WS_AB = 425 * MiB;
constexpr size_t WS_ST = 489 * MiB;
constexpr size_t WS_PBUF = 185 * MiB;
constexpr size_t WS_MERGED = 441 * MiB;
constexpr size_t WS_ACT0 = 185 * MiB;
constexpr size_t WS_H2B = 479 * MiB;
constexpr size_t WS_MOEW = 185 * MiB;
constexpr size_t WS_ACT1 = 1 * MiB;
constexpr size_t WS_Y = 317 * MiB;
constexpr size_t WS_ROUTE = 449 * MiB;
constexpr size_t WS_END = 543 * MiB;
static_assert(WS_ACT1 + (size_t)MOE_PASS_TILES * 256 * DFF * 2 <= WS_MOEW, "act1");
static_assert(WS_MOEW + 8 * SZ_FFNW <= WS_Y && WS_Y + (size_t)264 * 256 * D * 2 <= WS_ROUTE && WS_ROUTE + 4 * MiB <= WS_H2B && WS_H2B + 64 * MiB <= WS_END, "moe map");
static_assert(WS_PROJ + (size_t)NTOK * PJ * 2 <= WS_KV && WS_KV + (size_t)8 * 256 * 19456 <= WS_UW && WS_QB + 16 * MiB <= WS_END && WS_ST + (size_t)NINST * 8192 <= WS_END, "mixer map");
constexpr int CW_TMO = 0, CW_CODE = 1;
constexpr int CW_BAR = 4096;
constexpr int CW_MOD = 16384;
constexpr int CW_MOECNT = 65536;
constexpr int CW_NMAX = 66560;
constexpr int CW_ATTQ = 66688;
static_assert(CW_MOD + NLAYER * BATCH * 6 * D <= CW_MOECNT && (CW_ATTQ + 2 * 64) * 4 <= (int)CTL_ZERO_BYTES, "ctl");

constexpr int RING_OFF = 0, RING_BYTES = 131072;
constexpr int LDS_BYTES = 160 * 1024;
constexpr int MISC_OFF = LDS_BYTES - 256;

#define GAS __attribute__((address_space(1)))
#define LAS __attribute__((address_space(3)))
typedef unsigned short bf16;
typedef unsigned v4u __attribute__((ext_vector_type(4)));
typedef unsigned v2u __attribute__((ext_vector_type(2)));
typedef float f32x4 __attribute__((ext_vector_type(4)));
typedef float f32x16 __attribute__((ext_vector_type(16)));
typedef short bf16x8 __attribute__((ext_vector_type(8)));
typedef short bf16x4 __attribute__((ext_vector_type(4)));
typedef GAS unsigned gu32;
#define RLX_AGENT __ATOMIC_RELAXED, __HIP_MEMORY_SCOPE_AGENT
#define LDS_WAIT() asm volatile("s_waitcnt lgkmcnt(0)" ::: "memory")
#define VM_WAIT() asm volatile("s_waitcnt vmcnt(0)" ::: "memory")
__device__ __forceinline__ unsigned f2bf(float f) { unsigned u = __builtin_bit_cast(unsigned, f); return (u + 0x7fffu + ((u >> 16) & 1u)) >> 16; }
__device__ __forceinline__ unsigned pk2(float lo, float hi) { return f2bf(lo) | (f2bf(hi) << 16); }
__device__ __forceinline__ float bf2f(unsigned b) { return __builtin_bit_cast(float, b << 16); }
__device__ __forceinline__ float bflo(unsigned w) { return __builtin_bit_cast(float, w << 16); }
__device__ __forceinline__ float bfhi(unsigned w) { return __builtin_bit_cast(float, w & 0xffff0000u); }
__device__ __forceinline__ float fast_exp2(float x) { return __builtin_amdgcn_exp2f(x); }
__device__ __forceinline__ float fast_exp(float x) { return __builtin_amdgcn_exp2f(x * 1.4426950408889634f); }
__device__ __forceinline__ float fast_rcp(float x) { return __builtin_amdgcn_rcpf(x); }
__device__ __forceinline__ float sigmoidf_(float x) { return fast_rcp(1.f + fast_exp(-x)); }
__device__ __forceinline__ float siluf_(float x) { return x * sigmoidf_(x); }
__device__ __forceinline__ float wave_sum(float v) {
    v += __builtin_bit_cast(float, __builtin_amdgcn_update_dpp(0, __builtin_bit_cast(int, v), 0xB1, 0xf, 0xf, true));
    v += __builtin_bit_cast(float, __builtin_amdgcn_update_dpp(0, __builtin_bit_cast(int, v), 0x4E, 0xf, 0xf, true));
    v += __builtin_bit_cast(float, __builtin_amdgcn_update_dpp(0, __builtin_bit_cast(int, v), 0x141, 0xf, 0xf, true));
    v += __builtin_bit_cast(float, __builtin_amdgcn_update_dpp(0, __builtin_bit_cast(int, v), 0x140, 0xf, 0xf, true));
    v += __builtin_bit_cast(float, __builtin_amdgcn_ds_swizzle(__builtin_bit_cast(int, v), 0x401f));
    v += __shfl_xor(v, 32);
    return v;
}

#define XB_TMO      128
#define XB_XCNT(j)  (256  + 64 * (j))
#define XB_XSUB(j)  (1280 + 64 * (j))
#define XB_XGEN(j)  (2304 + 64 * (j))
#define XB_TOP      3328
#define XB_TOPGEN   3392
#define XCD_BAR_WORDS 3456
#define XB_SPIN_CAP (1u << 22)
__device__ __forceinline__ unsigned xb_ld(unsigned* p)              { return __hip_atomic_load(p, __ATOMIC_RELAXED, __HIP_MEMORY_SCOPE_AGENT); }
__device__ __forceinline__ unsigned xb_add(unsigned* p, unsigned v) { return __hip_atomic_fetch_add(p, v, __ATOMIC_RELAXED, __HIP_MEMORY_SCOPE_AGENT); }
__device__ __forceinline__ unsigned xb_xcc_id() { return (unsigned)__builtin_amdgcn_s_getreg((3 << 11) | 20) & 0xFu; }
#define XB_SPIN(cond, bar) do { unsigned _sp = 0; while (cond) { __builtin_amdgcn_s_sleep(1); \
    if ((++_sp & 255u) == 0u) { if (xb_ld(&(bar)[XB_TMO])) break; if (_sp > XB_SPIN_CAP) { atomicAdd(&(bar)[XB_TMO], 1u); break; } } } } while (0)
struct XcdBarrier { unsigned* bar; unsigned x; volatile LAS unsigned* st; };
__device__ __forceinline__ XcdBarrier xcd_barrier_post(unsigned* bar, volatile LAS unsigned* st) {
    XcdBarrier b; b.bar = bar; b.x = xb_xcc_id(); b.st = st;
    if (threadIdx.x == 0) (void)xb_add(&bar[XB_XCNT(b.x)], 1u);
    return b;
}
__device__ __forceinline__ void xcd_barrier_complete(unsigned* bar, unsigned x, unsigned& nloc, unsigned& nx) {
    const unsigned G = gridDim.x * gridDim.y * gridDim.z;
    unsigned sum, cnt, mine, sp = 0u;
    for (;;) {
        sum = 0u; cnt = 0u; mine = 0u;
#pragma unroll
        for (unsigned j = 0; j < 16; ++j) { const unsigned c = xb_ld(&bar[XB_XCNT(j)]); sum += c; cnt += (c > 0u) ? 1u : 0u; }
        mine = xb_ld(&bar[XB_XCNT(x)]);
        if (sum == G) break;
        __builtin_amdgcn_s_sleep(1);
        if ((++sp & 255u) == 0u) { if (xb_ld(&bar[XB_TMO])) break; if (sp > XB_SPIN_CAP) { atomicAdd(&bar[XB_TMO], 1u); break; } }
    }
    nloc = mine > 0u ? mine : 1u; nx = cnt > 0u ? cnt : 1u;
}
__device__ __forceinline__ void xcd_barrier(const XcdBarrier& b) {
    asm volatile("s_waitcnt vmcnt(0)" ::: "memory");
    __syncthreads();
    if (threadIdx.x == 0) {
        unsigned* bar = b.bar;
        __builtin_amdgcn_s_waitcnt(0);
        unsigned nloc = b.st[0], nx = b.st[1];
        if (nloc == 0u) { xcd_barrier_complete(bar, b.x, nloc, nx); b.st[0] = nloc; b.st[1] = nx; }
        const unsigned old = xb_add(&bar[XB_XSUB(b.x)], 1u);
        const unsigned gen = old / nloc;
        if (old + 1u == (gen + 1u) * nloc) {
            __builtin_amdgcn_fence(__ATOMIC_RELEASE, "agent");
            asm volatile("s_waitcnt vmcnt(0)" ::: "memory");
            const unsigned og = xb_add(&bar[XB_TOP], 1u);
            const unsigned tg = og / nx;
            if (og + 1u == (tg + 1u) * nx) xb_add(&bar[XB_TOPGEN], 1u);
            else XB_SPIN(xb_ld(&bar[XB_TOPGEN]) == tg, bar);
            __builtin_amdgcn_fence(__ATOMIC_ACQUIRE, "agent");
            xb_add(&bar[XB_XGEN(b.x)], 1u);
            asm volatile("s_waitcnt vmcnt(0)" ::: "memory");
        } else {
            XB_SPIN(xb_ld(&bar[XB_XGEN(b.x)]) == gen, bar);
            __builtin_amdgcn_fence(__ATOMIC_ACQUIRE, "agent");
            asm volatile("s_waitcnt vmcnt(0)" ::: "memory");
        }
    }
    __syncthreads();
}

struct Frame {
    LAS unsigned char* lds;
    volatile LAS unsigned* MISC;
    gu32* ctl;
    int tid, lane, wave;
    int vcu, G;
    unsigned char* ws;
    float* out;
    const float* const* in;
};
enum { I_X = 0, I_C, I_ADAW, I_ADAB, I_NMIXPRE, I_NMIXPOST, I_NFFNPRE, I_NFFNPOST, I_WIN, I_DLAMBDA, I_DSUBLN, I_POOLW, I_POOLSCALE, I_SCONVW, I_DCONVW, I_DALOG, I_DDTBIAS, I_DNORM,
       I_WBRANCH, I_WMERGE, I_BMERGE, I_WO, I_FFNG, I_FFNU, I_FFND, I_ROUTERW, I_ROUTERB, I_MOEG, I_MOEU, I_MOED, N_INPUTS };

__device__ __forceinline__ void cvt_item(const float* W, int ldw, int k0, int n0, bf16* WT, int Kd, int drow0, LAS float* scr, int lane) {
#pragma unroll 8
    for (int i = 0; i < 32; ++i) { const int kk = 2 * i + (lane >> 5); scr[kk * 33 + (lane & 31)] = W[(size_t)(k0 + kk) * ldw + n0 + (lane & 31)]; }
    LDS_WAIT(); asm volatile("" ::: "memory");
    const int c = lane & 7;
#pragma unroll
    for (int j = 0; j < 4; ++j) { const int n = (lane >> 3) + 8 * j; const LAS float* s = scr + (8 * c) * 33 + n;
        v4u o; o.x = pk2(s[0 * 33], s[1 * 33]); o.y = pk2(s[2 * 33], s[3 * 33]); o.z = pk2(s[4 * 33], s[5 * 33]); o.w = pk2(s[6 * 33], s[7 * 33]);
        *(GAS v4u*)(WT + (size_t)(drow0 + n) * Kd + k0 + 8 * c) = o; }
    LDS_WAIT(); asm volatile("" ::: "memory");
}
__device__ __forceinline__ void cvt_ffn_item(const float* wg, const float* wu, const float* wd, bf16* Wgu, bf16* Wd, int r, LAS float* scr, int lane) {
    constexpr int IG = (D / 64) * (DFF / 32);
    if (r < IG) { const int kb = r / (DFF / 32), nb = r % (DFF / 32), n0 = nb * 32; cvt_item(wg, DFF, kb * 64, n0, Wgu, D, 256 * (n0 >> 7) + (n0 & 127), scr, lane); return; } r -= IG;
    if (r < IG) { const int kb = r / (DFF / 32), nb = r % (DFF / 32), n0 = nb * 32; cvt_item(wu, DFF, kb * 64, n0, Wgu, D, 256 * (n0 >> 7) + (n0 & 127) + 128, scr, lane); return; } r -= IG;
    { const int kb = r / (D / 32), nb = r % (D / 32); cvt_item(wd, D, kb * 64, nb * 32, Wd, DFF, nb * 32, scr, lane); }
}
constexpr int FFN_ITEMS = 3 * (D / 64) * (DFF / 32);
__device__ __forceinline__ bf16* w_in_t(unsigned char* ws, int l) { return (bf16*)(ws + WS_W + (size_t)l * SZ_LAYERW); }
__device__ __forceinline__ bf16* w_m_t(unsigned char* ws, int l) { return (bf16*)(ws + WS_W + (size_t)l * SZ_LAYERW + SZ_WIN); }
__device__ __forceinline__ bf16* w_b_t(unsigned char* ws, int l) { return (bf16*)(ws + WS_W + (size_t)l * SZ_LAYERW + SZ_WIN + SZ_WM); }
__device__ __forceinline__ bf16* w_o_t(unsigned char* ws, int l) { return (bf16*)(ws + WS_W + (size_t)l * SZ_LAYERW + SZ_WIN + SZ_WM + SZ_WB); }

__device__ __forceinline__ void p_prologue(Frame& F) {
    LAS float* scr = (LAS float*)(F.lds + RING_OFF + F.wave * 16384);
    const int gw = F.vcu * NWAVES + F.wave, NGW = F.G * NWAVES;
    constexpr int I_IN = (D / 64) * (NPROJ / 32), I_M = (D / 64) * (D / 32), I_B = (256 / 64) * (D / 32);
    constexpr int PER_LAYER = I_IN + 4 * I_M + 4 * I_B + I_M;
    constexpr int NITEMS = NLAYER * PER_LAYER + FFN_ITEMS;
    for (int it = gw; it < NITEMS; it += NGW) {
        int r = it;
        if (r >= NLAYER * PER_LAYER) { r -= NLAYER * PER_LAYER;
            cvt_ffn_item(F.in[I_FFNG], F.in[I_FFNU], F.in[I_FFND], (bf16*)(F.ws + WS_WFFN), (bf16*)(F.ws + WS_WFFN + SZ_WGU), r, scr, F.lane); continue; }
        const int l = r / PER_LAYER; r -= l * PER_LAYER;
        if (r < I_IN) { const int kb = r / (NPROJ / 32), nb = r % (NPROJ / 32); cvt_item(F.in[I_WIN] + (size_t)l * D * IN_COLS, IN_COLS, kb * 64, nb * 32, w_in_t(F.ws, l), D, nb * 32, scr, F.lane); continue; } r -= I_IN;
        if (r < 4 * I_M) { const int i = r / I_M; r -= i * I_M; const int kb = r / (D / 32), nb = r % (D / 32);
            cvt_item(F.in[I_WMERGE] + ((size_t)l * 4 + i) * D * D, D, kb * 64, nb * 32, w_m_t(F.ws, l), D, i * 1024 + nb * 32, scr, F.lane); continue; } r -= 4 * I_M;
        if (r < 4 * I_B) { const int i = r / I_B; r -= i * I_B; const int kb = r / (D / 32), nb = r % (D / 32);
            cvt_item(F.in[I_WBRANCH] + ((size_t)l * 4 + i) * 256 * D, D, kb * 64, nb * 32, w_b_t(F.ws, l) + (size_t)i * 1024 * 256, 256, nb * 32, scr, F.lane); continue; } r -= 4 * I_B;
        { const int kb = r / (D / 32), nb = r % (D / 32); cvt_item(F.in[I_WO] + (size_t)l * D * D, D, kb * 64, nb * 32, w_o_t(F.ws, l), D, nb * 32, scr, F.lane); }
    }
    constexpr int MOD_ITEMS = NLAYER * 24;
    for (int it = gw; it < MOD_ITEMS; it += NGW) {
        const int l = it / 24, nb = it % 24;
        const float* Wp = F.in[I_ADAW] + (size_t)l * D * (6 * D) + nb * 256 + F.lane * 4;
        f32x4 a0 = {0.f, 0.f, 0.f, 0.f}, a1 = {0.f, 0.f, 0.f, 0.f};
#pragma unroll 8
        for (int k = 0; k < D; ++k) { const f32x4 w = *(const GAS f32x4*)(Wp + (size_t)k * (6 * D));
            const float c0 = siluf_(F.in[I_C][k]), c1 = siluf_(F.in[I_C][D + k]); a0 += w * c0; a1 += w * c1; }
        float* m0 = (float*)(F.ctl + CW_MOD) + (size_t)(l * BATCH + 0) * 6 * D + nb * 256 + F.lane * 4;
        *(GAS f32x4*)m0 = a0; *(GAS f32x4*)(m0 + 6 * D) = a1;
    }
}
__device__ __forceinline__ void p_moe_cvt(Frame& F) {
    LAS float* scr = (LAS float*)(F.lds + RING_OFF + F.wave * 16384);
    const int gw = F.vcu * NWAVES + F.wave, NGW = F.G * NWAVES;
    for (int it = gw; it < NEXP * FFN_ITEMS; it += NGW) {
        const int e = it / FFN_ITEMS, r = it % FFN_ITEMS;
        bf16* base = (bf16*)(F.ws + WS_MOEW + (size_t)e * SZ_FFNW);
        cvt_ffn_item(F.in[I_MOEG] + (size_t)e * D * DFF, F.in[I_MOEU] + (size_t)e * D * DFF, F.in[I_MOED] + (size_t)e * DFF * D, base, (bf16*)((unsigned char*)base + SZ_WGU), r, scr, F.lane);
    }
}

struct Row { f32x4 v[4]; };
__device__ __forceinline__ float modv(Frame& F, int l, int b, int idx) { return ((const float*)(F.ctl + CW_MOD))[(size_t)(l * BATCH + b) * 6 * D + idx] + F.in[I_ADAB][l * 6 * D + idx]; }
__device__ __forceinline__ f32x4 modv4(Frame& F, int l, int b, int idx) {
    const f32x4 a = *(const GAS f32x4*)((const float*)(F.ctl + CW_MOD) + (size_t)(l * BATCH + b) * 6 * D + idx), c = *(const GAS f32x4*)(F.in[I_ADAB] + l * 6 * D + idx); return a + c; }
__device__ __forceinline__ float row_rstd(const Row& r) {
    float s = 0.f;
#pragma unroll
    for (int j = 0; j < 4; ++j) s += (r.v[j].x * r.v[j].x + r.v[j].y * r.v[j].y) + (r.v[j].z * r.v[j].z + r.v[j].w * r.v[j].w);
    return 1.f / sqrtf(wave_sum(s) * (1.f / D) + EPS);
}
__device__ __forceinline__ void row_resid(Frame& F, Row& x, const Row& f, const float* gain, int l, int b, int gidx) {
    const float rs = row_rstd(f);
#pragma unroll
    for (int j = 0; j < 4; ++j) { const int c = 4 * F.lane + 256 * j; const f32x4 g = *(const GAS f32x4*)(gain + c), m = modv4(F, l, b, gidx + c); x.v[j] += m * (f.v[j] * rs * g); }
}
__device__ __forceinline__ void row_make_h(Frame& F, Row& h, const Row& x, const float* gain, int l, int b, int shidx, int scidx) {
    const float rs = row_rstd(x);
#pragma unroll
    for (int j = 0; j < 4; ++j) { const int c = 4 * F.lane + 256 * j; const f32x4 g = *(const GAS f32x4*)(gain + c), sc = modv4(F, l, b, scidx + c), sh = modv4(F, l, b, shidx + c);
        h.v[j] = (x.v[j] * rs * g) * (sc + 1.f) + sh; }
}
__device__ __forceinline__ void row_store_bf16(Frame& F, const Row& h, bf16* dst) {
    GAS unsigned long long* o8 = (GAS unsigned long long*)dst + F.lane;
#pragma unroll
    for (int j = 0; j < 4; ++j) o8[64 * j] = (unsigned long long)pk2(h.v[j].x, h.v[j].y) | ((unsigned long long)pk2(h.v[j].z, h.v[j].w) << 32);
}
__device__ __forceinline__ void row_load_f32(Frame& F, Row& r, const float* src) {
    const GAS f32x4* p = (const GAS f32x4*)src + F.lane;
#pragma unroll
    for (int j = 0; j < 4; ++j) r.v[j] = p[64 * j];
}
__device__ __forceinline__ void row_store_f32(Frame& F, const Row& r, float* dst) {
    GAS f32x4* p = (GAS f32x4*)dst + F.lane;
#pragma unroll
    for (int j = 0; j < 4; ++j) p[64 * j] = r.v[j];
}
__device__ __forceinline__ void row_load_bf16(Frame& F, Row& r, const bf16* src) {
    const GAS v2u* p = (const GAS v2u*)src + F.lane;
#pragma unroll
    for (int j = 0; j < 4; ++j) { const v2u w = p[64 * j]; r.v[j] = (f32x4){bflo(w.x), bfhi(w.x), bflo(w.y), bfhi(w.y)}; }
}
template <int NO> __device__ __forceinline__ void row_dots(Frame& F, const Row& h, const LAS float* WT, float (&out)[NO]) {
#pragma unroll
    for (int o = 0; o < NO; ++o) { float s = 0.f;
#pragma unroll
        for (int j = 0; j < 4; ++j) { const f32x4 w = *(const LAS f32x4*)(WT + o * 1024 + 4 * F.lane + 256 * j); s += (h.v[j].x * w.x + h.v[j].y * w.y) + (h.v[j].z * w.z + h.v[j].w * w.w); }
        out[o] = s; if ((o & 3) == 3) __builtin_amdgcn_sched_barrier(0); }
#pragma unroll
    for (int o = 0; o < NO; ++o) { out[o] = wave_sum(out[o]); if ((o & 3) == 3) __builtin_amdgcn_sched_barrier(0); }
}
template <int NO> __device__ __forceinline__ void load_wt(Frame& F, const float* W, int ldw, int col0, LAS float* WT) {
    for (int k = F.tid; k < 1024; k += NWAVES * 64) {
#pragma unroll
        for (int o = 0; o < NO; ++o) WT[o * 1024 + k] = W[(size_t)k * ldw + col0 + o];
    }
    __syncthreads();
}
__device__ __forceinline__ float softplusf_(float x) { return x > 20.f ? x : log1pf(__expf(x)); }
__device__ __forceinline__ void row_bd(Frame& F, const Row& h, const LAS float* W16T, int l, int row) {
    float o16[16]; row_dots<16>(F, h, W16T, o16);
    float mine = 0.f;
#pragma unroll
    for (int o = 0; o < 16; ++o) mine = (F.lane == o) ? o16[o] : mine;
    if (F.lane < 16) {
        float r;
        if (F.lane < 8) r = 1.f / (1.f + __expf(-mine));
        else { const int i = F.lane - 8; r = -__expf(F.in[I_DALOG][l * 8 + i]) * softplusf_(mine + F.in[I_DDTBIAS][l * 8 + i]); }
        ((float*)(F.ws + WS_BD))[(size_t)row * 16 + F.lane] = r;
    }
}
__device__ __forceinline__ void moe_tiles(Frame& F, int (&cnt)[NEXP], int (&tstart)[NEXP + 1]) {
    int acc = 0;
#pragma unroll
    for (int e = 0; e < NEXP; ++e) { cnt[e] = (int)__hip_atomic_load(F.ctl + CW_MOECNT + 64 * e, RLX_AGENT); tstart[e] = acc; acc += (cnt[e] + 255) >> 8; }
    tstart[NEXP] = acc;
}

constexpr int ROW_A = 0, ROW_B = 1, ROW_C = 2;
template <int MODE> __device__ __forceinline__ void p_rows(Frame& F, const int l) {
    const int gw = F.vcu * NWAVES + F.wave, NGW = F.G * NWAVES;
    LAS float* WT = (LAS float*)(F.lds + RING_OFF);
    LAS int* linfo = (LAS int*)(F.lds + RING_OFF + 65536);
    LAS int* lcnt = (LAS int*)(F.lds + RING_OFF + 65536 + 8 * 32 * 16);
    const bool do_h1 = (MODE == ROW_A) || (MODE == ROW_C && l + 1 < NLAYER);
    const int lh = (MODE == ROW_C) ? l + 1 : l;
    const bool router = (MODE == ROW_B) && (l == 1);
    if (do_h1) load_wt<16>(F, F.in[I_WIN] + (size_t)lh * D * IN_COLS, IN_COLS, NPROJ, WT);
    if (router) { if (F.tid < 16) lcnt[F.tid] = 0; load_wt<8>(F, F.in[I_ROUTERW], NEXP, 0, WT); }
    int cnt[NEXP], tstart[NEXP + 1];
    if (MODE == ROW_C && l == 1) moe_tiles(F, cnt, tstart);
    const float* xsrc = (MODE == ROW_A || (MODE == ROW_B && l == 0)) ? F.in[I_X] : F.out;
    int ri = 0;
    for (int m = gw; m < NTOK; m += NGW, ++ri) {
        const int b = m / SEQ;
        Row x; row_load_f32(F, x, xsrc + (size_t)m * D);
        if (MODE == ROW_B) {
            Row f; row_load_bf16(F, f, (const bf16*)(F.ws + WS_F) + (size_t)m * D);
            row_resid(F, x, f, F.in[I_NMIXPOST] + l * D, l, b, 2 * D);
            row_store_f32(F, x, F.out + (size_t)m * D);
            Row h; row_make_h(F, h, x, F.in[I_NFFNPRE] + l * D, l, b, 3 * D, 4 * D);
            row_store_bf16(F, h, (bf16*)(F.ws + (l == 0 ? WS_H : WS_H2B)) + (size_t)m * D);
            if (router) {
                float lg[NEXP]; row_dots<NEXP>(F, h, WT, lg);
                int e0 = 0; float l0 = lg[0] + F.in[I_ROUTERB][0];
#pragma unroll
                for (int e = 0; e < NEXP; ++e) lg[e] += F.in[I_ROUTERB][e];
#pragma unroll
                for (int e = 1; e < NEXP; ++e) if (lg[e] > l0) { l0 = lg[e]; e0 = e; }
                int e1 = -1; float l1 = -3.0e38f;
#pragma unroll
                for (int e = 0; e < NEXP; ++e) if (e != e0 && lg[e] > l1) { l1 = lg[e]; e1 = e; }
                const float q1 = __expf(l1 - l0), p0 = 1.f / (1.f + q1), p1 = q1 * p0;
                if (F.lane == 0) {
                    const int i0 = atomicAdd((int*)&lcnt[e0], 1), i1 = atomicAdd((int*)&lcnt[e1], 1);
                    LAS int* li = linfo + (F.wave * 32 + ri) * 4;
                    li[0] = e0 | (e1 << 8) | (i0 << 16); li[1] = i1; li[2] = __float_as_int(p0); li[3] = __float_as_int(p1);
                }
            }
        } else if (MODE == ROW_C) {
            Row f;
            if (l == 0) row_load_bf16(F, f, (const bf16*)(F.ws + WS_F) + (size_t)m * D);
            else {
                const int* ti = (const int*)(F.ws + WS_ROUTE) + (size_t)m * 8;
                const int e0 = ti[0], i0 = ti[1], e1 = ti[2], i1 = ti[3]; const float p0 = __int_as_float(ti[4]), p1 = __int_as_float(ti[5]);
                int s0 = 0, s1 = 0;
#pragma unroll
                for (int e = 0; e < NEXP; ++e) { s0 = (e == e0) ? tstart[e] * 256 + i0 : s0; s1 = (e == e1) ? tstart[e] * 256 + i1 : s1; }
                Row y0, y1; row_load_bf16(F, y0, (const bf16*)(F.ws + WS_Y) + (size_t)s0 * D); row_load_bf16(F, y1, (const bf16*)(F.ws + WS_Y) + (size_t)s1 * D);
#pragma unroll
                for (int j = 0; j < 4; ++j) f.v[j] = y0.v[j] * p0 + y1.v[j] * p1;
            }
            row_resid(F, x, f, F.in[I_NFFNPOST] + l * D, l, b, 5 * D);
            row_store_f32(F, x, F.out + (size_t)m * D);
        }
        if (do_h1) {
            Row h; row_make_h(F, h, x, F.in[I_NMIXPRE] + lh * D, lh, b, 0, 1 * D);
            row_store_bf16(F, h, (bf16*)(F.ws + WS_H) + (size_t)m * D);
            row_bd(F, h, WT, lh, m);
        }
    }
    if (router) {
        __syncthreads();
        if (F.tid < NEXP) lcnt[8 + F.tid] = (int)__hip_atomic_fetch_add(F.ctl + CW_MOECNT + 64 * F.tid, (unsigned)lcnt[F.tid], RLX_AGENT);
        __syncthreads();
        ri = 0;
        for (int m = gw; m < NTOK; m += NGW, ++ri) {
            if (F.lane == 0) {
                const LAS int* li = linfo + (F.wave * 32 + ri) * 4;
                const int w0 = li[0], e0 = w0 & 255, e1 = (w0 >> 8) & 255, i0 = (w0 >> 16) + lcnt[8 + e0], i1 = li[1] + lcnt[8 + e1];
                int* ti = (int*)(F.ws + WS_ROUTE) + (size_t)m * 8;
                ti[0] = e0; ti[1] = i0; ti[2] = e1; ti[3] = i1; ti[4] = li[2]; ti[5] = li[3];
                int* lists = (int*)(F.ws + WS_ROUTE + 1 * MiB);
                lists[(size_t)e0 * 65536 + i0] = m; lists[(size_t)e1 * 65536 + i1] = m;
            }
        }
    }
    __syncthreads();
}

namespace pg8 {
constexpr int NXCD = 8, WGM = 8;
struct SchedStd {
    int nM, nN, nwg, G, c; const char* A; size_t a_tile; const char* B; size_t b_tile;
    __device__ __forceinline__ void init(int nM_, int nN_, int G_, int c_, const void* A_, size_t a_tile_, const void* B_, size_t b_tile_) { nM = nM_; nN = nN_; nwg = nM * nN; G = G_; c = c_; A = (const char*)A_; a_tile = a_tile_; B = (const char*)B_; b_tile = b_tile_; }
    __device__ __forceinline__ bool next(int i, Unit& u) const {
        const long L = (long)i * G + c; if (L >= nwg) return false;
        int wgid = (int)L; { const int q = nwg / NXCD, r = nwg % NXCD, xcd = wgid % NXCD, off = wgid / NXCD; wgid = (xcd < r ? xcd * (q + 1) : r * (q + 1) + (xcd - r) * q) + off; }
        const int nig = WGM * nN, gid = wgid / nig, fm = gid * WGM, gsz = (nM - fm) < WGM ? (nM - fm) : WGM;
        u.pm = fm + ((wgid % nig) % gsz); u.pn = (wgid % nig) / gsz; u.aux = 0; u.pad = 0; u.a = A + (size_t)u.pm * a_tile; u.b = B + (size_t)u.pn * b_tile; u.rows = nullptr; return true;
    }
    __device__ __forceinline__ void a_ready(const Unit&) const {}
    __device__ __forceinline__ void done(const Unit&) const {}
};
struct SchedBranch {
    SchedStd s; const char* O4; const char* Wb;
    __device__ __forceinline__ bool next(int i, Unit& u) const {
        if (!s.next(i, u)) return false;
        const int br = u.pn >> 2; u.pn &= 3; u.aux = br;
        u.a = O4 + (size_t)u.pm * 256 * 1024 * 2 + (size_t)br * 256 * 2; u.b = Wb + (size_t)br * 1024 * 256 * 2 + (size_t)u.pn * 256 * 256 * 2; return true;
    }
    __device__ __forceinline__ void a_ready(const Unit&) const {}
    __device__ __forceinline__ void done(const Unit&) const {}
};
struct SchedGate {
    int vcu, G; const char* H; const char* Wm;
    __device__ __forceinline__ bool next(int i, Unit& u) const {
        const int tg = vcu + G * (i >> 2); if (tg >= 512) return false;
        u.pm = tg >> 2; u.pn = tg & 3; u.aux = i & 3; u.pad = 0; u.rows = nullptr;
        u.a = H + (size_t)u.pm * 256 * 1024 * 2; u.b = Wm + ((size_t)u.aux * 1024 + (size_t)u.pn * 256) * 1024 * 2; return true;
    }
    __device__ __forceinline__ void a_ready(const Unit&) const {}
    __device__ __forceinline__ void done(const Unit&) const {}
};
struct SchedMoe {
    int c, G, t0, t1, nN; int tstart[9]; int cnt[8];
    const char* A; const int* lists; const char* W; size_t w_tile; bool gather;
    __device__ __forceinline__ bool next(int i, Unit& u) const {
        const long L = (long)i * G + c; const int t = t0 + (int)(L / nN); if (t >= t1) return false;
        int e = 0;
#pragma unroll
        for (int k = 1; k < 8; ++k) e = (t >= tstart[k]) ? k : e;
        int ce = 0;
#pragma unroll
        for (int k = 0; k < 8; ++k) ce = (k == e) ? cnt[k] : ce;
        const int j = t - ((e == 0) ? 0 : 0), jj = t;
        (void)j; (void)jj;
        int ts = 0;
#pragma unroll
        for (int k = 0; k < 8; ++k) ts = (k == e) ? tstart[k] : ts;
        const int tj = t - ts;
        u.pn = (int)(L % nN); u.pad = 0;
        if (gather) { u.pm = t - t0; u.a = A; u.rows = lists + (size_t)e * 65536 + tj * 256; const int nv = ce - tj * 256; u.aux = nv > 256 ? 256 : nv; }
        else { u.pm = t; u.a = A + (size_t)(t - t0) * 256 * DFF_ * 2; u.rows = nullptr; u.aux = 0; }
        u.b = W + (size_t)e * SZ_EXP_ + (size_t)u.pn * w_tile; return true;
    }
    static constexpr size_t DFF_ = 2816; static constexpr size_t SZ_EXP_ = (size_t)2 * 2816 * 1024 * 2 + (size_t)1024 * 2816 * 2;
    __device__ __forceinline__ void a_ready(const Unit&) const {}
    __device__ __forceinline__ void done(const Unit&) const {}
};

struct EpiStore {
    static constexpr bool PERM = true;
    bf16_t* O; int ldc; size_t aux_stride; float scale0;
    __device__ __forceinline__ void operator()(const f32x4 (&acc)[2][2][4][2], const Unit& u, int wr, int wc, int fr, int fq) const {
        const int row0 = u.pm * BM + wr * 64 + fr, col0 = u.pn * BM + wc * 32 + 8 * fq; bf16_t* base = O + (size_t)u.aux * aux_stride;
        const float sc = (u.pn == 0) ? scale0 : 1.f;
#pragma unroll
        for (int ai = 0; ai < 2; ++ai)
#pragma unroll
            for (int m = 0; m < 4; ++m) { bf16_t* rowp = base + (size_t)(row0 + ai * HALF + m * 16) * ldc + col0;
#pragma unroll
                for (int bj = 0; bj < 2; ++bj) { const f32x4 v0 = acc[ai][bj][m][0] * sc, v1 = acc[ai][bj][m][1] * sc;
                    u32x4 w; w.x = cvt_pk_bf16(v0[0], v0[1]); w.y = cvt_pk_bf16(v0[2], v0[3]); w.z = cvt_pk_bf16(v1[0], v1[1]); w.w = cvt_pk_bf16(v1[2], v1[3]);
                    *(u32x4*)(rowp + bj * HALF) = w; } }
    }
};

struct EpiProj {
    static constexpr bool PERM = true;
    static constexpr int TILE_E = 9728;
    bf16_t* Qb; bf16_t* KV; bf16_t* Pj; unsigned* nmax; float qscale;
    __device__ __forceinline__ void operator()(const f32x4 (&acc)[2][2][4][2], const Unit& u, int wr, int wc, int fr, int fq) const {
        const int t0 = u.pm * BM + wr * 64 + fr;
        const int b = (u.pm * BM) >> 14;
        const int s00 = t0 & 16383;
        if (u.pn >= 3) {
            bf16_t* base = Pj + (size_t)t0 * 2048 + (u.pn - 3) * BM + wc * 32 + 8 * fq;
#pragma unroll
            for (int ai = 0; ai < 2; ++ai)
#pragma unroll
                for (int m = 0; m < 4; ++m) {
#pragma unroll
                    for (int bj = 0; bj < 2; ++bj) { const f32x4 v0 = acc[ai][bj][m][0], v1 = acc[ai][bj][m][1];
                        u32x4 w; w.x = cvt_pk_bf16(v0[0], v0[1]); w.y = cvt_pk_bf16(v0[2], v0[3]); w.z = cvt_pk_bf16(v1[0], v1[1]); w.w = cvt_pk_bf16(v1[2], v1[3]);
                        *(u32x4*)(base + (ai * HALF + m * 16) * 2048 + bj * HALF) = w; }
                    __builtin_amdgcn_sched_barrier(0); }
        } else if (u.pn == 2) {
            bf16_t* hb = KV + ((size_t)((b * 4 + (wc >> 1)) * 256 + (s00 >> 6))) * TILE_E + 5120 + (32 * (wc & 1) + 8 * fq) * 68 + (s00 & 63);
#pragma unroll
            for (int ai = 0; ai < 2; ++ai)
#pragma unroll
                for (int bj = 0; bj < 2; ++bj) { bf16_t* tb = hb + (size_t)bj * (2 * 256 * TILE_E) + ai * (2 * TILE_E);
#pragma unroll
                    for (int m = 0; m < 4; ++m)
#pragma unroll
                        for (int n = 0; n < 2; ++n)
#pragma unroll
                            for (int j = 0; j < 4; ++j) { const float v = acc[ai][bj][m][n][j];
                                unsigned bits = __builtin_bit_cast(unsigned, v); bits = (bits + 0x7fffu + ((bits >> 16) & 1u)) >> 16;
                                tb[(4 * n + j) * 68 + 16 * m] = (bf16_t)bits; }
                    __builtin_amdgcn_sched_barrier(0); }
        } else {
            const float sc = (u.pn == 0) ? qscale : 1.f; float nm = 0.f;
            bf16_t* qbase = Qb + ((size_t)(b * 4 + wc) * 16384 + s00) * 64 + 8 * fq;
            bf16_t* kbase = KV + ((size_t)((b * 4 + wc) * 256 + (s00 >> 6))) * TILE_E + (s00 & 63) * 40 + 8 * fq;
#pragma unroll
            for (int ai = 0; ai < 2; ++ai)
#pragma unroll
                for (int m = 0; m < 4; ++m) {
#pragma unroll
                    for (int bj = 0; bj < 2; ++bj) { const f32x4 v0 = acc[ai][bj][m][0] * sc, v1 = acc[ai][bj][m][1] * sc;
                        u32x4 w; w.x = cvt_pk_bf16(v0[0], v0[1]); w.y = cvt_pk_bf16(v0[2], v0[3]); w.z = cvt_pk_bf16(v1[0], v1[1]); w.w = cvt_pk_bf16(v1[2], v1[3]);
                        float ss = (v0[0] * v0[0] + v0[1] * v0[1]) + (v0[2] * v0[2] + v0[3] * v0[3]) + (v1[0] * v1[0] + v1[1] * v1[1]) + (v1[2] * v1[2] + v1[3] * v1[3]);
                        ss += __shfl_xor(ss, 16); ss += __shfl_xor(ss, 32); nm = fmaxf(nm, ss);
                        if (u.pn == 0) *(u32x4*)(qbase + (ai * HALF + m * 16) * 64 + 32 * bj) = w;
                        else *(u32x4*)(kbase + ai * (2 * TILE_E) + bj * 2560 + (16 * m) * 40) = w; }
                    __builtin_amdgcn_sched_barrier(0); }
            nm = fmaxf(nm, __shfl_xor(nm, 1)); nm = fmaxf(nm, __shfl_xor(nm, 2)); nm = fmaxf(nm, __shfl_xor(nm, 4)); nm = fmaxf(nm, __shfl_xor(nm, 8));
            if (fr == 0 && fq == 0) atomicMax(nmax + (b * 4 + wc) * 2 + u.pn, __builtin_bit_cast(unsigned, nm));
        }
    }
};
__device__ __forceinline__ float sigm(float x) { return __builtin_amdgcn_rcpf(1.f + __builtin_amdgcn_exp2f(-1.4426950408889634f * x)); }
struct EpiGate {
    static constexpr bool PERM = true;
    const bf16_t* P; bf16_t* Mg; const float* bias;
    __device__ __forceinline__ void operator()(const f32x4 (&acc)[2][2][4][2], const Unit& u, int wr, int wc, int fr, int fq) const {
        const int row0 = u.pm * BM + wr * 64 + fr, col0 = u.pn * BM + wc * 32 + 8 * fq; const int br = u.aux;
        const bf16_t* Pb = P + (size_t)br * 32768 * 1024; const float* bb = bias + br * 1024 + col0;
        f32x4 bv[2][2];
#pragma unroll
        for (int bj = 0; bj < 2; ++bj)
#pragma unroll
            for (int n = 0; n < 2; ++n) bv[bj][n] = *(const f32x4*)(bb + bj * HALF + 4 * n);
#pragma unroll
        for (int ai = 0; ai < 2; ++ai)
#pragma unroll
            for (int m = 0; m < 4; ++m) { const size_t ro = (size_t)(row0 + ai * HALF + m * 16) * 1024 + col0;
#pragma unroll
                for (int bj = 0; bj < 2; ++bj) {
                    const u32x4 pw = *(const u32x4*)(Pb + ro + bj * HALF);
                    u32x4 mw = {0u, 0u, 0u, 0u}; if (br != 0) mw = *(const u32x4*)(Mg + ro + bj * HALF);
                    float o[8];
#pragma unroll
                    for (int q = 0; q < 4; ++q) {
                        const float g0 = sigm(acc[ai][bj][m][q >> 1][(q & 1) * 2] + bv[bj][q >> 1][(q & 1) * 2]), g1 = sigm(acc[ai][bj][m][q >> 1][(q & 1) * 2 + 1] + bv[bj][q >> 1][(q & 1) * 2 + 1]);
                        o[2 * q] = g0 * __builtin_bit_cast(float, pw[q] << 16) + __builtin_bit_cast(float, mw[q] << 16);
                        o[2 * q + 1] = g1 * __builtin_bit_cast(float, pw[q] & 0xffff0000u) + __builtin_bit_cast(float, mw[q] & 0xffff0000u);
                    }
                    u32x4 w; w.x = cvt_pk_bf16(o[0], o[1]); w.y = cvt_pk_bf16(o[2], o[3]); w.z = cvt_pk_bf16(o[4], o[5]); w.w = cvt_pk_bf16(o[6], o[7]);
                    *(u32x4*)(Mg + ro + bj * HALF) = w; } }
    }
};
struct EpiSwiGLU {
    static constexpr bool PERM = true;
    bf16_t* O; int ldc;
    __device__ __forceinline__ void operator()(const f32x4 (&acc)[2][2][4][2], const Unit& u, int wr, int wc, int fr, int fq) const {
        const int row0 = u.pm * BM + wr * 64 + fr, col0 = u.pn * HALF + wc * 32 + 8 * fq;
#pragma unroll
        for (int ai = 0; ai < 2; ++ai)
#pragma unroll
            for (int m = 0; m < 4; ++m) { bf16_t* rowp = O + (size_t)(row0 + ai * HALF + m * 16) * ldc + col0;
                float o[8];
#pragma unroll
                for (int n = 0; n < 2; ++n)
#pragma unroll
                    for (int q = 0; q < 4; ++q) { const float g = acc[ai][0][m][n][q], up = acc[ai][1][m][n][q]; o[4 * n + q] = g * sigm(g) * up; }
                u32x4 w; w.x = cvt_pk_bf16(o[0], o[1]); w.y = cvt_pk_bf16(o[2], o[3]); w.z = cvt_pk_bf16(o[4], o[5]); w.w = cvt_pk_bf16(o[6], o[7]);
                *(u32x4*)rowp = w; }
    }
};
}

namespace att {
constexpr int SLOT = 19456, NSLOT = 3;
constexpr int ATTN_LDS = NSLOT * SLOT;
__device__ __forceinline__ unsigned cvtpk(float lo, float hi) { typedef float f2 __attribute__((ext_vector_type(2))); typedef __bf16 b2 __attribute__((ext_vector_type(2))); f2 v = {lo, hi}; b2 b = __builtin_convertvector(v, b2); return __builtin_bit_cast(unsigned, b); }
#define ATT_WAITV(n) asm volatile("s_waitcnt vmcnt(" #n ")" ::: "memory")

__device__ __forceinline__ void attn_unit(Frame& F, const int layer, const int b, const int h, const int qb) {
    const int lane = F.lane, r32 = lane & 31, hi = lane >> 5, wid = F.wave;
    LAS unsigned char* L = F.lds + RING_OFF;
    const int qw0 = qb * 256 + wid * 32, q = qw0 + r32;
    const float slope2 = exp2f(-2.f * (float)(h + 1)) * 1.4426950408889634f;
    int tlo, thi;
    { const unsigned* nm = (const unsigned*)(F.ctl + CW_NMAX) + layer * 16 + (b * 4 + h) * 2;
      const float qn = sqrtf(__builtin_bit_cast(float, __hip_atomic_load(nm, RLX_AGENT))) * 1.01f, kn = sqrtf(__builtin_bit_cast(float, __hip_atomic_load(nm + 1, RLX_AGENT))) * 1.01f;
      const float wf = (160.f + 2.f * qn * kn) / slope2; const int W = wf > 100000.f ? 100000 : (int)wf + 1;
      const int lo = qb * 256 - W, hi_ = qb * 256 + 255 + W; tlo = lo < 0 ? 0 : (lo >> 6); thi = hi_ >= SEQ ? (SEQ / 64 - 1) : (hi_ >> 6); }
    const int nT = thi - tlo + 1;
    const bf16* Qp = (const bf16*)(F.ws + WS_QB) + ((size_t)(b * 4 + h) * SEQ + q) * 64;
    bf16x8 q1f[2], q2f[2];
#pragma unroll
    for (int ks = 0; ks < 2; ++ks) { q1f[ks] = *(const GAS bf16x8*)(Qp + 16 * ks + 8 * hi); q2f[ks] = *(const GAS bf16x8*)(Qp + 32 + 16 * ks + 8 * hi); }
    const unsigned char* kvbase = F.ws + WS_KV + ((size_t)(b * 4 + h) * 256) * SLOT + (size_t)wid * 1024 + lane * 16;
    const int p3 = wid < 3 ? 16384 : 8192;
#define ATT_DMA(t, slot) do { const unsigned char* g_ = kvbase + (size_t)(t) * SLOT; LAS unsigned char* d_ = L + (slot) * SLOT + wid * 1024; \
        __builtin_amdgcn_global_load_lds((const unsigned*)g_, (LAS unsigned*)d_, 16, 0, 0); __builtin_amdgcn_global_load_lds((const unsigned*)(g_ + 8192), (LAS unsigned*)(d_ + 8192), 16, 0, 0); \
        __builtin_amdgcn_global_load_lds((const unsigned*)(g_ + p3), (LAS unsigned*)(d_ + p3), 16, 0, 0); } while (0)
    asm volatile("s_waitcnt vmcnt(0)" ::: "memory");
    ATT_DMA(tlo, 0);
    if (nT > 1) ATT_DMA(tlo + 1, 1);
    float R = 0.f, l1 = 0.f, l2 = 0.f;
    f32x16 O1[2], O2[2];
#pragma unroll
    for (int i = 0; i < 16; ++i) { O1[0][i] = 0.f; O1[1][i] = 0.f; O2[0][i] = 0.f; O2[1][i] = 0.f; }
    const int kfo = r32 * 80 + hi * 16;
    const int vfo = 10240 + r32 * 136 + hi * 8;
    int slot = 0;
    for (int i = 0; i < nT; ++i) {
        if (i + 1 < nT) ATT_WAITV(3); else ATT_WAITV(0);
        __builtin_amdgcn_s_barrier();
        asm volatile("" ::: "memory");
        if (i + 2 < nT) { const int s2 = slot >= 1 ? slot - 1 : 2; ATT_DMA(tlo + i + 2, s2); }
        const int t = tlo + i;
        const LAS unsigned char* Bf = L + slot * SLOT;
        const float dl = (float)(q - t * 64 - 4 * hi);
        f32x16 c0, c1;
        if (t * 64 + 63 < qw0) {
            const float tl = -slope2 * dl - R;
#pragma unroll
            for (int r = 0; r < 16; ++r) { const float cc = (float)((r & 3) + 8 * (r >> 2)); c0[r] = __builtin_fmaf(slope2, cc, tl); c1[r] = __builtin_fmaf(slope2, cc + 32.f, tl); }
        } else if (t * 64 > qw0 + 31) {
            const float tr = slope2 * dl - R;
#pragma unroll
            for (int r = 0; r < 16; ++r) { const float cc = (float)((r & 3) + 8 * (r >> 2)); c0[r] = __builtin_fmaf(-slope2, cc, tr); c1[r] = __builtin_fmaf(-slope2, cc + 32.f, tr); }
        } else {
#pragma unroll
            for (int r = 0; r < 16; ++r) { const float cc = (float)((r & 3) + 8 * (r >> 2)); c0[r] = __builtin_fmaf(-slope2, __builtin_fabsf(dl - cc), -R); c1[r] = __builtin_fmaf(-slope2, __builtin_fabsf(dl - (cc + 32.f)), -R); }
        }
#pragma unroll
        for (int mp = 0; mp < 2; ++mp) {
            const int koff = mp ? 5120 : 0;
            const bf16x8 qa = mp ? q2f[0] : q1f[0], qbb = mp ? q2f[1] : q1f[1];
            const bf16x8 k00 = *(const LAS bf16x8*)(Bf + koff + kfo), k01 = *(const LAS bf16x8*)(Bf + koff + kfo + 32);
            const bf16x8 k10 = *(const LAS bf16x8*)(Bf + koff + 32 * 80 + kfo), k11 = *(const LAS bf16x8*)(Bf + koff + 32 * 80 + kfo + 32);
            f32x16 s0 = __builtin_amdgcn_mfma_f32_32x32x16_bf16(k00, qa, c0, 0, 0, 0); s0 = __builtin_amdgcn_mfma_f32_32x32x16_bf16(k01, qbb, s0, 0, 0, 0);
            f32x16 s1 = __builtin_amdgcn_mfma_f32_32x32x16_bf16(k10, qa, c1, 0, 0, 0); s1 = __builtin_amdgcn_mfma_f32_32x32x16_bf16(k11, qbb, s1, 0, 0, 0);
            float rm = fmaxf(s0[0], s1[0]);
#pragma unroll
            for (int r = 1; r < 16; ++r) rm = fmaxf(rm, fmaxf(s0[r], s1[r]));
            { auto rr = __builtin_amdgcn_permlane32_swap(__builtin_bit_cast(unsigned, rm), __builtin_bit_cast(unsigned, rm), false, false); rm = fmaxf(__builtin_bit_cast(float, rr[0]), __builtin_bit_cast(float, rr[1])); }
            if (__any(rm > 8.f)) {
                const float dd = fmaxf(rm, 0.f); R += dd;
                const float f = fast_exp2(-dd); l1 *= f; l2 *= f;
#pragma unroll
                for (int r = 0; r < 16; ++r) { s0[r] -= dd; s1[r] -= dd; c0[r] -= dd; c1[r] -= dd; O1[0][r] *= f; O1[1][r] *= f; O2[0][r] *= f; O2[1][r] *= f; }
            }
            float sum = 0.f;
#pragma unroll
            for (int r = 0; r < 16; ++r) { s0[r] = fast_exp2(s0[r]); s1[r] = fast_exp2(s1[r]); sum += s0[r] + s1[r]; }
            if (mp) l2 += sum; else l1 += sum;
            v4u pw[4];
#pragma unroll
            for (int e = 0; e < 4; ++e) { pw[0][e] = cvtpk(s0[2 * e], s0[2 * e + 1]); pw[1][e] = cvtpk(s0[8 + 2 * e], s0[8 + 2 * e + 1]); pw[2][e] = cvtpk(s1[2 * e], s1[2 * e + 1]); pw[3][e] = cvtpk(s1[8 + 2 * e], s1[8 + 2 * e + 1]); }
#pragma unroll
            for (int db = 0; db < 2; ++db) {
                f32x16 o = mp ? O2[db] : O1[db];
#pragma unroll
                for (int ks = 0; ks < 4; ++ks) {
                    const v2u lo = *(const LAS v2u*)(Bf + vfo + db * 32 * 136 + ks * 32), hi8 = *(const LAS v2u*)(Bf + vfo + db * 32 * 136 + ks * 32 + 16);
                    const v4u vf = {lo.x, lo.y, hi8.x, hi8.y};
                    o = __builtin_amdgcn_mfma_f32_32x32x16_bf16(__builtin_bit_cast(bf16x8, vf), __builtin_bit_cast(bf16x8, pw[ks]), o, 0, 0, 0);
                }
                if (mp) O2[db] = o; else O1[db] = o;
            }
        }
        slot = slot == 2 ? 0 : slot + 1;
    }
    l1 += __shfl_xor(l1, 32); l2 += __shfl_xor(l2, 32);
    const float* dlm = F.in[I_DLAMBDA] + layer * 128;
    float a1 = 0.f, a2 = 0.f;
#pragma unroll 8
    for (int i = 0; i < 32; ++i) { a1 += dlm[i] * dlm[32 + i]; a2 += dlm[64 + i] * dlm[96 + i]; }
    const float lam_init = 0.8f - 0.6f * __expf(-0.3f * (float)layer);
    const float lam = __expf(a1) - __expf(a2) + lam_init;
    const float i1 = 1.f / fmaxf(l1, 1e-30f), i2 = lam / fmaxf(l2, 1e-30f);
    float ss = 0.f;
#pragma unroll
    for (int db = 0; db < 2; ++db)
#pragma unroll
        for (int r = 0; r < 16; ++r) { const float v = O1[db][r] * i1 - O2[db][r] * i2; O1[db][r] = v; ss += v * v; }
    ss += __shfl_xor(ss, 32);
    const float rs = (1.f / sqrtf(ss * (1.f / 64.f) + EPS)) * (1.f - lam_init);
    bf16* orow = (bf16*)(F.ws + WS_O4) + ((size_t)b * SEQ + q) * 1024 + 64 * h;
    const float* sg = F.in[I_DSUBLN] + layer * 64;
#pragma unroll
    for (int db = 0; db < 2; ++db)
#pragma unroll
        for (int g4 = 0; g4 < 4; ++g4) {
            const int d0 = 32 * db + 8 * g4 + 4 * hi;
            const float v0 = O1[db][4 * g4] * rs * sg[d0], v1 = O1[db][4 * g4 + 1] * rs * sg[d0 + 1], v2 = O1[db][4 * g4 + 2] * rs * sg[d0 + 2], v3 = O1[db][4 * g4 + 3] * rs * sg[d0 + 3];
            v2u w = {pk2(v0, v1), pk2(v2, v3)};
            *(GAS v2u*)(orow + d0) = w;
        }
    asm volatile("s_waitcnt lgkmcnt(0)" ::: "memory");
    __builtin_amdgcn_s_barrier();
#undef ATT_DMA
}
#undef ATT_WAITV
}

namespace pc {
constexpr int MPITCH = 72;
__device__ __forceinline__ void poolconv_phase(Frame& F, const int layer) {
    const int lane = F.lane, r32 = lane & 31, hi = lane >> 5, wid = F.wave;
    const bf16* P = (const bf16*)(F.ws + WS_PROJ);
    bf16* O4 = (bf16*)(F.ws + WS_O4);
    LAS unsigned char* mimg = F.lds + RING_OFF + wid * (64 * MPITCH * 2);
    bf16x8 wf[2][4];
    if (wid < 4) {
        const float* W = F.in[I_POOLW] + ((size_t)layer * 4 + wid) * 64 * 64;
#pragma unroll
        for (int nb = 0; nb < 2; ++nb)
#pragma unroll
            for (int ks = 0; ks < 4; ++ks) { v4u t;
#pragma unroll
                for (int jj = 0; jj < 4; ++jj) t[jj] = pk2(W[(16 * ks + 8 * hi + 2 * jj) * 64 + r32 + 32 * nb], W[(16 * ks + 8 * hi + 2 * jj + 1) * 64 + r32 + 32 * nb]);
                wf[nb][ks] = __builtin_bit_cast(bf16x8, t); }
    }
    for (int tile = F.vcu; tile < NTOK / 64; tile += F.G) {
        const int t0 = tile * 64, s0 = t0 % SEQ;
        if (wid < 4) {
            const int g = wid, hw = 1 << g;
            const bf16* src = P + (size_t)t0 * PJ + C_PIN + 64 * g + lane;
            float cs[81]; cs[0] = 0.f;
#pragma unroll
            for (int i = 0; i < 80; ++i) { const int s = s0 - 8 + i; float v = 0.f; if (s >= 0 && s < SEQ) v = bf2f(src[(long)(i - 8) * PJ]); cs[i + 1] = cs[i] + v; }
#pragma unroll
            for (int i = 0; i < 64; ++i) {
                const int s = s0 + i; int lo = s - hw, hiw = s + hw; lo = lo < 0 ? 0 : lo; hiw = hiw > SEQ ? SEQ : hiw;
                float wsum = 0.f;
                if (g == 0) wsum = cs[i + 8 + 1] - cs[i + 8 - 1]; else if (g == 1) wsum = cs[i + 8 + 2] - cs[i + 8 - 2]; else if (g == 2) wsum = cs[i + 8 + 4] - cs[i + 8 - 4]; else wsum = cs[i + 8 + 8] - cs[i + 8 - 8];
                const float pv = cs[i + 9] - cs[i + 8];
                const float mval = wsum / (float)(hiw - lo) - pv;
                *(LAS unsigned short*)(mimg + i * (MPITCH * 2) + lane * 2) = (unsigned short)f2bf(mval);
            }
            LDS_WAIT();
#pragma unroll
            for (int tb = 0; tb < 2; ++tb) {
                bf16x8 af[4];
#pragma unroll
                for (int ks = 0; ks < 4; ++ks) af[ks] = *(const LAS bf16x8*)(mimg + (r32 + 32 * tb) * (MPITCH * 2) + (16 * ks + 8 * hi) * 2);
#pragma unroll
                for (int nb = 0; nb < 2; ++nb) {
                    f32x16 acc;
#pragma unroll
                    for (int r = 0; r < 16; ++r) acc[r] = 0.f;
#pragma unroll
                    for (int ks = 0; ks < 4; ++ks) acc = __builtin_amdgcn_mfma_f32_32x32x16_bf16(af[ks], wf[nb][ks], acc, 0, 0, 0);
                    const int e = r32 + 32 * nb; const float sc = F.in[I_POOLSCALE][layer * 256 + 64 * g + e];
#pragma unroll
                    for (int r = 0; r < 16; ++r) { const int row = 32 * tb + (r & 3) + 8 * (r >> 2) + 4 * hi;
                        O4[(size_t)(t0 + row) * 1024 + 256 + 64 * g + e] = (bf16)f2bf(acc[r] * sc); }
                }
            }
            LDS_WAIT();
        } else {
            const int ch = 64 * (wid - 4) + lane;
            const float w0 = F.in[I_SCONVW][layer * 768 + ch], w1 = F.in[I_SCONVW][layer * 768 + 256 + ch], w2 = F.in[I_SCONVW][layer * 768 + 512 + ch];
            const bf16* base = P + (size_t)t0 * PJ + ch;
            float zm = 0.f, z0 = 0.f, zp = 0.f;
            if (s0 > 0) zm = bf2f(base[-(long)PJ + C_CC]) * bf2f(base[-(long)PJ + C_CX]);
            z0 = bf2f(base[C_CC]) * bf2f(base[C_CX]);
#pragma unroll 8
            for (int i = 0; i < 64; ++i) {
                zp = 0.f; if (s0 + i + 1 < SEQ) zp = bf2f(base[(long)(i + 1) * PJ + C_CC]) * bf2f(base[(long)(i + 1) * PJ + C_CX]);
                const float cbv = bf2f(base[(long)i * PJ + C_CB]);
                O4[(size_t)(t0 + i) * 1024 + 512 + ch] = (bf16)f2bf(cbv * (w0 * zm + w1 * z0 + w2 * zp));
                zm = z0; z0 = zp;
            }
        }
    }
    __syncthreads();
}
}

namespace dl {
constexpr int MP = 72, MB = 64 * MP * 2;
constexpr int WAVE_LDS = 2 * MB + 2 * MB;
__device__ __forceinline__ int crow(int r, int hi) { return (r & 3) + 8 * (r >> 2) + 4 * hi; }
__device__ __forceinline__ bf16x8 ldfrag(const LAS unsigned char* img, int row, int col) { return *(const LAS bf16x8*)(img + row * (MP * 2) + col * 2); }
__device__ __forceinline__ bf16x8 ldfragp(const LAS unsigned char* img, int row, int col4) {
    const v2u lo = *(const LAS v2u*)(img + row * (MP * 2) + col4 * 2), hi8 = *(const LAS v2u*)(img + row * (MP * 2) + col4 * 2 + 16); const v4u t = {lo.x, lo.y, hi8.x, hi8.y}; return __builtin_bit_cast(bf16x8, t); }
__device__ __forceinline__ bf16x8 cfrag(const f32x16& x, int half) {
    v4u t;
#pragma unroll
    for (int e = 0; e < 4; ++e) t[e] = att::cvtpk(x[8 * half + 2 * e], x[8 * half + 2 * e + 1]);
    return __builtin_bit_cast(bf16x8, t); }
#define MFMA32(a, b, c) __builtin_amdgcn_mfma_f32_32x32x16_bf16((a), (b), (c), 0, 0, 0)
#define SB() __builtin_amdgcn_sched_barrier(0)
#define LAUNDER() do { asm volatile("" : "+v"(lane)); r32 = lane & 31; hi = lane >> 5; } while (0)
__device__ __forceinline__ f32x16 zero16() { f32x16 z;
#pragma unroll
    for (int r = 0; r < 16; ++r) z[r] = 0.f;
    return z; }

#define DL_CONV(colbase, wbase, RAW, EMIT) do { \
    { const bf16* src_ = P + (size_t)tok0 * PJ + (colbase); const int rr_ = lane >> 3, ch_ = lane & 7; \
      _Pragma("unroll") for (int i_ = 0; i_ < 9; ++i_) { const int row_ = rr_ + 8 * i_; const int sq_ = s0 - 2 + row_; v4u t_ = {0u, 0u, 0u, 0u}; \
          if (row_ < 68 && sq_ >= 0 && sq_ < SEQ) t_ = *(const GAS v4u*)(src_ + (long)(row_ - 2) * PJ + ch_ * 8); if (row_ < 68) *(LAS v4u*)((RAW) + row_ * 128 + ch_ * 16) = t_; } } \
    LDS_WAIT(); \
    const float cw0 = cwp[(wbase) + lane], cw1 = cwp[768 + (wbase) + lane], cw2 = cwp[2 * 768 + (wbase) + lane], cw3 = cwp[3 * 768 + (wbase) + lane], cw4 = cwp[4 * 768 + (wbase) + lane]; \
    const LAS unsigned short* rw_ = (const LAS unsigned short*)(RAW) + lane; \
    float x0, x1 = bf2f(rw_[0]), x2 = bf2f(rw_[64]), x3 = bf2f(rw_[128]), x4 = bf2f(rw_[192]); \
    _Pragma("unroll 8") for (int i = 0; i < 64; ++i) { x0 = x1; x1 = x2; x2 = x3; x3 = x4; x4 = bf2f(rw_[(i + 4) * 64]); \
        const float cv_ = cw0 * x0 + cw1 * x1 + cw2 * x2 + cw3 * x3 + cw4 * x4; const float val = cv_ * sigmoidf_(cv_); EMIT; } \
    LDS_WAIT(); } while (0)

__device__ __forceinline__ void d1_instance(Frame& F, const int layer, const int b, const int h, const int norig, const int dir, LAS unsigned char* W, LAS float* tab) {
    int lane = F.lane, r32, hi; LAUNDER();
    const bf16* P = (const bf16*)(F.ws + WS_PROJ);
    const float* cwp = F.in[I_DCONVW] + (size_t)layer * 5 * 768;
    const int s0 = norig * 64, tok0 = b * SEQ + s0;
    const int npr = dir ? 255 - norig : norig;
    const int inst = ((b * 4 + h) * 2 + dir) * NCHUNK + npr;
    LAS unsigned char* VT = W;
    LAS unsigned char* KT = W + MB;
    LAS unsigned char* KR = W + 2 * MB;
    LAS unsigned char* T2 = W + 3 * MB;
    LAS float* SM = (LAS float*)(W + 2 * MB);
    DL_CONV(C_DK + 64 * h, 256 + 64 * h, T2, { const float ss = wave_sum(val * val); const float kn = val * (1.f / sqrtf(ss + EPS)); const int ip = dir ? 63 - i : i; const unsigned short kb = (unsigned short)f2bf(kn);
        *(LAS unsigned short*)(KR + ip * (MP * 2) + lane * 2) = kb; *(LAS unsigned short*)(KT + lane * (MP * 2) + ip * 2) = kb; });
    DL_CONV(C_DV + 64 * h, 512 + 64 * h, T2, { const int ip = dir ? 63 - i : i; *(LAS unsigned short*)(VT + lane * (MP * 2) + ip * 2) = (unsigned short)f2bf(val); });
    const int mytok = tok0 + (dir ? 63 - lane : lane);
    const float* BD = (const float*)(F.ws + WS_BD) + (size_t)mytok * 16;
    const float beta = BD[dir * 4 + h]; float gc = BD[8 + dir * 4 + h];
#pragma unroll
    for (int o = 1; o < 64; o <<= 1) { const float t = __shfl_up(gc, o); if (lane >= o) gc += t; }
    const float gl = __shfl(gc, 63);
    tab[lane] = gc; tab[64 + lane] = beta; tab[128 + lane] = __expf(gl - gc);
    LDS_WAIT();
    LAUNDER();
    f32x16 kk[2][2];
#pragma unroll
    for (int tb = 0; tb < 2; ++tb)
#pragma unroll
        for (int tn = 0; tn < 2; ++tn) { f32x16 acc = zero16();
#pragma unroll
            for (int ks = 0; ks < 4; ++ks) acc = MFMA32(ldfrag(KR, r32 + 32 * tb, 16 * ks + 8 * hi), ldfrag(KR, r32 + 32 * tn, 16 * ks + 8 * hi), acc);
            kk[tb][tn] = acc; SB(); }
    LDS_WAIT();
#pragma unroll
    for (int tb = 0; tb < 2; ++tb)
#pragma unroll
        for (int tn = 0; tn < 2; ++tn) {
            const int jc = r32 + 32 * tn; const float gcj = tab[jc];
#pragma unroll
            for (int r = 0; r < 16; ++r) { const int ir = 32 * tb + crow(r, hi); const float gci = tab[ir], bi = tab[64 + ir];
                const float mv = (ir > jc) ? bi * kk[tb][tn][r] * __expf(gci - gcj) : 0.f; SM[ir * 64 + jc] = mv; } SB(); }
    LDS_WAIT();
    LAUNDER();
    float T[64];
#pragma unroll
    for (int i = 0; i < 64; ++i) {
        float a = (lane == i) ? 1.f : 0.f;
#pragma unroll
        for (int j4 = 0; j4 < (i + 3) / 4; ++j4) { const f32x4 m4 = *(const LAS f32x4*)(SM + i * 64 + 4 * j4);
#pragma unroll
            for (int e = 0; e < 4; ++e) if (4 * j4 + e < i) a = __builtin_fmaf(-m4[e], T[4 * j4 + e], a); }
        T[i] = a; if ((i & 3) == 3) SB(); }
    LDS_WAIT();
    LAUNDER();
    { const float b1 = beta, b2 = beta * __expf(gc);
#pragma unroll
      for (int i = 0; i < 64; ++i) { *(LAS unsigned short*)(KR + i * (MP * 2) + lane * 2) = (unsigned short)f2bf(T[i] * b1); *(LAS unsigned short*)(T2 + i * (MP * 2) + lane * 2) = (unsigned short)f2bf(T[i] * b2); if ((i & 7) == 7) SB(); } }
    LDS_WAIT();
    LAUNDER();
    f32x16 u[2][2], w[2][2];
#pragma unroll
    for (int tb = 0; tb < 2; ++tb)
#pragma unroll
        for (int tn = 0; tn < 2; ++tn) { f32x16 au = zero16(), aw = zero16();
#pragma unroll
            for (int ks = 0; ks < 4; ++ks) { au = MFMA32(ldfrag(KR, r32 + 32 * tb, 16 * ks + 8 * hi), ldfrag(VT, r32 + 32 * tn, 16 * ks + 8 * hi), au);
                                             aw = MFMA32(ldfrag(T2, r32 + 32 * tb, 16 * ks + 8 * hi), ldfrag(KT, r32 + 32 * tn, 16 * ks + 8 * hi), aw); }
            u[tb][tn] = au; w[tb][tn] = aw; SB(); }
    LAUNDER();
    { unsigned* ud = (unsigned*)(F.ws + WS_UW + (size_t)inst * 16384); bf16* wd = (bf16*)(F.ws + WS_UW + (size_t)inst * 16384 + 8192);
#pragma unroll
      for (int tb = 0; tb < 2; ++tb)
#pragma unroll
          for (int tn = 0; tn < 2; ++tn) {
#pragma unroll
              for (int rp = 0; rp < 8; ++rp) ud[((tb * 2 + tn) * 8 + rp) * 64 + lane] = pk2(u[tb][tn][2 * rp], u[tb][tn][2 * rp + 1]);
#pragma unroll
              for (int r = 0; r < 16; ++r) wd[(32 * tb + crow(r, hi)) * 64 + r32 + 32 * tn] = (bf16)f2bf(w[tb][tn][r]); SB(); } }
    LAUNDER();
#pragma unroll
    for (int tb = 0; tb < 2; ++tb)
#pragma unroll
        for (int r = 0; r < 16; ++r) { const float e = tab[128 + 32 * tb + crow(r, hi)];
#pragma unroll
            for (int tn = 0; tn < 2; ++tn) { u[tb][tn][r] *= e; w[tb][tn][r] *= e; } }
    SB();
    bf16x8 kf[2][4];
#pragma unroll
    for (int tbb = 0; tbb < 2; ++tbb)
#pragma unroll
        for (int s = 0; s < 4; ++s) kf[tbb][s] = ldfragp(KT, r32 + 32 * tbb, 16 * s + 4 * hi);
    LDS_WAIT(); SB();
    LAUNDER();
    LAS unsigned char* AR = VT; LAS unsigned char* BT = KR;
#pragma unroll
    for (int tbb = 0; tbb < 2; ++tbb)
#pragma unroll
        for (int tx = 0; tx < 2; ++tx) { f32x16 aa = zero16(), ab = zero16();
#pragma unroll
            for (int s = 0; s < 4; ++s) { aa = MFMA32(cfrag(w[s >> 1][tx], s & 1), kf[tbb][s], aa); ab = MFMA32(kf[tbb][s], cfrag(u[s >> 1][tx], s & 1), ab); }
#pragma unroll
            for (int g4 = 0; g4 < 4; ++g4) {
                const v2u pa = {pk2(-aa[4 * g4], -aa[4 * g4 + 1]), pk2(-aa[4 * g4 + 2], -aa[4 * g4 + 3])};
                *(LAS v2u*)(AR + (r32 + 32 * tbb) * (MP * 2) + (32 * tx + 8 * g4 + 4 * hi) * 2) = pa;
                const v2u pb = {pk2(ab[4 * g4], ab[4 * g4 + 1]), pk2(ab[4 * g4 + 2], ab[4 * g4 + 3])};
                *(LAS v2u*)(BT + (r32 + 32 * tx) * (MP * 2) + (32 * tbb + 8 * g4 + 4 * hi) * 2) = pb;
            } SB(); }
    LDS_WAIT();
    LAUNDER();
    { unsigned char* ab = F.ws + WS_AB + (size_t)inst * 16384; const int m16 = lane & 15, g = lane >> 4;
#pragma unroll
      for (int rb = 0; rb < 4; ++rb)
#pragma unroll
          for (int ks = 0; ks < 2; ++ks) { const v2u lo = *(const LAS v2u*)(AR + (16 * rb + m16) * (MP * 2) + (32 * ks + 4 * g) * 2), hi8 = *(const LAS v2u*)(AR + (16 * rb + m16) * (MP * 2) + (32 * ks + 16 + 4 * g) * 2);
              const v4u t = {lo.x, lo.y, hi8.x, hi8.y}; *(GAS v4u*)(ab + ((rb * 2 + ks) * 64 + lane) * 16) = t; }
#pragma unroll
      for (int sl = 0; sl < 4; ++sl)
#pragma unroll
          for (int rb = 0; rb < 4; ++rb) { const v2u t = *(const LAS v2u*)(BT + (16 * sl + m16) * (MP * 2) + (16 * rb + 4 * g) * 2); *(GAS v2u*)(ab + 8192 + ((sl * 4 + rb) * 64 + lane) * 8) = t; } }
    if (lane == 0) ((float*)(F.ws + WS_DEC))[inst] = __expf(gl);
    LDS_WAIT();
}
__device__ __forceinline__ void d1_phase(Frame& F, const int layer) {
    if (F.wave < 4) {
        LAS unsigned char* W = F.lds + RING_OFF + F.wave * WAVE_LDS; LAS float* tab = (LAS float*)(F.lds + RING_OFF + 4 * WAVE_LDS + F.wave * 1024);
        const int gw = F.vcu * 4 + F.wave, NGW = F.G * 4;
        for (int it = gw; it < NINST; it += NGW) { const int dir = it & 1, u = it >> 1; d1_instance(F, layer, u >> 10, (u >> 8) & 3, u & 255, dir, W, tab); }
    }
    __syncthreads();
}

typedef float f32x4v __attribute__((ext_vector_type(4)));
struct D2Regs { v4u af[4][2]; v2u bm[4]; float dcy; };
__device__ __forceinline__ void d2_chain(Frame& F, const int chain) {
    const int lane = F.lane, n16 = lane & 15, g = lane >> 4, sl = F.wave;
    f32x4v S[4];
#pragma unroll
    for (int rb = 0; rb < 4; ++rb) S[rb] = (f32x4v){0.f, 0.f, 0.f, 0.f};
    const unsigned char* abase = F.ws + WS_AB + (size_t)chain * NCHUNK * 16384;
    unsigned char* sbase = F.ws + WS_ST + (size_t)chain * NCHUNK * 8192;
    const float* dec = (const float*)(F.ws + WS_DEC) + chain * NCHUNK;
    D2Regs q0, q1, q2;
#define D2_LOAD(Q, n) do { const unsigned char* ab_ = abase + (size_t)(n) * 16384; \
    _Pragma("unroll") for (int rb = 0; rb < 4; ++rb) { _Pragma("unroll") for (int ks = 0; ks < 2; ++ks) Q.af[rb][ks] = *(const GAS v4u*)(ab_ + ((rb * 2 + ks) * 64 + lane) * 16); \
        Q.bm[rb] = *(const GAS v2u*)(ab_ + 8192 + ((sl * 4 + rb) * 64 + lane) * 8); } Q.dcy = dec[n]; } while (0)
#define D2_STEP(Q, n) do { \
    unsigned char* st = sbase + (size_t)(n) * 8192 + (16 * sl + n16) * 128; \
    _Pragma("unroll") for (int rb = 0; rb < 4; ++rb) { const v2u t = {pk2(S[rb][0], S[rb][1]), pk2(S[rb][2], S[rb][3])}; *(GAS v2u*)(st + (16 * rb + 4 * g) * 2) = t; } \
    bf16x8 bfr[2]; \
    _Pragma("unroll") for (int ks = 0; ks < 2; ++ks) { const v4u t = {att::cvtpk(S[2 * ks][0], S[2 * ks][1]), att::cvtpk(S[2 * ks][2], S[2 * ks][3]), att::cvtpk(S[2 * ks + 1][0], S[2 * ks + 1][1]), att::cvtpk(S[2 * ks + 1][2], S[2 * ks + 1][3])}; bfr[ks] = __builtin_bit_cast(bf16x8, t); } \
    _Pragma("unroll") for (int rb = 0; rb < 4; ++rb) { const float cd = Q.dcy; \
        f32x4v c = {S[rb][0] * cd + bflo(Q.bm[rb].x), S[rb][1] * cd + bfhi(Q.bm[rb].x), S[rb][2] * cd + bflo(Q.bm[rb].y), S[rb][3] * cd + bfhi(Q.bm[rb].y)}; \
        c = __builtin_amdgcn_mfma_f32_16x16x32_bf16(__builtin_bit_cast(bf16x8, Q.af[rb][0]), bfr[0], c, 0, 0, 0); \
        c = __builtin_amdgcn_mfma_f32_16x16x32_bf16(__builtin_bit_cast(bf16x8, Q.af[rb][1]), bfr[1], c, 0, 0, 0); \
        S[rb] = c; } } while (0)
    D2_LOAD(q0, 0); D2_LOAD(q1, 1);
    for (int n = 0; n < NCHUNK - 1; n += 3) {
        D2_LOAD(q2, n + 2); D2_STEP(q0, n); SB();
        D2_LOAD(q0, n + 3); D2_STEP(q1, n + 1); SB();
        if (n + 4 < NCHUNK) D2_LOAD(q1, n + 4); D2_STEP(q2, n + 2); SB();
    }
    D2_STEP(q0, NCHUNK - 1);
#undef D2_LOAD
#undef D2_STEP
}

__device__ __forceinline__ void scan_attn_phase(Frame& F, const int layer) {
    for (;;) {
        { unsigned char* w_ = F.ws; int t_ = F.tid; asm volatile("" : "+s"(w_), "+v"(t_)); F.ws = w_; F.ctl = (gu32*)(w_ + WS_CTL); F.tid = t_; F.lane = t_ & 63; }
        if (F.tid == 0) F.MISC[16] = __hip_atomic_fetch_add(F.ctl + CW_ATTQ + 64 * layer, 1u, RLX_AGENT);
        __syncthreads();
        const int idx = (int)F.MISC[16];
        __syncthreads();
        if (idx >= 16 + BATCH * 4 * 64) break;
#ifndef NO_D2
        if (idx < 16) { if (F.wave < 4) d2_chain(F, idx); }
        else
#endif
#ifndef NO_ATT
        { const int j = idx - 16, h = 3 - (j >> 7), jj = j & 127, b = jj & 1, k = jj >> 1, qb = (k & 1) ? 31 - (k >> 1) : 32 + (k >> 1);
            att::attn_unit(F, layer, b, h, qb); }
#else
        {}
#endif
    }
    __syncthreads();
}

__device__ __forceinline__ void d3_unit(Frame& F, const int layer, const int b, const int h, const int norig, LAS unsigned char* W, LAS float* tab) {
    int lane = F.lane, r32, hi; LAUNDER();
    const bf16* P = (const bf16*)(F.ws + WS_PROJ);
    const float* cwp = F.in[I_DCONVW] + (size_t)layer * 5 * 768;
    const int s0 = norig * 64, tok0 = b * SEQ + s0;
    LAS unsigned char* QR = W;
    LAS unsigned char* KR = W + MB;
    LAS unsigned char* ST = W + 2 * MB;
    LAS unsigned char* WR = W + 3 * MB;
    f32x16 of[2][2];
#pragma unroll
    for (int dir = 0; dir < 2; ++dir) {
        const int npr = dir ? 255 - norig : norig;
        const int inst = ((b * 4 + h) * 2 + dir) * NCHUNK + npr;
        DL_CONV(C_DQ + 64 * h, 64 * h, WR, { const float ss = wave_sum(val * val); const float qn = val * (0.125f / sqrtf(ss + EPS)); const int ip = dir ? 63 - i : i; *(LAS unsigned short*)(QR + ip * (MP * 2) + lane * 2) = (unsigned short)f2bf(qn); });
        DL_CONV(C_DK + 64 * h, 256 + 64 * h, WR, { const float ss = wave_sum(val * val); const float kn = val * (1.f / sqrtf(ss + EPS)); const int ip = dir ? 63 - i : i; *(LAS unsigned short*)(KR + ip * (MP * 2) + lane * 2) = (unsigned short)f2bf(kn); });
        const int mytok = tok0 + (dir ? 63 - lane : lane);
        float gc = ((const float*)(F.ws + WS_BD))[(size_t)mytok * 16 + 8 + dir * 4 + h];
#pragma unroll
        for (int o = 1; o < 64; o <<= 1) { const float t = __shfl_up(gc, o); if (lane >= o) gc += t; }
        tab[lane] = gc; tab[64 + lane] = __expf(gc);
        LAUNDER();
        { const unsigned char* sg = F.ws + WS_ST + (size_t)inst * 8192; const unsigned char* wg = F.ws + WS_UW + (size_t)inst * 16384 + 8192;
#pragma unroll
          for (int i = 0; i < 8; ++i) { const int idx = i * 64 + lane, row = idx >> 3, ch = idx & 7; const v4u a = *(const GAS v4u*)(sg + idx * 16), c = *(const GAS v4u*)(wg + idx * 16);
              *(LAS v4u*)(ST + row * (MP * 2) + ch * 16) = a; *(LAS v4u*)(WR + row * (MP * 2) + ch * 16) = c; } }
        LDS_WAIT();
        LAUNDER();
        f32x16 qk[2][2];
#pragma unroll
        for (int tb = 0; tb < 2; ++tb)
#pragma unroll
            for (int tn = 0; tn < 2; ++tn) { f32x16 acc = zero16();
#pragma unroll
                for (int ks = 0; ks < 4; ++ks) acc = MFMA32(ldfrag(QR, r32 + 32 * tb, 16 * ks + 8 * hi), ldfrag(KR, r32 + 32 * tn, 16 * ks + 8 * hi), acc);
                qk[tb][tn] = acc; SB(); }
        LDS_WAIT();
#pragma unroll
        for (int tb = 0; tb < 2; ++tb)
#pragma unroll
            for (int tn = 0; tn < 2; ++tn) { const int jc = r32 + 32 * tn; const float gcj = tab[jc];
#pragma unroll
                for (int r = 0; r < 16; ++r) { const int ir = 32 * tb + crow(r, hi); const float gci = tab[ir];
                    const float av = (ir >= jc) ? qk[tb][tn][r] * __expf(gci - gcj) : 0.f; *(LAS unsigned short*)(KR + ir * (MP * 2) + jc * 2) = (unsigned short)f2bf(av); } SB(); }
        LDS_WAIT();
        LAUNDER();
        const unsigned* ud = (const unsigned*)(F.ws + WS_UW + (size_t)inst * 16384);
#pragma unroll
        for (int tn = 0; tn < 2; ++tn) {
            bf16x8 sf[4];
#pragma unroll
            for (int ks = 0; ks < 4; ++ks) sf[ks] = ldfrag(ST, r32 + 32 * tn, 16 * ks + 8 * hi);
            f32x16 vn[2], o[2];
#pragma unroll
            for (int tb = 0; tb < 2; ++tb) { f32x16 a1 = zero16(), a2 = zero16();
#pragma unroll
                for (int ks = 0; ks < 4; ++ks) { a1 = MFMA32(ldfrag(WR, r32 + 32 * tb, 16 * ks + 8 * hi), sf[ks], a1); a2 = MFMA32(ldfrag(QR, r32 + 32 * tb, 16 * ks + 8 * hi), sf[ks], a2); }
#pragma unroll
                for (int rp = 0; rp < 8; ++rp) { const unsigned uw = ud[((tb * 2 + tn) * 8 + rp) * 64 + lane]; a1[2 * rp] = bflo(uw) - a1[2 * rp]; a1[2 * rp + 1] = bfhi(uw) - a1[2 * rp + 1]; }
#pragma unroll
                for (int r = 0; r < 16; ++r) a2[r] *= tab[64 + 32 * tb + crow(r, hi)];
                vn[tb] = a1; o[tb] = a2; SB(); }
#pragma unroll
            for (int tb = 0; tb < 2; ++tb) { f32x16 acc = o[tb];
#pragma unroll
                for (int s = 0; s < 4; ++s) acc = MFMA32(ldfragp(KR, r32 + 32 * tb, 16 * s + 4 * hi), cfrag(vn[s >> 1], s & 1), acc);
                o[tb] = acc; SB(); }
            if (dir == 0) { of[0][tn] = o[0]; of[1][tn] = o[1]; }
            else {
#pragma unroll
                for (int tb = 0; tb < 2; ++tb)
#pragma unroll
                    for (int r = 0; r < 16; ++r) of[tb][tn][r] += __shfl_xor(o[1 - tb][15 - r], 32);
            }
        }
        LDS_WAIT();
    }
    LAUNDER();
    const float* dn = F.in[I_DNORM] + layer * 64;
#pragma unroll
    for (int tb = 0; tb < 2; ++tb)
#pragma unroll
        for (int r = 0; r < 16; ++r) {
            float ss = of[tb][0][r] * of[tb][0][r] + of[tb][1][r] * of[tb][1][r];
#pragma unroll
            for (int o = 1; o < 32; o <<= 1) ss += __shfl_xor(ss, o);
            const float rs = 1.f / sqrtf(ss * (1.f / 64.f) + EPS);
            const int tok = tok0 + 32 * tb + crow(r, hi);
#pragma unroll
            for (int tn = 0; tn < 2; ++tn) { const int dv = r32 + 32 * tn; const float z = bf2f(P[(size_t)tok * PJ + C_DZ + 64 * h + dv]);
                ((bf16*)(F.ws + WS_O4))[(size_t)tok * 1024 + 768 + 64 * h + dv] = (bf16)f2bf(of[tb][tn][r] * rs * dn[dv] * siluf_(z)); }
        }
}
__device__ __forceinline__ void d3_phase(Frame& F, const int layer) {
    if (F.wave < 4) {
        LAS unsigned char* W = F.lds + RING_OFF + F.wave * WAVE_LDS; LAS float* tab = (LAS float*)(F.lds + RING_OFF + 4 * WAVE_LDS + F.wave * 1024);
        const int gw = F.vcu * 4 + F.wave, NGW = F.G * 4;
        for (int u = gw; u < BATCH * 4 * NCHUNK; u += NGW) d3_unit(F, layer, u >> 10, (u >> 8) & 3, u & 255, W, tab);
    }
    __syncthreads();
}
#undef MFMA32
}

#ifndef ONLY_SITE
#define ONLY_SITE -1
#endif
#define SITE(k) (ONLY_SITE < 0 || ONLY_SITE == (k))
#ifndef PROBE_MASK
#define PROBE_MASK 0
#endif
#ifndef PROBE_N
#define PROBE_N 2
#endif
#define REPEAT(k) for (int rep_ = 0; rep_ < (((PROBE_MASK >> (k)) & 1) ? PROBE_N : 1); ++rep_)
#ifndef MK_SPLIT
#define MK_SPLIT 0
#endif
struct Args { const float* in[30]; float* out; unsigned char* ws; int ph_lo, ph_hi; };
constexpr int N_PHASES = 1 + 16 * NLAYER + 1;

#define IN_PH() (pid >= lo && pid < hi)
#define FRESH() do { unsigned char* w_ = args.ws; float* o_ = args.out; int t_ = threadIdx.x; asm volatile("" : "+s"(w_), "+s"(o_), "+v"(t_)); F.ws = w_; F.out = o_; F.ctl = (gu32*)(w_ + WS_CTL); F.tid = t_; F.lane = t_ & 63; } while (0)
#define SEAM() do { if (!MK_SPLIT && pid >= lo && pid + 1 < hi) xcd_barrier(bar); ++pid; } while (0)
#define NOSEAM() do { ++pid; } while (0)

template <int l> __device__ __forceinline__ void layer_phases(Frame& F, const Args& args, const XcdBarrier& bar, const int lo, const int hi, int& pid) {
    LAS unsigned char* ring = F.lds + RING_OFF;

        if (IN_PH() && l == 0 && SITE(1)) { FRESH(); p_rows<ROW_A>(F, 0); }
        SEAM();
        if (IN_PH() && SITE(2)) REPEAT(2) { FRESH();
            pg8::SchedStd S; S.init(NTOK / 256, NPROJ / 256, F.G, (int)blockIdx.x, F.ws + WS_H, (size_t)256 * D * 2, w_in_t(F.ws, l), (size_t)256 * D * 2);
            pg8::EpiProj E{(bf16*)(F.ws + WS_QB), (bf16*)(F.ws + WS_KV), (bf16*)(F.ws + WS_PROJ), (unsigned*)(F.ctl + CW_NMAX) + l * 16, QSCALE};
            pg8::gemm_phase<pg8::EpiProj, pg8::SchedStd, D, D, D>(ring, F.tid, S, E);
        }
        SEAM();
        if (IN_PH() && SITE(4)) REPEAT(4) { FRESH(); pc::poolconv_phase(F, l); }
        NOSEAM();
        if (IN_PH() && SITE(5)) REPEAT(5) { FRESH(); dl::d1_phase(F, l); }
        SEAM();
        if (IN_PH() && SITE(3)) REPEAT(3) { FRESH(); dl::scan_attn_phase(F, l); }
        SEAM();
        NOSEAM();
        if (IN_PH() && SITE(7)) REPEAT(7) { FRESH(); dl::d3_phase(F, l); }
        SEAM();
        if (IN_PH() && SITE(8)) REPEAT(8) { FRESH();
            pg8::SchedBranch S; S.s.init(NTOK / 256, 16, F.G, (int)blockIdx.x, nullptr, 0, nullptr, 0); S.O4 = (const char*)(F.ws + WS_O4); S.Wb = (const char*)w_b_t(F.ws, l);
            pg8::EpiStore E{(bf16*)(F.ws + WS_PBUF), 1024, (size_t)NTOK * 1024, 1.f};
            pg8::gemm_phase<pg8::EpiStore, pg8::SchedBranch, 256, 1024, 256>(ring, F.tid, S, E);
        }
        SEAM();
        if (IN_PH() && SITE(9)) REPEAT(9) { FRESH();
            pg8::SchedGate S{F.vcu, F.G, (const char*)(F.ws + WS_H), (const char*)w_m_t(F.ws, l)};
            pg8::EpiGate E{(const bf16*)(F.ws + WS_PBUF), (bf16*)(F.ws + WS_MERGED), F.in[I_BMERGE] + (size_t)l * 4 * D};
            pg8::gemm_phase<pg8::EpiGate, pg8::SchedGate, D, D, D>(ring, F.tid, S, E);
        }
        SEAM();
        if (IN_PH() && SITE(10)) REPEAT(10) { FRESH();
            pg8::SchedStd S; S.init(NTOK / 256, D / 256, F.G, (int)blockIdx.x, F.ws + WS_MERGED, (size_t)256 * D * 2, w_o_t(F.ws, l), (size_t)256 * D * 2);
            pg8::EpiStore E{(bf16*)(F.ws + WS_F), D, 0, 1.f};
            pg8::gemm_phase<pg8::EpiStore, pg8::SchedStd, D, D, D>(ring, F.tid, S, E);
        }
        SEAM();
        if (IN_PH() && SITE(11)) REPEAT(11) { FRESH(); p_rows<ROW_B>(F, l); }
        SEAM();
        if constexpr (l == 0) {
            if (IN_PH() && SITE(12)) REPEAT(12) { FRESH();
                pg8::SchedStd S; S.init(NTOK / 256, 2 * DFF / 256, F.G, (int)blockIdx.x, F.ws + WS_H, (size_t)256 * D * 2, F.ws + WS_WFFN, (size_t)256 * D * 2);
                pg8::EpiSwiGLU E{(bf16*)(F.ws + WS_ACT0), DFF};
                pg8::gemm_phase<pg8::EpiSwiGLU, pg8::SchedStd, D, D, D>(ring, F.tid, S, E);
            }
            SEAM();
            if (IN_PH() && SITE(13)) REPEAT(13) { FRESH();
                pg8::SchedStd S; S.init(NTOK / 256, D / 256, F.G, (int)blockIdx.x, F.ws + WS_ACT0, (size_t)256 * DFF * 2, F.ws + WS_WFFN + SZ_WGU, (size_t)256 * DFF * 2);
                pg8::EpiStore E{(bf16*)(F.ws + WS_F), D, 0, 1.f};
                pg8::gemm_phase<pg8::EpiStore, pg8::SchedStd, DFF, DFF, DFF>(ring, F.tid, S, E);
            }
            SEAM();
            if (IN_PH() && SITE(14)) REPEAT(14) { FRESH(); p_rows<ROW_C>(F, 0); }
            SEAM();
            NOSEAM(); NOSEAM();
        } else {
            if (IN_PH() && SITE(15)) REPEAT(15) { FRESH(); p_moe_cvt(F); }
            SEAM();
#pragma unroll 1
            for (int pass = 0; pass < 2; ++pass) {
                if (IN_PH() && SITE(16)) REPEAT(16) { FRESH();
                    pg8::SchedMoe S; S.c = (int)blockIdx.x; S.G = F.G; S.nN = 2 * DFF / 256; moe_tiles(F, S.cnt, S.tstart);
                    S.t0 = pass * MOE_PASS_TILES; S.t1 = S.tstart[8] < (pass + 1) * MOE_PASS_TILES ? S.tstart[8] : (pass + 1) * MOE_PASS_TILES;
                    S.A = (const char*)(F.ws + WS_H2B); S.lists = (const int*)(F.ws + WS_ROUTE + 1 * MiB); S.W = (const char*)(F.ws + WS_MOEW); S.w_tile = (size_t)256 * D * 2; S.gather = true;
                    pg8::EpiSwiGLU E{(bf16*)(F.ws + WS_ACT1), DFF};
                    pg8::gemm_phase<pg8::EpiSwiGLU, pg8::SchedMoe, D, D, D, true>(ring, F.tid, S, E);
                }
                SEAM();
                if (IN_PH() && SITE(17)) REPEAT(17) { FRESH();
                    pg8::SchedMoe S; S.c = (int)blockIdx.x; S.G = F.G; S.nN = D / 256; moe_tiles(F, S.cnt, S.tstart);
                    S.t0 = pass * MOE_PASS_TILES; S.t1 = S.tstart[8] < (pass + 1) * MOE_PASS_TILES ? S.tstart[8] : (pass + 1) * MOE_PASS_TILES;
                    S.A = (const char*)(F.ws + WS_ACT1); S.lists = nullptr; S.W = (const char*)(F.ws + WS_MOEW + SZ_WGU); S.w_tile = (size_t)256 * DFF * 2; S.gather = false;
                    pg8::EpiStore E{(bf16*)(F.ws + WS_Y), D, 0, 1.f};
                    pg8::gemm_phase<pg8::EpiStore, pg8::SchedMoe, DFF, DFF, DFF>(ring, F.tid, S, E);
                }
                SEAM();
            }
        }
    }

__global__ void __launch_bounds__(NWAVES * 64, 2) fwd_kernel(const Args args) {
    extern __shared__ __attribute__((aligned(16))) unsigned char lds[];
    Frame F;
    F.lds = (LAS unsigned char*)lds;
    F.MISC = (volatile LAS unsigned*)(F.lds + MISC_OFF);
    F.tid = threadIdx.x; F.lane = F.tid & 63; F.wave = __builtin_amdgcn_readfirstlane(F.tid >> 6);
    F.G = gridDim.x; { const int bx = blockIdx.x; F.vcu = (F.G % 8 == 0) ? (bx % 8) * (F.G / 8) + bx / 8 : bx; }
    F.ws = args.ws; F.out = args.out; F.ctl = (gu32*)(args.ws + WS_CTL);
    F.in = args.in;
    if (F.tid < 64) ((LAS unsigned*)(F.lds + MISC_OFF))[F.tid] = 0u;
    __syncthreads();
    XcdBarrier bar; bar.bar = (unsigned*)(F.ctl + CW_BAR); bar.x = 0; bar.st = nullptr;
    if (!MK_SPLIT) bar = xcd_barrier_post((unsigned*)(F.ctl + CW_BAR), F.MISC + 8);
    const int lo = args.ph_lo, hi = args.ph_hi;
    int pid = 0;
    LAS unsigned char* ring = F.lds + RING_OFF;

    if (IN_PH() && SITE(0)) REPEAT(0) { FRESH(); p_prologue(F); }
    SEAM();
    layer_phases<0>(F, args, bar, lo, hi, pid);
    layer_phases<1>(F, args, bar, lo, hi, pid);
    if (IN_PH() && SITE(18)) REPEAT(18) { FRESH(); p_rows<ROW_C>(F, 1); }
#undef IN_PH
#undef SEAM
#undef NOSEAM
}

extern "C" void kernel_launch(void* const* d_in, const int* in_sizes, int n_in, void* d_out, int out_size, void* d_ws, size_t ws_size, hipStream_t stream) {
    static int grid = 0;
    if (grid == 0) {
        if (n_in != N_INPUTS || in_sizes[0] != NTOK * D || out_size != NTOK * D || ws_size < WS_END) {
            fprintf(stderr, "kernel_launch: unexpected problem (n_in %d, in0 %d, out %d, ws %zu < %zu); nothing launched\n", n_in, n_in > 0 ? in_sizes[0] : -1, out_size, ws_size, (size_t)WS_END); grid = -1; return; }
        int dev = 0, cus = 0, per_cu = 0;
        if (hipGetDevice(&dev) != hipSuccess || hipDeviceGetAttribute(&cus, hipDeviceAttributeMultiprocessorCount, dev) != hipSuccess) { grid = -1; return; }
        if (hipFuncSetAttribute((const void*)fwd_kernel, hipFuncAttributeMaxDynamicSharedMemorySize, LDS_BYTES) != hipSuccess) { fprintf(stderr, "kernel_launch: hipFuncSetAttribute failed\n"); grid = -1; return; }
        if (hipOccupancyMaxActiveBlocksPerMultiprocessor(&per_cu, (const void*)fwd_kernel, NWAVES * 64, LDS_BYTES) != hipSuccess || per_cu < 1)
            fprintf(stderr, "kernel_launch: note: occupancy query reports %d workgroups per CU\n", per_cu);
        (void)hipGetLastError();
        grid = cus;
    }
    if (grid < 0) return;
    if (hipMemsetAsync((char*)d_ws + WS_CTL, 0, CTL_ZERO_BYTES, stream) != hipSuccess) return;
    Args a{};
    for (int i = 0; i < 30; ++i) a.in[i] = (const float*)d_in[i];
    a.out = (float*)d_out; a.ws = (unsigned char*)d_ws;
#if MK_SPLIT
    for (int p = 0; p < N_PHASES; ++p) { a.ph_lo = p; a.ph_hi = p + 1; hipLaunchKernelGGL(fwd_kernel, dim3(grid), dim3(NWAVES * 64), LDS_BYTES, stream, a); }
#else
    a.ph_lo = 0; a.ph_hi = N_PHASES;
    hipLaunchKernelGGL(fwd_kernel, dim3(grid), dim3(NWAVES * 64), LDS_BYTES, stream, a);
#endif
}
```

```cpp
#include <hip/hip_runtime.h>
#include <cstdio>
#include <cstdint>

namespace pg8 {
#define PG8_LAS __attribute__((address_space(3)))
typedef unsigned short bf16_t;
typedef short bf16x8 __attribute__((ext_vector_type(8)));
typedef float f32x4 __attribute__((ext_vector_type(4)));
typedef unsigned u32x4 __attribute__((ext_vector_type(4)));
typedef unsigned u32x2 __attribute__((ext_vector_type(2)));
constexpr int BM = 256, BK = 64, HALF = 128, HTB = HALF * BK * 2  , STAGE_BYTES = 8 * HTB;

__host__ __device__ __forceinline__ int lds_byte(int r, int c) { const int st = (r >> 4) * 2 + (c >> 5), rr = r & 15, cc = c & 31, ob = rr * 64 + cc * 2; return st * 1024 + (ob ^ (((ob >> 9) & 1) << 5)); }
__host__ __device__ __forceinline__ void stage_rc(int b, int& R, int& C) { const int st = b / 1024, sb = b % 1024, swz = sb ^ (((sb >> 9) & 1) << 5); R = (st >> 1) * 16 + swz / 64; C = (st & 1) * 32 + (swz % 64) / 2; }
__host__ __device__ __forceinline__ int perm32(int rho) { const int n = rho >> 4, i = rho & 15; return 8 * (i >> 2) + 4 * n + (i & 3); }

struct Unit { int pm, pn, aux, pad; const char* a; const char* b; const int* rows; };

__device__ __forceinline__ unsigned cvt_pk_bf16(float lo, float hi) { unsigned r; asm volatile("v_cvt_pk_bf16_f32 %0, %1, %2" : "=v"(r) : "v"(lo), "v"(hi)); return r; }


template <class Epi, class Sched, int K, int lda, int ldb, bool GATHER = false, bool ALIGN_EPI = true, bool SP2 = true>
__device__ __forceinline__ void gemm_phase(PG8_LAS unsigned char* lds, const int tid, const Sched& S, const Epi& E) {
    const int wid = __builtin_amdgcn_readfirstlane(tid >> 6), lane = tid & 63, wr = wid >> 2, wc = wid & 3, fr = lane & 15, fq = lane >> 4;
    constexpr int nt = K / BK;
    int Rs[2], Cs[2]; unsigned voffB[2];
#pragma unroll
    for (int i = 0; i < 2; ++i) { int R, C; stage_rc(tid * 16 + i * 8192, R, C); const int Rb = Epi::PERM ? ((R & ~31) + perm32(R & 31)) : R; Rs[i] = R; Cs[i] = C; voffB[i] = (unsigned)(Rb * ldb + C) * 2u; }
    const size_t kstep = (size_t)(BK * 2);
    const size_t hstepB = (size_t)HALF * ldb * 2;
    const unsigned ldsw = (unsigned)wid * 1024u;
    const int aoff = lds_byte(wr * 64 + fr, fq * 8), boff = lds_byte(wc * 32 + fr, fq * 8);
#define PG8_SA(b, h) (((b) * 2 + (h)) * HTB)
#define PG8_SB(b, h) ((4 + (b) * 2 + (h)) * HTB)
#define PG8_STAGE(bufoff, gbase, voff) do { _Pragma("unroll") for (int _i = 0; _i < 2; ++_i) \
        __builtin_amdgcn_global_load_lds((const unsigned*)((const char*)(gbase) + (voff)[_i]), (PG8_LAS unsigned*)(lds + (bufoff) + ldsw + _i * 8192), 16, 0, 0); } while (0)
#define PG8_LDA(dst, b, h) do { _Pragma("unroll") for (int m = 0; m < 4; ++m) _Pragma("unroll") for (int k = 0; k < 2; ++k) dst[m][k] = *(const PG8_LAS bf16x8*)(lds + PG8_SA(b, h) + aoff + m * 2048 + k * 1024); } while (0)
#define PG8_LDB(dst, b, h) do { _Pragma("unroll") for (int n = 0; n < 2; ++n) _Pragma("unroll") for (int k = 0; k < 2; ++k) dst[n][k] = *(const PG8_LAS bf16x8*)(lds + PG8_SB(b, h) + boff + n * 2048 + k * 1024); } while (0)
#define PG8_MMA(ai, bj, At, Bt) do { __builtin_amdgcn_s_setprio(1); _Pragma("unroll") for (int m = 0; m < 4; ++m) _Pragma("unroll") for (int n = 0; n < 2; ++n) _Pragma("unroll") for (int k = 0; k < 2; ++k) \
        acc[ai][bj][m][n] = __builtin_amdgcn_mfma_f32_16x16x32_bf16(Bt[n][k], At[m][k], acc[ai][bj][m][n], 0, 0, 0); __builtin_amdgcn_s_setprio(0); } while (0)
#define PG8_WAIT_V(n) asm volatile("s_waitcnt vmcnt(" #n ")" ::: "memory")
#define PG8_WAIT_L(n) asm volatile("s_waitcnt lgkmcnt(" #n ")" ::: "memory")
#define PG8_BAR __builtin_amdgcn_s_barrier()
#define PG8_SCHED __builtin_amdgcn_sched_barrier(0)
    Unit cur, nxt; int ui = 0;
    if (!S.next(0, cur)) return;
    f32x4 acc[2][2][4][2];
#pragma unroll
    for (int a = 0; a < 2; ++a)
#pragma unroll
        for (int b = 0; b < 2; ++b)
#pragma unroll
            for (int m = 0; m < 4; ++m)
#pragma unroll
                for (int n = 0; n < 2; ++n) acc[a][b][m][n] = (f32x4){0.f, 0.f, 0.f, 0.f};
    bf16x8 At[4][2], B0[2][2], B1[2][2];
    unsigned cOff[2][2], nOff[2][2];
#pragma unroll
    for (int hh = 0; hh < 2; ++hh)
#pragma unroll
        for (int i = 0; i < 2; ++i) {
            if constexpr (GATHER) { const int ridx = hh * HALF + Rs[i]; int tk = cur.rows[ridx]; tk = ridx < cur.aux ? tk : 0; cOff[hh][i] = (unsigned)(tk * lda + Cs[i]) * 2u; }
            else cOff[hh][i] = (unsigned)((hh * HALF + Rs[i]) * lda + Cs[i]) * 2u;
            if constexpr (GATHER) nOff[hh][i] = cOff[hh][i]; else nOff[hh][i] = 0u;
        }
    const char* cA = cur.a; const char* cB = cur.b;
    S.a_ready(cur);
    if constexpr (SP2) {
        PG8_STAGE(PG8_SB(0, 0), cB, voffB); PG8_STAGE(PG8_SB(0, 1), cB + hstepB, voffB); PG8_STAGE(PG8_SA(0, 0), cA, cOff[0]); PG8_STAGE(PG8_SA(0, 1), cA, cOff[1]);
        if (wr == 1) PG8_BAR;
        PG8_WAIT_V(2); PG8_BAR;
        PG8_STAGE(PG8_SB(1, 0), cB + kstep, voffB); PG8_STAGE(PG8_SA(1, 0), cA + kstep, cOff[0]); PG8_STAGE(PG8_SB(1, 1), cB + hstepB + kstep, voffB);
        PG8_WAIT_V(6); PG8_BAR;
    } else {
        PG8_STAGE(PG8_SB(0, 0), cB, voffB); PG8_STAGE(PG8_SA(0, 0), cA, cOff[0]); PG8_STAGE(PG8_SB(0, 1), cB + hstepB, voffB); PG8_STAGE(PG8_SA(0, 1), cA, cOff[1]);
        if (wr == 1) PG8_BAR;
        PG8_WAIT_V(4); PG8_BAR;
        PG8_STAGE(PG8_SB(1, 0), cB + kstep, voffB); PG8_STAGE(PG8_SA(1, 0), cA + kstep, cOff[0]); PG8_STAGE(PG8_SB(1, 1), cB + hstepB + kstep, voffB);
        PG8_WAIT_V(6); PG8_BAR;
    }
    for (;;) {
        const bool has_next = S.next(ui + 1, nxt);
        const char* nA = has_next ? nxt.a : cA; const char* nB = has_next ? nxt.b : cB;
        if constexpr (GATHER) {
            if (has_next) {
#pragma unroll
                for (int hh = 0; hh < 2; ++hh)
#pragma unroll
                    for (int i = 0; i < 2; ++i) { const int ridx = hh * HALF + Rs[i]; int tk = nxt.rows[ridx]; tk = ridx < nxt.aux ? tk : 0; nOff[hh][i] = (unsigned)(tk * lda + Cs[i]) * 2u; }
            } else {
#pragma unroll
                for (int hh = 0; hh < 2; ++hh)
#pragma unroll
                    for (int i = 0; i < 2; ++i) nOff[hh][i] = cOff[hh][i];
            }
        }
#pragma unroll 1
        for (int t = 0; t < nt; t += 2) {
            const bool last = (t == nt - 2);
            const char* a1 = cA + (size_t)(t + 1) * kstep;
            const char* a2 = last ? nA : cA + (size_t)(t + 2) * kstep; const char* b2 = last ? nB : cB + (size_t)(t + 2) * kstep;
            const char* a3 = a2 + kstep; const char* b3 = b2 + kstep;
            unsigned o2[2][2];
#pragma unroll
            for (int hh = 0; hh < 2; ++hh)
#pragma unroll
                for (int i = 0; i < 2; ++i) { if constexpr (GATHER) o2[hh][i] = last ? nOff[hh][i] : cOff[hh][i]; else o2[hh][i] = cOff[hh][i]; }
            if (last && has_next) S.a_ready(nxt);
            if constexpr (SP2) {
            PG8_LDB(B0, 0, 0); PG8_LDB(B1, 0, 1); PG8_SCHED; PG8_LDA(At, 0, 0); PG8_STAGE(PG8_SA(1, 1), a1, cOff[1]);
            PG8_WAIT_V(8); PG8_WAIT_L(0); PG8_BAR; PG8_MMA(0, 0, At, B0); PG8_MMA(0, 1, At, B1); PG8_BAR; PG8_SCHED;
            PG8_LDA(At, 0, 1); PG8_STAGE(PG8_SB(0, 0), b2, voffB); PG8_STAGE(PG8_SB(0, 1), b2 + hstepB, voffB); PG8_STAGE(PG8_SA(0, 0), a2, o2[0]);
            PG8_WAIT_V(8); PG8_WAIT_L(0); PG8_BAR; PG8_MMA(1, 0, At, B0); PG8_MMA(1, 1, At, B1); PG8_BAR; PG8_SCHED;
            PG8_LDB(B0, 1, 0); PG8_LDB(B1, 1, 1); PG8_SCHED; PG8_LDA(At, 1, 0); PG8_STAGE(PG8_SA(0, 1), a2, o2[1]);
            PG8_WAIT_V(8); PG8_WAIT_L(0); PG8_BAR; PG8_MMA(0, 0, At, B0); PG8_MMA(0, 1, At, B1); PG8_BAR; PG8_SCHED;
            PG8_LDA(At, 1, 1); PG8_STAGE(PG8_SB(1, 0), b3, voffB); PG8_STAGE(PG8_SB(1, 1), b3 + hstepB, voffB); PG8_STAGE(PG8_SA(1, 0), a3, o2[0]);
            PG8_WAIT_V(8); PG8_WAIT_L(0); PG8_BAR; PG8_MMA(1, 0, At, B0); PG8_MMA(1, 1, At, B1); PG8_BAR; PG8_SCHED;
            } else {
            PG8_LDB(B0, 0, 0); PG8_SCHED; PG8_LDA(At, 0, 0); PG8_STAGE(PG8_SA(1, 1), a1, cOff[1]);
            PG8_WAIT_L(8); PG8_BAR; PG8_WAIT_L(0); PG8_MMA(0, 0, At, B0); PG8_BAR; PG8_SCHED;
            PG8_LDB(B1, 0, 1); PG8_STAGE(PG8_SB(0, 0), b2, voffB);
            PG8_BAR; PG8_WAIT_L(0); PG8_MMA(0, 1, At, B1); PG8_BAR;
            PG8_LDA(At, 0, 1); PG8_STAGE(PG8_SA(0, 0), a2, o2[0]);
            PG8_BAR; PG8_WAIT_L(0); PG8_MMA(1, 0, At, B0); PG8_BAR; PG8_SCHED;
            PG8_STAGE(PG8_SB(0, 1), b2 + hstepB, voffB);
            PG8_WAIT_V(6); PG8_BAR; PG8_MMA(1, 1, At, B1); PG8_BAR;
            PG8_LDB(B0, 1, 0); PG8_SCHED; PG8_LDA(At, 1, 0); PG8_STAGE(PG8_SA(0, 1), a2, o2[1]);
            PG8_WAIT_L(8); PG8_BAR; PG8_WAIT_L(0); PG8_MMA(0, 0, At, B0); PG8_BAR; PG8_SCHED;
            PG8_LDB(B1, 1, 1); PG8_STAGE(PG8_SB(1, 0), b3, voffB);
            PG8_BAR; PG8_WAIT_L(0); PG8_MMA(0, 1, At, B1); PG8_BAR;
            PG8_LDA(At, 1, 1); PG8_STAGE(PG8_SA(1, 0), a3, o2[0]);
            PG8_BAR; PG8_WAIT_L(0); PG8_MMA(1, 0, At, B0); PG8_BAR; PG8_SCHED;
            PG8_STAGE(PG8_SB(1, 1), b3 + hstepB, voffB);
            PG8_WAIT_V(6); PG8_BAR; PG8_MMA(1, 1, At, B1); PG8_BAR;
            }
        }
        if constexpr (ALIGN_EPI) { if (wr == 0) PG8_BAR; }
        E(acc, cur, wr, wc, fr, fq); S.done(cur);
        if (!has_next) break;
#pragma unroll
        for (int a = 0; a < 2; ++a)
#pragma unroll
            for (int b = 0; b < 2; ++b)
#pragma unroll
                for (int m = 0; m < 4; ++m)
#pragma unroll
                    for (int n = 0; n < 2; ++n) acc[a][b][m][n] = (f32x4){0.f, 0.f, 0.f, 0.f};
        cur = nxt; cA = nA; cB = nB; ++ui;
        if constexpr (GATHER) {
#pragma unroll
            for (int hh = 0; hh < 2; ++hh)
#pragma unroll
                for (int i = 0; i < 2; ++i) cOff[hh][i] = nOff[hh][i];
        }
        if constexpr (ALIGN_EPI) { if (wr == 1) PG8_BAR; }
    }
    PG8_WAIT_V(0);
    if constexpr (!ALIGN_EPI) { if (wr == 0) PG8_BAR; }
    PG8_BAR;
#undef PG8_SA
#undef PG8_SB
#undef PG8_STAGE
#undef PG8_LDA
#undef PG8_LDB
#undef PG8_MMA
#undef PG8_WAIT_V
#undef PG8_WAIT_L
#undef PG8_BAR
#undef PG8_SCHED
}
}

constexpr int NWAVES = 8;
constexpr int BATCH = 2, SEQ = 16384, D = 1024, NTOK = BATCH * SEQ;
constexpr int NLAYER = 2;
constexpr int NPROJ = 2816, IN_COLS = 2832;
constexpr int PJ = 2048;
constexpr int C_PIN = 0, C_CB = 256, C_CC = 512, C_CX = 768, C_DQ = 1024, C_DK = 1280, C_DV = 1536, C_DZ = 1792;
constexpr int DFF = 2816, NEXP = 8;
constexpr int NCHUNK = SEQ / 64;
constexpr int NINST = BATCH * 4 * 2 * NCHUNK;
constexpr float EPS = 1e-6f;
constexpr float QSCALE = 0.17677669529663687f * 1.4426950408889634f;
constexpr int MOE_PASS_TILES = 132;

constexpr size_t MiB = 1u << 20;
constexpr size_t WS_CTL = 0, CTL_ZERO_BYTES = 1 * MiB;
constexpr size_t SZ_WIN = (size_t)NPROJ * D * 2, SZ_WM = (size_t)4096 * D * 2, SZ_WB = (size_t)4 * 1024 * 256 * 2, SZ_WO = (size_t)D * D * 2;
constexpr size_t SZ_LAYERW = SZ_WIN + SZ_WM + SZ_WB + SZ_WO;
constexpr size_t SZ_WGU = (size_t)2 * DFF * D * 2, SZ_WD = (size_t)D * DFF * 2, SZ_FFNW = SZ_WGU + SZ_WD;
constexpr size_t WS_W = 1 * MiB;
constexpr size_t WS_WFFN = WS_W + 2 * SZ_LAYERW;
static_assert(WS_WFFN + SZ_FFNW <= 53 * MiB, "weights");
constexpr size_t WS_H = 53 * MiB;
constexpr size_t WS_O4 = 117 * MiB;
constexpr size_t WS_F = WS_O4;
constexpr size_t WS_BD = 181 * MiB;
constexpr size_t WS_DEC = 183 * MiB;
constexpr size_t WS_PROJ = 185 * MiB;
constexpr size_t WS_QB = 521 * MiB;
constexpr size_t WS_KV = 313 * MiB;
constexpr size_t WS_UW = 361 * MiB;
constexpr size_t WS_AB = 425 * MiB;
constexpr size_t WS_ST = 489 * MiB;
constexpr size_t WS_PBUF = 185 * MiB;
constexpr size_t WS_MERGED = 441 * MiB;
constexpr size_t WS_ACT0 = 185 * MiB;
constexpr size_t WS_H2B = 479 * MiB;
constexpr size_t WS_MOEW = 185 * MiB;
constexpr size_t WS_ACT1 = 1 * MiB;
constexpr size_t WS_Y = 317 * MiB;
constexpr size_t WS_ROUTE = 449 * MiB;
constexpr size_t WS_END = 543 * MiB;
static_assert(WS_ACT1 + (size_t)MOE_PASS_TILES * 256 * DFF * 2 <= WS_MOEW, "act1");
static_assert(WS_MOEW + 8 * SZ_FFNW <= WS_Y && WS_Y + (size_t)264 * 256 * D * 2 <= WS_ROUTE && WS_ROUTE + 4 * MiB <= WS_H2B && WS_H2B + 64 * MiB <= WS_END, "moe map");
static_assert(WS_PROJ + (size_t)NTOK * PJ * 2 <= WS_KV && WS_KV + (size_t)8 * 256 * 19456 <= WS_UW && WS_QB + 16 * MiB <= WS_END && WS_ST + (size_t)NINST * 8192 <= WS_END, "mixer map");
constexpr int CW_TMO = 0, CW_CODE = 1;
constexpr int CW_BAR = 4096;
constexpr int CW_MOD = 16384;
constexpr int CW_MOECNT = 65536;
constexpr int CW_NMAX = 66560;
constexpr int CW_ATTQ = 66688;
static_assert(CW_MOD + NLAYER * BATCH * 6 * D <= CW_MOECNT && (CW_ATTQ + 32 * 64) * 4 <= (int)CTL_ZERO_BYTES, "ctl");

constexpr int RING_OFF = 0, RING_BYTES = 131072;
constexpr int LDS_BYTES = 160 * 1024;
constexpr int MISC_OFF = LDS_BYTES - 256;

#define GAS __attribute__((address_space(1)))
#define LAS __attribute__((address_space(3)))
typedef unsigned short bf16;
typedef unsigned v4u __attribute__((ext_vector_type(4)));
typedef unsigned v2u __attribute__((ext_vector_type(2)));
typedef float f32x4 __attribute__((ext_vector_type(4)));
typedef float f32x16 __attribute__((ext_vector_type(16)));
typedef short bf16x8 __attribute__((ext_vector_type(8)));
typedef short bf16x4 __attribute__((ext_vector_type(4)));
typedef GAS unsigned gu32;
#define RLX_AGENT __ATOMIC_RELAXED, __HIP_MEMORY_SCOPE_AGENT
#define LDS_WAIT() asm volatile("s_waitcnt lgkmcnt(0)" ::: "memory")
#define VM_WAIT() asm volatile("s_waitcnt vmcnt(0)" ::: "memory")
__device__ __forceinline__ unsigned f2bf(float f) { unsigned u = __builtin_bit_cast(unsigned, f); return (u + 0x7fffu + ((u >> 16) & 1u)) >> 16; }
__device__ __forceinline__ unsigned pk2(float lo, float hi) { return f2bf(lo) | (f2bf(hi) << 16); }
__device__ __forceinline__ float bf2f(unsigned b) { return __builtin_bit_cast(float, b << 16); }
__device__ __forceinline__ float bflo(unsigned w) { return __builtin_bit_cast(float, w << 16); }
__device__ __forceinline__ float bfhi(unsigned w) { return __builtin_bit_cast(float, w & 0xffff0000u); }
__device__ __forceinline__ float fast_exp2(float x) { return __builtin_amdgcn_exp2f(x); }
__device__ __forceinline__ float fast_exp(float x) { return __builtin_amdgcn_exp2f(x * 1.4426950408889634f); }
__device__ __forceinline__ float fast_rcp(float x) { return __builtin_amdgcn_rcpf(x); }
__device__ __forceinline__ float sigmoidf_(float x) { return fast_rcp(1.f + fast_exp(-x)); }
__device__ __forceinline__ float siluf_(float x) { return x * sigmoidf_(x); }
__device__ __forceinline__ float wave_sum(float v) {
    v += __builtin_bit_cast(float, __builtin_amdgcn_update_dpp(0, __builtin_bit_cast(int, v), 0xB1, 0xf, 0xf, true));
    v += __builtin_bit_cast(float, __builtin_amdgcn_update_dpp(0, __builtin_bit_cast(int, v), 0x4E, 0xf, 0xf, true));
    v += __builtin_bit_cast(float, __builtin_amdgcn_update_dpp(0, __builtin_bit_cast(int, v), 0x141, 0xf, 0xf, true));
    v += __builtin_bit_cast(float, __builtin_amdgcn_update_dpp(0, __builtin_bit_cast(int, v), 0x140, 0xf, 0xf, true));
    v += __builtin_bit_cast(float, __builtin_amdgcn_ds_swizzle(__builtin_bit_cast(int, v), 0x401f));
    v += __shfl_xor(v, 32);
    return v;
}

#define XB_TMO      128
#define XB_XCNT(j)  (256  + 64 * (j))
#define XB_XSUB(j)  (1280 + 64 * (j))
#define XB_XGEN(j)  (2304 + 64 * (j))
#define XB_TOP      3328
#define XB_TOPGEN   3392
#define XCD_BAR_WORDS 3456
#define XB_SPIN_CAP (1u << 22)
__device__ __forceinline__ unsigned xb_ld(unsigned* p)              { return __hip_atomic_load(p, __ATOMIC_RELAXED, __HIP_MEMORY_SCOPE_AGENT); }
__device__ __forceinline__ unsigned xb_add(unsigned* p, unsigned v) { return __hip_atomic_fetch_add(p, v, __ATOMIC_RELAXED, __HIP_MEMORY_SCOPE_AGENT); }
__device__ __forceinline__ unsigned xb_xcc_id() { return (unsigned)__builtin_amdgcn_s_getreg((3 << 11) | 20) & 0xFu; }
#define XB_SPIN(cond, bar) do { unsigned _sp = 0; while (cond) { __builtin_amdgcn_s_sleep(1); \
    if ((++_sp & 255u) == 0u) { if (xb_ld(&(bar)[XB_TMO])) break; if (_sp > XB_SPIN_CAP) { atomicAdd(&(bar)[XB_TMO], 1u); break; } } } } while (0)
struct XcdBarrier { unsigned* bar; unsigned x; volatile LAS unsigned* st; };
__device__ __forceinline__ XcdBarrier xcd_barrier_post(unsigned* bar, volatile LAS unsigned* st) {
    XcdBarrier b; b.bar = bar; b.x = xb_xcc_id(); b.st = st;
    if (threadIdx.x == 0) (void)xb_add(&bar[XB_XCNT(b.x)], 1u);
    return b;
}
__device__ __forceinline__ void xcd_barrier_complete(unsigned* bar, unsigned x, unsigned& nloc, unsigned& nx) {
    const unsigned G = gridDim.x * gridDim.y * gridDim.z;
    unsigned sum, cnt, mine, sp = 0u;
    for (;;) {
        sum = 0u; cnt = 0u; mine = 0u;
#pragma unroll
        for (unsigned j = 0; j < 16; ++j) { const unsigned c = xb_ld(&bar[XB_XCNT(j)]); sum += c; cnt += (c > 0u) ? 1u : 0u; }
        mine = xb_ld(&bar[XB_XCNT(x)]);
        if (sum == G) break;
        __builtin_amdgcn_s_sleep(1);
        if ((++sp & 255u) == 0u) { if (xb_ld(&bar[XB_TMO])) break; if (sp > XB_SPIN_CAP) { atomicAdd(&bar[XB_TMO], 1u); break; } }
    }
    nloc = mine > 0u ? mine : 1u; nx = cnt > 0u ? cnt : 1u;
}
__device__ __forceinline__ void xcd_barrier(const XcdBarrier& b) {
    asm volatile("s_waitcnt vmcnt(0)" ::: "memory");
    __syncthreads();
    if (threadIdx.x == 0) {
        unsigned* bar = b.bar;
        __builtin_amdgcn_s_waitcnt(0);
        unsigned nloc = b.st[0], nx = b.st[1];
        if (nloc == 0u) { xcd_barrier_complete(bar, b.x, nloc, nx); b.st[0] = nloc; b.st[1] = nx; }
        const unsigned old = xb_add(&bar[XB_XSUB(b.x)], 1u);
        const unsigned gen = old / nloc;
        if (old + 1u == (gen + 1u) * nloc) {
            __builtin_amdgcn_fence(__ATOMIC_RELEASE, "agent");
            asm volatile("s_waitcnt vmcnt(0)" ::: "memory");
            const unsigned og = xb_add(&bar[XB_TOP], 1u);
            const unsigned tg = og / nx;
            if (og + 1u == (tg + 1u) * nx) xb_add(&bar[XB_TOPGEN], 1u);
            else XB_SPIN(xb_ld(&bar[XB_TOPGEN]) == tg, bar);
            __builtin_amdgcn_fence(__ATOMIC_ACQUIRE, "agent");
            xb_add(&bar[XB_XGEN(b.x)], 1u);
            asm volatile("s_waitcnt vmcnt(0)" ::: "memory");
        } else {
            XB_SPIN(xb_ld(&bar[XB_XGEN(b.x)]) == gen, bar);
            __builtin_amdgcn_fence(__ATOMIC_ACQUIRE, "agent");
            asm volatile("s_waitcnt vmcnt(0)" ::: "memory");
        }
    }
    __syncthreads();
}

struct Frame {
    LAS unsigned char* lds;
    volatile LAS unsigned* MISC;
    gu32* ctl;
    int tid, lane, wave;
    int vcu, G;
    unsigned char* ws;
    float* out;
    const float* const* in;
};
enum { I_X = 0, I_C, I_ADAW, I_ADAB, I_NMIXPRE, I_NMIXPOST, I_NFFNPRE, I_NFFNPOST, I_WIN, I_DLAMBDA, I_DSUBLN, I_POOLW, I_POOLSCALE, I_SCONVW, I_DCONVW, I_DALOG, I_DDTBIAS, I_DNORM,
       I_WBRANCH, I_WMERGE, I_BMERGE, I_WO, I_FFNG, I_FFNU, I_FFND, I_ROUTERW, I_ROUTERB, I_MOEG, I_MOEU, I_MOED, N_INPUTS };

__device__ __forceinline__ void cvt_item(const float* W, int ldw, int k0, int n0, bf16* WT, int Kd, int drow0, LAS float* scr, int lane) {
#pragma unroll 8
    for (int i = 0; i < 32; ++i) { const int kk = 2 * i + (lane >> 5); scr[kk * 33 + (lane & 31)] = W[(size_t)(k0 + kk) * ldw + n0 + (lane & 31)]; }
    LDS_WAIT(); asm volatile("" ::: "memory");
    const int c = lane & 7;
#pragma unroll
    for (int j = 0; j < 4; ++j) { const int n = (lane >> 3) + 8 * j; const LAS float* s = scr + (8 * c) * 33 + n;
        v4u o; o.x = pk2(s[0 * 33], s[1 * 33]); o.y = pk2(s[2 * 33], s[3 * 33]); o.z = pk2(s[4 * 33], s[5 * 33]); o.w = pk2(s[6 * 33], s[7 * 33]);
        *(GAS v4u*)(WT + (size_t)(drow0 + n) * Kd + k0 + 8 * c) = o; }
    LDS_WAIT(); asm volatile("" ::: "memory");
}
__device__ __forceinline__ void cvt_ffn_item(const float* wg, const float* wu, const float* wd, bf16* Wgu, bf16* Wd, int r, LAS float* scr, int lane) {
    constexpr int IG = (D / 64) * (DFF / 32);
    if (r < IG) { const int kb = r / (DFF / 32), nb = r % (DFF / 32), n0 = nb * 32; cvt_item(wg, DFF, kb * 64, n0, Wgu, D, 256 * (n0 >> 7) + (n0 & 127), scr, lane); return; } r -= IG;
    if (r < IG) { const int kb = r / (DFF / 32), nb = r % (DFF / 32), n0 = nb * 32; cvt_item(wu, DFF, kb * 64, n0, Wgu, D, 256 * (n0 >> 7) + (n0 & 127) + 128, scr, lane); return; } r -= IG;
    { const int kb = r / (D / 32), nb = r % (D / 32); cvt_item(wd, D, kb * 64, nb * 32, Wd, DFF, nb * 32, scr, lane); }
}
constexpr int FFN_ITEMS = 3 * (D / 64) * (DFF / 32);
__device__ __forceinline__ bf16* w_in_t(unsigned char* ws, int l) { return (bf16*)(ws + WS_W + (size_t)l * SZ_LAYERW); }
__device__ __forceinline__ bf16* w_m_t(unsigned char* ws, int l) { return (bf16*)(ws + WS_W + (size_t)l * SZ_LAYERW + SZ_WIN); }
__device__ __forceinline__ bf16* w_b_t(unsigned char* ws, int l) { return (bf16*)(ws + WS_W + (size_t)l * SZ_LAYERW + SZ_WIN + SZ_WM); }
__device__ __forceinline__ bf16* w_o_t(unsigned char* ws, int l) { return (bf16*)(ws + WS_W + (size_t)l * SZ_LAYERW + SZ_WIN + SZ_WM + SZ_WB); }

__device__ __forceinline__ void p_prologue(Frame& F) {
    LAS float* scr = (LAS float*)(F.lds + RING_OFF + F.wave * 16384);
    const int gw = F.vcu * NWAVES + F.wave, NGW = F.G * NWAVES;
    constexpr int I_IN = (D / 64) * (NPROJ / 32), I_M = (D / 64) * (D / 32), I_B = (256 / 64) * (D / 32);
    constexpr int PER_LAYER = I_IN + 4 * I_M + 4 * I_B + I_M;
    constexpr int NITEMS = NLAYER * PER_LAYER + FFN_ITEMS;
    for (int it = gw; it < NITEMS; it += NGW) {
        int r = it;
        if (r >= NLAYER * PER_LAYER) { r -= NLAYER * PER_LAYER;
            cvt_ffn_item(F.in[I_FFNG], F.in[I_FFNU], F.in[I_FFND], (bf16*)(F.ws + WS_WFFN), (bf16*)(F.ws + WS_WFFN + SZ_WGU), r, scr, F.lane); continue; }
        const int l = r / PER_LAYER; r -= l * PER_LAYER;
        if (r < I_IN) { const int kb = r / (NPROJ / 32), nb = r % (NPROJ / 32); cvt_item(F.in[I_WIN] + (size_t)l * D * IN_COLS, IN_COLS, kb * 64, nb * 32, w_in_t(F.ws, l), D, nb * 32, scr, F.lane); continue; } r -= I_IN;
        if (r < 4 * I_M) { const int i = r / I_M; r -= i * I_M; const int kb = r / (D / 32), nb = r % (D / 32);
            cvt_item(F.in[I_WMERGE] + ((size_t)l * 4 + i) * D * D, D, kb * 64, nb * 32, w_m_t(F.ws, l), D, i * 1024 + nb * 32, scr, F.lane); continue; } r -= 4 * I_M;
        if (r < 4 * I_B) { const int i = r / I_B; r -= i * I_B; const int kb = r / (D / 32), nb = r % (D / 32);
            cvt_item(F.in[I_WBRANCH] + ((size_t)l * 4 + i) * 256 * D, D, kb * 64, nb * 32, w_b_t(F.ws, l) + (size_t)i * 1024 * 256, 256, nb * 32, scr, F.lane); continue; } r -= 4 * I_B;
        { const int kb = r / (D / 32), nb = r % (D / 32); cvt_item(F.in[I_WO] + (size_t)l * D * D, D, kb * 64, nb * 32, w_o_t(F.ws, l), D, nb * 32, scr, F.lane); }
    }
    constexpr int MOD_ITEMS = NLAYER * 24;
    for (int it = gw; it < MOD_ITEMS; it += NGW) {
        const int l = it / 24, nb = it % 24;
        const float* Wp = F.in[I_ADAW] + (size_t)l * D * (6 * D) + nb * 256 + F.lane * 4;
        f32x4 a0 = {0.f, 0.f, 0.f, 0.f}, a1 = {0.f, 0.f, 0.f, 0.f};
#pragma unroll 8
        for (int k = 0; k < D; ++k) { const f32x4 w = *(const GAS f32x4*)(Wp + (size_t)k * (6 * D));
            const float c0 = siluf_(F.in[I_C][k]), c1 = siluf_(F.in[I_C][D + k]); a0 += w * c0; a1 += w * c1; }
        float* m0 = (float*)(F.ctl + CW_MOD) + (size_t)(l * BATCH + 0) * 6 * D + nb * 256 + F.lane * 4;
        *(GAS f32x4*)m0 = a0; *(GAS f32x4*)(m0 + 6 * D) = a1;
    }
}
__device__ __forceinline__ void p_moe_cvt(Frame& F) {
    LAS float* scr = (LAS float*)(F.lds + RING_OFF + F.wave * 16384);
    const int gw = F.vcu * NWAVES + F.wave, NGW = F.G * NWAVES;
    for (int it = gw; it < NEXP * FFN_ITEMS; it += NGW) {
        const int e = it / FFN_ITEMS, r = it % FFN_ITEMS;
        bf16* base = (bf16*)(F.ws + WS_MOEW + (size_t)e * SZ_FFNW);
        cvt_ffn_item(F.in[I_MOEG] + (size_t)e * D * DFF, F.in[I_MOEU] + (size_t)e * D * DFF, F.in[I_MOED] + (size_t)e * DFF * D, base, (bf16*)((unsigned char*)base + SZ_WGU), r, scr, F.lane);
    }
}

struct Row { f32x4 v[4]; };
__device__ __forceinline__ float modv(Frame& F, int l, int b, int idx) { return ((const float*)(F.ctl + CW_MOD))[(size_t)(l * BATCH + b) * 6 * D + idx] + F.in[I_ADAB][l * 6 * D + idx]; }
__device__ __forceinline__ f32x4 modv4(Frame& F, int l, int b, int idx) {
    const f32x4 a = *(const GAS f32x4*)((const float*)(F.ctl + CW_MOD) + (size_t)(l * BATCH + b) * 6 * D + idx), c = *(const GAS f32x4*)(F.in[I_ADAB] + l * 6 * D + idx); return a + c; }
__device__ __forceinline__ float row_rstd(const Row& r) {
    float s = 0.f;
#pragma unroll
    for (int j = 0; j < 4; ++j) s += (r.v[j].x * r.v[j].x + r.v[j].y * r.v[j].y) + (r.v[j].z * r.v[j].z + r.v[j].w * r.v[j].w);
    return 1.f / sqrtf(wave_sum(s) * (1.f / D) + EPS);
}
__device__ __forceinline__ void row_resid(Frame& F, Row& x, const Row& f, const float* gain, int l, int b, int gidx) {
    const float rs = row_rstd(f);
#pragma unroll
    for (int j = 0; j < 4; ++j) { const int c = 4 * F.lane + 256 * j; const f32x4 g = *(const GAS f32x4*)(gain + c), m = modv4(F, l, b, gidx + c); x.v[j] += m * (f.v[j] * rs * g); }
}
__device__ __forceinline__ void row_make_h(Frame& F, Row& h, const Row& x, const float* gain, int l, int b, int shidx, int scidx) {
    const float rs = row_rstd(x);
#pragma unroll
    for (int j = 0; j < 4; ++j) { const int c = 4 * F.lane + 256 * j; const f32x4 g = *(const GAS f32x4*)(gain + c), sc = modv4(F, l, b, scidx + c), sh = modv4(F, l, b, shidx + c);
        h.v[j] = (x.v[j] * rs * g) * (sc + 1.f) + sh; }
}
__device__ __forceinline__ void row_store_bf16(Frame& F, const Row& h, bf16* dst) {
    GAS unsigned long long* o8 = (GAS unsigned long long*)dst + F.lane;
#pragma unroll
    for (int j = 0; j < 4; ++j) o8[64 * j] = (unsigned long long)pk2(h.v[j].x, h.v[j].y) | ((unsigned long long)pk2(h.v[j].z, h.v[j].w) << 32);
}
__device__ __forceinline__ void row_load_f32(Frame& F, Row& r, const float* src) {
    const GAS f32x4* p = (const GAS f32x4*)src + F.lane;
#pragma unroll
    for (int j = 0; j < 4; ++j) r.v[j] = p[64 * j];
}
__device__ __forceinline__ void row_store_f32(Frame& F, const Row& r, float* dst) {
    GAS f32x4* p = (GAS f32x4*)dst + F.lane;
#pragma unroll
    for (int j = 0; j < 4; ++j) p[64 * j] = r.v[j];
}
__device__ __forceinline__ void row_load_bf16(Frame& F, Row& r, const bf16* src) {
    const GAS v2u* p = (const GAS v2u*)src + F.lane;
#pragma unroll
    for (int j = 0; j < 4; ++j) { const v2u w = p[64 * j]; r.v[j] = (f32x4){bflo(w.x), bfhi(w.x), bflo(w.y), bfhi(w.y)}; }
}
template <int NO> __device__ __forceinline__ void row_dots(Frame& F, const Row& h, const LAS float* WT, float (&out)[NO]) {
#pragma unroll
    for (int o = 0; o < NO; ++o) { float s = 0.f;
#pragma unroll
        for (int j = 0; j < 4; ++j) { const f32x4 w = *(const LAS f32x4*)(WT + o * 1024 + 4 * F.lane + 256 * j); s += (h.v[j].x * w.x + h.v[j].y * w.y) + (h.v[j].z * w.z + h.v[j].w * w.w); }
        out[o] = s; if ((o & 3) == 3) __builtin_amdgcn_sched_barrier(0); }
#pragma unroll
    for (int o = 0; o < NO; ++o) { out[o] = wave_sum(out[o]); if ((o & 3) == 3) __builtin_amdgcn_sched_barrier(0); }
}
template <int NO> __device__ __forceinline__ void load_wt(Frame& F, const float* W, int ldw, int col0, LAS float* WT) {
    for (int k = F.tid; k < 1024; k += NWAVES * 64) {
#pragma unroll
        for (int o = 0; o < NO; ++o) WT[o * 1024 + k] = W[(size_t)k * ldw + col0 + o];
    }
    __syncthreads();
}
__device__ __forceinline__ float softplusf_(float x) { return x > 20.f ? x : log1pf(__expf(x)); }
__device__ __forceinline__ void row_bd(Frame& F, const Row& h, const LAS float* W16T, int l, int row) {
    float o16[16]; row_dots<16>(F, h, W16T, o16);
    float mine = 0.f;
#pragma unroll
    for (int o = 0; o < 16; ++o) mine = (F.lane == o) ? o16[o] : mine;
    if (F.lane < 16) {
        float r;
        if (F.lane < 8) r = 1.f / (1.f + __expf(-mine));
        else { const int i = F.lane - 8; r = -__expf(F.in[I_DALOG][l * 8 + i]) * softplusf_(mine + F.in[I_DDTBIAS][l * 8 + i]); }
        ((float*)(F.ws + WS_BD))[(size_t)row * 16 + F.lane] = r;
    }
}
__device__ __forceinline__ void moe_tiles(Frame& F, int (&cnt)[NEXP], int (&tstart)[NEXP + 1]) {
    int acc = 0;
#pragma unroll
    for (int e = 0; e < NEXP; ++e) { cnt[e] = (int)__hip_atomic_load(F.ctl + CW_MOECNT + 64 * e, RLX_AGENT); tstart[e] = acc; acc += (cnt[e] + 255) >> 8; }
    tstart[NEXP] = acc;
}

constexpr int ROW_A = 0, ROW_B = 1, ROW_C = 2;
template <int MODE> __device__ __forceinline__ void p_rows(Frame& F, const int l) {
    const int gw = F.vcu * NWAVES + F.wave, NGW = F.G * NWAVES;
    LAS float* WT = (LAS float*)(F.lds + RING_OFF);
    LAS int* linfo = (LAS int*)(F.lds + RING_OFF + 65536);
    LAS int* lcnt = (LAS int*)(F.lds + RING_OFF + 65536 + 8 * 32 * 16);
    const bool do_h1 = (MODE == ROW_A) || (MODE == ROW_C && l + 1 < NLAYER);
    const int lh = (MODE == ROW_C) ? l + 1 : l;
    const bool router = (MODE == ROW_B) && (l == 1);
    if (do_h1) load_wt<16>(F, F.in[I_WIN] + (size_t)lh * D * IN_COLS, IN_COLS, NPROJ, WT);
    if (router) { if (F.tid < 16) lcnt[F.tid] = 0; load_wt<8>(F, F.in[I_ROUTERW], NEXP, 0, WT); }
    int cnt[NEXP], tstart[NEXP + 1];
    if (MODE == ROW_C && l == 1) moe_tiles(F, cnt, tstart);
    const float* xsrc = (MODE == ROW_A || (MODE == ROW_B && l == 0)) ? F.in[I_X] : F.out;
    int ri = 0;
    for (int m = gw; m < NTOK; m += NGW, ++ri) {
        const int b = m / SEQ;
        Row x; row_load_f32(F, x, xsrc + (size_t)m * D);
        if (MODE == ROW_B) {
            Row f; row_load_bf16(F, f, (const bf16*)(F.ws + WS_F) + (size_t)m * D);
            row_resid(F, x, f, F.in[I_NMIXPOST] + l * D, l, b, 2 * D);
            row_store_f32(F, x, F.out + (size_t)m * D);
            Row h; row_make_h(F, h, x, F.in[I_NFFNPRE] + l * D, l, b, 3 * D, 4 * D);
            row_store_bf16(F, h, (bf16*)(F.ws + (l == 0 ? WS_H : WS_H2B)) + (size_t)m * D);
            if (router) {
                float lg[NEXP]; row_dots<NEXP>(F, h, WT, lg);
                int e0 = 0; float l0 = lg[0] + F.in[I_ROUTERB][0];
#pragma unroll
                for (int e = 0; e < NEXP; ++e) lg[e] += F.in[I_ROUTERB][e];
#pragma unroll
                for (int e = 1; e < NEXP; ++e) if (lg[e] > l0) { l0 = lg[e]; e0 = e; }
                int e1 = -1; float l1 = -3.0e38f;
#pragma unroll
                for (int e = 0; e < NEXP; ++e) if (e != e0 && lg[e] > l1) { l1 = lg[e]; e1 = e; }
                const float q1 = __expf(l1 - l0), p0 = 1.f / (1.f + q1), p1 = q1 * p0;
                if (F.lane == 0) {
                    const int i0 = atomicAdd((int*)&lcnt[e0], 1), i1 = atomicAdd((int*)&lcnt[e1], 1);
                    LAS int* li = linfo + (F.wave * 32 + ri) * 4;
                    li[0] = e0 | (e1 << 8) | (i0 << 16); li[1] = i1; li[2] = __float_as_int(p0); li[3] = __float_as_int(p1);
                }
            }
        } else if (MODE == ROW_C) {
            Row f;
            if (l == 0) row_load_bf16(F, f, (const bf16*)(F.ws + WS_F) + (size_t)m * D);
            else {
                const int* ti = (const int*)(F.ws + WS_ROUTE) + (size_t)m * 8;
                const int e0 = ti[0], i0 = ti[1], e1 = ti[2], i1 = ti[3]; const float p0 = __int_as_float(ti[4]), p1 = __int_as_float(ti[5]);
                int s0 = 0, s1 = 0;
#pragma unroll
                for (int e = 0; e < NEXP; ++e) { s0 = (e == e0) ? tstart[e] * 256 + i0 : s0; s1 = (e == e1) ? tstart[e] * 256 + i1 : s1; }
                Row y0, y1; row_load_bf16(F, y0, (const bf16*)(F.ws + WS_Y) + (size_t)s0 * D); row_load_bf16(F, y1, (const bf16*)(F.ws + WS_Y) + (size_t)s1 * D);
#pragma unroll
                for (int j = 0; j < 4; ++j) f.v[j] = y0.v[j] * p0 + y1.v[j] * p1;
            }
            row_resid(F, x, f, F.in[I_NFFNPOST] + l * D, l, b, 5 * D);
            row_store_f32(F, x, F.out + (size_t)m * D);
        }
        if (do_h1) {
            Row h; row_make_h(F, h, x, F.in[I_NMIXPRE] + lh * D, lh, b, 0, 1 * D);
            row_store_bf16(F, h, (bf16*)(F.ws + WS_H) + (size_t)m * D);
            row_bd(F, h, WT, lh, m);
        }
    }
    if (router) {
        __syncthreads();
        if (F.tid < NEXP) lcnt[8 + F.tid] = (int)__hip_atomic_fetch_add(F.ctl + CW_MOECNT + 64 * F.tid, (unsigned)lcnt[F.tid], RLX_AGENT);
        __syncthreads();
        ri = 0;
        for (int m = gw; m < NTOK; m += NGW, ++ri) {
            if (F.lane == 0) {
                const LAS int* li = linfo + (F.wave * 32 + ri) * 4;
                const int w0 = li[0], e0 = w0 & 255, e1 = (w0 >> 8) & 255, i0 = (w0 >> 16) + lcnt[8 + e0], i1 = li[1] + lcnt[8 + e1];
                int* ti = (int*)(F.ws + WS_ROUTE) + (size_t)m * 8;
                ti[0] = e0; ti[1] = i0; ti[2] = e1; ti[3] = i1; ti[4] = li[2]; ti[5] = li[3];
                int* lists = (int*)(F.ws + WS_ROUTE + 1 * MiB);
                lists[(size_t)e0 * 65536 + i0] = m; lists[(size_t)e1 * 65536 + i1] = m;
            }
        }
    }
    __syncthreads();
}

namespace pg8 {
constexpr int NXCD = 8, WGM = 8;
struct SchedStd {
    int nM, nN, nwg, G, c; const char* A; size_t a_tile; const char* B; size_t b_tile;
    __device__ __forceinline__ void init(int nM_, int nN_, int G_, int c_, const void* A_, size_t a_tile_, const void* B_, size_t b_tile_) { nM = nM_; nN = nN_; nwg = nM * nN; G = G_; c = c_; A = (const char*)A_; a_tile = a_tile_; B = (const char*)B_; b_tile = b_tile_; }
    __device__ __forceinline__ bool next(int i, Unit& u) const {
        const long L = (long)i * G + c; if (L >= nwg) return false;
        int wgid = (int)L; { const int q = nwg / NXCD, r = nwg % NXCD, xcd = wgid % NXCD, off = wgid / NXCD; wgid = (xcd < r ? xcd * (q + 1) : r * (q + 1) + (xcd - r) * q) + off; }
        const int nig = WGM * nN, gid = wgid / nig, fm = gid * WGM, gsz = (nM - fm) < WGM ? (nM - fm) : WGM;
        u.pm = fm + ((wgid % nig) % gsz); u.pn = (wgid % nig) / gsz; u.aux = 0; u.pad = 0; u.a = A + (size_t)u.pm * a_tile; u.b = B + (size_t)u.pn * b_tile; u.rows = nullptr; return true;
    }
    __device__ __forceinline__ void a_ready(const Unit&) const {}
    __device__ __forceinline__ void done(const Unit&) const {}
};
struct SchedBranch {
    SchedStd s; const char* O4; const char* Wb;
    __device__ __forceinline__ bool next(int i, Unit& u) const {
        if (!s.next(i, u)) return false;
        const int br = u.pn >> 2; u.pn &= 3; u.aux = br;
        u.a = O4 + (size_t)u.pm * 256 * 1024 * 2 + (size_t)br * 256 * 2; u.b = Wb + (size_t)br * 1024 * 256 * 2 + (size_t)u.pn * 256 * 256 * 2; return true;
    }
    __device__ __forceinline__ void a_ready(const Unit&) const {}
    __device__ __forceinline__ void done(const Unit&) const {}
};
struct SchedGate {
    int vcu, G; const char* H; const char* Wm;
    __device__ __forceinline__ bool next(int i, Unit& u) const {
        const int tg = vcu + G * (i >> 2); if (tg >= 512) return false;
        u.pm = tg >> 2; u.pn = tg & 3; u.aux = i & 3; u.pad = 0; u.rows = nullptr;
        u.a = H + (size_t)u.pm * 256 * 1024 * 2; u.b = Wm + ((size_t)u.aux * 1024 + (size_t)u.pn * 256) * 1024 * 2; return true;
    }
    __device__ __forceinline__ void a_ready(const Unit&) const {}
    __device__ __forceinline__ void done(const Unit&) const {}
};
struct SchedMoe {
    int c, G, t0, t1, nN; int tstart[9]; int cnt[8];
    const char* A; const int* lists; const char* W; size_t w_tile; bool gather;
    __device__ __forceinline__ bool next(int i, Unit& u) const {
        const long L = (long)i * G + c; const int t = t0 + (int)(L / nN); if (t >= t1) return false;
        int e = 0;
#pragma unroll
        for (int k = 1; k < 8; ++k) e = (t >= tstart[k]) ? k : e;
        int ce = 0;
#pragma unroll
        for (int k = 0; k < 8; ++k) ce = (k == e) ? cnt[k] : ce;
        const int j = t - ((e == 0) ? 0 : 0), jj = t;
        (void)j; (void)jj;
        int ts = 0;
#pragma unroll
        for (int k = 0; k < 8; ++k) ts = (k == e) ? tstart[k] : ts;
        const int tj = t - ts;
        u.pn = (int)(L % nN); u.pad = 0;
        if (gather) { u.pm = t - t0; u.a = A; u.rows = lists + (size_t)e * 65536 + tj * 256; const int nv = ce - tj * 256; u.aux = nv > 256 ? 256 : nv; }
        else { u.pm = t; u.a = A + (size_t)(t - t0) * 256 * DFF_ * 2; u.rows = nullptr; u.aux = 0; }
        u.b = W + (size_t)e * SZ_EXP_ + (size_t)u.pn * w_tile; return true;
    }
    static constexpr size_t DFF_ = 2816; static constexpr size_t SZ_EXP_ = (size_t)2 * 2816 * 1024 * 2 + (size_t)1024 * 2816 * 2;
    __device__ __forceinline__ void a_ready(const Unit&) const {}
    __device__ __forceinline__ void done(const Unit&) const {}
};

struct EpiStore {
    static constexpr bool PERM = true;
    bf16_t* O; int ldc; size_t aux_stride; float scale0;
    __device__ __forceinline__ void operator()(const f32x4 (&acc)[2][2][4][2], const Unit& u, int wr, int wc, int fr, int fq) const {
        const int row0 = u.pm * BM + wr * 64 + fr, col0 = u.pn * BM + wc * 32 + 8 * fq; bf16_t* base = O + (size_t)u.aux * aux_stride;
        const float sc = (u.pn == 0) ? scale0 : 1.f;
#pragma unroll
        for (int ai = 0; ai < 2; ++ai)
#pragma unroll
            for (int m = 0; m < 4; ++m) { bf16_t* rowp = base + (size_t)(row0 + ai * HALF + m * 16) * ldc + col0;
#pragma unroll
                for (int bj = 0; bj < 2; ++bj) { const f32x4 v0 = acc[ai][bj][m][0] * sc, v1 = acc[ai][bj][m][1] * sc;
                    u32x4 w; w.x = cvt_pk_bf16(v0[0], v0[1]); w.y = cvt_pk_bf16(v0[2], v0[3]); w.z = cvt_pk_bf16(v1[0], v1[1]); w.w = cvt_pk_bf16(v1[2], v1[3]);
                    *(u32x4*)(rowp + bj * HALF) = w; } }
    }
};

struct EpiProj {
    static constexpr bool PERM = true;
    static constexpr int TILE_E = 9728;
    bf16_t* Qb; bf16_t* KV; bf16_t* Pj; unsigned* nmax; float qscale;
    __device__ __forceinline__ void operator()(const f32x4 (&acc)[2][2][4][2], const Unit& u, int wr, int wc, int fr, int fq) const {
        const int t0 = u.pm * BM + wr * 64 + fr;
        const int b = (u.pm * BM) >> 14;
        const int s00 = t0 & 16383;
        if (u.pn >= 3) {
            bf16_t* base = Pj + (size_t)t0 * 2048 + (u.pn - 3) * BM + wc * 32 + 8 * fq;
#pragma unroll
            for (int ai = 0; ai < 2; ++ai)
#pragma unroll
                for (int m = 0; m < 4; ++m) {
#pragma unroll
                    for (int bj = 0; bj < 2; ++bj) { const f32x4 v0 = acc[ai][bj][m][0], v1 = acc[ai][bj][m][1];
                        u32x4 w; w.x = cvt_pk_bf16(v0[0], v0[1]); w.y = cvt_pk_bf16(v0[2], v0[3]); w.z = cvt_pk_bf16(v1[0], v1[1]); w.w = cvt_pk_bf16(v1[2], v1[3]);
                        *(u32x4*)(base + (ai * HALF + m * 16) * 2048 + bj * HALF) = w; }
                    __builtin_amdgcn_sched_barrier(0); }
        } else if (u.pn == 2) {
            bf16_t* hb = KV + ((size_t)((b * 4 + (wc >> 1)) * 256 + (s00 >> 6))) * TILE_E + 5120 + (32 * (wc & 1) + 8 * fq) * 72 + (s00 & 63);
#pragma unroll
            for (int ai = 0; ai < 2; ++ai)
#pragma unroll
                for (int bj = 0; bj < 2; ++bj) { bf16_t* tb = hb + (size_t)bj * (2 * 256 * TILE_E) + ai * (2 * TILE_E);
#pragma unroll
                    for (int m = 0; m < 4; ++m)
#pragma unroll
                        for (int n = 0; n < 2; ++n)
#pragma unroll
                            for (int j = 0; j < 4; ++j) { const float v = acc[ai][bj][m][n][j];
                                unsigned bits = __builtin_bit_cast(unsigned, v); bits = (bits + 0x7fffu + ((bits >> 16) & 1u)) >> 16;
                                tb[(4 * n + j) * 72 + 16 * m] = (bf16_t)bits; }
                    __builtin_amdgcn_sched_barrier(0); }
        } else {
            const float sc = (u.pn == 0) ? qscale : 1.f; float nm = 0.f;
            bf16_t* qbase = Qb + ((size_t)(b * 4 + wc) * 16384 + s00) * 64 + 8 * fq;
            bf16_t* kbase = KV + ((size_t)((b * 4 + wc) * 256 + (s00 >> 6))) * TILE_E + (s00 & 63) * 40 + 8 * fq;
#pragma unroll
            for (int ai = 0; ai < 2; ++ai)
#pragma unroll
                for (int m = 0; m < 4; ++m) {
#pragma unroll
                    for (int bj = 0; bj < 2; ++bj) { const f32x4 v0 = acc[ai][bj][m][0] * sc, v1 = acc[ai][bj][m][1] * sc;
                        u32x4 w; w.x = cvt_pk_bf16(v0[0], v0[1]); w.y = cvt_pk_bf16(v0[2], v0[3]); w.z = cvt_pk_bf16(v1[0], v1[1]); w.w = cvt_pk_bf16(v1[2], v1[3]);
                        float ss = (v0[0] * v0[0] + v0[1] * v0[1]) + (v0[2] * v0[2] + v0[3] * v0[3]) + (v1[0] * v1[0] + v1[1] * v1[1]) + (v1[2] * v1[2] + v1[3] * v1[3]);
                        ss += __shfl_xor(ss, 16); ss += __shfl_xor(ss, 32); nm = fmaxf(nm, ss);
                        if (u.pn == 0) *(u32x4*)(qbase + (ai * HALF + m * 16) * 64 + 32 * bj) = w;
                        else *(u32x4*)(kbase + ai * (2 * TILE_E) + bj * 2560 + (16 * m) * 40) = w; }
                    __builtin_amdgcn_sched_barrier(0); }
            nm = fmaxf(nm, __shfl_xor(nm, 1)); nm = fmaxf(nm, __shfl_xor(nm, 2)); nm = fmaxf(nm, __shfl_xor(nm, 4)); nm = fmaxf(nm, __shfl_xor(nm, 8));
            if (fr == 0 && fq == 0) atomicMax(nmax + (b * 4 + wc) * 2 + u.pn, __builtin_bit_cast(unsigned, nm));
        }
    }
};
__device__ __forceinline__ float sigm(float x) { return __builtin_amdgcn_rcpf(1.f + __builtin_amdgcn_exp2f(-1.4426950408889634f * x)); }
struct EpiGate {
    static constexpr bool PERM = true;
    const bf16_t* P; bf16_t* Mg; const float* bias;
    __device__ __forceinline__ void operator()(const f32x4 (&acc)[2][2][4][2], const Unit& u, int wr, int wc, int fr, int fq) const {
        const int row0 = u.pm * BM + wr * 64 + fr, col0 = u.pn * BM + wc * 32 + 8 * fq; const int br = u.aux;
        const bf16_t* Pb = P + (size_t)br * 32768 * 1024; const float* bb = bias + br * 1024 + col0;
        f32x4 bv[2][2];
#pragma unroll
        for (int bj = 0; bj < 2; ++bj)
#pragma unroll
            for (int n = 0; n < 2; ++n) bv[bj][n] = *(const f32x4*)(bb + bj * HALF + 4 * n);
#pragma unroll
        for (int ai = 0; ai < 2; ++ai)
#pragma unroll
            for (int m = 0; m < 4; ++m) { const size_t ro = (size_t)(row0 + ai * HALF + m * 16) * 1024 + col0;
#pragma unroll
                for (int bj = 0; bj < 2; ++bj) {
                    const u32x4 pw = *(const u32x4*)(Pb + ro + bj * HALF);
                    u32x4 mw = {0u, 0u, 0u, 0u}; if (br != 0) mw = *(const u32x4*)(Mg + ro + bj * HALF);
                    float o[8];
#pragma unroll
                    for (int q = 0; q < 4; ++q) {
                        const float g0 = sigm(acc[ai][bj][m][q >> 1][(q & 1) * 2] + bv[bj][q >> 1][(q & 1) * 2]), g1 = sigm(acc[ai][bj][m][q >> 1][(q & 1) * 2 + 1] + bv[bj][q >> 1][(q & 1) * 2 + 1]);
                        o[2 * q] = g0 * __builtin_bit_cast(float, pw[q] << 16) + __builtin_bit_cast(float, mw[q] << 16);
                        o[2 * q + 1] = g1 * __builtin_bit_cast(float, pw[q] & 0xffff0000u) + __builtin_bit_cast(float, mw[q] & 0xffff0000u);
                    }
                    u32x4 w; w.x = cvt_pk_bf16(o[0], o[1]); w.y = cvt_pk_bf16(o[2], o[3]); w.z = cvt_pk_bf16(o[4], o[5]); w.w = cvt_pk_bf16(o[6], o[7]);
                    *(u32x4*)(Mg + ro + bj * HALF) = w; } }
    }
};
struct EpiSwiGLU {
    static constexpr bool PERM = true;
    bf16_t* O; int ldc;
    __device__ __forceinline__ void operator()(const f32x4 (&acc)[2][2][4][2], const Unit& u, int wr, int wc, int fr, int fq) const {
        const int row0 = u.pm * BM + wr * 64 + fr, col0 = u.pn * HALF + wc * 32 + 8 * fq;
#pragma unroll
        for (int ai = 0; ai < 2; ++ai)
#pragma unroll
            for (int m = 0; m < 4; ++m) { bf16_t* rowp = O + (size_t)(row0 + ai * HALF + m * 16) * ldc + col0;
                float o[8];
#pragma unroll
                for (int n = 0; n < 2; ++n)
#pragma unroll
                    for (int q = 0; q < 4; ++q) { const float g = acc[ai][0][m][n][q], up = acc[ai][1][m][n][q]; o[4 * n + q] = g * sigm(g) * up; }
                u32x4 w; w.x = cvt_pk_bf16(o[0], o[1]); w.y = cvt_pk_bf16(o[2], o[3]); w.z = cvt_pk_bf16(o[4], o[5]); w.w = cvt_pk_bf16(o[6], o[7]);
                *(u32x4*)rowp = w; }
    }
};
}

namespace att {
constexpr int SLOT = 19456, NSLOT = 6;
constexpr int ATTN_LDS = NSLOT * SLOT;
__device__ __forceinline__ unsigned cvtpk(float lo, float hi) { typedef float f2 __attribute__((ext_vector_type(2))); typedef __bf16 b2 __attribute__((ext_vector_type(2))); f2 v = {lo, hi}; b2 b = __builtin_convertvector(v, b2); return __builtin_bit_cast(unsigned, b); }
#define ATT_WAITV(n) asm volatile("s_waitcnt vmcnt(" #n ")" ::: "memory")
__device__ __forceinline__ float max3f(float a, float b, float c) { float r; asm("v_max3_f32 %0, %1, %2, %3" : "=v"(r) : "v"(a), "v"(b), "v"(c)); return r; }

#define ATT_SOFTMAX(s0, s1, pw) do { \
    asm volatile("s_nop 15\n\ts_nop 7" : "+v"(s0), "+v"(s1)); \
    float rm = max3f(s0[0], s0[1], s1[0]), rm2 = max3f(s0[2], s0[3], s1[1]); rm = max3f(rm, s1[2], s1[3]); \
    _Pragma("unroll") for (int r = 4; r < 16; r += 4) { rm = max3f(rm, s0[r], s0[r + 1]); rm2 = max3f(rm2, s0[r + 2], s0[r + 3]); rm = max3f(rm, s1[r], s1[r + 1]); rm2 = max3f(rm2, s1[r + 2], s1[r + 3]); } \
    rm = fmaxf(rm, rm2); \
    { auto rr = __builtin_amdgcn_permlane32_swap(__builtin_bit_cast(unsigned, rm), __builtin_bit_cast(unsigned, rm), false, false); rm = fmaxf(__builtin_bit_cast(float, rr[0]), __builtin_bit_cast(float, rr[1])); } \
    if (__any(rm > 8.f)) { \
        const float dd = fmaxf(rm, 0.f); R += dd; \
        const float f = fast_exp2(-dd); L1[0] *= f; L2[0] *= f; \
        _Pragma("unroll") for (int r = 0; r < 16; ++r) { s0[r] -= dd; s1[r] -= dd; c0[r] -= dd; c1[r] -= dd; O1[0][r] *= f; O1[1][r] *= f; O2[0][r] *= f; O2[1][r] *= f; } \
        RESC_EXTRA(f); \
    } \
    _Pragma("unroll") for (int r = 0; r < 16; ++r) { s0[r] = fast_exp2(s0[r]); s1[r] = fast_exp2(s1[r]); } \
    _Pragma("unroll") for (int e = 0; e < 4; ++e) { pw[0][e] = cvtpk(s0[2 * e], s0[2 * e + 1]); pw[1][e] = cvtpk(s0[8 + 2 * e], s0[8 + 2 * e + 1]); pw[2][e] = cvtpk(s1[2 * e], s1[2 * e + 1]); pw[3][e] = cvtpk(s1[8 + 2 * e], s1[8 + 2 * e + 1]); } \
} while (0)

__device__ __forceinline__ void attn_unit(Frame& F, const int layer, const int b, const int h, const int qb) {
    const int lane = F.lane, r32 = lane & 31, hi = lane >> 5, wid = F.wave;
    LAS unsigned char* L = F.lds + RING_OFF;
    const int qw0 = qb * 256 + wid * 32, q = qw0 + r32;
    const float slope2 = exp2f(-2.f * (float)(h + 1)) * 1.4426950408889634f;
    int tlo, thi;
    { const unsigned* nm = (const unsigned*)(F.ctl + CW_NMAX) + layer * 16 + (b * 4 + h) * 2;
      const float qn = sqrtf(__builtin_bit_cast(float, __hip_atomic_load(nm, RLX_AGENT))) * 1.01f, kn = sqrtf(__builtin_bit_cast(float, __hip_atomic_load(nm + 1, RLX_AGENT))) * 1.01f;
      const float wf = (160.f + 2.f * qn * kn) / slope2; const int W = wf > 100000.f ? 100000 : (int)wf + 1;
      const int lo = qb * 256 - W, hi_ = qb * 256 + 255 + W; tlo = lo < 0 ? 0 : (lo >> 6); thi = hi_ >= SEQ ? (SEQ / 64 - 1) : (hi_ >> 6);
      if (((thi - tlo + 1) & 1) != 0) { if (thi < SEQ / 64 - 1) ++thi; else --tlo; } }
    const int nP = (thi - tlo + 1) >> 1;
    const bf16* Qp = (const bf16*)(F.ws + WS_QB) + ((size_t)(b * 4 + h) * SEQ + q) * 64;
    bf16x8 q1f[2], q2f[2];
#pragma unroll
    for (int ks = 0; ks < 2; ++ks) { q1f[ks] = *(const GAS bf16x8*)(Qp + 16 * ks + 8 * hi); q2f[ks] = *(const GAS bf16x8*)(Qp + 32 + 16 * ks + 8 * hi); }
    const unsigned char* kvbase = F.ws + WS_KV + ((size_t)(b * 4 + h) * 256) * SLOT + (size_t)wid * 1024 + lane * 16;
    const bool w3 = wid < 3;
#define ATT_DMA1(t, slot) do { const unsigned char* g_ = kvbase + (size_t)(t) * SLOT; LAS unsigned char* d_ = L + (slot) * SLOT + wid * 1024; \
        __builtin_amdgcn_global_load_lds((const unsigned*)g_, (LAS unsigned*)d_, 16, 0, 0); __builtin_amdgcn_global_load_lds((const unsigned*)(g_ + 8192), (LAS unsigned*)(d_ + 8192), 16, 0, 0); \
        if (w3) __builtin_amdgcn_global_load_lds((const unsigned*)(g_ + 16384), (LAS unsigned*)(d_ + 16384), 16, 0, 0); } while (0)
#define ATT_DMA2(pr, ps) do { ATT_DMA1(tlo + 2 * (pr), 2 * (ps)); ATT_DMA1(tlo + 2 * (pr) + 1, 2 * (ps) + 1); } while (0)
    asm volatile("s_waitcnt vmcnt(0)" ::: "memory");
    ATT_DMA2(0, 0);
    if (nP > 1) ATT_DMA2(1, 1);
    float R = 0.f;
    f32x16 O1[2], O2[2], L1, L2;
#pragma unroll
    for (int i = 0; i < 16; ++i) { O1[0][i] = 0.f; O1[1][i] = 0.f; O2[0][i] = 0.f; O2[1][i] = 0.f; L1[i] = 0.f; L2[i] = 0.f; }
    const bf16x8 ones = {(short)0x3F80, (short)0x3F80, (short)0x3F80, (short)0x3F80, (short)0x3F80, (short)0x3F80, (short)0x3F80, (short)0x3F80};
    const int pr32 = (r32 & 0x13) | ((r32 & 4) << 1) | ((r32 & 8) >> 1);
    const int kfo = pr32 * 80 + hi * 16;
    const int vfo = 10240 + r32 * 144 + hi * 16;
    int ps = 0;
    for (int ip = 0; ip < nP; ++ip) {
        if (ip + 1 < nP) { if (w3) ATT_WAITV(6); else ATT_WAITV(4); } else ATT_WAITV(0);
        __builtin_amdgcn_s_barrier();
        asm volatile("" ::: "memory");
        if (ip + 2 < nP) { const int s2 = ps >= 1 ? ps - 1 : 2; ATT_DMA2(ip + 2, s2); }
#pragma unroll
        for (int half = 0; half < 2; ++half) {
            const int t = tlo + 2 * ip + half;
            const LAS unsigned char* Bf = L + (2 * ps + half) * SLOT;
            const float dl = (float)(q - t * 64 - 8 * hi);
            f32x16 c0, c1;
            if (t * 64 + 63 < qw0) {
                const float tl = -slope2 * dl - R;
#pragma unroll
                for (int r = 0; r < 16; ++r) { const float cc = (float)(16 * (r >> 3) + (r & 7)); c0[r] = __builtin_fmaf(slope2, cc, tl); c1[r] = __builtin_fmaf(slope2, cc + 32.f, tl); }
            } else if (t * 64 > qw0 + 31) {
                const float tr = slope2 * dl - R;
#pragma unroll
                for (int r = 0; r < 16; ++r) { const float cc = (float)(16 * (r >> 3) + (r & 7)); c0[r] = __builtin_fmaf(-slope2, cc, tr); c1[r] = __builtin_fmaf(-slope2, cc + 32.f, tr); }
            } else {
#pragma unroll
                for (int r = 0; r < 16; ++r) { const float cc = (float)(16 * (r >> 3) + (r & 7)); c0[r] = __builtin_fmaf(-slope2, __builtin_fabsf(dl - cc), -R); c1[r] = __builtin_fmaf(-slope2, __builtin_fabsf(dl - (cc + 32.f)), -R); }
            }
            v4u pw1[4], pw2[4];
            {
                const bf16x8 k00 = *(const LAS bf16x8*)(Bf + kfo), k01 = *(const LAS bf16x8*)(Bf + kfo + 32), k10 = *(const LAS bf16x8*)(Bf + 32 * 80 + kfo), k11 = *(const LAS bf16x8*)(Bf + 32 * 80 + kfo + 32);
                f32x16 s0 = __builtin_amdgcn_mfma_f32_32x32x16_bf16(k00, q1f[0], c0, 0, 0, 0); s0 = __builtin_amdgcn_mfma_f32_32x32x16_bf16(k01, q1f[1], s0, 0, 0, 0);
                f32x16 s1 = __builtin_amdgcn_mfma_f32_32x32x16_bf16(k10, q1f[0], c1, 0, 0, 0); s1 = __builtin_amdgcn_mfma_f32_32x32x16_bf16(k11, q1f[1], s1, 0, 0, 0);
#define RESC_EXTRA(f) do {} while (0)
                ATT_SOFTMAX(s0, s1, pw1);
#undef RESC_EXTRA
            }
            {
                const bf16x8 k00 = *(const LAS bf16x8*)(Bf + 5120 + kfo), k01 = *(const LAS bf16x8*)(Bf + 5120 + kfo + 32), k10 = *(const LAS bf16x8*)(Bf + 5120 + 32 * 80 + kfo), k11 = *(const LAS bf16x8*)(Bf + 5120 + 32 * 80 + kfo + 32);
                f32x16 s0 = __builtin_amdgcn_mfma_f32_32x32x16_bf16(k00, q2f[0], c0, 0, 0, 0); s0 = __builtin_amdgcn_mfma_f32_32x32x16_bf16(k01, q2f[1], s0, 0, 0, 0);
                f32x16 s1 = __builtin_amdgcn_mfma_f32_32x32x16_bf16(k10, q2f[0], c1, 0, 0, 0); s1 = __builtin_amdgcn_mfma_f32_32x32x16_bf16(k11, q2f[1], s1, 0, 0, 0);
                float p1scale = 1.f;
#define RESC_EXTRA(f) do { p1scale = (f); } while (0)
                ATT_SOFTMAX(s0, s1, pw2);
#undef RESC_EXTRA
                if (__any(p1scale != 1.f)) {
#pragma unroll
                    for (int ks = 0; ks < 4; ++ks)
#pragma unroll
                        for (int e = 0; e < 4; ++e) { const unsigned w = pw1[ks][e]; pw1[ks][e] = cvtpk(bflo(w) * p1scale, bfhi(w) * p1scale); }
                }
            }
#pragma unroll
            for (int db = 0; db < 2; ++db)
#pragma unroll
                for (int ks = 0; ks < 4; ++ks) {
                    const bf16x8 vf = *(const LAS bf16x8*)(Bf + vfo + db * 32 * 144 + ks * 32);
                    O1[db] = __builtin_amdgcn_mfma_f32_32x32x16_bf16(vf, __builtin_bit_cast(bf16x8, pw1[ks]), O1[db], 0, 0, 0);
                    O2[db] = __builtin_amdgcn_mfma_f32_32x32x16_bf16(vf, __builtin_bit_cast(bf16x8, pw2[ks]), O2[db], 0, 0, 0);
                }
#pragma unroll
            for (int ks = 0; ks < 4; ++ks) { L1 = __builtin_amdgcn_mfma_f32_32x32x16_bf16(ones, __builtin_bit_cast(bf16x8, pw1[ks]), L1, 0, 0, 0); L2 = __builtin_amdgcn_mfma_f32_32x32x16_bf16(ones, __builtin_bit_cast(bf16x8, pw2[ks]), L2, 0, 0, 0); }
        }
        ps = ps == 2 ? 0 : ps + 1;
    }
    const float l1 = L1[0], l2 = L2[0];
    const float* dlm = F.in[I_DLAMBDA] + layer * 128;
    float a1 = 0.f, a2 = 0.f;
#pragma unroll 8
    for (int i = 0; i < 32; ++i) { a1 += dlm[i] * dlm[32 + i]; a2 += dlm[64 + i] * dlm[96 + i]; }
    const float lam_init = 0.8f - 0.6f * __expf(-0.3f * (float)layer);
    const float lam = __expf(a1) - __expf(a2) + lam_init;
    const float i1 = 1.f / fmaxf(l1, 1e-30f), i2 = lam / fmaxf(l2, 1e-30f);
    float ss = 0.f;
#pragma unroll
    for (int db = 0; db < 2; ++db)
#pragma unroll
        for (int r = 0; r < 16; ++r) { const float v = O1[db][r] * i1 - O2[db][r] * i2; O1[db][r] = v; ss += v * v; }
    ss += __shfl_xor(ss, 32);
    const float rs = (1.f / sqrtf(ss * (1.f / 64.f) + EPS)) * (1.f - lam_init);
    bf16* orow = (bf16*)(F.ws + WS_O4) + ((size_t)b * SEQ + q) * 1024 + 64 * h;
    const float* sg = F.in[I_DSUBLN] + layer * 64;
#pragma unroll
    for (int db = 0; db < 2; ++db)
#pragma unroll
        for (int g4 = 0; g4 < 4; ++g4) {
            const int d0 = 32 * db + 8 * g4 + 4 * hi;
            const float v0 = O1[db][4 * g4] * rs * sg[d0], v1 = O1[db][4 * g4 + 1] * rs * sg[d0 + 1], v2 = O1[db][4 * g4 + 2] * rs * sg[d0 + 2], v3 = O1[db][4 * g4 + 3] * rs * sg[d0 + 3];
            v2u w = {pk2(v0, v1), pk2(v2, v3)};
            *(GAS v2u*)(orow + d0) = w;
        }
    asm volatile("s_waitcnt lgkmcnt(0)" ::: "memory");
    __builtin_amdgcn_s_barrier();
#undef ATT_DMA1
#undef ATT_DMA2
}
#undef ATT_SOFTMAX
#undef ATT_WAITV
}

namespace pc {
constexpr int MPITCH = 72;
__device__ __forceinline__ void poolconv_phase(Frame& F, const int layer) {
    const int lane = F.lane, r32 = lane & 31, hi = lane >> 5, wid = F.wave;
    const bf16* P = (const bf16*)(F.ws + WS_PROJ);
    bf16* O4 = (bf16*)(F.ws + WS_O4);
    LAS unsigned char* mimg = F.lds + RING_OFF + wid * (64 * MPITCH * 2);
    bf16x8 wf[2][4];
    if (wid < 4) {
        const float* W = F.in[I_POOLW] + ((size_t)layer * 4 + wid) * 64 * 64;
#pragma unroll
        for (int nb = 0; nb < 2; ++nb)
#pragma unroll
            for (int ks = 0; ks < 4; ++ks) { v4u t;
#pragma unroll
                for (int jj = 0; jj < 4; ++jj) t[jj] = pk2(W[(16 * ks + 8 * hi + 2 * jj) * 64 + r32 + 32 * nb], W[(16 * ks + 8 * hi + 2 * jj + 1) * 64 + r32 + 32 * nb]);
                wf[nb][ks] = __builtin_bit_cast(bf16x8, t); }
    }
    for (int tile = F.vcu; tile < NTOK / 64; tile += F.G) {
        const int t0 = tile * 64, s0 = t0 % SEQ;
        if (wid < 4) {
            const int g = wid, hw = 1 << g;
            const bf16* src = P + (size_t)t0 * PJ + C_PIN + 64 * g + lane;
            float cs[81]; cs[0] = 0.f;
#pragma unroll
            for (int i = 0; i < 80; ++i) { const int s = s0 - 8 + i; float v = 0.f; if (s >= 0 && s < SEQ) v = bf2f(src[(long)(i - 8) * PJ]); cs[i + 1] = cs[i] + v; }
#pragma unroll
            for (int i = 0; i < 64; ++i) {
                const int s = s0 + i; int lo = s - hw, hiw = s + hw; lo = lo < 0 ? 0 : lo; hiw = hiw > SEQ ? SEQ : hiw;
                float wsum = 0.f;
                if (g == 0) wsum = cs[i + 8 + 1] - cs[i + 8 - 1]; else if (g == 1) wsum = cs[i + 8 + 2] - cs[i + 8 - 2]; else if (g == 2) wsum = cs[i + 8 + 4] - cs[i + 8 - 4]; else wsum = cs[i + 8 + 8] - cs[i + 8 - 8];
                const float pv = cs[i + 9] - cs[i + 8];
                const float mval = wsum / (float)(hiw - lo) - pv;
                *(LAS unsigned short*)(mimg + i * (MPITCH * 2) + lane * 2) = (unsigned short)f2bf(mval);
            }
            LDS_WAIT();
#pragma unroll
            for (int tb = 0; tb < 2; ++tb) {
                bf16x8 af[4];
#pragma unroll
                for (int ks = 0; ks < 4; ++ks) af[ks] = *(const LAS bf16x8*)(mimg + (r32 + 32 * tb) * (MPITCH * 2) + (16 * ks + 8 * hi) * 2);
#pragma unroll
                for (int nb = 0; nb < 2; ++nb) {
                    f32x16 acc;
#pragma unroll
                    for (int r = 0; r < 16; ++r) acc[r] = 0.f;
#pragma unroll
                    for (int ks = 0; ks < 4; ++ks) acc = __builtin_amdgcn_mfma_f32_32x32x16_bf16(af[ks], wf[nb][ks], acc, 0, 0, 0);
                    const int e = r32 + 32 * nb; const float sc = F.in[I_POOLSCALE][layer * 256 + 64 * g + e];
#pragma unroll
                    for (int r = 0; r < 16; ++r) { const int row = 32 * tb + (r & 3) + 8 * (r >> 2) + 4 * hi;
                        O4[(size_t)(t0 + row) * 1024 + 256 + 64 * g + e] = (bf16)f2bf(acc[r] * sc); }
                }
            }
            LDS_WAIT();
        } else {
            const int ch = 64 * (wid - 4) + lane;
            const float w0 = F.in[I_SCONVW][layer * 768 + ch], w1 = F.in[I_SCONVW][layer * 768 + 256 + ch], w2 = F.in[I_SCONVW][layer * 768 + 512 + ch];
            const bf16* base = P + (size_t)t0 * PJ + ch;
            float zm = 0.f, z0 = 0.f, zp = 0.f;
            if (s0 > 0) zm = bf2f(base[-(long)PJ + C_CC]) * bf2f(base[-(long)PJ + C_CX]);
            z0 = bf2f(base[C_CC]) * bf2f(base[C_CX]);
#pragma unroll 8
            for (int i = 0; i < 64; ++i) {
                zp = 0.f; if (s0 + i + 1 < SEQ) zp = bf2f(base[(long)(i + 1) * PJ + C_CC]) * bf2f(base[(long)(i + 1) * PJ + C_CX]);
                const float cbv = bf2f(base[(long)i * PJ + C_CB]);
                O4[(size_t)(t0 + i) * 1024 + 512 + ch] = (bf16)f2bf(cbv * (w0 * zm + w1 * z0 + w2 * zp));
                zm = z0; z0 = zp;
            }
        }
    }
    __syncthreads();
}
}

namespace dl {
constexpr int MP = 72, MB = 64 * MP * 2;
constexpr int WAVE_LDS = 2 * MB + 2 * MB;
__device__ __forceinline__ int crow(int r, int hi) { return (r & 3) + 8 * (r >> 2) + 4 * hi; }
__device__ __forceinline__ bf16x8 ldfrag(const LAS unsigned char* img, int row, int col) { return *(const LAS bf16x8*)(img + row * (MP * 2) + col * 2); }
__device__ __forceinline__ bf16x8 ldfragp(const LAS unsigned char* img, int row, int col4) {
    const v2u lo = *(const LAS v2u*)(img + row * (MP * 2) + col4 * 2), hi8 = *(const LAS v2u*)(img + row * (MP * 2) + col4 * 2 + 16); const v4u t = {lo.x, lo.y, hi8.x, hi8.y}; return __builtin_bit_cast(bf16x8, t); }
__device__ __forceinline__ bf16x8 cfrag(const f32x16& x, int half) {
    v4u t;
#pragma unroll
    for (int e = 0; e < 4; ++e) t[e] = att::cvtpk(x[8 * half + 2 * e], x[8 * half + 2 * e + 1]);
    return __builtin_bit_cast(bf16x8, t); }
#define MFMA32(a, b, c) __builtin_amdgcn_mfma_f32_32x32x16_bf16((a), (b), (c), 0, 0, 0)
#define SB() __builtin_amdgcn_sched_barrier(0)
#define LAUNDER() do { asm volatile("" : "+v"(lane)); r32 = lane & 31; hi = lane >> 5; } while (0)
__device__ __forceinline__ f32x16 zero16() { f32x16 z;
#pragma unroll
    for (int r = 0; r < 16; ++r) z[r] = 0.f;
    return z; }

#define DL_CONV(colbase, wbase, RAW) do { \
    { const bf16* src_ = P + (size_t)tok0 * PJ + (colbase); const int rr_ = lane >> 3, ch_ = lane & 7; \
      _Pragma("unroll") for (int i_ = 0; i_ < 9; ++i_) { const int row_ = rr_ + 8 * i_; const int sq_ = s0 - 2 + row_; v4u t_ = {0u, 0u, 0u, 0u}; \
          if (row_ < 68 && sq_ >= 0 && sq_ < SEQ) t_ = *(const GAS v4u*)(src_ + (long)(row_ - 2) * PJ + ch_ * 8); if (row_ < 68) *(LAS v4u*)((RAW) + row_ * 128 + ch_ * 16) = t_; } } \
    LDS_WAIT(); \
    const float cw0 = cwp[(wbase) + lane], cw1 = cwp[768 + (wbase) + lane], cw2 = cwp[2 * 768 + (wbase) + lane], cw3 = cwp[3 * 768 + (wbase) + lane], cw4 = cwp[4 * 768 + (wbase) + lane]; \
    const LAS unsigned short* rw_ = (const LAS unsigned short*)(RAW) + lane; \
    _Pragma("unroll") for (int i = 0; i < 64; ++i) { \
        const float cv_ = cw0 * bf2f(rw_[i * 64]) + cw1 * bf2f(rw_[(i + 1) * 64]) + cw2 * bf2f(rw_[(i + 2) * 64]) + cw3 * bf2f(rw_[(i + 3) * 64]) + cw4 * bf2f(rw_[(i + 4) * 64]); \
        cval[i] = cv_ * sigmoidf_(cv_); if ((i & 7) == 7) SB(); } \
    LDS_WAIT(); } while (0)
#define DL_NORM(SQ, scale) do { \
    _Pragma("unroll") for (int i = 0; i < 64; ++i) *(LAS unsigned short*)((SQ) + i * 144 + lane * 2) = (unsigned short)f2bf(cval[i] * cval[i]); \
    LDS_WAIT(); \
    { float sm_ = 0.f; _Pragma("unroll") for (int c8 = 0; c8 < 8; ++c8) { const v4u w_ = *(const LAS v4u*)((SQ) + lane * 144 + c8 * 16); \
          sm_ += (bflo(w_.x) + bfhi(w_.x)) + (bflo(w_.y) + bfhi(w_.y)) + (bflo(w_.z) + bfhi(w_.z)) + (bflo(w_.w) + bfhi(w_.w)); } \
      tab[192 + lane] = (scale) / sqrtf(sm_ + EPS); } \
    LDS_WAIT(); \
    _Pragma("unroll") for (int i4 = 0; i4 < 16; ++i4) { const f32x4 r4_ = *(const LAS f32x4*)(tab + 192 + 4 * i4); cval[4 * i4] *= r4_.x; cval[4 * i4 + 1] *= r4_.y; cval[4 * i4 + 2] *= r4_.z; cval[4 * i4 + 3] *= r4_.w; } \
    } while (0)

__device__ __forceinline__ void d1_instance(Frame& F, const int layer, const int b, const int h, const int norig, const int dir, LAS unsigned char* W, LAS float* tab) {
    int lane = F.lane, r32, hi; LAUNDER();
    const bf16* P = (const bf16*)(F.ws + WS_PROJ);
    const float* cwp = F.in[I_DCONVW] + (size_t)layer * 5 * 768;
    const int s0 = norig * 64, tok0 = b * SEQ + s0;
    const int npr = dir ? 255 - norig : norig;
    const int inst = ((b * 4 + h) * 2 + dir) * NCHUNK + npr;
    LAS unsigned char* VT = W;
    LAS unsigned char* KT = W + MB;
    LAS unsigned char* KR = W + 2 * MB;
    LAS unsigned char* T2 = W + 3 * MB;
    LAS float* SM = (LAS float*)(W + 2 * MB);
    float cval[64];
    DL_CONV(C_DK + 64 * h, 256 + 64 * h, T2);
    DL_NORM(VT, 1.f);
#pragma unroll
    for (int i = 0; i < 64; ++i) { const int ip = dir ? 63 - i : i; const unsigned short kb = (unsigned short)f2bf(cval[i]);
        *(LAS unsigned short*)(KR + ip * (MP * 2) + lane * 2) = kb; *(LAS unsigned short*)(KT + lane * (MP * 2) + ip * 2) = kb; }
    LDS_WAIT();
    DL_CONV(C_DV + 64 * h, 512 + 64 * h, T2);
#pragma unroll
    for (int i = 0; i < 64; ++i) { const int ip = dir ? 63 - i : i; *(LAS unsigned short*)(VT + lane * (MP * 2) + ip * 2) = (unsigned short)f2bf(cval[i]); }
    const int mytok = tok0 + (dir ? 63 - lane : lane);
    const float* BD = (const float*)(F.ws + WS_BD) + (size_t)mytok * 16;
    const float beta = BD[dir * 4 + h]; float gc = BD[8 + dir * 4 + h];
#pragma unroll
    for (int o = 1; o < 64; o <<= 1) { const float t = __shfl_up(gc, o); if (lane >= o) gc += t; }
    const float gl = __shfl(gc, 63);
    tab[lane] = gc; tab[64 + lane] = beta; tab[128 + lane] = __expf(gl - gc);
    LDS_WAIT();
    LAUNDER();
    f32x16 kk[2][2];
#pragma unroll
    for (int tb = 0; tb < 2; ++tb)
#pragma unroll
        for (int tn = 0; tn < 2; ++tn) { f32x16 acc = zero16();
#pragma unroll
            for (int ks = 0; ks < 4; ++ks) acc = MFMA32(ldfrag(KR, r32 + 32 * tb, 16 * ks + 8 * hi), ldfrag(KR, r32 + 32 * tn, 16 * ks + 8 * hi), acc);
            kk[tb][tn] = acc; SB(); }
    LDS_WAIT();
#pragma unroll
    for (int tb = 0; tb < 2; ++tb)
#pragma unroll
        for (int tn = 0; tn < 2; ++tn) {
            const int jc = r32 + 32 * tn; const float gcj = tab[jc];
#pragma unroll
            for (int r = 0; r < 16; ++r) { const int ir = 32 * tb + crow(r, hi); const float gci = tab[ir], bi = tab[64 + ir];
                const float mv = (ir > jc) ? bi * kk[tb][tn][r] * __expf(gci - gcj) : 0.f; SM[ir * 64 + jc] = mv; } SB(); }
    LDS_WAIT();
    LAUNDER();
    float T[64];
#pragma unroll
    for (int i = 0; i < 64; ++i) {
        float a0 = (lane == i) ? 1.f : 0.f, a1 = 0.f, a2 = 0.f, a3 = 0.f;
#pragma unroll
        for (int j4 = 0; j4 < (i + 3) / 4; ++j4) { const f32x4 m4 = *(const LAS f32x4*)(SM + i * 64 + 4 * j4);
            if (4 * j4 + 0 < i) a0 = __builtin_fmaf(-m4[0], T[4 * j4 + 0], a0);
            if (4 * j4 + 1 < i) a1 = __builtin_fmaf(-m4[1], T[4 * j4 + 1], a1);
            if (4 * j4 + 2 < i) a2 = __builtin_fmaf(-m4[2], T[4 * j4 + 2], a2);
            if (4 * j4 + 3 < i) a3 = __builtin_fmaf(-m4[3], T[4 * j4 + 3], a3); }
        T[i] = (a0 + a1) + (a2 + a3); if ((i & 3) == 3) SB(); }
    LDS_WAIT();
    LAUNDER();
    { const float b1 = beta, b2 = beta * __expf(gc);
#pragma unroll
      for (int i = 0; i < 64; ++i) { *(LAS unsigned short*)(KR + i * (MP * 2) + lane * 2) = (unsigned short)f2bf(T[i] * b1); *(LAS unsigned short*)(T2 + i * (MP * 2) + lane * 2) = (unsigned short)f2bf(T[i] * b2); if ((i & 7) == 7) SB(); } }
    LDS_WAIT();
    LAUNDER();
    f32x16 u[2][2], w[2][2];
#pragma unroll
    for (int tb = 0; tb < 2; ++tb)
#pragma unroll
        for (int tn = 0; tn < 2; ++tn) { f32x16 au = zero16(), aw = zero16();
#pragma unroll
            for (int ks = 0; ks < 4; ++ks) { au = MFMA32(ldfrag(KR, r32 + 32 * tb, 16 * ks + 8 * hi), ldfrag(VT, r32 + 32 * tn, 16 * ks + 8 * hi), au);
                                             aw = MFMA32(ldfrag(T2, r32 + 32 * tb, 16 * ks + 8 * hi), ldfrag(KT, r32 + 32 * tn, 16 * ks + 8 * hi), aw); }
            u[tb][tn] = au; w[tb][tn] = aw; SB(); }
    LAUNDER();
    { unsigned* ud = (unsigned*)(F.ws + WS_UW + (size_t)inst * 16384); bf16* wd = (bf16*)(F.ws + WS_UW + (size_t)inst * 16384 + 8192);
#pragma unroll
      for (int tb = 0; tb < 2; ++tb)
#pragma unroll
          for (int tn = 0; tn < 2; ++tn) {
#pragma unroll
              for (int rp = 0; rp < 8; ++rp) ud[((tb * 2 + tn) * 8 + rp) * 64 + lane] = pk2(u[tb][tn][2 * rp], u[tb][tn][2 * rp + 1]);
#pragma unroll
              for (int r = 0; r < 16; ++r) wd[(32 * tb + crow(r, hi)) * 64 + r32 + 32 * tn] = (bf16)f2bf(w[tb][tn][r]); SB(); } }
    LAUNDER();
#pragma unroll
    for (int tb = 0; tb < 2; ++tb)
#pragma unroll
        for (int r = 0; r < 16; ++r) { const float e = tab[128 + 32 * tb + crow(r, hi)];
#pragma unroll
            for (int tn = 0; tn < 2; ++tn) { u[tb][tn][r] *= e; w[tb][tn][r] *= e; } }
    SB();
    bf16x8 kf[2][4];
#pragma unroll
    for (int tbb = 0; tbb < 2; ++tbb)
#pragma unroll
        for (int s = 0; s < 4; ++s) kf[tbb][s] = ldfragp(KT, r32 + 32 * tbb, 16 * s + 4 * hi);
    LDS_WAIT(); SB();
    LAUNDER();
    LAS unsigned char* AR = VT; LAS unsigned char* BT = KR;
#pragma unroll
    for (int tbb = 0; tbb < 2; ++tbb)
#pragma unroll
        for (int tx = 0; tx < 2; ++tx) { f32x16 aa = zero16(), ab = zero16();
#pragma unroll
            for (int s = 0; s < 4; ++s) { aa = MFMA32(cfrag(w[s >> 1][tx], s & 1), kf[tbb][s], aa); ab = MFMA32(kf[tbb][s], cfrag(u[s >> 1][tx], s & 1), ab); }
#pragma unroll
            for (int g4 = 0; g4 < 4; ++g4) {
                const v2u pa = {pk2(-aa[4 * g4], -aa[4 * g4 + 1]), pk2(-aa[4 * g4 + 2], -aa[4 * g4 + 3])};
                *(LAS v2u*)(AR + (r32 + 32 * tbb) * (MP * 2) + (32 * tx + 8 * g4 + 4 * hi) * 2) = pa;
                const v2u pb = {pk2(ab[4 * g4], ab[4 * g4 + 1]), pk2(ab[4 * g4 + 2], ab[4 * g4 + 3])};
                *(LAS v2u*)(BT + (r32 + 32 * tx) * (MP * 2) + (32 * tbb + 8 * g4 + 4 * hi) * 2) = pb;
            } SB(); }
    LDS_WAIT();
    LAUNDER();
    { unsigned char* ab = F.ws + WS_AB + (size_t)inst * 16384; const int m16 = lane & 15, g = lane >> 4;
#pragma unroll
      for (int rb = 0; rb < 4; ++rb)
#pragma unroll
          for (int ks = 0; ks < 2; ++ks) { const v2u lo = *(const LAS v2u*)(AR + (16 * rb + m16) * (MP * 2) + (32 * ks + 4 * g) * 2), hi8 = *(const LAS v2u*)(AR + (16 * rb + m16) * (MP * 2) + (32 * ks + 16 + 4 * g) * 2);
              const v4u t = {lo.x, lo.y, hi8.x, hi8.y}; *(GAS v4u*)(ab + ((rb * 2 + ks) * 64 + lane) * 16) = t; }
#pragma unroll
      for (int sl = 0; sl < 4; ++sl)
#pragma unroll
          for (int rb = 0; rb < 4; ++rb) { const v2u t = *(const LAS v2u*)(BT + (16 * sl + m16) * (MP * 2) + (16 * rb + 4 * g) * 2); *(GAS v2u*)(ab + 8192 + ((sl * 4 + rb) * 64 + lane) * 8) = t; } }
    if (lane == 0) ((float*)(F.ws + WS_DEC))[inst] = __expf(gl);
    LDS_WAIT();
}
__device__ __forceinline__ void d1_phase(Frame& F, const int layer) {
    if (F.wave < 4) {
        LAS unsigned char* W = F.lds + RING_OFF + F.wave * WAVE_LDS; LAS float* tab = (LAS float*)(F.lds + RING_OFF + 4 * WAVE_LDS + F.wave * 1024);
        const int gw = F.vcu * 4 + F.wave, NGW = F.G * 4;
        for (int it = gw; it < NINST; it += NGW) { const int dir = it & 1, u = it >> 1; d1_instance(F, layer, u >> 10, (u >> 8) & 3, u & 255, dir, W, tab); }
    }
    __syncthreads();
}

typedef float f32x4v __attribute__((ext_vector_type(4)));
struct D2Regs { v4u af[4][2]; v2u bm[4]; float dcy; };
__device__ __forceinline__ void d2_chain(Frame& F, const int chain) {
    const int lane = F.lane, n16 = lane & 15, g = lane >> 4, sl = F.wave;
    f32x4v S[4];
#pragma unroll
    for (int rb = 0; rb < 4; ++rb) S[rb] = (f32x4v){0.f, 0.f, 0.f, 0.f};
    const unsigned char* abase = F.ws + WS_AB + (size_t)chain * NCHUNK * 16384;
    unsigned char* sbase = F.ws + WS_ST + (size_t)chain * NCHUNK * 8192;
    const float* dec = (const float*)(F.ws + WS_DEC) + chain * NCHUNK;
    D2Regs q0, q1, q2;
#define D2_LOAD(Q, n) do { const unsigned char* ab_ = abase + (size_t)(n) * 16384; \
    _Pragma("unroll") for (int rb = 0; rb < 4; ++rb) { _Pragma("unroll") for (int ks = 0; ks < 2; ++ks) Q.af[rb][ks] = *(const GAS v4u*)(ab_ + ((rb * 2 + ks) * 64 + lane) * 16); \
        Q.bm[rb] = *(const GAS v2u*)(ab_ + 8192 + ((sl * 4 + rb) * 64 + lane) * 8); } Q.dcy = dec[n]; } while (0)
#define D2_STEP(Q, n) do { \
    unsigned char* st = sbase + (size_t)(n) * 8192 + (16 * sl + n16) * 128; \
    _Pragma("unroll") for (int rb = 0; rb < 4; ++rb) { const v2u t = {pk2(S[rb][0], S[rb][1]), pk2(S[rb][2], S[rb][3])}; *(GAS v2u*)(st + (16 * rb + 4 * g) * 2) = t; } \
    bf16x8 bfr[2]; \
    _Pragma("unroll") for (int ks = 0; ks < 2; ++ks) { const v4u t = {att::cvtpk(S[2 * ks][0], S[2 * ks][1]), att::cvtpk(S[2 * ks][2], S[2 * ks][3]), att::cvtpk(S[2 * ks + 1][0], S[2 * ks + 1][1]), att::cvtpk(S[2 * ks + 1][2], S[2 * ks + 1][3])}; bfr[ks] = __builtin_bit_cast(bf16x8, t); } \
    _Pragma("unroll") for (int rb = 0; rb < 4; ++rb) { const float cd = Q.dcy; \
        f32x4v c = {S[rb][0] * cd + bflo(Q.bm[rb].x), S[rb][1] * cd + bfhi(Q.bm[rb].x), S[rb][2] * cd + bflo(Q.bm[rb].y), S[rb][3] * cd + bfhi(Q.bm[rb].y)}; \
        c = __builtin_amdgcn_mfma_f32_16x16x32_bf16(__builtin_bit_cast(bf16x8, Q.af[rb][0]), bfr[0], c, 0, 0, 0); \
        c = __builtin_amdgcn_mfma_f32_16x16x32_bf16(__builtin_bit_cast(bf16x8, Q.af[rb][1]), bfr[1], c, 0, 0, 0); \
        S[rb] = c; } } while (0)
    D2_LOAD(q0, 0); D2_LOAD(q1, 1);
    for (int n = 0; n < NCHUNK - 1; n += 3) {
        D2_LOAD(q2, n + 2); D2_STEP(q0, n); SB();
        D2_LOAD(q0, n + 3); D2_STEP(q1, n + 1); SB();
        if (n + 4 < NCHUNK) D2_LOAD(q1, n + 4); D2_STEP(q2, n + 2); SB();
    }
    D2_STEP(q0, NCHUNK - 1);
#undef D2_LOAD
#undef D2_STEP
}

__device__ __forceinline__ void scan_attn_phase(Frame& F, const int layer, const int qword) {
    for (;;) {
        { unsigned char* w_ = F.ws; int t_ = F.tid; asm volatile("" : "+s"(w_), "+v"(t_)); F.ws = w_; F.ctl = (gu32*)(w_ + WS_CTL); F.tid = t_; F.lane = t_ & 63; }
        if (F.tid == 0) F.MISC[16] = __hip_atomic_fetch_add(F.ctl + CW_ATTQ + 64 * qword, 1u, RLX_AGENT);
        __syncthreads();
        const int idx = (int)F.MISC[16];
        __syncthreads();
        if (idx >= 16 + BATCH * 4 * 64) break;
        if (idx < 16) { if (F.wave < 4) d2_chain(F, idx); }
        else { const int j = idx - 16, h = 3 - (j >> 7), jj = j & 127, b = jj & 1, k = jj >> 1, qb = (k & 1) ? 31 - (k >> 1) : 32 + (k >> 1);
            att::attn_unit(F, layer, b, h, qb); }
    }
    __syncthreads();
}

__device__ __forceinline__ void d3_unit(Frame& F, const int layer, const int b, const int h, const int norig, LAS unsigned char* W, LAS float* tab) {
    int lane = F.lane, r32, hi; LAUNDER();
    const bf16* P = (const bf16*)(F.ws + WS_PROJ);
    const float* cwp = F.in[I_DCONVW] + (size_t)layer * 5 * 768;
    const int s0 = norig * 64, tok0 = b * SEQ + s0;
    LAS unsigned char* QR = W;
    LAS unsigned char* KR = W + MB;
    LAS unsigned char* AT = W + 2 * MB;
    LAS unsigned char* WR = W + 3 * MB;
    { float cval[64];
      DL_CONV(C_DQ + 64 * h, 64 * h, WR);
      DL_NORM(AT, 0.125f);
#pragma unroll
      for (int i = 0; i < 64; ++i) *(LAS unsigned short*)(QR + i * (MP * 2) + lane * 2) = (unsigned short)f2bf(cval[i]);
      LDS_WAIT();
      DL_CONV(C_DK + 64 * h, 256 + 64 * h, WR);
      DL_NORM(AT, 1.f);
#pragma unroll
      for (int i = 0; i < 64; ++i) *(LAS unsigned short*)(KR + i * (MP * 2) + lane * 2) = (unsigned short)f2bf(cval[i]);
      LDS_WAIT(); }
    f32x16 of[2][2];
#pragma unroll
    for (int dir = 0; dir < 2; ++dir) {
        LAUNDER();
        const int npr = dir ? 255 - norig : norig;
        const int inst = ((b * 4 + h) * 2 + dir) * NCHUNK + npr;
        const int mytok = tok0 + (dir ? 63 - lane : lane);
        float gc = ((const float*)(F.ws + WS_BD))[(size_t)mytok * 16 + 8 + dir * 4 + h];
#pragma unroll
        for (int o = 1; o < 64; o <<= 1) { const float t = __shfl_up(gc, o); if (lane >= o) gc += t; }
        tab[lane] = gc; tab[64 + lane] = __expf(gc);
        { const unsigned char* wg = F.ws + WS_UW + (size_t)inst * 16384 + 8192;
#pragma unroll
          for (int i = 0; i < 8; ++i) { const int idx = i * 64 + lane, row = idx >> 3, ch = idx & 7; const v4u c = *(const GAS v4u*)(wg + idx * 16); *(LAS v4u*)(WR + row * (MP * 2) + ch * 16) = c; } }
        LDS_WAIT();
        LAUNDER();
        const int ra0 = dir ? 63 - r32 : r32, ra1 = dir ? 31 - r32 : 32 + r32;
        f32x16 qk[2][2];
#pragma unroll
        for (int tb = 0; tb < 2; ++tb)
#pragma unroll
            for (int tn = 0; tn < 2; ++tn) { f32x16 acc = zero16();
#pragma unroll
                for (int ks = 0; ks < 4; ++ks) acc = MFMA32(ldfrag(QR, tb ? ra1 : ra0, 16 * ks + 8 * hi), ldfrag(KR, tn ? ra1 : ra0, 16 * ks + 8 * hi), acc);
                qk[tb][tn] = acc; SB(); }
        LDS_WAIT();
#pragma unroll
        for (int tb = 0; tb < 2; ++tb)
#pragma unroll
            for (int tn = 0; tn < 2; ++tn) { const int jc = r32 + 32 * tn; const float gcj = tab[jc];
#pragma unroll
                for (int r = 0; r < 16; ++r) { const int ir = 32 * tb + crow(r, hi); const float gci = tab[ir];
                    const float av = (ir >= jc) ? qk[tb][tn][r] * __expf(gci - gcj) : 0.f; *(LAS unsigned short*)(AT + ir * (MP * 2) + jc * 2) = (unsigned short)f2bf(av); } SB(); }
        LDS_WAIT();
        LAUNDER();
        const unsigned* ud = (const unsigned*)(F.ws + WS_UW + (size_t)inst * 16384);
        const unsigned char* sg = F.ws + WS_ST + (size_t)inst * 8192;
#pragma unroll
        for (int tn = 0; tn < 2; ++tn) {
            bf16x8 sf[4];
#pragma unroll
            for (int ks = 0; ks < 4; ++ks) sf[ks] = *(const GAS bf16x8*)(sg + ((r32 + 32 * tn) * 64 + 16 * ks + 8 * hi) * 2);
            f32x16 vn[2], o[2];
#pragma unroll
            for (int tb = 0; tb < 2; ++tb) { f32x16 a1 = zero16(), a2 = zero16();
#pragma unroll
                for (int ks = 0; ks < 4; ++ks) { a1 = MFMA32(ldfrag(WR, r32 + 32 * tb, 16 * ks + 8 * hi), sf[ks], a1); a2 = MFMA32(ldfrag(QR, tb ? ra1 : ra0, 16 * ks + 8 * hi), sf[ks], a2); }
#pragma unroll
                for (int rp = 0; rp < 8; ++rp) { const unsigned uw = ud[((tb * 2 + tn) * 8 + rp) * 64 + lane]; a1[2 * rp] = bflo(uw) - a1[2 * rp]; a1[2 * rp + 1] = bfhi(uw) - a1[2 * rp + 1]; }
#pragma unroll
                for (int r = 0; r < 16; ++r) a2[r] *= tab[64 + 32 * tb + crow(r, hi)];
                vn[tb] = a1; o[tb] = a2; SB(); }
#pragma unroll
            for (int tb = 0; tb < 2; ++tb) { f32x16 acc = o[tb];
#pragma unroll
                for (int s = 0; s < 4; ++s) acc = MFMA32(ldfragp(AT, r32 + 32 * tb, 16 * s + 4 * hi), cfrag(vn[s >> 1], s & 1), acc);
                o[tb] = acc; SB(); }
            if (dir == 0) { of[0][tn] = o[0]; of[1][tn] = o[1]; }
            else {
#pragma unroll
                for (int tb = 0; tb < 2; ++tb)
#pragma unroll
                    for (int r = 0; r < 16; ++r) of[tb][tn][r] += __shfl_xor(o[1 - tb][15 - r], 32);
            }
        }
        LDS_WAIT();
    }
    const float* dn = F.in[I_DNORM] + layer * 64;
#pragma unroll
    for (int tb = 0; tb < 2; ++tb)
#pragma unroll
        for (int r = 0; r < 16; ++r) {
            float ss = of[tb][0][r] * of[tb][0][r] + of[tb][1][r] * of[tb][1][r];
#pragma unroll
            for (int o = 1; o < 32; o <<= 1) ss += __shfl_xor(ss, o);
            const float rs = 1.f / sqrtf(ss * (1.f / 64.f) + EPS);
            const int tok = tok0 + 32 * tb + crow(r, hi);
#pragma unroll
            for (int tn = 0; tn < 2; ++tn) { const int dv = r32 + 32 * tn; const float z = bf2f(P[(size_t)tok * PJ + C_DZ + 64 * h + dv]);
                ((bf16*)(F.ws + WS_O4))[(size_t)tok * 1024 + 768 + 64 * h + dv] = (bf16)f2bf(of[tb][tn][r] * rs * dn[dv] * siluf_(z)); }
        }
}
__device__ __forceinline__ void d3_phase(Frame& F, const int layer) {
    if (F.wave < 4) {
        LAS unsigned char* W = F.lds + RING_OFF + F.wave * WAVE_LDS; LAS float* tab = (LAS float*)(F.lds + RING_OFF + 4 * WAVE_LDS + F.wave * 1024);
        const int gw = F.vcu * 4 + F.wave, NGW = F.G * 4;
        for (int u = gw; u < BATCH * 4 * NCHUNK; u += NGW) d3_unit(F, layer, u >> 10, (u >> 8) & 3, u & 255, W, tab);
    }
    __syncthreads();
}
#undef MFMA32
}

#ifndef ONLY_SITE
#define ONLY_SITE -1
#endif
#define SITE(k) (ONLY_SITE < 0 || ONLY_SITE == (k))
#ifndef PROBE_MASK
#define PROBE_MASK 0
#endif
#ifndef PROBE_N
#define PROBE_N 2
#endif
#define REPEAT(k) for (int rep_ = 0; rep_ < (((PROBE_MASK >> (k)) & 1) ? PROBE_N : 1); ++rep_)
#ifndef MK_SPLIT
#define MK_SPLIT 0
#endif
struct Args { const float* in[30]; float* out; unsigned char* ws; int ph_lo, ph_hi; };
constexpr int N_PHASES = 1 + 16 * NLAYER + 1;

#define IN_PH() (pid >= lo && pid < hi)
#define FRESH() do { unsigned char* w_ = args.ws; float* o_ = args.out; int t_ = threadIdx.x; asm volatile("" : "+s"(w_), "+s"(o_), "+v"(t_)); F.ws = w_; F.out = o_; F.ctl = (gu32*)(w_ + WS_CTL); F.tid = t_; F.lane = t_ & 63; } while (0)
#define SEAM() do { if (!MK_SPLIT && pid >= lo && pid + 1 < hi) xcd_barrier(bar); ++pid; } while (0)
#define NOSEAM() do { ++pid; } while (0)

template <int l> __device__ __forceinline__ void layer_phases(Frame& F, const Args& args, const XcdBarrier& bar, const int lo, const int hi, int& pid) {
    LAS unsigned char* ring = F.lds + RING_OFF;

        if (IN_PH() && l == 0 && SITE(1)) { FRESH(); p_rows<ROW_A>(F, 0); }
        SEAM();
        if (IN_PH() && SITE(2)) REPEAT(2) { FRESH();
            pg8::SchedStd S; S.init(NTOK / 256, NPROJ / 256, F.G, (int)blockIdx.x, F.ws + WS_H, (size_t)256 * D * 2, w_in_t(F.ws, l), (size_t)256 * D * 2);
            pg8::EpiProj E{(bf16*)(F.ws + WS_QB), (bf16*)(F.ws + WS_KV), (bf16*)(F.ws + WS_PROJ), (unsigned*)(F.ctl + CW_NMAX) + l * 16, QSCALE};
            pg8::gemm_phase<pg8::EpiProj, pg8::SchedStd, D, D, D>(ring, F.tid, S, E);
        }
        SEAM();
        if (IN_PH() && SITE(4)) REPEAT(4) { FRESH(); pc::poolconv_phase(F, l); }
        NOSEAM();
        if (IN_PH() && SITE(5)) REPEAT(5) { FRESH(); dl::d1_phase(F, l); }
        SEAM();
        if (IN_PH() && SITE(3)) REPEAT(3) { FRESH(); dl::scan_attn_phase(F, l, l * 2 + rep_); }
        SEAM();
        NOSEAM();
        if (IN_PH() && SITE(7)) REPEAT(7) { FRESH(); dl::d3_phase(F, l); }
        SEAM();
        if (IN_PH() && SITE(8)) REPEAT(8) { FRESH();
            pg8::SchedBranch S; S.s.init(NTOK / 256, 16, F.G, (int)blockIdx.x, nullptr, 0, nullptr, 0); S.O4 = (const char*)(F.ws + WS_O4); S.Wb = (const char*)w_b_t(F.ws, l);
            pg8::EpiStore E{(bf16*)(F.ws + WS_PBUF), 1024, (size_t)NTOK * 1024, 1.f};
            pg8::gemm_phase<pg8::EpiStore, pg8::SchedBranch, 256, 1024, 256>(ring, F.tid, S, E);
        }
        SEAM();
        if (IN_PH() && SITE(9)) REPEAT(9) { FRESH();
            pg8::SchedGate S{F.vcu, F.G, (const char*)(F.ws + WS_H), (const char*)w_m_t(F.ws, l)};
            pg8::EpiGate E{(const bf16*)(F.ws + WS_PBUF), (bf16*)(F.ws + WS_MERGED), F.in[I_BMERGE] + (size_t)l * 4 * D};
            pg8::gemm_phase<pg8::EpiGate, pg8::SchedGate, D, D, D>(ring, F.tid, S, E);
        }
        SEAM();
        if (IN_PH() && SITE(10)) REPEAT(10) { FRESH();
            pg8::SchedStd S; S.init(NTOK / 256, D / 256, F.G, (int)blockIdx.x, F.ws + WS_MERGED, (size_t)256 * D * 2, w_o_t(F.ws, l), (size_t)256 * D * 2);
            pg8::EpiStore E{(bf16*)(F.ws + WS_F), D, 0, 1.f};
            pg8::gemm_phase<pg8::EpiStore, pg8::SchedStd, D, D, D>(ring, F.tid, S, E);
        }
        SEAM();
        if (IN_PH() && SITE(11)) REPEAT(11) { FRESH(); p_rows<ROW_B>(F, l); }
        SEAM();
        if constexpr (l == 0) {
            if (IN_PH() && SITE(12)) REPEAT(12) { FRESH();
                pg8::SchedStd S; S.init(NTOK / 256, 2 * DFF / 256, F.G, (int)blockIdx.x, F.ws + WS_H, (size_t)256 * D * 2, F.ws + WS_WFFN, (size_t)256 * D * 2);
                pg8::EpiSwiGLU E{(bf16*)(F.ws + WS_ACT0), DFF};
                pg8::gemm_phase<pg8::EpiSwiGLU, pg8::SchedStd, D, D, D>(ring, F.tid, S, E);
            }
            SEAM();
            if (IN_PH() && SITE(13)) REPEAT(13) { FRESH();
                pg8::SchedStd S; S.init(NTOK / 256, D / 256, F.G, (int)blockIdx.x, F.ws + WS_ACT0, (size_t)256 * DFF * 2, F.ws + WS_WFFN + SZ_WGU, (size_t)256 * DFF * 2);
                pg8::EpiStore E{(bf16*)(F.ws + WS_F), D, 0, 1.f};
                pg8::gemm_phase<pg8::EpiStore, pg8::SchedStd, DFF, DFF, DFF>(ring, F.tid, S, E);
            }
            SEAM();
            if (IN_PH() && SITE(14)) REPEAT(14) { FRESH(); p_rows<ROW_C>(F, 0); }
            SEAM();
            NOSEAM(); NOSEAM();
        } else {
            if (IN_PH() && SITE(15)) REPEAT(15) { FRESH(); p_moe_cvt(F); }
            SEAM();
#pragma unroll 1
            for (int pass = 0; pass < 2; ++pass) {
                if (IN_PH() && SITE(16)) REPEAT(16) { FRESH();
                    pg8::SchedMoe S; S.c = (int)blockIdx.x; S.G = F.G; S.nN = 2 * DFF / 256; moe_tiles(F, S.cnt, S.tstart);
                    S.t0 = pass * MOE_PASS_TILES; S.t1 = S.tstart[8] < (pass + 1) * MOE_PASS_TILES ? S.tstart[8] : (pass + 1) * MOE_PASS_TILES;
                    S.A = (const char*)(F.ws + WS_H2B); S.lists = (const int*)(F.ws + WS_ROUTE + 1 * MiB); S.W = (const char*)(F.ws + WS_MOEW); S.w_tile = (size_t)256 * D * 2; S.gather = true;
                    pg8::EpiSwiGLU E{(bf16*)(F.ws + WS_ACT1), DFF};
                    pg8::gemm_phase<pg8::EpiSwiGLU, pg8::SchedMoe, D, D, D, true>(ring, F.tid, S, E);
                }
                SEAM();
                if (IN_PH() && SITE(17)) REPEAT(17) { FRESH();
                    pg8::SchedMoe S; S.c = (int)blockIdx.x; S.G = F.G; S.nN = D / 256; moe_tiles(F, S.cnt, S.tstart);
                    S.t0 = pass * MOE_PASS_TILES; S.t1 = S.tstart[8] < (pass + 1) * MOE_PASS_TILES ? S.tstart[8] : (pass + 1) * MOE_PASS_TILES;
                    S.A = (const char*)(F.ws + WS_ACT1); S.lists = nullptr; S.W = (const char*)(F.ws + WS_MOEW + SZ_WGU); S.w_tile = (size_t)256 * DFF * 2; S.gather = false;
                    pg8::EpiStore E{(bf16*)(F.ws + WS_Y), D, 0, 1.f};
                    pg8::gemm_phase<pg8::EpiStore, pg8::SchedMoe, DFF, DFF, DFF>(ring, F.tid, S, E);
                }
                SEAM();
            }
        }
    }

__global__ void __launch_bounds__(NWAVES * 64, 2) fwd_kernel(const Args args) {
    extern __shared__ __attribute__((aligned(16))) unsigned char lds[];
    Frame F;
    F.lds = (LAS unsigned char*)lds;
    F.MISC = (volatile LAS unsigned*)(F.lds + MISC_OFF);
    F.tid = threadIdx.x; F.lane = F.tid & 63; F.wave = __builtin_amdgcn_readfirstlane(F.tid >> 6);
    F.G = gridDim.x; { const int bx = blockIdx.x; F.vcu = (F.G % 8 == 0) ? (bx % 8) * (F.G / 8) + bx / 8 : bx; }
    F.ws = args.ws; F.out = args.out; F.ctl = (gu32*)(args.ws + WS_CTL);
    F.in = args.in;
    if (F.tid < 64) ((LAS unsigned*)(F.lds + MISC_OFF))[F.tid] = 0u;
    __syncthreads();
    XcdBarrier bar; bar.bar = (unsigned*)(F.ctl + CW_BAR); bar.x = 0; bar.st = nullptr;
    if (!MK_SPLIT) bar = xcd_barrier_post((unsigned*)(F.ctl + CW_BAR), F.MISC + 8);
    const int lo = args.ph_lo, hi = args.ph_hi;
    int pid = 0;
    LAS unsigned char* ring = F.lds + RING_OFF;

    if (IN_PH() && SITE(0)) REPEAT(0) { FRESH(); p_prologue(F); }
    SEAM();
    layer_phases<0>(F, args, bar, lo, hi, pid);
    layer_phases<1>(F, args, bar, lo, hi, pid);
    if (IN_PH() && SITE(18)) REPEAT(18) { FRESH(); p_rows<ROW_C>(F, 1); }
#undef IN_PH
#undef SEAM
#undef NOSEAM
}

extern "C" void kernel_launch(void* const* d_in, const int* in_sizes, int n_in, void* d_out, int out_size, void* d_ws, size_t ws_size, hipStream_t stream) {
    static int grid = 0;
    if (grid == 0) {
        if (n_in != N_INPUTS || in_sizes[0] != NTOK * D || out_size != NTOK * D || ws_size < WS_END) {
            fprintf(stderr, "kernel_launch: unexpected problem (n_in %d, in0 %d, out %d, ws %zu < %zu); nothing launched\n", n_in, n_in > 0 ? in_sizes[0] : -1, out_size, ws_size, (size_t)WS_END); grid = -1; return; }
        int dev = 0, cus = 0, per_cu = 0;
        if (hipGetDevice(&dev) != hipSuccess || hipDeviceGetAttribute(&cus, hipDeviceAttributeMultiprocessorCount, dev) != hipSuccess) { grid = -1; return; }
        if (hipFuncSetAttribute((const void*)fwd_kernel, hipFuncAttributeMaxDynamicSharedMemorySize, LDS_BYTES) != hipSuccess) { fprintf(stderr, "kernel_launch: hipFuncSetAttribute failed\n"); grid = -1; return; }
        if (hipOccupancyMaxActiveBlocksPerMultiprocessor(&per_cu, (const void*)fwd_kernel, NWAVES * 64, LDS_BYTES) != hipSuccess || per_cu < 1)
            fprintf(stderr, "kernel_launch: note: occupancy query reports %d workgroups per CU\n", per_cu);
        (void)hipGetLastError();
        grid = cus;
    }
    if (grid < 0) return;
    if (hipMemsetAsync((char*)d_ws + WS_CTL, 0, CTL_ZERO_BYTES, stream) != hipSuccess) return;
    Args a{};
    for (int i = 0; i < 30; ++i) a.in[i] = (const float*)d_in[i];
    a.out = (float*)d_out; a.ws = (unsigned char*)d_ws;
#if MK_SPLIT
    for (int p = 0; p < N_PHASES; ++p) { a.ph_lo = p; a.ph_hi = p + 1; hipLaunchKernelGGL(fwd_kernel, dim3(grid), dim3(NWAVES * 64), LDS_BYTES, stream, a); }
#else
    a.ph_lo = 0; a.ph_hi = N_PHASES;
    hipLaunchKernelGGL(fwd_kernel, dim3(grid), dim3(NWAVES * 64), LDS_BYTES, stream, a);
#endif
}
```

```cpp
#include <hip/hip_runtime.h>
#include <cstdio>
#include <cstdint>

namespace pg8 {
#define PG8_LAS __attribute__((address_space(3)))
typedef unsigned short bf16_t;
typedef short bf16x8 __attribute__((ext_vector_type(8)));
typedef float f32x4 __attribute__((ext_vector_type(4)));
typedef unsigned u32x4 __attribute__((ext_vector_type(4)));
typedef unsigned u32x2 __attribute__((ext_vector_type(2)));
constexpr int BM = 256, BK = 64, HALF = 128, HTB = HALF * BK * 2  , STAGE_BYTES = 8 * HTB;

__host__ __device__ __forceinline__ int lds_byte(int r, int c) { const int st = (r >> 4) * 2 + (c >> 5), rr = r & 15, cc = c & 31, ob = rr * 64 + cc * 2; return st * 1024 + (ob ^ (((ob >> 9) & 1) << 5)); }
__host__ __device__ __forceinline__ void stage_rc(int b, int& R, int& C) { const int st = b / 1024, sb = b % 1024, swz = sb ^ (((sb >> 9) & 1) << 5); R = (st >> 1) * 16 + swz / 64; C = (st & 1) * 32 + (swz % 64) / 2; }
__host__ __device__ __forceinline__ int perm32(int rho) { const int n = rho >> 4, i = rho & 15; return 8 * (i >> 2) + 4 * n + (i & 3); }

struct Unit { int pm, pn, aux, pad; const char* a; const char* b; const int* rows; };

__device__ __forceinline__ unsigned cvt_pk_bf16(float lo, float hi) { unsigned r; asm volatile("v_cvt_pk_bf16_f32 %0, %1, %2" : "=v"(r) : "v"(lo), "v"(hi)); return r; }


template <class Epi, class Sched, int K, int lda, int ldb, bool GATHER = false, bool ALIGN_EPI = true, bool SP2 = true>
__device__ __forceinline__ void gemm_phase(PG8_LAS unsigned char* lds, const int tid, const Sched& S, const Epi& E) {
    const int wid = __builtin_amdgcn_readfirstlane(tid >> 6), lane = tid & 63, wr = wid >> 2, wc = wid & 3, fr = lane & 15, fq = lane >> 4;
    constexpr int nt = K / BK;
    int Rs[2], Cs[2]; unsigned voffB[2];
#pragma unroll
    for (int i = 0; i < 2; ++i) { int R, C; stage_rc(tid * 16 + i * 8192, R, C); const int Rb = Epi::PERM ? ((R & ~31) + perm32(R & 31)) : R; Rs[i] = R; Cs[i] = C; voffB[i] = (unsigned)(Rb * ldb + C) * 2u; }
    const size_t kstep = (size_t)(BK * 2);
    const size_t hstepB = (size_t)HALF * ldb * 2;
    const unsigned ldsw = (unsigned)wid * 1024u;
    const int aoff = lds_byte(wr * 64 + fr, fq * 8), boff = lds_byte(wc * 32 + fr, fq * 8);
#define PG8_SA(b, h) (((b) * 2 + (h)) * HTB)
#define PG8_SB(b, h) ((4 + (b) * 2 + (h)) * HTB)
#define PG8_STAGE(bufoff, gbase, voff) do { _Pragma("unroll") for (int _i = 0; _i < 2; ++_i) \
        __builtin_amdgcn_global_load_lds((const unsigned*)((const char*)(gbase) + (voff)[_i]), (PG8_LAS unsigned*)(lds + (bufoff) + ldsw + _i * 8192), 16, 0, 0); } while (0)
#define PG8_LDA(dst, b, h) do { _Pragma("unroll") for (int m = 0; m < 4; ++m) _Pragma("unroll") for (int k = 0; k < 2; ++k) dst[m][k] = *(const PG8_LAS bf16x8*)(lds + PG8_SA(b, h) + aoff + m * 2048 + k * 1024); } while (0)
#define PG8_LDB(dst, b, h) do { _Pragma("unroll") for (int n = 0; n < 2; ++n) _Pragma("unroll") for (int k = 0; k < 2; ++k) dst[n][k] = *(const PG8_LAS bf16x8*)(lds + PG8_SB(b, h) + boff + n * 2048 + k * 1024); } while (0)
#define PG8_MMA(ai, bj, At, Bt) do { __builtin_amdgcn_s_setprio(1); _Pragma("unroll") for (int m = 0; m < 4; ++m) _Pragma("unroll") for (int n = 0; n < 2; ++n) _Pragma("unroll") for (int k = 0; k < 2; ++k) \
        acc[ai][bj][m][n] = __builtin_amdgcn_mfma_f32_16x16x32_bf16(Bt[n][k], At[m][k], acc[ai][bj][m][n], 0, 0, 0); __builtin_amdgcn_s_setprio(0); } while (0)
#define PG8_WAIT_V(n) asm volatile("s_waitcnt vmcnt(" #n ")" ::: "memory")
#define PG8_WAIT_L(n) asm volatile("s_waitcnt lgkmcnt(" #n ")" ::: "memory")
#define PG8_BAR __builtin_amdgcn_s_barrier()
#define PG8_SCHED __builtin_amdgcn_sched_barrier(0)
    Unit cur, nxt; int ui = 0;
    if (!S.next(0, cur)) return;
    f32x4 acc[2][2][4][2];
#pragma unroll
    for (int a = 0; a < 2; ++a)
#pragma unroll
        for (int b = 0; b < 2; ++b)
#pragma unroll
            for (int m = 0; m < 4; ++m)
#pragma unroll
                for (int n = 0; n < 2; ++n) acc[a][b][m][n] = (f32x4){0.f, 0.f, 0.f, 0.f};
    bf16x8 At[4][2], B0[2][2], B1[2][2];
    unsigned cOff[2][2], nOff[2][2];
#pragma unroll
    for (int hh = 0; hh < 2; ++hh)
#pragma unroll
        for (int i = 0; i < 2; ++i) {
            if constexpr (GATHER) { const int ridx = hh * HALF + Rs[i]; int tk = cur.rows[ridx]; tk = ridx < cur.aux ? tk : 0; cOff[hh][i] = (unsigned)(tk * lda + Cs[i]) * 2u; }
            else cOff[hh][i] = (unsigned)((hh * HALF + Rs[i]) * lda + Cs[i]) * 2u;
            if constexpr (GATHER) nOff[hh][i] = cOff[hh][i]; else nOff[hh][i] = 0u;
        }
    const char* cA = cur.a; const char* cB = cur.b;
    S.a_ready(cur);
    if constexpr (SP2) {
        PG8_STAGE(PG8_SB(0, 0), cB, voffB); PG8_STAGE(PG8_SB(0, 1), cB + hstepB, voffB); PG8_STAGE(PG8_SA(0, 0), cA, cOff[0]); PG8_STAGE(PG8_SA(0, 1), cA, cOff[1]);
        if (wr == 1) PG8_BAR;
        PG8_WAIT_V(2); PG8_BAR;
        PG8_STAGE(PG8_SB(1, 0), cB + kstep, voffB); PG8_STAGE(PG8_SA(1, 0), cA + kstep, cOff[0]); PG8_STAGE(PG8_SB(1, 1), cB + hstepB + kstep, voffB);
        PG8_WAIT_V(6); PG8_BAR;
    } else {
        PG8_STAGE(PG8_SB(0, 0), cB, voffB); PG8_STAGE(PG8_SA(0, 0), cA, cOff[0]); PG8_STAGE(PG8_SB(0, 1), cB + hstepB, voffB); PG8_STAGE(PG8_SA(0, 1), cA, cOff[1]);
        if (wr == 1) PG8_BAR;
        PG8_WAIT_V(4); PG8_BAR;
        PG8_STAGE(PG8_SB(1, 0), cB + kstep, voffB); PG8_STAGE(PG8_SA(1, 0), cA + kstep, cOff[0]); PG8_STAGE(PG8_SB(1, 1), cB + hstepB + kstep, voffB);
        PG8_WAIT_V(6); PG8_BAR;
    }
    for (;;) {
        const bool has_next = S.next(ui + 1, nxt);
        const char* nA = has_next ? nxt.a : cA; const char* nB = has_next ? nxt.b : cB;
        if constexpr (GATHER) {
            if (has_next) {
#pragma unroll
                for (int hh = 0; hh < 2; ++hh)
#pragma unroll
                    for (int i = 0; i < 2; ++i) { const int ridx = hh * HALF + Rs[i]; int tk = nxt.rows[ridx]; tk = ridx < nxt.aux ? tk : 0; nOff[hh][i] = (unsigned)(tk * lda + Cs[i]) * 2u; }
            } else {
#pragma unroll
                for (int hh = 0; hh < 2; ++hh)
#pragma unroll
                    for (int i = 0; i < 2; ++i) nOff[hh][i] = cOff[hh][i];
            }
        }
#pragma unroll 1
        for (int t = 0; t < nt; t += 2) {
            const bool last = (t == nt - 2);
            const char* a1 = cA + (size_t)(t + 1) * kstep;
            const char* a2 = last ? nA : cA + (size_t)(t + 2) * kstep; const char* b2 = last ? nB : cB + (size_t)(t + 2) * kstep;
            const char* a3 = a2 + kstep; const char* b3 = b2 + kstep;
            unsigned o2[2][2];
#pragma unroll
            for (int hh = 0; hh < 2; ++hh)
#pragma unroll
                for (int i = 0; i < 2; ++i) { if constexpr (GATHER) o2[hh][i] = last ? nOff[hh][i] : cOff[hh][i]; else o2[hh][i] = cOff[hh][i]; }
            if (last && has_next) S.a_ready(nxt);
            if constexpr (SP2) {
            PG8_LDB(B0, 0, 0); PG8_LDB(B1, 0, 1); PG8_SCHED; PG8_LDA(At, 0, 0); PG8_STAGE(PG8_SA(1, 1), a1, cOff[1]);
            PG8_WAIT_V(8); PG8_WAIT_L(0); PG8_BAR; PG8_MMA(0, 0, At, B0); PG8_MMA(0, 1, At, B1); PG8_BAR; PG8_SCHED;
            PG8_LDA(At, 0, 1); PG8_STAGE(PG8_SB(0, 0), b2, voffB); PG8_STAGE(PG8_SB(0, 1), b2 + hstepB, voffB); PG8_STAGE(PG8_SA(0, 0), a2, o2[0]);
            PG8_WAIT_V(8); PG8_WAIT_L(0); PG8_BAR; PG8_MMA(1, 0, At, B0); PG8_MMA(1, 1, At, B1); PG8_BAR; PG8_SCHED;
            PG8_LDB(B0, 1, 0); PG8_LDB(B1, 1, 1); PG8_SCHED; PG8_LDA(At, 1, 0); PG8_STAGE(PG8_SA(0, 1), a2, o2[1]);
            PG8_WAIT_V(8); PG8_WAIT_L(0); PG8_BAR; PG8_MMA(0, 0, At, B0); PG8_MMA(0, 1, At, B1); PG8_BAR; PG8_SCHED;
            PG8_LDA(At, 1, 1); PG8_STAGE(PG8_SB(1, 0), b3, voffB); PG8_STAGE(PG8_SB(1, 1), b3 + hstepB, voffB); PG8_STAGE(PG8_SA(1, 0), a3, o2[0]);
            PG8_WAIT_V(8); PG8_WAIT_L(0); PG8_BAR; PG8_MMA(1, 0, At, B0); PG8_MMA(1, 1, At, B1); PG8_BAR; PG8_SCHED;
            } else {
            PG8_LDB(B0, 0, 0); PG8_SCHED; PG8_LDA(At, 0, 0); PG8_STAGE(PG8_SA(1, 1), a1, cOff[1]);
            PG8_WAIT_L(8); PG8_BAR; PG8_WAIT_L(0); PG8_MMA(0, 0, At, B0); PG8_BAR; PG8_SCHED;
            PG8_LDB(B1, 0, 1); PG8_STAGE(PG8_SB(0, 0), b2, voffB);
            PG8_BAR; PG8_WAIT_L(0); PG8_MMA(0, 1, At, B1); PG8_BAR;
            PG8_LDA(At, 0, 1); PG8_STAGE(PG8_SA(0, 0), a2, o2[0]);
            PG8_BAR; PG8_WAIT_L(0); PG8_MMA(1, 0, At, B0); PG8_BAR; PG8_SCHED;
            PG8_STAGE(PG8_SB(0, 1), b2 + hstepB, voffB);
            PG8_WAIT_V(6); PG8_BAR; PG8_MMA(1, 1, At, B1); PG8_BAR;
            PG8_LDB(B0, 1, 0); PG8_SCHED; PG8_LDA(At, 1, 0); PG8_STAGE(PG8_SA(0, 1), a2, o2[1]);
            PG8_WAIT_L(8); PG8_BAR; PG8_WAIT_L(0); PG8_MMA(0, 0, At, B0); PG8_BAR; PG8_SCHED;
            PG8_LDB(B1, 1, 1); PG8_STAGE(PG8_SB(1, 0), b3, voffB);
            PG8_BAR; PG8_WAIT_L(0); PG8_MMA(0, 1, At, B1); PG8_BAR;
            PG8_LDA(At, 1, 1); PG8_STAGE(PG8_SA(1, 0), a3, o2[0]);
            PG8_BAR; PG8_WAIT_L(0); PG8_MMA(1, 0, At, B0); PG8_BAR; PG8_SCHED;
            PG8_STAGE(PG8_SB(1, 1), b3 + hstepB, voffB);
            PG8_WAIT_V(6); PG8_BAR; PG8_MMA(1, 1, At, B1); PG8_BAR;
            }
        }
        if constexpr (ALIGN_EPI) { if (wr == 0) PG8_BAR; }
        E(acc, cur, wr, wc, fr, fq); S.done(cur);
        if (!has_next) break;
#pragma unroll
        for (int a = 0; a < 2; ++a)
#pragma unroll
            for (int b = 0; b < 2; ++b)
#pragma unroll
                for (int m = 0; m < 4; ++m)
#pragma unroll
                    for (int n = 0; n < 2; ++n) acc[a][b][m][n] = (f32x4){0.f, 0.f, 0.f, 0.f};
        cur = nxt; cA = nA; cB = nB; ++ui;
        if constexpr (GATHER) {
#pragma unroll
            for (int hh = 0; hh < 2; ++hh)
#pragma unroll
                for (int i = 0; i < 2; ++i) cOff[hh][i] = nOff[hh][i];
        }
        if constexpr (ALIGN_EPI) { if (wr == 1) PG8_BAR; }
    }
    PG8_WAIT_V(0);
    if constexpr (!ALIGN_EPI) { if (wr == 0) PG8_BAR; }
    PG8_BAR;
#undef PG8_SA
#undef PG8_SB
#undef PG8_STAGE
#undef PG8_LDA
#undef PG8_LDB
#undef PG8_MMA
#undef PG8_WAIT_V
#undef PG8_WAIT_L
#undef PG8_BAR
#undef PG8_SCHED
}
}

constexpr int NWAVES = 8;
constexpr int BATCH = 2, SEQ = 16384, D = 1024, NTOK = BATCH * SEQ;
constexpr int NLAYER = 2;
constexpr int NPROJ = 2816, IN_COLS = 2832;
constexpr int PJ = 2048;
constexpr int C_PIN = 0, C_CB = 256, C_CC = 512, C_CX = 768, C_DQ = 1024, C_DK = 1280, C_DV = 1536, C_DZ = 1792;
constexpr int DFF = 2816, NEXP = 8;
constexpr int NCHUNK = SEQ / 64;
constexpr int NINST = BATCH * 4 * 2 * NCHUNK;
constexpr float EPS = 1e-6f;
constexpr float QSCALE = 0.17677669529663687f * 1.4426950408889634f;
constexpr int MOE_PASS_TILES = 132;

constexpr size_t MiB = 1u << 20;
constexpr size_t WS_CTL = 0, CTL_ZERO_BYTES = 1 * MiB;
constexpr size_t SZ_WIN = (size_t)NPROJ * D * 2, SZ_WM = (size_t)4096 * D * 2, SZ_WB = (size_t)4 * 1024 * 256 * 2, SZ_WO = (size_t)D * D * 2;
constexpr size_t SZ_LAYERW = SZ_WIN + SZ_WM + SZ_WB + SZ_WO;
constexpr size_t SZ_WGU = (size_t)2 * DFF * D * 2, SZ_WD = (size_t)D * DFF * 2, SZ_FFNW = SZ_WGU + SZ_WD;
constexpr size_t WS_W = 1 * MiB;
constexpr size_t WS_WFFN = WS_W + 2 * SZ_LAYERW;
static_assert(WS_WFFN + SZ_FFNW <= 53 * MiB, "weights");
constexpr size_t WS_H = 53 * MiB;
constexpr size_t WS_O4 = 117 * MiB;
constexpr size_t WS_F = WS_O4;
constexpr size_t WS_BD = 181 * MiB;
constexpr size_t WS_DEC = 183 * MiB;
constexpr size_t WS_PROJ = 185 * MiB;
constexpr size_t WS_QB = 521 * MiB;
constexpr size_t WS_KV = 313 * MiB;
constexpr size_t WS_UW = 361 * MiB;
constexpr size_t WS_AB = 425 * MiB;
constexpr size_t WS_ST = 489 * MiB;
constexpr size_t WS_PBUF = 185 * MiB;
constexpr size_t WS_MERGED = 441 * MiB;
constexpr size_t WS_ACT0 = 185 * MiB;
constexpr size_t WS_H2B = 479 * MiB;
constexpr size_t WS_MOEW = 185 * MiB;
constexpr size_t WS_ACT1 = 1 * MiB;
constexpr size_t WS_Y = 317 * MiB;
constexpr size_t WS_ROUTE = 449 * MiB;
constexpr size_t WS_END = 543 * MiB;
static_assert(WS_ACT1 + (size_t)MOE_PASS_TILES * 256 * DFF * 2 <= WS_MOEW, "act1");
static_assert(WS_MOEW + 8 * SZ_FFNW <= WS_Y && WS_Y + (size_t)264 * 256 * D * 2 <= WS_ROUTE && WS_ROUTE + 4 * MiB <= WS_H2B && WS_H2B + 64 * MiB <= WS_END, "moe map");
static_assert(WS_PROJ + (size_t)NTOK * PJ * 2 <= WS_KV && WS_KV + (size_t)8 * 256 * 19456 <= WS_UW && WS_QB + 16 * MiB <= WS_END && WS_ST + (size_t)NINST * 8192 <= WS_END, "mixer map");
constexpr int CW_TMO = 0, CW_CODE = 1;
constexpr int CW_BAR = 4096;
constexpr int CW_MOD = 16384;
constexpr int CW_MOECNT = 65536;
constexpr int CW_NMAX = 66560;
constexpr int CW_MODCNT = 66624;
constexpr int CW_ATTQ = 66688;
static_assert(CW_MOD + NLAYER * BATCH * 6 * D <= CW_MOECNT && (CW_ATTQ + 32 * 64) * 4 <= (int)CTL_ZERO_BYTES, "ctl");

constexpr int RING_OFF = 0, RING_BYTES = 131072;
constexpr int LDS_BYTES = 160 * 1024;
constexpr int MISC_OFF = LDS_BYTES - 256;

#define GAS __attribute__((address_space(1)))
#define LAS __attribute__((address_space(3)))
typedef unsigned short bf16;
typedef unsigned v4u __attribute__((ext_vector_type(4)));
typedef unsigned v2u __attribute__((ext_vector_type(2)));
typedef float f32x4 __attribute__((ext_vector_type(4)));
typedef float f32x16 __attribute__((ext_vector_type(16)));
typedef short bf16x8 __attribute__((ext_vector_type(8)));
typedef short bf16x4 __attribute__((ext_vector_type(4)));
typedef GAS unsigned gu32;
#define RLX_AGENT __ATOMIC_RELAXED, __HIP_MEMORY_SCOPE_AGENT
#define LDS_WAIT() asm volatile("s_waitcnt lgkmcnt(0)" ::: "memory")
#define VM_WAIT() asm volatile("s_waitcnt vmcnt(0)" ::: "memory")
__device__ __forceinline__ unsigned f2bf(float f) { unsigned u = __builtin_bit_cast(unsigned, f); return (u + 0x7fffu + ((u >> 16) & 1u)) >> 16; }
__device__ __forceinline__ unsigned pk2(float lo, float hi) { return f2bf(lo) | (f2bf(hi) << 16); }
__device__ __forceinline__ float bf2f(unsigned b) { return __builtin_bit_cast(float, b << 16); }
__device__ __forceinline__ float bflo(unsigned w) { return __builtin_bit_cast(float, w << 16); }
__device__ __forceinline__ float bfhi(unsigned w) { return __builtin_bit_cast(float, w & 0xffff0000u); }
__device__ __forceinline__ float fast_exp2(float x) { return __builtin_amdgcn_exp2f(x); }
__device__ __forceinline__ float fast_exp(float x) { return __builtin_amdgcn_exp2f(x * 1.4426950408889634f); }
__device__ __forceinline__ float fast_rcp(float x) { return __builtin_amdgcn_rcpf(x); }
__device__ __forceinline__ float sigmoidf_(float x) { return fast_rcp(1.f + fast_exp(-x)); }
__device__ __forceinline__ float siluf_(float x) { return x * sigmoidf_(x); }
__device__ __forceinline__ float wave_sum(float v) {
    v += __builtin_bit_cast(float, __builtin_amdgcn_update_dpp(0, __builtin_bit_cast(int, v), 0xB1, 0xf, 0xf, true));
    v += __builtin_bit_cast(float, __builtin_amdgcn_update_dpp(0, __builtin_bit_cast(int, v), 0x4E, 0xf, 0xf, true));
    v += __builtin_bit_cast(float, __builtin_amdgcn_update_dpp(0, __builtin_bit_cast(int, v), 0x141, 0xf, 0xf, true));
    v += __builtin_bit_cast(float, __builtin_amdgcn_update_dpp(0, __builtin_bit_cast(int, v), 0x140, 0xf, 0xf, true));
    v += __builtin_bit_cast(float, __builtin_amdgcn_ds_swizzle(__builtin_bit_cast(int, v), 0x401f));
    v += __shfl_xor(v, 32);
    return v;
}

#define XB_TMO      128
#define XB_XCNT(j)  (256  + 64 * (j))
#define XB_XSUB(j)  (1280 + 64 * (j))
#define XB_XGEN(j)  (2304 + 64 * (j))
#define XB_TOP      3328
#define XB_TOPGEN   3392
#define XCD_BAR_WORDS 3456
#define XB_SPIN_CAP (1u << 22)
__device__ __forceinline__ unsigned xb_ld(unsigned* p)              { return __hip_atomic_load(p, __ATOMIC_RELAXED, __HIP_MEMORY_SCOPE_AGENT); }
__device__ __forceinline__ unsigned xb_add(unsigned* p, unsigned v) { return __hip_atomic_fetch_add(p, v, __ATOMIC_RELAXED, __HIP_MEMORY_SCOPE_AGENT); }
__device__ __forceinline__ unsigned xb_xcc_id() { return (unsigned)__builtin_amdgcn_s_getreg((3 << 11) | 20) & 0xFu; }
#define XB_SPIN(cond, bar) do { unsigned _sp = 0; while (cond) { __builtin_amdgcn_s_sleep(1); \
    if ((++_sp & 255u) == 0u) { if (xb_ld(&(bar)[XB_TMO])) break; if (_sp > XB_SPIN_CAP) { atomicAdd(&(bar)[XB_TMO], 1u); break; } } } } while (0)
struct XcdBarrier { unsigned* bar; unsigned x; volatile LAS unsigned* st; };
__device__ __forceinline__ XcdBarrier xcd_barrier_post(unsigned* bar, volatile LAS unsigned* st) {
    XcdBarrier b; b.bar = bar; b.x = xb_xcc_id(); b.st = st;
    if (threadIdx.x == 0) (void)xb_add(&bar[XB_XCNT(b.x)], 1u);
    return b;
}
__device__ __forceinline__ void xcd_barrier_complete(unsigned* bar, unsigned x, unsigned& nloc, unsigned& nx) {
    const unsigned G = gridDim.x * gridDim.y * gridDim.z;
    unsigned sum, cnt, mine, sp = 0u;
    for (;;) {
        sum = 0u; cnt = 0u; mine = 0u;
#pragma unroll
        for (unsigned j = 0; j < 16; ++j) { const unsigned c = xb_ld(&bar[XB_XCNT(j)]); sum += c; cnt += (c > 0u) ? 1u : 0u; }
        mine = xb_ld(&bar[XB_XCNT(x)]);
        if (sum == G) break;
        __builtin_amdgcn_s_sleep(1);
        if ((++sp & 255u) == 0u) { if (xb_ld(&bar[XB_TMO])) break; if (sp > XB_SPIN_CAP) { atomicAdd(&bar[XB_TMO], 1u); break; } }
    }
    nloc = mine > 0u ? mine : 1u; nx = cnt > 0u ? cnt : 1u;
}
__device__ __forceinline__ void xcd_barrier(const XcdBarrier& b) {
    asm volatile("s_waitcnt vmcnt(0)" ::: "memory");
    __syncthreads();
    if (threadIdx.x == 0) {
        unsigned* bar = b.bar;
        __builtin_amdgcn_s_waitcnt(0);
        unsigned nloc = b.st[0], nx = b.st[1];
        if (nloc == 0u) { xcd_barrier_complete(bar, b.x, nloc, nx); b.st[0] = nloc; b.st[1] = nx; }
        const unsigned old = xb_add(&bar[XB_XSUB(b.x)], 1u);
        const unsigned gen = old / nloc;
        if (old + 1u == (gen + 1u) * nloc) {
            __builtin_amdgcn_fence(__ATOMIC_RELEASE, "agent");
            asm volatile("s_waitcnt vmcnt(0)" ::: "memory");
            const unsigned og = xb_add(&bar[XB_TOP], 1u);
            const unsigned tg = og / nx;
            if (og + 1u == (tg + 1u) * nx) xb_add(&bar[XB_TOPGEN], 1u);
            else XB_SPIN(xb_ld(&bar[XB_TOPGEN]) == tg, bar);
            __builtin_amdgcn_fence(__ATOMIC_ACQUIRE, "agent");
            xb_add(&bar[XB_XGEN(b.x)], 1u);
            asm volatile("s_waitcnt vmcnt(0)" ::: "memory");
        } else {
            XB_SPIN(xb_ld(&bar[XB_XGEN(b.x)]) == gen, bar);
            __builtin_amdgcn_fence(__ATOMIC_ACQUIRE, "agent");
            asm volatile("s_waitcnt vmcnt(0)" ::: "memory");
        }
    }
    __syncthreads();
}

struct Frame {
    LAS unsigned char* lds;
    volatile LAS unsigned* MISC;
    gu32* ctl;
    int tid, lane, wave;
    int vcu, G;
    unsigned char* ws;
    float* out;
    const float* const* in;
};
enum { I_X = 0, I_C, I_ADAW, I_ADAB, I_NMIXPRE, I_NMIXPOST, I_NFFNPRE, I_NFFNPOST, I_WIN, I_DLAMBDA, I_DSUBLN, I_POOLW, I_POOLSCALE, I_SCONVW, I_DCONVW, I_DALOG, I_DDTBIAS, I_DNORM,
       I_WBRANCH, I_WMERGE, I_BMERGE, I_WO, I_FFNG, I_FFNU, I_FFND, I_ROUTERW, I_ROUTERB, I_MOEG, I_MOEU, I_MOED, N_INPUTS };

__device__ __forceinline__ void cvt_item(const float* W, int ldw, int k0, int n0, bf16* WT, int Kd, int drow0, LAS float* scr, int lane) {
#pragma unroll 8
    for (int i = 0; i < 32; ++i) { const int kk = 2 * i + (lane >> 5); scr[kk * 33 + (lane & 31)] = W[(size_t)(k0 + kk) * ldw + n0 + (lane & 31)]; }
    LDS_WAIT(); asm volatile("" ::: "memory");
    const int c = lane & 7;
#pragma unroll
    for (int j = 0; j < 4; ++j) { const int n = (lane >> 3) + 8 * j; const LAS float* s = scr + (8 * c) * 33 + n;
        v4u o; o.x = pk2(s[0 * 33], s[1 * 33]); o.y = pk2(s[2 * 33], s[3 * 33]); o.z = pk2(s[4 * 33], s[5 * 33]); o.w = pk2(s[6 * 33], s[7 * 33]);
        *(GAS v4u*)(WT + (size_t)(drow0 + n) * Kd + k0 + 8 * c) = o; }
    LDS_WAIT(); asm volatile("" ::: "memory");
}
__device__ __forceinline__ void cvt_ffn_item(const float* wg, const float* wu, const float* wd, bf16* Wgu, bf16* Wd, int r, LAS float* scr, int lane) {
    constexpr int IG = (D / 64) * (DFF / 32);
    if (r < IG) { const int kb = r / (DFF / 32), nb = r % (DFF / 32), n0 = nb * 32; cvt_item(wg, DFF, kb * 64, n0, Wgu, D, 256 * (n0 >> 7) + (n0 & 127), scr, lane); return; } r -= IG;
    if (r < IG) { const int kb = r / (DFF / 32), nb = r % (DFF / 32), n0 = nb * 32; cvt_item(wu, DFF, kb * 64, n0, Wgu, D, 256 * (n0 >> 7) + (n0 & 127) + 128, scr, lane); return; } r -= IG;
    { const int kb = r / (D / 32), nb = r % (D / 32); cvt_item(wd, D, kb * 64, nb * 32, Wd, DFF, nb * 32, scr, lane); }
}
constexpr int FFN_ITEMS = 3 * (D / 64) * (DFF / 32);
__device__ __forceinline__ bf16* w_in_t(unsigned char* ws, int l) { return (bf16*)(ws + WS_W + (size_t)l * SZ_LAYERW); }
__device__ __forceinline__ bf16* w_m_t(unsigned char* ws, int l) { return (bf16*)(ws + WS_W + (size_t)l * SZ_LAYERW + SZ_WIN); }
__device__ __forceinline__ bf16* w_b_t(unsigned char* ws, int l) { return (bf16*)(ws + WS_W + (size_t)l * SZ_LAYERW + SZ_WIN + SZ_WM); }
__device__ __forceinline__ bf16* w_o_t(unsigned char* ws, int l) { return (bf16*)(ws + WS_W + (size_t)l * SZ_LAYERW + SZ_WIN + SZ_WM + SZ_WB); }

__device__ __forceinline__ void p_prologue(Frame& F) {
    LAS float* scr = (LAS float*)(F.lds + RING_OFF + F.wave * 16384);
    const int gw = F.vcu * NWAVES + F.wave, NGW = F.G * NWAVES;
    constexpr int I_IN = (D / 64) * (NPROJ / 32), I_M = (D / 64) * (D / 32), I_B = (256 / 64) * (D / 32);
    constexpr int PER_LAYER = I_IN + 4 * I_M + 4 * I_B + I_M;
    constexpr int NITEMS = NLAYER * PER_LAYER + FFN_ITEMS;
    for (int it = gw; it < NITEMS; it += NGW) {
        int r = it;
        if (r >= NLAYER * PER_LAYER) { r -= NLAYER * PER_LAYER;
            cvt_ffn_item(F.in[I_FFNG], F.in[I_FFNU], F.in[I_FFND], (bf16*)(F.ws + WS_WFFN), (bf16*)(F.ws + WS_WFFN + SZ_WGU), r, scr, F.lane); continue; }
        const int l = r / PER_LAYER; r -= l * PER_LAYER;
        if (r < I_IN) { const int kb = r / (NPROJ / 32), nb = r % (NPROJ / 32); cvt_item(F.in[I_WIN] + (size_t)l * D * IN_COLS, IN_COLS, kb * 64, nb * 32, w_in_t(F.ws, l), D, nb * 32, scr, F.lane); continue; } r -= I_IN;
        if (r < 4 * I_M) { const int i = r / I_M; r -= i * I_M; const int kb = r / (D / 32), nb = r % (D / 32);
            cvt_item(F.in[I_WMERGE] + ((size_t)l * 4 + i) * D * D, D, kb * 64, nb * 32, w_m_t(F.ws, l), D, i * 1024 + nb * 32, scr, F.lane); continue; } r -= 4 * I_M;
        if (r < 4 * I_B) { const int i = r / I_B; r -= i * I_B; const int kb = r / (D / 32), nb = r % (D / 32);
            cvt_item(F.in[I_WBRANCH] + ((size_t)l * 4 + i) * 256 * D, D, kb * 64, nb * 32, w_b_t(F.ws, l) + (size_t)i * 1024 * 256, 256, nb * 32, scr, F.lane); continue; } r -= 4 * I_B;
        { const int kb = r / (D / 32), nb = r % (D / 32); cvt_item(F.in[I_WO] + (size_t)l * D * D, D, kb * 64, nb * 32, w_o_t(F.ws, l), D, nb * 32, scr, F.lane); }
    }
    constexpr int MOD_ITEMS = NLAYER * 24 * 16;
    for (int it = gw; it < MOD_ITEMS; it += NGW) {
        const int grp = it >> 4, kc = it & 15, l = grp / 24, nb = grp % 24;
        const float* Wp = F.in[I_ADAW] + ((size_t)l * D + kc * 64) * (6 * D) + nb * 256 + F.lane * 4;
        f32x4 a0 = {0.f, 0.f, 0.f, 0.f}, a1 = {0.f, 0.f, 0.f, 0.f};
#pragma unroll 8
        for (int k = 0; k < 64; ++k) { const f32x4 w = *(const GAS f32x4*)(Wp + (size_t)k * (6 * D));
            const float c0 = siluf_(F.in[I_C][kc * 64 + k]), c1 = siluf_(F.in[I_C][D + kc * 64 + k]); a0 += w * c0; a1 += w * c1; }
        float* part = (float*)(F.ws + WS_BD) + ((size_t)grp * 16 + kc) * 512 + F.lane * 4;
        *(GAS f32x4*)part = a0; *(GAS f32x4*)(part + 256) = a1;
        __threadfence();
        unsigned old = 0;
        if (F.lane == 0) old = __hip_atomic_fetch_add(F.ctl + CW_MODCNT + grp, 1u, RLX_AGENT);
        old = __builtin_amdgcn_readfirstlane(old);
        if (old == 15u) {
            __threadfence();
            f32x4 s0 = {0.f, 0.f, 0.f, 0.f}, s1 = {0.f, 0.f, 0.f, 0.f};
            const float* pg = (const float*)(F.ws + WS_BD) + (size_t)grp * 16 * 512 + F.lane * 4;
#pragma unroll
            for (int q = 0; q < 16; ++q) { s0 += __builtin_nontemporal_load((const f32x4*)(pg + q * 512)); s1 += __builtin_nontemporal_load((const f32x4*)(pg + q * 512 + 256)); }
            float* m0 = (float*)(F.ctl + CW_MOD) + (size_t)(l * BATCH + 0) * 6 * D + nb * 256 + F.lane * 4;
            *(GAS f32x4*)m0 = s0; *(GAS f32x4*)(m0 + 6 * D) = s1;
        }
    }
}
__device__ __forceinline__ void p_moe_cvt(Frame& F) {
    LAS float* scr = (LAS float*)(F.lds + RING_OFF + F.wave * 16384);
    const int gw = F.vcu * NWAVES + F.wave, NGW = F.G * NWAVES;
    for (int it = gw; it < NEXP * FFN_ITEMS; it += NGW) {
        const int e = it / FFN_ITEMS, r = it % FFN_ITEMS;
        bf16* base = (bf16*)(F.ws + WS_MOEW + (size_t)e * SZ_FFNW);
        cvt_ffn_item(F.in[I_MOEG] + (size_t)e * D * DFF, F.in[I_MOEU] + (size_t)e * D * DFF, F.in[I_MOED] + (size_t)e * DFF * D, base, (bf16*)((unsigned char*)base + SZ_WGU), r, scr, F.lane);
    }
}

struct Row { f32x4 v[4]; };
__device__ __forceinline__ float modv(Frame& F, int l, int b, int idx) { return ((const float*)(F.ctl + CW_MOD))[(size_t)(l * BATCH + b) * 6 * D + idx] + F.in[I_ADAB][l * 6 * D + idx]; }
__device__ __forceinline__ f32x4 modv4(Frame& F, int l, int b, int idx) {
    const f32x4 a = *(const GAS f32x4*)((const float*)(F.ctl + CW_MOD) + (size_t)(l * BATCH + b) * 6 * D + idx), c = *(const GAS f32x4*)(F.in[I_ADAB] + l * 6 * D + idx); return a + c; }
__device__ __forceinline__ float row_rstd(const Row& r) {
    float s = 0.f;
#pragma unroll
    for (int j = 0; j < 4; ++j) s += (r.v[j].x * r.v[j].x + r.v[j].y * r.v[j].y) + (r.v[j].z * r.v[j].z + r.v[j].w * r.v[j].w);
    return 1.f / sqrtf(wave_sum(s) * (1.f / D) + EPS);
}
__device__ __forceinline__ void row_resid(Frame& F, Row& x, const Row& f, const float* gain, int l, int b, int gidx) {
    const float rs = row_rstd(f);
#pragma unroll
    for (int j = 0; j < 4; ++j) { const int c = 4 * F.lane + 256 * j; const f32x4 g = *(const GAS f32x4*)(gain + c), m = modv4(F, l, b, gidx + c); x.v[j] += m * (f.v[j] * rs * g); }
}
__device__ __forceinline__ void row_make_h(Frame& F, Row& h, const Row& x, const float* gain, int l, int b, int shidx, int scidx) {
    const float rs = row_rstd(x);
#pragma unroll
    for (int j = 0; j < 4; ++j) { const int c = 4 * F.lane + 256 * j; const f32x4 g = *(const GAS f32x4*)(gain + c), sc = modv4(F, l, b, scidx + c), sh = modv4(F, l, b, shidx + c);
        h.v[j] = (x.v[j] * rs * g) * (sc + 1.f) + sh; }
}
__device__ __forceinline__ void row_store_bf16(Frame& F, const Row& h, bf16* dst) {
    GAS unsigned long long* o8 = (GAS unsigned long long*)dst + F.lane;
#pragma unroll
    for (int j = 0; j < 4; ++j) o8[64 * j] = (unsigned long long)pk2(h.v[j].x, h.v[j].y) | ((unsigned long long)pk2(h.v[j].z, h.v[j].w) << 32);
}
__device__ __forceinline__ void row_load_f32(Frame& F, Row& r, const float* src) {
    const GAS f32x4* p = (const GAS f32x4*)src + F.lane;
#pragma unroll
    for (int j = 0; j < 4; ++j) r.v[j] = p[64 * j];
}
__device__ __forceinline__ void row_store_f32(Frame& F, const Row& r, float* dst) {
    GAS f32x4* p = (GAS f32x4*)dst + F.lane;
#pragma unroll
    for (int j = 0; j < 4; ++j) p[64 * j] = r.v[j];
}
__device__ __forceinline__ void row_load_bf16(Frame& F, Row& r, const bf16* src) {
    const GAS v2u* p = (const GAS v2u*)src + F.lane;
#pragma unroll
    for (int j = 0; j < 4; ++j) { const v2u w = p[64 * j]; r.v[j] = (f32x4){bflo(w.x), bfhi(w.x), bflo(w.y), bfhi(w.y)}; }
}
template <int NO> __device__ __forceinline__ void row_dots(Frame& F, const Row& h, const LAS float* WT, float (&out)[NO]) {
#pragma unroll
    for (int o = 0; o < NO; ++o) { float s = 0.f;
#pragma unroll
        for (int j = 0; j < 4; ++j) { const f32x4 w = *(const LAS f32x4*)(WT + o * 1024 + 4 * F.lane + 256 * j); s += (h.v[j].x * w.x + h.v[j].y * w.y) + (h.v[j].z * w.z + h.v[j].w * w.w); }
        out[o] = s; if ((o & 3) == 3) __builtin_amdgcn_sched_barrier(0); }
#pragma unroll
    for (int o = 0; o < NO; ++o) { out[o] = wave_sum(out[o]); if ((o & 3) == 3) __builtin_amdgcn_sched_barrier(0); }
}
template <int NO> __device__ __forceinline__ void load_wt(Frame& F, const float* W, int ldw, int col0, LAS float* WT) {
    for (int k = F.tid; k < 1024; k += NWAVES * 64) {
#pragma unroll
        for (int o = 0; o < NO; ++o) WT[o * 1024 + k] = W[(size_t)k * ldw + col0 + o];
    }
    __syncthreads();
}
__device__ __forceinline__ float softplusf_(float x) { return x > 20.f ? x : log1pf(__expf(x)); }
__device__ __forceinline__ void row_bd(Frame& F, const Row& h, const LAS float* W16T, int l, int row) {
    float o16[16]; row_dots<16>(F, h, W16T, o16);
    float mine = 0.f;
#pragma unroll
    for (int o = 0; o < 16; ++o) mine = (F.lane == o) ? o16[o] : mine;
    if (F.lane < 16) {
        float r;
        if (F.lane < 8) r = 1.f / (1.f + __expf(-mine));
        else { const int i = F.lane - 8; r = -__expf(F.in[I_DALOG][l * 8 + i]) * softplusf_(mine + F.in[I_DDTBIAS][l * 8 + i]); }
        ((float*)(F.ws + WS_BD))[(size_t)row * 16 + F.lane] = r;
    }
}
__device__ __forceinline__ void moe_tiles(Frame& F, int (&cnt)[NEXP], int (&tstart)[NEXP + 1]) {
    int acc = 0;
#pragma unroll
    for (int e = 0; e < NEXP; ++e) { cnt[e] = (int)__hip_atomic_load(F.ctl + CW_MOECNT + 64 * e, RLX_AGENT); tstart[e] = acc; acc += (cnt[e] + 255) >> 8; }
    tstart[NEXP] = acc;
}

constexpr int ROW_A = 0, ROW_B = 1, ROW_C = 2;
template <int MODE> __device__ __forceinline__ void p_rows(Frame& F, const int l) {
    const int gw = F.vcu * NWAVES + F.wave, NGW = F.G * NWAVES;
    LAS float* WT = (LAS float*)(F.lds + RING_OFF);
    LAS int* linfo = (LAS int*)(F.lds + RING_OFF + 65536);
    LAS int* lcnt = (LAS int*)(F.lds + RING_OFF + 65536 + 8 * 32 * 16);
    const bool do_h1 = (MODE == ROW_A) || (MODE == ROW_C && l + 1 < NLAYER);
    const int lh = (MODE == ROW_C) ? l + 1 : l;
    const bool router = (MODE == ROW_B) && (l == 1);
    if (do_h1) load_wt<16>(F, F.in[I_WIN] + (size_t)lh * D * IN_COLS, IN_COLS, NPROJ, WT);
    if (router) { if (F.tid < 16) lcnt[F.tid] = 0; load_wt<8>(F, F.in[I_ROUTERW], NEXP, 0, WT); }
    int cnt[NEXP], tstart[NEXP + 1];
    if (MODE == ROW_C && l == 1) moe_tiles(F, cnt, tstart);
    const float* xsrc = (MODE == ROW_A || (MODE == ROW_B && l == 0)) ? F.in[I_X] : F.out;
    int ri = 0;
    for (int m = gw; m < NTOK; m += NGW, ++ri) {
        const int b = m / SEQ;
        Row x; row_load_f32(F, x, xsrc + (size_t)m * D);
        if (MODE == ROW_B) {
            Row f; row_load_bf16(F, f, (const bf16*)(F.ws + WS_F) + (size_t)m * D);
            row_resid(F, x, f, F.in[I_NMIXPOST] + l * D, l, b, 2 * D);
            row_store_f32(F, x, F.out + (size_t)m * D);
            Row h; row_make_h(F, h, x, F.in[I_NFFNPRE] + l * D, l, b, 3 * D, 4 * D);
            row_store_bf16(F, h, (bf16*)(F.ws + (l == 0 ? WS_H : WS_H2B)) + (size_t)m * D);
            if (router) {
                float lg[NEXP]; row_dots<NEXP>(F, h, WT, lg);
                int e0 = 0; float l0 = lg[0] + F.in[I_ROUTERB][0];
#pragma unroll
                for (int e = 0; e < NEXP; ++e) lg[e] += F.in[I_ROUTERB][e];
#pragma unroll
                for (int e = 1; e < NEXP; ++e) if (lg[e] > l0) { l0 = lg[e]; e0 = e; }
                int e1 = -1; float l1 = -3.0e38f;
#pragma unroll
                for (int e = 0; e < NEXP; ++e) if (e != e0 && lg[e] > l1) { l1 = lg[e]; e1 = e; }
                const float q1 = __expf(l1 - l0), p0 = 1.f / (1.f + q1), p1 = q1 * p0;
                if (F.lane == 0) {
                    const int i0 = atomicAdd((int*)&lcnt[e0], 1), i1 = atomicAdd((int*)&lcnt[e1], 1);
                    LAS int* li = linfo + (F.wave * 32 + ri) * 4;
                    li[0] = e0 | (e1 << 8) | (i0 << 16); li[1] = i1; li[2] = __float_as_int(p0); li[3] = __float_as_int(p1);
                }
            }
        } else if (MODE == ROW_C) {
            Row f;
            if (l == 0) row_load_bf16(F, f, (const bf16*)(F.ws + WS_F) + (size_t)m * D);
            else {
                const int* ti = (const int*)(F.ws + WS_ROUTE) + (size_t)m * 8;
                const int e0 = ti[0], i0 = ti[1], e1 = ti[2], i1 = ti[3]; const float p0 = __int_as_float(ti[4]), p1 = __int_as_float(ti[5]);
                int s0 = 0, s1 = 0;
#pragma unroll
                for (int e = 0; e < NEXP; ++e) { s0 = (e == e0) ? tstart[e] * 256 + i0 : s0; s1 = (e == e1) ? tstart[e] * 256 + i1 : s1; }
                Row y0, y1; row_load_bf16(F, y0, (const bf16*)(F.ws + WS_Y) + (size_t)s0 * D); row_load_bf16(F, y1, (const bf16*)(F.ws + WS_Y) + (size_t)s1 * D);
#pragma unroll
                for (int j = 0; j < 4; ++j) f.v[j] = y0.v[j] * p0 + y1.v[j] * p1;
            }
            row_resid(F, x, f, F.in[I_NFFNPOST] + l * D, l, b, 5 * D);
            row_store_f32(F, x, F.out + (size_t)m * D);
        }
        if (do_h1) {
            Row h; row_make_h(F, h, x, F.in[I_NMIXPRE] + lh * D, lh, b, 0, 1 * D);
            row_store_bf16(F, h, (bf16*)(F.ws + WS_H) + (size_t)m * D);
            row_bd(F, h, WT, lh, m);
        }
    }
    if (router) {
        __syncthreads();
        if (F.tid < NEXP) lcnt[8 + F.tid] = (int)__hip_atomic_fetch_add(F.ctl + CW_MOECNT + 64 * F.tid, (unsigned)lcnt[F.tid], RLX_AGENT);
        __syncthreads();
        ri = 0;
        for (int m = gw; m < NTOK; m += NGW, ++ri) {
            if (F.lane == 0) {
                const LAS int* li = linfo + (F.wave * 32 + ri) * 4;
                const int w0 = li[0], e0 = w0 & 255, e1 = (w0 >> 8) & 255, i0 = (w0 >> 16) + lcnt[8 + e0], i1 = li[1] + lcnt[8 + e1];
                int* ti = (int*)(F.ws + WS_ROUTE) + (size_t)m * 8;
                ti[0] = e0; ti[1] = i0; ti[2] = e1; ti[3] = i1; ti[4] = li[2]; ti[5] = li[3];
                int* lists = (int*)(F.ws + WS_ROUTE + 1 * MiB);
                lists[(size_t)e0 * 65536 + i0] = m; lists[(size_t)e1 * 65536 + i1] = m;
            }
        }
    }
    __syncthreads();
}

namespace pg8 {
constexpr int NXCD = 8, WGM = 8;
struct SchedStd {
    int nM, nN, nwg, G, c; const char* A; size_t a_tile; const char* B; size_t b_tile;
    __device__ __forceinline__ void init(int nM_, int nN_, int G_, int c_, const void* A_, size_t a_tile_, const void* B_, size_t b_tile_) { nM = nM_; nN = nN_; nwg = nM * nN; G = G_; c = c_; A = (const char*)A_; a_tile = a_tile_; B = (const char*)B_; b_tile = b_tile_; }
    __device__ __forceinline__ bool next(int i, Unit& u) const {
        const long L = (long)i * G + c; if (L >= nwg) return false;
        int wgid = (int)L; { const int q = nwg / NXCD, r = nwg % NXCD, xcd = wgid % NXCD, off = wgid / NXCD; wgid = (xcd < r ? xcd * (q + 1) : r * (q + 1) + (xcd - r) * q) + off; }
        const int nig = WGM * nN, gid = wgid / nig, fm = gid * WGM, gsz = (nM - fm) < WGM ? (nM - fm) : WGM;
        u.pm = fm + ((wgid % nig) % gsz); u.pn = (wgid % nig) / gsz; u.aux = 0; u.pad = 0; u.a = A + (size_t)u.pm * a_tile; u.b = B + (size_t)u.pn * b_tile; u.rows = nullptr; return true;
    }
    __device__ __forceinline__ void a_ready(const Unit&) const {}
    __device__ __forceinline__ void done(const Unit&) const {}
};
struct SchedBranch {
    SchedStd s; const char* O4; const char* Wb;
    __device__ __forceinline__ bool next(int i, Unit& u) const {
        if (!s.next(i, u)) return false;
        const int br = u.pn >> 2; u.pn &= 3; u.aux = br;
        u.a = O4 + (size_t)u.pm * 256 * 1024 * 2 + (size_t)br * 256 * 2; u.b = Wb + (size_t)br * 1024 * 256 * 2 + (size_t)u.pn * 256 * 256 * 2; return true;
    }
    __device__ __forceinline__ void a_ready(const Unit&) const {}
    __device__ __forceinline__ void done(const Unit&) const {}
};
struct SchedGate {
    int vcu, G; const char* H; const char* Wm;
    __device__ __forceinline__ bool next(int i, Unit& u) const {
        const int tg = vcu + G * (i >> 2); if (tg >= 512) return false;
        u.pm = tg >> 2; u.pn = tg & 3; u.aux = i & 3; u.pad = 0; u.rows = nullptr;
        u.a = H + (size_t)u.pm * 256 * 1024 * 2; u.b = Wm + ((size_t)u.aux * 1024 + (size_t)u.pn * 256) * 1024 * 2; return true;
    }
    __device__ __forceinline__ void a_ready(const Unit&) const {}
    __device__ __forceinline__ void done(const Unit&) const {}
};
struct SchedMoe {
    int c, G, t0, t1, nN; int tstart[9]; int cnt[8];
    const char* A; const int* lists; const char* W; size_t w_tile; bool gather;
    __device__ __forceinline__ bool next(int i, Unit& u) const {
        const long L = (long)i * G + c; const int t = t0 + (int)(L / nN); if (t >= t1) return false;
        int e = 0;
#pragma unroll
        for (int k = 1; k < 8; ++k) e = (t >= tstart[k]) ? k : e;
        int ce = 0;
#pragma unroll
        for (int k = 0; k < 8; ++k) ce = (k == e) ? cnt[k] : ce;
        const int j = t - ((e == 0) ? 0 : 0), jj = t;
        (void)j; (void)jj;
        int ts = 0;
#pragma unroll
        for (int k = 0; k < 8; ++k) ts = (k == e) ? tstart[k] : ts;
        const int tj = t - ts;
        u.pn = (int)(L % nN); u.pad = 0;
        if (gather) { u.pm = t - t0; u.a = A; u.rows = lists + (size_t)e * 65536 + tj * 256; const int nv = ce - tj * 256; u.aux = nv > 256 ? 256 : nv; }
        else { u.pm = t; u.a = A + (size_t)(t - t0) * 256 * DFF_ * 2; u.rows = nullptr; u.aux = 0; }
        u.b = W + (size_t)e * SZ_EXP_ + (size_t)u.pn * w_tile; return true;
    }
    static constexpr size_t DFF_ = 2816; static constexpr size_t SZ_EXP_ = (size_t)2 * 2816 * 1024 * 2 + (size_t)1024 * 2816 * 2;
    __device__ __forceinline__ void a_ready(const Unit&) const {}
    __device__ __forceinline__ void done(const Unit&) const {}
};

struct EpiStore {
    static constexpr bool PERM = true;
    bf16_t* O; int ldc; size_t aux_stride; float scale0;
    __device__ __forceinline__ void operator()(const f32x4 (&acc)[2][2][4][2], const Unit& u, int wr, int wc, int fr, int fq) const {
        const int row0 = u.pm * BM + wr * 64 + fr, col0 = u.pn * BM + wc * 32 + 8 * fq; bf16_t* base = O + (size_t)u.aux * aux_stride;
        const float sc = (u.pn == 0) ? scale0 : 1.f;
#pragma unroll
        for (int ai = 0; ai < 2; ++ai)
#pragma unroll
            for (int m = 0; m < 4; ++m) { bf16_t* rowp = base + (size_t)(row0 + ai * HALF + m * 16) * ldc + col0;
#pragma unroll
                for (int bj = 0; bj < 2; ++bj) { const f32x4 v0 = acc[ai][bj][m][0] * sc, v1 = acc[ai][bj][m][1] * sc;
                    u32x4 w; w.x = cvt_pk_bf16(v0[0], v0[1]); w.y = cvt_pk_bf16(v0[2], v0[3]); w.z = cvt_pk_bf16(v1[0], v1[1]); w.w = cvt_pk_bf16(v1[2], v1[3]);
                    *(u32x4*)(rowp + bj * HALF) = w; } }
    }
};

struct EpiProj {
    static constexpr bool PERM = true;
    static constexpr int TILE_E = 9728;
    bf16_t* Qb; bf16_t* KV; bf16_t* Pj; unsigned* nmax; float qscale;
    __device__ __forceinline__ void operator()(const f32x4 (&acc)[2][2][4][2], const Unit& u, int wr, int wc, int fr, int fq) const {
        const int t0 = u.pm * BM + wr * 64 + fr;
        const int b = (u.pm * BM) >> 14;
        const int s00 = t0 & 16383;
        if (u.pn >= 3) {
            bf16_t* base = Pj + (size_t)t0 * 2048 + (u.pn - 3) * BM + wc * 32 + 8 * fq;
#pragma unroll
            for (int ai = 0; ai < 2; ++ai)
#pragma unroll
                for (int m = 0; m < 4; ++m) {
#pragma unroll
                    for (int bj = 0; bj < 2; ++bj) { const f32x4 v0 = acc[ai][bj][m][0], v1 = acc[ai][bj][m][1];
                        u32x4 w; w.x = cvt_pk_bf16(v0[0], v0[1]); w.y = cvt_pk_bf16(v0[2], v0[3]); w.z = cvt_pk_bf16(v1[0], v1[1]); w.w = cvt_pk_bf16(v1[2], v1[3]);
                        *(u32x4*)(base + (ai * HALF + m * 16) * 2048 + bj * HALF) = w; }
                    __builtin_amdgcn_sched_barrier(0); }
        } else if (u.pn == 2) {
            bf16_t* hb = KV + ((size_t)((b * 4 + (wc >> 1)) * 256 + (s00 >> 6))) * TILE_E + 5120 + (32 * (wc & 1) + 8 * fq) * 72 + (s00 & 63);
#pragma unroll
            for (int ai = 0; ai < 2; ++ai)
#pragma unroll
                for (int bj = 0; bj < 2; ++bj) { bf16_t* tb = hb + (size_t)bj * (2 * 256 * TILE_E) + ai * (2 * TILE_E);
#pragma unroll
                    for (int m = 0; m < 4; ++m)
#pragma unroll
                        for (int n = 0; n < 2; ++n)
#pragma unroll
                            for (int j = 0; j < 4; ++j) { const float v = acc[ai][bj][m][n][j];
                                unsigned bits = __builtin_bit_cast(unsigned, v); bits = (bits + 0x7fffu + ((bits >> 16) & 1u)) >> 16;
                                tb[(4 * n + j) * 72 + 16 * m] = (bf16_t)bits; }
                    __builtin_amdgcn_sched_barrier(0); }
        } else {
            const float sc = (u.pn == 0) ? qscale : 1.f; float nm = 0.f;
            bf16_t* qbase = Qb + ((size_t)(b * 4 + wc) * 16384 + s00) * 64 + 8 * fq;
            bf16_t* kbase = KV + ((size_t)((b * 4 + wc) * 256 + (s00 >> 6))) * TILE_E + (s00 & 63) * 40 + 8 * fq;
#pragma unroll
            for (int ai = 0; ai < 2; ++ai)
#pragma unroll
                for (int m = 0; m < 4; ++m) {
#pragma unroll
                    for (int bj = 0; bj < 2; ++bj) { const f32x4 v0 = acc[ai][bj][m][0] * sc, v1 = acc[ai][bj][m][1] * sc;
                        u32x4 w; w.x = cvt_pk_bf16(v0[0], v0[1]); w.y = cvt_pk_bf16(v0[2], v0[3]); w.z = cvt_pk_bf16(v1[0], v1[1]); w.w = cvt_pk_bf16(v1[2], v1[3]);
                        float ss = (v0[0] * v0[0] + v0[1] * v0[1]) + (v0[2] * v0[2] + v0[3] * v0[3]) + (v1[0] * v1[0] + v1[1] * v1[1]) + (v1[2] * v1[2] + v1[3] * v1[3]);
                        ss += __shfl_xor(ss, 16); ss += __shfl_xor(ss, 32); nm = fmaxf(nm, ss);
                        if (u.pn == 0) *(u32x4*)(qbase + (ai * HALF + m * 16) * 64 + 32 * bj) = w;
                        else *(u32x4*)(kbase + ai * (2 * TILE_E) + bj * 2560 + (16 * m) * 40) = w; }
                    __builtin_amdgcn_sched_barrier(0); }
            nm = fmaxf(nm, __shfl_xor(nm, 1)); nm = fmaxf(nm, __shfl_xor(nm, 2)); nm = fmaxf(nm, __shfl_xor(nm, 4)); nm = fmaxf(nm, __shfl_xor(nm, 8));
            if (fr == 0 && fq == 0) atomicMax(nmax + (b * 4 + wc) * 2 + u.pn, __builtin_bit_cast(unsigned, nm));
        }
    }
};
__device__ __forceinline__ float sigm(float x) { return __builtin_amdgcn_rcpf(1.f + __builtin_amdgcn_exp2f(-1.4426950408889634f * x)); }
struct EpiGate {
    static constexpr bool PERM = true;
    const bf16_t* P; bf16_t* Mg; const float* bias;
    __device__ __forceinline__ void operator()(const f32x4 (&acc)[2][2][4][2], const Unit& u, int wr, int wc, int fr, int fq) const {
        const int row0 = u.pm * BM + wr * 64 + fr, col0 = u.pn * BM + wc * 32 + 8 * fq; const int br = u.aux;
        const bf16_t* Pb = P + (size_t)br * 32768 * 1024; const float* bb = bias + br * 1024 + col0;
        f32x4 bv[2][2];
#pragma unroll
        for (int bj = 0; bj < 2; ++bj)
#pragma unroll
            for (int n = 0; n < 2; ++n) bv[bj][n] = *(const f32x4*)(bb + bj * HALF + 4 * n);
#pragma unroll
        for (int ai = 0; ai < 2; ++ai)
#pragma unroll
            for (int m = 0; m < 4; ++m) { const size_t ro = (size_t)(row0 + ai * HALF + m * 16) * 1024 + col0;
#pragma unroll
                for (int bj = 0; bj < 2; ++bj) {
                    const u32x4 pw = *(const u32x4*)(Pb + ro + bj * HALF);
                    u32x4 mw = {0u, 0u, 0u, 0u}; if (br != 0) mw = *(const u32x4*)(Mg + ro + bj * HALF);
                    float o[8];
#pragma unroll
                    for (int q = 0; q < 4; ++q) {
                        const float g0 = sigm(acc[ai][bj][m][q >> 1][(q & 1) * 2] + bv[bj][q >> 1][(q & 1) * 2]), g1 = sigm(acc[ai][bj][m][q >> 1][(q & 1) * 2 + 1] + bv[bj][q >> 1][(q & 1) * 2 + 1]);
                        o[2 * q] = g0 * __builtin_bit_cast(float, pw[q] << 16) + __builtin_bit_cast(float, mw[q] << 16);
                        o[2 * q + 1] = g1 * __builtin_bit_cast(float, pw[q] & 0xffff0000u) + __builtin_bit_cast(float, mw[q] & 0xffff0000u);
                    }
                    u32x4 w; w.x = cvt_pk_bf16(o[0], o[1]); w.y = cvt_pk_bf16(o[2], o[3]); w.z = cvt_pk_bf16(o[4], o[5]); w.w = cvt_pk_bf16(o[6], o[7]);
                    *(u32x4*)(Mg + ro + bj * HALF) = w; } }
    }
};
struct EpiSwiGLU {
    static constexpr bool PERM = true;
    bf16_t* O; int ldc;
    __device__ __forceinline__ void operator()(const f32x4 (&acc)[2][2][4][2], const Unit& u, int wr, int wc, int fr, int fq) const {
        const int row0 = u.pm * BM + wr * 64 + fr, col0 = u.pn * HALF + wc * 32 + 8 * fq;
#pragma unroll
        for (int ai = 0; ai < 2; ++ai)
#pragma unroll
            for (int m = 0; m < 4; ++m) { bf16_t* rowp = O + (size_t)(row0 + ai * HALF + m * 16) * ldc + col0;
                float o[8];
#pragma unroll
                for (int n = 0; n < 2; ++n)
#pragma unroll
                    for (int q = 0; q < 4; ++q) { const float g = acc[ai][0][m][n][q], up = acc[ai][1][m][n][q]; o[4 * n + q] = g * sigm(g) * up; }
                u32x4 w; w.x = cvt_pk_bf16(o[0], o[1]); w.y = cvt_pk_bf16(o[2], o[3]); w.z = cvt_pk_bf16(o[4], o[5]); w.w = cvt_pk_bf16(o[6], o[7]);
                *(u32x4*)rowp = w; }
    }
};
}

namespace att {
constexpr int SLOT = 19456, NSLOT = 6;
constexpr int ATTN_LDS = NSLOT * SLOT;
__device__ __forceinline__ unsigned cvtpk(float lo, float hi) { typedef float f2 __attribute__((ext_vector_type(2))); typedef __bf16 b2 __attribute__((ext_vector_type(2))); f2 v = {lo, hi}; b2 b = __builtin_convertvector(v, b2); return __builtin_bit_cast(unsigned, b); }
#define ATT_WAITV(n) asm volatile("s_waitcnt vmcnt(" #n ")" ::: "memory")
__device__ __forceinline__ float max3f(float a, float b, float c) { float r; asm("v_max3_f32 %0, %1, %2, %3" : "=v"(r) : "v"(a), "v"(b), "v"(c)); return r; }

#define ATT_SOFTMAX(s0, s1, pw) do { \
    asm volatile("s_nop 15\n\ts_nop 7" : "+v"(s0), "+v"(s1)); \
    float rm = max3f(s0[0], s0[1], s1[0]), rm2 = max3f(s0[2], s0[3], s1[1]); rm = max3f(rm, s1[2], s1[3]); \
    _Pragma("unroll") for (int r = 4; r < 16; r += 4) { rm = max3f(rm, s0[r], s0[r + 1]); rm2 = max3f(rm2, s0[r + 2], s0[r + 3]); rm = max3f(rm, s1[r], s1[r + 1]); rm2 = max3f(rm2, s1[r + 2], s1[r + 3]); } \
    rm = fmaxf(rm, rm2); \
    { auto rr = __builtin_amdgcn_permlane32_swap(__builtin_bit_cast(unsigned, rm), __builtin_bit_cast(unsigned, rm), false, false); rm = fmaxf(__builtin_bit_cast(float, rr[0]), __builtin_bit_cast(float, rr[1])); } \
    if (__any(rm > 8.f)) { \
        const float dd = fmaxf(rm, 0.f); R += dd; \
        const float f = fast_exp2(-dd); L1[0] *= f; L2[0] *= f; \
        _Pragma("unroll") for (int r = 0; r < 16; ++r) { s0[r] -= dd; s1[r] -= dd; c0[r] -= dd; c1[r] -= dd; O1[0][r] *= f; O1[1][r] *= f; O2[0][r] *= f; O2[1][r] *= f; } \
        RESC_EXTRA(f); \
    } \
    _Pragma("unroll") for (int r = 0; r < 16; ++r) { s0[r] = fast_exp2(s0[r]); s1[r] = fast_exp2(s1[r]); } \
    _Pragma("unroll") for (int e = 0; e < 4; ++e) { pw[0][e] = cvtpk(s0[2 * e], s0[2 * e + 1]); pw[1][e] = cvtpk(s0[8 + 2 * e], s0[8 + 2 * e + 1]); pw[2][e] = cvtpk(s1[2 * e], s1[2 * e + 1]); pw[3][e] = cvtpk(s1[8 + 2 * e], s1[8 + 2 * e + 1]); } \
} while (0)

__device__ __forceinline__ void attn_unit(Frame& F, const int layer, const int b, const int h, const int qb) {
    const int lane = F.lane, r32 = lane & 31, hi = lane >> 5, wid = F.wave;
    LAS unsigned char* L = F.lds + RING_OFF;
    const int qw0 = qb * 256 + wid * 32, q = qw0 + r32;
    const float slope2 = exp2f(-2.f * (float)(h + 1)) * 1.4426950408889634f;
    int tlo, thi;
    { const unsigned* nm = (const unsigned*)(F.ctl + CW_NMAX) + layer * 16 + (b * 4 + h) * 2;
      const float qn = sqrtf(__builtin_bit_cast(float, __hip_atomic_load(nm, RLX_AGENT))) * 1.01f, kn = sqrtf(__builtin_bit_cast(float, __hip_atomic_load(nm + 1, RLX_AGENT))) * 1.01f;
      const float wf = (160.f + 2.f * qn * kn) / slope2; const int W = wf > 100000.f ? 100000 : (int)wf + 1;
      const int lo = qb * 256 - W, hi_ = qb * 256 + 255 + W; tlo = lo < 0 ? 0 : (lo >> 6); thi = hi_ >= SEQ ? (SEQ / 64 - 1) : (hi_ >> 6);
      if (((thi - tlo + 1) & 1) != 0) { if (thi < SEQ / 64 - 1) ++thi; else --tlo; } }
    const int nP = (thi - tlo + 1) >> 1;
    const bf16* Qp = (const bf16*)(F.ws + WS_QB) + ((size_t)(b * 4 + h) * SEQ + q) * 64;
    bf16x8 q1f[2], q2f[2];
#pragma unroll
    for (int ks = 0; ks < 2; ++ks) { q1f[ks] = *(const GAS bf16x8*)(Qp + 16 * ks + 8 * hi); q2f[ks] = *(const GAS bf16x8*)(Qp + 32 + 16 * ks + 8 * hi); }
    const unsigned char* kvbase = F.ws + WS_KV + ((size_t)(b * 4 + h) * 256) * SLOT + (size_t)wid * 1024 + lane * 16;
    const bool w3 = wid < 3;
#define ATT_DMA1(t, slot) do { const unsigned char* g_ = kvbase + (size_t)(t) * SLOT; LAS unsigned char* d_ = L + (slot) * SLOT + wid * 1024; \
        __builtin_amdgcn_global_load_lds((const unsigned*)g_, (LAS unsigned*)d_, 16, 0, 0); __builtin_amdgcn_global_load_lds((const unsigned*)(g_ + 8192), (LAS unsigned*)(d_ + 8192), 16, 0, 0); \
        if (w3) __builtin_amdgcn_global_load_lds((const unsigned*)(g_ + 16384), (LAS unsigned*)(d_ + 16384), 16, 0, 0); } while (0)
#define ATT_DMA2(pr, ps) do { ATT_DMA1(tlo + 2 * (pr), 2 * (ps)); ATT_DMA1(tlo + 2 * (pr) + 1, 2 * (ps) + 1); } while (0)
    asm volatile("s_waitcnt vmcnt(0)" ::: "memory");
    ATT_DMA2(0, 0);
    if (nP > 1) ATT_DMA2(1, 1);
    float R = 0.f;
    f32x16 O1[2], O2[2], L1, L2;
#pragma unroll
    for (int i = 0; i < 16; ++i) { O1[0][i] = 0.f; O1[1][i] = 0.f; O2[0][i] = 0.f; O2[1][i] = 0.f; L1[i] = 0.f; L2[i] = 0.f; }
    const bf16x8 ones = {(short)0x3F80, (short)0x3F80, (short)0x3F80, (short)0x3F80, (short)0x3F80, (short)0x3F80, (short)0x3F80, (short)0x3F80};
    const int pr32 = (r32 & 0x13) | ((r32 & 4) << 1) | ((r32 & 8) >> 1);
    const int kfo = pr32 * 80 + hi * 16;
    const int vfo = 10240 + r32 * 144 + hi * 16;
    int ps = 0;
    for (int ip = 0; ip < nP; ++ip) {
        if (ip + 1 < nP) { if (w3) ATT_WAITV(6); else ATT_WAITV(4); } else ATT_WAITV(0);
        __builtin_amdgcn_s_barrier();
        asm volatile("" ::: "memory");
        if (ip + 2 < nP) { const int s2 = ps >= 1 ? ps - 1 : 2; ATT_DMA2(ip + 2, s2); }
#pragma unroll
        for (int half = 0; half < 2; ++half) {
            const int t = tlo + 2 * ip + half;
            const LAS unsigned char* Bf = L + (2 * ps + half) * SLOT;
            const float dl = (float)(q - t * 64 - 8 * hi);
            f32x16 c0, c1;
            if (t * 64 + 63 < qw0) {
                const float tl = -slope2 * dl - R;
#pragma unroll
                for (int r = 0; r < 16; ++r) { const float cc = (float)(16 * (r >> 3) + (r & 7)); c0[r] = __builtin_fmaf(slope2, cc, tl); c1[r] = __builtin_fmaf(slope2, cc + 32.f, tl); }
            } else if (t * 64 > qw0 + 31) {
                const float tr = slope2 * dl - R;
#pragma unroll
                for (int r = 0; r < 16; ++r) { const float cc = (float)(16 * (r >> 3) + (r & 7)); c0[r] = __builtin_fmaf(-slope2, cc, tr); c1[r] = __builtin_fmaf(-slope2, cc + 32.f, tr); }
            } else {
#pragma unroll
                for (int r = 0; r < 16; ++r) { const float cc = (float)(16 * (r >> 3) + (r & 7)); c0[r] = __builtin_fmaf(-slope2, __builtin_fabsf(dl - cc), -R); c1[r] = __builtin_fmaf(-slope2, __builtin_fabsf(dl - (cc + 32.f)), -R); }
            }
            v4u pw1[4], pw2[4];
            {
                const bf16x8 k00 = *(const LAS bf16x8*)(Bf + kfo), k01 = *(const LAS bf16x8*)(Bf + kfo + 32), k10 = *(const LAS bf16x8*)(Bf + 32 * 80 + kfo), k11 = *(const LAS bf16x8*)(Bf + 32 * 80 + kfo + 32);
                f32x16 s0 = __builtin_amdgcn_mfma_f32_32x32x16_bf16(k00, q1f[0], c0, 0, 0, 0); s0 = __builtin_amdgcn_mfma_f32_32x32x16_bf16(k01, q1f[1], s0, 0, 0, 0);
                f32x16 s1 = __builtin_amdgcn_mfma_f32_32x32x16_bf16(k10, q1f[0], c1, 0, 0, 0); s1 = __builtin_amdgcn_mfma_f32_32x32x16_bf16(k11, q1f[1], s1, 0, 0, 0);
#define RESC_EXTRA(f) do {} while (0)
                ATT_SOFTMAX(s0, s1, pw1);
#undef RESC_EXTRA
            }
            {
                const bf16x8 k00 = *(const LAS bf16x8*)(Bf + 5120 + kfo), k01 = *(const LAS bf16x8*)(Bf + 5120 + kfo + 32), k10 = *(const LAS bf16x8*)(Bf + 5120 + 32 * 80 + kfo), k11 = *(const LAS bf16x8*)(Bf + 5120 + 32 * 80 + kfo + 32);
                f32x16 s0 = __builtin_amdgcn_mfma_f32_32x32x16_bf16(k00, q2f[0], c0, 0, 0, 0); s0 = __builtin_amdgcn_mfma_f32_32x32x16_bf16(k01, q2f[1], s0, 0, 0, 0);
                f32x16 s1 = __builtin_amdgcn_mfma_f32_32x32x16_bf16(k10, q2f[0], c1, 0, 0, 0); s1 = __builtin_amdgcn_mfma_f32_32x32x16_bf16(k11, q2f[1], s1, 0, 0, 0);
                float p1scale = 1.f;
#define RESC_EXTRA(f) do { p1scale = (f); } while (0)
                ATT_SOFTMAX(s0, s1, pw2);
#undef RESC_EXTRA
                if (__any(p1scale != 1.f)) {
#pragma unroll
                    for (int ks = 0; ks < 4; ++ks)
#pragma unroll
                        for (int e = 0; e < 4; ++e) { const unsigned w = pw1[ks][e]; pw1[ks][e] = cvtpk(bflo(w) * p1scale, bfhi(w) * p1scale); }
                }
            }
#pragma unroll
            for (int db = 0; db < 2; ++db)
#pragma unroll
                for (int ks = 0; ks < 4; ++ks) {
                    const bf16x8 vf = *(const LAS bf16x8*)(Bf + vfo + db * 32 * 144 + ks * 32);
                    O1[db] = __builtin_amdgcn_mfma_f32_32x32x16_bf16(vf, __builtin_bit_cast(bf16x8, pw1[ks]), O1[db], 0, 0, 0);
                    O2[db] = __builtin_amdgcn_mfma_f32_32x32x16_bf16(vf, __builtin_bit_cast(bf16x8, pw2[ks]), O2[db], 0, 0, 0);
                }
#pragma unroll
            for (int ks = 0; ks < 4; ++ks) { L1 = __builtin_amdgcn_mfma_f32_32x32x16_bf16(ones, __builtin_bit_cast(bf16x8, pw1[ks]), L1, 0, 0, 0); L2 = __builtin_amdgcn_mfma_f32_32x32x16_bf16(ones, __builtin_bit_cast(bf16x8, pw2[ks]), L2, 0, 0, 0); }
        }
        ps = ps == 2 ? 0 : ps + 1;
    }
    const float l1 = L1[0], l2 = L2[0];
    const float* dlm = F.in[I_DLAMBDA] + layer * 128;
    float a1 = 0.f, a2 = 0.f;
#pragma unroll 8
    for (int i = 0; i < 32; ++i) { a1 += dlm[i] * dlm[32 + i]; a2 += dlm[64 + i] * dlm[96 + i]; }
    const float lam_init = 0.8f - 0.6f * __expf(-0.3f * (float)layer);
    const float lam = __expf(a1) - __expf(a2) + lam_init;
    const float i1 = 1.f / fmaxf(l1, 1e-30f), i2 = lam / fmaxf(l2, 1e-30f);
    float ss = 0.f;
#pragma unroll
    for (int db = 0; db < 2; ++db)
#pragma unroll
        for (int r = 0; r < 16; ++r) { const float v = O1[db][r] * i1 - O2[db][r] * i2; O1[db][r] = v; ss += v * v; }
    ss += __shfl_xor(ss, 32);
    const float rs = (1.f / sqrtf(ss * (1.f / 64.f) + EPS)) * (1.f - lam_init);
    bf16* orow = (bf16*)(F.ws + WS_O4) + ((size_t)b * SEQ + q) * 1024 + 64 * h;
    const float* sg = F.in[I_DSUBLN] + layer * 64;
#pragma unroll
    for (int db = 0; db < 2; ++db)
#pragma unroll
        for (int g4 = 0; g4 < 4; ++g4) {
            const int d0 = 32 * db + 8 * g4 + 4 * hi;
            const float v0 = O1[db][4 * g4] * rs * sg[d0], v1 = O1[db][4 * g4 + 1] * rs * sg[d0 + 1], v2 = O1[db][4 * g4 + 2] * rs * sg[d0 + 2], v3 = O1[db][4 * g4 + 3] * rs * sg[d0 + 3];
            v2u w = {pk2(v0, v1), pk2(v2, v3)};
            *(GAS v2u*)(orow + d0) = w;
        }
    asm volatile("s_waitcnt lgkmcnt(0)" ::: "memory");
    __builtin_amdgcn_s_barrier();
#undef ATT_DMA1
#undef ATT_DMA2
}
#undef ATT_SOFTMAX
#undef ATT_WAITV
}

namespace pc {
constexpr int MPITCH = 72;
__device__ __forceinline__ void pool_task(Frame& F, const int layer, const int tile, const int g, LAS unsigned char* mimg) {
    const int lane = F.lane, r32 = lane & 31, hi = lane >> 5;
    const bf16* P = (const bf16*)(F.ws + WS_PROJ);
    bf16* O4 = (bf16*)(F.ws + WS_O4);
    bf16x8 wf[2][4];
    { const float* W = F.in[I_POOLW] + ((size_t)layer * 4 + g) * 64 * 64;
#pragma unroll
      for (int nb = 0; nb < 2; ++nb)
#pragma unroll
          for (int ks = 0; ks < 4; ++ks) { v4u t;
#pragma unroll
              for (int jj = 0; jj < 4; ++jj) t[jj] = pk2(W[(16 * ks + 8 * hi + 2 * jj) * 64 + r32 + 32 * nb], W[(16 * ks + 8 * hi + 2 * jj + 1) * 64 + r32 + 32 * nb]);
              wf[nb][ks] = __builtin_bit_cast(bf16x8, t); } }
    const int t0 = tile * 64, s0 = t0 % SEQ, hw = 1 << g;
    const bf16* src = P + (size_t)t0 * PJ + C_PIN + 64 * g + lane;
    float cs[81]; cs[0] = 0.f;
#pragma unroll
    for (int i = 0; i < 80; ++i) { const int s = s0 - 8 + i; float v = 0.f; if (s >= 0 && s < SEQ) v = bf2f(src[(long)(i - 8) * PJ]); cs[i + 1] = cs[i] + v; }
#pragma unroll
    for (int i = 0; i < 64; ++i) {
        const int s = s0 + i; int lo = s - hw, hiw = s + hw; lo = lo < 0 ? 0 : lo; hiw = hiw > SEQ ? SEQ : hiw;
        float wsum = 0.f;
        if (g == 0) wsum = cs[i + 8 + 1] - cs[i + 8 - 1]; else if (g == 1) wsum = cs[i + 8 + 2] - cs[i + 8 - 2]; else if (g == 2) wsum = cs[i + 8 + 4] - cs[i + 8 - 4]; else wsum = cs[i + 8 + 8] - cs[i + 8 - 8];
        const float pv = cs[i + 9] - cs[i + 8];
        const float mval = wsum / (float)(hiw - lo) - pv;
        *(LAS unsigned short*)(mimg + i * (MPITCH * 2) + lane * 2) = (unsigned short)f2bf(mval);
    }
    LDS_WAIT();
#pragma unroll
    for (int tb = 0; tb < 2; ++tb) {
        bf16x8 af[4];
#pragma unroll
        for (int ks = 0; ks < 4; ++ks) af[ks] = *(const LAS bf16x8*)(mimg + (r32 + 32 * tb) * (MPITCH * 2) + (16 * ks + 8 * hi) * 2);
#pragma unroll
        for (int nb = 0; nb < 2; ++nb) {
            f32x16 acc;
#pragma unroll
            for (int r = 0; r < 16; ++r) acc[r] = 0.f;
#pragma unroll
            for (int ks = 0; ks < 4; ++ks) acc = __builtin_amdgcn_mfma_f32_32x32x16_bf16(af[ks], wf[nb][ks], acc, 0, 0, 0);
            const int e = r32 + 32 * nb; const float sc = F.in[I_POOLSCALE][layer * 256 + 64 * g + e];
#pragma unroll
            for (int r = 0; r < 16; ++r) { const int row = 32 * tb + (r & 3) + 8 * (r >> 2) + 4 * hi;
                O4[(size_t)(t0 + row) * 1024 + 256 + 64 * g + e] = (bf16)f2bf(acc[r] * sc); }
        }
    }
    LDS_WAIT();
}
__device__ __forceinline__ void conv_task(Frame& F, const int layer, const int tile, const int cg) {
    const int lane = F.lane;
    const bf16* P = (const bf16*)(F.ws + WS_PROJ);
    bf16* O4 = (bf16*)(F.ws + WS_O4);
    const int t0 = tile * 64, s0 = t0 % SEQ;
    const int ch = 64 * cg + lane;
    const float w0 = F.in[I_SCONVW][layer * 768 + ch], w1 = F.in[I_SCONVW][layer * 768 + 256 + ch], w2 = F.in[I_SCONVW][layer * 768 + 512 + ch];
    const bf16* base = P + (size_t)t0 * PJ + ch;
    float zm = 0.f, z0 = 0.f, zp = 0.f;
    if (s0 > 0) zm = bf2f(base[-(long)PJ + C_CC]) * bf2f(base[-(long)PJ + C_CX]);
    z0 = bf2f(base[C_CC]) * bf2f(base[C_CX]);
#pragma unroll 8
    for (int i = 0; i < 64; ++i) {
        zp = 0.f; if (s0 + i + 1 < SEQ) zp = bf2f(base[(long)(i + 1) * PJ + C_CC]) * bf2f(base[(long)(i + 1) * PJ + C_CX]);
        const float cbv = bf2f(base[(long)i * PJ + C_CB]);
        O4[(size_t)(t0 + i) * 1024 + 512 + ch] = (bf16)f2bf(cbv * (w0 * zm + w1 * z0 + w2 * zp));
        zm = z0; z0 = zp;
    }
}
}

namespace dl {
constexpr int MP = 72, MB = 64 * MP * 2;
constexpr int WAVE_LDS = 2 * MB + 2 * MB;
__device__ __forceinline__ int crow(int r, int hi) { return (r & 3) + 8 * (r >> 2) + 4 * hi; }
__device__ __forceinline__ bf16x8 ldfrag(const LAS unsigned char* img, int row, int col) { return *(const LAS bf16x8*)(img + row * (MP * 2) + col * 2); }
__device__ __forceinline__ bf16x8 ldfragp(const LAS unsigned char* img, int row, int col4) {
    const v2u lo = *(const LAS v2u*)(img + row * (MP * 2) + col4 * 2), hi8 = *(const LAS v2u*)(img + row * (MP * 2) + col4 * 2 + 16); const v4u t = {lo.x, lo.y, hi8.x, hi8.y}; return __builtin_bit_cast(bf16x8, t); }
__device__ __forceinline__ bf16x8 cfrag(const f32x16& x, int half) {
    v4u t;
#pragma unroll
    for (int e = 0; e < 4; ++e) t[e] = att::cvtpk(x[8 * half + 2 * e], x[8 * half + 2 * e + 1]);
    return __builtin_bit_cast(bf16x8, t); }
#define MFMA32(a, b, c) __builtin_amdgcn_mfma_f32_32x32x16_bf16((a), (b), (c), 0, 0, 0)
#define SB() __builtin_amdgcn_sched_barrier(0)
#define LAUNDER() do { asm volatile("" : "+v"(lane)); r32 = lane & 31; hi = lane >> 5; } while (0)
__device__ __forceinline__ f32x16 zero16() { f32x16 z;
#pragma unroll
    for (int r = 0; r < 16; ++r) z[r] = 0.f;
    return z; }

#define DL_CONV(colbase, wbase, RAW) do { \
    { const bf16* src_ = P + (size_t)tok0 * PJ + (colbase); const int rr_ = lane >> 3, ch_ = lane & 7; \
      _Pragma("unroll") for (int i_ = 0; i_ < 9; ++i_) { const int row_ = rr_ + 8 * i_; const int sq_ = s0 - 2 + row_; v4u t_ = {0u, 0u, 0u, 0u}; \
          if (row_ < 68 && sq_ >= 0 && sq_ < SEQ) t_ = *(const GAS v4u*)(src_ + (long)(row_ - 2) * PJ + ch_ * 8); if (row_ < 68) *(LAS v4u*)((RAW) + row_ * 128 + ch_ * 16) = t_; } } \
    LDS_WAIT(); \
    const float cw0 = cwp[(wbase) + lane], cw1 = cwp[768 + (wbase) + lane], cw2 = cwp[2 * 768 + (wbase) + lane], cw3 = cwp[3 * 768 + (wbase) + lane], cw4 = cwp[4 * 768 + (wbase) + lane]; \
    const LAS unsigned short* rw_ = (const LAS unsigned short*)(RAW) + lane; \
    _Pragma("unroll") for (int i = 0; i < 64; ++i) { \
        const float cv_ = cw0 * bf2f(rw_[i * 64]) + cw1 * bf2f(rw_[(i + 1) * 64]) + cw2 * bf2f(rw_[(i + 2) * 64]) + cw3 * bf2f(rw_[(i + 3) * 64]) + cw4 * bf2f(rw_[(i + 4) * 64]); \
        cval[i] = cv_ * sigmoidf_(cv_); if ((i & 7) == 7) SB(); } \
    LDS_WAIT(); } while (0)
#define DL_NORM(SQ, scale) do { \
    _Pragma("unroll") for (int i = 0; i < 64; ++i) *(LAS unsigned short*)((SQ) + i * 144 + lane * 2) = (unsigned short)f2bf(cval[i] * cval[i]); \
    LDS_WAIT(); \
    { float sm_ = 0.f; _Pragma("unroll") for (int c8 = 0; c8 < 8; ++c8) { const v4u w_ = *(const LAS v4u*)((SQ) + lane * 144 + c8 * 16); \
          sm_ += (bflo(w_.x) + bfhi(w_.x)) + (bflo(w_.y) + bfhi(w_.y)) + (bflo(w_.z) + bfhi(w_.z)) + (bflo(w_.w) + bfhi(w_.w)); } \
      tab[192 + lane] = (scale) / sqrtf(sm_ + EPS); } \
    LDS_WAIT(); \
    _Pragma("unroll") for (int i4 = 0; i4 < 16; ++i4) { const f32x4 r4_ = *(const LAS f32x4*)(tab + 192 + 4 * i4); cval[4 * i4] *= r4_.x; cval[4 * i4 + 1] *= r4_.y; cval[4 * i4 + 2] *= r4_.z; cval[4 * i4 + 3] *= r4_.w; } \
    } while (0)

__device__ __forceinline__ void d1_instance(Frame& F, const int layer, const int b, const int h, const int norig, const int dir, LAS unsigned char* W, LAS float* tab) {
    int lane = F.lane, r32, hi; LAUNDER();
    const bf16* P = (const bf16*)(F.ws + WS_PROJ);
    const float* cwp = F.in[I_DCONVW] + (size_t)layer * 5 * 768;
    const int s0 = norig * 64, tok0 = b * SEQ + s0;
    const int npr = dir ? 255 - norig : norig;
    const int inst = ((b * 4 + h) * 2 + dir) * NCHUNK + npr;
    LAS unsigned char* VT = W;
    LAS unsigned char* KT = W + MB;
    LAS unsigned char* KR = W + 2 * MB;
    LAS unsigned char* T2 = W + 3 * MB;
    LAS float* SM = (LAS float*)(W + 2 * MB);
    float cval[64];
    DL_CONV(C_DK + 64 * h, 256 + 64 * h, T2);
    DL_NORM(VT, 1.f);
#pragma unroll
    for (int i = 0; i < 64; ++i) { const int ip = dir ? 63 - i : i; const unsigned short kb = (unsigned short)f2bf(cval[i]);
        *(LAS unsigned short*)(KR + ip * (MP * 2) + lane * 2) = kb; *(LAS unsigned short*)(KT + lane * (MP * 2) + ip * 2) = kb; }
    LDS_WAIT();
    DL_CONV(C_DV + 64 * h, 512 + 64 * h, T2);
#pragma unroll
    for (int i = 0; i < 64; ++i) { const int ip = dir ? 63 - i : i; *(LAS unsigned short*)(VT + lane * (MP * 2) + ip * 2) = (unsigned short)f2bf(cval[i]); }
    const int mytok = tok0 + (dir ? 63 - lane : lane);
    const float* BD = (const float*)(F.ws + WS_BD) + (size_t)mytok * 16;
    const float beta = BD[dir * 4 + h]; float gc = BD[8 + dir * 4 + h];
#pragma unroll
    for (int o = 1; o < 64; o <<= 1) { const float t = __shfl_up(gc, o); if (lane >= o) gc += t; }
    const float gl = __shfl(gc, 63);
    tab[lane] = gc; tab[64 + lane] = beta; tab[128 + lane] = __expf(gl - gc);
    LDS_WAIT();
    LAUNDER();
    f32x16 kk[2][2];
#pragma unroll
    for (int tb = 0; tb < 2; ++tb)
#pragma unroll
        for (int tn = 0; tn < 2; ++tn) { f32x16 acc = zero16();
#pragma unroll
            for (int ks = 0; ks < 4; ++ks) acc = MFMA32(ldfrag(KR, r32 + 32 * tb, 16 * ks + 8 * hi), ldfrag(KR, r32 + 32 * tn, 16 * ks + 8 * hi), acc);
            kk[tb][tn] = acc; SB(); }
    LDS_WAIT();
#pragma unroll
    for (int tb = 0; tb < 2; ++tb)
#pragma unroll
        for (int tn = 0; tn < 2; ++tn) {
            const int jc = r32 + 32 * tn; const float gcj = tab[jc];
#pragma unroll
            for (int r = 0; r < 16; ++r) { const int ir = 32 * tb + crow(r, hi); const float gci = tab[ir], bi = tab[64 + ir];
                const float mv = (ir > jc) ? bi * kk[tb][tn][r] * __expf(gci - gcj) : 0.f; SM[ir * 64 + jc] = mv; } SB(); }
    LDS_WAIT();
    LAUNDER();
    float T[64];
#pragma unroll
    for (int i = 0; i < 64; ++i) {
        float a0 = (lane == i) ? 1.f : 0.f, a1 = 0.f, a2 = 0.f, a3 = 0.f;
#pragma unroll
        for (int j4 = 0; j4 < (i + 3) / 4; ++j4) { const f32x4 m4 = *(const LAS f32x4*)(SM + i * 64 + 4 * j4);
            if (4 * j4 + 0 < i) a0 = __builtin_fmaf(-m4[0], T[4 * j4 + 0], a0);
            if (4 * j4 + 1 < i) a1 = __builtin_fmaf(-m4[1], T[4 * j4 + 1], a1);
            if (4 * j4 + 2 < i) a2 = __builtin_fmaf(-m4[2], T[4 * j4 + 2], a2);
            if (4 * j4 + 3 < i) a3 = __builtin_fmaf(-m4[3], T[4 * j4 + 3], a3); }
        T[i] = (a0 + a1) + (a2 + a3); if ((i & 3) == 3) SB(); }
    LDS_WAIT();
    LAUNDER();
    { const float b1 = beta, b2 = beta * __expf(gc);
#pragma unroll
      for (int i = 0; i < 64; ++i) { *(LAS unsigned short*)(KR + i * (MP * 2) + lane * 2) = (unsigned short)f2bf(T[i] * b1); *(LAS unsigned short*)(T2 + i * (MP * 2) + lane * 2) = (unsigned short)f2bf(T[i] * b2); if ((i & 7) == 7) SB(); } }
    LDS_WAIT();
    LAUNDER();
    f32x16 u[2][2], w[2][2];
#pragma unroll
    for (int tb = 0; tb < 2; ++tb)
#pragma unroll
        for (int tn = 0; tn < 2; ++tn) { f32x16 au = zero16(), aw = zero16();
#pragma unroll
            for (int ks = 0; ks < 4; ++ks) { au = MFMA32(ldfrag(KR, r32 + 32 * tb, 16 * ks + 8 * hi), ldfrag(VT, r32 + 32 * tn, 16 * ks + 8 * hi), au);
                                             aw = MFMA32(ldfrag(T2, r32 + 32 * tb, 16 * ks + 8 * hi), ldfrag(KT, r32 + 32 * tn, 16 * ks + 8 * hi), aw); }
            u[tb][tn] = au; w[tb][tn] = aw; SB(); }
    LAUNDER();
    { unsigned* ud = (unsigned*)(F.ws + WS_UW + (size_t)inst * 16384); bf16* wd = (bf16*)(F.ws + WS_UW + (size_t)inst * 16384 + 8192);
#pragma unroll
      for (int tb = 0; tb < 2; ++tb)
#pragma unroll
          for (int tn = 0; tn < 2; ++tn) {
#pragma unroll
              for (int rp = 0; rp < 8; ++rp) ud[((tb * 2 + tn) * 8 + rp) * 64 + lane] = pk2(u[tb][tn][2 * rp], u[tb][tn][2 * rp + 1]);
#pragma unroll
              for (int r = 0; r < 16; ++r) wd[(32 * tb + crow(r, hi)) * 64 + r32 + 32 * tn] = (bf16)f2bf(w[tb][tn][r]); SB(); } }
    LAUNDER();
#pragma unroll
    for (int tb = 0; tb < 2; ++tb)
#pragma unroll
        for (int r = 0; r < 16; ++r) { const float e = tab[128 + 32 * tb + crow(r, hi)];
#pragma unroll
            for (int tn = 0; tn < 2; ++tn) { u[tb][tn][r] *= e; w[tb][tn][r] *= e; } }
    SB();
    bf16x8 kf[2][4];
#pragma unroll
    for (int tbb = 0; tbb < 2; ++tbb)
#pragma unroll
        for (int s = 0; s < 4; ++s) kf[tbb][s] = ldfragp(KT, r32 + 32 * tbb, 16 * s + 4 * hi);
    LDS_WAIT(); SB();
    LAUNDER();
    LAS unsigned char* AR = VT; LAS unsigned char* BT = KR;
#pragma unroll
    for (int tbb = 0; tbb < 2; ++tbb)
#pragma unroll
        for (int tx = 0; tx < 2; ++tx) { f32x16 aa = zero16(), ab = zero16();
#pragma unroll
            for (int s = 0; s < 4; ++s) { aa = MFMA32(cfrag(w[s >> 1][tx], s & 1), kf[tbb][s], aa); ab = MFMA32(kf[tbb][s], cfrag(u[s >> 1][tx], s & 1), ab); }
#pragma unroll
            for (int g4 = 0; g4 < 4; ++g4) {
                const v2u pa = {pk2(-aa[4 * g4], -aa[4 * g4 + 1]), pk2(-aa[4 * g4 + 2], -aa[4 * g4 + 3])};
                *(LAS v2u*)(AR + (r32 + 32 * tbb) * (MP * 2) + (32 * tx + 8 * g4 + 4 * hi) * 2) = pa;
                const v2u pb = {pk2(ab[4 * g4], ab[4 * g4 + 1]), pk2(ab[4 * g4 + 2], ab[4 * g4 + 3])};
                *(LAS v2u*)(BT + (r32 + 32 * tx) * (MP * 2) + (32 * tbb + 8 * g4 + 4 * hi) * 2) = pb;
            } SB(); }
    LDS_WAIT();
    LAUNDER();
    { unsigned char* ab = F.ws + WS_AB + (size_t)inst * 16384; const int m16 = lane & 15, g = lane >> 4;
#pragma unroll
      for (int rb = 0; rb < 4; ++rb)
#pragma unroll
          for (int ks = 0; ks < 2; ++ks) { const v2u lo = *(const LAS v2u*)(AR + (16 * rb + m16) * (MP * 2) + (32 * ks + 4 * g) * 2), hi8 = *(const LAS v2u*)(AR + (16 * rb + m16) * (MP * 2) + (32 * ks + 16 + 4 * g) * 2);
              const v4u t = {lo.x, lo.y, hi8.x, hi8.y}; *(GAS v4u*)(ab + ((rb * 2 + ks) * 64 + lane) * 16) = t; }
#pragma unroll
      for (int sl = 0; sl < 4; ++sl)
#pragma unroll
          for (int rb = 0; rb < 4; ++rb) { const v2u t = *(const LAS v2u*)(BT + (16 * sl + m16) * (MP * 2) + (16 * rb + 4 * g) * 2); *(GAS v2u*)(ab + 8192 + ((sl * 4 + rb) * 64 + lane) * 8) = t; } }
    if (lane == 0) ((float*)(F.ws + WS_DEC))[inst] = __expf(gl);
    LDS_WAIT();
}
__device__ __forceinline__ void pc_side_tasks(Frame& F, const int layer, const int half) {
    if (F.wave == 4) {
        LAS unsigned char* mimg = F.lds + RING_OFF + 4 * WAVE_LDS + 4096;
        for (int tile = F.vcu + half * F.G; tile < NTOK / 64; tile += 2 * F.G)
            for (int g = 0; g < 4; ++g) pc::pool_task(F, layer, tile, g, mimg);
    } else if (F.wave > 4) {
        int k = 0;
        for (int tile = F.vcu + half * F.G; tile < NTOK / 64; tile += 2 * F.G)
            for (int cg = 0; cg < 4; ++cg, ++k) if (k % 3 == F.wave - 5) pc::conv_task(F, layer, tile, cg);
    }
}
__device__ __forceinline__ void d1_phase(Frame& F, const int layer) {
    if (F.wave < 4) {
        LAS unsigned char* W = F.lds + RING_OFF + F.wave * WAVE_LDS; LAS float* tab = (LAS float*)(F.lds + RING_OFF + 4 * WAVE_LDS + F.wave * 1024);
        const int gw = F.vcu * 4 + F.wave, NGW = F.G * 4;
        for (int it = gw; it < NINST; it += NGW) { const int dir = it & 1, u = it >> 1; d1_instance(F, layer, u >> 10, (u >> 8) & 3, u & 255, dir, W, tab); }
    } else pc_side_tasks(F, layer, 0);
    __syncthreads();
}

typedef float f32x4v __attribute__((ext_vector_type(4)));
struct D2Regs { v4u af[4][2]; v2u bm[4]; float dcy; };
__device__ __forceinline__ void d2_chain(Frame& F, const int chain) {
    const int lane = F.lane, n16 = lane & 15, g = lane >> 4, sl = F.wave;
    f32x4v S[4];
#pragma unroll
    for (int rb = 0; rb < 4; ++rb) S[rb] = (f32x4v){0.f, 0.f, 0.f, 0.f};
    const unsigned char* abase = F.ws + WS_AB + (size_t)chain * NCHUNK * 16384;
    unsigned char* sbase = F.ws + WS_ST + (size_t)chain * NCHUNK * 8192;
    const float* dec = (const float*)(F.ws + WS_DEC) + chain * NCHUNK;
    D2Regs q0, q1, q2;
#define D2_LOAD(Q, n) do { const unsigned char* ab_ = abase + (size_t)(n) * 16384; \
    _Pragma("unroll") for (int rb = 0; rb < 4; ++rb) { _Pragma("unroll") for (int ks = 0; ks < 2; ++ks) Q.af[rb][ks] = *(const GAS v4u*)(ab_ + ((rb * 2 + ks) * 64 + lane) * 16); \
        Q.bm[rb] = *(const GAS v2u*)(ab_ + 8192 + ((sl * 4 + rb) * 64 + lane) * 8); } Q.dcy = dec[n]; } while (0)
#define D2_STEP(Q, n) do { \
    unsigned char* st = sbase + (size_t)(n) * 8192 + (16 * sl + n16) * 128; \
    _Pragma("unroll") for (int rb = 0; rb < 4; ++rb) { const v2u t = {pk2(S[rb][0], S[rb][1]), pk2(S[rb][2], S[rb][3])}; *(GAS v2u*)(st + (16 * rb + 4 * g) * 2) = t; } \
    bf16x8 bfr[2]; \
    _Pragma("unroll") for (int ks = 0; ks < 2; ++ks) { const v4u t = {att::cvtpk(S[2 * ks][0], S[2 * ks][1]), att::cvtpk(S[2 * ks][2], S[2 * ks][3]), att::cvtpk(S[2 * ks + 1][0], S[2 * ks + 1][1]), att::cvtpk(S[2 * ks + 1][2], S[2 * ks + 1][3])}; bfr[ks] = __builtin_bit_cast(bf16x8, t); } \
    _Pragma("unroll") for (int rb = 0; rb < 4; ++rb) { const float cd = Q.dcy; \
        f32x4v c = {S[rb][0] * cd + bflo(Q.bm[rb].x), S[rb][1] * cd + bfhi(Q.bm[rb].x), S[rb][2] * cd + bflo(Q.bm[rb].y), S[rb][3] * cd + bfhi(Q.bm[rb].y)}; \
        c = __builtin_amdgcn_mfma_f32_16x16x32_bf16(__builtin_bit_cast(bf16x8, Q.af[rb][0]), bfr[0], c, 0, 0, 0); \
        c = __builtin_amdgcn_mfma_f32_16x16x32_bf16(__builtin_bit_cast(bf16x8, Q.af[rb][1]), bfr[1], c, 0, 0, 0); \
        S[rb] = c; } } while (0)
    D2_LOAD(q0, 0); D2_LOAD(q1, 1);
    for (int n = 0; n < NCHUNK - 1; n += 3) {
        D2_LOAD(q2, n + 2); D2_STEP(q0, n); SB();
        D2_LOAD(q0, n + 3); D2_STEP(q1, n + 1); SB();
        if (n + 4 < NCHUNK) D2_LOAD(q1, n + 4); D2_STEP(q2, n + 2); SB();
    }
    D2_STEP(q0, NCHUNK - 1);
#undef D2_LOAD
#undef D2_STEP
}

__device__ __forceinline__ void scan_attn_phase(Frame& F, const int layer, const int qword) {
    for (;;) {
        { unsigned char* w_ = F.ws; int t_ = F.tid; asm volatile("" : "+s"(w_), "+v"(t_)); F.ws = w_; F.ctl = (gu32*)(w_ + WS_CTL); F.tid = t_; F.lane = t_ & 63; }
        if (F.tid == 0) F.MISC[16] = __hip_atomic_fetch_add(F.ctl + CW_ATTQ + 64 * qword, 1u, RLX_AGENT);
        __syncthreads();
        const int idx = (int)F.MISC[16];
        __syncthreads();
        if (idx >= 16 + BATCH * 4 * 64) break;
        if (idx < 16) { if (F.wave < 4) d2_chain(F, idx); }
        else { const int j = idx - 16, h = 3 - (j >> 7), jj = j & 127, b = jj & 1, k = jj >> 1, qb = (k & 1) ? 31 - (k >> 1) : 32 + (k >> 1);
            att::attn_unit(F, layer, b, h, qb); }
    }
    __syncthreads();
}

__device__ __forceinline__ void d3_unit(Frame& F, const int layer, const int b, const int h, const int norig, LAS unsigned char* W, LAS float* tab) {
    int lane = F.lane, r32, hi; LAUNDER();
    const bf16* P = (const bf16*)(F.ws + WS_PROJ);
    const float* cwp = F.in[I_DCONVW] + (size_t)layer * 5 * 768;
    const int s0 = norig * 64, tok0 = b * SEQ + s0;
    LAS unsigned char* QR = W;
    LAS unsigned char* KR = W + MB;
    LAS unsigned char* AT = W + 2 * MB;
    LAS unsigned char* WR = W + 3 * MB;
    { float cval[64];
      DL_CONV(C_DQ + 64 * h, 64 * h, WR);
      DL_NORM(AT, 0.125f);
#pragma unroll
      for (int i = 0; i < 64; ++i) *(LAS unsigned short*)(QR + i * (MP * 2) + lane * 2) = (unsigned short)f2bf(cval[i]);
      LDS_WAIT();
      DL_CONV(C_DK + 64 * h, 256 + 64 * h, WR);
      DL_NORM(AT, 1.f);
#pragma unroll
      for (int i = 0; i < 64; ++i) *(LAS unsigned short*)(KR + i * (MP * 2) + lane * 2) = (unsigned short)f2bf(cval[i]);
      LDS_WAIT(); }
    f32x16 of[2][2];
#pragma unroll
    for (int dir = 0; dir < 2; ++dir) {
        LAUNDER();
        const int npr = dir ? 255 - norig : norig;
        const int inst = ((b * 4 + h) * 2 + dir) * NCHUNK + npr;
        const int mytok = tok0 + (dir ? 63 - lane : lane);
        float gc = ((const float*)(F.ws + WS_BD))[(size_t)mytok * 16 + 8 + dir * 4 + h];
#pragma unroll
        for (int o = 1; o < 64; o <<= 1) { const float t = __shfl_up(gc, o); if (lane >= o) gc += t; }
        tab[lane] = gc; tab[64 + lane] = __expf(gc);
        { const unsigned char* wg = F.ws + WS_UW + (size_t)inst * 16384 + 8192;
#pragma unroll
          for (int i = 0; i < 8; ++i) { const int idx = i * 64 + lane, row = idx >> 3, ch = idx & 7; const v4u c = *(const GAS v4u*)(wg + idx * 16); *(LAS v4u*)(WR + row * (MP * 2) + ch * 16) = c; } }
        LDS_WAIT();
        LAUNDER();
        const int ra0 = dir ? 63 - r32 : r32, ra1 = dir ? 31 - r32 : 32 + r32;
        f32x16 qk[2][2];
#pragma unroll
        for (int tb = 0; tb < 2; ++tb)
#pragma unroll
            for (int tn = 0; tn < 2; ++tn) { f32x16 acc = zero16();
#pragma unroll
                for (int ks = 0; ks < 4; ++ks) acc = MFMA32(ldfrag(QR, tb ? ra1 : ra0, 16 * ks + 8 * hi), ldfrag(KR, tn ? ra1 : ra0, 16 * ks + 8 * hi), acc);
                qk[tb][tn] = acc; SB(); }
        LDS_WAIT();
#pragma unroll
        for (int tb = 0; tb < 2; ++tb)
#pragma unroll
            for (int tn = 0; tn < 2; ++tn) { const int jc = r32 + 32 * tn; const float gcj = tab[jc];
#pragma unroll
                for (int r = 0; r < 16; ++r) { const int ir = 32 * tb + crow(r, hi); const float gci = tab[ir];
                    const float av = (ir >= jc) ? qk[tb][tn][r] * __expf(gci - gcj) : 0.f; *(LAS unsigned short*)(AT + ir * (MP * 2) + jc * 2) = (unsigned short)f2bf(av); } SB(); }
        LDS_WAIT();
        LAUNDER();
        const unsigned* ud = (const unsigned*)(F.ws + WS_UW + (size_t)inst * 16384);
        const unsigned char* sg = F.ws + WS_ST + (size_t)inst * 8192;
#pragma unroll
        for (int tn = 0; tn < 2; ++tn) {
            bf16x8 sf[4];
#pragma unroll
            for (int ks = 0; ks < 4; ++ks) sf[ks] = *(const GAS bf16x8*)(sg + ((r32 + 32 * tn) * 64 + 16 * ks + 8 * hi) * 2);
            f32x16 vn[2], o[2];
#pragma unroll
            for (int tb = 0; tb < 2; ++tb) { f32x16 a1 = zero16(), a2 = zero16();
#pragma unroll
                for (int ks = 0; ks < 4; ++ks) { a1 = MFMA32(ldfrag(WR, r32 + 32 * tb, 16 * ks + 8 * hi), sf[ks], a1); a2 = MFMA32(ldfrag(QR, tb ? ra1 : ra0, 16 * ks + 8 * hi), sf[ks], a2); }
#pragma unroll
                for (int rp = 0; rp < 8; ++rp) { const unsigned uw = ud[((tb * 2 + tn) * 8 + rp) * 64 + lane]; a1[2 * rp] = bflo(uw) - a1[2 * rp]; a1[2 * rp + 1] = bfhi(uw) - a1[2 * rp + 1]; }
#pragma unroll
                for (int r = 0; r < 16; ++r) a2[r] *= tab[64 + 32 * tb + crow(r, hi)];
                vn[tb] = a1; o[tb] = a2; SB(); }
#pragma unroll
            for (int tb = 0; tb < 2; ++tb) { f32x16 acc = o[tb];
#pragma unroll
                for (int s = 0; s < 4; ++s) acc = MFMA32(ldfragp(AT, r32 + 32 * tb, 16 * s + 4 * hi), cfrag(vn[s >> 1], s & 1), acc);
                o[tb] = acc; SB(); }
            if (dir == 0) { of[0][tn] = o[0]; of[1][tn] = o[1]; }
            else {
#pragma unroll
                for (int tb = 0; tb < 2; ++tb)
#pragma unroll
                    for (int r = 0; r < 16; ++r) of[tb][tn][r] += __shfl_xor(o[1 - tb][15 - r], 32);
            }
        }
        LDS_WAIT();
    }
    const float* dn = F.in[I_DNORM] + layer * 64;
#pragma unroll
    for (int tb = 0; tb < 2; ++tb)
#pragma unroll
        for (int r = 0; r < 16; ++r) {
            float ss = of[tb][0][r] * of[tb][0][r] + of[tb][1][r] * of[tb][1][r];
#pragma unroll
            for (int o = 1; o < 32; o <<= 1) ss += __shfl_xor(ss, o);
            const float rs = 1.f / sqrtf(ss * (1.f / 64.f) + EPS);
            const int tok = tok0 + 32 * tb + crow(r, hi);
#pragma unroll
            for (int tn = 0; tn < 2; ++tn) { const int dv = r32 + 32 * tn; const float z = bf2f(P[(size_t)tok * PJ + C_DZ + 64 * h + dv]);
                ((bf16*)(F.ws + WS_O4))[(size_t)tok * 1024 + 768 + 64 * h + dv] = (bf16)f2bf(of[tb][tn][r] * rs * dn[dv] * siluf_(z)); }
        }
}
__device__ __forceinline__ void d3_phase(Frame& F, const int layer) {
    if (F.wave < 4) {
        LAS unsigned char* W = F.lds + RING_OFF + F.wave * WAVE_LDS; LAS float* tab = (LAS float*)(F.lds + RING_OFF + 4 * WAVE_LDS + F.wave * 1024);
        const int gw = F.vcu * 4 + F.wave, NGW = F.G * 4;
        for (int u = gw; u < BATCH * 4 * NCHUNK; u += NGW) d3_unit(F, layer, u >> 10, (u >> 8) & 3, u & 255, W, tab);
    } else pc_side_tasks(F, layer, 1);
    __syncthreads();
}
#undef MFMA32
}

#ifndef ONLY_SITE
#define ONLY_SITE -1
#endif
#define SITE(k) (ONLY_SITE < 0 || ONLY_SITE == (k))
#ifndef PROBE_MASK
#define PROBE_MASK 0
#endif
#ifndef PROBE_N
#define PROBE_N 2
#endif
#define REPEAT(k) for (int rep_ = 0; rep_ < (((PROBE_MASK >> (k)) & 1) ? PROBE_N : 1); ++rep_)
#ifndef MK_SPLIT
#define MK_SPLIT 0
#endif
struct Args { const float* in[30]; float* out; unsigned char* ws; int ph_lo, ph_hi; };
constexpr int N_PHASES = 1 + 16 * NLAYER + 1;

#define IN_PH() (pid >= lo && pid < hi)
#define FRESH() do { unsigned char* w_ = args.ws; float* o_ = args.out; int t_ = threadIdx.x; asm volatile("" : "+s"(w_), "+s"(o_), "+v"(t_)); F.ws = w_; F.out = o_; F.ctl = (gu32*)(w_ + WS_CTL); F.tid = t_; F.lane = t_ & 63; } while (0)
#define SEAM() do { if (!MK_SPLIT && pid >= lo && pid + 1 < hi) xcd_barrier(bar); ++pid; } while (0)
#define NOSEAM() do { ++pid; } while (0)

template <int l> __device__ __forceinline__ void layer_phases(Frame& F, const Args& args, const XcdBarrier& bar, const int lo, const int hi, int& pid) {
    LAS unsigned char* ring = F.lds + RING_OFF;

        if constexpr (l == 0) { if (IN_PH() && SITE(1)) REPEAT(1) { FRESH(); p_rows<ROW_A>(F, 0); } SEAM(); } else { NOSEAM(); }
        if (IN_PH() && SITE(2)) REPEAT(2) { FRESH();
            pg8::SchedStd S; S.init(NTOK / 256, NPROJ / 256, F.G, (int)blockIdx.x, F.ws + WS_H, (size_t)256 * D * 2, w_in_t(F.ws, l), (size_t)256 * D * 2);
            pg8::EpiProj E{(bf16*)(F.ws + WS_QB), (bf16*)(F.ws + WS_KV), (bf16*)(F.ws + WS_PROJ), (unsigned*)(F.ctl + CW_NMAX) + l * 16, QSCALE};
            pg8::gemm_phase<pg8::EpiProj, pg8::SchedStd, D, D, D>(ring, F.tid, S, E);
        }
        SEAM();
        NOSEAM();
        if (IN_PH() && SITE(5)) REPEAT(5) { FRESH(); dl::d1_phase(F, l); }
        SEAM();
        if (IN_PH() && SITE(3)) REPEAT(3) { FRESH(); dl::scan_attn_phase(F, l, l * 2 + rep_); }
        SEAM();
        NOSEAM();
        if (IN_PH() && SITE(7)) REPEAT(7) { FRESH(); dl::d3_phase(F, l); }
        SEAM();
        if (IN_PH() && SITE(8)) REPEAT(8) { FRESH();
            pg8::SchedBranch S; S.s.init(NTOK / 256, 16, F.G, (int)blockIdx.x, nullptr, 0, nullptr, 0); S.O4 = (const char*)(F.ws + WS_O4); S.Wb = (const char*)w_b_t(F.ws, l);
            pg8::EpiStore E{(bf16*)(F.ws + WS_PBUF), 1024, (size_t)NTOK * 1024, 1.f};
            pg8::gemm_phase<pg8::EpiStore, pg8::SchedBranch, 256, 1024, 256>(ring, F.tid, S, E);
        }
        SEAM();
        if (IN_PH() && SITE(9)) REPEAT(9) { FRESH();
            pg8::SchedGate S{F.vcu, F.G, (const char*)(F.ws + WS_H), (const char*)w_m_t(F.ws, l)};
            pg8::EpiGate E{(const bf16*)(F.ws + WS_PBUF), (bf16*)(F.ws + WS_MERGED), F.in[I_BMERGE] + (size_t)l * 4 * D};
            pg8::gemm_phase<pg8::EpiGate, pg8::SchedGate, D, D, D>(ring, F.tid, S, E);
        }
        SEAM();
        if (IN_PH() && SITE(10)) REPEAT(10) { FRESH();
            pg8::SchedStd S; S.init(NTOK / 256, D / 256, F.G, (int)blockIdx.x, F.ws + WS_MERGED, (size_t)256 * D * 2, w_o_t(F.ws, l), (size_t)256 * D * 2);
            pg8::EpiStore E{(bf16*)(F.ws + WS_F), D, 0, 1.f};
            pg8::gemm_phase<pg8::EpiStore, pg8::SchedStd, D, D, D>(ring, F.tid, S, E);
        }
        SEAM();
        if (IN_PH() && SITE(11)) REPEAT(11) { FRESH(); p_rows<ROW_B>(F, l); }
        SEAM();
        if constexpr (l == 0) {
            if (IN_PH() && SITE(12)) REPEAT(12) { FRESH();
                pg8::SchedStd S; S.init(NTOK / 256, 2 * DFF / 256, F.G, (int)blockIdx.x, F.ws + WS_H, (size_t)256 * D * 2, F.ws + WS_WFFN, (size_t)256 * D * 2);
                pg8::EpiSwiGLU E{(bf16*)(F.ws + WS_ACT0), DFF};
                pg8::gemm_phase<pg8::EpiSwiGLU, pg8::SchedStd, D, D, D>(ring, F.tid, S, E);
            }
            SEAM();
            if (IN_PH() && SITE(13)) REPEAT(13) { FRESH();
                pg8::SchedStd S; S.init(NTOK / 256, D / 256, F.G, (int)blockIdx.x, F.ws + WS_ACT0, (size_t)256 * DFF * 2, F.ws + WS_WFFN + SZ_WGU, (size_t)256 * DFF * 2);
                pg8::EpiStore E{(bf16*)(F.ws + WS_F), D, 0, 1.f};
                pg8::gemm_phase<pg8::EpiStore, pg8::SchedStd, DFF, DFF, DFF>(ring, F.tid, S, E);
            }
            SEAM();
            if (IN_PH() && SITE(14)) REPEAT(14) { FRESH(); p_rows<ROW_C>(F, 0); }
            SEAM();
            NOSEAM(); NOSEAM();
        } else {
            if (IN_PH() && SITE(15)) REPEAT(15) { FRESH(); p_moe_cvt(F); }
            SEAM();
#pragma unroll 1
            for (int pass = 0; pass < 2; ++pass) {
                if (IN_PH() && SITE(16)) REPEAT(16) { FRESH();
                    pg8::SchedMoe S; S.c = (int)blockIdx.x; S.G = F.G; S.nN = 2 * DFF / 256; moe_tiles(F, S.cnt, S.tstart);
                    S.t0 = pass * MOE_PASS_TILES; S.t1 = S.tstart[8] < (pass + 1) * MOE_PASS_TILES ? S.tstart[8] : (pass + 1) * MOE_PASS_TILES;
                    S.A = (const char*)(F.ws + WS_H2B); S.lists = (const int*)(F.ws + WS_ROUTE + 1 * MiB); S.W = (const char*)(F.ws + WS_MOEW); S.w_tile = (size_t)256 * D * 2; S.gather = true;
                    pg8::EpiSwiGLU E{(bf16*)(F.ws + WS_ACT1), DFF};
                    pg8::gemm_phase<pg8::EpiSwiGLU, pg8::SchedMoe, D, D, D, true>(ring, F.tid, S, E);
                }
                SEAM();
                if (IN_PH() && SITE(17)) REPEAT(17) { FRESH();
                    pg8::SchedMoe S; S.c = (int)blockIdx.x; S.G = F.G; S.nN = D / 256; moe_tiles(F, S.cnt, S.tstart);
                    S.t0 = pass * MOE_PASS_TILES; S.t1 = S.tstart[8] < (pass + 1) * MOE_PASS_TILES ? S.tstart[8] : (pass + 1) * MOE_PASS_TILES;
                    S.A = (const char*)(F.ws + WS_ACT1); S.lists = nullptr; S.W = (const char*)(F.ws + WS_MOEW + SZ_WGU); S.w_tile = (size_t)256 * DFF * 2; S.gather = false;
                    pg8::EpiStore E{(bf16*)(F.ws + WS_Y), D, 0, 1.f};
                    pg8::gemm_phase<pg8::EpiStore, pg8::SchedMoe, DFF, DFF, DFF>(ring, F.tid, S, E);
                }
                SEAM();
            }
        }
    }

__global__ void __launch_bounds__(NWAVES * 64, 2) fwd_kernel(const Args args) {
    extern __shared__ __attribute__((aligned(16))) unsigned char lds[];
    Frame F;
    F.lds = (LAS unsigned char*)lds;
    F.MISC = (volatile LAS unsigned*)(F.lds + MISC_OFF);
    F.tid = threadIdx.x; F.lane = F.tid & 63; F.wave = __builtin_amdgcn_readfirstlane(F.tid >> 6);
    F.G = gridDim.x; { const int bx = blockIdx.x; F.vcu = (F.G % 8 == 0) ? (bx % 8) * (F.G / 8) + bx / 8 : bx; }
    F.ws = args.ws; F.out = args.out; F.ctl = (gu32*)(args.ws + WS_CTL);
    F.in = args.in;
    if (F.tid < 64) ((LAS unsigned*)(F.lds + MISC_OFF))[F.tid] = 0u;
    __syncthreads();
    XcdBarrier bar; bar.bar = (unsigned*)(F.ctl + CW_BAR); bar.x = 0; bar.st = nullptr;
    if (!MK_SPLIT) bar = xcd_barrier_post((unsigned*)(F.ctl + CW_BAR), F.MISC + 8);
    const int lo = args.ph_lo, hi = args.ph_hi;
    int pid = 0;
    LAS unsigned char* ring = F.lds + RING_OFF;

    if (IN_PH() && SITE(0)) REPEAT(0) { FRESH(); p_prologue(F); }
    SEAM();
    layer_phases<0>(F, args, bar, lo, hi, pid);
    layer_phases<1>(F, args, bar, lo, hi, pid);
    if (IN_PH() && SITE(18)) REPEAT(18) { FRESH(); p_rows<ROW_C>(F, 1); }
#undef IN_PH
#undef SEAM
#undef NOSEAM
}

extern "C" void kernel_launch(void* const* d_in, const int* in_sizes, int n_in, void* d_out, int out_size, void* d_ws, size_t ws_size, hipStream_t stream) {
    static int grid = 0;
    if (grid == 0) {
        if (n_in != N_INPUTS || in_sizes[0] != NTOK * D || out_size != NTOK * D || ws_size < WS_END) {
            fprintf(stderr, "kernel_launch: unexpected problem (n_in %d, in0 %d, out %d, ws %zu < %zu); nothing launched\n", n_in, n_in > 0 ? in_sizes[0] : -1, out_size, ws_size, (size_t)WS_END); grid = -1; return; }
        int dev = 0, cus = 0, per_cu = 0;
        if (hipGetDevice(&dev) != hipSuccess || hipDeviceGetAttribute(&cus, hipDeviceAttributeMultiprocessorCount, dev) != hipSuccess) { grid = -1; return; }
        if (hipFuncSetAttribute((const void*)fwd_kernel, hipFuncAttributeMaxDynamicSharedMemorySize, LDS_BYTES) != hipSuccess) { fprintf(stderr, "kernel_launch: hipFuncSetAttribute failed\n"); grid = -1; return; }
        if (hipOccupancyMaxActiveBlocksPerMultiprocessor(&per_cu, (const void*)fwd_kernel, NWAVES * 64, LDS_BYTES) != hipSuccess || per_cu < 1)
            fprintf(stderr, "kernel_launch: note: occupancy query reports %d workgroups per CU\n", per_cu);
        (void)hipGetLastError();
        grid = cus;
    }
    if (grid < 0) return;
    if (hipMemsetAsync((char*)d_ws + WS_CTL, 0, CTL_ZERO_BYTES, stream) != hipSuccess) return;
    Args a{};
    for (int i = 0; i < 30; ++i) a.in[i] = (const float*)d_in[i];
    a.out = (float*)d_out; a.ws = (unsigned char*)d_ws;
#if MK_SPLIT
    for (int p = 0; p < N_PHASES; ++p) { a.ph_lo = p; a.ph_hi = p + 1; hipLaunchKernelGGL(fwd_kernel, dim3(grid), dim3(NWAVES * 64), LDS_BYTES, stream, a); }
#else
    a.ph_lo = 0; a.ph_hi = N_PHASES;
    hipLaunchKernelGGL(fwd_kernel, dim3(grid), dim3(NWAVES * 64), LDS_BYTES, stream, a);
#endif
}
```

```cpp
#include <hip/hip_runtime.h>
#include <cstdio>
#include <cstdint>

namespace pg8 {
#define PG8_LAS __attribute__((address_space(3)))
typedef unsigned short bf16_t;
typedef short bf16x8 __attribute__((ext_vector_type(8)));
typedef float f32x4 __attribute__((ext_vector_type(4)));
typedef unsigned u32x4 __attribute__((ext_vector_type(4)));
typedef unsigned u32x2 __attribute__((ext_vector_type(2)));
constexpr int BM = 256, BK = 64, HALF = 128, HTB = HALF * BK * 2  , STAGE_BYTES = 8 * HTB;

__host__ __device__ __forceinline__ int lds_byte(int r, int c) { const int st = (r >> 4) * 2 + (c >> 5), rr = r & 15, cc = c & 31, ob = rr * 64 + cc * 2; return st * 1024 + (ob ^ (((ob >> 9) & 1) << 5)); }
__host__ __device__ __forceinline__ void stage_rc(int b, int& R, int& C) { const int st = b / 1024, sb = b % 1024, swz = sb ^ (((sb >> 9) & 1) << 5); R = (st >> 1) * 16 + swz / 64; C = (st & 1) * 32 + (swz % 64) / 2; }
__host__ __device__ __forceinline__ int perm32(int rho) { const int n = rho >> 4, i = rho & 15; return 8 * (i >> 2) + 4 * n + (i & 3); }

struct Unit { int pm, pn, aux, pad; const char* a; const char* b; const int* rows; };

__device__ __forceinline__ unsigned cvt_pk_bf16(float lo, float hi) { unsigned r; asm volatile("v_cvt_pk_bf16_f32 %0, %1, %2" : "=v"(r) : "v"(lo), "v"(hi)); return r; }


template <class Epi, class Sched, int K, int lda, int ldb, bool GATHER = false, bool ALIGN_EPI = true, bool SP2 = true>
__device__ __forceinline__ void gemm_phase(PG8_LAS unsigned char* lds, const int tid, const Sched& S, const Epi& E) {
    const int wid = __builtin_amdgcn_readfirstlane(tid >> 6), lane = tid & 63, wr = wid >> 2, wc = wid & 3, fr = lane & 15, fq = lane >> 4;
    constexpr int nt = K / BK;
    int Rs[2], Cs[2]; unsigned voffB[2];
#pragma unroll
    for (int i = 0; i < 2; ++i) { int R, C; stage_rc(tid * 16 + i * 8192, R, C); const int Rb = Epi::PERM ? ((R & ~31) + perm32(R & 31)) : R; Rs[i] = R; Cs[i] = C; voffB[i] = (unsigned)(Rb * ldb + C) * 2u; }
    const size_t kstep = (size_t)(BK * 2);
    const size_t hstepB = (size_t)HALF * ldb * 2;
    const unsigned ldsw = (unsigned)wid * 1024u;
    const int aoff = lds_byte(wr * 64 + fr, fq * 8), boff = lds_byte(wc * 32 + fr, fq * 8);
#define PG8_SA(b, h) (((b) * 2 + (h)) * HTB)
#define PG8_SB(b, h) ((4 + (b) * 2 + (h)) * HTB)
#define PG8_STAGE(bufoff, gbase, voff) do { _Pragma("unroll") for (int _i = 0; _i < 2; ++_i) \
        __builtin_amdgcn_global_load_lds((const unsigned*)((const char*)(gbase) + (voff)[_i]), (PG8_LAS unsigned*)(lds + (bufoff) + ldsw + _i * 8192), 16, 0, 0); } while (0)
#define PG8_LDA(dst, b, h) do { _Pragma("unroll") for (int m = 0; m < 4; ++m) _Pragma("unroll") for (int k = 0; k < 2; ++k) dst[m][k] = *(const PG8_LAS bf16x8*)(lds + PG8_SA(b, h) + aoff + m * 2048 + k * 1024); } while (0)
#define PG8_LDB(dst, b, h) do { _Pragma("unroll") for (int n = 0; n < 2; ++n) _Pragma("unroll") for (int k = 0; k < 2; ++k) dst[n][k] = *(const PG8_LAS bf16x8*)(lds + PG8_SB(b, h) + boff + n * 2048 + k * 1024); } while (0)
#define PG8_MMA(ai, bj, At, Bt) do { __builtin_amdgcn_s_setprio(1); _Pragma("unroll") for (int m = 0; m < 4; ++m) _Pragma("unroll") for (int n = 0; n < 2; ++n) _Pragma("unroll") for (int k = 0; k < 2; ++k) \
        acc[ai][bj][m][n] = __builtin_amdgcn_mfma_f32_16x16x32_bf16(Bt[n][k], At[m][k], acc[ai][bj][m][n], 0, 0, 0); __builtin_amdgcn_s_setprio(0); } while (0)
#define PG8_WAIT_V(n) asm volatile("s_waitcnt vmcnt(" #n ")" ::: "memory")
#define PG8_WAIT_L(n) asm volatile("s_waitcnt lgkmcnt(" #n ")" ::: "memory")
#define PG8_BAR __builtin_amdgcn_s_barrier()
#define PG8_SCHED __builtin_amdgcn_sched_barrier(0)
    Unit cur, nxt; int ui = 0;
    if (!S.next(0, cur)) return;
    f32x4 acc[2][2][4][2];
#pragma unroll
    for (int a = 0; a < 2; ++a)
#pragma unroll
        for (int b = 0; b < 2; ++b)
#pragma unroll
            for (int m = 0; m < 4; ++m)
#pragma unroll
                for (int n = 0; n < 2; ++n) acc[a][b][m][n] = (f32x4){0.f, 0.f, 0.f, 0.f};
    bf16x8 At[4][2], B0[2][2], B1[2][2];
    unsigned cOff[2][2], nOff[2][2];
#pragma unroll
    for (int hh = 0; hh < 2; ++hh)
#pragma unroll
        for (int i = 0; i < 2; ++i) {
            if constexpr (GATHER) { const int ridx = hh * HALF + Rs[i]; int tk = cur.rows[ridx]; tk = ridx < cur.aux ? tk : 0; cOff[hh][i] = (unsigned)(tk * lda + Cs[i]) * 2u; }
            else cOff[hh][i] = (unsigned)((hh * HALF + Rs[i]) * lda + Cs[i]) * 2u;
            if constexpr (GATHER) nOff[hh][i] = cOff[hh][i]; else nOff[hh][i] = 0u;
        }
    const char* cA = cur.a; const char* cB = cur.b;
    S.a_ready(cur);
    if constexpr (SP2) {
        PG8_STAGE(PG8_SB(0, 0), cB, voffB); PG8_STAGE(PG8_SB(0, 1), cB + hstepB, voffB); PG8_STAGE(PG8_SA(0, 0), cA, cOff[0]); PG8_STAGE(PG8_SA(0, 1), cA, cOff[1]);
        if (wr == 1) PG8_BAR;
        PG8_WAIT_V(2); PG8_BAR;
        PG8_STAGE(PG8_SB(1, 0), cB + kstep, voffB); PG8_STAGE(PG8_SA(1, 0), cA + kstep, cOff[0]); PG8_STAGE(PG8_SB(1, 1), cB + hstepB + kstep, voffB);
        PG8_WAIT_V(6); PG8_BAR;
    } else {
        PG8_STAGE(PG8_SB(0, 0), cB, voffB); PG8_STAGE(PG8_SA(0, 0), cA, cOff[0]); PG8_STAGE(PG8_SB(0, 1), cB + hstepB, voffB); PG8_STAGE(PG8_SA(0, 1), cA, cOff[1]);
        if (wr == 1) PG8_BAR;
        PG8_WAIT_V(4); PG8_BAR;
        PG8_STAGE(PG8_SB(1, 0), cB + kstep, voffB); PG8_STAGE(PG8_SA(1, 0), cA + kstep, cOff[0]); PG8_STAGE(PG8_SB(1, 1), cB + hstepB + kstep, voffB);
        PG8_WAIT_V(6); PG8_BAR;
    }
    for (;;) {
        const bool has_next = S.next(ui + 1, nxt);
        const char* nA = has_next ? nxt.a : cA; const char* nB = has_next ? nxt.b : cB;
        if constexpr (GATHER) {
            if (has_next) {
#pragma unroll
                for (int hh = 0; hh < 2; ++hh)
#pragma unroll
                    for (int i = 0; i < 2; ++i) { const int ridx = hh * HALF + Rs[i]; int tk = nxt.rows[ridx]; tk = ridx < nxt.aux ? tk : 0; nOff[hh][i] = (unsigned)(tk * lda + Cs[i]) * 2u; }
            } else {
#pragma unroll
                for (int hh = 0; hh < 2; ++hh)
#pragma unroll
                    for (int i = 0; i < 2; ++i) nOff[hh][i] = cOff[hh][i];
            }
        }
#pragma unroll 1
        for (int t = 0; t < nt; t += 2) {
            const bool last = (t == nt - 2);
            const char* a1 = cA + (size_t)(t + 1) * kstep;
            const char* a2 = last ? nA : cA + (size_t)(t + 2) * kstep; const char* b2 = last ? nB : cB + (size_t)(t + 2) * kstep;
            const char* a3 = a2 + kstep; const char* b3 = b2 + kstep;
            unsigned o2[2][2];
#pragma unroll
            for (int hh = 0; hh < 2; ++hh)
#pragma unroll
                for (int i = 0; i < 2; ++i) { if constexpr (GATHER) o2[hh][i] = last ? nOff[hh][i] : cOff[hh][i]; else o2[hh][i] = cOff[hh][i]; }
            if (last && has_next) S.a_ready(nxt);
            if constexpr (SP2) {
            PG8_LDB(B0, 0, 0); PG8_LDB(B1, 0, 1); PG8_SCHED; PG8_LDA(At, 0, 0); PG8_STAGE(PG8_SA(1, 1), a1, cOff[1]);
            PG8_WAIT_V(8); PG8_WAIT_L(0); PG8_BAR; PG8_MMA(0, 0, At, B0); PG8_MMA(0, 1, At, B1); PG8_BAR; PG8_SCHED;
            PG8_LDA(At, 0, 1); PG8_STAGE(PG8_SB(0, 0), b2, voffB); PG8_STAGE(PG8_SB(0, 1), b2 + hstepB, voffB); PG8_STAGE(PG8_SA(0, 0), a2, o2[0]);
            PG8_WAIT_V(8); PG8_WAIT_L(0); PG8_BAR; PG8_MMA(1, 0, At, B0); PG8_MMA(1, 1, At, B1); PG8_BAR; PG8_SCHED;
            PG8_LDB(B0, 1, 0); PG8_LDB(B1, 1, 1); PG8_SCHED; PG8_LDA(At, 1, 0); PG8_STAGE(PG8_SA(0, 1), a2, o2[1]);
            PG8_WAIT_V(8); PG8_WAIT_L(0); PG8_BAR; PG8_MMA(0, 0, At, B0); PG8_MMA(0, 1, At, B1); PG8_BAR; PG8_SCHED;
            PG8_LDA(At, 1, 1); PG8_STAGE(PG8_SB(1, 0), b3, voffB); PG8_STAGE(PG8_SB(1, 1), b3 + hstepB, voffB); PG8_STAGE(PG8_SA(1, 0), a3, o2[0]);
            PG8_WAIT_V(8); PG8_WAIT_L(0); PG8_BAR; PG8_MMA(1, 0, At, B0); PG8_MMA(1, 1, At, B1); PG8_BAR; PG8_SCHED;
            } else {
            PG8_LDB(B0, 0, 0); PG8_SCHED; PG8_LDA(At, 0, 0); PG8_STAGE(PG8_SA(1, 1), a1, cOff[1]);
            PG8_WAIT_L(8); PG8_BAR; PG8_WAIT_L(0); PG8_MMA(0, 0, At, B0); PG8_BAR; PG8_SCHED;
            PG8_LDB(B1, 0, 1); PG8_STAGE(PG8_SB(0, 0), b2, voffB);
            PG8_BAR; PG8_WAIT_L(0); PG8_MMA(0, 1, At, B1); PG8_BAR;
            PG8_LDA(At, 0, 1); PG8_STAGE(PG8_SA(0, 0), a2, o2[0]);
            PG8_BAR; PG8_WAIT_L(0); PG8_MMA(1, 0, At, B0); PG8_BAR; PG8_SCHED;
            PG8_STAGE(PG8_SB(0, 1), b2 + hstepB, voffB);
            PG8_WAIT_V(6); PG8_BAR; PG8_MMA(1, 1, At, B1); PG8_BAR;
            PG8_LDB(B0, 1, 0); PG8_SCHED; PG8_LDA(At, 1, 0); PG8_STAGE(PG8_SA(0, 1), a2, o2[1]);
            PG8_WAIT_L(8); PG8_BAR; PG8_WAIT_L(0); PG8_MMA(0, 0, At, B0); PG8_BAR; PG8_SCHED;
            PG8_LDB(B1, 1, 1); PG8_STAGE(PG8_SB(1, 0), b3, voffB);
            PG8_BAR; PG8_WAIT_L(0); PG8_MMA(0, 1, At, B1); PG8_BAR;
            PG8_LDA(At, 1, 1); PG8_STAGE(PG8_SA(1, 0), a3, o2[0]);
            PG8_BAR; PG8_WAIT_L(0); PG8_MMA(1, 0, At, B0); PG8_BAR; PG8_SCHED;
            PG8_STAGE(PG8_SB(1, 1), b3 + hstepB, voffB);
            PG8_WAIT_V(6); PG8_BAR; PG8_MMA(1, 1, At, B1); PG8_BAR;
            }
        }
        if constexpr (ALIGN_EPI) { if (wr == 0) PG8_BAR; }
        E(acc, cur, wr, wc, fr, fq); S.done(cur);
        if (!has_next) break;
#pragma unroll
        for (int a = 0; a < 2; ++a)
#pragma unroll
            for (int b = 0; b < 2; ++b)
#pragma unroll
                for (int m = 0; m < 4; ++m)
#pragma unroll
                    for (int n = 0; n < 2; ++n) acc[a][b][m][n] = (f32x4){0.f, 0.f, 0.f, 0.f};
        cur = nxt; cA = nA; cB = nB; ++ui;
        if constexpr (GATHER) {
#pragma unroll
            for (int hh = 0; hh < 2; ++hh)
#pragma unroll
                for (int i = 0; i < 2; ++i) cOff[hh][i] = nOff[hh][i];
        }
        if constexpr (ALIGN_EPI) { if (wr == 1) PG8_BAR; }
    }
    PG8_WAIT_V(0);
    if constexpr (!ALIGN_EPI) { if (wr == 0) PG8_BAR; }
    PG8_BAR;
#undef PG8_SA
#undef PG8_SB
#undef PG8_STAGE
#undef PG8_LDA
#undef PG8_LDB
#undef PG8_MMA
#undef PG8_WAIT_V
#undef PG8_WAIT_L
#undef PG8_BAR
#undef PG8_SCHED
}
}

constexpr int NWAVES = 8;
constexpr int BATCH = 2, SEQ = 16384, D = 1024, NTOK = BATCH * SEQ;
constexpr int NLAYER = 2;
constexpr int NPROJ = 2816, IN_COLS = 2832;
constexpr int PJ = 2048;
constexpr int C_PIN = 0, C_CB = 256, C_CC = 512, C_CX = 768, C_DQ = 1024, C_DK = 1280, C_DV = 1536, C_DZ = 1792;
constexpr int DFF = 2816, NEXP = 8;
constexpr int NCHUNK = SEQ / 64;
constexpr int NINST = BATCH * 4 * 2 * NCHUNK;
constexpr float EPS = 1e-6f;
constexpr float QSCALE = 0.17677669529663687f * 1.4426950408889634f;
constexpr int MOE_PASS_TILES = 132;

constexpr size_t MiB = 1u << 20;
constexpr size_t WS_CTL = 0, CTL_ZERO_BYTES = 1 * MiB;
constexpr size_t SZ_WIN = (size_t)NPROJ * D * 2, SZ_WM = (size_t)4096 * D * 2, SZ_WB = (size_t)4 * 1024 * 256 * 2, SZ_WO = (size_t)D * D * 2;
constexpr size_t SZ_LAYERW = SZ_WIN + SZ_WM + SZ_WB + SZ_WO;
constexpr size_t SZ_WGU = (size_t)2 * DFF * D * 2, SZ_WD = (size_t)D * DFF * 2, SZ_FFNW = SZ_WGU + SZ_WD;
constexpr size_t WS_W = 1 * MiB;
constexpr size_t WS_WFFN = WS_W + 2 * SZ_LAYERW;
static_assert(WS_WFFN + SZ_FFNW <= 53 * MiB, "weights");
constexpr size_t WS_H = 53 * MiB;
constexpr size_t WS_O4 = 117 * MiB;
constexpr size_t WS_F = WS_O4;
constexpr size_t WS_BD = 181 * MiB;
constexpr size_t WS_DEC = 183 * MiB;
constexpr size_t WS_PROJ = 185 * MiB;
constexpr size_t WS_QB = 521 * MiB;
constexpr size_t WS_KV = 313 * MiB;
constexpr size_t WS_UW = 361 * MiB;
constexpr size_t WS_AB = 425 * MiB;
constexpr size_t WS_ST = 489 * MiB;
constexpr size_t WS_PBUF = 185 * MiB;
constexpr size_t WS_MERGED = 441 * MiB;
constexpr size_t WS_ACT0 = 185 * MiB;
constexpr size_t WS_H2B = 479 * MiB;
constexpr size_t WS_MOEW = 185 * MiB;
constexpr size_t WS_ACT1 = 1 * MiB;
constexpr size_t WS_Y = 317 * MiB;
constexpr size_t WS_ROUTE = 449 * MiB;
constexpr size_t WS_END = 543 * MiB;
static_assert(WS_ACT1 + (size_t)MOE_PASS_TILES * 256 * DFF * 2 <= WS_MOEW, "act1");
static_assert(WS_MOEW + 8 * SZ_FFNW <= WS_Y && WS_Y + (size_t)264 * 256 * D * 2 <= WS_ROUTE && WS_ROUTE + 4 * MiB <= WS_H2B && WS_H2B + 64 * MiB <= WS_END, "moe map");
static_assert(WS_PROJ + (size_t)NTOK * PJ * 2 <= WS_KV && WS_KV + (size_t)8 * 256 * 19456 <= WS_UW && WS_QB + 16 * MiB <= WS_END && WS_ST + (size_t)NINST * 8192 <= WS_END, "mixer map");
constexpr int CW_TMO = 0, CW_CODE = 1;
constexpr int CW_BAR = 4096;
constexpr int CW_MOD = 16384;
constexpr int CW_MOECNT = 65536;
constexpr int CW_NMAX = 66560;
constexpr int CW_MODCNT = 66624;
constexpr int CW_ATTQ = 66688;
static_assert(CW_MOD + NLAYER * BATCH * 6 * D <= CW_MOECNT && (CW_ATTQ + 32 * 64) * 4 <= (int)CTL_ZERO_BYTES, "ctl");

constexpr int RING_OFF = 0, RING_BYTES = 131072;
constexpr int LDS_BYTES = 160 * 1024;
constexpr int MISC_OFF = LDS_BYTES - 256;

#define GAS __attribute__((address_space(1)))
#define LAS __attribute__((address_space(3)))
typedef unsigned short bf16;
typedef unsigned v4u __attribute__((ext_vector_type(4)));
typedef unsigned v2u __attribute__((ext_vector_type(2)));
typedef float f32x4 __attribute__((ext_vector_type(4)));
typedef float f32x16 __attribute__((ext_vector_type(16)));
typedef short bf16x8 __attribute__((ext_vector_type(8)));
typedef short bf16x4 __attribute__((ext_vector_type(4)));
typedef GAS unsigned gu32;
#define RLX_AGENT __ATOMIC_RELAXED, __HIP_MEMORY_SCOPE_AGENT
#define LDS_WAIT() asm volatile("s_waitcnt lgkmcnt(0)" ::: "memory")
#define VM_WAIT() asm volatile("s_waitcnt vmcnt(0)" ::: "memory")
__device__ __forceinline__ unsigned f2bf(float f) { unsigned u = __builtin_bit_cast(unsigned, f); return (u + 0x7fffu + ((u >> 16) & 1u)) >> 16; }
__device__ __forceinline__ unsigned pk2(float lo, float hi) { return f2bf(lo) | (f2bf(hi) << 16); }
__device__ __forceinline__ float bf2f(unsigned b) { return __builtin_bit_cast(float, b << 16); }
__device__ __forceinline__ float bflo(unsigned w) { return __builtin_bit_cast(float, w << 16); }
__device__ __forceinline__ float bfhi(unsigned w) { return __builtin_bit_cast(float, w & 0xffff0000u); }
__device__ __forceinline__ float fast_exp2(float x) { return __builtin_amdgcn_exp2f(x); }
__device__ __forceinline__ float fast_exp(float x) { return __builtin_amdgcn_exp2f(x * 1.4426950408889634f); }
__device__ __forceinline__ float fast_rcp(float x) { return __builtin_amdgcn_rcpf(x); }
__device__ __forceinline__ float sigmoidf_(float x) { return fast_rcp(1.f + fast_exp(-x)); }
__device__ __forceinline__ float siluf_(float x) { return x * sigmoidf_(x); }
__device__ __forceinline__ float wave_sum(float v) {
    v += __builtin_bit_cast(float, __builtin_amdgcn_update_dpp(0, __builtin_bit_cast(int, v), 0xB1, 0xf, 0xf, true));
    v += __builtin_bit_cast(float, __builtin_amdgcn_update_dpp(0, __builtin_bit_cast(int, v), 0x4E, 0xf, 0xf, true));
    v += __builtin_bit_cast(float, __builtin_amdgcn_update_dpp(0, __builtin_bit_cast(int, v), 0x141, 0xf, 0xf, true));
    v += __builtin_bit_cast(float, __builtin_amdgcn_update_dpp(0, __builtin_bit_cast(int, v), 0x140, 0xf, 0xf, true));
    v += __builtin_bit_cast(float, __builtin_amdgcn_ds_swizzle(__builtin_bit_cast(int, v), 0x401f));
    v += __shfl_xor(v, 32);
    return v;
}

#define XB_TMO      128
#define XB_XCNT(j)  (256  + 64 * (j))
#define XB_XSUB(j)  (1280 + 64 * (j))
#define XB_XGEN(j)  (2304 + 64 * (j))
#define XB_TOP      3328
#define XB_TOPGEN   3392
#define XCD_BAR_WORDS 3456
#define XB_SPIN_CAP (1u << 22)
__device__ __forceinline__ unsigned xb_ld(unsigned* p)              { return __hip_atomic_load(p, __ATOMIC_RELAXED, __HIP_MEMORY_SCOPE_AGENT); }
__device__ __forceinline__ unsigned xb_add(unsigned* p, unsigned v) { return __hip_atomic_fetch_add(p, v, __ATOMIC_RELAXED, __HIP_MEMORY_SCOPE_AGENT); }
__device__ __forceinline__ unsigned xb_xcc_id() { return (unsigned)__builtin_amdgcn_s_getreg((3 << 11) | 20) & 0xFu; }
#define XB_SPIN(cond, bar) do { unsigned _sp = 0; while (cond) { __builtin_amdgcn_s_sleep(1); \
    if ((++_sp & 255u) == 0u) { if (xb_ld(&(bar)[XB_TMO])) break; if (_sp > XB_SPIN_CAP) { atomicAdd(&(bar)[XB_TMO], 1u); break; } } } } while (0)
struct XcdBarrier { unsigned* bar; unsigned x; volatile LAS unsigned* st; };
__device__ __forceinline__ XcdBarrier xcd_barrier_post(unsigned* bar, volatile LAS unsigned* st) {
    XcdBarrier b; b.bar = bar; b.x = xb_xcc_id(); b.st = st;
    if (threadIdx.x == 0) (void)xb_add(&bar[XB_XCNT(b.x)], 1u);
    return b;
}
__device__ __forceinline__ void xcd_barrier_complete(unsigned* bar, unsigned x, unsigned& nloc, unsigned& nx) {
    const unsigned G = gridDim.x * gridDim.y * gridDim.z;
    unsigned sum, cnt, mine, sp = 0u;
    for (;;) {
        sum = 0u; cnt = 0u; mine = 0u;
#pragma unroll
        for (unsigned j = 0; j < 16; ++j) { const unsigned c = xb_ld(&bar[XB_XCNT(j)]); sum += c; cnt += (c > 0u) ? 1u : 0u; }
        mine = xb_ld(&bar[XB_XCNT(x)]);
        if (sum == G) break;
        __builtin_amdgcn_s_sleep(1);
        if ((++sp & 255u) == 0u) { if (xb_ld(&bar[XB_TMO])) break; if (sp > XB_SPIN_CAP) { atomicAdd(&bar[XB_TMO], 1u); break; } }
    }
    nloc = mine > 0u ? mine : 1u; nx = cnt > 0u ? cnt : 1u;
}
__device__ __forceinline__ void xcd_barrier(const XcdBarrier& b) {
    asm volatile("s_waitcnt vmcnt(0)" ::: "memory");
    __syncthreads();
    if (threadIdx.x == 0) {
        unsigned* bar = b.bar;
        __builtin_amdgcn_s_waitcnt(0);
        unsigned nloc = b.st[0], nx = b.st[1];
        if (nloc == 0u) { xcd_barrier_complete(bar, b.x, nloc, nx); b.st[0] = nloc; b.st[1] = nx; }
        const unsigned old = xb_add(&bar[XB_XSUB(b.x)], 1u);
        const unsigned gen = old / nloc;
        if (old + 1u == (gen + 1u) * nloc) {
            __builtin_amdgcn_fence(__ATOMIC_RELEASE, "agent");
            asm volatile("s_waitcnt vmcnt(0)" ::: "memory");
            const unsigned og = xb_add(&bar[XB_TOP], 1u);
            const unsigned tg = og / nx;
            if (og + 1u == (tg + 1u) * nx) xb_add(&bar[XB_TOPGEN], 1u);
            else XB_SPIN(xb_ld(&bar[XB_TOPGEN]) == tg, bar);
            __builtin_amdgcn_fence(__ATOMIC_ACQUIRE, "agent");
            xb_add(&bar[XB_XGEN(b.x)], 1u);
            asm volatile("s_waitcnt vmcnt(0)" ::: "memory");
        } else {
            XB_SPIN(xb_ld(&bar[XB_XGEN(b.x)]) == gen, bar);
            __builtin_amdgcn_fence(__ATOMIC_ACQUIRE, "agent");
            asm volatile("s_waitcnt vmcnt(0)" ::: "memory");
        }
    }
    __syncthreads();
}

struct Frame {
    LAS unsigned char* lds;
    volatile LAS unsigned* MISC;
    gu32* ctl;
    int tid, lane, wave;
    int vcu, G;
    unsigned char* ws;
    float* out;
    const float* const* in;
};
enum { I_X = 0, I_C, I_ADAW, I_ADAB, I_NMIXPRE, I_NMIXPOST, I_NFFNPRE, I_NFFNPOST, I_WIN, I_DLAMBDA, I_DSUBLN, I_POOLW, I_POOLSCALE, I_SCONVW, I_DCONVW, I_DALOG, I_DDTBIAS, I_DNORM,
       I_WBRANCH, I_WMERGE, I_BMERGE, I_WO, I_FFNG, I_FFNU, I_FFND, I_ROUTERW, I_ROUTERB, I_MOEG, I_MOEU, I_MOED, N_INPUTS };

__device__ __forceinline__ void cvt_item(const float* W, int ldw, int k0, int n0, bf16* WT, int Kd, int drow0, LAS float* scr, int lane) {
#pragma unroll 8
    for (int i = 0; i < 32; ++i) { const int kk = 2 * i + (lane >> 5); scr[kk * 33 + (lane & 31)] = W[(size_t)(k0 + kk) * ldw + n0 + (lane & 31)]; }
    LDS_WAIT(); asm volatile("" ::: "memory");
    const int c = lane & 7;
#pragma unroll
    for (int j = 0; j < 4; ++j) { const int n = (lane >> 3) + 8 * j; const LAS float* s = scr + (8 * c) * 33 + n;
        v4u o; o.x = pk2(s[0 * 33], s[1 * 33]); o.y = pk2(s[2 * 33], s[3 * 33]); o.z = pk2(s[4 * 33], s[5 * 33]); o.w = pk2(s[6 * 33], s[7 * 33]);
        *(GAS v4u*)(WT + (size_t)(drow0 + n) * Kd + k0 + 8 * c) = o; }
    LDS_WAIT(); asm volatile("" ::: "memory");
}
__device__ __forceinline__ void cvt_ffn_item(const float* wg, const float* wu, const float* wd, bf16* Wgu, bf16* Wd, int r, LAS float* scr, int lane) {
    constexpr int IG = (D / 64) * (DFF / 32);
    if (r < IG) { const int kb = r / (DFF / 32), nb = r % (DFF / 32), n0 = nb * 32; cvt_item(wg, DFF, kb * 64, n0, Wgu, D, 256 * (n0 >> 7) + (n0 & 127), scr, lane); return; } r -= IG;
    if (r < IG) { const int kb = r / (DFF / 32), nb = r % (DFF / 32), n0 = nb * 32; cvt_item(wu, DFF, kb * 64, n0, Wgu, D, 256 * (n0 >> 7) + (n0 & 127) + 128, scr, lane); return; } r -= IG;
    { const int kb = r / (D / 32), nb = r % (D / 32); cvt_item(wd, D, kb * 64, nb * 32, Wd, DFF, nb * 32, scr, lane); }
}
constexpr int FFN_ITEMS = 3 * (D / 64) * (DFF / 32);
__device__ __forceinline__ bf16* w_in_t(unsigned char* ws, int l) { return (bf16*)(ws + WS_W + (size_t)l * SZ_LAYERW); }
__device__ __forceinline__ bf16* w_m_t(unsigned char* ws, int l) { return (bf16*)(ws + WS_W + (size_t)l * SZ_LAYERW + SZ_WIN); }
__device__ __forceinline__ bf16* w_b_t(unsigned char* ws, int l) { return (bf16*)(ws + WS_W + (size_t)l * SZ_LAYERW + SZ_WIN + SZ_WM); }
__device__ __forceinline__ bf16* w_o_t(unsigned char* ws, int l) { return (bf16*)(ws + WS_W + (size_t)l * SZ_LAYERW + SZ_WIN + SZ_WM + SZ_WB); }

__device__ __forceinline__ void p_prologue(Frame& F) {
    LAS float* scr = (LAS float*)(F.lds + RING_OFF + F.wave * 16384);
    const int gw = F.vcu * NWAVES + F.wave, NGW = F.G * NWAVES;
    constexpr int I_IN = (D / 64) * (NPROJ / 32), I_M = (D / 64) * (D / 32), I_B = (256 / 64) * (D / 32);
    constexpr int PER_LAYER = I_IN + 4 * I_M + 4 * I_B + I_M;
    constexpr int NITEMS = NLAYER * PER_LAYER + FFN_ITEMS;
    for (int it = gw; it < NITEMS; it += NGW) {
        int r = it;
        if (r >= NLAYER * PER_LAYER) { r -= NLAYER * PER_LAYER;
            cvt_ffn_item(F.in[I_FFNG], F.in[I_FFNU], F.in[I_FFND], (bf16*)(F.ws + WS_WFFN), (bf16*)(F.ws + WS_WFFN + SZ_WGU), r, scr, F.lane); continue; }
        const int l = r / PER_LAYER; r -= l * PER_LAYER;
        if (r < I_IN) { const int kb = r / (NPROJ / 32), nb = r % (NPROJ / 32); cvt_item(F.in[I_WIN] + (size_t)l * D * IN_COLS, IN_COLS, kb * 64, nb * 32, w_in_t(F.ws, l), D, nb * 32, scr, F.lane); continue; } r -= I_IN;
        if (r < 4 * I_M) { const int i = r / I_M; r -= i * I_M; const int kb = r / (D / 32), nb = r % (D / 32);
            cvt_item(F.in[I_WMERGE] + ((size_t)l * 4 + i) * D * D, D, kb * 64, nb * 32, w_m_t(F.ws, l), D, i * 1024 + nb * 32, scr, F.lane); continue; } r -= 4 * I_M;
        if (r < 4 * I_B) { const int i = r / I_B; r -= i * I_B; const int kb = r / (D / 32), nb = r % (D / 32);
            cvt_item(F.in[I_WBRANCH] + ((size_t)l * 4 + i) * 256 * D, D, kb * 64, nb * 32, w_b_t(F.ws, l) + (size_t)i * 1024 * 256, 256, nb * 32, scr, F.lane); continue; } r -= 4 * I_B;
        { const int kb = r / (D / 32), nb = r % (D / 32); cvt_item(F.in[I_WO] + (size_t)l * D * D, D, kb * 64, nb * 32, w_o_t(F.ws, l), D, nb * 32, scr, F.lane); }
    }
    constexpr int MOD_ITEMS = NLAYER * 24 * 16;
    for (int it = gw; it < MOD_ITEMS; it += NGW) {
        const int grp = it >> 4, kc = it & 15, l = grp / 24, nb = grp % 24;
        const float* Wp = F.in[I_ADAW] + ((size_t)l * D + kc * 64) * (6 * D) + nb * 256 + F.lane * 4;
        f32x4 a0 = {0.f, 0.f, 0.f, 0.f}, a1 = {0.f, 0.f, 0.f, 0.f};
#pragma unroll 8
        for (int k = 0; k < 64; ++k) { const f32x4 w = *(const GAS f32x4*)(Wp + (size_t)k * (6 * D));
            const float c0 = siluf_(F.in[I_C][kc * 64 + k]), c1 = siluf_(F.in[I_C][D + kc * 64 + k]); a0 += w * c0; a1 += w * c1; }
        float* part = (float*)(F.ws + WS_BD) + ((size_t)grp * 16 + kc) * 512 + F.lane * 4;
        *(GAS f32x4*)part = a0; *(GAS f32x4*)(part + 256) = a1;
        __threadfence();
        unsigned old = 0;
        if (F.lane == 0) old = __hip_atomic_fetch_add(F.ctl + CW_MODCNT + grp, 1u, RLX_AGENT);
        old = __builtin_amdgcn_readfirstlane(old);
        if (old == 15u) {
            __threadfence();
            f32x4 s0 = {0.f, 0.f, 0.f, 0.f}, s1 = {0.f, 0.f, 0.f, 0.f};
            const float* pg = (const float*)(F.ws + WS_BD) + (size_t)grp * 16 * 512 + F.lane * 4;
#pragma unroll
            for (int q = 0; q < 16; ++q) { s0 += __builtin_nontemporal_load((const f32x4*)(pg + q * 512)); s1 += __builtin_nontemporal_load((const f32x4*)(pg + q * 512 + 256)); }
            float* m0 = (float*)(F.ctl + CW_MOD) + (size_t)(l * BATCH + 0) * 6 * D + nb * 256 + F.lane * 4;
            *(GAS f32x4*)m0 = s0; *(GAS f32x4*)(m0 + 6 * D) = s1;
        }
    }
}
__device__ __forceinline__ void p_moe_cvt(Frame& F) {
    LAS float* scr = (LAS float*)(F.lds + RING_OFF + F.wave * 16384);
    const int gw = F.vcu * NWAVES + F.wave, NGW = F.G * NWAVES;
    for (int it = gw; it < NEXP * FFN_ITEMS; it += NGW) {
        const int e = it / FFN_ITEMS, r = it % FFN_ITEMS;
        bf16* base = (bf16*)(F.ws + WS_MOEW + (size_t)e * SZ_FFNW);
        cvt_ffn_item(F.in[I_MOEG] + (size_t)e * D * DFF, F.in[I_MOEU] + (size_t)e * D * DFF, F.in[I_MOED] + (size_t)e * DFF * D, base, (bf16*)((unsigned char*)base + SZ_WGU), r, scr, F.lane);
    }
}

struct Row { f32x4 v[4]; };
__device__ __forceinline__ float modv(Frame& F, int l, int b, int idx) { return ((const float*)(F.ctl + CW_MOD))[(size_t)(l * BATCH + b) * 6 * D + idx] + F.in[I_ADAB][l * 6 * D + idx]; }
__device__ __forceinline__ f32x4 modv4(Frame& F, int l, int b, int idx) {
    const f32x4 a = *(const GAS f32x4*)((const float*)(F.ctl + CW_MOD) + (size_t)(l * BATCH + b) * 6 * D + idx), c = *(const GAS f32x4*)(F.in[I_ADAB] + l * 6 * D + idx); return a + c; }
__device__ __forceinline__ float row_rstd(const Row& r) {
    float s = 0.f;
#pragma unroll
    for (int j = 0; j < 4; ++j) s += (r.v[j].x * r.v[j].x + r.v[j].y * r.v[j].y) + (r.v[j].z * r.v[j].z + r.v[j].w * r.v[j].w);
    return 1.f / sqrtf(wave_sum(s) * (1.f / D) + EPS);
}
__device__ __forceinline__ void row_resid(Frame& F, Row& x, const Row& f, const float* gain, int l, int b, int gidx) {
    const float rs = row_rstd(f);
#pragma unroll
    for (int j = 0; j < 4; ++j) { const int c = 4 * F.lane + 256 * j; const f32x4 g = *(const GAS f32x4*)(gain + c), m = modv4(F, l, b, gidx + c); x.v[j] += m * (f.v[j] * rs * g); }
}
__device__ __forceinline__ void row_make_h(Frame& F, Row& h, const Row& x, const float* gain, int l, int b, int shidx, int scidx) {
    const float rs = row_rstd(x);
#pragma unroll
    for (int j = 0; j < 4; ++j) { const int c = 4 * F.lane + 256 * j; const f32x4 g = *(const GAS f32x4*)(gain + c), sc = modv4(F, l, b, scidx + c), sh = modv4(F, l, b, shidx + c);
        h.v[j] = (x.v[j] * rs * g) * (sc + 1.f) + sh; }
}
__device__ __forceinline__ void row_store_bf16(Frame& F, const Row& h, bf16* dst) {
    GAS unsigned long long* o8 = (GAS unsigned long long*)dst + F.lane;
#pragma unroll
    for (int j = 0; j < 4; ++j) o8[64 * j] = (unsigned long long)pk2(h.v[j].x, h.v[j].y) | ((unsigned long long)pk2(h.v[j].z, h.v[j].w) << 32);
}
__device__ __forceinline__ void row_load_f32(Frame& F, Row& r, const float* src) {
    const GAS f32x4* p = (const GAS f32x4*)src + F.lane;
#pragma unroll
    for (int j = 0; j < 4; ++j) r.v[j] = p[64 * j];
}
__device__ __forceinline__ void row_store_f32(Frame& F, const Row& r, float* dst) {
    GAS f32x4* p = (GAS f32x4*)dst + F.lane;
#pragma unroll
    for (int j = 0; j < 4; ++j) p[64 * j] = r.v[j];
}
__device__ __forceinline__ void row_load_bf16(Frame& F, Row& r, const bf16* src) {
    const GAS v2u* p = (const GAS v2u*)src + F.lane;
#pragma unroll
    for (int j = 0; j < 4; ++j) { const v2u w = p[64 * j]; r.v[j] = (f32x4){bflo(w.x), bfhi(w.x), bflo(w.y), bfhi(w.y)}; }
}
template <int NO> __device__ __forceinline__ void row_dots(Frame& F, const Row& h, const LAS float* WT, float (&out)[NO]) {
#pragma unroll
    for (int o = 0; o < NO; ++o) { float s = 0.f;
#pragma unroll
        for (int j = 0; j < 4; ++j) { const f32x4 w = *(const LAS f32x4*)(WT + o * 1024 + 4 * F.lane + 256 * j); s += (h.v[j].x * w.x + h.v[j].y * w.y) + (h.v[j].z * w.z + h.v[j].w * w.w); }
        out[o] = s; if ((o & 3) == 3) __builtin_amdgcn_sched_barrier(0); }
#pragma unroll
    for (int o = 0; o < NO; ++o) { out[o] = wave_sum(out[o]); if ((o & 3) == 3) __builtin_amdgcn_sched_barrier(0); }
}
template <int NO> __device__ __forceinline__ void load_wt(Frame& F, const float* W, int ldw, int col0, LAS float* WT) {
    for (int k = F.tid; k < 1024; k += NWAVES * 64) {
#pragma unroll
        for (int o = 0; o < NO; ++o) WT[o * 1024 + k] = W[(size_t)k * ldw + col0 + o];
    }
    __syncthreads();
}
__device__ __forceinline__ float softplusf_(float x) { return x > 20.f ? x : log1pf(__expf(x)); }
__device__ __forceinline__ void row_bd(Frame& F, const Row& h, const LAS float* W16T, int l, int row) {
    float o16[16]; row_dots<16>(F, h, W16T, o16);
    float mine = 0.f;
#pragma unroll
    for (int o = 0; o < 16; ++o) mine = (F.lane == o) ? o16[o] : mine;
    if (F.lane < 16) {
        float r;
        if (F.lane < 8) r = 1.f / (1.f + __expf(-mine));
        else { const int i = F.lane - 8; r = -__expf(F.in[I_DALOG][l * 8 + i]) * softplusf_(mine + F.in[I_DDTBIAS][l * 8 + i]); }
        ((float*)(F.ws + WS_BD))[(size_t)row * 16 + F.lane] = r;
    }
}
__device__ __forceinline__ void moe_tiles(Frame& F, int (&cnt)[NEXP], int (&tstart)[NEXP + 1]) {
    int acc = 0;
#pragma unroll
    for (int e = 0; e < NEXP; ++e) { cnt[e] = (int)__hip_atomic_load(F.ctl + CW_MOECNT + 64 * e, RLX_AGENT); tstart[e] = acc; acc += (cnt[e] + 255) >> 8; }
    tstart[NEXP] = acc;
}

constexpr int ROW_A = 0, ROW_B = 1, ROW_C = 2;
template <int MODE> __device__ __forceinline__ void p_rows(Frame& F, const int l) {
    const int gw = F.vcu * NWAVES + F.wave, NGW = F.G * NWAVES;
    LAS float* WT = (LAS float*)(F.lds + RING_OFF);
    LAS int* linfo = (LAS int*)(F.lds + RING_OFF + 65536);
    LAS int* lcnt = (LAS int*)(F.lds + RING_OFF + 65536 + 8 * 32 * 16);
    const bool do_h1 = (MODE == ROW_A) || (MODE == ROW_C && l + 1 < NLAYER);
    const int lh = (MODE == ROW_C) ? l + 1 : l;
    const bool router = (MODE == ROW_B) && (l == 1);
    if (do_h1) load_wt<16>(F, F.in[I_WIN] + (size_t)lh * D * IN_COLS, IN_COLS, NPROJ, WT);
    if (router) { if (F.tid < 16) lcnt[F.tid] = 0; load_wt<8>(F, F.in[I_ROUTERW], NEXP, 0, WT); }
    int cnt[NEXP], tstart[NEXP + 1];
    if (MODE == ROW_C && l == 1) moe_tiles(F, cnt, tstart);
    const float* xsrc = (MODE == ROW_A || (MODE == ROW_B && l == 0)) ? F.in[I_X] : F.out;
    int ri = 0;
    for (int m = gw; m < NTOK; m += NGW, ++ri) {
        const int b = m / SEQ;
        Row x; row_load_f32(F, x, xsrc + (size_t)m * D);
        if (MODE == ROW_B) {
            Row f; row_load_bf16(F, f, (const bf16*)(F.ws + WS_F) + (size_t)m * D);
            row_resid(F, x, f, F.in[I_NMIXPOST] + l * D, l, b, 2 * D);
            row_store_f32(F, x, F.out + (size_t)m * D);
            Row h; row_make_h(F, h, x, F.in[I_NFFNPRE] + l * D, l, b, 3 * D, 4 * D);
            row_store_bf16(F, h, (bf16*)(F.ws + (l == 0 ? WS_H : WS_H2B)) + (size_t)m * D);
            if (router) {
                float lg[NEXP]; row_dots<NEXP>(F, h, WT, lg);
                int e0 = 0; float l0 = lg[0] + F.in[I_ROUTERB][0];
#pragma unroll
                for (int e = 0; e < NEXP; ++e) lg[e] += F.in[I_ROUTERB][e];
#pragma unroll
                for (int e = 1; e < NEXP; ++e) if (lg[e] > l0) { l0 = lg[e]; e0 = e; }
                int e1 = -1; float l1 = -3.0e38f;
#pragma unroll
                for (int e = 0; e < NEXP; ++e) if (e != e0 && lg[e] > l1) { l1 = lg[e]; e1 = e; }
                const float q1 = __expf(l1 - l0), p0 = 1.f / (1.f + q1), p1 = q1 * p0;
                if (F.lane == 0) {
                    const int i0 = atomicAdd((int*)&lcnt[e0], 1), i1 = atomicAdd((int*)&lcnt[e1], 1);
                    LAS int* li = linfo + (F.wave * 32 + ri) * 4;
                    li[0] = e0 | (e1 << 8) | (i0 << 16); li[1] = i1; li[2] = __float_as_int(p0); li[3] = __float_as_int(p1);
                }
            }
        } else if (MODE == ROW_C) {
            Row f;
            if (l == 0) row_load_bf16(F, f, (const bf16*)(F.ws + WS_F) + (size_t)m * D);
            else {
                const int* ti = (const int*)(F.ws + WS_ROUTE) + (size_t)m * 8;
                const int e0 = ti[0], i0 = ti[1], e1 = ti[2], i1 = ti[3]; const float p0 = __int_as_float(ti[4]), p1 = __int_as_float(ti[5]);
                int s0 = 0, s1 = 0;
#pragma unroll
                for (int e = 0; e < NEXP; ++e) { s0 = (e == e0) ? tstart[e] * 256 + i0 : s0; s1 = (e == e1) ? tstart[e] * 256 + i1 : s1; }
                Row y0, y1; row_load_bf16(F, y0, (const bf16*)(F.ws + WS_Y) + (size_t)s0 * D); row_load_bf16(F, y1, (const bf16*)(F.ws + WS_Y) + (size_t)s1 * D);
#pragma unroll
                for (int j = 0; j < 4; ++j) f.v[j] = y0.v[j] * p0 + y1.v[j] * p1;
            }
            row_resid(F, x, f, F.in[I_NFFNPOST] + l * D, l, b, 5 * D);
            row_store_f32(F, x, F.out + (size_t)m * D);
        }
        if (do_h1) {
            Row h; row_make_h(F, h, x, F.in[I_NMIXPRE] + lh * D, lh, b, 0, 1 * D);
            row_store_bf16(F, h, (bf16*)(F.ws + WS_H) + (size_t)m * D);
            row_bd(F, h, WT, lh, m);
        }
    }
    if (router) {
        __syncthreads();
        if (F.tid < NEXP) lcnt[8 + F.tid] = (int)__hip_atomic_fetch_add(F.ctl + CW_MOECNT + 64 * F.tid, (unsigned)lcnt[F.tid], RLX_AGENT);
        __syncthreads();
        ri = 0;
        for (int m = gw; m < NTOK; m += NGW, ++ri) {
            if (F.lane == 0) {
                const LAS int* li = linfo + (F.wave * 32 + ri) * 4;
                const int w0 = li[0], e0 = w0 & 255, e1 = (w0 >> 8) & 255, i0 = (w0 >> 16) + lcnt[8 + e0], i1 = li[1] + lcnt[8 + e1];
                int* ti = (int*)(F.ws + WS_ROUTE) + (size_t)m * 8;
                ti[0] = e0; ti[1] = i0; ti[2] = e1; ti[3] = i1; ti[4] = li[2]; ti[5] = li[3];
                int* lists = (int*)(F.ws + WS_ROUTE + 1 * MiB);
                lists[(size_t)e0 * 65536 + i0] = m; lists[(size_t)e1 * 65536 + i1] = m;
            }
        }
    }
    __syncthreads();
}

namespace pg8 {
constexpr int NXCD = 8, WGM = 8;
struct SchedStd {
    int nM, nN, nwg, G, c; const char* A; size_t a_tile; const char* B; size_t b_tile;
    __device__ __forceinline__ void init(int nM_, int nN_, int G_, int c_, const void* A_, size_t a_tile_, const void* B_, size_t b_tile_) { nM = nM_; nN = nN_; nwg = nM * nN; G = G_; c = c_; A = (const char*)A_; a_tile = a_tile_; B = (const char*)B_; b_tile = b_tile_; }
    __device__ __forceinline__ bool next(int i, Unit& u) const {
        const long L = (long)i * G + c; if (L >= nwg) return false;
        int wgid = (int)L; { const int q = nwg / NXCD, r = nwg % NXCD, xcd = wgid % NXCD, off = wgid / NXCD; wgid = (xcd < r ? xcd * (q + 1) : r * (q + 1) + (xcd - r) * q) + off; }
        const int nig = WGM * nN, gid = wgid / nig, fm = gid * WGM, gsz = (nM - fm) < WGM ? (nM - fm) : WGM;
        u.pm = fm + ((wgid % nig) % gsz); u.pn = (wgid % nig) / gsz; u.aux = 0; u.pad = 0; u.a = A + (size_t)u.pm * a_tile; u.b = B + (size_t)u.pn * b_tile; u.rows = nullptr; return true;
    }
    __device__ __forceinline__ void a_ready(const Unit&) const {}
    __device__ __forceinline__ void done(const Unit&) const {}
};
struct SchedBranch {
    SchedStd s; const char* O4; const char* Wb;
    __device__ __forceinline__ bool next(int i, Unit& u) const {
        if (!s.next(i, u)) return false;
        const int br = u.pn >> 2; u.pn &= 3; u.aux = br;
        u.a = O4 + (size_t)u.pm * 256 * 1024 * 2 + (size_t)br * 256 * 2; u.b = Wb + (size_t)br * 1024 * 256 * 2 + (size_t)u.pn * 256 * 256 * 2; return true;
    }
    __device__ __forceinline__ void a_ready(const Unit&) const {}
    __device__ __forceinline__ void done(const Unit&) const {}
};
struct SchedGate {
    int vcu, G; const char* H; const char* Wm;
    __device__ __forceinline__ bool next(int i, Unit& u) const {
        const int tg = vcu + G * (i >> 2); if (tg >= 512) return false;
        u.pm = tg >> 2; u.pn = tg & 3; u.aux = i & 3; u.pad = 0; u.rows = nullptr;
        u.a = H + (size_t)u.pm * 256 * 1024 * 2; u.b = Wm + ((size_t)u.aux * 1024 + (size_t)u.pn * 256) * 1024 * 2; return true;
    }
    __device__ __forceinline__ void a_ready(const Unit&) const {}
    __device__ __forceinline__ void done(const Unit&) const {}
};
struct SchedMoe {
    int c, G, t0, t1, nN; int tstart[9]; int cnt[8];
    const char* A; const int* lists; const char* W; size_t w_tile; bool gather;
    __device__ __forceinline__ bool next(int i, Unit& u) const {
        const long L = (long)i * G + c; const int t = t0 + (int)(L / nN); if (t >= t1) return false;
        int e = 0;
#pragma unroll
        for (int k = 1; k < 8; ++k) e = (t >= tstart[k]) ? k : e;
        int ce = 0;
#pragma unroll
        for (int k = 0; k < 8; ++k) ce = (k == e) ? cnt[k] : ce;
        const int j = t - ((e == 0) ? 0 : 0), jj = t;
        (void)j; (void)jj;
        int ts = 0;
#pragma unroll
        for (int k = 0; k < 8; ++k) ts = (k == e) ? tstart[k] : ts;
        const int tj = t - ts;
        u.pn = (int)(L % nN); u.pad = 0;
        if (gather) { u.pm = t - t0; u.a = A; u.rows = lists + (size_t)e * 65536 + tj * 256; const int nv = ce - tj * 256; u.aux = nv > 256 ? 256 : nv; }
        else { u.pm = t; u.a = A + (size_t)(t - t0) * 256 * DFF_ * 2; u.rows = nullptr; u.aux = 0; }
        u.b = W + (size_t)e * SZ_EXP_ + (size_t)u.pn * w_tile; return true;
    }
    static constexpr size_t DFF_ = 2816; static constexpr size_t SZ_EXP_ = (size_t)2 * 2816 * 1024 * 2 + (size_t)1024 * 2816 * 2;
    __device__ __forceinline__ void a_ready(const Unit&) const {}
    __device__ __forceinline__ void done(const Unit&) const {}
};

struct EpiStore {
    static constexpr bool PERM = true;
    bf16_t* O; int ldc; size_t aux_stride; float scale0;
    __device__ __forceinline__ void operator()(const f32x4 (&acc)[2][2][4][2], const Unit& u, int wr, int wc, int fr, int fq) const {
        const int row0 = u.pm * BM + wr * 64 + fr, col0 = u.pn * BM + wc * 32 + 8 * fq; bf16_t* base = O + (size_t)u.aux * aux_stride;
        const float sc = (u.pn == 0) ? scale0 : 1.f;
#pragma unroll
        for (int ai = 0; ai < 2; ++ai)
#pragma unroll
            for (int m = 0; m < 4; ++m) { bf16_t* rowp = base + (size_t)(row0 + ai * HALF + m * 16) * ldc + col0;
#pragma unroll
                for (int bj = 0; bj < 2; ++bj) { const f32x4 v0 = acc[ai][bj][m][0] * sc, v1 = acc[ai][bj][m][1] * sc;
                    u32x4 w; w.x = cvt_pk_bf16(v0[0], v0[1]); w.y = cvt_pk_bf16(v0[2], v0[3]); w.z = cvt_pk_bf16(v1[0], v1[1]); w.w = cvt_pk_bf16(v1[2], v1[3]);
                    *(u32x4*)(rowp + bj * HALF) = w; } }
    }
};

struct EpiProj {
    static constexpr bool PERM = true;
    static constexpr int TILE_E = 9728;
    bf16_t* Qb; bf16_t* KV; bf16_t* Pj; unsigned* nmax; float qscale;
    __device__ __forceinline__ void operator()(const f32x4 (&acc)[2][2][4][2], const Unit& u, int wr, int wc, int fr, int fq) const {
        const int t0 = u.pm * BM + wr * 64 + fr;
        const int b = (u.pm * BM) >> 14;
        const int s00 = t0 & 16383;
        if (u.pn >= 3) {
            bf16_t* base = Pj + (size_t)t0 * 2048 + (u.pn - 3) * BM + wc * 32 + 8 * fq;
#pragma unroll
            for (int ai = 0; ai < 2; ++ai)
#pragma unroll
                for (int m = 0; m < 4; ++m) {
#pragma unroll
                    for (int bj = 0; bj < 2; ++bj) { const f32x4 v0 = acc[ai][bj][m][0], v1 = acc[ai][bj][m][1];
                        u32x4 w; w.x = cvt_pk_bf16(v0[0], v0[1]); w.y = cvt_pk_bf16(v0[2], v0[3]); w.z = cvt_pk_bf16(v1[0], v1[1]); w.w = cvt_pk_bf16(v1[2], v1[3]);
                        *(u32x4*)(base + (ai * HALF + m * 16) * 2048 + bj * HALF) = w; }
                    __builtin_amdgcn_sched_barrier(0); }
        } else if (u.pn == 2) {
            bf16_t* hb = KV + ((size_t)((b * 4 + (wc >> 1)) * 256 + (s00 >> 6))) * TILE_E + 5120 + (32 * (wc & 1) + 8 * fq) * 72 + (s00 & 63);
#pragma unroll
            for (int ai = 0; ai < 2; ++ai)
#pragma unroll
                for (int bj = 0; bj < 2; ++bj) { bf16_t* tb = hb + (size_t)bj * (2 * 256 * TILE_E) + ai * (2 * TILE_E);
#pragma unroll
                    for (int m = 0; m < 4; ++m)
#pragma unroll
                        for (int n = 0; n < 2; ++n)
#pragma unroll
                            for (int j = 0; j < 4; ++j) { const float v = acc[ai][bj][m][n][j];
                                unsigned bits = __builtin_bit_cast(unsigned, v); bits = (bits + 0x7fffu + ((bits >> 16) & 1u)) >> 16;
                                tb[(4 * n + j) * 72 + 16 * m] = (bf16_t)bits; }
                    __builtin_amdgcn_sched_barrier(0); }
        } else {
            const float sc = (u.pn == 0) ? qscale : 1.f; float nm = 0.f;
            bf16_t* qbase = Qb + ((size_t)(b * 4 + wc) * 16384 + s00) * 64 + 8 * fq;
            bf16_t* kbase = KV + ((size_t)((b * 4 + wc) * 256 + (s00 >> 6))) * TILE_E + (s00 & 63) * 40 + 8 * fq;
#pragma unroll
            for (int ai = 0; ai < 2; ++ai)
#pragma unroll
                for (int m = 0; m < 4; ++m) {
#pragma unroll
                    for (int bj = 0; bj < 2; ++bj) { const f32x4 v0 = acc[ai][bj][m][0] * sc, v1 = acc[ai][bj][m][1] * sc;
                        u32x4 w; w.x = cvt_pk_bf16(v0[0], v0[1]); w.y = cvt_pk_bf16(v0[2], v0[3]); w.z = cvt_pk_bf16(v1[0], v1[1]); w.w = cvt_pk_bf16(v1[2], v1[3]);
                        float ss = (v0[0] * v0[0] + v0[1] * v0[1]) + (v0[2] * v0[2] + v0[3] * v0[3]) + (v1[0] * v1[0] + v1[1] * v1[1]) + (v1[2] * v1[2] + v1[3] * v1[3]);
                        ss += __shfl_xor(ss, 16); ss += __shfl_xor(ss, 32); nm = fmaxf(nm, ss);
                        if (u.pn == 0) *(u32x4*)(qbase + (ai * HALF + m * 16) * 64 + 32 * bj) = w;
                        else *(u32x4*)(kbase + ai * (2 * TILE_E) + bj * 2560 + (16 * m) * 40) = w; }
                    __builtin_amdgcn_sched_barrier(0); }
            nm = fmaxf(nm, __shfl_xor(nm, 1)); nm = fmaxf(nm, __shfl_xor(nm, 2)); nm = fmaxf(nm, __shfl_xor(nm, 4)); nm = fmaxf(nm, __shfl_xor(nm, 8));
            if (fr == 0 && fq == 0) atomicMax(nmax + (b * 4 + wc) * 2 + u.pn, __builtin_bit_cast(unsigned, nm));
        }
    }
};
__device__ __forceinline__ float sigm(float x) { return __builtin_amdgcn_rcpf(1.f + __builtin_amdgcn_exp2f(-1.4426950408889634f * x)); }
struct EpiGate {
    static constexpr bool PERM = true;
    const bf16_t* P; bf16_t* Mg; const float* bias;
    __device__ __forceinline__ void operator()(const f32x4 (&acc)[2][2][4][2], const Unit& u, int wr, int wc, int fr, int fq) const {
        const int row0 = u.pm * BM + wr * 64 + fr, col0 = u.pn * BM + wc * 32 + 8 * fq; const int br = u.aux;
        const bf16_t* Pb = P + (size_t)br * 32768 * 1024; const float* bb = bias + br * 1024 + col0;
        f32x4 bv[2][2];
#pragma unroll
        for (int bj = 0; bj < 2; ++bj)
#pragma unroll
            for (int n = 0; n < 2; ++n) bv[bj][n] = *(const f32x4*)(bb + bj * HALF + 4 * n);
#pragma unroll
        for (int ai = 0; ai < 2; ++ai)
#pragma unroll
            for (int m = 0; m < 4; ++m) { const size_t ro = (size_t)(row0 + ai * HALF + m * 16) * 1024 + col0;
#pragma unroll
                for (int bj = 0; bj < 2; ++bj) {
                    const u32x4 pw = *(const u32x4*)(Pb + ro + bj * HALF);
                    u32x4 mw = {0u, 0u, 0u, 0u}; if (br != 0) mw = *(const u32x4*)(Mg + ro + bj * HALF);
                    float o[8];
#pragma unroll
                    for (int q = 0; q < 4; ++q) {
                        const float g0 = sigm(acc[ai][bj][m][q >> 1][(q & 1) * 2] + bv[bj][q >> 1][(q & 1) * 2]), g1 = sigm(acc[ai][bj][m][q >> 1][(q & 1) * 2 + 1] + bv[bj][q >> 1][(q & 1) * 2 + 1]);
                        o[2 * q] = g0 * __builtin_bit_cast(float, pw[q] << 16) + __builtin_bit_cast(float, mw[q] << 16);
                        o[2 * q + 1] = g1 * __builtin_bit_cast(float, pw[q] & 0xffff0000u) + __builtin_bit_cast(float, mw[q] & 0xffff0000u);
                    }
                    u32x4 w; w.x = cvt_pk_bf16(o[0], o[1]); w.y = cvt_pk_bf16(o[2], o[3]); w.z = cvt_pk_bf16(o[4], o[5]); w.w = cvt_pk_bf16(o[6], o[7]);
                    *(u32x4*)(Mg + ro + bj * HALF) = w; } }
    }
};
struct EpiSwiGLU {
    static constexpr bool PERM = true;
    bf16_t* O; int ldc;
    __device__ __forceinline__ void operator()(const f32x4 (&acc)[2][2][4][2], const Unit& u, int wr, int wc, int fr, int fq) const {
        const int row0 = u.pm * BM + wr * 64 + fr, col0 = u.pn * HALF + wc * 32 + 8 * fq;
#pragma unroll
        for (int ai = 0; ai < 2; ++ai)
#pragma unroll
            for (int m = 0; m < 4; ++m) { bf16_t* rowp = O + (size_t)(row0 + ai * HALF + m * 16) * ldc + col0;
                float o[8];
#pragma unroll
                for (int n = 0; n < 2; ++n)
#pragma unroll
                    for (int q = 0; q < 4; ++q) { const float g = acc[ai][0][m][n][q], up = acc[ai][1][m][n][q]; o[4 * n + q] = g * sigm(g) * up; }
                u32x4 w; w.x = cvt_pk_bf16(o[0], o[1]); w.y = cvt_pk_bf16(o[2], o[3]); w.z = cvt_pk_bf16(o[4], o[5]); w.w = cvt_pk_bf16(o[6], o[7]);
                *(u32x4*)rowp = w; }
    }
};
}

namespace att {
constexpr int SLOT = 19456, NSLOT = 6;
constexpr int ATTN_LDS = NSLOT * SLOT;
__device__ __forceinline__ unsigned cvtpk(float lo, float hi) { typedef float f2 __attribute__((ext_vector_type(2))); typedef __bf16 b2 __attribute__((ext_vector_type(2))); f2 v = {lo, hi}; b2 b = __builtin_convertvector(v, b2); return __builtin_bit_cast(unsigned, b); }
#define ATT_WAITV(n) asm volatile("s_waitcnt vmcnt(" #n ")" ::: "memory")
__device__ __forceinline__ float max3f(float a, float b, float c) { float r; asm("v_max3_f32 %0, %1, %2, %3" : "=v"(r) : "v"(a), "v"(b), "v"(c)); return r; }

#define ATT_SOFTMAX(s0, s1, pw, LS) do { \
    asm volatile("s_nop 15\n\ts_nop 7" : "+v"(s0), "+v"(s1)); \
    float rm = max3f(s0[0], s0[1], s1[0]), rm2 = max3f(s0[2], s0[3], s1[1]); rm = max3f(rm, s1[2], s1[3]); \
    _Pragma("unroll") for (int r = 4; r < 16; r += 4) { rm = max3f(rm, s0[r], s0[r + 1]); rm2 = max3f(rm2, s0[r + 2], s0[r + 3]); rm = max3f(rm, s1[r], s1[r + 1]); rm2 = max3f(rm2, s1[r + 2], s1[r + 3]); } \
    rm = fmaxf(rm, rm2); \
    { auto rr = __builtin_amdgcn_permlane32_swap(__builtin_bit_cast(unsigned, rm), __builtin_bit_cast(unsigned, rm), false, false); rm = fmaxf(__builtin_bit_cast(float, rr[0]), __builtin_bit_cast(float, rr[1])); } \
    if (__any(rm > 8.f)) { \
        const float dd = fmaxf(rm, 0.f); R += dd; \
        const float f = fast_exp2(-dd); l1 *= f; l2 *= f; \
        _Pragma("unroll") for (int r = 0; r < 16; ++r) { s0[r] -= dd; s1[r] -= dd; c0[r] -= dd; c1[r] -= dd; O1[0][r] *= f; O1[1][r] *= f; O2[0][r] *= f; O2[1][r] *= f; } \
        p1scale = f; \
    } \
    { float sa_ = 0.f, sb_ = 0.f; _Pragma("unroll") for (int r = 0; r < 16; ++r) { s0[r] = fast_exp2(s0[r]); s1[r] = fast_exp2(s1[r]); sa_ += s0[r]; sb_ += s1[r]; } LS += sa_ + sb_; } \
    _Pragma("unroll") for (int e = 0; e < 4; ++e) { pw[0][e] = cvtpk(s0[2 * e], s0[2 * e + 1]); pw[1][e] = cvtpk(s0[8 + 2 * e], s0[8 + 2 * e + 1]); pw[2][e] = cvtpk(s1[2 * e], s1[2 * e + 1]); pw[3][e] = cvtpk(s1[8 + 2 * e], s1[8 + 2 * e + 1]); } \
} while (0)

__device__ __forceinline__ void attn_unit(Frame& F, const int layer, const int b, const int h, const int qb) {
    const int lane = F.lane, r32 = lane & 31, hi = lane >> 5, wid = F.wave;
    LAS unsigned char* L = F.lds + RING_OFF;
    const int qw0 = qb * 256 + wid * 32, q = qw0 + r32;
    const float slope2 = exp2f(-2.f * (float)(h + 1)) * 1.4426950408889634f;
    int tlo, thi;
    { const unsigned* nm = (const unsigned*)(F.ctl + CW_NMAX) + layer * 16 + (b * 4 + h) * 2;
      const float qn = sqrtf(__builtin_bit_cast(float, __hip_atomic_load(nm, RLX_AGENT))) * 1.01f, kn = sqrtf(__builtin_bit_cast(float, __hip_atomic_load(nm + 1, RLX_AGENT))) * 1.01f;
      const float wf = (160.f + 2.f * qn * kn) / slope2; const int W = wf > 100000.f ? 100000 : (int)wf + 1;
      const int lo = qb * 256 - W, hi_ = qb * 256 + 255 + W; tlo = lo < 0 ? 0 : (lo >> 6); thi = hi_ >= SEQ ? (SEQ / 64 - 1) : (hi_ >> 6);
      if (((thi - tlo + 1) & 1) != 0) { if (thi < SEQ / 64 - 1) ++thi; else --tlo; } }
    const int nP = (thi - tlo + 1) >> 1;
    const bf16* Qp = (const bf16*)(F.ws + WS_QB) + ((size_t)(b * 4 + h) * SEQ + q) * 64;
    bf16x8 q1f[2], q2f[2];
#pragma unroll
    for (int ks = 0; ks < 2; ++ks) { q1f[ks] = *(const GAS bf16x8*)(Qp + 16 * ks + 8 * hi); q2f[ks] = *(const GAS bf16x8*)(Qp + 32 + 16 * ks + 8 * hi); }
    const unsigned char* kvbase = F.ws + WS_KV + ((size_t)(b * 4 + h) * 256) * SLOT + (size_t)wid * 1024 + lane * 16;
    const bool w3 = wid < 3;
#define ATT_DMA1(t, slot) do { const unsigned char* g_ = kvbase + (size_t)(t) * SLOT; LAS unsigned char* d_ = L + (slot) * SLOT + wid * 1024; \
        __builtin_amdgcn_global_load_lds((const unsigned*)g_, (LAS unsigned*)d_, 16, 0, 0); __builtin_amdgcn_global_load_lds((const unsigned*)(g_ + 8192), (LAS unsigned*)(d_ + 8192), 16, 0, 0); \
        if (w3) __builtin_amdgcn_global_load_lds((const unsigned*)(g_ + 16384), (LAS unsigned*)(d_ + 16384), 16, 0, 0); } while (0)
#define ATT_DMA2(pr, ps) do { ATT_DMA1(tlo + 2 * (pr), 2 * (ps)); ATT_DMA1(tlo + 2 * (pr) + 1, 2 * (ps) + 1); } while (0)
    asm volatile("s_waitcnt vmcnt(0)" ::: "memory");
    ATT_DMA2(0, 0);
    if (nP > 1) ATT_DMA2(1, 1);
    float R = 0.f, l1 = 0.f, l2 = 0.f;
    f32x16 O1[2], O2[2];
#pragma unroll
    for (int i = 0; i < 16; ++i) { O1[0][i] = 0.f; O1[1][i] = 0.f; O2[0][i] = 0.f; O2[1][i] = 0.f; }
    const int pr32 = (r32 & 0x13) | ((r32 & 4) << 1) | ((r32 & 8) >> 1);
    const int kfo = pr32 * 80 + hi * 16;
    const int vfo = 10240 + r32 * 144 + hi * 16;
    int ps = 0;
    for (int ip = 0; ip < nP; ++ip) {
        if (ip + 1 < nP) { if (w3) ATT_WAITV(6); else ATT_WAITV(4); } else ATT_WAITV(0);
        __builtin_amdgcn_s_barrier();
        asm volatile("" ::: "memory");
        if (ip + 2 < nP) { const int s2 = ps >= 1 ? ps - 1 : 2; ATT_DMA2(ip + 2, s2); }
#pragma unroll
        for (int half = 0; half < 2; ++half) {
            const int t = tlo + 2 * ip + half;
            const LAS unsigned char* Bf = L + (2 * ps + half) * SLOT;
            const float dl = (float)(q - t * 64 - 8 * hi);
            v4u pw1[4], pw2[4];
            const bf16x8 ka00 = *(const LAS bf16x8*)(Bf + kfo), ka01 = *(const LAS bf16x8*)(Bf + kfo + 32), ka10 = *(const LAS bf16x8*)(Bf + 32 * 80 + kfo), ka11 = *(const LAS bf16x8*)(Bf + 32 * 80 + kfo + 32);
            const bf16x8 kb00 = *(const LAS bf16x8*)(Bf + 5120 + kfo), kb01 = *(const LAS bf16x8*)(Bf + 5120 + kfo + 32), kb10 = *(const LAS bf16x8*)(Bf + 5120 + 32 * 80 + kfo), kb11 = *(const LAS bf16x8*)(Bf + 5120 + 32 * 80 + kfo + 32);
            f32x16 c0, c1;
            if (t * 64 + 63 < qw0) {
                const float tl = -slope2 * dl - R;
#pragma unroll
                for (int r = 0; r < 16; ++r) { const float cc = (float)(16 * (r >> 3) + (r & 7)); c0[r] = __builtin_fmaf(slope2, cc, tl); c1[r] = __builtin_fmaf(slope2, cc + 32.f, tl); }
            } else if (t * 64 > qw0 + 31) {
                const float tr = slope2 * dl - R;
#pragma unroll
                for (int r = 0; r < 16; ++r) { const float cc = (float)(16 * (r >> 3) + (r & 7)); c0[r] = __builtin_fmaf(-slope2, cc, tr); c1[r] = __builtin_fmaf(-slope2, cc + 32.f, tr); }
            } else {
#pragma unroll
                for (int r = 0; r < 16; ++r) { const float cc = (float)(16 * (r >> 3) + (r & 7)); c0[r] = __builtin_fmaf(-slope2, __builtin_fabsf(dl - cc), -R); c1[r] = __builtin_fmaf(-slope2, __builtin_fabsf(dl - (cc + 32.f)), -R); }
            }
            {
                f32x16 s0 = __builtin_amdgcn_mfma_f32_32x32x16_bf16(ka00, q1f[0], c0, 0, 0, 0); s0 = __builtin_amdgcn_mfma_f32_32x32x16_bf16(ka01, q1f[1], s0, 0, 0, 0);
                f32x16 s1 = __builtin_amdgcn_mfma_f32_32x32x16_bf16(ka10, q1f[0], c1, 0, 0, 0); s1 = __builtin_amdgcn_mfma_f32_32x32x16_bf16(ka11, q1f[1], s1, 0, 0, 0);
                float p1scale = 1.f; ATT_SOFTMAX(s0, s1, pw1, l1); (void)p1scale;
            }
            bf16x8 vf[2][4];
            {
                f32x16 s0 = __builtin_amdgcn_mfma_f32_32x32x16_bf16(kb00, q2f[0], c0, 0, 0, 0); s0 = __builtin_amdgcn_mfma_f32_32x32x16_bf16(kb01, q2f[1], s0, 0, 0, 0);
                f32x16 s1 = __builtin_amdgcn_mfma_f32_32x32x16_bf16(kb10, q2f[0], c1, 0, 0, 0); s1 = __builtin_amdgcn_mfma_f32_32x32x16_bf16(kb11, q2f[1], s1, 0, 0, 0);
#pragma unroll
                for (int db = 0; db < 2; ++db)
#pragma unroll
                    for (int ks = 0; ks < 4; ++ks) vf[db][ks] = *(const LAS bf16x8*)(Bf + vfo + db * 32 * 144 + ks * 32);
                float p1scale = 1.f; ATT_SOFTMAX(s0, s1, pw2, l2);
                if (__any(p1scale != 1.f)) {
#pragma unroll
                    for (int ks = 0; ks < 4; ++ks)
#pragma unroll
                        for (int e = 0; e < 4; ++e) { const unsigned w = pw1[ks][e]; pw1[ks][e] = cvtpk(bflo(w) * p1scale, bfhi(w) * p1scale); }
                }
            }
#pragma unroll
            for (int db = 0; db < 2; ++db)
#pragma unroll
                for (int ks = 0; ks < 4; ++ks) {
                    O1[db] = __builtin_amdgcn_mfma_f32_32x32x16_bf16(vf[db][ks], __builtin_bit_cast(bf16x8, pw1[ks]), O1[db], 0, 0, 0);
                    O2[db] = __builtin_amdgcn_mfma_f32_32x32x16_bf16(vf[db][ks], __builtin_bit_cast(bf16x8, pw2[ks]), O2[db], 0, 0, 0);
                }
        }
        ps = ps == 2 ? 0 : ps + 1;
    }
    l1 += __shfl_xor(l1, 32); l2 += __shfl_xor(l2, 32);
    const float* dlm = F.in[I_DLAMBDA] + layer * 128;
    float a1 = 0.f, a2 = 0.f;
#pragma unroll 8
    for (int i = 0; i < 32; ++i) { a1 += dlm[i] * dlm[32 + i]; a2 += dlm[64 + i] * dlm[96 + i]; }
    const float lam_init = 0.8f - 0.6f * __expf(-0.3f * (float)layer);
    const float lam = __expf(a1) - __expf(a2) + lam_init;
    const float i1 = 1.f / fmaxf(l1, 1e-30f), i2 = lam / fmaxf(l2, 1e-30f);
    float ss = 0.f;
#pragma unroll
    for (int db = 0; db < 2; ++db)
#pragma unroll
        for (int r = 0; r < 16; ++r) { const float v = O1[db][r] * i1 - O2[db][r] * i2; O1[db][r] = v; ss += v * v; }
    ss += __shfl_xor(ss, 32);
    const float rs = (1.f / sqrtf(ss * (1.f / 64.f) + EPS)) * (1.f - lam_init);
    bf16* orow = (bf16*)(F.ws + WS_O4) + ((size_t)b * SEQ + q) * 1024 + 64 * h;
    const float* sg = F.in[I_DSUBLN] + layer * 64;
#pragma unroll
    for (int db = 0; db < 2; ++db)
#pragma unroll
        for (int g4 = 0; g4 < 4; ++g4) {
            const int d0 = 32 * db + 8 * g4 + 4 * hi;
            const float v0 = O1[db][4 * g4] * rs * sg[d0], v1 = O1[db][4 * g4 + 1] * rs * sg[d0 + 1], v2 = O1[db][4 * g4 + 2] * rs * sg[d0 + 2], v3 = O1[db][4 * g4 + 3] * rs * sg[d0 + 3];
            v2u w = {pk2(v0, v1), pk2(v2, v3)};
            *(GAS v2u*)(orow + d0) = w;
        }
    asm volatile("s_waitcnt lgkmcnt(0)" ::: "memory");
    __builtin_amdgcn_s_barrier();
#undef ATT_DMA1
#undef ATT_DMA2
}
#undef ATT_SOFTMAX
#undef ATT_WAITV
}

namespace pc {
constexpr int MPITCH = 72;
__device__ __forceinline__ void pool_task(Frame& F, const int layer, const int tile, const int g, LAS unsigned char* mimg) {
    const int lane = F.lane, r32 = lane & 31, hi = lane >> 5;
    const bf16* P = (const bf16*)(F.ws + WS_PROJ);
    bf16* O4 = (bf16*)(F.ws + WS_O4);
    bf16x8 wf[2][4];
    { const float* W = F.in[I_POOLW] + ((size_t)layer * 4 + g) * 64 * 64;
#pragma unroll
      for (int nb = 0; nb < 2; ++nb)
#pragma unroll
          for (int ks = 0; ks < 4; ++ks) { v4u t;
#pragma unroll
              for (int jj = 0; jj < 4; ++jj) t[jj] = pk2(W[(16 * ks + 8 * hi + 2 * jj) * 64 + r32 + 32 * nb], W[(16 * ks + 8 * hi + 2 * jj + 1) * 64 + r32 + 32 * nb]);
              wf[nb][ks] = __builtin_bit_cast(bf16x8, t); } }
    const int t0 = tile * 64, s0 = t0 % SEQ, hw = 1 << g;
    const bf16* src = P + (size_t)t0 * PJ + C_PIN + 64 * g + lane;
    float cs[81]; cs[0] = 0.f;
#pragma unroll
    for (int i = 0; i < 80; ++i) { const int s = s0 - 8 + i; float v = 0.f; if (s >= 0 && s < SEQ) v = bf2f(src[(long)(i - 8) * PJ]); cs[i + 1] = cs[i] + v; }
#pragma unroll
    for (int i = 0; i < 64; ++i) {
        const int s = s0 + i; int lo = s - hw, hiw = s + hw; lo = lo < 0 ? 0 : lo; hiw = hiw > SEQ ? SEQ : hiw;
        float wsum = 0.f;
        if (g == 0) wsum = cs[i + 8 + 1] - cs[i + 8 - 1]; else if (g == 1) wsum = cs[i + 8 + 2] - cs[i + 8 - 2]; else if (g == 2) wsum = cs[i + 8 + 4] - cs[i + 8 - 4]; else wsum = cs[i + 8 + 8] - cs[i + 8 - 8];
        const float pv = cs[i + 9] - cs[i + 8];
        const float mval = wsum / (float)(hiw - lo) - pv;
        *(LAS unsigned short*)(mimg + i * (MPITCH * 2) + lane * 2) = (unsigned short)f2bf(mval);
    }
    LDS_WAIT();
#pragma unroll
    for (int tb = 0; tb < 2; ++tb) {
        bf16x8 af[4];
#pragma unroll
        for (int ks = 0; ks < 4; ++ks) af[ks] = *(const LAS bf16x8*)(mimg + (r32 + 32 * tb) * (MPITCH * 2) + (16 * ks + 8 * hi) * 2);
#pragma unroll
        for (int nb = 0; nb < 2; ++nb) {
            f32x16 acc;
#pragma unroll
            for (int r = 0; r < 16; ++r) acc[r] = 0.f;
#pragma unroll
            for (int ks = 0; ks < 4; ++ks) acc = __builtin_amdgcn_mfma_f32_32x32x16_bf16(af[ks], wf[nb][ks], acc, 0, 0, 0);
            const int e = r32 + 32 * nb; const float sc = F.in[I_POOLSCALE][layer * 256 + 64 * g + e];
#pragma unroll
            for (int r = 0; r < 16; ++r) { const int row = 32 * tb + (r & 3) + 8 * (r >> 2) + 4 * hi;
                O4[(size_t)(t0 + row) * 1024 + 256 + 64 * g + e] = (bf16)f2bf(acc[r] * sc); }
        }
    }
    LDS_WAIT();
}
__device__ __forceinline__ void conv_task(Frame& F, const int layer, const int tile, const int cg) {
    const int lane = F.lane;
    const bf16* P = (const bf16*)(F.ws + WS_PROJ);
    bf16* O4 = (bf16*)(F.ws + WS_O4);
    const int t0 = tile * 64, s0 = t0 % SEQ;
    const int ch = 64 * cg + lane;
    const float w0 = F.in[I_SCONVW][layer * 768 + ch], w1 = F.in[I_SCONVW][layer * 768 + 256 + ch], w2 = F.in[I_SCONVW][layer * 768 + 512 + ch];
    const bf16* base = P + (size_t)t0 * PJ + ch;
    float zm = 0.f, z0 = 0.f, zp = 0.f;
    if (s0 > 0) zm = bf2f(base[-(long)PJ + C_CC]) * bf2f(base[-(long)PJ + C_CX]);
    z0 = bf2f(base[C_CC]) * bf2f(base[C_CX]);
#pragma unroll 8
    for (int i = 0; i < 64; ++i) {
        zp = 0.f; if (s0 + i + 1 < SEQ) zp = bf2f(base[(long)(i + 1) * PJ + C_CC]) * bf2f(base[(long)(i + 1) * PJ + C_CX]);
        const float cbv = bf2f(base[(long)i * PJ + C_CB]);
        O4[(size_t)(t0 + i) * 1024 + 512 + ch] = (bf16)f2bf(cbv * (w0 * zm + w1 * z0 + w2 * zp));
        zm = z0; z0 = zp;
    }
}
}

namespace dl {
constexpr int MP = 72, MB = 64 * MP * 2;
constexpr int WAVE_LDS = 2 * MB + 2 * MB;
__device__ __forceinline__ int crow(int r, int hi) { return (r & 3) + 8 * (r >> 2) + 4 * hi; }
__device__ __forceinline__ bf16x8 ldfrag(const LAS unsigned char* img, int row, int col) { return *(const LAS bf16x8*)(img + row * (MP * 2) + col * 2); }
__device__ __forceinline__ bf16x8 ldfragp(const LAS unsigned char* img, int row, int col4) {
    const v2u lo = *(const LAS v2u*)(img + row * (MP * 2) + col4 * 2), hi8 = *(const LAS v2u*)(img + row * (MP * 2) + col4 * 2 + 16); const v4u t = {lo.x, lo.y, hi8.x, hi8.y}; return __builtin_bit_cast(bf16x8, t); }
__device__ __forceinline__ bf16x8 cfrag(const f32x16& x, int half) {
    v4u t;
#pragma unroll
    for (int e = 0; e < 4; ++e) t[e] = att::cvtpk(x[8 * half + 2 * e], x[8 * half + 2 * e + 1]);
    return __builtin_bit_cast(bf16x8, t); }
#define MFMA32(a, b, c) __builtin_amdgcn_mfma_f32_32x32x16_bf16((a), (b), (c), 0, 0, 0)
#define SB() __builtin_amdgcn_sched_barrier(0)
#define LAUNDER() do { asm volatile("" : "+v"(lane)); r32 = lane & 31; hi = lane >> 5; } while (0)
__device__ __forceinline__ f32x16 zero16() { f32x16 z;
#pragma unroll
    for (int r = 0; r < 16; ++r) z[r] = 0.f;
    return z; }

#define DL_CONV(colbase, wbase, RAW) do { \
    { const bf16* src_ = P + (size_t)tok0 * PJ + (colbase); const int rr_ = lane >> 3, ch_ = lane & 7; \
      _Pragma("unroll") for (int i_ = 0; i_ < 9; ++i_) { const int row_ = rr_ + 8 * i_; const int sq_ = s0 - 2 + row_; v4u t_ = {0u, 0u, 0u, 0u}; \
          if (row_ < 68 && sq_ >= 0 && sq_ < SEQ) t_ = *(const GAS v4u*)(src_ + (long)(row_ - 2) * PJ + ch_ * 8); if (row_ < 68) *(LAS v4u*)((RAW) + row_ * 128 + ch_ * 16) = t_; } } \
    LDS_WAIT(); \
    const float cw0 = cwp[(wbase) + lane], cw1 = cwp[768 + (wbase) + lane], cw2 = cwp[2 * 768 + (wbase) + lane], cw3 = cwp[3 * 768 + (wbase) + lane], cw4 = cwp[4 * 768 + (wbase) + lane]; \
    const LAS unsigned short* rw_ = (const LAS unsigned short*)(RAW) + lane; \
    _Pragma("unroll") for (int i = 0; i < 64; ++i) { \
        const float cv_ = cw0 * bf2f(rw_[i * 64]) + cw1 * bf2f(rw_[(i + 1) * 64]) + cw2 * bf2f(rw_[(i + 2) * 64]) + cw3 * bf2f(rw_[(i + 3) * 64]) + cw4 * bf2f(rw_[(i + 4) * 64]); \
        cval[i] = cv_ * sigmoidf_(cv_); if ((i & 7) == 7) SB(); } \
    LDS_WAIT(); } while (0)
#define DL_NORM(SQ, scale) do { \
    _Pragma("unroll") for (int i = 0; i < 64; ++i) *(LAS unsigned short*)((SQ) + i * 144 + lane * 2) = (unsigned short)f2bf(cval[i] * cval[i]); \
    LDS_WAIT(); \
    { float sm_ = 0.f; _Pragma("unroll") for (int c8 = 0; c8 < 8; ++c8) { const v4u w_ = *(const LAS v4u*)((SQ) + lane * 144 + c8 * 16); \
          sm_ += (bflo(w_.x) + bfhi(w_.x)) + (bflo(w_.y) + bfhi(w_.y)) + (bflo(w_.z) + bfhi(w_.z)) + (bflo(w_.w) + bfhi(w_.w)); } \
      tab[192 + lane] = (scale) / sqrtf(sm_ + EPS); } \
    LDS_WAIT(); \
    _Pragma("unroll") for (int i4 = 0; i4 < 16; ++i4) { const f32x4 r4_ = *(const LAS f32x4*)(tab + 192 + 4 * i4); cval[4 * i4] *= r4_.x; cval[4 * i4 + 1] *= r4_.y; cval[4 * i4 + 2] *= r4_.z; cval[4 * i4 + 3] *= r4_.w; } \
    } while (0)

__device__ __forceinline__ void d1_instance(Frame& F, const int layer, const int b, const int h, const int norig, const int dir, LAS unsigned char* W, LAS float* tab) {
    int lane = F.lane, r32, hi; LAUNDER();
    const bf16* P = (const bf16*)(F.ws + WS_PROJ);
    const float* cwp = F.in[I_DCONVW] + (size_t)layer * 5 * 768;
    const int s0 = norig * 64, tok0 = b * SEQ + s0;
    const int npr = dir ? 255 - norig : norig;
    const int inst = ((b * 4 + h) * 2 + dir) * NCHUNK + npr;
    LAS unsigned char* VT = W;
    LAS unsigned char* KT = W + MB;
    LAS unsigned char* KR = W + 2 * MB;
    LAS unsigned char* T2 = W + 3 * MB;
    LAS float* SM = (LAS float*)(W + 2 * MB);
    float cval[64];
    DL_CONV(C_DK + 64 * h, 256 + 64 * h, T2);
    DL_NORM(VT, 1.f);
#pragma unroll
    for (int i = 0; i < 64; ++i) { const int ip = dir ? 63 - i : i; const unsigned short kb = (unsigned short)f2bf(cval[i]);
        *(LAS unsigned short*)(KR + ip * (MP * 2) + lane * 2) = kb; *(LAS unsigned short*)(KT + lane * (MP * 2) + ip * 2) = kb; }
    LDS_WAIT();
    DL_CONV(C_DV + 64 * h, 512 + 64 * h, T2);
#pragma unroll
    for (int i = 0; i < 64; ++i) { const int ip = dir ? 63 - i : i; *(LAS unsigned short*)(VT + lane * (MP * 2) + ip * 2) = (unsigned short)f2bf(cval[i]); }
    const int mytok = tok0 + (dir ? 63 - lane : lane);
    const float* BD = (const float*)(F.ws + WS_BD) + (size_t)mytok * 16;
    const float beta = BD[dir * 4 + h]; float gc = BD[8 + dir * 4 + h];
#pragma unroll
    for (int o = 1; o < 64; o <<= 1) { const float t = __shfl_up(gc, o); if (lane >= o) gc += t; }
    const float gl = __shfl(gc, 63);
    tab[lane] = gc; tab[64 + lane] = beta; tab[128 + lane] = __expf(gl - gc);
    LDS_WAIT();
    LAUNDER();
    f32x16 kk[2][2];
#pragma unroll
    for (int tb = 0; tb < 2; ++tb)
#pragma unroll
        for (int tn = 0; tn < 2; ++tn) { f32x16 acc = zero16();
#pragma unroll
            for (int ks = 0; ks < 4; ++ks) acc = MFMA32(ldfrag(KR, r32 + 32 * tb, 16 * ks + 8 * hi), ldfrag(KR, r32 + 32 * tn, 16 * ks + 8 * hi), acc);
            kk[tb][tn] = acc; SB(); }
    LDS_WAIT();
#pragma unroll
    for (int tb = 0; tb < 2; ++tb)
#pragma unroll
        for (int tn = 0; tn < 2; ++tn) {
            const int jc = r32 + 32 * tn; const float gcj = tab[jc];
#pragma unroll
            for (int r = 0; r < 16; ++r) { const int ir = 32 * tb + crow(r, hi); const float gci = tab[ir], bi = tab[64 + ir];
                const float mv = (ir > jc) ? bi * kk[tb][tn][r] * __expf(gci - gcj) : 0.f; SM[ir * 64 + jc] = mv; } SB(); }
    LDS_WAIT();
    LAUNDER();
    float T[64];
#pragma unroll
    for (int i = 0; i < 64; ++i) {
        float a0 = (lane == i) ? 1.f : 0.f, a1 = 0.f, a2 = 0.f, a3 = 0.f;
#pragma unroll
        for (int j4 = 0; j4 < (i + 3) / 4; ++j4) { const f32x4 m4 = *(const LAS f32x4*)(SM + i * 64 + 4 * j4);
            if (4 * j4 + 0 < i) a0 = __builtin_fmaf(-m4[0], T[4 * j4 + 0], a0);
            if (4 * j4 + 1 < i) a1 = __builtin_fmaf(-m4[1], T[4 * j4 + 1], a1);
            if (4 * j4 + 2 < i) a2 = __builtin_fmaf(-m4[2], T[4 * j4 + 2], a2);
            if (4 * j4 + 3 < i) a3 = __builtin_fmaf(-m4[3], T[4 * j4 + 3], a3); }
        T[i] = (a0 + a1) + (a2 + a3); if ((i & 3) == 3) SB(); }
    LDS_WAIT();
    LAUNDER();
    { const float b1 = beta, b2 = beta * __expf(gc);
#pragma unroll
      for (int i = 0; i < 64; ++i) { *(LAS unsigned short*)(KR + i * (MP * 2) + lane * 2) = (unsigned short)f2bf(T[i] * b1); *(LAS unsigned short*)(T2 + i * (MP * 2) + lane * 2) = (unsigned short)f2bf(T[i] * b2); if ((i & 7) == 7) SB(); } }
    LDS_WAIT();
    LAUNDER();
    f32x16 u[2][2], w[2][2];
#pragma unroll
    for (int tb = 0; tb < 2; ++tb)
#pragma unroll
        for (int tn = 0; tn < 2; ++tn) { f32x16 au = zero16(), aw = zero16();
#pragma unroll
            for (int ks = 0; ks < 4; ++ks) { au = MFMA32(ldfrag(KR, r32 + 32 * tb, 16 * ks + 8 * hi), ldfrag(VT, r32 + 32 * tn, 16 * ks + 8 * hi), au);
                                             aw = MFMA32(ldfrag(T2, r32 + 32 * tb, 16 * ks + 8 * hi), ldfrag(KT, r32 + 32 * tn, 16 * ks + 8 * hi), aw); }
            u[tb][tn] = au; w[tb][tn] = aw; SB(); }
    LAUNDER();
    { unsigned* ud = (unsigned*)(F.ws + WS_UW + (size_t)inst * 16384); bf16* wd = (bf16*)(F.ws + WS_UW + (size_t)inst * 16384 + 8192);
#pragma unroll
      for (int tb = 0; tb < 2; ++tb)
#pragma unroll
          for (int tn = 0; tn < 2; ++tn) {
#pragma unroll
              for (int rp = 0; rp < 8; ++rp) ud[((tb * 2 + tn) * 8 + rp) * 64 + lane] = pk2(u[tb][tn][2 * rp], u[tb][tn][2 * rp + 1]);
#pragma unroll
              for (int r = 0; r < 16; ++r) wd[(32 * tb + crow(r, hi)) * 64 + r32 + 32 * tn] = (bf16)f2bf(w[tb][tn][r]); SB(); } }
    LAUNDER();
#pragma unroll
    for (int tb = 0; tb < 2; ++tb)
#pragma unroll
        for (int r = 0; r < 16; ++r) { const float e = tab[128 + 32 * tb + crow(r, hi)];
#pragma unroll
            for (int tn = 0; tn < 2; ++tn) { u[tb][tn][r] *= e; w[tb][tn][r] *= e; } }
    SB();
    bf16x8 kf[2][4];
#pragma unroll
    for (int tbb = 0; tbb < 2; ++tbb)
#pragma unroll
        for (int s = 0; s < 4; ++s) kf[tbb][s] = ldfragp(KT, r32 + 32 * tbb, 16 * s + 4 * hi);
    LDS_WAIT(); SB();
    LAUNDER();
    LAS unsigned char* AR = VT; LAS unsigned char* BT = KR;
#pragma unroll
    for (int tbb = 0; tbb < 2; ++tbb)
#pragma unroll
        for (int tx = 0; tx < 2; ++tx) { f32x16 aa = zero16(), ab = zero16();
#pragma unroll
            for (int s = 0; s < 4; ++s) { aa = MFMA32(cfrag(w[s >> 1][tx], s & 1), kf[tbb][s], aa); ab = MFMA32(kf[tbb][s], cfrag(u[s >> 1][tx], s & 1), ab); }
#pragma unroll
            for (int g4 = 0; g4 < 4; ++g4) {
                const v2u pa = {pk2(-aa[4 * g4], -aa[4 * g4 + 1]), pk2(-aa[4 * g4 + 2], -aa[4 * g4 + 3])};
                *(LAS v2u*)(AR + (r32 + 32 * tbb) * (MP * 2) + (32 * tx + 8 * g4 + 4 * hi) * 2) = pa;
                const v2u pb = {pk2(ab[4 * g4], ab[4 * g4 + 1]), pk2(ab[4 * g4 + 2], ab[4 * g4 + 3])};
                *(LAS v2u*)(BT + (r32 + 32 * tx) * (MP * 2) + (32 * tbb + 8 * g4 + 4 * hi) * 2) = pb;
            } SB(); }
    LDS_WAIT();
    LAUNDER();
    { unsigned char* ab = F.ws + WS_AB + (size_t)inst * 16384; const int m16 = lane & 15, g = lane >> 4;
#pragma unroll
      for (int rb = 0; rb < 4; ++rb)
#pragma unroll
          for (int ks = 0; ks < 2; ++ks) { const v2u lo = *(const LAS v2u*)(AR + (16 * rb + m16) * (MP * 2) + (32 * ks + 4 * g) * 2), hi8 = *(const LAS v2u*)(AR + (16 * rb + m16) * (MP * 2) + (32 * ks + 16 + 4 * g) * 2);
              const v4u t = {lo.x, lo.y, hi8.x, hi8.y}; *(GAS v4u*)(ab + ((rb * 2 + ks) * 64 + lane) * 16) = t; }
#pragma unroll
      for (int sl = 0; sl < 4; ++sl)
#pragma unroll
          for (int rb = 0; rb < 4; ++rb) { const v2u t = *(const LAS v2u*)(BT + (16 * sl + m16) * (MP * 2) + (16 * rb + 4 * g) * 2); *(GAS v2u*)(ab + 8192 + ((sl * 4 + rb) * 64 + lane) * 8) = t; } }
    if (lane == 0) ((float*)(F.ws + WS_DEC))[inst] = __expf(gl);
    LDS_WAIT();
}
__device__ __forceinline__ void pc_side_tasks(Frame& F, const int layer, const int half) {
    if (F.wave == 4) {
        LAS unsigned char* mimg = F.lds + RING_OFF + 4 * WAVE_LDS + 4096;
        for (int tile = F.vcu + half * F.G; tile < NTOK / 64; tile += 2 * F.G)
            for (int g = 0; g < 4; ++g) pc::pool_task(F, layer, tile, g, mimg);
    } else if (F.wave > 4) {
        int k = 0;
        for (int tile = F.vcu + half * F.G; tile < NTOK / 64; tile += 2 * F.G)
            for (int cg = 0; cg < 4; ++cg, ++k) if (k % 3 == F.wave - 5) pc::conv_task(F, layer, tile, cg);
    }
}
__device__ __forceinline__ void d1_phase(Frame& F, const int layer) {
    if (F.wave < 4) {
        LAS unsigned char* W = F.lds + RING_OFF + F.wave * WAVE_LDS; LAS float* tab = (LAS float*)(F.lds + RING_OFF + 4 * WAVE_LDS + F.wave * 1024);
        const int gw = F.vcu * 4 + F.wave, NGW = F.G * 4;
        for (int it = gw; it < NINST; it += NGW) { const int dir = it & 1, u = it >> 1; d1_instance(F, layer, u >> 10, (u >> 8) & 3, u & 255, dir, W, tab); }
    } else pc_side_tasks(F, layer, 0);
    __syncthreads();
}

typedef float f32x4v __attribute__((ext_vector_type(4)));
struct D2Regs { v4u af[4][2]; v2u bm[4]; float dcy; };
__device__ __forceinline__ void d2_chain(Frame& F, const int chain) {
    const int lane = F.lane, n16 = lane & 15, g = lane >> 4, sl = F.wave;
    f32x4v S[4];
#pragma unroll
    for (int rb = 0; rb < 4; ++rb) S[rb] = (f32x4v){0.f, 0.f, 0.f, 0.f};
    const unsigned char* abase = F.ws + WS_AB + (size_t)chain * NCHUNK * 16384;
    unsigned char* sbase = F.ws + WS_ST + (size_t)chain * NCHUNK * 8192;
    const float* dec = (const float*)(F.ws + WS_DEC) + chain * NCHUNK;
    D2Regs q0, q1, q2;
#define D2_LOAD(Q, n) do { const unsigned char* ab_ = abase + (size_t)(n) * 16384; \
    _Pragma("unroll") for (int rb = 0; rb < 4; ++rb) { _Pragma("unroll") for (int ks = 0; ks < 2; ++ks) Q.af[rb][ks] = *(const GAS v4u*)(ab_ + ((rb * 2 + ks) * 64 + lane) * 16); \
        Q.bm[rb] = *(const GAS v2u*)(ab_ + 8192 + ((sl * 4 + rb) * 64 + lane) * 8); } Q.dcy = dec[n]; } while (0)
#define D2_STEP(Q, n) do { \
    unsigned char* st = sbase + (size_t)(n) * 8192 + (16 * sl + n16) * 128; \
    _Pragma("unroll") for (int rb = 0; rb < 4; ++rb) { const v2u t = {pk2(S[rb][0], S[rb][1]), pk2(S[rb][2], S[rb][3])}; *(GAS v2u*)(st + (16 * rb + 4 * g) * 2) = t; } \
    bf16x8 bfr[2]; \
    _Pragma("unroll") for (int ks = 0; ks < 2; ++ks) { const v4u t = {att::cvtpk(S[2 * ks][0], S[2 * ks][1]), att::cvtpk(S[2 * ks][2], S[2 * ks][3]), att::cvtpk(S[2 * ks + 1][0], S[2 * ks + 1][1]), att::cvtpk(S[2 * ks + 1][2], S[2 * ks + 1][3])}; bfr[ks] = __builtin_bit_cast(bf16x8, t); } \
    _Pragma("unroll") for (int rb = 0; rb < 4; ++rb) { const float cd = Q.dcy; \
        f32x4v c = {S[rb][0] * cd + bflo(Q.bm[rb].x), S[rb][1] * cd + bfhi(Q.bm[rb].x), S[rb][2] * cd + bflo(Q.bm[rb].y), S[rb][3] * cd + bfhi(Q.bm[rb].y)}; \
        c = __builtin_amdgcn_mfma_f32_16x16x32_bf16(__builtin_bit_cast(bf16x8, Q.af[rb][0]), bfr[0], c, 0, 0, 0); \
        c = __builtin_amdgcn_mfma_f32_16x16x32_bf16(__builtin_bit_cast(bf16x8, Q.af[rb][1]), bfr[1], c, 0, 0, 0); \
        S[rb] = c; } } while (0)
    D2_LOAD(q0, 0); D2_LOAD(q1, 1);
    for (int n = 0; n < NCHUNK - 1; n += 3) {
        D2_LOAD(q2, n + 2); D2_STEP(q0, n); SB();
        D2_LOAD(q0, n + 3); D2_STEP(q1, n + 1); SB();
        if (n + 4 < NCHUNK) D2_LOAD(q1, n + 4); D2_STEP(q2, n + 2); SB();
    }
    D2_STEP(q0, NCHUNK - 1);
#undef D2_LOAD
#undef D2_STEP
}

__device__ __forceinline__ void scan_attn_phase(Frame& F, const int layer, const int qword) {
    for (;;) {
        { unsigned char* w_ = F.ws; int t_ = F.tid; asm volatile("" : "+s"(w_), "+v"(t_)); F.ws = w_; F.ctl = (gu32*)(w_ + WS_CTL); F.tid = t_; F.lane = t_ & 63; }
        if (F.tid == 0) F.MISC[16] = __hip_atomic_fetch_add(F.ctl + CW_ATTQ + 64 * qword, 1u, RLX_AGENT);
        __syncthreads();
        const int idx = (int)F.MISC[16];
        __syncthreads();
        if (idx >= 16 + BATCH * 4 * 64) break;
        if (idx < 16) { if (F.wave < 4) d2_chain(F, idx); }
        else { const int j = idx - 16, h = 3 - (j >> 7), jj = j & 127, b = jj & 1, k = jj >> 1, qb = (k & 1) ? 31 - (k >> 1) : 32 + (k >> 1);
            att::attn_unit(F, layer, b, h, qb); }
    }
    __syncthreads();
}

__device__ __forceinline__ void d3_unit(Frame& F, const int layer, const int b, const int h, const int norig, LAS unsigned char* W, LAS float* tab) {
    int lane = F.lane, r32, hi; LAUNDER();
    const bf16* P = (const bf16*)(F.ws + WS_PROJ);
    const float* cwp = F.in[I_DCONVW] + (size_t)layer * 5 * 768;
    const int s0 = norig * 64, tok0 = b * SEQ + s0;
    LAS unsigned char* QR = W;
    LAS unsigned char* KR = W + MB;
    LAS unsigned char* AT = W + 2 * MB;
    LAS unsigned char* WR = W + 3 * MB;
    { float cval[64];
      DL_CONV(C_DQ + 64 * h, 64 * h, WR);
      DL_NORM(AT, 0.125f);
#pragma unroll
      for (int i = 0; i < 64; ++i) *(LAS unsigned short*)(QR + i * (MP * 2) + lane * 2) = (unsigned short)f2bf(cval[i]);
      LDS_WAIT();
      DL_CONV(C_DK + 64 * h, 256 + 64 * h, WR);
      DL_NORM(AT, 1.f);
#pragma unroll
      for (int i = 0; i < 64; ++i) *(LAS unsigned short*)(KR + i * (MP * 2) + lane * 2) = (unsigned short)f2bf(cval[i]);
      LDS_WAIT(); }
    f32x16 of[2][2];
#pragma unroll
    for (int dir = 0; dir < 2; ++dir) {
        LAUNDER();
        const int npr = dir ? 255 - norig : norig;
        const int inst = ((b * 4 + h) * 2 + dir) * NCHUNK + npr;
        const int mytok = tok0 + (dir ? 63 - lane : lane);
        float gc = ((const float*)(F.ws + WS_BD))[(size_t)mytok * 16 + 8 + dir * 4 + h];
#pragma unroll
        for (int o = 1; o < 64; o <<= 1) { const float t = __shfl_up(gc, o); if (lane >= o) gc += t; }
        tab[lane] = gc; tab[64 + lane] = __expf(gc);
        { const unsigned char* wg = F.ws + WS_UW + (size_t)inst * 16384 + 8192;
#pragma unroll
          for (int i = 0; i < 8; ++i) { const int idx = i * 64 + lane, row = idx >> 3, ch = idx & 7; const v4u c = *(const GAS v4u*)(wg + idx * 16); *(LAS v4u*)(WR + row * (MP * 2) + ch * 16) = c; } }
        LDS_WAIT();
        LAUNDER();
        const int ra0 = dir ? 63 - r32 : r32, ra1 = dir ? 31 - r32 : 32 + r32;
        f32x16 qk[2][2];
#pragma unroll
        for (int tb = 0; tb < 2; ++tb)
#pragma unroll
            for (int tn = 0; tn < 2; ++tn) { f32x16 acc = zero16();
#pragma unroll
                for (int ks = 0; ks < 4; ++ks) acc = MFMA32(ldfrag(QR, tb ? ra1 : ra0, 16 * ks + 8 * hi), ldfrag(KR, tn ? ra1 : ra0, 16 * ks + 8 * hi), acc);
                qk[tb][tn] = acc; SB(); }
        LDS_WAIT();
#pragma unroll
        for (int tb = 0; tb < 2; ++tb)
#pragma unroll
            for (int tn = 0; tn < 2; ++tn) { const int jc = r32 + 32 * tn; const float gcj = tab[jc];
#pragma unroll
                for (int r = 0; r < 16; ++r) { const int ir = 32 * tb + crow(r, hi); const float gci = tab[ir];
                    const float av = (ir >= jc) ? qk[tb][tn][r] * __expf(gci - gcj) : 0.f; *(LAS unsigned short*)(AT + ir * (MP * 2) + jc * 2) = (unsigned short)f2bf(av); } SB(); }
        LDS_WAIT();
        LAUNDER();
        const unsigned* ud = (const unsigned*)(F.ws + WS_UW + (size_t)inst * 16384);
        const unsigned char* sg = F.ws + WS_ST + (size_t)inst * 8192;
#pragma unroll
        for (int tn = 0; tn < 2; ++tn) {
            bf16x8 sf[4];
#pragma unroll
            for (int ks = 0; ks < 4; ++ks) sf[ks] = *(const GAS bf16x8*)(sg + ((r32 + 32 * tn) * 64 + 16 * ks + 8 * hi) * 2);
            f32x16 vn[2], o[2];
#pragma unroll
            for (int tb = 0; tb < 2; ++tb) { f32x16 a1 = zero16(), a2 = zero16();
#pragma unroll
                for (int ks = 0; ks < 4; ++ks) { a1 = MFMA32(ldfrag(WR, r32 + 32 * tb, 16 * ks + 8 * hi), sf[ks], a1); a2 = MFMA32(ldfrag(QR, tb ? ra1 : ra0, 16 * ks + 8 * hi), sf[ks], a2); }
#pragma unroll
                for (int rp = 0; rp < 8; ++rp) { const unsigned uw = ud[((tb * 2 + tn) * 8 + rp) * 64 + lane]; a1[2 * rp] = bflo(uw) - a1[2 * rp]; a1[2 * rp + 1] = bfhi(uw) - a1[2 * rp + 1]; }
#pragma unroll
                for (int r = 0; r < 16; ++r) a2[r] *= tab[64 + 32 * tb + crow(r, hi)];
                vn[tb] = a1; o[tb] = a2; SB(); }
#pragma unroll
            for (int tb = 0; tb < 2; ++tb) { f32x16 acc = o[tb];
#pragma unroll
                for (int s = 0; s < 4; ++s) acc = MFMA32(ldfragp(AT, r32 + 32 * tb, 16 * s + 4 * hi), cfrag(vn[s >> 1], s & 1), acc);
                o[tb] = acc; SB(); }
            if (dir == 0) { of[0][tn] = o[0]; of[1][tn] = o[1]; }
            else {
#pragma unroll
                for (int tb = 0; tb < 2; ++tb)
#pragma unroll
                    for (int r = 0; r < 16; ++r) of[tb][tn][r] += __shfl_xor(o[1 - tb][15 - r], 32);
            }
        }
        LDS_WAIT();
    }
    const float* dn = F.in[I_DNORM] + layer * 64;
#pragma unroll
    for (int tb = 0; tb < 2; ++tb)
#pragma unroll
        for (int r = 0; r < 16; ++r) {
            float ss = of[tb][0][r] * of[tb][0][r] + of[tb][1][r] * of[tb][1][r];
#pragma unroll
            for (int o = 1; o < 32; o <<= 1) ss += __shfl_xor(ss, o);
            const float rs = 1.f / sqrtf(ss * (1.f / 64.f) + EPS);
            const int tok = tok0 + 32 * tb + crow(r, hi);
#pragma unroll
            for (int tn = 0; tn < 2; ++tn) { const int dv = r32 + 32 * tn; const float z = bf2f(P[(size_t)tok * PJ + C_DZ + 64 * h + dv]);
                ((bf16*)(F.ws + WS_O4))[(size_t)tok * 1024 + 768 + 64 * h + dv] = (bf16)f2bf(of[tb][tn][r] * rs * dn[dv] * siluf_(z)); }
        }
}
__device__ __forceinline__ void d3_phase(Frame& F, const int layer) {
    if (F.wave < 4) {
        LAS unsigned char* W = F.lds + RING_OFF + F.wave * WAVE_LDS; LAS float* tab = (LAS float*)(F.lds + RING_OFF + 4 * WAVE_LDS + F.wave * 1024);
        const int gw = F.vcu * 4 + F.wave, NGW = F.G * 4;
        for (int u = gw; u < BATCH * 4 * NCHUNK; u += NGW) d3_unit(F, layer, u >> 10, (u >> 8) & 3, u & 255, W, tab);
    } else pc_side_tasks(F, layer, 1);
    __syncthreads();
}
#undef MFMA32
}

#ifndef ONLY_SITE
#define ONLY_SITE -1
#endif
#define SITE(k) (ONLY_SITE < 0 || ONLY_SITE == (k))
#ifndef PROBE_MASK
#define PROBE_MASK 0
#endif
#ifndef PROBE_N
#define PROBE_N 2
#endif
#define REPEAT(k) for (int rep_ = 0; rep_ < (((PROBE_MASK >> (k)) & 1) ? PROBE_N : 1); ++rep_)
#ifndef MK_SPLIT
#define MK_SPLIT 0
#endif
struct Args { const float* in[30]; float* out; unsigned char* ws; int ph_lo, ph_hi; };
constexpr int N_PHASES = 1 + 16 * NLAYER + 1;

#define IN_PH() (pid >= lo && pid < hi)
#define FRESH() do { unsigned char* w_ = args.ws; float* o_ = args.out; int t_ = threadIdx.x; asm volatile("" : "+s"(w_), "+s"(o_), "+v"(t_)); F.ws = w_; F.out = o_; F.ctl = (gu32*)(w_ + WS_CTL); F.tid = t_; F.lane = t_ & 63; } while (0)
#define SEAM() do { if (!MK_SPLIT && pid >= lo && pid + 1 < hi) xcd_barrier(bar); ++pid; } while (0)
#define NOSEAM() do { ++pid; } while (0)

template <int l> __device__ __forceinline__ void layer_phases(Frame& F, const Args& args, const XcdBarrier& bar, const int lo, const int hi, int& pid) {
    LAS unsigned char* ring = F.lds + RING_OFF;

        if constexpr (l == 0) { if (IN_PH() && SITE(1)) REPEAT(1) { FRESH(); p_rows<ROW_A>(F, 0); } SEAM(); } else { NOSEAM(); }
        if (IN_PH() && SITE(2)) REPEAT(2) { FRESH();
            pg8::SchedStd S; S.init(NTOK / 256, NPROJ / 256, F.G, (int)blockIdx.x, F.ws + WS_H, (size_t)256 * D * 2, w_in_t(F.ws, l), (size_t)256 * D * 2);
            pg8::EpiProj E{(bf16*)(F.ws + WS_QB), (bf16*)(F.ws + WS_KV), (bf16*)(F.ws + WS_PROJ), (unsigned*)(F.ctl + CW_NMAX) + l * 16, QSCALE};
            pg8::gemm_phase<pg8::EpiProj, pg8::SchedStd, D, D, D>(ring, F.tid, S, E);
        }
        SEAM();
        NOSEAM();
        if (IN_PH() && SITE(5)) REPEAT(5) { FRESH(); dl::d1_phase(F, l); }
        SEAM();
        if (IN_PH() && SITE(3)) REPEAT(3) { FRESH(); dl::scan_attn_phase(F, l, l * 2 + rep_); }
        SEAM();
        NOSEAM();
        if (IN_PH() && SITE(7)) REPEAT(7) { FRESH(); dl::d3_phase(F, l); }
        SEAM();
        if (IN_PH() && SITE(8)) REPEAT(8) { FRESH();
            pg8::SchedBranch S; S.s.init(NTOK / 256, 16, F.G, (int)blockIdx.x, nullptr, 0, nullptr, 0); S.O4 = (const char*)(F.ws + WS_O4); S.Wb = (const char*)w_b_t(F.ws, l);
            pg8::EpiStore E{(bf16*)(F.ws + WS_PBUF), 1024, (size_t)NTOK * 1024, 1.f};
            pg8::gemm_phase<pg8::EpiStore, pg8::SchedBranch, 256, 1024, 256>(ring, F.tid, S, E);
        }
        SEAM();
        if (IN_PH() && SITE(9)) REPEAT(9) { FRESH();
            pg8::SchedGate S{F.vcu, F.G, (const char*)(F.ws + WS_H), (const char*)w_m_t(F.ws, l)};
            pg8::EpiGate E{(const bf16*)(F.ws + WS_PBUF), (bf16*)(F.ws + WS_MERGED), F.in[I_BMERGE] + (size_t)l * 4 * D};
            pg8::gemm_phase<pg8::EpiGate, pg8::SchedGate, D, D, D>(ring, F.tid, S, E);
        }
        SEAM();
        if (IN_PH() && SITE(10)) REPEAT(10) { FRESH();
            pg8::SchedStd S; S.init(NTOK / 256, D / 256, F.G, (int)blockIdx.x, F.ws + WS_MERGED, (size_t)256 * D * 2, w_o_t(F.ws, l), (size_t)256 * D * 2);
            pg8::EpiStore E{(bf16*)(F.ws + WS_F), D, 0, 1.f};
            pg8::gemm_phase<pg8::EpiStore, pg8::SchedStd, D, D, D>(ring, F.tid, S, E);
        }
        SEAM();
        if (IN_PH() && SITE(11)) REPEAT(11) { FRESH(); p_rows<ROW_B>(F, l); }
        SEAM();
        if constexpr (l == 0) {
            if (IN_PH() && SITE(12)) REPEAT(12) { FRESH();
                pg8::SchedStd S; S.init(NTOK / 256, 2 * DFF / 256, F.G, (int)blockIdx.x, F.ws + WS_H, (size_t)256 * D * 2, F.ws + WS_WFFN, (size_t)256 * D * 2);
                pg8::EpiSwiGLU E{(bf16*)(F.ws + WS_ACT0), DFF};
                pg8::gemm_phase<pg8::EpiSwiGLU, pg8::SchedStd, D, D, D>(ring, F.tid, S, E);
            }
            SEAM();
            if (IN_PH() && SITE(13)) REPEAT(13) { FRESH();
                pg8::SchedStd S; S.init(NTOK / 256, D / 256, F.G, (int)blockIdx.x, F.ws + WS_ACT0, (size_t)256 * DFF * 2, F.ws + WS_WFFN + SZ_WGU, (size_t)256 * DFF * 2);
                pg8::EpiStore E{(bf16*)(F.ws + WS_F), D, 0, 1.f};
                pg8::gemm_phase<pg8::EpiStore, pg8::SchedStd, DFF, DFF, DFF>(ring, F.tid, S, E);
            }
            SEAM();
            if (IN_PH() && SITE(14)) REPEAT(14) { FRESH(); p_rows<ROW_C>(F, 0); }
            SEAM();
            NOSEAM(); NOSEAM();
        } else {
            if (IN_PH() && SITE(15)) REPEAT(15) { FRESH(); p_moe_cvt(F); }
            SEAM();
#pragma unroll 1
            for (int pass = 0; pass < 2; ++pass) {
                if (IN_PH() && SITE(16)) REPEAT(16) { FRESH();
                    pg8::SchedMoe S; S.c = (int)blockIdx.x; S.G = F.G; S.nN = 2 * DFF / 256; moe_tiles(F, S.cnt, S.tstart);
                    S.t0 = pass * MOE_PASS_TILES; S.t1 = S.tstart[8] < (pass + 1) * MOE_PASS_TILES ? S.tstart[8] : (pass + 1) * MOE_PASS_TILES;
                    S.A = (const char*)(F.ws + WS_H2B); S.lists = (const int*)(F.ws + WS_ROUTE + 1 * MiB); S.W = (const char*)(F.ws + WS_MOEW); S.w_tile = (size_t)256 * D * 2; S.gather = true;
                    pg8::EpiSwiGLU E{(bf16*)(F.ws + WS_ACT1), DFF};
                    pg8::gemm_phase<pg8::EpiSwiGLU, pg8::SchedMoe, D, D, D, true>(ring, F.tid, S, E);
                }
                SEAM();
                if (IN_PH() && SITE(17)) REPEAT(17) { FRESH();
                    pg8::SchedMoe S; S.c = (int)blockIdx.x; S.G = F.G; S.nN = D / 256; moe_tiles(F, S.cnt, S.tstart);
                    S.t0 = pass * MOE_PASS_TILES; S.t1 = S.tstart[8] < (pass + 1) * MOE_PASS_TILES ? S.tstart[8] : (pass + 1) * MOE_PASS_TILES;
                    S.A = (const char*)(F.ws + WS_ACT1); S.lists = nullptr; S.W = (const char*)(F.ws + WS_MOEW + SZ_WGU); S.w_tile = (size_t)256 * DFF * 2; S.gather = false;
                    pg8::EpiStore E{(bf16*)(F.ws + WS_Y), D, 0, 1.f};
                    pg8::gemm_phase<pg8::EpiStore, pg8::SchedMoe, DFF, DFF, DFF>(ring, F.tid, S, E);
                }
                SEAM();
            }
        }
    }

__global__ void __launch_bounds__(NWAVES * 64, 2) fwd_kernel(const Args args) {
    extern __shared__ __attribute__((aligned(16))) unsigned char lds[];
    Frame F;
    F.lds = (LAS unsigned char*)lds;
    F.MISC = (volatile LAS unsigned*)(F.lds + MISC_OFF);
    F.tid = threadIdx.x; F.lane = F.tid & 63; F.wave = __builtin_amdgcn_readfirstlane(F.tid >> 6);
    F.G = gridDim.x; { const int bx = blockIdx.x; F.vcu = (F.G % 8 == 0) ? (bx % 8) * (F.G / 8) + bx / 8 : bx; }
    F.ws = args.ws; F.out = args.out; F.ctl = (gu32*)(args.ws + WS_CTL);
    F.in = args.in;
    if (F.tid < 64) ((LAS unsigned*)(F.lds + MISC_OFF))[F.tid] = 0u;
    __syncthreads();
    XcdBarrier bar; bar.bar = (unsigned*)(F.ctl + CW_BAR); bar.x = 0; bar.st = nullptr;
    if (!MK_SPLIT) bar = xcd_barrier_post((unsigned*)(F.ctl + CW_BAR), F.MISC + 8);
    const int lo = args.ph_lo, hi = args.ph_hi;
    int pid = 0;
    LAS unsigned char* ring = F.lds + RING_OFF;

    if (IN_PH() && SITE(0)) REPEAT(0) { FRESH(); p_prologue(F); }
    SEAM();
    layer_phases<0>(F, args, bar, lo, hi, pid);
    layer_phases<1>(F, args, bar, lo, hi, pid);
    if (IN_PH() && SITE(18)) REPEAT(18) { FRESH(); p_rows<ROW_C>(F, 1); }
#undef IN_PH
#undef SEAM
#undef NOSEAM
}

extern "C" void kernel_launch(void* const* d_in, const int* in_sizes, int n_in, void* d_out, int out_size, void* d_ws, size_t ws_size, hipStream_t stream) {
    static int grid = 0;
    if (grid == 0) {
        if (n_in != N_INPUTS || in_sizes[0] != NTOK * D || out_size != NTOK * D || ws_size < WS_END) {
            fprintf(stderr, "kernel_launch: unexpected problem (n_in %d, in0 %d, out %d, ws %zu < %zu); nothing launched\n", n_in, n_in > 0 ? in_sizes[0] : -1, out_size, ws_size, (size_t)WS_END); grid = -1; return; }
        int dev = 0, cus = 0, per_cu = 0;
        if (hipGetDevice(&dev) != hipSuccess || hipDeviceGetAttribute(&cus, hipDeviceAttributeMultiprocessorCount, dev) != hipSuccess) { grid = -1; return; }
        if (hipFuncSetAttribute((const void*)fwd_kernel, hipFuncAttributeMaxDynamicSharedMemorySize, LDS_BYTES) != hipSuccess) { fprintf(stderr, "kernel_launch: hipFuncSetAttribute failed\n"); grid = -1; return; }
        if (hipOccupancyMaxActiveBlocksPerMultiprocessor(&per_cu, (const void*)fwd_kernel, NWAVES * 64, LDS_BYTES) != hipSuccess || per_cu < 1)
            fprintf(stderr, "kernel_launch: note: occupancy query reports %d workgroups per CU\n", per_cu);
        (void)hipGetLastError();
        grid = cus;
    }
    if (grid < 0) return;
    if (hipMemsetAsync((char*)d_ws + WS_CTL, 0, CTL_ZERO_BYTES, stream) != hipSuccess) return;
    Args a{};
    for (int i = 0; i < 30; ++i) a.in[i] = (const float*)d_in[i];
    a.out = (float*)d_out; a.ws = (unsigned char*)d_ws;
#if MK_SPLIT
    for (int p = 0; p < N_PHASES; ++p) { a.ph_lo = p; a.ph_hi = p + 1; hipLaunchKernelGGL(fwd_kernel, dim3(grid), dim3(NWAVES * 64), LDS_BYTES, stream, a); }
#else
    a.ph_lo = 0; a.ph_hi = N_PHASES;
    hipLaunchKernelGGL(fwd_kernel, dim3(grid), dim3(NWAVES * 64), LDS_BYTES, stream, a);
#endif
}
```

```cpp
#include <hip/hip_runtime.h>
#include <cstdio>
#include <cstdint>

namespace pg8 {
#define PG8_LAS __attribute__((address_space(3)))
typedef unsigned short bf16_t;
typedef short bf16x8 __attribute__((ext_vector_type(8)));
typedef float f32x4 __attribute__((ext_vector_type(4)));
typedef unsigned u32x4 __attribute__((ext_vector_type(4)));
typedef unsigned u32x2 __attribute__((ext_vector_type(2)));
typedef int i32x4 __attribute__((ext_vector_type(4)));
constexpr int BM = 256, BK = 64, HALF = 128, HTB = HALF * BK * 2  , STAGE_BYTES = 8 * HTB;

__host__ __device__ __forceinline__ int lds_byte(int r, int c) { const int st = (r >> 4) * 2 + (c >> 5), rr = r & 15, cc = c & 31, ob = rr * 64 + cc * 2; return st * 1024 + (ob ^ (((ob >> 9) & 1) << 5)); }
__host__ __device__ __forceinline__ void stage_rc(int b, int& R, int& C) { const int st = b / 1024, sb = b % 1024, swz = sb ^ (((sb >> 9) & 1) << 5); R = (st >> 1) * 16 + swz / 64; C = (st & 1) * 32 + (swz % 64) / 2; }
__host__ __device__ __forceinline__ int perm32(int rho) { const int n = rho >> 4, i = rho & 15; return 8 * (i >> 2) + 4 * n + (i & 3); }

struct Unit { int pm, pn, aux, pad; const char* a; const char* b; const int* rows; };

__device__ __forceinline__ unsigned cvt_pk_bf16(float lo, float hi) { unsigned r; asm volatile("v_cvt_pk_bf16_f32 %0, %1, %2" : "=v"(r) : "v"(lo), "v"(hi)); return r; }


template <class Epi, class Sched, int K, int lda, int ldb, bool GATHER = false, bool FP8 = false, bool ALIGN_EPI = true, bool SP2 = true>
__device__ __forceinline__ void gemm_phase(PG8_LAS unsigned char* lds, const int tid, const Sched& S, const Epi& E) {
    const int wid = __builtin_amdgcn_readfirstlane(tid >> 6), lane = tid & 63, wr = wid >> 2, wc = wid & 3, fr = lane & 15, fq = lane >> 4;
    constexpr int nt = K / BK;
    int Rs[2], Cs[2]; unsigned voffB[2];
#pragma unroll
    for (int i = 0; i < 2; ++i) { int R, C; stage_rc(tid * 16 + i * 8192, R, C); const int Rb = Epi::PERM ? ((R & ~31) + perm32(R & 31)) : R; Rs[i] = R; Cs[i] = C; voffB[i] = (unsigned)(Rb * ldb + C) * 2u; }
    const size_t kstep = (size_t)(BK * 2);
    const size_t hstepB = (size_t)HALF * ldb * 2;
    constexpr unsigned hstepA = GATHER ? 0u : (unsigned)HALF * lda * 2u;
    const unsigned ldsw = (unsigned)wid * 1024u;
    const int aoff = lds_byte(wr * 64 + fr, fq * 8), boff = lds_byte(wc * 32 + fr, fq * 8);
#define PG8_SA(b, h) (((b) * 2 + (h)) * HTB)
#define PG8_SB(b, h) ((4 + (b) * 2 + (h)) * HTB)
#define PG8_RSRC(p) __builtin_amdgcn_make_buffer_rsrc((void*)(p), 0, 0x7fffffff, 0x00020000)
#define PG8_STAGE(bufoff, gbase, soff, voff) do { const __amdgpu_buffer_rsrc_t r_ = PG8_RSRC(gbase); _Pragma("unroll") for (int _i = 0; _i < 2; ++_i) \
        __builtin_amdgcn_raw_ptr_buffer_load_lds(r_, (PG8_LAS unsigned*)(lds + (bufoff) + ldsw + _i * 8192), 16, (voff)[_i], (int)(soff), 0, 0); } while (0)
#define PG8_LDA(dst, b, h) do { _Pragma("unroll") for (int m = 0; m < 4; ++m) _Pragma("unroll") for (int k = 0; k < 2; ++k) dst[m][k] = *(const PG8_LAS bf16x8*)(lds + PG8_SA(b, h) + aoff + m * 2048 + k * 1024); } while (0)
#define PG8_LDB(dst, b, h) do { _Pragma("unroll") for (int n = 0; n < 2; ++n) _Pragma("unroll") for (int k = 0; k < 2; ++k) dst[n][k] = *(const PG8_LAS bf16x8*)(lds + PG8_SB(b, h) + boff + n * 2048 + k * 1024); } while (0)
#define PG8_CAT(x0, x1) __builtin_shufflevector(__builtin_bit_cast(i32x4, (x0)), __builtin_bit_cast(i32x4, (x1)), 0, 1, 2, 3, 4, 5, 6, 7)
#define PG8_MMA(ai, bj, At, Bt) do { __builtin_amdgcn_s_setprio(1); _Pragma("unroll") for (int m = 0; m < 4; ++m) _Pragma("unroll") for (int n = 0; n < 2; ++n) { \
        if constexpr (FP8) acc[ai][bj][m][n] = __builtin_amdgcn_mfma_scale_f32_16x16x128_f8f6f4(PG8_CAT(Bt[n][0], Bt[n][1]), PG8_CAT(At[m][0], At[m][1]), acc[ai][bj][m][n], 0, 0, 0, 0x7f7f7f7f, 0, 0x7f7f7f7f); \
        else { _Pragma("unroll") for (int k = 0; k < 2; ++k) acc[ai][bj][m][n] = __builtin_amdgcn_mfma_f32_16x16x32_bf16(Bt[n][k], At[m][k], acc[ai][bj][m][n], 0, 0, 0); } } __builtin_amdgcn_s_setprio(0); } while (0)
#define PG8_WAIT_V(n) asm volatile("s_waitcnt vmcnt(" #n ")" ::: "memory")
#define PG8_WAIT_L(n) asm volatile("s_waitcnt lgkmcnt(" #n ")" ::: "memory")
#define PG8_BAR __builtin_amdgcn_s_barrier()
#define PG8_SCHED __builtin_amdgcn_sched_barrier(0)
    Unit cur, nxt; int ui = 0;
    if (!S.next(0, cur)) return;
    f32x4 acc[2][2][4][2];
#pragma unroll
    for (int a = 0; a < 2; ++a)
#pragma unroll
        for (int b = 0; b < 2; ++b)
#pragma unroll
            for (int m = 0; m < 4; ++m)
#pragma unroll
                for (int n = 0; n < 2; ++n) acc[a][b][m][n] = (f32x4){0.f, 0.f, 0.f, 0.f};
    bf16x8 At[4][2], B0[2][2], B1[2][2];
    unsigned cOff[2][2], nOff[2][2];
#pragma unroll
    for (int hh = 0; hh < 2; ++hh)
#pragma unroll
        for (int i = 0; i < 2; ++i) {
            if constexpr (GATHER) { const int ridx = hh * HALF + Rs[i]; int tk = cur.rows[ridx]; tk = ridx < cur.aux ? tk : 0; cOff[hh][i] = (unsigned)(tk * lda + Cs[i]) * 2u; }
            else cOff[hh][i] = (unsigned)(Rs[i] * lda + Cs[i]) * 2u;
            if constexpr (GATHER) nOff[hh][i] = cOff[hh][i]; else nOff[hh][i] = 0u;
        }
    const char* cA = cur.a; const char* cB = cur.b;
    S.a_ready(cur);
    if constexpr (SP2) {
        PG8_STAGE(PG8_SB(0, 0), cB, 0, voffB); PG8_STAGE(PG8_SB(0, 1), cB, hstepB, voffB); PG8_STAGE(PG8_SA(0, 0), cA, 0, cOff[0]); PG8_STAGE(PG8_SA(0, 1), cA, hstepA, cOff[GATHER ? 1 : 0]);
        if (wr == 1) PG8_BAR;
        PG8_WAIT_V(2); PG8_BAR;
        PG8_STAGE(PG8_SB(1, 0), cB, kstep, voffB); PG8_STAGE(PG8_SA(1, 0), cA, kstep, cOff[0]); PG8_STAGE(PG8_SB(1, 1), cB, hstepB + kstep, voffB);
        PG8_WAIT_V(6); PG8_BAR;
    } else {
        PG8_STAGE(PG8_SB(0, 0), cB, 0, voffB); PG8_STAGE(PG8_SA(0, 0), cA, 0, cOff[0]); PG8_STAGE(PG8_SB(0, 1), cB, hstepB, voffB); PG8_STAGE(PG8_SA(0, 1), cA, hstepA, cOff[GATHER ? 1 : 0]);
        if (wr == 1) PG8_BAR;
        PG8_WAIT_V(4); PG8_BAR;
        PG8_STAGE(PG8_SB(1, 0), cB, kstep, voffB); PG8_STAGE(PG8_SA(1, 0), cA, kstep, cOff[0]); PG8_STAGE(PG8_SB(1, 1), cB, hstepB + kstep, voffB);
        PG8_WAIT_V(6); PG8_BAR;
    }
    for (;;) {
        const bool has_next = S.next(ui + 1, nxt);
        const char* nA = has_next ? nxt.a : cA; const char* nB = has_next ? nxt.b : cB;
        if constexpr (GATHER) {
            if (has_next) {
#pragma unroll
                for (int hh = 0; hh < 2; ++hh)
#pragma unroll
                    for (int i = 0; i < 2; ++i) { const int ridx = hh * HALF + Rs[i]; int tk = nxt.rows[ridx]; tk = ridx < nxt.aux ? tk : 0; nOff[hh][i] = (unsigned)(tk * lda + Cs[i]) * 2u; }
            } else {
#pragma unroll
                for (int hh = 0; hh < 2; ++hh)
#pragma unroll
                    for (int i = 0; i < 2; ++i) nOff[hh][i] = cOff[hh][i];
            }
        }
#pragma unroll 1
        for (int t = 0; t < nt; t += 2) {
            const bool last = (t == nt - 2);
            const unsigned o1 = (unsigned)((t + 1) * kstep);
            const char* a2 = last ? nA : cA; const char* b2 = last ? nB : cB; const unsigned o2k = last ? 0u : (unsigned)((t + 2) * kstep), o3k = o2k + (unsigned)kstep;
            unsigned o2[2][2];
#pragma unroll
            for (int hh = 0; hh < 2; ++hh)
#pragma unroll
                for (int i = 0; i < 2; ++i) { if constexpr (GATHER) o2[hh][i] = last ? nOff[hh][i] : cOff[hh][i]; else o2[hh][i] = cOff[hh][i]; }
            if (last && has_next) S.a_ready(nxt);
            if constexpr (SP2) {
            PG8_LDB(B0, 0, 0); PG8_LDB(B1, 0, 1); PG8_SCHED; PG8_LDA(At, 0, 0); PG8_STAGE(PG8_SA(1, 1), cA, o1 + hstepA, cOff[GATHER ? 1 : 0]);
            PG8_WAIT_V(8); PG8_WAIT_L(0); PG8_BAR; PG8_MMA(0, 0, At, B0); PG8_MMA(0, 1, At, B1); PG8_BAR; PG8_SCHED;
            PG8_LDA(At, 0, 1); PG8_STAGE(PG8_SB(0, 0), b2, o2k, voffB); PG8_STAGE(PG8_SB(0, 1), b2, o2k + hstepB, voffB); PG8_STAGE(PG8_SA(0, 0), a2, o2k, o2[0]);
            PG8_WAIT_V(8); PG8_WAIT_L(0); PG8_BAR; PG8_MMA(1, 0, At, B0); PG8_MMA(1, 1, At, B1); PG8_BAR; PG8_SCHED;
            PG8_LDB(B0, 1, 0); PG8_LDB(B1, 1, 1); PG8_SCHED; PG8_LDA(At, 1, 0); PG8_STAGE(PG8_SA(0, 1), a2, o2k + hstepA, o2[GATHER ? 1 : 0]);
            PG8_WAIT_V(8); PG8_WAIT_L(0); PG8_BAR; PG8_MMA(0, 0, At, B0); PG8_MMA(0, 1, At, B1); PG8_BAR; PG8_SCHED;
            PG8_LDA(At, 1, 1); PG8_STAGE(PG8_SB(1, 0), b2, o3k, voffB); PG8_STAGE(PG8_SB(1, 1), b2, o3k + hstepB, voffB); PG8_STAGE(PG8_SA(1, 0), a2, o3k, o2[0]);
            PG8_WAIT_V(8); PG8_WAIT_L(0); PG8_BAR; PG8_MMA(1, 0, At, B0); PG8_MMA(1, 1, At, B1); PG8_BAR; PG8_SCHED;
            } else {
            PG8_LDB(B0, 0, 0); PG8_SCHED; PG8_LDA(At, 0, 0); PG8_STAGE(PG8_SA(1, 1), cA, o1 + hstepA, cOff[GATHER ? 1 : 0]);
            PG8_WAIT_L(8); PG8_BAR; PG8_WAIT_L(0); PG8_MMA(0, 0, At, B0); PG8_BAR; PG8_SCHED;
            PG8_LDB(B1, 0, 1); PG8_STAGE(PG8_SB(0, 0), b2, o2k, voffB);
            PG8_BAR; PG8_WAIT_L(0); PG8_MMA(0, 1, At, B1); PG8_BAR;
            PG8_LDA(At, 0, 1); PG8_STAGE(PG8_SA(0, 0), a2, o2k, o2[0]);
            PG8_BAR; PG8_WAIT_L(0); PG8_MMA(1, 0, At, B0); PG8_BAR; PG8_SCHED;
            PG8_STAGE(PG8_SB(0, 1), b2, o2k + hstepB, voffB);
            PG8_WAIT_V(6); PG8_BAR; PG8_MMA(1, 1, At, B1); PG8_BAR;
            PG8_LDB(B0, 1, 0); PG8_SCHED; PG8_LDA(At, 1, 0); PG8_STAGE(PG8_SA(0, 1), a2, o2k + hstepA, o2[GATHER ? 1 : 0]);
            PG8_WAIT_L(8); PG8_BAR; PG8_WAIT_L(0); PG8_MMA(0, 0, At, B0); PG8_BAR; PG8_SCHED;
            PG8_LDB(B1, 1, 1); PG8_STAGE(PG8_SB(1, 0), b2, o3k, voffB);
            PG8_BAR; PG8_WAIT_L(0); PG8_MMA(0, 1, At, B1); PG8_BAR;
            PG8_LDA(At, 1, 1); PG8_STAGE(PG8_SA(1, 0), a2, o3k, o2[0]);
            PG8_BAR; PG8_WAIT_L(0); PG8_MMA(1, 0, At, B0); PG8_BAR; PG8_SCHED;
            PG8_STAGE(PG8_SB(1, 1), b2, o3k + hstepB, voffB);
            PG8_WAIT_V(6); PG8_BAR; PG8_MMA(1, 1, At, B1); PG8_BAR;
            }
        }
        if constexpr (ALIGN_EPI) { if (wr == 0) PG8_BAR; }
        E(acc, cur, wr, wc, fr, fq); S.done(cur);
        if (!has_next) break;
#pragma unroll
        for (int a = 0; a < 2; ++a)
#pragma unroll
            for (int b = 0; b < 2; ++b)
#pragma unroll
                for (int m = 0; m < 4; ++m)
#pragma unroll
                    for (int n = 0; n < 2; ++n) acc[a][b][m][n] = (f32x4){0.f, 0.f, 0.f, 0.f};
        cur = nxt; cA = nA; cB = nB; ++ui;
        if constexpr (GATHER) {
#pragma unroll
            for (int hh = 0; hh < 2; ++hh)
#pragma unroll
                for (int i = 0; i < 2; ++i) cOff[hh][i] = nOff[hh][i];
        }
        if constexpr (ALIGN_EPI) { if (wr == 1) PG8_BAR; }
    }
    PG8_WAIT_V(0);
    if constexpr (!ALIGN_EPI) { if (wr == 0) PG8_BAR; }
    PG8_BAR;
#undef PG8_SA
#undef PG8_SB
#undef PG8_STAGE
#undef PG8_RSRC
#undef PG8_LDA
#undef PG8_LDB
#undef PG8_MMA
#undef PG8_CAT
#undef PG8_WAIT_V
#undef PG8_WAIT_L
#undef PG8_BAR
#undef PG8_SCHED
}
}

constexpr int NWAVES = 8;
constexpr int BATCH = 2, SEQ = 16384, D = 1024, NTOK = BATCH * SEQ;
constexpr int NLAYER = 2;
constexpr int NPROJ = 2816, IN_COLS = 2832;
constexpr int PJ = 2048;
constexpr int C_PIN = 0, C_CB = 256, C_CC = 512, C_CX = 768, C_DQ = 1024, C_DK = 1280, C_DV = 1536, C_DZ = 1792;
constexpr int DFF = 2816, NEXP = 8;
constexpr int NCHUNK = SEQ / 64;
constexpr int NINST = BATCH * 4 * 2 * NCHUNK;
constexpr float EPS = 1e-6f;
constexpr float QSCALE = 0.17677669529663687f * 1.4426950408889634f;
#ifndef MOE_FP8
#define MOE_FP8 1
#endif
constexpr float W8SCALE = 64.f;
constexpr int MOE_PASS_TILES = MOE_FP8 ? 264 : 132;
constexpr int MOE_NPASS = MOE_FP8 ? 1 : 2;

constexpr size_t MiB = 1u << 20;
constexpr size_t WS_CTL = 0, CTL_ZERO_BYTES = 1 * MiB;
constexpr size_t SZ_WIN = (size_t)NPROJ * D * 2, SZ_WM = (size_t)4096 * D * 2, SZ_WB = (size_t)4 * 1024 * 256 * 2, SZ_WO = (size_t)D * D * 2;
constexpr size_t SZ_LAYERW = SZ_WIN + SZ_WM + SZ_WB + SZ_WO;
constexpr size_t SZ_WGU = (size_t)2 * DFF * D * 2, SZ_WD = (size_t)D * DFF * 2, SZ_FFNW = SZ_WGU + SZ_WD;
constexpr size_t WS_W = 1 * MiB;
constexpr size_t WS_WFFN = WS_W + 2 * SZ_LAYERW;
static_assert(WS_WFFN + SZ_FFNW <= 53 * MiB, "weights");
constexpr size_t WS_H = 53 * MiB;
constexpr size_t WS_O4 = 117 * MiB;
constexpr size_t WS_F = WS_O4;
constexpr size_t WS_BD = 181 * MiB;
constexpr size_t WS_DEC = 183 * MiB;
constexpr size_t WS_PROJ = 185 * MiB;
constexpr size_t WS_QB = 521 * MiB;
constexpr size_t WS_KV = 313 * MiB;
constexpr size_t WS_UW = 361 * MiB;
constexpr size_t WS_AB = 425 * MiB;
constexpr size_t WS_ST = 489 * MiB;
constexpr size_t WS_PBUF = 185 * MiB;
constexpr size_t WS_MERGED = 441 * MiB;
constexpr size_t WS_ACT0 = 185 * MiB;
constexpr size_t WS_H2B = 479 * MiB;
constexpr size_t WS_MOEW = 185 * MiB;
constexpr size_t WS_XG = 251 * MiB;
constexpr size_t WS_ACT1 = 1 * MiB;
constexpr size_t WS_Y = 317 * MiB;
constexpr size_t WS_ROUTE = 449 * MiB;
constexpr size_t WS_END = 543 * MiB;
static_assert(WS_ACT1 + (size_t)MOE_PASS_TILES * 256 * DFF * (MOE_FP8 ? 1 : 2) <= WS_MOEW, "act1");
static_assert((MOE_FP8 ? WS_XG + (size_t)264 * 256 * D : WS_MOEW + 8 * SZ_FFNW) <= WS_Y && WS_MOEW + 8 * SZ_FFNW / 2 <= WS_XG && WS_Y + (size_t)264 * 256 * D * 2 <= WS_ROUTE && WS_ROUTE + 4 * MiB <= WS_H2B && WS_H2B + 64 * MiB <= WS_END, "moe map");
static_assert(WS_PROJ + (size_t)NTOK * PJ * 2 <= WS_KV && WS_KV + (size_t)8 * 256 * 19456 <= WS_UW && WS_QB + 16 * MiB <= WS_END && WS_ST + (size_t)NINST * 8192 <= WS_END, "mixer map");
constexpr int CW_TMO = 0, CW_CODE = 1;
constexpr int CW_BAR = 4096;
constexpr int CW_MOD = 16384;
constexpr int CW_MOECNT = 65536;
constexpr int CW_NMAX = 66560;
constexpr int CW_MODCNT = 66624;
constexpr int CW_ATTQ = 66688;
static_assert(CW_MOD + NLAYER * BATCH * 6 * D <= CW_MOECNT && (CW_ATTQ + 32 * 64) * 4 <= (int)CTL_ZERO_BYTES, "ctl");

constexpr int RING_OFF = 0, RING_BYTES = 131072;
constexpr int LDS_BYTES = 160 * 1024;
constexpr int MISC_OFF = LDS_BYTES - 256;

#define GAS __attribute__((address_space(1)))
#define LAS __attribute__((address_space(3)))
typedef unsigned short bf16;
typedef unsigned v4u __attribute__((ext_vector_type(4)));
typedef unsigned v2u __attribute__((ext_vector_type(2)));
typedef float f32x4 __attribute__((ext_vector_type(4)));
typedef float f32x16 __attribute__((ext_vector_type(16)));
typedef short bf16x8 __attribute__((ext_vector_type(8)));
typedef short bf16x4 __attribute__((ext_vector_type(4)));
typedef GAS unsigned gu32;
#define RLX_AGENT __ATOMIC_RELAXED, __HIP_MEMORY_SCOPE_AGENT
#define LDS_WAIT() asm volatile("s_waitcnt lgkmcnt(0)" ::: "memory")
#define VM_WAIT() asm volatile("s_waitcnt vmcnt(0)" ::: "memory")
__device__ __forceinline__ unsigned f2bf(float f) { unsigned u = __builtin_bit_cast(unsigned, f); return (u + 0x7fffu + ((u >> 16) & 1u)) >> 16; }
__device__ __forceinline__ unsigned pk2(float lo, float hi) { return f2bf(lo) | (f2bf(hi) << 16); }
__device__ __forceinline__ float bf2f(unsigned b) { return __builtin_bit_cast(float, b << 16); }
__device__ __forceinline__ float bflo(unsigned w) { return __builtin_bit_cast(float, w << 16); }
__device__ __forceinline__ float bfhi(unsigned w) { return __builtin_bit_cast(float, w & 0xffff0000u); }
__device__ __forceinline__ float fast_exp2(float x) { return __builtin_amdgcn_exp2f(x); }
__device__ __forceinline__ float fast_exp(float x) { return __builtin_amdgcn_exp2f(x * 1.4426950408889634f); }
__device__ __forceinline__ float fast_rcp(float x) { return __builtin_amdgcn_rcpf(x); }
__device__ __forceinline__ float sigmoidf_(float x) { return fast_rcp(1.f + fast_exp(-x)); }
__device__ __forceinline__ float siluf_(float x) { return x * sigmoidf_(x); }
__device__ __forceinline__ float wave_sum(float v) {
    v += __builtin_bit_cast(float, __builtin_amdgcn_update_dpp(0, __builtin_bit_cast(int, v), 0xB1, 0xf, 0xf, true));
    v += __builtin_bit_cast(float, __builtin_amdgcn_update_dpp(0, __builtin_bit_cast(int, v), 0x4E, 0xf, 0xf, true));
    v += __builtin_bit_cast(float, __builtin_amdgcn_update_dpp(0, __builtin_bit_cast(int, v), 0x141, 0xf, 0xf, true));
    v += __builtin_bit_cast(float, __builtin_amdgcn_update_dpp(0, __builtin_bit_cast(int, v), 0x140, 0xf, 0xf, true));
    v += __builtin_bit_cast(float, __builtin_amdgcn_ds_swizzle(__builtin_bit_cast(int, v), 0x401f));
    v += __shfl_xor(v, 32);
    return v;
}

#define XB_TMO      128
#define XB_XCNT(j)  (256  + 64 * (j))
#define XB_XSUB(j)  (1280 + 64 * (j))
#define XB_XGEN(j)  (2304 + 64 * (j))
#define XB_TOP      3328
#define XB_TOPGEN   3392
#define XCD_BAR_WORDS 3456
#define XB_SPIN_CAP (1u << 22)
__device__ __forceinline__ unsigned xb_ld(unsigned* p)              { return __hip_atomic_load(p, __ATOMIC_RELAXED, __HIP_MEMORY_SCOPE_AGENT); }
__device__ __forceinline__ unsigned xb_add(unsigned* p, unsigned v) { return __hip_atomic_fetch_add(p, v, __ATOMIC_RELAXED, __HIP_MEMORY_SCOPE_AGENT); }
__device__ __forceinline__ unsigned xb_xcc_id() { return (unsigned)__builtin_amdgcn_s_getreg((3 << 11) | 20) & 0xFu; }
#define XB_SPIN(cond, bar) do { unsigned _sp = 0; while (cond) { __builtin_amdgcn_s_sleep(1); \
    if ((++_sp & 255u) == 0u) { if (xb_ld(&(bar)[XB_TMO])) break; if (_sp > XB_SPIN_CAP) { atomicAdd(&(bar)[XB_TMO], 1u); break; } } } } while (0)
struct XcdBarrier { unsigned* bar; unsigned x; volatile LAS unsigned* st; };
__device__ __forceinline__ XcdBarrier xcd_barrier_post(unsigned* bar, volatile LAS unsigned* st) {
    XcdBarrier b; b.bar = bar; b.x = xb_xcc_id(); b.st = st;
    if (threadIdx.x == 0) (void)xb_add(&bar[XB_XCNT(b.x)], 1u);
    return b;
}
__device__ __forceinline__ void xcd_barrier_complete(unsigned* bar, unsigned x, unsigned& nloc, unsigned& nx) {
    const unsigned G = gridDim.x * gridDim.y * gridDim.z;
    unsigned sum, cnt, mine, sp = 0u;
    for (;;) {
        sum = 0u; cnt = 0u; mine = 0u;
#pragma unroll
        for (unsigned j = 0; j < 16; ++j) { const unsigned c = xb_ld(&bar[XB_XCNT(j)]); sum += c; cnt += (c > 0u) ? 1u : 0u; }
        mine = xb_ld(&bar[XB_XCNT(x)]);
        if (sum == G) break;
        __builtin_amdgcn_s_sleep(1);
        if ((++sp & 255u) == 0u) { if (xb_ld(&bar[XB_TMO])) break; if (sp > XB_SPIN_CAP) { atomicAdd(&bar[XB_TMO], 1u); break; } }
    }
    nloc = mine > 0u ? mine : 1u; nx = cnt > 0u ? cnt : 1u;
}
__device__ __forceinline__ void xcd_barrier(const XcdBarrier& b) {
    asm volatile("s_waitcnt vmcnt(0)" ::: "memory");
    __syncthreads();
    if (threadIdx.x == 0) {
        unsigned* bar = b.bar;
        __builtin_amdgcn_s_waitcnt(0);
        unsigned nloc = b.st[0], nx = b.st[1];
        if (nloc == 0u) { xcd_barrier_complete(bar, b.x, nloc, nx); b.st[0] = nloc; b.st[1] = nx; }
        const unsigned old = xb_add(&bar[XB_XSUB(b.x)], 1u);
        const unsigned gen = old / nloc;
        if (old + 1u == (gen + 1u) * nloc) {
            __builtin_amdgcn_fence(__ATOMIC_RELEASE, "agent");
            asm volatile("s_waitcnt vmcnt(0)" ::: "memory");
            const unsigned og = xb_add(&bar[XB_TOP], 1u);
            const unsigned tg = og / nx;
            if (og + 1u == (tg + 1u) * nx) xb_add(&bar[XB_TOPGEN], 1u);
            else XB_SPIN(xb_ld(&bar[XB_TOPGEN]) == tg, bar);
            __builtin_amdgcn_fence(__ATOMIC_ACQUIRE, "agent");
            xb_add(&bar[XB_XGEN(b.x)], 1u);
            asm volatile("s_waitcnt vmcnt(0)" ::: "memory");
        } else {
            XB_SPIN(xb_ld(&bar[XB_XGEN(b.x)]) == gen, bar);
            __builtin_amdgcn_fence(__ATOMIC_ACQUIRE, "agent");
            asm volatile("s_waitcnt vmcnt(0)" ::: "memory");
        }
    }
    __syncthreads();
}

struct Frame {
    LAS unsigned char* lds;
    volatile LAS unsigned* MISC;
    gu32* ctl;
    int tid, lane, wave;
    int vcu, G;
    unsigned char* ws;
    float* out;
    const float* const* in;
};
enum { I_X = 0, I_C, I_ADAW, I_ADAB, I_NMIXPRE, I_NMIXPOST, I_NFFNPRE, I_NFFNPOST, I_WIN, I_DLAMBDA, I_DSUBLN, I_POOLW, I_POOLSCALE, I_SCONVW, I_DCONVW, I_DALOG, I_DDTBIAS, I_DNORM,
       I_WBRANCH, I_WMERGE, I_BMERGE, I_WO, I_FFNG, I_FFNU, I_FFND, I_ROUTERW, I_ROUTERB, I_MOEG, I_MOEU, I_MOED, N_INPUTS };

__device__ __forceinline__ unsigned pk4_fp8(float a, float b, float c, float d) { int w = __builtin_amdgcn_cvt_pk_fp8_f32(a, b, 0, false); w = __builtin_amdgcn_cvt_pk_fp8_f32(c, d, w, true); return (unsigned)w; }
template <bool F8 = false> __device__ __forceinline__ void cvt_item(const float* W, int ldw, int k0, int n0, bf16* WT, int Kd, int drow0, LAS float* scr, int lane) {
#pragma unroll 8
    for (int i = 0; i < 32; ++i) { const int kk = 2 * i + (lane >> 5); scr[kk * 33 + (lane & 31)] = W[(size_t)(k0 + kk) * ldw + n0 + (lane & 31)]; }
    LDS_WAIT(); asm volatile("" ::: "memory");
    const int c = lane & 7;
#pragma unroll
    for (int j = 0; j < 4; ++j) { const int n = (lane >> 3) + 8 * j; const LAS float* s = scr + (8 * c) * 33 + n;
        if constexpr (F8) { v2u o; o.x = pk4_fp8(s[0 * 33] * W8SCALE, s[1 * 33] * W8SCALE, s[2 * 33] * W8SCALE, s[3 * 33] * W8SCALE); o.y = pk4_fp8(s[4 * 33] * W8SCALE, s[5 * 33] * W8SCALE, s[6 * 33] * W8SCALE, s[7 * 33] * W8SCALE);
            *(GAS v2u*)((unsigned char*)WT + (size_t)(drow0 + n) * Kd + k0 + 8 * c) = o; }
        else { v4u o; o.x = pk2(s[0 * 33], s[1 * 33]); o.y = pk2(s[2 * 33], s[3 * 33]); o.z = pk2(s[4 * 33], s[5 * 33]); o.w = pk2(s[6 * 33], s[7 * 33]);
            *(GAS v4u*)(WT + (size_t)(drow0 + n) * Kd + k0 + 8 * c) = o; } }
    LDS_WAIT(); asm volatile("" ::: "memory");
}
template <bool F8 = false> __device__ __forceinline__ void cvt_ffn_item(const float* wg, const float* wu, const float* wd, bf16* Wgu, bf16* Wd, int r, LAS float* scr, int lane) {
    constexpr int IG = (D / 64) * (DFF / 32);
    if (r < IG) { const int kb = r / (DFF / 32), nb = r % (DFF / 32), n0 = nb * 32; cvt_item<F8>(wg, DFF, kb * 64, n0, Wgu, D, 256 * (n0 >> 7) + (n0 & 127), scr, lane); return; } r -= IG;
    if (r < IG) { const int kb = r / (DFF / 32), nb = r % (DFF / 32), n0 = nb * 32; cvt_item<F8>(wu, DFF, kb * 64, n0, Wgu, D, 256 * (n0 >> 7) + (n0 & 127) + 128, scr, lane); return; } r -= IG;
    { const int kb = r / (D / 32), nb = r % (D / 32); cvt_item<F8>(wd, D, kb * 64, nb * 32, Wd, DFF, nb * 32, scr, lane); }
}
constexpr int FFN_ITEMS = 3 * (D / 64) * (DFF / 32);
__device__ __forceinline__ bf16* w_in_t(unsigned char* ws, int l) { return (bf16*)(ws + WS_W + (size_t)l * SZ_LAYERW); }
__device__ __forceinline__ bf16* w_m_t(unsigned char* ws, int l) { return (bf16*)(ws + WS_W + (size_t)l * SZ_LAYERW + SZ_WIN); }
__device__ __forceinline__ bf16* w_b_t(unsigned char* ws, int l) { return (bf16*)(ws + WS_W + (size_t)l * SZ_LAYERW + SZ_WIN + SZ_WM); }
__device__ __forceinline__ bf16* w_o_t(unsigned char* ws, int l) { return (bf16*)(ws + WS_W + (size_t)l * SZ_LAYERW + SZ_WIN + SZ_WM + SZ_WB); }

__device__ __forceinline__ void p_prologue(Frame& F) {
    LAS float* scr = (LAS float*)(F.lds + RING_OFF + F.wave * 16384);
    const int gw = F.vcu * NWAVES + F.wave, NGW = F.G * NWAVES;
    constexpr int I_IN = (D / 64) * (NPROJ / 32), I_M = (D / 64) * (D / 32), I_B = (256 / 64) * (D / 32);
    constexpr int PER_LAYER = I_IN + 4 * I_M + 4 * I_B + I_M;
    constexpr int NITEMS = NLAYER * PER_LAYER + FFN_ITEMS;
    for (int it = gw; it < NITEMS; it += NGW) {
        int r = it;
        if (r >= NLAYER * PER_LAYER) { r -= NLAYER * PER_LAYER;
            cvt_ffn_item(F.in[I_FFNG], F.in[I_FFNU], F.in[I_FFND], (bf16*)(F.ws + WS_WFFN), (bf16*)(F.ws + WS_WFFN + SZ_WGU), r, scr, F.lane); continue; }
        const int l = r / PER_LAYER; r -= l * PER_LAYER;
        if (r < I_IN) { const int kb = r / (NPROJ / 32), nb = r % (NPROJ / 32); cvt_item(F.in[I_WIN] + (size_t)l * D * IN_COLS, IN_COLS, kb * 64, nb * 32, w_in_t(F.ws, l), D, nb * 32, scr, F.lane); continue; } r -= I_IN;
        if (r < 4 * I_M) { const int i = r / I_M; r -= i * I_M; const int kb = r / (D / 32), nb = r % (D / 32);
            cvt_item(F.in[I_WMERGE] + ((size_t)l * 4 + i) * D * D, D, kb * 64, nb * 32, w_m_t(F.ws, l), D, i * 1024 + nb * 32, scr, F.lane); continue; } r -= 4 * I_M;
        if (r < 4 * I_B) { const int i = r / I_B; r -= i * I_B; const int kb = r / (D / 32), nb = r % (D / 32);
            cvt_item(F.in[I_WBRANCH] + ((size_t)l * 4 + i) * 256 * D, D, kb * 64, nb * 32, w_b_t(F.ws, l) + (size_t)i * 1024 * 256, 256, nb * 32, scr, F.lane); continue; } r -= 4 * I_B;
        { const int kb = r / (D / 32), nb = r % (D / 32); cvt_item(F.in[I_WO] + (size_t)l * D * D, D, kb * 64, nb * 32, w_o_t(F.ws, l), D, nb * 32, scr, F.lane); }
    }
    constexpr int MOD_ITEMS = NLAYER * 24 * 16;
    for (int it = gw; it < MOD_ITEMS; it += NGW) {
        const int grp = it >> 4, kc = it & 15, l = grp / 24, nb = grp % 24;
        const float* Wp = F.in[I_ADAW] + ((size_t)l * D + kc * 64) * (6 * D) + nb * 256 + F.lane * 4;
        f32x4 a0 = {0.f, 0.f, 0.f, 0.f}, a1 = {0.f, 0.f, 0.f, 0.f};
#pragma unroll 8
        for (int k = 0; k < 64; ++k) { const f32x4 w = *(const GAS f32x4*)(Wp + (size_t)k * (6 * D));
            const float c0 = siluf_(F.in[I_C][kc * 64 + k]), c1 = siluf_(F.in[I_C][D + kc * 64 + k]); a0 += w * c0; a1 += w * c1; }
        float* part = (float*)(F.ws + WS_BD) + ((size_t)grp * 16 + kc) * 512 + F.lane * 4;
        *(GAS f32x4*)part = a0; *(GAS f32x4*)(part + 256) = a1;
        __threadfence();
        unsigned old = 0;
        if (F.lane == 0) old = __hip_atomic_fetch_add(F.ctl + CW_MODCNT + grp, 1u, RLX_AGENT);
        old = __builtin_amdgcn_readfirstlane(old);
        if (old == 15u) {
            __threadfence();
            f32x4 s0 = {0.f, 0.f, 0.f, 0.f}, s1 = {0.f, 0.f, 0.f, 0.f};
            const float* pg = (const float*)(F.ws + WS_BD) + (size_t)grp * 16 * 512 + F.lane * 4;
#pragma unroll
            for (int q = 0; q < 16; ++q) { s0 += __builtin_nontemporal_load((const f32x4*)(pg + q * 512)); s1 += __builtin_nontemporal_load((const f32x4*)(pg + q * 512 + 256)); }
            float* m0 = (float*)(F.ctl + CW_MOD) + (size_t)(l * BATCH + 0) * 6 * D + nb * 256 + F.lane * 4;
            *(GAS f32x4*)m0 = s0; *(GAS f32x4*)(m0 + 6 * D) = s1;
        }
    }
}
__device__ __forceinline__ void moe_tiles(Frame& F, int (&cnt)[NEXP], int (&tstart)[NEXP + 1]) {
    int acc = 0;
#pragma unroll
    for (int e = 0; e < NEXP; ++e) { cnt[e] = __builtin_amdgcn_readfirstlane((int)__hip_atomic_load(F.ctl + CW_MOECNT + 64 * e, RLX_AGENT)); tstart[e] = acc; acc += (cnt[e] + 255) >> 8; }
    tstart[NEXP] = acc;
}
__device__ __forceinline__ void p_moe_cvt(Frame& F) {
    LAS float* scr = (LAS float*)(F.lds + RING_OFF + F.wave * 16384);
    const int gw = F.vcu * NWAVES + F.wave, NGW = F.G * NWAVES;
    for (int it = gw; it < NEXP * FFN_ITEMS; it += NGW) {
        const int e = it / FFN_ITEMS, r = it % FFN_ITEMS;
        unsigned char* base = F.ws + WS_MOEW + (size_t)e * (MOE_FP8 ? SZ_FFNW / 2 : SZ_FFNW);
        cvt_ffn_item<MOE_FP8 != 0>(F.in[I_MOEG] + (size_t)e * D * DFF, F.in[I_MOEU] + (size_t)e * D * DFF, F.in[I_MOED] + (size_t)e * DFF * D, (bf16*)base, (bf16*)(base + (MOE_FP8 ? SZ_WGU / 2 : SZ_WGU)), r, scr, F.lane);
    }
#if MOE_FP8
    int cnt[NEXP], tstart[NEXP + 1]; moe_tiles(F, cnt, tstart);
    const int* lists = (const int*)(F.ws + WS_ROUTE + 1 * MiB);
    for (int gs = gw; gs < tstart[NEXP] * 256; gs += NGW) {
        const int t = gs >> 8; int e = 0;
#pragma unroll
        for (int k = 1; k < NEXP; ++k) e = (t >= tstart[k]) ? k : e;
        int ts = 0, ce = 0;
#pragma unroll
        for (int k = 0; k < NEXP; ++k) { ts = (k == e) ? tstart[k] : ts; ce = (k == e) ? cnt[k] : ce; }
        const int i = (t - ts) * 256 + (gs & 255);
        int tok = lists[(size_t)e * 65536 + i]; tok = i < ce ? tok : 0;
        const v4u v = *(const GAS v4u*)(F.ws + WS_H2B + (size_t)tok * D + F.lane * 16);
        *(GAS v4u*)(F.ws + WS_XG + (size_t)gs * D + F.lane * 16) = v;
    }
#endif
}

struct Row { f32x4 v[4]; };
__device__ __forceinline__ float modv(Frame& F, int l, int b, int idx) { return ((const float*)(F.ctl + CW_MOD))[(size_t)(l * BATCH + b) * 6 * D + idx] + F.in[I_ADAB][l * 6 * D + idx]; }
__device__ __forceinline__ f32x4 modv4(Frame& F, int l, int b, int idx) {
    const f32x4 a = *(const GAS f32x4*)((const float*)(F.ctl + CW_MOD) + (size_t)(l * BATCH + b) * 6 * D + idx), c = *(const GAS f32x4*)(F.in[I_ADAB] + l * 6 * D + idx); return a + c; }
__device__ __forceinline__ float row_rstd(const Row& r) {
    float s = 0.f;
#pragma unroll
    for (int j = 0; j < 4; ++j) s += (r.v[j].x * r.v[j].x + r.v[j].y * r.v[j].y) + (r.v[j].z * r.v[j].z + r.v[j].w * r.v[j].w);
    return 1.f / sqrtf(wave_sum(s) * (1.f / D) + EPS);
}
__device__ __forceinline__ void row_resid(Frame& F, Row& x, const Row& f, const float* gain, int l, int b, int gidx) {
    const float rs = row_rstd(f);
#pragma unroll
    for (int j = 0; j < 4; ++j) { const int c = 4 * F.lane + 256 * j; const f32x4 g = *(const GAS f32x4*)(gain + c), m = modv4(F, l, b, gidx + c); x.v[j] += m * (f.v[j] * rs * g); }
}
__device__ __forceinline__ void row_make_h(Frame& F, Row& h, const Row& x, const float* gain, int l, int b, int shidx, int scidx) {
    const float rs = row_rstd(x);
#pragma unroll
    for (int j = 0; j < 4; ++j) { const int c = 4 * F.lane + 256 * j; const f32x4 g = *(const GAS f32x4*)(gain + c), sc = modv4(F, l, b, scidx + c), sh = modv4(F, l, b, shidx + c);
        h.v[j] = (x.v[j] * rs * g) * (sc + 1.f) + sh; }
}
__device__ __forceinline__ void row_store_bf16(Frame& F, const Row& h, bf16* dst) {
    GAS unsigned long long* o8 = (GAS unsigned long long*)dst + F.lane;
#pragma unroll
    for (int j = 0; j < 4; ++j) o8[64 * j] = (unsigned long long)pk2(h.v[j].x, h.v[j].y) | ((unsigned long long)pk2(h.v[j].z, h.v[j].w) << 32);
}
__device__ __forceinline__ void row_load_f32(Frame& F, Row& r, const float* src) {
    const GAS f32x4* p = (const GAS f32x4*)src + F.lane;
#pragma unroll
    for (int j = 0; j < 4; ++j) r.v[j] = p[64 * j];
}
__device__ __forceinline__ void row_store_f32(Frame& F, const Row& r, float* dst) {
    GAS f32x4* p = (GAS f32x4*)dst + F.lane;
#pragma unroll
    for (int j = 0; j < 4; ++j) p[64 * j] = r.v[j];
}
__device__ __forceinline__ void row_load_bf16(Frame& F, Row& r, const bf16* src) {
    const GAS v2u* p = (const GAS v2u*)src + F.lane;
#pragma unroll
    for (int j = 0; j < 4; ++j) { const v2u w = p[64 * j]; r.v[j] = (f32x4){bflo(w.x), bfhi(w.x), bflo(w.y), bfhi(w.y)}; }
}
template <int NO> __device__ __forceinline__ void row_dots(Frame& F, const Row& h, const LAS float* WT, float (&out)[NO]) {
#pragma unroll
    for (int o = 0; o < NO; ++o) { float s = 0.f;
#pragma unroll
        for (int j = 0; j < 4; ++j) { const f32x4 w = *(const LAS f32x4*)(WT + o * 1024 + 4 * F.lane + 256 * j); s += (h.v[j].x * w.x + h.v[j].y * w.y) + (h.v[j].z * w.z + h.v[j].w * w.w); }
        out[o] = s; if ((o & 3) == 3) __builtin_amdgcn_sched_barrier(0); }
#pragma unroll
    for (int o = 0; o < NO; ++o) { out[o] = wave_sum(out[o]); if ((o & 3) == 3) __builtin_amdgcn_sched_barrier(0); }
}
template <int NO> __device__ __forceinline__ void load_wt(Frame& F, const float* W, int ldw, int col0, LAS float* WT) {
    for (int k = F.tid; k < 1024; k += NWAVES * 64) {
#pragma unroll
        for (int o = 0; o < NO; ++o) WT[o * 1024 + k] = W[(size_t)k * ldw + col0 + o];
    }
    __syncthreads();
}
__device__ __forceinline__ float softplusf_(float x) { return x > 20.f ? x : log1pf(__expf(x)); }
__device__ __forceinline__ void row_bd(Frame& F, const Row& h, const LAS float* W16T, int l, int row) {
    float o16[16]; row_dots<16>(F, h, W16T, o16);
    float mine = 0.f;
#pragma unroll
    for (int o = 0; o < 16; ++o) mine = (F.lane == o) ? o16[o] : mine;
    if (F.lane < 16) {
        float r;
        if (F.lane < 8) r = 1.f / (1.f + __expf(-mine));
        else { const int i = F.lane - 8; r = -__expf(F.in[I_DALOG][l * 8 + i]) * softplusf_(mine + F.in[I_DDTBIAS][l * 8 + i]); }
        ((float*)(F.ws + WS_BD))[(size_t)row * 16 + F.lane] = r;
    }
}
constexpr int ROW_A = 0, ROW_B = 1, ROW_C = 2;
template <int MODE> __device__ __forceinline__ void p_rows(Frame& F, const int l) {
    const int gw = F.vcu * NWAVES + F.wave, NGW = F.G * NWAVES;
    LAS float* WT = (LAS float*)(F.lds + RING_OFF);
    LAS int* linfo = (LAS int*)(F.lds + RING_OFF + 65536);
    LAS int* lcnt = (LAS int*)(F.lds + RING_OFF + 65536 + 8 * 32 * 16);
    const bool do_h1 = (MODE == ROW_A) || (MODE == ROW_C && l + 1 < NLAYER);
    const int lh = (MODE == ROW_C) ? l + 1 : l;
    const bool router = (MODE == ROW_B) && (l == 1);
    if (do_h1) load_wt<16>(F, F.in[I_WIN] + (size_t)lh * D * IN_COLS, IN_COLS, NPROJ, WT);
    if (router) { if (F.tid < 16) lcnt[F.tid] = 0; load_wt<8>(F, F.in[I_ROUTERW], NEXP, 0, WT); }
    int cnt[NEXP], tstart[NEXP + 1];
    if (MODE == ROW_C && l == 1) moe_tiles(F, cnt, tstart);
    const float* xsrc = (MODE == ROW_A || (MODE == ROW_B && l == 0)) ? F.in[I_X] : F.out;
    int ri = 0;
    for (int m = gw; m < NTOK; m += NGW, ++ri) {
        const int b = m / SEQ;
        Row x; row_load_f32(F, x, xsrc + (size_t)m * D);
        if (MODE == ROW_B) {
            Row f; row_load_bf16(F, f, (const bf16*)(F.ws + WS_F) + (size_t)m * D);
            row_resid(F, x, f, F.in[I_NMIXPOST] + l * D, l, b, 2 * D);
            row_store_f32(F, x, F.out + (size_t)m * D);
            Row h; row_make_h(F, h, x, F.in[I_NFFNPRE] + l * D, l, b, 3 * D, 4 * D);
            if (MOE_FP8 && l == 1) { GAS unsigned* o4 = (GAS unsigned*)(F.ws + WS_H2B + (size_t)m * D) + F.lane;
#pragma unroll
                for (int j = 0; j < 4; ++j) o4[64 * j] = pk4_fp8(h.v[j].x, h.v[j].y, h.v[j].z, h.v[j].w); }
            else row_store_bf16(F, h, (bf16*)(F.ws + (l == 0 ? WS_H : WS_H2B)) + (size_t)m * D);
            if (router) {
                float lg[NEXP]; row_dots<NEXP>(F, h, WT, lg);
                int e0 = 0; float l0 = lg[0] + F.in[I_ROUTERB][0];
#pragma unroll
                for (int e = 0; e < NEXP; ++e) lg[e] += F.in[I_ROUTERB][e];
#pragma unroll
                for (int e = 1; e < NEXP; ++e) if (lg[e] > l0) { l0 = lg[e]; e0 = e; }
                int e1 = -1; float l1 = -3.0e38f;
#pragma unroll
                for (int e = 0; e < NEXP; ++e) if (e != e0 && lg[e] > l1) { l1 = lg[e]; e1 = e; }
                const float q1 = __expf(l1 - l0), p0 = 1.f / (1.f + q1), p1 = q1 * p0;
                if (F.lane == 0) {
                    const int i0 = atomicAdd((int*)&lcnt[e0], 1), i1 = atomicAdd((int*)&lcnt[e1], 1);
                    LAS int* li = linfo + (F.wave * 32 + ri) * 4;
                    li[0] = e0 | (e1 << 8) | (i0 << 16); li[1] = i1; li[2] = __float_as_int(p0); li[3] = __float_as_int(p1);
                }
            }
        } else if (MODE == ROW_C) {
            Row f;
            if (l == 0) row_load_bf16(F, f, (const bf16*)(F.ws + WS_F) + (size_t)m * D);
            else {
                const int* ti = (const int*)(F.ws + WS_ROUTE) + (size_t)m * 8;
                const int e0 = ti[0], i0 = ti[1], e1 = ti[2], i1 = ti[3]; const float p0 = __int_as_float(ti[4]), p1 = __int_as_float(ti[5]);
                int s0 = 0, s1 = 0;
#pragma unroll
                for (int e = 0; e < NEXP; ++e) { s0 = (e == e0) ? tstart[e] * 256 + i0 : s0; s1 = (e == e1) ? tstart[e] * 256 + i1 : s1; }
                Row y0, y1; row_load_bf16(F, y0, (const bf16*)(F.ws + WS_Y) + (size_t)s0 * D); row_load_bf16(F, y1, (const bf16*)(F.ws + WS_Y) + (size_t)s1 * D);
#pragma unroll
                for (int j = 0; j < 4; ++j) f.v[j] = y0.v[j] * p0 + y1.v[j] * p1;
            }
            row_resid(F, x, f, F.in[I_NFFNPOST] + l * D, l, b, 5 * D);
            row_store_f32(F, x, F.out + (size_t)m * D);
        }
        if (do_h1) {
            Row h; row_make_h(F, h, x, F.in[I_NMIXPRE] + lh * D, lh, b, 0, 1 * D);
            row_store_bf16(F, h, (bf16*)(F.ws + WS_H) + (size_t)m * D);
            row_bd(F, h, WT, lh, m);
        }
    }
    if (router) {
        __syncthreads();
        if (F.tid < NEXP) lcnt[8 + F.tid] = (int)__hip_atomic_fetch_add(F.ctl + CW_MOECNT + 64 * F.tid, (unsigned)lcnt[F.tid], RLX_AGENT);
        __syncthreads();
        ri = 0;
        for (int m = gw; m < NTOK; m += NGW, ++ri) {
            if (F.lane == 0) {
                const LAS int* li = linfo + (F.wave * 32 + ri) * 4;
                const int w0 = li[0], e0 = w0 & 255, e1 = (w0 >> 8) & 255, i0 = (w0 >> 16) + lcnt[8 + e0], i1 = li[1] + lcnt[8 + e1];
                int* ti = (int*)(F.ws + WS_ROUTE) + (size_t)m * 8;
                ti[0] = e0; ti[1] = i0; ti[2] = e1; ti[3] = i1; ti[4] = li[2]; ti[5] = li[3];
                int* lists = (int*)(F.ws + WS_ROUTE + 1 * MiB);
                lists[(size_t)e0 * 65536 + i0] = m; lists[(size_t)e1 * 65536 + i1] = m;
            }
        }
    }
    __syncthreads();
}

namespace pg8 {
constexpr int NXCD = 8, WGM = 8;
struct SchedStd {
    int nM, nN, nwg, G, c; const char* A; size_t a_tile; const char* B; size_t b_tile;
    __device__ __forceinline__ void init(int nM_, int nN_, int G_, int c_, const void* A_, size_t a_tile_, const void* B_, size_t b_tile_) { nM = nM_; nN = nN_; nwg = nM * nN; G = G_; c = c_; A = (const char*)A_; a_tile = a_tile_; B = (const char*)B_; b_tile = b_tile_; }
    __device__ __forceinline__ bool next(int i, Unit& u) const {
        const long L = (long)i * G + c; if (L >= nwg) return false;
        int wgid = (int)L; { const int q = nwg / NXCD, r = nwg % NXCD, xcd = wgid % NXCD, off = wgid / NXCD; wgid = (xcd < r ? xcd * (q + 1) : r * (q + 1) + (xcd - r) * q) + off; }
        const int nig = WGM * nN, gid = wgid / nig, fm = gid * WGM, gsz = (nM - fm) < WGM ? (nM - fm) : WGM;
        u.pm = fm + ((wgid % nig) % gsz); u.pn = (wgid % nig) / gsz; u.aux = 0; u.pad = 0; u.a = A + (size_t)u.pm * a_tile; u.b = B + (size_t)u.pn * b_tile; u.rows = nullptr; return true;
    }
    __device__ __forceinline__ void a_ready(const Unit&) const {}
    __device__ __forceinline__ void done(const Unit&) const {}
};
struct SchedBranch {
    SchedStd s; const char* O4; const char* Wb;
    __device__ __forceinline__ bool next(int i, Unit& u) const {
        if (!s.next(i, u)) return false;
        const int br = u.pn >> 2; u.pn &= 3; u.aux = br;
        u.a = O4 + (size_t)u.pm * 256 * 1024 * 2 + (size_t)br * 256 * 2; u.b = Wb + (size_t)br * 1024 * 256 * 2 + (size_t)u.pn * 256 * 256 * 2; return true;
    }
    __device__ __forceinline__ void a_ready(const Unit&) const {}
    __device__ __forceinline__ void done(const Unit&) const {}
};
struct SchedGate {
    int vcu, G; const char* H; const char* Wm;
    __device__ __forceinline__ bool next(int i, Unit& u) const {
        const int tg = vcu + G * (i >> 2); if (tg >= 512) return false;
        u.pm = tg >> 2; u.pn = tg & 3; u.aux = i & 3; u.pad = 0; u.rows = nullptr;
        u.a = H + (size_t)u.pm * 256 * 1024 * 2; u.b = Wm + ((size_t)u.aux * 1024 + (size_t)u.pn * 256) * 1024 * 2; return true;
    }
    __device__ __forceinline__ void a_ready(const Unit&) const {}
    __device__ __forceinline__ void done(const Unit&) const {}
};
struct SchedMoe {
    int c, G, t0, t1, nN; int tstart[9]; int cnt[8];
    const char* A; const int* lists; const char* W; size_t w_tile; bool gather; size_t exp_stride, act_tile;
    __device__ __forceinline__ bool next(int i, Unit& u) const {
        const long L = (long)i * G + c; const int t = t0 + (int)(L / nN); if (t >= t1) return false;
        int e = 0;
#pragma unroll
        for (int k = 1; k < 8; ++k) e = (t >= tstart[k]) ? k : e;
        int ce = 0;
#pragma unroll
        for (int k = 0; k < 8; ++k) ce = (k == e) ? cnt[k] : ce;
        const int j = t - ((e == 0) ? 0 : 0), jj = t;
        (void)j; (void)jj;
        int ts = 0;
#pragma unroll
        for (int k = 0; k < 8; ++k) ts = (k == e) ? tstart[k] : ts;
        const int tj = t - ts;
        u.pn = (int)(L % nN); u.pad = 0;
        if (gather) { u.pm = t - t0; u.a = A; u.rows = lists + (size_t)e * 65536 + tj * 256; const int nv = ce - tj * 256; u.aux = nv > 256 ? 256 : nv; }
        else { u.pm = t; u.a = A + (size_t)(t - t0) * act_tile; u.rows = nullptr; u.aux = 0; }
        u.b = W + (size_t)e * exp_stride + (size_t)u.pn * w_tile; return true;
    }
    static constexpr size_t DFF_ = 2816; static constexpr size_t SZ_EXP_ = (size_t)2 * 2816 * 1024 * 2 + (size_t)1024 * 2816 * 2;
    __device__ __forceinline__ void a_ready(const Unit&) const {}
    __device__ __forceinline__ void done(const Unit&) const {}
};

struct EpiStore {
    static constexpr bool PERM = true;
    bf16_t* O; int ldc; size_t aux_stride; float scale0;
    __device__ __forceinline__ void operator()(const f32x4 (&acc)[2][2][4][2], const Unit& u, int wr, int wc, int fr, int fq) const {
        const int row0 = u.pm * BM + wr * 64 + fr, col0 = u.pn * BM + wc * 32 + 8 * fq; bf16_t* base = O + (size_t)u.aux * aux_stride;
        const float sc = scale0;
#pragma unroll
        for (int ai = 0; ai < 2; ++ai)
#pragma unroll
            for (int m = 0; m < 4; ++m) { bf16_t* rowp = base + (size_t)(row0 + ai * HALF + m * 16) * ldc + col0;
#pragma unroll
                for (int bj = 0; bj < 2; ++bj) { const f32x4 v0 = acc[ai][bj][m][0] * sc, v1 = acc[ai][bj][m][1] * sc;
                    u32x4 w; w.x = cvt_pk_bf16(v0[0], v0[1]); w.y = cvt_pk_bf16(v0[2], v0[3]); w.z = cvt_pk_bf16(v1[0], v1[1]); w.w = cvt_pk_bf16(v1[2], v1[3]);
                    *(u32x4*)(rowp + bj * HALF) = w; } }
    }
};

struct EpiStore64 {
    static constexpr bool PERM = true;
    bf16_t* O;
    __device__ __forceinline__ void operator()(const f32x4 (&acc)[2][2][4][2], const Unit& u, int wr, int wc, int fr, int fq) const {
        int fr_ = fr, fq_ = fq; asm volatile("" : "+v"(fr_), "+v"(fq_));
        bf16_t* base = O + (size_t)(u.pm * BM + wr * 64 + fr_) * 1024 + u.pn * BM + wc * 32 + 8 * fq_;
#pragma unroll
        for (int ai = 0; ai < 2; ++ai)
#pragma unroll
            for (int m = 0; m < 4; ++m) {
#pragma unroll
                for (int bj = 0; bj < 2; ++bj) { const f32x4 v0 = acc[ai][bj][m][0] * (1.f / 64.f), v1 = acc[ai][bj][m][1] * (1.f / 64.f);
                    u32x4 w; w.x = cvt_pk_bf16(v0[0], v0[1]); w.y = cvt_pk_bf16(v0[2], v0[3]); w.z = cvt_pk_bf16(v1[0], v1[1]); w.w = cvt_pk_bf16(v1[2], v1[3]);
                    *(u32x4*)(base + (ai * HALF + m * 16) * 1024 + bj * HALF) = w; }
                __builtin_amdgcn_sched_barrier(0); }
    }
};
struct EpiProj {
    static constexpr bool PERM = true;
    static constexpr int TILE_E = 9728;
    bf16_t* Qb; bf16_t* KV; bf16_t* Pj; unsigned* nmax; float qscale;
    __device__ __forceinline__ void operator()(const f32x4 (&acc)[2][2][4][2], const Unit& u, int wr, int wc, int fr, int fq) const {
        const int t0 = u.pm * BM + wr * 64 + fr;
        const int b = (u.pm * BM) >> 14;
        const int s00 = t0 & 16383;
        if (u.pn >= 3) {
            bf16_t* base = Pj + (size_t)t0 * 2048 + (u.pn - 3) * BM + wc * 32 + 8 * fq;
#pragma unroll
            for (int ai = 0; ai < 2; ++ai)
#pragma unroll
                for (int m = 0; m < 4; ++m) {
#pragma unroll
                    for (int bj = 0; bj < 2; ++bj) { const f32x4 v0 = acc[ai][bj][m][0], v1 = acc[ai][bj][m][1];
                        u32x4 w; w.x = cvt_pk_bf16(v0[0], v0[1]); w.y = cvt_pk_bf16(v0[2], v0[3]); w.z = cvt_pk_bf16(v1[0], v1[1]); w.w = cvt_pk_bf16(v1[2], v1[3]);
                        *(u32x4*)(base + (ai * HALF + m * 16) * 2048 + bj * HALF) = w; }
                    __builtin_amdgcn_sched_barrier(0); }
        } else if (u.pn == 2) {
            bf16_t* hb = KV + ((size_t)((b * 4 + (wc >> 1)) * 256 + (s00 >> 6))) * TILE_E + 5120 + (32 * (wc & 1) + 8 * fq) * 72 + (s00 & 63);
#pragma unroll
            for (int ai = 0; ai < 2; ++ai)
#pragma unroll
                for (int bj = 0; bj < 2; ++bj) { bf16_t* tb = hb + (size_t)bj * (2 * 256 * TILE_E) + ai * (2 * TILE_E);
#pragma unroll
                    for (int m = 0; m < 4; ++m)
#pragma unroll
                        for (int n = 0; n < 2; ++n)
#pragma unroll
                            for (int j = 0; j < 4; ++j) { const float v = acc[ai][bj][m][n][j];
                                unsigned bits = __builtin_bit_cast(unsigned, v); bits = (bits + 0x7fffu + ((bits >> 16) & 1u)) >> 16;
                                tb[(4 * n + j) * 72 + 16 * m] = (bf16_t)bits; }
                    __builtin_amdgcn_sched_barrier(0); }
        } else {
            const float sc = (u.pn == 0) ? qscale : 1.f; float nm = 0.f;
            bf16_t* qbase = Qb + ((size_t)(b * 4 + wc) * 16384 + s00) * 64 + 8 * fq;
            bf16_t* kbase = KV + ((size_t)((b * 4 + wc) * 256 + (s00 >> 6))) * TILE_E + (s00 & 63) * 40 + 8 * fq;
#pragma unroll
            for (int ai = 0; ai < 2; ++ai)
#pragma unroll
                for (int m = 0; m < 4; ++m) {
#pragma unroll
                    for (int bj = 0; bj < 2; ++bj) { const f32x4 v0 = acc[ai][bj][m][0] * sc, v1 = acc[ai][bj][m][1] * sc;
                        u32x4 w; w.x = cvt_pk_bf16(v0[0], v0[1]); w.y = cvt_pk_bf16(v0[2], v0[3]); w.z = cvt_pk_bf16(v1[0], v1[1]); w.w = cvt_pk_bf16(v1[2], v1[3]);
                        float ss = (v0[0] * v0[0] + v0[1] * v0[1]) + (v0[2] * v0[2] + v0[3] * v0[3]) + (v1[0] * v1[0] + v1[1] * v1[1]) + (v1[2] * v1[2] + v1[3] * v1[3]);
                        ss += __shfl_xor(ss, 16); ss += __shfl_xor(ss, 32); nm = fmaxf(nm, ss);
                        if (u.pn == 0) *(u32x4*)(qbase + (ai * HALF + m * 16) * 64 + 32 * bj) = w;
                        else *(u32x4*)(kbase + ai * (2 * TILE_E) + bj * 2560 + (16 * m) * 40) = w; }
                    __builtin_amdgcn_sched_barrier(0); }
            nm = fmaxf(nm, __shfl_xor(nm, 1)); nm = fmaxf(nm, __shfl_xor(nm, 2)); nm = fmaxf(nm, __shfl_xor(nm, 4)); nm = fmaxf(nm, __shfl_xor(nm, 8));
            if (fr == 0 && fq == 0) atomicMax(nmax + (b * 4 + wc) * 2 + u.pn, __builtin_bit_cast(unsigned, nm));
        }
    }
};
__device__ __forceinline__ float sigm(float x) { return __builtin_amdgcn_rcpf(1.f + __builtin_amdgcn_exp2f(-1.4426950408889634f * x)); }
struct EpiGate {
    static constexpr bool PERM = true;
    const bf16_t* P; bf16_t* Mg; const float* bias;
    __device__ __forceinline__ void operator()(const f32x4 (&acc)[2][2][4][2], const Unit& u, int wr, int wc, int fr, int fq) const {
        const int row0 = u.pm * BM + wr * 64 + fr, col0 = u.pn * BM + wc * 32 + 8 * fq; const int br = u.aux;
        const bf16_t* Pb = P + (size_t)br * 32768 * 1024; const float* bb = bias + br * 1024 + col0;
        f32x4 bv[2][2];
#pragma unroll
        for (int bj = 0; bj < 2; ++bj)
#pragma unroll
            for (int n = 0; n < 2; ++n) bv[bj][n] = *(const f32x4*)(bb + bj * HALF + 4 * n);
#pragma unroll
        for (int ai = 0; ai < 2; ++ai)
#pragma unroll
            for (int m = 0; m < 4; ++m) { const size_t ro = (size_t)(row0 + ai * HALF + m * 16) * 1024 + col0;
#pragma unroll
                for (int bj = 0; bj < 2; ++bj) {
                    const u32x4 pw = *(const u32x4*)(Pb + ro + bj * HALF);
                    u32x4 mw = {0u, 0u, 0u, 0u}; if (br != 0) mw = *(const u32x4*)(Mg + ro + bj * HALF);
                    float o[8];
#pragma unroll
                    for (int q = 0; q < 4; ++q) {
                        const float g0 = sigm(acc[ai][bj][m][q >> 1][(q & 1) * 2] + bv[bj][q >> 1][(q & 1) * 2]), g1 = sigm(acc[ai][bj][m][q >> 1][(q & 1) * 2 + 1] + bv[bj][q >> 1][(q & 1) * 2 + 1]);
                        o[2 * q] = g0 * __builtin_bit_cast(float, pw[q] << 16) + __builtin_bit_cast(float, mw[q] << 16);
                        o[2 * q + 1] = g1 * __builtin_bit_cast(float, pw[q] & 0xffff0000u) + __builtin_bit_cast(float, mw[q] & 0xffff0000u);
                    }
                    u32x4 w; w.x = cvt_pk_bf16(o[0], o[1]); w.y = cvt_pk_bf16(o[2], o[3]); w.z = cvt_pk_bf16(o[4], o[5]); w.w = cvt_pk_bf16(o[6], o[7]);
                    *(u32x4*)(Mg + ro + bj * HALF) = w; } }
    }
};
template <bool F8 = false> struct EpiSwiGLU {
    static constexpr bool PERM = true;
    bf16_t* O; int ldc;
    __device__ __forceinline__ void operator()(const f32x4 (&acc)[2][2][4][2], const Unit& u, int wr, int wc, int fr, int fq) const {
        const int row0 = u.pm * BM + wr * 64 + fr, col0 = u.pn * HALF + wc * 32 + 8 * fq;
#pragma unroll
        for (int ai = 0; ai < 2; ++ai)
#pragma unroll
            for (int m = 0; m < 4; ++m) {
                float o[8]; constexpr float isc = F8 ? (1.f / 64.f) : 1.f;
#pragma unroll
                for (int n = 0; n < 2; ++n)
#pragma unroll
                    for (int q = 0; q < 4; ++q) { const float g = acc[ai][0][m][n][q] * isc, up = acc[ai][1][m][n][q] * isc; o[4 * n + q] = g * sigm(g) * up; }
                if constexpr (F8) { int w0 = __builtin_amdgcn_cvt_pk_fp8_f32(o[0], o[1], 0, false); w0 = __builtin_amdgcn_cvt_pk_fp8_f32(o[2], o[3], w0, true);
                    int w1 = __builtin_amdgcn_cvt_pk_fp8_f32(o[4], o[5], 0, false); w1 = __builtin_amdgcn_cvt_pk_fp8_f32(o[6], o[7], w1, true);
                    u32x2 w = {(unsigned)w0, (unsigned)w1}; *(u32x2*)((unsigned char*)O + (size_t)(row0 + ai * HALF + m * 16) * ldc + col0) = w; }
                else { bf16_t* rowp = O + (size_t)(row0 + ai * HALF + m * 16) * ldc + col0;
                    u32x4 w; w.x = cvt_pk_bf16(o[0], o[1]); w.y = cvt_pk_bf16(o[2], o[3]); w.z = cvt_pk_bf16(o[4], o[5]); w.w = cvt_pk_bf16(o[6], o[7]);
                    *(u32x4*)rowp = w; } }
    }
};
}

namespace att {
constexpr int SLOT = 19456, NSLOT = 6;
constexpr int ATTN_LDS = NSLOT * SLOT;
__device__ __forceinline__ unsigned cvtpk(float lo, float hi) { typedef float f2 __attribute__((ext_vector_type(2))); typedef __bf16 b2 __attribute__((ext_vector_type(2))); f2 v = {lo, hi}; b2 b = __builtin_convertvector(v, b2); return __builtin_bit_cast(unsigned, b); }
#define ATT_WAITV(n) asm volatile("s_waitcnt vmcnt(" #n ")" ::: "memory")
__device__ __forceinline__ float max3f(float a, float b, float c) { float r; asm("v_max3_f32 %0, %1, %2, %3" : "=v"(r) : "v"(a), "v"(b), "v"(c)); return r; }

#define ATT_SOFTMAX(s0, s1, pw, LS) do { \
    asm volatile("s_nop 15\n\ts_nop 7" : "+v"(s0), "+v"(s1)); \
    float rm = max3f(s0[0], s0[1], s1[0]), rm2 = max3f(s0[2], s0[3], s1[1]); rm = max3f(rm, s1[2], s1[3]); \
    _Pragma("unroll") for (int r = 4; r < 16; r += 4) { rm = max3f(rm, s0[r], s0[r + 1]); rm2 = max3f(rm2, s0[r + 2], s0[r + 3]); rm = max3f(rm, s1[r], s1[r + 1]); rm2 = max3f(rm2, s1[r + 2], s1[r + 3]); } \
    rm = fmaxf(rm, rm2); \
    { auto rr = __builtin_amdgcn_permlane32_swap(__builtin_bit_cast(unsigned, rm), __builtin_bit_cast(unsigned, rm), false, false); rm = fmaxf(__builtin_bit_cast(float, rr[0]), __builtin_bit_cast(float, rr[1])); } \
    if (__any(rm > 8.f)) { \
        const float dd = fmaxf(rm, 0.f); R += dd; \
        const float f = fast_exp2(-dd); l1 *= f; l2 *= f; \
        _Pragma("unroll") for (int r = 0; r < 16; ++r) { s0[r] -= dd; s1[r] -= dd; c0[r] -= dd; c1[r] -= dd; O1[0][r] *= f; O1[1][r] *= f; O2[0][r] *= f; O2[1][r] *= f; } \
        p1scale = f; \
    } \
    { float sa_ = 0.f, sb_ = 0.f; _Pragma("unroll") for (int r = 0; r < 16; ++r) { s0[r] = fast_exp2(s0[r]); s1[r] = fast_exp2(s1[r]); sa_ += s0[r]; sb_ += s1[r]; } LS += sa_ + sb_; } \
    _Pragma("unroll") for (int e = 0; e < 4; ++e) { pw[0][e] = cvtpk(s0[2 * e], s0[2 * e + 1]); pw[1][e] = cvtpk(s0[8 + 2 * e], s0[8 + 2 * e + 1]); pw[2][e] = cvtpk(s1[2 * e], s1[2 * e + 1]); pw[3][e] = cvtpk(s1[8 + 2 * e], s1[8 + 2 * e + 1]); } \
} while (0)

__device__ __forceinline__ void attn_unit(Frame& F, const int layer, const int b, const int h, const int qb) {
    const int lane = F.lane, r32 = lane & 31, hi = lane >> 5, wid = F.wave;
    LAS unsigned char* L = F.lds + RING_OFF;
    const int qw0 = qb * 256 + wid * 32, q = qw0 + r32;
    const float slope2 = exp2f(-2.f * (float)(h + 1)) * 1.4426950408889634f;
    int tlo, thi;
    { const unsigned* nm = (const unsigned*)(F.ctl + CW_NMAX) + layer * 16 + (b * 4 + h) * 2;
      const float qn = sqrtf(__builtin_bit_cast(float, __hip_atomic_load(nm, RLX_AGENT))) * 1.01f, kn = sqrtf(__builtin_bit_cast(float, __hip_atomic_load(nm + 1, RLX_AGENT))) * 1.01f;
      const float wf = (160.f + 2.f * qn * kn) / slope2; const int W = wf > 100000.f ? 100000 : (int)wf + 1;
      const int lo = qb * 256 - W, hi_ = qb * 256 + 255 + W; tlo = lo < 0 ? 0 : (lo >> 6); thi = hi_ >= SEQ ? (SEQ / 64 - 1) : (hi_ >> 6);
      if (((thi - tlo + 1) & 1) != 0) { if (thi < SEQ / 64 - 1) ++thi; else --tlo; } }
    const int nP = (thi - tlo + 1) >> 1;
    const bf16* Qp = (const bf16*)(F.ws + WS_QB) + ((size_t)(b * 4 + h) * SEQ + q) * 64;
    bf16x8 q1f[2], q2f[2];
#pragma unroll
    for (int ks = 0; ks < 2; ++ks) { q1f[ks] = *(const GAS bf16x8*)(Qp + 16 * ks + 8 * hi); q2f[ks] = *(const GAS bf16x8*)(Qp + 32 + 16 * ks + 8 * hi); }
    const unsigned char* kvbase = F.ws + WS_KV + ((size_t)(b * 4 + h) * 256) * SLOT + (size_t)wid * 1024 + lane * 16;
    const bool w3 = wid < 3;
#define ATT_DMA1(t, slot) do { const unsigned char* g_ = kvbase + (size_t)(t) * SLOT; LAS unsigned char* d_ = L + (slot) * SLOT + wid * 1024; \
        __builtin_amdgcn_global_load_lds((const unsigned*)g_, (LAS unsigned*)d_, 16, 0, 0); __builtin_amdgcn_global_load_lds((const unsigned*)(g_ + 8192), (LAS unsigned*)(d_ + 8192), 16, 0, 0); \
        if (w3) __builtin_amdgcn_global_load_lds((const unsigned*)(g_ + 16384), (LAS unsigned*)(d_ + 16384), 16, 0, 0); } while (0)
#define ATT_DMA2(pr, ps) do { ATT_DMA1(tlo + 2 * (pr), 2 * (ps)); ATT_DMA1(tlo + 2 * (pr) + 1, 2 * (ps) + 1); } while (0)
    asm volatile("s_waitcnt vmcnt(0)" ::: "memory");
    ATT_DMA2(0, 0);
    if (nP > 1) ATT_DMA2(1, 1);
    float R = 0.f, l1 = 0.f, l2 = 0.f;
    f32x16 O1[2], O2[2];
#pragma unroll
    for (int i = 0; i < 16; ++i) { O1[0][i] = 0.f; O1[1][i] = 0.f; O2[0][i] = 0.f; O2[1][i] = 0.f; }
    const int pr32 = (r32 & 0x13) | ((r32 & 4) << 1) | ((r32 & 8) >> 1);
    const int kfo = pr32 * 80 + hi * 16;
    const int vfo = 10240 + r32 * 144 + hi * 16;
    int ps = 0;
    for (int ip = 0; ip < nP; ++ip) {
        if (ip + 1 < nP) { if (w3) ATT_WAITV(6); else ATT_WAITV(4); } else ATT_WAITV(0);
        __builtin_amdgcn_s_barrier();
        asm volatile("" ::: "memory");
        if (ip + 2 < nP) { const int s2 = ps >= 1 ? ps - 1 : 2; ATT_DMA2(ip + 2, s2); }
#pragma unroll
        for (int half = 0; half < 2; ++half) {
            const int t = tlo + 2 * ip + half;
            const LAS unsigned char* Bf = L + (2 * ps + half) * SLOT;
            const float dl = (float)(q - t * 64 - 8 * hi);
            v4u pw1[4], pw2[4];
            const bf16x8 ka00 = *(const LAS bf16x8*)(Bf + kfo), ka01 = *(const LAS bf16x8*)(Bf + kfo + 32), ka10 = *(const LAS bf16x8*)(Bf + 32 * 80 + kfo), ka11 = *(const LAS bf16x8*)(Bf + 32 * 80 + kfo + 32);
            const bf16x8 kb00 = *(const LAS bf16x8*)(Bf + 5120 + kfo), kb01 = *(const LAS bf16x8*)(Bf + 5120 + kfo + 32), kb10 = *(const LAS bf16x8*)(Bf + 5120 + 32 * 80 + kfo), kb11 = *(const LAS bf16x8*)(Bf + 5120 + 32 * 80 + kfo + 32);
            f32x16 c0, c1;
            if (t * 64 + 63 < qw0) {
                const float tl = -slope2 * dl - R;
#pragma unroll
                for (int r = 0; r < 16; ++r) { const float cc = (float)(16 * (r >> 3) + (r & 7)); c0[r] = __builtin_fmaf(slope2, cc, tl); c1[r] = __builtin_fmaf(slope2, cc + 32.f, tl); }
            } else if (t * 64 > qw0 + 31) {
                const float tr = slope2 * dl - R;
#pragma unroll
                for (int r = 0; r < 16; ++r) { const float cc = (float)(16 * (r >> 3) + (r & 7)); c0[r] = __builtin_fmaf(-slope2, cc, tr); c1[r] = __builtin_fmaf(-slope2, cc + 32.f, tr); }
            } else {
#pragma unroll
                for (int r = 0; r < 16; ++r) { const float cc = (float)(16 * (r >> 3) + (r & 7)); c0[r] = __builtin_fmaf(-slope2, __builtin_fabsf(dl - cc), -R); c1[r] = __builtin_fmaf(-slope2, __builtin_fabsf(dl - (cc + 32.f)), -R); }
            }
            {
                f32x16 s0 = __builtin_amdgcn_mfma_f32_32x32x16_bf16(ka00, q1f[0], c0, 0, 0, 0); s0 = __builtin_amdgcn_mfma_f32_32x32x16_bf16(ka01, q1f[1], s0, 0, 0, 0);
                f32x16 s1 = __builtin_amdgcn_mfma_f32_32x32x16_bf16(ka10, q1f[0], c1, 0, 0, 0); s1 = __builtin_amdgcn_mfma_f32_32x32x16_bf16(ka11, q1f[1], s1, 0, 0, 0);
                float p1scale = 1.f; ATT_SOFTMAX(s0, s1, pw1, l1); (void)p1scale;
            }
            bf16x8 vf[2][4];
            {
                f32x16 s0 = __builtin_amdgcn_mfma_f32_32x32x16_bf16(kb00, q2f[0], c0, 0, 0, 0); s0 = __builtin_amdgcn_mfma_f32_32x32x16_bf16(kb01, q2f[1], s0, 0, 0, 0);
                f32x16 s1 = __builtin_amdgcn_mfma_f32_32x32x16_bf16(kb10, q2f[0], c1, 0, 0, 0); s1 = __builtin_amdgcn_mfma_f32_32x32x16_bf16(kb11, q2f[1], s1, 0, 0, 0);
#pragma unroll
                for (int db = 0; db < 2; ++db)
#pragma unroll
                    for (int ks = 0; ks < 4; ++ks) vf[db][ks] = *(const LAS bf16x8*)(Bf + vfo + db * 32 * 144 + ks * 32);
                float p1scale = 1.f; ATT_SOFTMAX(s0, s1, pw2, l2);
                if (__any(p1scale != 1.f)) {
#pragma unroll
                    for (int ks = 0; ks < 4; ++ks)
#pragma unroll
                        for (int e = 0; e < 4; ++e) { const unsigned w = pw1[ks][e]; pw1[ks][e] = cvtpk(bflo(w) * p1scale, bfhi(w) * p1scale); }
                }
            }
#pragma unroll
            for (int db = 0; db < 2; ++db)
#pragma unroll
                for (int ks = 0; ks < 4; ++ks) {
                    O1[db] = __builtin_amdgcn_mfma_f32_32x32x16_bf16(vf[db][ks], __builtin_bit_cast(bf16x8, pw1[ks]), O1[db], 0, 0, 0);
                    O2[db] = __builtin_amdgcn_mfma_f32_32x32x16_bf16(vf[db][ks], __builtin_bit_cast(bf16x8, pw2[ks]), O2[db], 0, 0, 0);
                }
        }
        ps = ps == 2 ? 0 : ps + 1;
    }
    l1 += __shfl_xor(l1, 32); l2 += __shfl_xor(l2, 32);
    const float* dlm = F.in[I_DLAMBDA] + layer * 128;
    float a1 = 0.f, a2 = 0.f;
#pragma unroll 8
    for (int i = 0; i < 32; ++i) { a1 += dlm[i] * dlm[32 + i]; a2 += dlm[64 + i] * dlm[96 + i]; }
    const float lam_init = 0.8f - 0.6f * __expf(-0.3f * (float)layer);
    const float lam = __expf(a1) - __expf(a2) + lam_init;
    const float i1 = 1.f / fmaxf(l1, 1e-30f), i2 = lam / fmaxf(l2, 1e-30f);
    float ss = 0.f;
#pragma unroll
    for (int db = 0; db < 2; ++db)
#pragma unroll
        for (int r = 0; r < 16; ++r) { const float v = O1[db][r] * i1 - O2[db][r] * i2; O1[db][r] = v; ss += v * v; }
    ss += __shfl_xor(ss, 32);
    const float rs = (1.f / sqrtf(ss * (1.f / 64.f) + EPS)) * (1.f - lam_init);
    bf16* orow = (bf16*)(F.ws + WS_O4) + ((size_t)b * SEQ + q) * 1024 + 64 * h;
    const float* sg = F.in[I_DSUBLN] + layer * 64;
#pragma unroll
    for (int db = 0; db < 2; ++db)
#pragma unroll
        for (int g4 = 0; g4 < 4; ++g4) {
            const int d0 = 32 * db + 8 * g4 + 4 * hi;
            const float v0 = O1[db][4 * g4] * rs * sg[d0], v1 = O1[db][4 * g4 + 1] * rs * sg[d0 + 1], v2 = O1[db][4 * g4 + 2] * rs * sg[d0 + 2], v3 = O1[db][4 * g4 + 3] * rs * sg[d0 + 3];
            v2u w = {pk2(v0, v1), pk2(v2, v3)};
            *(GAS v2u*)(orow + d0) = w;
        }
    asm volatile("s_waitcnt lgkmcnt(0)" ::: "memory");
    __builtin_amdgcn_s_barrier();
#undef ATT_DMA1
#undef ATT_DMA2
}
#undef ATT_SOFTMAX
#undef ATT_WAITV
}

namespace pc {
constexpr int MPITCH = 72;
__device__ __forceinline__ void pool_task(Frame& F, const int layer, const int tile, const int g, LAS unsigned char* mimg) {
    const int lane = F.lane, r32 = lane & 31, hi = lane >> 5;
    const bf16* P = (const bf16*)(F.ws + WS_PROJ);
    bf16* O4 = (bf16*)(F.ws + WS_O4);
    bf16x8 wf[2][4];
    { const float* W = F.in[I_POOLW] + ((size_t)layer * 4 + g) * 64 * 64;
#pragma unroll
      for (int nb = 0; nb < 2; ++nb)
#pragma unroll
          for (int ks = 0; ks < 4; ++ks) { v4u t;
#pragma unroll
              for (int jj = 0; jj < 4; ++jj) t[jj] = pk2(W[(16 * ks + 8 * hi + 2 * jj) * 64 + r32 + 32 * nb], W[(16 * ks + 8 * hi + 2 * jj + 1) * 64 + r32 + 32 * nb]);
              wf[nb][ks] = __builtin_bit_cast(bf16x8, t); } }
    const int t0 = tile * 64, s0 = t0 % SEQ, hw = 1 << g;
    const bf16* src = P + (size_t)t0 * PJ + C_PIN + 64 * g + lane;
    float cs[81]; cs[0] = 0.f;
#pragma unroll
    for (int i = 0; i < 80; ++i) { const int s = s0 - 8 + i; float v = 0.f; if (s >= 0 && s < SEQ) v = bf2f(src[(long)(i - 8) * PJ]); cs[i + 1] = cs[i] + v; }
#pragma unroll
    for (int i = 0; i < 64; ++i) {
        const int s = s0 + i; int lo = s - hw, hiw = s + hw; lo = lo < 0 ? 0 : lo; hiw = hiw > SEQ ? SEQ : hiw;
        float wsum = 0.f;
        if (g == 0) wsum = cs[i + 8 + 1] - cs[i + 8 - 1]; else if (g == 1) wsum = cs[i + 8 + 2] - cs[i + 8 - 2]; else if (g == 2) wsum = cs[i + 8 + 4] - cs[i + 8 - 4]; else wsum = cs[i + 8 + 8] - cs[i + 8 - 8];
        const float pv = cs[i + 9] - cs[i + 8];
        const float mval = wsum / (float)(hiw - lo) - pv;
        *(LAS unsigned short*)(mimg + i * (MPITCH * 2) + lane * 2) = (unsigned short)f2bf(mval);
    }
    LDS_WAIT();
#pragma unroll
    for (int tb = 0; tb < 2; ++tb) {
        bf16x8 af[4];
#pragma unroll
        for (int ks = 0; ks < 4; ++ks) af[ks] = *(const LAS bf16x8*)(mimg + (r32 + 32 * tb) * (MPITCH * 2) + (16 * ks + 8 * hi) * 2);
#pragma unroll
        for (int nb = 0; nb < 2; ++nb) {
            f32x16 acc;
#pragma unroll
            for (int r = 0; r < 16; ++r) acc[r] = 0.f;
#pragma unroll
            for (int ks = 0; ks < 4; ++ks) acc = __builtin_amdgcn_mfma_f32_32x32x16_bf16(af[ks], wf[nb][ks], acc, 0, 0, 0);
            const int e = r32 + 32 * nb; const float sc = F.in[I_POOLSCALE][layer * 256 + 64 * g + e];
#pragma unroll
            for (int r = 0; r < 16; ++r) { const int row = 32 * tb + (r & 3) + 8 * (r >> 2) + 4 * hi;
                O4[(size_t)(t0 + row) * 1024 + 256 + 64 * g + e] = (bf16)f2bf(acc[r] * sc); }
        }
    }
    LDS_WAIT();
}
__device__ __forceinline__ void conv_task(Frame& F, const int layer, const int tile, const int cg) {
    const int lane = F.lane;
    const bf16* P = (const bf16*)(F.ws + WS_PROJ);
    bf16* O4 = (bf16*)(F.ws + WS_O4);
    const int t0 = tile * 64, s0 = t0 % SEQ;
    const int ch = 64 * cg + lane;
    const float w0 = F.in[I_SCONVW][layer * 768 + ch], w1 = F.in[I_SCONVW][layer * 768 + 256 + ch], w2 = F.in[I_SCONVW][layer * 768 + 512 + ch];
    const bf16* base = P + (size_t)t0 * PJ + ch;
    float zm = 0.f, z0 = 0.f, zp = 0.f;
    if (s0 > 0) zm = bf2f(base[-(long)PJ + C_CC]) * bf2f(base[-(long)PJ + C_CX]);
    z0 = bf2f(base[C_CC]) * bf2f(base[C_CX]);
#pragma unroll 8
    for (int i = 0; i < 64; ++i) {
        zp = 0.f; if (s0 + i + 1 < SEQ) zp = bf2f(base[(long)(i + 1) * PJ + C_CC]) * bf2f(base[(long)(i + 1) * PJ + C_CX]);
        const float cbv = bf2f(base[(long)i * PJ + C_CB]);
        O4[(size_t)(t0 + i) * 1024 + 512 + ch] = (bf16)f2bf(cbv * (w0 * zm + w1 * z0 + w2 * zp));
        zm = z0; z0 = zp;
    }
}
}

namespace dl {
constexpr int MP = 72, MB = 64 * MP * 2;
constexpr int WAVE_LDS = 2 * MB + 2 * MB;
__device__ __forceinline__ int crow(int r, int hi) { return (r & 3) + 8 * (r >> 2) + 4 * hi; }
__device__ __forceinline__ bf16x8 ldfrag(const LAS unsigned char* img, int row, int col) { return *(const LAS bf16x8*)(img + row * (MP * 2) + col * 2); }
__device__ __forceinline__ bf16x8 ldfragp(const LAS unsigned char* img, int row, int col4) {
    const v2u lo = *(const LAS v2u*)(img + row * (MP * 2) + col4 * 2), hi8 = *(const LAS v2u*)(img + row * (MP * 2) + col4 * 2 + 16); const v4u t = {lo.x, lo.y, hi8.x, hi8.y}; return __builtin_bit_cast(bf16x8, t); }
__device__ __forceinline__ bf16x8 cfrag(const f32x16& x, int half) {
    v4u t;
#pragma unroll
    for (int e = 0; e < 4; ++e) t[e] = att::cvtpk(x[8 * half + 2 * e], x[8 * half + 2 * e + 1]);
    return __builtin_bit_cast(bf16x8, t); }
#define MFMA32(a, b, c) __builtin_amdgcn_mfma_f32_32x32x16_bf16((a), (b), (c), 0, 0, 0)
#define SB() __builtin_amdgcn_sched_barrier(0)
#define LAUNDER() do { asm volatile("" : "+v"(lane)); r32 = lane & 31; hi = lane >> 5; } while (0)
__device__ __forceinline__ f32x16 zero16() { f32x16 z;
#pragma unroll
    for (int r = 0; r < 16; ++r) z[r] = 0.f;
    return z; }

#define DL_CONV(colbase, wbase, RAW) do { \
    { const bf16* src_ = P + (size_t)tok0 * PJ + (colbase); const int rr_ = lane >> 3, ch_ = lane & 7; \
      _Pragma("unroll") for (int i_ = 0; i_ < 9; ++i_) { const int row_ = rr_ + 8 * i_; const int sq_ = s0 - 2 + row_; v4u t_ = {0u, 0u, 0u, 0u}; \
          if (row_ < 68 && sq_ >= 0 && sq_ < SEQ) t_ = *(const GAS v4u*)(src_ + (long)(row_ - 2) * PJ + ch_ * 8); if (row_ < 68) *(LAS v4u*)((RAW) + row_ * 128 + ch_ * 16) = t_; } } \
    LDS_WAIT(); \
    const float cw0 = cwp[(wbase) + lane], cw1 = cwp[768 + (wbase) + lane], cw2 = cwp[2 * 768 + (wbase) + lane], cw3 = cwp[3 * 768 + (wbase) + lane], cw4 = cwp[4 * 768 + (wbase) + lane]; \
    const LAS unsigned short* rw_ = (const LAS unsigned short*)(RAW) + lane; \
    _Pragma("unroll") for (int i = 0; i < 64; ++i) { \
        const float cv_ = cw0 * bf2f(rw_[i * 64]) + cw1 * bf2f(rw_[(i + 1) * 64]) + cw2 * bf2f(rw_[(i + 2) * 64]) + cw3 * bf2f(rw_[(i + 3) * 64]) + cw4 * bf2f(rw_[(i + 4) * 64]); \
        cval[i] = cv_ * sigmoidf_(cv_); if ((i & 7) == 7) SB(); } \
    LDS_WAIT(); } while (0)
#define DL_NORM(SQ, scale) do { \
    _Pragma("unroll") for (int i = 0; i < 64; ++i) *(LAS unsigned short*)((SQ) + i * 144 + lane * 2) = (unsigned short)f2bf(cval[i] * cval[i]); \
    LDS_WAIT(); \
    { float sm_ = 0.f; _Pragma("unroll") for (int c8 = 0; c8 < 8; ++c8) { const v4u w_ = *(const LAS v4u*)((SQ) + lane * 144 + c8 * 16); \
          sm_ += (bflo(w_.x) + bfhi(w_.x)) + (bflo(w_.y) + bfhi(w_.y)) + (bflo(w_.z) + bfhi(w_.z)) + (bflo(w_.w) + bfhi(w_.w)); } \
      tab[192 + lane] = (scale) / sqrtf(sm_ + EPS); } \
    LDS_WAIT(); \
    _Pragma("unroll") for (int i4 = 0; i4 < 16; ++i4) { const f32x4 r4_ = *(const LAS f32x4*)(tab + 192 + 4 * i4); cval[4 * i4] *= r4_.x; cval[4 * i4 + 1] *= r4_.y; cval[4 * i4 + 2] *= r4_.z; cval[4 * i4 + 3] *= r4_.w; } \
    } while (0)

__device__ __forceinline__ void d1_instance(Frame& F, const int layer, const int b, const int h, const int norig, const int dir, LAS unsigned char* W, LAS float* tab) {
    int lane = F.lane, r32, hi; LAUNDER();
    const bf16* P = (const bf16*)(F.ws + WS_PROJ);
    const float* cwp = F.in[I_DCONVW] + (size_t)layer * 5 * 768;
    const int s0 = norig * 64, tok0 = b * SEQ + s0;
    const int npr = dir ? 255 - norig : norig;
    const int inst = ((b * 4 + h) * 2 + dir) * NCHUNK + npr;
    LAS unsigned char* VT = W;
    LAS unsigned char* KT = W + MB;
    LAS unsigned char* KR = W + 2 * MB;
    LAS unsigned char* T2 = W + 3 * MB;
    LAS float* SM = (LAS float*)(W + 2 * MB);
    float cval[64];
    DL_CONV(C_DK + 64 * h, 256 + 64 * h, T2);
    DL_NORM(VT, 1.f);
#pragma unroll
    for (int i = 0; i < 64; ++i) { const int ip = dir ? 63 - i : i; const unsigned short kb = (unsigned short)f2bf(cval[i]);
        *(LAS unsigned short*)(KR + ip * (MP * 2) + lane * 2) = kb; *(LAS unsigned short*)(KT + lane * (MP * 2) + ip * 2) = kb; }
    LDS_WAIT();
    DL_CONV(C_DV + 64 * h, 512 + 64 * h, T2);
#pragma unroll
    for (int i = 0; i < 64; ++i) { const int ip = dir ? 63 - i : i; *(LAS unsigned short*)(VT + lane * (MP * 2) + ip * 2) = (unsigned short)f2bf(cval[i]); }
    const int mytok = tok0 + (dir ? 63 - lane : lane);
    const float* BD = (const float*)(F.ws + WS_BD) + (size_t)mytok * 16;
    const float beta = BD[dir * 4 + h]; float gc = BD[8 + dir * 4 + h];
#pragma unroll
    for (int o = 1; o < 64; o <<= 1) { const float t = __shfl_up(gc, o); if (lane >= o) gc += t; }
    const float gl = __shfl(gc, 63);
    tab[lane] = gc; tab[64 + lane] = beta; tab[128 + lane] = __expf(gl - gc);
    LDS_WAIT();
    LAUNDER();
    f32x16 kk[2][2];
#pragma unroll
    for (int tb = 0; tb < 2; ++tb)
#pragma unroll
        for (int tn = 0; tn < 2; ++tn) { f32x16 acc = zero16();
#pragma unroll
            for (int ks = 0; ks < 4; ++ks) acc = MFMA32(ldfrag(KR, r32 + 32 * tb, 16 * ks + 8 * hi), ldfrag(KR, r32 + 32 * tn, 16 * ks + 8 * hi), acc);
            kk[tb][tn] = acc; SB(); }
    LDS_WAIT();
#pragma unroll
    for (int tb = 0; tb < 2; ++tb)
#pragma unroll
        for (int tn = 0; tn < 2; ++tn) {
            const int jc = r32 + 32 * tn; const float gcj = tab[jc];
#pragma unroll
            for (int r = 0; r < 16; ++r) { const int ir = 32 * tb + crow(r, hi); const float gci = tab[ir], bi = tab[64 + ir];
                const float mv = (ir > jc) ? bi * kk[tb][tn][r] * __expf(gci - gcj) : 0.f; SM[ir * 64 + jc] = mv; } SB(); }
    LDS_WAIT();
    LAUNDER();
    float T[64];
#pragma unroll
    for (int i = 0; i < 64; ++i) {
        float a0 = (lane == i) ? 1.f : 0.f, a1 = 0.f, a2 = 0.f, a3 = 0.f;
#pragma unroll
        for (int j4 = 0; j4 < (i + 3) / 4; ++j4) { const f32x4 m4 = *(const LAS f32x4*)(SM + i * 64 + 4 * j4);
            if (4 * j4 + 0 < i) a0 = __builtin_fmaf(-m4[0], T[4 * j4 + 0], a0);
            if (4 * j4 + 1 < i) a1 = __builtin_fmaf(-m4[1], T[4 * j4 + 1], a1);
            if (4 * j4 + 2 < i) a2 = __builtin_fmaf(-m4[2], T[4 * j4 + 2], a2);
            if (4 * j4 + 3 < i) a3 = __builtin_fmaf(-m4[3], T[4 * j4 + 3], a3); }
        T[i] = (a0 + a1) + (a2 + a3); if ((i & 3) == 3) SB(); }
    LDS_WAIT();
    LAUNDER();
    { const float b1 = beta, b2 = beta * __expf(gc);
#pragma unroll
      for (int i = 0; i < 64; ++i) { *(LAS unsigned short*)(KR + i * (MP * 2) + lane * 2) = (unsigned short)f2bf(T[i] * b1); *(LAS unsigned short*)(T2 + i * (MP * 2) + lane * 2) = (unsigned short)f2bf(T[i] * b2); if ((i & 7) == 7) SB(); } }
    LDS_WAIT();
    LAUNDER();
    f32x16 u[2][2], w[2][2];
#pragma unroll
    for (int tb = 0; tb < 2; ++tb)
#pragma unroll
        for (int tn = 0; tn < 2; ++tn) { f32x16 au = zero16(), aw = zero16();
#pragma unroll
            for (int ks = 0; ks < 4; ++ks) { au = MFMA32(ldfrag(KR, r32 + 32 * tb, 16 * ks + 8 * hi), ldfrag(VT, r32 + 32 * tn, 16 * ks + 8 * hi), au);
                                             aw = MFMA32(ldfrag(T2, r32 + 32 * tb, 16 * ks + 8 * hi), ldfrag(KT, r32 + 32 * tn, 16 * ks + 8 * hi), aw); }
            u[tb][tn] = au; w[tb][tn] = aw; SB(); }
    LAUNDER();
    { unsigned* ud = (unsigned*)(F.ws + WS_UW + (size_t)inst * 16384); bf16* wd = (bf16*)(F.ws + WS_UW + (size_t)inst * 16384 + 8192);
#pragma unroll
      for (int tb = 0; tb < 2; ++tb)
#pragma unroll
          for (int tn = 0; tn < 2; ++tn) {
#pragma unroll
              for (int rp = 0; rp < 8; ++rp) ud[((tb * 2 + tn) * 8 + rp) * 64 + lane] = pk2(u[tb][tn][2 * rp], u[tb][tn][2 * rp + 1]);
#pragma unroll
              for (int r = 0; r < 16; ++r) wd[(32 * tb + crow(r, hi)) * 64 + r32 + 32 * tn] = (bf16)f2bf(w[tb][tn][r]); SB(); } }
    LAUNDER();
#pragma unroll
    for (int tb = 0; tb < 2; ++tb)
#pragma unroll
        for (int r = 0; r < 16; ++r) { const float e = tab[128 + 32 * tb + crow(r, hi)];
#pragma unroll
            for (int tn = 0; tn < 2; ++tn) { u[tb][tn][r] *= e; w[tb][tn][r] *= e; } }
    SB();
    bf16x8 kf[2][4];
#pragma unroll
    for (int tbb = 0; tbb < 2; ++tbb)
#pragma unroll
        for (int s = 0; s < 4; ++s) kf[tbb][s] = ldfragp(KT, r32 + 32 * tbb, 16 * s + 4 * hi);
    LDS_WAIT(); SB();
    LAUNDER();
    LAS unsigned char* AR = VT; LAS unsigned char* BT = KR;
#pragma unroll
    for (int tbb = 0; tbb < 2; ++tbb)
#pragma unroll
        for (int tx = 0; tx < 2; ++tx) { f32x16 aa = zero16(), ab = zero16();
#pragma unroll
            for (int s = 0; s < 4; ++s) { aa = MFMA32(cfrag(w[s >> 1][tx], s & 1), kf[tbb][s], aa); ab = MFMA32(kf[tbb][s], cfrag(u[s >> 1][tx], s & 1), ab); }
#pragma unroll
            for (int g4 = 0; g4 < 4; ++g4) {
                const v2u pa = {pk2(-aa[4 * g4], -aa[4 * g4 + 1]), pk2(-aa[4 * g4 + 2], -aa[4 * g4 + 3])};
                *(LAS v2u*)(AR + (r32 + 32 * tbb) * (MP * 2) + (32 * tx + 8 * g4 + 4 * hi) * 2) = pa;
                const v2u pb = {pk2(ab[4 * g4], ab[4 * g4 + 1]), pk2(ab[4 * g4 + 2], ab[4 * g4 + 3])};
                *(LAS v2u*)(BT + (r32 + 32 * tx) * (MP * 2) + (32 * tbb + 8 * g4 + 4 * hi) * 2) = pb;
            } SB(); }
    LDS_WAIT();
    LAUNDER();
    { unsigned char* ab = F.ws + WS_AB + (size_t)inst * 16384; const int m16 = lane & 15, g = lane >> 4;
#pragma unroll
      for (int rb = 0; rb < 4; ++rb)
#pragma unroll
          for (int ks = 0; ks < 2; ++ks) { const v2u lo = *(const LAS v2u*)(AR + (16 * rb + m16) * (MP * 2) + (32 * ks + 4 * g) * 2), hi8 = *(const LAS v2u*)(AR + (16 * rb + m16) * (MP * 2) + (32 * ks + 16 + 4 * g) * 2);
              const v4u t = {lo.x, lo.y, hi8.x, hi8.y}; *(GAS v4u*)(ab + ((rb * 2 + ks) * 64 + lane) * 16) = t; }
#pragma unroll
      for (int sl = 0; sl < 4; ++sl)
#pragma unroll
          for (int rb = 0; rb < 4; ++rb) { const v2u t = *(const LAS v2u*)(BT + (16 * sl + m16) * (MP * 2) + (16 * rb + 4 * g) * 2); *(GAS v2u*)(ab + 8192 + ((sl * 4 + rb) * 64 + lane) * 8) = t; } }
    if (lane == 0) ((float*)(F.ws + WS_DEC))[inst] = __expf(gl);
    LDS_WAIT();
}
__device__ __forceinline__ void pc_side_tasks(Frame& F, const int layer, const int half) {
    if (F.wave == 4) {
        LAS unsigned char* mimg = F.lds + RING_OFF + 4 * WAVE_LDS + 4096;
        for (int tile = F.vcu + half * F.G; tile < NTOK / 64; tile += 2 * F.G)
            for (int g = 0; g < 4; ++g) pc::pool_task(F, layer, tile, g, mimg);
    } else if (F.wave > 4) {
        int k = 0;
        for (int tile = F.vcu + half * F.G; tile < NTOK / 64; tile += 2 * F.G)
            for (int cg = 0; cg < 4; ++cg, ++k) if (k % 3 == F.wave - 5) pc::conv_task(F, layer, tile, cg);
    }
}
__device__ __forceinline__ void d1_phase(Frame& F, const int layer) {
    if (F.wave < 4) {
        LAS unsigned char* W = F.lds + RING_OFF + F.wave * WAVE_LDS; LAS float* tab = (LAS float*)(F.lds + RING_OFF + 4 * WAVE_LDS + F.wave * 1024);
        const int gw = F.vcu * 4 + F.wave, NGW = F.G * 4;
        for (int it = gw; it < NINST; it += NGW) { const int dir = it & 1, u = it >> 1; d1_instance(F, layer, u >> 10, (u >> 8) & 3, u & 255, dir, W, tab); }
    } else pc_side_tasks(F, layer, 0);
    __syncthreads();
}

typedef float f32x4v __attribute__((ext_vector_type(4)));
struct D2Regs { v4u af[4][2]; v2u bm[4]; float dcy; };
__device__ __forceinline__ void d2_chain(Frame& F, const int chain) {
    const int lane = F.lane, n16 = lane & 15, g = lane >> 4, sl = F.wave;
    f32x4v S[4];
#pragma unroll
    for (int rb = 0; rb < 4; ++rb) S[rb] = (f32x4v){0.f, 0.f, 0.f, 0.f};
    const unsigned char* abase = F.ws + WS_AB + (size_t)chain * NCHUNK * 16384;
    unsigned char* sbase = F.ws + WS_ST + (size_t)chain * NCHUNK * 8192;
    const float* dec = (const float*)(F.ws + WS_DEC) + chain * NCHUNK;
    D2Regs q0, q1, q2;
#define D2_LOAD(Q, n) do { const unsigned char* ab_ = abase + (size_t)(n) * 16384; \
    _Pragma("unroll") for (int rb = 0; rb < 4; ++rb) { _Pragma("unroll") for (int ks = 0; ks < 2; ++ks) Q.af[rb][ks] = *(const GAS v4u*)(ab_ + ((rb * 2 + ks) * 64 + lane) * 16); \
        Q.bm[rb] = *(const GAS v2u*)(ab_ + 8192 + ((sl * 4 + rb) * 64 + lane) * 8); } Q.dcy = dec[n]; } while (0)
#define D2_STEP(Q, n) do { \
    unsigned char* st = sbase + (size_t)(n) * 8192 + (16 * sl + n16) * 128; \
    _Pragma("unroll") for (int rb = 0; rb < 4; ++rb) { const v2u t = {pk2(S[rb][0], S[rb][1]), pk2(S[rb][2], S[rb][3])}; *(GAS v2u*)(st + (16 * rb + 4 * g) * 2) = t; } \
    bf16x8 bfr[2]; \
    _Pragma("unroll") for (int ks = 0; ks < 2; ++ks) { const v4u t = {att::cvtpk(S[2 * ks][0], S[2 * ks][1]), att::cvtpk(S[2 * ks][2], S[2 * ks][3]), att::cvtpk(S[2 * ks + 1][0], S[2 * ks + 1][1]), att::cvtpk(S[2 * ks + 1][2], S[2 * ks + 1][3])}; bfr[ks] = __builtin_bit_cast(bf16x8, t); } \
    _Pragma("unroll") for (int rb = 0; rb < 4; ++rb) { const float cd = Q.dcy; \
        f32x4v c = {S[rb][0] * cd + bflo(Q.bm[rb].x), S[rb][1] * cd + bfhi(Q.bm[rb].x), S[rb][2] * cd + bflo(Q.bm[rb].y), S[rb][3] * cd + bfhi(Q.bm[rb].y)}; \
        c = __builtin_amdgcn_mfma_f32_16x16x32_bf16(__builtin_bit_cast(bf16x8, Q.af[rb][0]), bfr[0], c, 0, 0, 0); \
        c = __builtin_amdgcn_mfma_f32_16x16x32_bf16(__builtin_bit_cast(bf16x8, Q.af[rb][1]), bfr[1], c, 0, 0, 0); \
        S[rb] = c; } } while (0)
    D2_LOAD(q0, 0); D2_LOAD(q1, 1);
    for (int n = 0; n < NCHUNK - 1; n += 3) {
        D2_LOAD(q2, n + 2); D2_STEP(q0, n); SB();
        D2_LOAD(q0, n + 3); D2_STEP(q1, n + 1); SB();
        if (n + 4 < NCHUNK) D2_LOAD(q1, n + 4); D2_STEP(q2, n + 2); SB();
    }
    D2_STEP(q0, NCHUNK - 1);
#undef D2_LOAD
#undef D2_STEP
}

__device__ __forceinline__ void scan_attn_phase(Frame& F, const int layer, const int qword) {
    for (;;) {
        { unsigned char* w_ = F.ws; int t_ = F.tid; asm volatile("" : "+s"(w_), "+v"(t_)); F.ws = w_; F.ctl = (gu32*)(w_ + WS_CTL); F.tid = t_; F.lane = t_ & 63; }
        if (F.tid == 0) F.MISC[16] = __hip_atomic_fetch_add(F.ctl + CW_ATTQ + 64 * qword, 1u, RLX_AGENT);
        __syncthreads();
        const int idx = (int)F.MISC[16];
        __syncthreads();
        if (idx >= 16 + BATCH * 4 * 64) break;
        if (idx < 16) { if (F.wave < 4) d2_chain(F, idx); }
        else { const int j = idx - 16, h = 3 - (j >> 7), jj = j & 127, b = jj & 1, k = jj >> 1, qb = (k & 1) ? 31 - (k >> 1) : 32 + (k >> 1);
            att::attn_unit(F, layer, b, h, qb); }
    }
    __syncthreads();
}

__device__ __forceinline__ void d3_unit(Frame& F, const int layer, const int b, const int h, const int norig, LAS unsigned char* W, LAS float* tab) {
    int lane = F.lane, r32, hi; LAUNDER();
    const bf16* P = (const bf16*)(F.ws + WS_PROJ);
    const float* cwp = F.in[I_DCONVW] + (size_t)layer * 5 * 768;
    const int s0 = norig * 64, tok0 = b * SEQ + s0;
    LAS unsigned char* QR = W;
    LAS unsigned char* KR = W + MB;
    LAS unsigned char* AT = W + 2 * MB;
    LAS unsigned char* WR = W + 3 * MB;
    { float cval[64];
      DL_CONV(C_DQ + 64 * h, 64 * h, WR);
      DL_NORM(AT, 0.125f);
#pragma unroll
      for (int i = 0; i < 64; ++i) *(LAS unsigned short*)(QR + i * (MP * 2) + lane * 2) = (unsigned short)f2bf(cval[i]);
      LDS_WAIT();
      DL_CONV(C_DK + 64 * h, 256 + 64 * h, WR);
      DL_NORM(AT, 1.f);
#pragma unroll
      for (int i = 0; i < 64; ++i) *(LAS unsigned short*)(KR + i * (MP * 2) + lane * 2) = (unsigned short)f2bf(cval[i]);
      LDS_WAIT(); }
    f32x16 of[2][2];
#pragma unroll
    for (int dir = 0; dir < 2; ++dir) {
        LAUNDER();
        const int npr = dir ? 255 - norig : norig;
        const int inst = ((b * 4 + h) * 2 + dir) * NCHUNK + npr;
        const int mytok = tok0 + (dir ? 63 - lane : lane);
        float gc = ((const float*)(F.ws + WS_BD))[(size_t)mytok * 16 + 8 + dir * 4 + h];
#pragma unroll
        for (int o = 1; o < 64; o <<= 1) { const float t = __shfl_up(gc, o); if (lane >= o) gc += t; }
        tab[lane] = gc; tab[64 + lane] = __expf(gc);
        { const unsigned char* wg = F.ws + WS_UW + (size_t)inst * 16384 + 8192;
#pragma unroll
          for (int i = 0; i < 8; ++i) { const int idx = i * 64 + lane, row = idx >> 3, ch = idx & 7; const v4u c = *(const GAS v4u*)(wg + idx * 16); *(LAS v4u*)(WR + row * (MP * 2) + ch * 16) = c; } }
        LDS_WAIT();
        LAUNDER();
        const int ra0 = dir ? 63 - r32 : r32, ra1 = dir ? 31 - r32 : 32 + r32;
        f32x16 qk[2][2];
#pragma unroll
        for (int tb = 0; tb < 2; ++tb)
#pragma unroll
            for (int tn = 0; tn < 2; ++tn) { f32x16 acc = zero16();
#pragma unroll
                for (int ks = 0; ks < 4; ++ks) acc = MFMA32(ldfrag(QR, tb ? ra1 : ra0, 16 * ks + 8 * hi), ldfrag(KR, tn ? ra1 : ra0, 16 * ks + 8 * hi), acc);
                qk[tb][tn] = acc; SB(); }
        LDS_WAIT();
#pragma unroll
        for (int tb = 0; tb < 2; ++tb)
#pragma unroll
            for (int tn = 0; tn < 2; ++tn) { const int jc = r32 + 32 * tn; const float gcj = tab[jc];
#pragma unroll
                for (int r = 0; r < 16; ++r) { const int ir = 32 * tb + crow(r, hi); const float gci = tab[ir];
                    const float av = (ir >= jc) ? qk[tb][tn][r] * __expf(gci - gcj) : 0.f; *(LAS unsigned short*)(AT + ir * (MP * 2) + jc * 2) = (unsigned short)f2bf(av); } SB(); }
        LDS_WAIT();
        LAUNDER();
        const unsigned* ud = (const unsigned*)(F.ws + WS_UW + (size_t)inst * 16384);
        const unsigned char* sg = F.ws + WS_ST + (size_t)inst * 8192;
#pragma unroll
        for (int tn = 0; tn < 2; ++tn) {
            bf16x8 sf[4];
#pragma unroll
            for (int ks = 0; ks < 4; ++ks) sf[ks] = *(const GAS bf16x8*)(sg + ((r32 + 32 * tn) * 64 + 16 * ks + 8 * hi) * 2);
            f32x16 vn[2], o[2];
#pragma unroll
            for (int tb = 0; tb < 2; ++tb) { f32x16 a1 = zero16(), a2 = zero16();
#pragma unroll
                for (int ks = 0; ks < 4; ++ks) { a1 = MFMA32(ldfrag(WR, r32 + 32 * tb, 16 * ks + 8 * hi), sf[ks], a1); a2 = MFMA32(ldfrag(QR, tb ? ra1 : ra0, 16 * ks + 8 * hi), sf[ks], a2); }
#pragma unroll
                for (int rp = 0; rp < 8; ++rp) { const unsigned uw = ud[((tb * 2 + tn) * 8 + rp) * 64 + lane]; a1[2 * rp] = bflo(uw) - a1[2 * rp]; a1[2 * rp + 1] = bfhi(uw) - a1[2 * rp + 1]; }
#pragma unroll
                for (int r = 0; r < 16; ++r) a2[r] *= tab[64 + 32 * tb + crow(r, hi)];
                vn[tb] = a1; o[tb] = a2; SB(); }
#pragma unroll
            for (int tb = 0; tb < 2; ++tb) { f32x16 acc = o[tb];
#pragma unroll
                for (int s = 0; s < 4; ++s) acc = MFMA32(ldfragp(AT, r32 + 32 * tb, 16 * s + 4 * hi), cfrag(vn[s >> 1], s & 1), acc);
                o[tb] = acc; SB(); }
            if (dir == 0) { of[0][tn] = o[0]; of[1][tn] = o[1]; }
            else {
#pragma unroll
                for (int tb = 0; tb < 2; ++tb)
#pragma unroll
                    for (int r = 0; r < 16; ++r) of[tb][tn][r] += __shfl_xor(o[1 - tb][15 - r], 32);
            }
        }
        LDS_WAIT();
    }
    const float* dn = F.in[I_DNORM] + layer * 64;
#pragma unroll
    for (int tb = 0; tb < 2; ++tb)
#pragma unroll
        for (int r = 0; r < 16; ++r) {
            float ss = of[tb][0][r] * of[tb][0][r] + of[tb][1][r] * of[tb][1][r];
#pragma unroll
            for (int o = 1; o < 32; o <<= 1) ss += __shfl_xor(ss, o);
            const float rs = 1.f / sqrtf(ss * (1.f / 64.f) + EPS);
            const int tok = tok0 + 32 * tb + crow(r, hi);
#pragma unroll
            for (int tn = 0; tn < 2; ++tn) { const int dv = r32 + 32 * tn; const float z = bf2f(P[(size_t)tok * PJ + C_DZ + 64 * h + dv]);
                ((bf16*)(F.ws + WS_O4))[(size_t)tok * 1024 + 768 + 64 * h + dv] = (bf16)f2bf(of[tb][tn][r] * rs * dn[dv] * siluf_(z)); }
        }
}
__device__ __forceinline__ void d3_phase(Frame& F, const int layer) {
    if (F.wave < 4) {
        LAS unsigned char* W = F.lds + RING_OFF + F.wave * WAVE_LDS; LAS float* tab = (LAS float*)(F.lds + RING_OFF + 4 * WAVE_LDS + F.wave * 1024);
        const int gw = F.vcu * 4 + F.wave, NGW = F.G * 4;
        for (int u = gw; u < BATCH * 4 * NCHUNK; u += NGW) d3_unit(F, layer, u >> 10, (u >> 8) & 3, u & 255, W, tab);
    } else pc_side_tasks(F, layer, 1);
    __syncthreads();
}
#undef MFMA32
}

#ifndef ONLY_SITE
#define ONLY_SITE -1
#endif
#define SITE(k) (ONLY_SITE < 0 || ONLY_SITE == (k))
#ifndef PROBE_MASK
#define PROBE_MASK 0
#endif
#ifndef PROBE_N
#define PROBE_N 2
#endif
#define REPEAT(k) for (int rep_ = 0; rep_ < (((PROBE_MASK >> (k)) & 1) ? PROBE_N : 1); ++rep_)
#ifndef MK_SPLIT
#define MK_SPLIT 0
#endif
struct Args { const float* in[30]; float* out; unsigned char* ws; int ph_lo, ph_hi; };
constexpr int N_PHASES = 1 + 16 * NLAYER + 1;

#define IN_PH() (pid >= lo && pid < hi)
#define FRESH() do { unsigned char* w_ = args.ws; float* o_ = args.out; int t_ = F.wave * 64 + (int)__builtin_amdgcn_mbcnt_hi(~0u, __builtin_amdgcn_mbcnt_lo(~0u, 0u)); asm volatile("" : "+s"(w_), "+s"(o_), "+v"(t_)); F.ws = w_; F.out = o_; F.ctl = (gu32*)(w_ + WS_CTL); F.tid = t_; F.lane = t_ & 63; } while (0)
#define SEAM() do { if (!MK_SPLIT && pid >= lo && pid + 1 < hi) xcd_barrier(bar); ++pid; } while (0)
#define NOSEAM() do { ++pid; } while (0)

template <int l> __device__ __forceinline__ void layer_phases(Frame& F, const Args& args, const XcdBarrier& bar, const int lo, const int hi, int& pid) {
    LAS unsigned char* ring = F.lds + RING_OFF;

        if constexpr (l == 0) { if (IN_PH() && SITE(1)) REPEAT(1) { FRESH(); p_rows<ROW_A>(F, 0); } SEAM(); } else { NOSEAM(); }
        if (IN_PH() && SITE(2)) REPEAT(2) { FRESH();
            pg8::SchedStd S; S.init(NTOK / 256, NPROJ / 256, F.G, (int)blockIdx.x, F.ws + WS_H, (size_t)256 * D * 2, w_in_t(F.ws, l), (size_t)256 * D * 2);
            pg8::EpiProj E{(bf16*)(F.ws + WS_QB), (bf16*)(F.ws + WS_KV), (bf16*)(F.ws + WS_PROJ), (unsigned*)(F.ctl + CW_NMAX) + l * 16, QSCALE};
            pg8::gemm_phase<pg8::EpiProj, pg8::SchedStd, D, D, D>(ring, F.tid, S, E);
        }
        SEAM();
        NOSEAM();
        if (IN_PH() && SITE(5)) REPEAT(5) { FRESH(); dl::d1_phase(F, l); }
        SEAM();
        if (IN_PH() && SITE(3)) REPEAT(3) { FRESH(); dl::scan_attn_phase(F, l, l * 2 + rep_); }
        SEAM();
        NOSEAM();
        if (IN_PH() && SITE(7)) REPEAT(7) { FRESH(); dl::d3_phase(F, l); }
        SEAM();
        if (IN_PH() && SITE(8)) REPEAT(8) { FRESH();
            pg8::SchedBranch S; S.s.init(NTOK / 256, 16, F.G, (int)blockIdx.x, nullptr, 0, nullptr, 0); S.O4 = (const char*)(F.ws + WS_O4); S.Wb = (const char*)w_b_t(F.ws, l);
            pg8::EpiStore E{(bf16*)(F.ws + WS_PBUF), 1024, (size_t)NTOK * 1024, 1.f};
            pg8::gemm_phase<pg8::EpiStore, pg8::SchedBranch, 256, 1024, 256>(ring, F.tid, S, E);
        }
        SEAM();
        if (IN_PH() && SITE(9)) REPEAT(9) { FRESH();
            pg8::SchedGate S{F.vcu, F.G, (const char*)(F.ws + WS_H), (const char*)w_m_t(F.ws, l)};
            pg8::EpiGate E{(const bf16*)(F.ws + WS_PBUF), (bf16*)(F.ws + WS_MERGED), F.in[I_BMERGE] + (size_t)l * 4 * D};
            pg8::gemm_phase<pg8::EpiGate, pg8::SchedGate, D, D, D>(ring, F.tid, S, E);
        }
        SEAM();
        if (IN_PH() && SITE(10)) REPEAT(10) { FRESH();
            pg8::SchedStd S; S.init(NTOK / 256, D / 256, F.G, (int)blockIdx.x, F.ws + WS_MERGED, (size_t)256 * D * 2, w_o_t(F.ws, l), (size_t)256 * D * 2);
            pg8::EpiStore E{(bf16*)(F.ws + WS_F), D, 0, 1.f};
            pg8::gemm_phase<pg8::EpiStore, pg8::SchedStd, D, D, D>(ring, F.tid, S, E);
        }
        SEAM();
        if (IN_PH() && SITE(11)) REPEAT(11) { FRESH(); p_rows<ROW_B>(F, l); }
        SEAM();
        if constexpr (l == 0) {
            if (IN_PH() && SITE(12)) REPEAT(12) { FRESH();
                pg8::SchedStd S; S.init(NTOK / 256, 2 * DFF / 256, F.G, (int)blockIdx.x, F.ws + WS_H, (size_t)256 * D * 2, F.ws + WS_WFFN, (size_t)256 * D * 2);
                pg8::EpiSwiGLU<false> E{(bf16*)(F.ws + WS_ACT0), DFF};
                pg8::gemm_phase<pg8::EpiSwiGLU<false>, pg8::SchedStd, D, D, D>(ring, F.tid, S, E);
            }
            SEAM();
            if (IN_PH() && SITE(13)) REPEAT(13) { FRESH();
                pg8::SchedStd S; S.init(NTOK / 256, D / 256, F.G, (int)blockIdx.x, F.ws + WS_ACT0, (size_t)256 * DFF * 2, F.ws + WS_WFFN + SZ_WGU, (size_t)256 * DFF * 2);
                pg8::EpiStore E{(bf16*)(F.ws + WS_F), D, 0, 1.f};
                pg8::gemm_phase<pg8::EpiStore, pg8::SchedStd, DFF, DFF, DFF>(ring, F.tid, S, E);
            }
            SEAM();
            if (IN_PH() && SITE(14)) REPEAT(14) { FRESH(); p_rows<ROW_C>(F, 0); }
            SEAM();
            NOSEAM(); NOSEAM();
        } else {
            if (IN_PH() && SITE(15)) REPEAT(15) { FRESH(); p_moe_cvt(F); }
            SEAM();
#pragma unroll 1
            for (int pass = 0; pass < MOE_NPASS; ++pass) {
                if (IN_PH() && SITE(16)) REPEAT(16) { FRESH();
                    constexpr int EB = MOE_FP8 ? 1 : 2;
                    pg8::SchedMoe S; S.c = (int)blockIdx.x; S.G = F.G; S.nN = 2 * DFF / 256; moe_tiles(F, S.cnt, S.tstart);
                    S.t0 = pass * MOE_PASS_TILES; S.t1 = S.tstart[8] < (pass + 1) * MOE_PASS_TILES ? S.tstart[8] : (pass + 1) * MOE_PASS_TILES;
                    S.lists = (const int*)(F.ws + WS_ROUTE + 1 * MiB); S.W = (const char*)(F.ws + WS_MOEW); S.w_tile = (size_t)256 * D * EB; S.exp_stride = SZ_FFNW / 2 * EB;
#if MOE_FP8
                    S.A = (const char*)(F.ws + WS_XG); S.gather = false; S.act_tile = (size_t)256 * D;
                    pg8::EpiSwiGLU<true> E{(bf16*)(F.ws + WS_ACT1), DFF};
                    pg8::gemm_phase<pg8::EpiSwiGLU<true>, pg8::SchedMoe, D / 2, D / 2, D / 2, false, true>(ring, F.tid, S, E);
#else
                    S.A = (const char*)(F.ws + WS_H2B); S.gather = true; S.act_tile = 0;
                    pg8::EpiSwiGLU<false> E{(bf16*)(F.ws + WS_ACT1), DFF};
                    pg8::gemm_phase<pg8::EpiSwiGLU<false>, pg8::SchedMoe, D, D, D, true, false>(ring, F.tid, S, E);
#endif
                }
                SEAM();
                if (IN_PH() && SITE(17)) REPEAT(17) { FRESH();
                    constexpr int EB = MOE_FP8 ? 1 : 2;
                    pg8::SchedMoe S; S.c = (int)blockIdx.x; S.G = F.G; S.nN = D / 256; moe_tiles(F, S.cnt, S.tstart);
                    S.t0 = pass * MOE_PASS_TILES; S.t1 = S.tstart[8] < (pass + 1) * MOE_PASS_TILES ? S.tstart[8] : (pass + 1) * MOE_PASS_TILES;
                    S.A = (const char*)(F.ws + WS_ACT1); S.lists = nullptr; S.W = (const char*)(F.ws + WS_MOEW + SZ_WGU / 2 * EB); S.w_tile = (size_t)256 * DFF * EB; S.gather = false;
                    S.exp_stride = SZ_FFNW / 2 * EB; S.act_tile = (size_t)256 * DFF * EB;
#if MOE_FP8
                    pg8::EpiStore64 E{(bf16*)(F.ws + WS_Y)};
                    pg8::gemm_phase<pg8::EpiStore64, pg8::SchedMoe, DFF * EB / 2, DFF * EB / 2, DFF * EB / 2, false, true>(ring, F.tid, S, E);
#else
                    pg8::EpiStore E{(bf16*)(F.ws + WS_Y), D, 0, 1.f};
                    pg8::gemm_phase<pg8::EpiStore, pg8::SchedMoe, DFF * EB / 2, DFF * EB / 2, DFF * EB / 2, false, false>(ring, F.tid, S, E);
#endif
                }
                SEAM();
            }
            if constexpr (MOE_NPASS == 1) { NOSEAM(); NOSEAM(); }
        }
    }

__global__ void __launch_bounds__(NWAVES * 64, 2) fwd_kernel(const Args args) {
    extern __shared__ __attribute__((aligned(16))) unsigned char lds[];
    Frame F;
    F.lds = (LAS unsigned char*)lds;
    F.MISC = (volatile LAS unsigned*)(F.lds + MISC_OFF);
    F.tid = threadIdx.x; F.lane = F.tid & 63; F.wave = __builtin_amdgcn_readfirstlane(F.tid >> 6);
    F.G = gridDim.x; { const int bx = blockIdx.x; F.vcu = (F.G % 8 == 0) ? (bx % 8) * (F.G / 8) + bx / 8 : bx; }
    F.ws = args.ws; F.out = args.out; F.ctl = (gu32*)(args.ws + WS_CTL);
    F.in = args.in;
    if (F.tid < 64) ((LAS unsigned*)(F.lds + MISC_OFF))[F.tid] = 0u;
    __syncthreads();
    XcdBarrier bar; bar.bar = (unsigned*)(F.ctl + CW_BAR); bar.x = 0; bar.st = nullptr;
    if (!MK_SPLIT) bar = xcd_barrier_post((unsigned*)(F.ctl + CW_BAR), F.MISC + 8);
    const int lo = args.ph_lo, hi = args.ph_hi;
    int pid = 0;
    LAS unsigned char* ring = F.lds + RING_OFF;

    if (IN_PH() && SITE(0)) REPEAT(0) { FRESH(); p_prologue(F); }
    SEAM();
    layer_phases<0>(F, args, bar, lo, hi, pid);
    layer_phases<1>(F, args, bar, lo, hi, pid);
    if (IN_PH() && SITE(18)) REPEAT(18) { FRESH(); p_rows<ROW_C>(F, 1); }
#undef IN_PH
#undef SEAM
#undef NOSEAM
}

extern "C" void kernel_launch(void* const* d_in, const int* in_sizes, int n_in, void* d_out, int out_size, void* d_ws, size_t ws_size, hipStream_t stream) {
    static int grid = 0;
    if (grid == 0) {
        if (n_in != N_INPUTS || in_sizes[0] != NTOK * D || out_size != NTOK * D || ws_size < WS_END) {
            fprintf(stderr, "kernel_launch: unexpected problem (n_in %d, in0 %d, out %d, ws %zu < %zu); nothing launched\n", n_in, n_in > 0 ? in_sizes[0] : -1, out_size, ws_size, (size_t)WS_END); grid = -1; return; }
        int dev = 0, cus = 0, per_cu = 0;
        if (hipGetDevice(&dev) != hipSuccess || hipDeviceGetAttribute(&cus, hipDeviceAttributeMultiprocessorCount, dev) != hipSuccess) { grid = -1; return; }
        if (hipFuncSetAttribute((const void*)fwd_kernel, hipFuncAttributeMaxDynamicSharedMemorySize, LDS_BYTES) != hipSuccess) { fprintf(stderr, "kernel_launch: hipFuncSetAttribute failed\n"); grid = -1; return; }
        if (hipOccupancyMaxActiveBlocksPerMultiprocessor(&per_cu, (const void*)fwd_kernel, NWAVES * 64, LDS_BYTES) != hipSuccess || per_cu < 1)
            fprintf(stderr, "kernel_launch: note: occupancy query reports %d workgroups per CU\n", per_cu);
        (void)hipGetLastError();
        grid = cus;
    }
    if (grid < 0) return;
    if (hipMemsetAsync((char*)d_ws + WS_CTL, 0, CTL_ZERO_BYTES, stream) != hipSuccess) return;
    Args a{};
    for (int i = 0; i < 30; ++i) a.in[i] = (const float*)d_in[i];
    a.out = (float*)d_out; a.ws = (unsigned char*)d_ws;
#if MK_SPLIT
    for (int p = 0; p < N_PHASES; ++p) { a.ph_lo = p; a.ph_hi = p + 1; hipLaunchKernelGGL(fwd_kernel, dim3(grid), dim3(NWAVES * 64), LDS_BYTES, stream, a); }
#else
    a.ph_lo = 0; a.ph_hi = N_PHASES;
    hipLaunchKernelGGL(fwd_kernel, dim3(grid), dim3(NWAVES * 64), LDS_BYTES, stream, a);
#endif
}
```

```cpp
#include <hip/hip_runtime.h>
#include <cstdio>
#include <cstdint>

namespace pg8 {
#define PG8_LAS __attribute__((address_space(3)))
typedef unsigned short bf16_t;
typedef short bf16x8 __attribute__((ext_vector_type(8)));
typedef float f32x4 __attribute__((ext_vector_type(4)));
typedef unsigned u32x4 __attribute__((ext_vector_type(4)));
typedef unsigned u32x2 __attribute__((ext_vector_type(2)));
typedef int i32x4 __attribute__((ext_vector_type(4)));
constexpr int BM = 256, BK = 64, HALF = 128, HTB = HALF * BK * 2  , STAGE_BYTES = 8 * HTB;

__host__ __device__ __forceinline__ int lds_byte(int r, int c) { const int st = (r >> 4) * 2 + (c >> 5), rr = r & 15, cc = c & 31, ob = rr * 64 + cc * 2; return st * 1024 + (ob ^ (((ob >> 9) & 1) << 5)); }
__host__ __device__ __forceinline__ void stage_rc(int b, int& R, int& C) { const int st = b / 1024, sb = b % 1024, swz = sb ^ (((sb >> 9) & 1) << 5); R = (st >> 1) * 16 + swz / 64; C = (st & 1) * 32 + (swz % 64) / 2; }
__host__ __device__ __forceinline__ int perm32(int rho) { const int n = rho >> 4, i = rho & 15; return 8 * (i >> 2) + 4 * n + (i & 3); }

struct Unit { int pm, pn, aux, nt; const char* a; const char* b; const int* rows; };

__device__ __forceinline__ unsigned cvt_pk_bf16(float lo, float hi) { unsigned r; asm volatile("v_cvt_pk_bf16_f32 %0, %1, %2" : "=v"(r) : "v"(lo), "v"(hi)); return r; }


__device__ __forceinline__ const char* uniform_ptr(const char* p) { const unsigned long long v = (unsigned long long)p; return (const char*)(((unsigned long long)(unsigned)__builtin_amdgcn_readfirstlane((int)(v >> 32)) << 32) | (unsigned)__builtin_amdgcn_readfirstlane((int)(unsigned)v)); }
template <class Epi, class Sched, int K, int lda, int ldb, bool GATHER = false, bool FP8 = false, bool ALIGN_EPI = true, bool SP2 = true>
__device__ __forceinline__ void gemm_phase(PG8_LAS unsigned char* lds, const int tid, const Sched& S, const Epi& E) {
    const int wid = __builtin_amdgcn_readfirstlane(tid >> 6), lane = tid & 63, wr = wid >> 2, wc = wid & 3, fr = lane & 15, fq = lane >> 4;
    constexpr int ntK = K / BK;
    int Rs[2], Cs[2]; unsigned voffB[2];
#pragma unroll
    for (int i = 0; i < 2; ++i) { int R, C; stage_rc(tid * 16 + i * 8192, R, C); const int Rb = Epi::PERM ? ((R & ~31) + perm32(R & 31)) : R; Rs[i] = R; Cs[i] = C; voffB[i] = (unsigned)(Rb * ldb + C) * 2u; }
    const size_t kstep = (size_t)(BK * 2);
    const size_t hstepB = (size_t)HALF * ldb * 2;
    constexpr unsigned hstepA = GATHER ? 0u : (unsigned)HALF * lda * 2u;
    const unsigned ldsw = (unsigned)wid * 1024u;
    const int aoff = lds_byte(wr * 64 + fr, fq * 8), boff = lds_byte(wc * 32 + fr, fq * 8);
#define PG8_SA(b, h) (((b) * 2 + (h)) * HTB)
#define PG8_SB(b, h) ((4 + (b) * 2 + (h)) * HTB)
#define PG8_RSRC(p) __builtin_amdgcn_make_buffer_rsrc((void*)pg8::uniform_ptr((const char*)(p)), 0, 0x7fffffff, 0x00020000)
#define PG8_STAGE(bufoff, gbase, soff, voff) do { const __amdgpu_buffer_rsrc_t r_ = PG8_RSRC(gbase); _Pragma("unroll") for (int _i = 0; _i < 2; ++_i) \
        __builtin_amdgcn_raw_ptr_buffer_load_lds(r_, (PG8_LAS unsigned*)(lds + (bufoff) + ldsw + _i * 8192), 16, (voff)[_i], (int)(soff), 0, 0); } while (0)
#define PG8_LDA(dst, b, h) do { _Pragma("unroll") for (int m = 0; m < 4; ++m) _Pragma("unroll") for (int k = 0; k < 2; ++k) dst[m][k] = *(const PG8_LAS bf16x8*)(lds + PG8_SA(b, h) + aoff + m * 2048 + k * 1024); } while (0)
#define PG8_LDB(dst, b, h) do { _Pragma("unroll") for (int n = 0; n < 2; ++n) _Pragma("unroll") for (int k = 0; k < 2; ++k) dst[n][k] = *(const PG8_LAS bf16x8*)(lds + PG8_SB(b, h) + boff + n * 2048 + k * 1024); } while (0)
#define PG8_CAT(x0, x1) __builtin_shufflevector(__builtin_bit_cast(i32x4, (x0)), __builtin_bit_cast(i32x4, (x1)), 0, 1, 2, 3, 4, 5, 6, 7)
#define PG8_MMA(ai, bj, At, Bt) do { __builtin_amdgcn_s_setprio(1); _Pragma("unroll") for (int m = 0; m < 4; ++m) _Pragma("unroll") for (int n = 0; n < 2; ++n) { \
        if constexpr (FP8) acc[ai][bj][m][n] = __builtin_amdgcn_mfma_scale_f32_16x16x128_f8f6f4(PG8_CAT(Bt[n][0], Bt[n][1]), PG8_CAT(At[m][0], At[m][1]), acc[ai][bj][m][n], 0, 0, 0, 0x7f7f7f7f, 0, 0x7f7f7f7f); \
        else { _Pragma("unroll") for (int k = 0; k < 2; ++k) acc[ai][bj][m][n] = __builtin_amdgcn_mfma_f32_16x16x32_bf16(Bt[n][k], At[m][k], acc[ai][bj][m][n], 0, 0, 0); } } __builtin_amdgcn_s_setprio(0); } while (0)
#define PG8_WAIT_V(n) asm volatile("s_waitcnt vmcnt(" #n ")" ::: "memory")
#define PG8_WAIT_L(n) asm volatile("s_waitcnt lgkmcnt(" #n ")" ::: "memory")
#define PG8_BAR __builtin_amdgcn_s_barrier()
#define PG8_SCHED __builtin_amdgcn_sched_barrier(0)
    Unit cur, nxt; int ui = 0;
    if (!S.next(0, cur)) return;
    f32x4 acc[2][2][4][2];
#pragma unroll
    for (int a = 0; a < 2; ++a)
#pragma unroll
        for (int b = 0; b < 2; ++b)
#pragma unroll
            for (int m = 0; m < 4; ++m)
#pragma unroll
                for (int n = 0; n < 2; ++n) acc[a][b][m][n] = (f32x4){0.f, 0.f, 0.f, 0.f};
    bf16x8 At[4][2], B0[2][2], B1[2][2];
    unsigned cOff[2][2], nOff[2][2];
#pragma unroll
    for (int hh = 0; hh < 2; ++hh)
#pragma unroll
        for (int i = 0; i < 2; ++i) {
            if constexpr (GATHER) { const int ridx = hh * HALF + Rs[i]; int tk = cur.rows[ridx]; tk = ridx < cur.aux ? tk : 0; cOff[hh][i] = (unsigned)(tk * lda + Cs[i]) * 2u; }
            else cOff[hh][i] = (unsigned)(Rs[i] * lda + Cs[i]) * 2u;
            if constexpr (GATHER) nOff[hh][i] = cOff[hh][i]; else nOff[hh][i] = 0u;
        }
    const char* cA = cur.a; const char* cB = cur.b;
    S.a_ready(cur);
    if constexpr (SP2) {
        PG8_STAGE(PG8_SB(0, 0), cB, 0, voffB); PG8_STAGE(PG8_SB(0, 1), cB, hstepB, voffB); PG8_STAGE(PG8_SA(0, 0), cA, 0, cOff[0]); PG8_STAGE(PG8_SA(0, 1), cA, hstepA, cOff[GATHER ? 1 : 0]);
        if (wr == 1) PG8_BAR;
        PG8_WAIT_V(2); PG8_BAR;
        PG8_STAGE(PG8_SB(1, 0), cB, kstep, voffB); PG8_STAGE(PG8_SA(1, 0), cA, kstep, cOff[0]); PG8_STAGE(PG8_SB(1, 1), cB, hstepB + kstep, voffB);
        PG8_WAIT_V(6); PG8_BAR;
    } else {
        PG8_STAGE(PG8_SB(0, 0), cB, 0, voffB); PG8_STAGE(PG8_SA(0, 0), cA, 0, cOff[0]); PG8_STAGE(PG8_SB(0, 1), cB, hstepB, voffB); PG8_STAGE(PG8_SA(0, 1), cA, hstepA, cOff[GATHER ? 1 : 0]);
        if (wr == 1) PG8_BAR;
        PG8_WAIT_V(4); PG8_BAR;
        PG8_STAGE(PG8_SB(1, 0), cB, kstep, voffB); PG8_STAGE(PG8_SA(1, 0), cA, kstep, cOff[0]); PG8_STAGE(PG8_SB(1, 1), cB, hstepB + kstep, voffB);
        PG8_WAIT_V(6); PG8_BAR;
    }
    for (;;) {
        const bool has_next = S.next(ui + 1, nxt);
        const char* nA = has_next ? nxt.a : cA; const char* nB = has_next ? nxt.b : cB;
        if constexpr (GATHER) {
            if (has_next) {
#pragma unroll
                for (int hh = 0; hh < 2; ++hh)
#pragma unroll
                    for (int i = 0; i < 2; ++i) { const int ridx = hh * HALF + Rs[i]; int tk = nxt.rows[ridx]; tk = ridx < nxt.aux ? tk : 0; nOff[hh][i] = (unsigned)(tk * lda + Cs[i]) * 2u; }
            } else {
#pragma unroll
                for (int hh = 0; hh < 2; ++hh)
#pragma unroll
                    for (int i = 0; i < 2; ++i) nOff[hh][i] = cOff[hh][i];
            }
        }
        const int nt = cur.nt ? cur.nt : ntK;
#pragma unroll 1
        for (int t = 0; t < nt; t += 2) {
            const bool last = (t == nt - 2);
            const unsigned o1 = (unsigned)((t + 1) * kstep);
            const char* a2 = last ? nA : cA; const char* b2 = last ? nB : cB; const unsigned o2k = last ? 0u : (unsigned)((t + 2) * kstep), o3k = o2k + (unsigned)kstep;
            unsigned o2[2][2];
#pragma unroll
            for (int hh = 0; hh < 2; ++hh)
#pragma unroll
                for (int i = 0; i < 2; ++i) { if constexpr (GATHER) o2[hh][i] = last ? nOff[hh][i] : cOff[hh][i]; else o2[hh][i] = cOff[hh][i]; }
            if (last && has_next) S.a_ready(nxt);
            if constexpr (SP2) {
            PG8_LDB(B0, 0, 0); PG8_LDB(B1, 0, 1); PG8_SCHED; PG8_LDA(At, 0, 0); PG8_STAGE(PG8_SA(1, 1), cA, o1 + hstepA, cOff[GATHER ? 1 : 0]);
            PG8_WAIT_V(8); PG8_WAIT_L(0); PG8_BAR; PG8_MMA(0, 0, At, B0); PG8_MMA(0, 1, At, B1); PG8_BAR; PG8_SCHED;
            PG8_LDA(At, 0, 1); PG8_STAGE(PG8_SB(0, 0), b2, o2k, voffB); PG8_STAGE(PG8_SB(0, 1), b2, o2k + hstepB, voffB); PG8_STAGE(PG8_SA(0, 0), a2, o2k, o2[0]);
            PG8_WAIT_V(8); PG8_WAIT_L(0); PG8_BAR; PG8_MMA(1, 0, At, B0); PG8_MMA(1, 1, At, B1); PG8_BAR; PG8_SCHED;
            PG8_LDB(B0, 1, 0); PG8_LDB(B1, 1, 1); PG8_SCHED; PG8_LDA(At, 1, 0); PG8_STAGE(PG8_SA(0, 1), a2, o2k + hstepA, o2[GATHER ? 1 : 0]);
            PG8_WAIT_V(8); PG8_WAIT_L(0); PG8_BAR; PG8_MMA(0, 0, At, B0); PG8_MMA(0, 1, At, B1); PG8_BAR; PG8_SCHED;
            PG8_LDA(At, 1, 1); PG8_STAGE(PG8_SB(1, 0), b2, o3k, voffB); PG8_STAGE(PG8_SB(1, 1), b2, o3k + hstepB, voffB); PG8_STAGE(PG8_SA(1, 0), a2, o3k, o2[0]);
            PG8_WAIT_V(8); PG8_WAIT_L(0); PG8_BAR; PG8_MMA(1, 0, At, B0); PG8_MMA(1, 1, At, B1); PG8_BAR; PG8_SCHED;
            } else {
            PG8_LDB(B0, 0, 0); PG8_SCHED; PG8_LDA(At, 0, 0); PG8_STAGE(PG8_SA(1, 1), cA, o1 + hstepA, cOff[GATHER ? 1 : 0]);
            PG8_WAIT_L(8); PG8_BAR; PG8_WAIT_L(0); PG8_MMA(0, 0, At, B0); PG8_BAR; PG8_SCHED;
            PG8_LDB(B1, 0, 1); PG8_STAGE(PG8_SB(0, 0), b2, o2k, voffB);
            PG8_BAR; PG8_WAIT_L(0); PG8_MMA(0, 1, At, B1); PG8_BAR;
            PG8_LDA(At, 0, 1); PG8_STAGE(PG8_SA(0, 0), a2, o2k, o2[0]);
            PG8_BAR; PG8_WAIT_L(0); PG8_MMA(1, 0, At, B0); PG8_BAR; PG8_SCHED;
            PG8_STAGE(PG8_SB(0, 1), b2, o2k + hstepB, voffB);
            PG8_WAIT_V(6); PG8_BAR; PG8_MMA(1, 1, At, B1); PG8_BAR;
            PG8_LDB(B0, 1, 0); PG8_SCHED; PG8_LDA(At, 1, 0); PG8_STAGE(PG8_SA(0, 1), a2, o2k + hstepA, o2[GATHER ? 1 : 0]);
            PG8_WAIT_L(8); PG8_BAR; PG8_WAIT_L(0); PG8_MMA(0, 0, At, B0); PG8_BAR; PG8_SCHED;
            PG8_LDB(B1, 1, 1); PG8_STAGE(PG8_SB(1, 0), b2, o3k, voffB);
            PG8_BAR; PG8_WAIT_L(0); PG8_MMA(0, 1, At, B1); PG8_BAR;
            PG8_LDA(At, 1, 1); PG8_STAGE(PG8_SA(1, 0), a2, o3k, o2[0]);
            PG8_BAR; PG8_WAIT_L(0); PG8_MMA(1, 0, At, B0); PG8_BAR; PG8_SCHED;
            PG8_STAGE(PG8_SB(1, 1), b2, o3k + hstepB, voffB);
            PG8_WAIT_V(6); PG8_BAR; PG8_MMA(1, 1, At, B1); PG8_BAR;
            }
        }
        if constexpr (ALIGN_EPI) { if (wr == 0) PG8_BAR; }
        { int tl_ = tid; asm volatile("" : "+v"(tl_)); const int l2_ = tl_ & 63; E(acc, cur, wr, wc, l2_ & 15, l2_ >> 4); } S.done(cur);
        if (!has_next) break;
#pragma unroll
        for (int a = 0; a < 2; ++a)
#pragma unroll
            for (int b = 0; b < 2; ++b)
#pragma unroll
                for (int m = 0; m < 4; ++m)
#pragma unroll
                    for (int n = 0; n < 2; ++n) acc[a][b][m][n] = (f32x4){0.f, 0.f, 0.f, 0.f};
        cur = nxt; cA = nA; cB = nB; ++ui;
        if constexpr (GATHER) {
#pragma unroll
            for (int hh = 0; hh < 2; ++hh)
#pragma unroll
                for (int i = 0; i < 2; ++i) cOff[hh][i] = nOff[hh][i];
        }
        if constexpr (ALIGN_EPI) { if (wr == 1) PG8_BAR; }
    }
    PG8_WAIT_V(0);
    if constexpr (!ALIGN_EPI) { if (wr == 0) PG8_BAR; }
    PG8_BAR;
#undef PG8_SA
#undef PG8_SB
#undef PG8_STAGE
#undef PG8_RSRC
#undef PG8_LDA
#undef PG8_LDB
#undef PG8_MMA
#undef PG8_CAT
#undef PG8_WAIT_V
#undef PG8_WAIT_L
#undef PG8_BAR
#undef PG8_SCHED
}
}

constexpr int NWAVES = 8;
constexpr int BATCH = 2, SEQ = 16384, D = 1024, NTOK = BATCH * SEQ;
constexpr int NLAYER = 2;
constexpr int NPROJ = 2816, IN_COLS = 2832;
constexpr int PJ = 2048;
constexpr int C_PIN = 0, C_CB = 256, C_CC = 512, C_CX = 768, C_DQ = 1024, C_DK = 1280, C_DV = 1536, C_DZ = 1792;
constexpr int DFF = 2816, NEXP = 8;
constexpr int NCHUNK = SEQ / 64;
constexpr int NINST = BATCH * 4 * 2 * NCHUNK;
constexpr float EPS = 1e-6f;
constexpr float QSCALE = 0.17677669529663687f * 1.4426950408889634f;
#ifndef MOE_FP8
#define MOE_FP8 1
#endif
constexpr float W8SCALE = 64.f;
constexpr int MOE_PASS_TILES = MOE_FP8 ? 264 : 132;
constexpr int MOE_NPASS = MOE_FP8 ? 1 : 2;

constexpr size_t MiB = 1u << 20;
constexpr size_t WS_CTL = 0, CTL_ZERO_BYTES = 1 * MiB;
constexpr size_t SZ_WIN = (size_t)NPROJ * D * 2, SZ_WM = (size_t)4096 * D * 2, SZ_WB = (size_t)4 * 1024 * 256 * 2, SZ_WO = (size_t)D * D * 2;
constexpr size_t SZ_LAYERW = SZ_WIN + SZ_WM + SZ_WB + SZ_WO;
constexpr size_t SZ_WGU = (size_t)2 * DFF * D * 2, SZ_WD = (size_t)D * DFF * 2, SZ_FFNW = SZ_WGU + SZ_WD;
constexpr size_t WS_W = 1 * MiB;
constexpr size_t WS_WFFN = WS_W + 2 * SZ_LAYERW;
static_assert(WS_WFFN + SZ_FFNW <= 53 * MiB, "weights");
constexpr size_t WS_H = 53 * MiB;
constexpr size_t WS_O4 = 117 * MiB;
constexpr size_t WS_F = WS_O4;
constexpr size_t WS_BD = 181 * MiB;
constexpr size_t WS_DEC = 183 * MiB;
constexpr size_t WS_PROJ = 185 * MiB;
constexpr size_t WS_QB = 521 * MiB;
constexpr size_t WS_KV = 313 * MiB;
constexpr size_t WS_UW = 361 * MiB;
constexpr size_t WS_AB = 425 * MiB;
constexpr size_t WS_ST = 489 * MiB;
constexpr size_t WS_PBUF = 185 * MiB;
constexpr size_t WS_MERGED = 441 * MiB;
constexpr size_t WS_ACT0 = 185 * MiB;
constexpr size_t WS_H2B = 479 * MiB;
constexpr size_t WS_MOEW = 185 * MiB;
constexpr size_t WS_XG = 251 * MiB;
constexpr size_t WS_ACT1 = 1 * MiB;
constexpr size_t WS_Y = 317 * MiB;
constexpr size_t WS_ROUTE = 449 * MiB;
constexpr size_t WS_END = 543 * MiB;
static_assert(WS_ACT1 + (size_t)MOE_PASS_TILES * 256 * DFF * (MOE_FP8 ? 1 : 2) <= WS_MOEW, "act1");
static_assert((MOE_FP8 ? WS_XG + (size_t)264 * 256 * D : WS_MOEW + 8 * SZ_FFNW) <= WS_Y && WS_MOEW + 8 * SZ_FFNW / 2 <= WS_XG && WS_Y + (size_t)264 * 256 * D * 2 <= WS_ROUTE && WS_ROUTE + 4 * MiB <= WS_H2B && WS_H2B + 64 * MiB <= WS_END, "moe map");
static_assert(WS_PROJ + (size_t)NTOK * PJ * 2 <= WS_KV && WS_KV + (size_t)8 * 256 * 19456 <= WS_UW && WS_QB + 16 * MiB <= WS_END && WS_ST + (size_t)NINST * 8192 <= WS_END, "mixer map");
constexpr int CW_TMO = 0, CW_CODE = 1;
constexpr int CW_BAR = 4096;
constexpr int CW_MOD = 16384;
constexpr int CW_MOECNT = 65536;
constexpr int CW_NMAX = 66560;
constexpr int CW_MODCNT = 66624;
constexpr int CW_ATTQ = 66688;
static_assert(CW_MOD + NLAYER * BATCH * 6 * D <= CW_MOECNT && (CW_ATTQ + 32 * 64) * 4 <= (int)CTL_ZERO_BYTES, "ctl");

constexpr int RING_OFF = 0, RING_BYTES = 131072;
constexpr int LDS_BYTES = 160 * 1024;
constexpr int MISC_OFF = LDS_BYTES - 256;

#define GAS __attribute__((address_space(1)))
#define LAS __attribute__((address_space(3)))
typedef unsigned short bf16;
typedef unsigned v4u __attribute__((ext_vector_type(4)));
typedef unsigned v2u __attribute__((ext_vector_type(2)));
typedef float f32x4 __attribute__((ext_vector_type(4)));
typedef float f32x16 __attribute__((ext_vector_type(16)));
typedef short bf16x8 __attribute__((ext_vector_type(8)));
typedef short bf16x4 __attribute__((ext_vector_type(4)));
typedef GAS unsigned gu32;
#define RLX_AGENT __ATOMIC_RELAXED, __HIP_MEMORY_SCOPE_AGENT
#define LDS_WAIT() asm volatile("s_waitcnt lgkmcnt(0)" ::: "memory")
#define VM_WAIT() asm volatile("s_waitcnt vmcnt(0)" ::: "memory")
__device__ __forceinline__ unsigned f2bf(float f) { unsigned u = __builtin_bit_cast(unsigned, f); return (u + 0x7fffu + ((u >> 16) & 1u)) >> 16; }
__device__ __forceinline__ unsigned pk2(float lo, float hi) { return f2bf(lo) | (f2bf(hi) << 16); }
__device__ __forceinline__ float bf2f(unsigned b) { return __builtin_bit_cast(float, b << 16); }
__device__ __forceinline__ float bflo(unsigned w) { return __builtin_bit_cast(float, w << 16); }
__device__ __forceinline__ float bfhi(unsigned w) { return __builtin_bit_cast(float, w & 0xffff0000u); }
__device__ __forceinline__ float fast_exp2(float x) { return __builtin_amdgcn_exp2f(x); }
__device__ __forceinline__ float fast_exp(float x) { return __builtin_amdgcn_exp2f(x * 1.4426950408889634f); }
__device__ __forceinline__ float fast_rcp(float x) { return __builtin_amdgcn_rcpf(x); }
__device__ __forceinline__ float sigmoidf_(float x) { return fast_rcp(1.f + fast_exp(-x)); }
__device__ __forceinline__ float siluf_(float x) { return x * sigmoidf_(x); }
__device__ __forceinline__ float wave_sum(float v) {
    v += __builtin_bit_cast(float, __builtin_amdgcn_update_dpp(0, __builtin_bit_cast(int, v), 0xB1, 0xf, 0xf, true));
    v += __builtin_bit_cast(float, __builtin_amdgcn_update_dpp(0, __builtin_bit_cast(int, v), 0x4E, 0xf, 0xf, true));
    v += __builtin_bit_cast(float, __builtin_amdgcn_update_dpp(0, __builtin_bit_cast(int, v), 0x141, 0xf, 0xf, true));
    v += __builtin_bit_cast(float, __builtin_amdgcn_update_dpp(0, __builtin_bit_cast(int, v), 0x140, 0xf, 0xf, true));
    v += __builtin_bit_cast(float, __builtin_amdgcn_ds_swizzle(__builtin_bit_cast(int, v), 0x401f));
    v += __shfl_xor(v, 32);
    return v;
}

#define XB_TMO      128
#define XB_XCNT(j)  (256  + 64 * (j))
#define XB_XSUB(j)  (1280 + 64 * (j))
#define XB_XGEN(j)  (2304 + 64 * (j))
#define XB_TOP      3328
#define XB_TOPGEN   3392
#define XCD_BAR_WORDS 3456
#define XB_SPIN_CAP (1u << 22)
__device__ __forceinline__ unsigned xb_ld(unsigned* p)              { return __hip_atomic_load(p, __ATOMIC_RELAXED, __HIP_MEMORY_SCOPE_AGENT); }
__device__ __forceinline__ unsigned xb_add(unsigned* p, unsigned v) { return __hip_atomic_fetch_add(p, v, __ATOMIC_RELAXED, __HIP_MEMORY_SCOPE_AGENT); }
__device__ __forceinline__ unsigned xb_xcc_id() { return (unsigned)__builtin_amdgcn_s_getreg((3 << 11) | 20) & 0xFu; }
#define XB_SPIN(cond, bar) do { unsigned _sp = 0; while (cond) { __builtin_amdgcn_s_sleep(1); \
    if ((++_sp & 255u) == 0u) { if (xb_ld(&(bar)[XB_TMO])) break; if (_sp > XB_SPIN_CAP) { atomicAdd(&(bar)[XB_TMO], 1u); break; } } } } while (0)
struct XcdBarrier { unsigned* bar; unsigned x; volatile LAS unsigned* st; };
__device__ __forceinline__ XcdBarrier xcd_barrier_post(unsigned* bar, volatile LAS unsigned* st) {
    XcdBarrier b; b.bar = bar; b.x = xb_xcc_id(); b.st = st;
    if (threadIdx.x == 0) (void)xb_add(&bar[XB_XCNT(b.x)], 1u);
    return b;
}
__device__ __forceinline__ void xcd_barrier_complete(unsigned* bar, unsigned x, unsigned& nloc, unsigned& nx) {
    const unsigned G = gridDim.x * gridDim.y * gridDim.z;
    unsigned sum, cnt, mine, sp = 0u;
    for (;;) {
        sum = 0u; cnt = 0u; mine = 0u;
#pragma unroll
        for (unsigned j = 0; j < 16; ++j) { const unsigned c = xb_ld(&bar[XB_XCNT(j)]); sum += c; cnt += (c > 0u) ? 1u : 0u; }
        mine = xb_ld(&bar[XB_XCNT(x)]);
        if (sum == G) break;
        __builtin_amdgcn_s_sleep(1);
        if ((++sp & 255u) == 0u) { if (xb_ld(&bar[XB_TMO])) break; if (sp > XB_SPIN_CAP) { atomicAdd(&bar[XB_TMO], 1u); break; } }
    }
    nloc = mine > 0u ? mine : 1u; nx = cnt > 0u ? cnt : 1u;
}
__device__ __forceinline__ void xcd_barrier(const XcdBarrier& b) {
    asm volatile("s_waitcnt vmcnt(0)" ::: "memory");
    __syncthreads();
    if (threadIdx.x == 0) {
        unsigned* bar = b.bar;
        __builtin_amdgcn_s_waitcnt(0);
        unsigned nloc = b.st[0], nx = b.st[1];
        if (nloc == 0u) { xcd_barrier_complete(bar, b.x, nloc, nx); b.st[0] = nloc; b.st[1] = nx; }
        const unsigned old = xb_add(&bar[XB_XSUB(b.x)], 1u);
        const unsigned gen = old / nloc;
        if (old + 1u == (gen + 1u) * nloc) {
            __builtin_amdgcn_fence(__ATOMIC_RELEASE, "agent");
            asm volatile("s_waitcnt vmcnt(0)" ::: "memory");
            const unsigned og = xb_add(&bar[XB_TOP], 1u);
            const unsigned tg = og / nx;
            if (og + 1u == (tg + 1u) * nx) xb_add(&bar[XB_TOPGEN], 1u);
            else XB_SPIN(xb_ld(&bar[XB_TOPGEN]) == tg, bar);
            __builtin_amdgcn_fence(__ATOMIC_ACQUIRE, "agent");
            xb_add(&bar[XB_XGEN(b.x)], 1u);
            asm volatile("s_waitcnt vmcnt(0)" ::: "memory");
        } else {
            XB_SPIN(xb_ld(&bar[XB_XGEN(b.x)]) == gen, bar);
            __builtin_amdgcn_fence(__ATOMIC_ACQUIRE, "agent");
            asm volatile("s_waitcnt vmcnt(0)" ::: "memory");
        }
    }
    __syncthreads();
}

struct Frame {
    LAS unsigned char* lds;
    volatile LAS unsigned* MISC;
    gu32* ctl;
    int tid, lane, wave;
    int vcu, G;
    unsigned char* ws;
    float* out;
    const float* const* in;
};
enum { I_X = 0, I_C, I_ADAW, I_ADAB, I_NMIXPRE, I_NMIXPOST, I_NFFNPRE, I_NFFNPOST, I_WIN, I_DLAMBDA, I_DSUBLN, I_POOLW, I_POOLSCALE, I_SCONVW, I_DCONVW, I_DALOG, I_DDTBIAS, I_DNORM,
       I_WBRANCH, I_WMERGE, I_BMERGE, I_WO, I_FFNG, I_FFNU, I_FFND, I_ROUTERW, I_ROUTERB, I_MOEG, I_MOEU, I_MOED, N_INPUTS };

__device__ __forceinline__ unsigned pk4_fp8(float a, float b, float c, float d) { int w = __builtin_amdgcn_cvt_pk_fp8_f32(a, b, 0, false); w = __builtin_amdgcn_cvt_pk_fp8_f32(c, d, w, true); return (unsigned)w; }
template <bool F8 = false> __device__ __forceinline__ void cvt_item(const float* W, int ldw, int k0, int n0, bf16* WT, int Kd, int drow0, LAS float* scr, int lane) {
#pragma unroll 8
    for (int i = 0; i < 32; ++i) { const int kk = 2 * i + (lane >> 5); scr[kk * 33 + (lane & 31)] = W[(size_t)(k0 + kk) * ldw + n0 + (lane & 31)]; }
    LDS_WAIT(); asm volatile("" ::: "memory");
    const int c = lane & 7;
#pragma unroll
    for (int j = 0; j < 4; ++j) { const int n = (lane >> 3) + 8 * j; const LAS float* s = scr + (8 * c) * 33 + n;
        if constexpr (F8) { v2u o; o.x = pk4_fp8(s[0 * 33] * W8SCALE, s[1 * 33] * W8SCALE, s[2 * 33] * W8SCALE, s[3 * 33] * W8SCALE); o.y = pk4_fp8(s[4 * 33] * W8SCALE, s[5 * 33] * W8SCALE, s[6 * 33] * W8SCALE, s[7 * 33] * W8SCALE);
            *(GAS v2u*)((unsigned char*)WT + (size_t)(drow0 + n) * Kd + k0 + 8 * c) = o; }
        else { v4u o; o.x = pk2(s[0 * 33], s[1 * 33]); o.y = pk2(s[2 * 33], s[3 * 33]); o.z = pk2(s[4 * 33], s[5 * 33]); o.w = pk2(s[6 * 33], s[7 * 33]);
            *(GAS v4u*)(WT + (size_t)(drow0 + n) * Kd + k0 + 8 * c) = o; } }
    LDS_WAIT(); asm volatile("" ::: "memory");
}
template <bool F8 = false> __device__ __forceinline__ void cvt_ffn_item(const float* wg, const float* wu, const float* wd, bf16* Wgu, bf16* Wd, int r, LAS float* scr, int lane) {
    constexpr int IG = (D / 64) * (DFF / 32);
    if (r < IG) { const int kb = r / (DFF / 32), nb = r % (DFF / 32), n0 = nb * 32; cvt_item<F8>(wg, DFF, kb * 64, n0, Wgu, D, 256 * (n0 >> 7) + (n0 & 127), scr, lane); return; } r -= IG;
    if (r < IG) { const int kb = r / (DFF / 32), nb = r % (DFF / 32), n0 = nb * 32; cvt_item<F8>(wu, DFF, kb * 64, n0, Wgu, D, 256 * (n0 >> 7) + (n0 & 127) + 128, scr, lane); return; } r -= IG;
    { const int kb = r / (D / 32), nb = r % (D / 32); cvt_item<F8>(wd, D, kb * 64, nb * 32, Wd, DFF, nb * 32, scr, lane); }
}
constexpr int FFN_ITEMS = 3 * (D / 64) * (DFF / 32);
__device__ __forceinline__ bf16* w_in_t(unsigned char* ws, int l) { return (bf16*)(ws + WS_W + (size_t)l * SZ_LAYERW); }
__device__ __forceinline__ bf16* w_m_t(unsigned char* ws, int l) { return (bf16*)(ws + WS_W + (size_t)l * SZ_LAYERW + SZ_WIN); }
__device__ __forceinline__ bf16* w_b_t(unsigned char* ws, int l) { return (bf16*)(ws + WS_W + (size_t)l * SZ_LAYERW + SZ_WIN + SZ_WM); }
__device__ __forceinline__ bf16* w_o_t(unsigned char* ws, int l) { return (bf16*)(ws + WS_W + (size_t)l * SZ_LAYERW + SZ_WIN + SZ_WM + SZ_WB); }

__device__ __forceinline__ void p_prologue(Frame& F) {
    LAS float* scr = (LAS float*)(F.lds + RING_OFF + F.wave * 16384);
    const int gw = F.vcu * NWAVES + F.wave, NGW = F.G * NWAVES;
    constexpr int I_IN = (D / 64) * (NPROJ / 32), I_M = (D / 64) * (D / 32), I_B = (256 / 64) * (D / 32);
    constexpr int PER_LAYER = I_IN + 4 * I_M + 4 * I_B + I_M;
    constexpr int NITEMS = NLAYER * PER_LAYER + FFN_ITEMS;
    for (int it = gw; it < NITEMS; it += NGW) {
        int r = it;
        if (r >= NLAYER * PER_LAYER) { r -= NLAYER * PER_LAYER;
            cvt_ffn_item(F.in[I_FFNG], F.in[I_FFNU], F.in[I_FFND], (bf16*)(F.ws + WS_WFFN), (bf16*)(F.ws + WS_WFFN + SZ_WGU), r, scr, F.lane); continue; }
        const int l = r / PER_LAYER; r -= l * PER_LAYER;
        if (r < I_IN) { const int kb = r / (NPROJ / 32), nb = r % (NPROJ / 32); cvt_item(F.in[I_WIN] + (size_t)l * D * IN_COLS, IN_COLS, kb * 64, nb * 32, w_in_t(F.ws, l), D, nb * 32, scr, F.lane); continue; } r -= I_IN;
        if (r < 4 * I_M) { const int i = r / I_M; r -= i * I_M; const int kb = r / (D / 32), nb = r % (D / 32);
            cvt_item(F.in[I_WMERGE] + ((size_t)l * 4 + i) * D * D, D, kb * 64, nb * 32, w_m_t(F.ws, l), D, i * 1024 + nb * 32, scr, F.lane); continue; } r -= 4 * I_M;
        if (r < 4 * I_B) { const int i = r / I_B; r -= i * I_B; const int kb = r / (D / 32), nb = r % (D / 32);
            cvt_item(F.in[I_WBRANCH] + ((size_t)l * 4 + i) * 256 * D, D, kb * 64, nb * 32, w_b_t(F.ws, l) + i * 256, 1024, nb * 32, scr, F.lane); continue; } r -= 4 * I_B;
        { const int kb = r / (D / 32), nb = r % (D / 32); cvt_item(F.in[I_WO] + (size_t)l * D * D, D, kb * 64, nb * 32, w_o_t(F.ws, l), D, nb * 32, scr, F.lane); }
    }
    constexpr int MOD_ITEMS = NLAYER * 24 * 16;
    for (int it = gw; it < MOD_ITEMS; it += NGW) {
        const int grp = it >> 4, kc = it & 15, l = grp / 24, nb = grp % 24;
        const float* Wp = F.in[I_ADAW] + ((size_t)l * D + kc * 64) * (6 * D) + nb * 256 + F.lane * 4;
        f32x4 a0 = {0.f, 0.f, 0.f, 0.f}, a1 = {0.f, 0.f, 0.f, 0.f};
#pragma unroll 8
        for (int k = 0; k < 64; ++k) { const f32x4 w = *(const GAS f32x4*)(Wp + (size_t)k * (6 * D));
            const float c0 = siluf_(F.in[I_C][kc * 64 + k]), c1 = siluf_(F.in[I_C][D + kc * 64 + k]); a0 += w * c0; a1 += w * c1; }
        float* part = (float*)(F.ws + WS_BD) + ((size_t)grp * 16 + kc) * 512 + F.lane * 4;
        *(GAS f32x4*)part = a0; *(GAS f32x4*)(part + 256) = a1;
        __threadfence();
        unsigned old = 0;
        if (F.lane == 0) old = __hip_atomic_fetch_add(F.ctl + CW_MODCNT + grp, 1u, RLX_AGENT);
        old = __builtin_amdgcn_readfirstlane(old);
        if (old == 15u) {
            __threadfence();
            f32x4 s0 = {0.f, 0.f, 0.f, 0.f}, s1 = {0.f, 0.f, 0.f, 0.f};
            const float* pg = (const float*)(F.ws + WS_BD) + (size_t)grp * 16 * 512 + F.lane * 4;
#pragma unroll
            for (int q = 0; q < 16; ++q) { s0 += __builtin_nontemporal_load((const f32x4*)(pg + q * 512)); s1 += __builtin_nontemporal_load((const f32x4*)(pg + q * 512 + 256)); }
            float* m0 = (float*)(F.ctl + CW_MOD) + (size_t)(l * BATCH + 0) * 6 * D + nb * 256 + F.lane * 4;
            *(GAS f32x4*)m0 = s0; *(GAS f32x4*)(m0 + 6 * D) = s1;
        }
    }
}
__device__ __forceinline__ void moe_tiles(Frame& F, int (&cnt)[NEXP], int (&tstart)[NEXP + 1]) {
    int acc = 0;
#pragma unroll
    for (int e = 0; e < NEXP; ++e) { cnt[e] = __builtin_amdgcn_readfirstlane((int)__hip_atomic_load(F.ctl + CW_MOECNT + 64 * e, RLX_AGENT)); tstart[e] = acc; acc += (cnt[e] + 255) >> 8; }
    tstart[NEXP] = acc;
}
__device__ __forceinline__ void p_moe_cvt(Frame& F) {
    LAS float* scr = (LAS float*)(F.lds + RING_OFF + F.wave * 16384);
    const int gw = F.vcu * NWAVES + F.wave, NGW = F.G * NWAVES;
    for (int it = gw; it < NEXP * FFN_ITEMS; it += NGW) {
        const int e = it / FFN_ITEMS, r = it % FFN_ITEMS;
        unsigned char* base = F.ws + WS_MOEW + (size_t)e * (MOE_FP8 ? SZ_FFNW / 2 : SZ_FFNW);
        cvt_ffn_item<MOE_FP8 != 0>(F.in[I_MOEG] + (size_t)e * D * DFF, F.in[I_MOEU] + (size_t)e * D * DFF, F.in[I_MOED] + (size_t)e * DFF * D, (bf16*)base, (bf16*)(base + (MOE_FP8 ? SZ_WGU / 2 : SZ_WGU)), r, scr, F.lane);
    }
#if MOE_FP8
    int cnt[NEXP], tstart[NEXP + 1]; moe_tiles(F, cnt, tstart);
    const int* lists = (const int*)(F.ws + WS_ROUTE + 1 * MiB);
    for (int gs = gw; gs < tstart[NEXP] * 256; gs += NGW) {
        const int t = gs >> 8; int e = 0;
#pragma unroll
        for (int k = 1; k < NEXP; ++k) e = (t >= tstart[k]) ? k : e;
        int ts = 0, ce = 0;
#pragma unroll
        for (int k = 0; k < NEXP; ++k) { ts = (k == e) ? tstart[k] : ts; ce = (k == e) ? cnt[k] : ce; }
        const int i = (t - ts) * 256 + (gs & 255);
        int tok = lists[(size_t)e * 65536 + i]; tok = i < ce ? tok : 0;
        const v4u v = *(const GAS v4u*)(F.ws + WS_H2B + (size_t)tok * D + F.lane * 16);
        *(GAS v4u*)(F.ws + WS_XG + (size_t)gs * D + F.lane * 16) = v;
    }
#endif
}

struct Row { f32x4 v[4]; };
__device__ __forceinline__ float modv(Frame& F, int l, int b, int idx) { return ((const float*)(F.ctl + CW_MOD))[(size_t)(l * BATCH + b) * 6 * D + idx] + F.in[I_ADAB][l * 6 * D + idx]; }
__device__ __forceinline__ f32x4 modv4(Frame& F, int l, int b, int idx) {
    const f32x4 a = *(const GAS f32x4*)((const float*)(F.ctl + CW_MOD) + (size_t)(l * BATCH + b) * 6 * D + idx), c = *(const GAS f32x4*)(F.in[I_ADAB] + l * 6 * D + idx); return a + c; }
__device__ __forceinline__ float row_rstd(const Row& r) {
    float s = 0.f;
#pragma unroll
    for (int j = 0; j < 4; ++j) s += (r.v[j].x * r.v[j].x + r.v[j].y * r.v[j].y) + (r.v[j].z * r.v[j].z + r.v[j].w * r.v[j].w);
    return 1.f / sqrtf(wave_sum(s) * (1.f / D) + EPS);
}
__device__ __forceinline__ void row_resid(Frame& F, Row& x, const Row& f, const float* gain, int l, int b, int gidx) {
    const float rs = row_rstd(f);
#pragma unroll
    for (int j = 0; j < 4; ++j) { const int c = 4 * F.lane + 256 * j; const f32x4 g = *(const GAS f32x4*)(gain + c), m = modv4(F, l, b, gidx + c); x.v[j] += m * (f.v[j] * rs * g); }
}
__device__ __forceinline__ void row_make_h(Frame& F, Row& h, const Row& x, const float* gain, int l, int b, int shidx, int scidx) {
    const float rs = row_rstd(x);
#pragma unroll
    for (int j = 0; j < 4; ++j) { const int c = 4 * F.lane + 256 * j; const f32x4 g = *(const GAS f32x4*)(gain + c), sc = modv4(F, l, b, scidx + c), sh = modv4(F, l, b, shidx + c);
        h.v[j] = (x.v[j] * rs * g) * (sc + 1.f) + sh; }
}
__device__ __forceinline__ void row_store_bf16(Frame& F, const Row& h, bf16* dst) {
    GAS unsigned long long* o8 = (GAS unsigned long long*)dst + F.lane;
#pragma unroll
    for (int j = 0; j < 4; ++j) o8[64 * j] = (unsigned long long)pk2(h.v[j].x, h.v[j].y) | ((unsigned long long)pk2(h.v[j].z, h.v[j].w) << 32);
}
__device__ __forceinline__ void row_load_f32(Frame& F, Row& r, const float* src) {
    const GAS f32x4* p = (const GAS f32x4*)src + F.lane;
#pragma unroll
    for (int j = 0; j < 4; ++j) r.v[j] = p[64 * j];
}
__device__ __forceinline__ void row_store_f32(Frame& F, const Row& r, float* dst) {
    GAS f32x4* p = (GAS f32x4*)dst + F.lane;
#pragma unroll
    for (int j = 0; j < 4; ++j) p[64 * j] = r.v[j];
}
__device__ __forceinline__ void row_load_bf16(Frame& F, Row& r, const bf16* src) {
    const GAS v2u* p = (const GAS v2u*)src + F.lane;
#pragma unroll
    for (int j = 0; j < 4; ++j) { const v2u w = p[64 * j]; r.v[j] = (f32x4){bflo(w.x), bfhi(w.x), bflo(w.y), bfhi(w.y)}; }
}
template <int NO> __device__ __forceinline__ void row_dots(Frame& F, const Row& h, const LAS float* WT, float (&out)[NO]) {
#pragma unroll
    for (int o = 0; o < NO; ++o) { float s = 0.f;
#pragma unroll
        for (int j = 0; j < 4; ++j) { const f32x4 w = *(const LAS f32x4*)(WT + o * 1024 + 4 * F.lane + 256 * j); s += (h.v[j].x * w.x + h.v[j].y * w.y) + (h.v[j].z * w.z + h.v[j].w * w.w); }
        out[o] = s; if ((o & 3) == 3) __builtin_amdgcn_sched_barrier(0); }
#pragma unroll
    for (int o = 0; o < NO; ++o) { out[o] = wave_sum(out[o]); if ((o & 3) == 3) __builtin_amdgcn_sched_barrier(0); }
}
template <int NO> __device__ __forceinline__ void load_wt(Frame& F, const float* W, int ldw, int col0, LAS float* WT) {
    for (int k = F.tid; k < 1024; k += NWAVES * 64) {
#pragma unroll
        for (int o = 0; o < NO; ++o) WT[o * 1024 + k] = W[(size_t)k * ldw + col0 + o];
    }
    __syncthreads();
}
__device__ __forceinline__ float softplusf_(float x) { return x > 20.f ? x : log1pf(__expf(x)); }
__device__ __forceinline__ void row_bd(Frame& F, const Row& h, const LAS float* W16T, int l, int row) {
    float o16[16]; row_dots<16>(F, h, W16T, o16);
    float mine = 0.f;
#pragma unroll
    for (int o = 0; o < 16; ++o) mine = (F.lane == o) ? o16[o] : mine;
    if (F.lane < 16) {
        float r;
        if (F.lane < 8) r = 1.f / (1.f + __expf(-mine));
        else { const int i = F.lane - 8; r = -__expf(F.in[I_DALOG][l * 8 + i]) * softplusf_(mine + F.in[I_DDTBIAS][l * 8 + i]); }
        ((float*)(F.ws + WS_BD))[(size_t)row * 16 + F.lane] = r;
    }
}
constexpr int ROW_A = 0, ROW_B = 1, ROW_C = 2;
template <int MODE> __device__ __forceinline__ void p_rows(Frame& F, const int l) {
    const int gw = F.vcu * NWAVES + F.wave, NGW = F.G * NWAVES;
    LAS float* WT = (LAS float*)(F.lds + RING_OFF);
    LAS int* linfo = (LAS int*)(F.lds + RING_OFF + 65536);
    LAS int* lcnt = (LAS int*)(F.lds + RING_OFF + 65536 + 8 * 32 * 16);
    const bool do_h1 = (MODE == ROW_A) || (MODE == ROW_C && l + 1 < NLAYER);
    const int lh = (MODE == ROW_C) ? l + 1 : l;
    const bool router = (MODE == ROW_B) && (l == 1);
    if (do_h1) load_wt<16>(F, F.in[I_WIN] + (size_t)lh * D * IN_COLS, IN_COLS, NPROJ, WT);
    if (router) { if (F.tid < 16) lcnt[F.tid] = 0; load_wt<8>(F, F.in[I_ROUTERW], NEXP, 0, WT); }
    int cnt[NEXP], tstart[NEXP + 1];
    if (MODE == ROW_C && l == 1) moe_tiles(F, cnt, tstart);
    const float* xsrc = (MODE == ROW_A || (MODE == ROW_B && l == 0)) ? F.in[I_X] : F.out;
    int ri = 0;
    for (int m = gw; m < NTOK; m += NGW, ++ri) {
        const int b = m / SEQ;
        Row x; row_load_f32(F, x, xsrc + (size_t)m * D);
        if (MODE == ROW_B) {
            Row f; row_load_bf16(F, f, (const bf16*)(F.ws + WS_F) + (size_t)m * D);
            row_resid(F, x, f, F.in[I_NMIXPOST] + l * D, l, b, 2 * D);
            row_store_f32(F, x, F.out + (size_t)m * D);
            Row h; row_make_h(F, h, x, F.in[I_NFFNPRE] + l * D, l, b, 3 * D, 4 * D);
            if (MOE_FP8 && l == 1) { GAS unsigned* o4 = (GAS unsigned*)(F.ws + WS_H2B + (size_t)m * D) + F.lane;
#pragma unroll
                for (int j = 0; j < 4; ++j) o4[64 * j] = pk4_fp8(h.v[j].x, h.v[j].y, h.v[j].z, h.v[j].w); }
            else row_store_bf16(F, h, (bf16*)(F.ws + (l == 0 ? WS_H : WS_H2B)) + (size_t)m * D);
            if (router) {
                float lg[NEXP]; row_dots<NEXP>(F, h, WT, lg);
                int e0 = 0; float l0 = lg[0] + F.in[I_ROUTERB][0];
#pragma unroll
                for (int e = 0; e < NEXP; ++e) lg[e] += F.in[I_ROUTERB][e];
#pragma unroll
                for (int e = 1; e < NEXP; ++e) if (lg[e] > l0) { l0 = lg[e]; e0 = e; }
                int e1 = -1; float l1 = -3.0e38f;
#pragma unroll
                for (int e = 0; e < NEXP; ++e) if (e != e0 && lg[e] > l1) { l1 = lg[e]; e1 = e; }
                const float q1 = __expf(l1 - l0), p0 = 1.f / (1.f + q1), p1 = q1 * p0;
                if (F.lane == 0) {
                    const int i0 = atomicAdd((int*)&lcnt[e0], 1), i1 = atomicAdd((int*)&lcnt[e1], 1);
                    LAS int* li = linfo + (F.wave * 32 + ri) * 4;
                    li[0] = e0 | (e1 << 8) | (i0 << 16); li[1] = i1; li[2] = __float_as_int(p0); li[3] = __float_as_int(p1);
                }
            }
        } else if (MODE == ROW_C) {
            Row f;
            if (l == 0) row_load_bf16(F, f, (const bf16*)(F.ws + WS_F) + (size_t)m * D);
            else {
                const int* ti = (const int*)(F.ws + WS_ROUTE) + (size_t)m * 8;
                const int e0 = ti[0], i0 = ti[1], e1 = ti[2], i1 = ti[3]; const float p0 = __int_as_float(ti[4]), p1 = __int_as_float(ti[5]);
                int s0 = 0, s1 = 0;
#pragma unroll
                for (int e = 0; e < NEXP; ++e) { s0 = (e == e0) ? tstart[e] * 256 + i0 : s0; s1 = (e == e1) ? tstart[e] * 256 + i1 : s1; }
                Row y0, y1; row_load_bf16(F, y0, (const bf16*)(F.ws + WS_Y) + (size_t)s0 * D); row_load_bf16(F, y1, (const bf16*)(F.ws + WS_Y) + (size_t)s1 * D);
#pragma unroll
                for (int j = 0; j < 4; ++j) f.v[j] = y0.v[j] * p0 + y1.v[j] * p1;
            }
            row_resid(F, x, f, F.in[I_NFFNPOST] + l * D, l, b, 5 * D);
            row_store_f32(F, x, F.out + (size_t)m * D);
        }
        if (do_h1) {
            Row h; row_make_h(F, h, x, F.in[I_NMIXPRE] + lh * D, lh, b, 0, 1 * D);
            row_store_bf16(F, h, (bf16*)(F.ws + WS_H) + (size_t)m * D);
            row_bd(F, h, WT, lh, m);
        }
    }
    if (router) {
        __syncthreads();
        if (F.tid < NEXP) lcnt[8 + F.tid] = (int)__hip_atomic_fetch_add(F.ctl + CW_MOECNT + 64 * F.tid, (unsigned)lcnt[F.tid], RLX_AGENT);
        __syncthreads();
        ri = 0;
        for (int m = gw; m < NTOK; m += NGW, ++ri) {
            if (F.lane == 0) {
                const LAS int* li = linfo + (F.wave * 32 + ri) * 4;
                const int w0 = li[0], e0 = w0 & 255, e1 = (w0 >> 8) & 255, i0 = (w0 >> 16) + lcnt[8 + e0], i1 = li[1] + lcnt[8 + e1];
                int* ti = (int*)(F.ws + WS_ROUTE) + (size_t)m * 8;
                ti[0] = e0; ti[1] = i0; ti[2] = e1; ti[3] = i1; ti[4] = li[2]; ti[5] = li[3];
                int* lists = (int*)(F.ws + WS_ROUTE + 1 * MiB);
                lists[(size_t)e0 * 65536 + i0] = m; lists[(size_t)e1 * 65536 + i1] = m;
            }
        }
    }
    __syncthreads();
}

namespace pg8 {
constexpr int NXCD = 8, WGM = 8;
struct SchedStd {
    int nM, nN, nwg, G, c; const char* A; size_t a_tile; const char* B; size_t b_tile;
    __device__ __forceinline__ void init(int nM_, int nN_, int G_, int c_, const void* A_, size_t a_tile_, const void* B_, size_t b_tile_) { nM = nM_; nN = nN_; nwg = nM * nN; G = G_; c = c_; A = (const char*)A_; a_tile = a_tile_; B = (const char*)B_; b_tile = b_tile_; }
    __device__ __forceinline__ bool next(int i, Unit& u) const {
        const long L = (long)i * G + c; if (L >= nwg) return false;
        int wgid = (int)L; { const int q = nwg / NXCD, r = nwg % NXCD, xcd = wgid % NXCD, off = wgid / NXCD; wgid = (xcd < r ? xcd * (q + 1) : r * (q + 1) + (xcd - r) * q) + off; }
        const int nig = WGM * nN, gid = wgid / nig, fm = gid * WGM, gsz = (nM - fm) < WGM ? (nM - fm) : WGM;
        u.pm = fm + ((wgid % nig) % gsz); u.pn = (wgid % nig) / gsz; u.aux = 0; u.nt = 0; u.a = A + (size_t)u.pm * a_tile; u.b = B + (size_t)u.pn * b_tile; u.rows = nullptr; return true;
    }
    __device__ __forceinline__ void a_ready(const Unit&) const {}
    __device__ __forceinline__ void done(const Unit&) const {}
};
struct SchedBranch {
    SchedStd s; const char* O4; const char* Wb;
    __device__ __forceinline__ bool next(int i, Unit& u) const {
        if (!s.next(i, u)) return false;
        const int br = u.pn >> 2; u.pn &= 3; u.aux = br;
        u.a = O4 + (size_t)u.pm * 256 * 1024 * 2 + (size_t)br * 256 * 2; u.b = Wb + (size_t)br * 1024 * 256 * 2 + (size_t)u.pn * 256 * 256 * 2; return true;
    }
    __device__ __forceinline__ void a_ready(const Unit&) const {}
    __device__ __forceinline__ void done(const Unit&) const {}
};
struct SchedGate {
    int vcu, G; const char* H; const char* Wm;
    __device__ __forceinline__ bool next(int i, Unit& u) const {
        const int tg = vcu + G * (i >> 2); if (tg >= 512) return false;
        u.pm = tg >> 2; u.pn = tg & 3; u.aux = i & 3; u.nt = 0; u.rows = nullptr;
        u.a = H + (size_t)u.pm * 256 * 1024 * 2; u.b = Wm + ((size_t)u.aux * 1024 + (size_t)u.pn * 256) * 1024 * 2; return true;
    }
    __device__ __forceinline__ void a_ready(const Unit&) const {}
    __device__ __forceinline__ void done(const Unit&) const {}
};
struct SchedMoe {
    int c, G, t0, t1, nN; int tstart[9]; int cnt[8];
    const char* A; const int* lists; const char* W; size_t w_tile; bool gather; size_t exp_stride, act_tile;
    __device__ __forceinline__ bool next(int i, Unit& u) const {
        const long L = (long)i * G + c; const int t = t0 + (int)(L / nN); if (t >= t1) return false;
        int e = 0;
#pragma unroll
        for (int k = 1; k < 8; ++k) e = (t >= tstart[k]) ? k : e;
        int ce = 0;
#pragma unroll
        for (int k = 0; k < 8; ++k) ce = (k == e) ? cnt[k] : ce;
        const int j = t - ((e == 0) ? 0 : 0), jj = t;
        (void)j; (void)jj;
        int ts = 0;
#pragma unroll
        for (int k = 0; k < 8; ++k) ts = (k == e) ? tstart[k] : ts;
        const int tj = t - ts;
        u.pn = (int)(L % nN); u.nt = 0;
        if (gather) { u.pm = t - t0; u.a = A; u.rows = lists + (size_t)e * 65536 + tj * 256; const int nv = ce - tj * 256; u.aux = nv > 256 ? 256 : nv; }
        else { u.pm = t; u.a = A + (size_t)(t - t0) * act_tile; u.rows = nullptr; u.aux = 0; }
        u.b = W + (size_t)e * exp_stride + (size_t)u.pn * w_tile; return true;
    }
    static constexpr size_t DFF_ = 2816; static constexpr size_t SZ_EXP_ = (size_t)2 * 2816 * 1024 * 2 + (size_t)1024 * 2816 * 2;
    __device__ __forceinline__ void a_ready(const Unit&) const {}
    __device__ __forceinline__ void done(const Unit&) const {}
};

struct EpiStore {
    static constexpr bool PERM = true;
    bf16_t* O; int ldc; size_t aux_stride; float scale0;
    __device__ __forceinline__ void operator()(const f32x4 (&acc)[2][2][4][2], const Unit& u, int wr, int wc, int fr, int fq) const {
        const int row0 = u.pm * BM + wr * 64 + fr, col0 = u.pn * BM + wc * 32 + 8 * fq; bf16_t* base = O + (size_t)u.aux * aux_stride;
        const float sc = scale0;
#pragma unroll
        for (int ai = 0; ai < 2; ++ai)
#pragma unroll
            for (int m = 0; m < 4; ++m) { bf16_t* rowp = base + (size_t)(row0 + ai * HALF + m * 16) * ldc + col0;
#pragma unroll
                for (int bj = 0; bj < 2; ++bj) { const f32x4 v0 = acc[ai][bj][m][0] * sc, v1 = acc[ai][bj][m][1] * sc;
                    u32x4 w; w.x = cvt_pk_bf16(v0[0], v0[1]); w.y = cvt_pk_bf16(v0[2], v0[3]); w.z = cvt_pk_bf16(v1[0], v1[1]); w.w = cvt_pk_bf16(v1[2], v1[3]);
                    *(u32x4*)(rowp + bj * HALF) = w; } }
    }
};

struct EpiStore64 {
    static constexpr bool PERM = true;
    bf16_t* O;
    __device__ __forceinline__ void operator()(const f32x4 (&acc)[2][2][4][2], const Unit& u, int wr, int wc, int fr, int fq) const {
        int fr_ = fr, fq_ = fq; asm volatile("" : "+v"(fr_), "+v"(fq_));
        bf16_t* base = O + (size_t)(u.pm * BM + wr * 64 + fr_) * 1024 + u.pn * BM + wc * 32 + 8 * fq_;
#pragma unroll
        for (int ai = 0; ai < 2; ++ai)
#pragma unroll
            for (int m = 0; m < 4; ++m) {
#pragma unroll
                for (int bj = 0; bj < 2; ++bj) { const f32x4 v0 = acc[ai][bj][m][0] * (1.f / 64.f), v1 = acc[ai][bj][m][1] * (1.f / 64.f);
                    u32x4 w; w.x = cvt_pk_bf16(v0[0], v0[1]); w.y = cvt_pk_bf16(v0[2], v0[3]); w.z = cvt_pk_bf16(v1[0], v1[1]); w.w = cvt_pk_bf16(v1[2], v1[3]);
                    *(u32x4*)(base + (ai * HALF + m * 16) * 1024 + bj * HALF) = w; }
                __builtin_amdgcn_sched_barrier(0); }
    }
};
struct EpiProj {
    static constexpr bool PERM = true;
    static constexpr int TILE_E = 9728;
    bf16_t* Qb; bf16_t* KV; bf16_t* Pj; unsigned* nmax; float qscale;
    __device__ __forceinline__ void operator()(const f32x4 (&acc)[2][2][4][2], const Unit& u, int wr, int wc, int fr, int fq) const {
        const int t0 = u.pm * BM + wr * 64 + fr;
        const int b = (u.pm * BM) >> 14;
        const int s00 = t0 & 16383;
        if (u.pn >= 3) {
            bf16_t* base = Pj + (size_t)t0 * 2048 + (u.pn - 3) * BM + wc * 32 + 8 * fq;
#pragma unroll
            for (int ai = 0; ai < 2; ++ai)
#pragma unroll
                for (int m = 0; m < 4; ++m) {
#pragma unroll
                    for (int bj = 0; bj < 2; ++bj) { const f32x4 v0 = acc[ai][bj][m][0], v1 = acc[ai][bj][m][1];
                        u32x4 w; w.x = cvt_pk_bf16(v0[0], v0[1]); w.y = cvt_pk_bf16(v0[2], v0[3]); w.z = cvt_pk_bf16(v1[0], v1[1]); w.w = cvt_pk_bf16(v1[2], v1[3]);
                        *(u32x4*)(base + (ai * HALF + m * 16) * 2048 + bj * HALF) = w; }
                    __builtin_amdgcn_sched_barrier(0); }
        } else if (u.pn == 2) {
            bf16_t* hb = KV + ((size_t)((b * 4 + (wc >> 1)) * 256 + (s00 >> 6))) * TILE_E + 5120 + (32 * (wc & 1) + 8 * fq) * 72 + (s00 & 63);
#pragma unroll
            for (int ai = 0; ai < 2; ++ai)
#pragma unroll
                for (int bj = 0; bj < 2; ++bj) { bf16_t* tb = hb + (size_t)bj * (2 * 256 * TILE_E) + ai * (2 * TILE_E);
#pragma unroll
                    for (int m = 0; m < 4; ++m)
#pragma unroll
                        for (int n = 0; n < 2; ++n)
#pragma unroll
                            for (int j = 0; j < 4; ++j) { const float v = acc[ai][bj][m][n][j];
                                unsigned bits = __builtin_bit_cast(unsigned, v); bits = (bits + 0x7fffu + ((bits >> 16) & 1u)) >> 16;
                                tb[(4 * n + j) * 72 + 16 * m] = (bf16_t)bits; }
                    __builtin_amdgcn_sched_barrier(0); }
        } else {
            const float sc = (u.pn == 0) ? qscale : 1.f; float nm = 0.f;
            bf16_t* qbase = Qb + ((size_t)(b * 4 + wc) * 16384 + s00) * 64 + 8 * fq;
            bf16_t* kbase = KV + ((size_t)((b * 4 + wc) * 256 + (s00 >> 6))) * TILE_E + (s00 & 63) * 40 + 8 * fq;
#pragma unroll
            for (int ai = 0; ai < 2; ++ai)
#pragma unroll
                for (int m = 0; m < 4; ++m) {
#pragma unroll
                    for (int bj = 0; bj < 2; ++bj) { const f32x4 v0 = acc[ai][bj][m][0] * sc, v1 = acc[ai][bj][m][1] * sc;
                        u32x4 w; w.x = cvt_pk_bf16(v0[0], v0[1]); w.y = cvt_pk_bf16(v0[2], v0[3]); w.z = cvt_pk_bf16(v1[0], v1[1]); w.w = cvt_pk_bf16(v1[2], v1[3]);
                        float ss = (v0[0] * v0[0] + v0[1] * v0[1]) + (v0[2] * v0[2] + v0[3] * v0[3]) + (v1[0] * v1[0] + v1[1] * v1[1]) + (v1[2] * v1[2] + v1[3] * v1[3]);
                        ss += __shfl_xor(ss, 16); ss += __shfl_xor(ss, 32); nm = fmaxf(nm, ss);
                        if (u.pn == 0) *(u32x4*)(qbase + (ai * HALF + m * 16) * 64 + 32 * bj) = w;
                        else *(u32x4*)(kbase + ai * (2 * TILE_E) + bj * 2560 + (16 * m) * 40) = w; }
                    __builtin_amdgcn_sched_barrier(0); }
            nm = fmaxf(nm, __shfl_xor(nm, 1)); nm = fmaxf(nm, __shfl_xor(nm, 2)); nm = fmaxf(nm, __shfl_xor(nm, 4)); nm = fmaxf(nm, __shfl_xor(nm, 8));
            if (fr == 0 && fq == 0) atomicMax(nmax + (b * 4 + wc) * 2 + u.pn, __builtin_bit_cast(unsigned, nm));
        }
    }
};
__device__ __forceinline__ float sigm(float x) { return __builtin_amdgcn_rcpf(1.f + __builtin_amdgcn_exp2f(-1.4426950408889634f * x)); }
struct EpiGate {
    static constexpr bool PERM = true;
    const bf16_t* P; bf16_t* Mg; const float* bias;
    __device__ __forceinline__ void operator()(const f32x4 (&acc)[2][2][4][2], const Unit& u, int wr, int wc, int fr, int fq) const {
        const int row0 = u.pm * BM + wr * 64 + fr, col0 = u.pn * BM + wc * 32 + 8 * fq; const int br = u.aux;
        const bf16_t* Pb = P + (size_t)br * 32768 * 1024; const float* bb = bias + br * 1024 + col0;
        f32x4 bv[2][2];
#pragma unroll
        for (int bj = 0; bj < 2; ++bj)
#pragma unroll
            for (int n = 0; n < 2; ++n) bv[bj][n] = *(const f32x4*)(bb + bj * HALF + 4 * n);
#pragma unroll
        for (int ai = 0; ai < 2; ++ai)
#pragma unroll
            for (int m = 0; m < 4; ++m) { const size_t ro = (size_t)(row0 + ai * HALF + m * 16) * 1024 + col0;
#pragma unroll
                for (int bj = 0; bj < 2; ++bj) {
                    const u32x4 pw = *(const u32x4*)(Pb + ro + bj * HALF);
                    u32x4 mw = {0u, 0u, 0u, 0u}; if (br != 0) mw = *(const u32x4*)(Mg + ro + bj * HALF);
                    float o[8];
#pragma unroll
                    for (int q = 0; q < 4; ++q) {
                        const float g0 = sigm(acc[ai][bj][m][q >> 1][(q & 1) * 2] + bv[bj][q >> 1][(q & 1) * 2]), g1 = sigm(acc[ai][bj][m][q >> 1][(q & 1) * 2 + 1] + bv[bj][q >> 1][(q & 1) * 2 + 1]);
                        o[2 * q] = g0 * __builtin_bit_cast(float, pw[q] << 16) + __builtin_bit_cast(float, mw[q] << 16);
                        o[2 * q + 1] = g1 * __builtin_bit_cast(float, pw[q] & 0xffff0000u) + __builtin_bit_cast(float, mw[q] & 0xffff0000u);
                    }
                    u32x4 w; w.x = cvt_pk_bf16(o[0], o[1]); w.y = cvt_pk_bf16(o[2], o[3]); w.z = cvt_pk_bf16(o[4], o[5]); w.w = cvt_pk_bf16(o[6], o[7]);
                    *(u32x4*)(Mg + ro + bj * HALF) = w; } }
    }
};
struct SchedGateP {
    int vcu, G; const char* ws; size_t oH, oWm, oO4, oWb4;
    __device__ __forceinline__ bool next(int i, Unit& u) const {
        const int tg = vcu + G * (i >> 3); if (tg >= 512) return false;
        const int br = (i >> 1) & 3, isg = i & 1;
        u.pm = tg >> 2; u.pn = tg & 3; u.rows = nullptr;
        if (isg) { u.aux = br; u.nt = 16; u.a = ws + oH + (size_t)u.pm * 256 * 1024 * 2; u.b = ws + oWm + ((size_t)br * 1024 + (size_t)u.pn * 256) * 1024 * 2; }
        else { u.aux = br | 4; u.nt = 4; u.a = ws + oO4 + (size_t)u.pm * 256 * 1024 * 2 + br * 512; u.b = ws + oWb4 + (size_t)u.pn * 256 * 1024 * 2 + br * 512; }
        return true;
    }
    __device__ __forceinline__ void a_ready(const Unit&) const {}
    __device__ __forceinline__ void done(const Unit&) const {}
};
struct EpiGateP {
    static constexpr bool PERM = true;
    bf16_t* Pscr; bf16_t* Mg; const float* bias; int tid;
    __device__ __forceinline__ void operator()(const f32x4 (&acc)[2][2][4][2], const Unit& u, int wr, int wc, int fr, int fq) const {
        u32x4* ps = (u32x4*)Pscr + tid;
        if (u.aux & 4) {
#pragma unroll
            for (int ai = 0; ai < 2; ++ai)
#pragma unroll
                for (int m = 0; m < 4; ++m)
#pragma unroll
                    for (int bj = 0; bj < 2; ++bj) { const f32x4 v0 = acc[ai][bj][m][0], v1 = acc[ai][bj][m][1];
                        u32x4 w; w.x = cvt_pk_bf16(v0[0], v0[1]); w.y = cvt_pk_bf16(v0[2], v0[3]); w.z = cvt_pk_bf16(v1[0], v1[1]); w.w = cvt_pk_bf16(v1[2], v1[3]);
                        ps[((ai * 4 + m) * 2 + bj) * 512] = w; }
            return;
        }
        int fr_ = fr, fq_ = fq; asm volatile("" : "+v"(fr_), "+v"(fq_));
        const int row0 = u.pm * BM + wr * 64 + fr_, col0 = u.pn * BM + wc * 32 + 8 * fq_; const int br = u.aux;
        const float* bb = bias + br * 1024 + col0;
#pragma unroll
        for (int ai = 0; ai < 2; ++ai)
#pragma unroll
            for (int m = 0; m < 4; ++m) { const size_t ro = (size_t)(row0 + ai * HALF + m * 16) * 1024 + col0;
#pragma unroll
                for (int bj = 0; bj < 2; ++bj) {
                    const f32x4 b0 = *(const f32x4*)(bb + bj * HALF), b1 = *(const f32x4*)(bb + bj * HALF + 4);
                    const u32x4 pw = ps[((ai * 4 + m) * 2 + bj) * 512];
                    u32x4 mw = {0u, 0u, 0u, 0u}; if (br != 0) mw = *(const u32x4*)(Mg + ro + bj * HALF);
                    const f32x4 a0 = acc[ai][bj][m][0] + b0, a1 = acc[ai][bj][m][1] + b1;
                    float o[8];
                    o[0] = sigm(a0[0]) * __builtin_bit_cast(float, pw[0] << 16) + __builtin_bit_cast(float, mw[0] << 16);
                    o[1] = sigm(a0[1]) * __builtin_bit_cast(float, pw[0] & 0xffff0000u) + __builtin_bit_cast(float, mw[0] & 0xffff0000u);
                    o[2] = sigm(a0[2]) * __builtin_bit_cast(float, pw[1] << 16) + __builtin_bit_cast(float, mw[1] << 16);
                    o[3] = sigm(a0[3]) * __builtin_bit_cast(float, pw[1] & 0xffff0000u) + __builtin_bit_cast(float, mw[1] & 0xffff0000u);
                    o[4] = sigm(a1[0]) * __builtin_bit_cast(float, pw[2] << 16) + __builtin_bit_cast(float, mw[2] << 16);
                    o[5] = sigm(a1[1]) * __builtin_bit_cast(float, pw[2] & 0xffff0000u) + __builtin_bit_cast(float, mw[2] & 0xffff0000u);
                    o[6] = sigm(a1[2]) * __builtin_bit_cast(float, pw[3] << 16) + __builtin_bit_cast(float, mw[3] << 16);
                    o[7] = sigm(a1[3]) * __builtin_bit_cast(float, pw[3] & 0xffff0000u) + __builtin_bit_cast(float, mw[3] & 0xffff0000u);
                    u32x4 w; w.x = cvt_pk_bf16(o[0], o[1]); w.y = cvt_pk_bf16(o[2], o[3]); w.z = cvt_pk_bf16(o[4], o[5]); w.w = cvt_pk_bf16(o[6], o[7]);
                    *(u32x4*)(Mg + ro + bj * HALF) = w;
                    __builtin_amdgcn_sched_barrier(0); } }
    }
};
template <bool F8 = false> struct EpiSwiGLU {
    static constexpr bool PERM = true;
    bf16_t* O; int ldc;
    __device__ __forceinline__ void operator()(const f32x4 (&acc)[2][2][4][2], const Unit& u, int wr, int wc, int fr, int fq) const {
        const int row0 = u.pm * BM + wr * 64 + fr, col0 = u.pn * HALF + wc * 32 + 8 * fq;
#pragma unroll
        for (int ai = 0; ai < 2; ++ai)
#pragma unroll
            for (int m = 0; m < 4; ++m) {
                float o[8]; constexpr float isc = F8 ? (1.f / 64.f) : 1.f;
#pragma unroll
                for (int n = 0; n < 2; ++n)
#pragma unroll
                    for (int q = 0; q < 4; ++q) { const float g = acc[ai][0][m][n][q] * isc, up = acc[ai][1][m][n][q] * isc; o[4 * n + q] = g * sigm(g) * up; }
                if constexpr (F8) { int w0 = __builtin_amdgcn_cvt_pk_fp8_f32(o[0], o[1], 0, false); w0 = __builtin_amdgcn_cvt_pk_fp8_f32(o[2], o[3], w0, true);
                    int w1 = __builtin_amdgcn_cvt_pk_fp8_f32(o[4], o[5], 0, false); w1 = __builtin_amdgcn_cvt_pk_fp8_f32(o[6], o[7], w1, true);
                    u32x2 w = {(unsigned)w0, (unsigned)w1}; *(u32x2*)((unsigned char*)O + (size_t)(row0 + ai * HALF + m * 16) * ldc + col0) = w; }
                else { bf16_t* rowp = O + (size_t)(row0 + ai * HALF + m * 16) * ldc + col0;
                    u32x4 w; w.x = cvt_pk_bf16(o[0], o[1]); w.y = cvt_pk_bf16(o[2], o[3]); w.z = cvt_pk_bf16(o[4], o[5]); w.w = cvt_pk_bf16(o[6], o[7]);
                    *(u32x4*)rowp = w; } }
    }
};
}

namespace att {
constexpr int SLOT = 19456, NSLOT = 6;
constexpr int ATTN_LDS = NSLOT * SLOT;
__device__ __forceinline__ unsigned cvtpk(float lo, float hi) { typedef float f2 __attribute__((ext_vector_type(2))); typedef __bf16 b2 __attribute__((ext_vector_type(2))); f2 v = {lo, hi}; b2 b = __builtin_convertvector(v, b2); return __builtin_bit_cast(unsigned, b); }
#define ATT_WAITV(n) asm volatile("s_waitcnt vmcnt(" #n ")" ::: "memory")
__device__ __forceinline__ float max3f(float a, float b, float c) { float r; asm("v_max3_f32 %0, %1, %2, %3" : "=v"(r) : "v"(a), "v"(b), "v"(c)); return r; }

#define ATT_SOFTMAX(s0, s1, pw, LS) do { \
    asm volatile("s_nop 15\n\ts_nop 7" : "+v"(s0), "+v"(s1)); \
    float rm = max3f(s0[0], s0[1], s1[0]), rm2 = max3f(s0[2], s0[3], s1[1]); rm = max3f(rm, s1[2], s1[3]); \
    _Pragma("unroll") for (int r = 4; r < 16; r += 4) { rm = max3f(rm, s0[r], s0[r + 1]); rm2 = max3f(rm2, s0[r + 2], s0[r + 3]); rm = max3f(rm, s1[r], s1[r + 1]); rm2 = max3f(rm2, s1[r + 2], s1[r + 3]); } \
    rm = fmaxf(rm, rm2); \
    { auto rr = __builtin_amdgcn_permlane32_swap(__builtin_bit_cast(unsigned, rm), __builtin_bit_cast(unsigned, rm), false, false); rm = fmaxf(__builtin_bit_cast(float, rr[0]), __builtin_bit_cast(float, rr[1])); } \
    if (__any(rm > 8.f)) { \
        const float dd = fmaxf(rm, 0.f); R += dd; \
        const float f = fast_exp2(-dd); l1 *= f; l2 *= f; \
        _Pragma("unroll") for (int r = 0; r < 16; ++r) { s0[r] -= dd; s1[r] -= dd; c0[r] -= dd; c1[r] -= dd; O1[0][r] *= f; O1[1][r] *= f; O2[0][r] *= f; O2[1][r] *= f; } \
        p1scale = f; \
    } \
    { float sa_ = 0.f, sb_ = 0.f; _Pragma("unroll") for (int r = 0; r < 16; ++r) { s0[r] = fast_exp2(s0[r]); s1[r] = fast_exp2(s1[r]); sa_ += s0[r]; sb_ += s1[r]; } LS += sa_ + sb_; } \
    _Pragma("unroll") for (int e = 0; e < 4; ++e) { pw[0][e] = cvtpk(s0[2 * e], s0[2 * e + 1]); pw[1][e] = cvtpk(s0[8 + 2 * e], s0[8 + 2 * e + 1]); pw[2][e] = cvtpk(s1[2 * e], s1[2 * e + 1]); pw[3][e] = cvtpk(s1[8 + 2 * e], s1[8 + 2 * e + 1]); } \
} while (0)

__device__ __forceinline__ void attn_unit(Frame& F, const int layer, const int b, const int h, const int qb) {
    const int lane = F.lane, r32 = lane & 31, hi = lane >> 5, wid = F.wave;
    LAS unsigned char* L = F.lds + RING_OFF;
    const int qw0 = qb * 256 + wid * 32, q = qw0 + r32;
    const float slope2 = exp2f(-2.f * (float)(h + 1)) * 1.4426950408889634f;
    int tlo, thi;
    { const unsigned* nm = (const unsigned*)(F.ctl + CW_NMAX) + layer * 16 + (b * 4 + h) * 2;
      const float qn = sqrtf(__builtin_bit_cast(float, __hip_atomic_load(nm, RLX_AGENT))) * 1.01f, kn = sqrtf(__builtin_bit_cast(float, __hip_atomic_load(nm + 1, RLX_AGENT))) * 1.01f;
      const float wf = (160.f + 2.f * qn * kn) / slope2; const int W = wf > 100000.f ? 100000 : (int)wf + 1;
      const int lo = qb * 256 - W, hi_ = qb * 256 + 255 + W; tlo = lo < 0 ? 0 : (lo >> 6); thi = hi_ >= SEQ ? (SEQ / 64 - 1) : (hi_ >> 6);
      if (((thi - tlo + 1) & 1) != 0) { if (thi < SEQ / 64 - 1) ++thi; else --tlo; } }
    const int nP = (thi - tlo + 1) >> 1;
    const bf16* Qp = (const bf16*)(F.ws + WS_QB) + ((size_t)(b * 4 + h) * SEQ + q) * 64;
    bf16x8 q1f[2], q2f[2];
#pragma unroll
    for (int ks = 0; ks < 2; ++ks) { q1f[ks] = *(const GAS bf16x8*)(Qp + 16 * ks + 8 * hi); q2f[ks] = *(const GAS bf16x8*)(Qp + 32 + 16 * ks + 8 * hi); }
    const unsigned char* kvbase = F.ws + WS_KV + ((size_t)(b * 4 + h) * 256) * SLOT + (size_t)wid * 1024 + lane * 16;
    const bool w3 = wid < 3;
#define ATT_DMA1(t, slot) do { const unsigned char* g_ = kvbase + (size_t)(t) * SLOT; LAS unsigned char* d_ = L + (slot) * SLOT + wid * 1024; \
        __builtin_amdgcn_global_load_lds((const unsigned*)g_, (LAS unsigned*)d_, 16, 0, 0); __builtin_amdgcn_global_load_lds((const unsigned*)(g_ + 8192), (LAS unsigned*)(d_ + 8192), 16, 0, 0); \
        if (w3) __builtin_amdgcn_global_load_lds((const unsigned*)(g_ + 16384), (LAS unsigned*)(d_ + 16384), 16, 0, 0); } while (0)
#define ATT_DMA2(pr, ps) do { ATT_DMA1(tlo + 2 * (pr), 2 * (ps)); ATT_DMA1(tlo + 2 * (pr) + 1, 2 * (ps) + 1); } while (0)
    asm volatile("s_waitcnt vmcnt(0)" ::: "memory");
    ATT_DMA2(0, 0);
    if (nP > 1) ATT_DMA2(1, 1);
    float R = 0.f, l1 = 0.f, l2 = 0.f;
    f32x16 O1[2], O2[2];
#pragma unroll
    for (int i = 0; i < 16; ++i) { O1[0][i] = 0.f; O1[1][i] = 0.f; O2[0][i] = 0.f; O2[1][i] = 0.f; }
    const int pr32 = (r32 & 0x13) | ((r32 & 4) << 1) | ((r32 & 8) >> 1);
    const int kfo = pr32 * 80 + hi * 16;
    const int vfo = 10240 + r32 * 144 + hi * 16;
    int ps = 0;
    for (int ip = 0; ip < nP; ++ip) {
        if (ip + 1 < nP) { if (w3) ATT_WAITV(6); else ATT_WAITV(4); } else ATT_WAITV(0);
        __builtin_amdgcn_s_barrier();
        asm volatile("" ::: "memory");
        if (ip + 2 < nP) { const int s2 = ps >= 1 ? ps - 1 : 2; ATT_DMA2(ip + 2, s2); }
#pragma unroll
        for (int half = 0; half < 2; ++half) {
            const int t = tlo + 2 * ip + half;
            const LAS unsigned char* Bf = L + (2 * ps + half) * SLOT;
            const float dl = (float)(q - t * 64 - 8 * hi);
            v4u pw1[4], pw2[4];
            const bf16x8 ka00 = *(const LAS bf16x8*)(Bf + kfo), ka01 = *(const LAS bf16x8*)(Bf + kfo + 32), ka10 = *(const LAS bf16x8*)(Bf + 32 * 80 + kfo), ka11 = *(const LAS bf16x8*)(Bf + 32 * 80 + kfo + 32);
            const bf16x8 kb00 = *(const LAS bf16x8*)(Bf + 5120 + kfo), kb01 = *(const LAS bf16x8*)(Bf + 5120 + kfo + 32), kb10 = *(const LAS bf16x8*)(Bf + 5120 + 32 * 80 + kfo), kb11 = *(const LAS bf16x8*)(Bf + 5120 + 32 * 80 + kfo + 32);
            f32x16 c0, c1;
            if (t * 64 + 63 < qw0) {
                const float tl = -slope2 * dl - R;
#pragma unroll
                for (int r = 0; r < 16; ++r) { const float cc = (float)(16 * (r >> 3) + (r & 7)); c0[r] = __builtin_fmaf(slope2, cc, tl); c1[r] = __builtin_fmaf(slope2, cc + 32.f, tl); }
            } else if (t * 64 > qw0 + 31) {
                const float tr = slope2 * dl - R;
#pragma unroll
                for (int r = 0; r < 16; ++r) { const float cc = (float)(16 * (r >> 3) + (r & 7)); c0[r] = __builtin_fmaf(-slope2, cc, tr); c1[r] = __builtin_fmaf(-slope2, cc + 32.f, tr); }
            } else {
#pragma unroll
                for (int r = 0; r < 16; ++r) { const float cc = (float)(16 * (r >> 3) + (r & 7)); c0[r] = __builtin_fmaf(-slope2, __builtin_fabsf(dl - cc), -R); c1[r] = __builtin_fmaf(-slope2, __builtin_fabsf(dl - (cc + 32.f)), -R); }
            }
            {
                f32x16 s0 = __builtin_amdgcn_mfma_f32_32x32x16_bf16(ka00, q1f[0], c0, 0, 0, 0); s0 = __builtin_amdgcn_mfma_f32_32x32x16_bf16(ka01, q1f[1], s0, 0, 0, 0);
                f32x16 s1 = __builtin_amdgcn_mfma_f32_32x32x16_bf16(ka10, q1f[0], c1, 0, 0, 0); s1 = __builtin_amdgcn_mfma_f32_32x32x16_bf16(ka11, q1f[1], s1, 0, 0, 0);
                float p1scale = 1.f; ATT_SOFTMAX(s0, s1, pw1, l1); (void)p1scale;
            }
            bf16x8 vf[2][4];
            {
                f32x16 s0 = __builtin_amdgcn_mfma_f32_32x32x16_bf16(kb00, q2f[0], c0, 0, 0, 0); s0 = __builtin_amdgcn_mfma_f32_32x32x16_bf16(kb01, q2f[1], s0, 0, 0, 0);
                f32x16 s1 = __builtin_amdgcn_mfma_f32_32x32x16_bf16(kb10, q2f[0], c1, 0, 0, 0); s1 = __builtin_amdgcn_mfma_f32_32x32x16_bf16(kb11, q2f[1], s1, 0, 0, 0);
#pragma unroll
                for (int db = 0; db < 2; ++db)
#pragma unroll
                    for (int ks = 0; ks < 4; ++ks) vf[db][ks] = *(const LAS bf16x8*)(Bf + vfo + db * 32 * 144 + ks * 32);
                float p1scale = 1.f; ATT_SOFTMAX(s0, s1, pw2, l2);
                if (__any(p1scale != 1.f)) {
#pragma unroll
                    for (int ks = 0; ks < 4; ++ks)
#pragma unroll
                        for (int e = 0; e < 4; ++e) { const unsigned w = pw1[ks][e]; pw1[ks][e] = cvtpk(bflo(w) * p1scale, bfhi(w) * p1scale); }
                }
            }
#pragma unroll
            for (int db = 0; db < 2; ++db)
#pragma unroll
                for (int ks = 0; ks < 4; ++ks) {
                    O1[db] = __builtin_amdgcn_mfma_f32_32x32x16_bf16(vf[db][ks], __builtin_bit_cast(bf16x8, pw1[ks]), O1[db], 0, 0, 0);
                    O2[db] = __builtin_amdgcn_mfma_f32_32x32x16_bf16(vf[db][ks], __builtin_bit_cast(bf16x8, pw2[ks]), O2[db], 0, 0, 0);
                }
        }
        ps = ps == 2 ? 0 : ps + 1;
    }
    l1 += __shfl_xor(l1, 32); l2 += __shfl_xor(l2, 32);
    const float* dlm = F.in[I_DLAMBDA] + layer * 128;
    float a1 = 0.f, a2 = 0.f;
#pragma unroll 8
    for (int i = 0; i < 32; ++i) { a1 += dlm[i] * dlm[32 + i]; a2 += dlm[64 + i] * dlm[96 + i]; }
    const float lam_init = 0.8f - 0.6f * __expf(-0.3f * (float)layer);
    const float lam = __expf(a1) - __expf(a2) + lam_init;
    const float i1 = 1.f / fmaxf(l1, 1e-30f), i2 = lam / fmaxf(l2, 1e-30f);
    float ss = 0.f;
#pragma unroll
    for (int db = 0; db < 2; ++db)
#pragma unroll
        for (int r = 0; r < 16; ++r) { const float v = O1[db][r] * i1 - O2[db][r] * i2; O1[db][r] = v; ss += v * v; }
    ss += __shfl_xor(ss, 32);
    const float rs = (1.f / sqrtf(ss * (1.f / 64.f) + EPS)) * (1.f - lam_init);
    bf16* orow = (bf16*)(F.ws + WS_O4) + ((size_t)b * SEQ + q) * 1024 + 64 * h;
    const float* sg = F.in[I_DSUBLN] + layer * 64;
#pragma unroll
    for (int db = 0; db < 2; ++db)
#pragma unroll
        for (int g4 = 0; g4 < 4; ++g4) {
            const int d0 = 32 * db + 8 * g4 + 4 * hi;
            const float v0 = O1[db][4 * g4] * rs * sg[d0], v1 = O1[db][4 * g4 + 1] * rs * sg[d0 + 1], v2 = O1[db][4 * g4 + 2] * rs * sg[d0 + 2], v3 = O1[db][4 * g4 + 3] * rs * sg[d0 + 3];
            v2u w = {pk2(v0, v1), pk2(v2, v3)};
            *(GAS v2u*)(orow + d0) = w;
        }
    asm volatile("s_waitcnt lgkmcnt(0)" ::: "memory");
    __builtin_amdgcn_s_barrier();
#undef ATT_DMA1
#undef ATT_DMA2
}
#undef ATT_SOFTMAX
#undef ATT_WAITV
}

namespace pc {
constexpr int MPITCH = 72;
__device__ __forceinline__ void pool_task(Frame& F, const int layer, const int tile, const int g, LAS unsigned char* mimg) {
    const int lane = F.lane, r32 = lane & 31, hi = lane >> 5;
    const bf16* P = (const bf16*)(F.ws + WS_PROJ);
    bf16* O4 = (bf16*)(F.ws + WS_O4);
    bf16x8 wf[2][4];
    { const float* W = F.in[I_POOLW] + ((size_t)layer * 4 + g) * 64 * 64;
#pragma unroll
      for (int nb = 0; nb < 2; ++nb)
#pragma unroll
          for (int ks = 0; ks < 4; ++ks) { v4u t;
#pragma unroll
              for (int jj = 0; jj < 4; ++jj) t[jj] = pk2(W[(16 * ks + 8 * hi + 2 * jj) * 64 + r32 + 32 * nb], W[(16 * ks + 8 * hi + 2 * jj + 1) * 64 + r32 + 32 * nb]);
              wf[nb][ks] = __builtin_bit_cast(bf16x8, t); } }
    const int t0 = tile * 64, s0 = t0 % SEQ, hw = 1 << g;
    const bf16* src = P + (size_t)t0 * PJ + C_PIN + 64 * g + lane;
    float cs[81]; cs[0] = 0.f;
#pragma unroll
    for (int i = 0; i < 80; ++i) { const int s = s0 - 8 + i; float v = 0.f; if (s >= 0 && s < SEQ) v = bf2f(src[(long)(i - 8) * PJ]); cs[i + 1] = cs[i] + v; }
#pragma unroll
    for (int i = 0; i < 64; ++i) {
        const int s = s0 + i; int lo = s - hw, hiw = s + hw; lo = lo < 0 ? 0 : lo; hiw = hiw > SEQ ? SEQ : hiw;
        float wsum = 0.f;
        if (g == 0) wsum = cs[i + 8 + 1] - cs[i + 8 - 1]; else if (g == 1) wsum = cs[i + 8 + 2] - cs[i + 8 - 2]; else if (g == 2) wsum = cs[i + 8 + 4] - cs[i + 8 - 4]; else wsum = cs[i + 8 + 8] - cs[i + 8 - 8];
        const float pv = cs[i + 9] - cs[i + 8];
        const float mval = wsum / (float)(hiw - lo) - pv;
        *(LAS unsigned short*)(mimg + i * (MPITCH * 2) + lane * 2) = (unsigned short)f2bf(mval);
    }
    LDS_WAIT();
#pragma unroll
    for (int tb = 0; tb < 2; ++tb) {
        bf16x8 af[4];
#pragma unroll
        for (int ks = 0; ks < 4; ++ks) af[ks] = *(const LAS bf16x8*)(mimg + (r32 + 32 * tb) * (MPITCH * 2) + (16 * ks + 8 * hi) * 2);
#pragma unroll
        for (int nb = 0; nb < 2; ++nb) {
            f32x16 acc;
#pragma unroll
            for (int r = 0; r < 16; ++r) acc[r] = 0.f;
#pragma unroll
            for (int ks = 0; ks < 4; ++ks) acc = __builtin_amdgcn_mfma_f32_32x32x16_bf16(af[ks], wf[nb][ks], acc, 0, 0, 0);
            const int e = r32 + 32 * nb; const float sc = F.in[I_POOLSCALE][layer * 256 + 64 * g + e];
#pragma unroll
            for (int r = 0; r < 16; ++r) { const int row = 32 * tb + (r & 3) + 8 * (r >> 2) + 4 * hi;
                O4[(size_t)(t0 + row) * 1024 + 256 + 64 * g + e] = (bf16)f2bf(acc[r] * sc); }
        }
    }
    LDS_WAIT();
}
__device__ __forceinline__ void conv_task(Frame& F, const int layer, const int tile, const int cg) {
    const int lane = F.lane;
    const bf16* P = (const bf16*)(F.ws + WS_PROJ);
    bf16* O4 = (bf16*)(F.ws + WS_O4);
    const int t0 = tile * 64, s0 = t0 % SEQ;
    const int ch = 64 * cg + lane;
    const float w0 = F.in[I_SCONVW][layer * 768 + ch], w1 = F.in[I_SCONVW][layer * 768 + 256 + ch], w2 = F.in[I_SCONVW][layer * 768 + 512 + ch];
    const bf16* base = P + (size_t)t0 * PJ + ch;
    float zm = 0.f, z0 = 0.f, zp = 0.f;
    if (s0 > 0) zm = bf2f(base[-(long)PJ + C_CC]) * bf2f(base[-(long)PJ + C_CX]);
    z0 = bf2f(base[C_CC]) * bf2f(base[C_CX]);
#pragma unroll 8
    for (int i = 0; i < 64; ++i) {
        zp = 0.f; if (s0 + i + 1 < SEQ) zp = bf2f(base[(long)(i + 1) * PJ + C_CC]) * bf2f(base[(long)(i + 1) * PJ + C_CX]);
        const float cbv = bf2f(base[(long)i * PJ + C_CB]);
        O4[(size_t)(t0 + i) * 1024 + 512 + ch] = (bf16)f2bf(cbv * (w0 * zm + w1 * z0 + w2 * zp));
        zm = z0; z0 = zp;
    }
}
}

namespace dl {
constexpr int MP = 72, MB = 64 * MP * 2;
constexpr int WAVE_LDS = 2 * MB + 2 * MB;
__device__ __forceinline__ int crow(int r, int hi) { return (r & 3) + 8 * (r >> 2) + 4 * hi; }
__device__ __forceinline__ bf16x8 ldfrag(const LAS unsigned char* img, int row, int col) { return *(const LAS bf16x8*)(img + row * (MP * 2) + col * 2); }
__device__ __forceinline__ bf16x8 ldfragp(const LAS unsigned char* img, int row, int col4) {
    const v2u lo = *(const LAS v2u*)(img + row * (MP * 2) + col4 * 2), hi8 = *(const LAS v2u*)(img + row * (MP * 2) + col4 * 2 + 16); const v4u t = {lo.x, lo.y, hi8.x, hi8.y}; return __builtin_bit_cast(bf16x8, t); }
__device__ __forceinline__ bf16x8 cfrag(const f32x16& x, int half) {
    v4u t;
#pragma unroll
    for (int e = 0; e < 4; ++e) t[e] = att::cvtpk(x[8 * half + 2 * e], x[8 * half + 2 * e + 1]);
    return __builtin_bit_cast(bf16x8, t); }
#define MFMA32(a, b, c) __builtin_amdgcn_mfma_f32_32x32x16_bf16((a), (b), (c), 0, 0, 0)
#define SB() __builtin_amdgcn_sched_barrier(0)
#define LAUNDER() do { asm volatile("" : "+v"(lane)); r32 = lane & 31; hi = lane >> 5; } while (0)
__device__ __forceinline__ f32x16 zero16() { f32x16 z;
#pragma unroll
    for (int r = 0; r < 16; ++r) z[r] = 0.f;
    return z; }

#define DL_CONV(colbase, wbase, RAW) do { \
    { const bf16* src_ = P + (size_t)tok0 * PJ + (colbase); const int rr_ = lane >> 3, ch_ = lane & 7; \
      _Pragma("unroll") for (int i_ = 0; i_ < 9; ++i_) { const int row_ = rr_ + 8 * i_; const int sq_ = s0 - 2 + row_; v4u t_ = {0u, 0u, 0u, 0u}; \
          if (row_ < 68 && sq_ >= 0 && sq_ < SEQ) t_ = *(const GAS v4u*)(src_ + (long)(row_ - 2) * PJ + ch_ * 8); if (row_ < 68) *(LAS v4u*)((RAW) + row_ * 128 + ch_ * 16) = t_; } } \
    LDS_WAIT(); \
    const float cw0 = cwp[(wbase) + lane], cw1 = cwp[768 + (wbase) + lane], cw2 = cwp[2 * 768 + (wbase) + lane], cw3 = cwp[3 * 768 + (wbase) + lane], cw4 = cwp[4 * 768 + (wbase) + lane]; \
    const LAS unsigned short* rw_ = (const LAS unsigned short*)(RAW) + lane; \
    _Pragma("unroll") for (int i = 0; i < 64; ++i) { \
        const float cv_ = cw0 * bf2f(rw_[i * 64]) + cw1 * bf2f(rw_[(i + 1) * 64]) + cw2 * bf2f(rw_[(i + 2) * 64]) + cw3 * bf2f(rw_[(i + 3) * 64]) + cw4 * bf2f(rw_[(i + 4) * 64]); \
        cval[i] = cv_ * sigmoidf_(cv_); if ((i & 7) == 7) SB(); } \
    LDS_WAIT(); } while (0)
#define DL_NORM(SQ, scale) do { \
    _Pragma("unroll") for (int i = 0; i < 64; ++i) *(LAS unsigned short*)((SQ) + i * 144 + lane * 2) = (unsigned short)f2bf(cval[i] * cval[i]); \
    LDS_WAIT(); \
    { float sm_ = 0.f; _Pragma("unroll") for (int c8 = 0; c8 < 8; ++c8) { const v4u w_ = *(const LAS v4u*)((SQ) + lane * 144 + c8 * 16); \
          sm_ += (bflo(w_.x) + bfhi(w_.x)) + (bflo(w_.y) + bfhi(w_.y)) + (bflo(w_.z) + bfhi(w_.z)) + (bflo(w_.w) + bfhi(w_.w)); } \
      tab[192 + lane] = (scale) / sqrtf(sm_ + EPS); } \
    LDS_WAIT(); \
    _Pragma("unroll") for (int i4 = 0; i4 < 16; ++i4) { const f32x4 r4_ = *(const LAS f32x4*)(tab + 192 + 4 * i4); cval[4 * i4] *= r4_.x; cval[4 * i4 + 1] *= r4_.y; cval[4 * i4 + 2] *= r4_.z; cval[4 * i4 + 3] *= r4_.w; } \
    } while (0)

__device__ __forceinline__ void d1_instance(Frame& F, const int layer, const int b, const int h, const int norig, const int dir, LAS unsigned char* W, LAS float* tab) {
    int lane = F.lane, r32, hi; LAUNDER();
    const bf16* P = (const bf16*)(F.ws + WS_PROJ);
    const float* cwp = F.in[I_DCONVW] + (size_t)layer * 5 * 768;
    const int s0 = norig * 64, tok0 = b * SEQ + s0;
    const int npr = dir ? 255 - norig : norig;
    const int inst = ((b * 4 + h) * 2 + dir) * NCHUNK + npr;
    LAS unsigned char* VT = W;
    LAS unsigned char* KT = W + MB;
    LAS unsigned char* KR = W + 2 * MB;
    LAS unsigned char* T2 = W + 3 * MB;
    LAS float* SM = (LAS float*)(W + 2 * MB);
    float cval[64];
    DL_CONV(C_DK + 64 * h, 256 + 64 * h, T2);
    DL_NORM(VT, 1.f);
#pragma unroll
    for (int i = 0; i < 64; ++i) { const int ip = dir ? 63 - i : i; const unsigned short kb = (unsigned short)f2bf(cval[i]);
        *(LAS unsigned short*)(KR + ip * (MP * 2) + lane * 2) = kb; *(LAS unsigned short*)(KT + lane * (MP * 2) + ip * 2) = kb; }
    LDS_WAIT();
    DL_CONV(C_DV + 64 * h, 512 + 64 * h, T2);
#pragma unroll
    for (int i = 0; i < 64; ++i) { const int ip = dir ? 63 - i : i; *(LAS unsigned short*)(VT + lane * (MP * 2) + ip * 2) = (unsigned short)f2bf(cval[i]); }
    const int mytok = tok0 + (dir ? 63 - lane : lane);
    const float* BD = (const float*)(F.ws + WS_BD) + (size_t)mytok * 16;
    const float beta = BD[dir * 4 + h]; float gc = BD[8 + dir * 4 + h];
#pragma unroll
    for (int o = 1; o < 64; o <<= 1) { const float t = __shfl_up(gc, o); if (lane >= o) gc += t; }
    const float gl = __shfl(gc, 63);
    tab[lane] = gc; tab[64 + lane] = beta; tab[128 + lane] = __expf(gl - gc);
    LDS_WAIT();
    LAUNDER();
    f32x16 kk[2][2];
#pragma unroll
    for (int tb = 0; tb < 2; ++tb)
#pragma unroll
        for (int tn = 0; tn < 2; ++tn) { f32x16 acc = zero16();
#pragma unroll
            for (int ks = 0; ks < 4; ++ks) acc = MFMA32(ldfrag(KR, r32 + 32 * tb, 16 * ks + 8 * hi), ldfrag(KR, r32 + 32 * tn, 16 * ks + 8 * hi), acc);
            kk[tb][tn] = acc; SB(); }
    LDS_WAIT();
#pragma unroll
    for (int tb = 0; tb < 2; ++tb)
#pragma unroll
        for (int tn = 0; tn < 2; ++tn) {
            const int jc = r32 + 32 * tn; const float gcj = tab[jc];
#pragma unroll
            for (int r = 0; r < 16; ++r) { const int ir = 32 * tb + crow(r, hi); const float gci = tab[ir], bi = tab[64 + ir];
                const float mv = (ir > jc) ? bi * kk[tb][tn][r] * __expf(gci - gcj) : 0.f; SM[ir * 64 + jc] = mv; } SB(); }
    LDS_WAIT();
    LAUNDER();
    float T[64];
#pragma unroll
    for (int i = 0; i < 64; ++i) {
        float a0 = (lane == i) ? 1.f : 0.f, a1 = 0.f, a2 = 0.f, a3 = 0.f;
#pragma unroll
        for (int j4 = 0; j4 < (i + 3) / 4; ++j4) { const f32x4 m4 = *(const LAS f32x4*)(SM + i * 64 + 4 * j4);
            if (4 * j4 + 0 < i) a0 = __builtin_fmaf(-m4[0], T[4 * j4 + 0], a0);
            if (4 * j4 + 1 < i) a1 = __builtin_fmaf(-m4[1], T[4 * j4 + 1], a1);
            if (4 * j4 + 2 < i) a2 = __builtin_fmaf(-m4[2], T[4 * j4 + 2], a2);
            if (4 * j4 + 3 < i) a3 = __builtin_fmaf(-m4[3], T[4 * j4 + 3], a3); }
        T[i] = (a0 + a1) + (a2 + a3); if ((i & 3) == 3) SB(); }
    LDS_WAIT();
    LAUNDER();
    { const float b1 = beta, b2 = beta * __expf(gc);
#pragma unroll
      for (int i = 0; i < 64; ++i) { *(LAS unsigned short*)(KR + i * (MP * 2) + lane * 2) = (unsigned short)f2bf(T[i] * b1); *(LAS unsigned short*)(T2 + i * (MP * 2) + lane * 2) = (unsigned short)f2bf(T[i] * b2); if ((i & 7) == 7) SB(); } }
    LDS_WAIT();
    LAUNDER();
    f32x16 u[2][2], w[2][2];
#pragma unroll
    for (int tb = 0; tb < 2; ++tb)
#pragma unroll
        for (int tn = 0; tn < 2; ++tn) { f32x16 au = zero16(), aw = zero16();
#pragma unroll
            for (int ks = 0; ks < 4; ++ks) { au = MFMA32(ldfrag(KR, r32 + 32 * tb, 16 * ks + 8 * hi), ldfrag(VT, r32 + 32 * tn, 16 * ks + 8 * hi), au);
                                             aw = MFMA32(ldfrag(T2, r32 + 32 * tb, 16 * ks + 8 * hi), ldfrag(KT, r32 + 32 * tn, 16 * ks + 8 * hi), aw); }
            u[tb][tn] = au; w[tb][tn] = aw; SB(); }
    LAUNDER();
    { unsigned* ud = (unsigned*)(F.ws + WS_UW + (size_t)inst * 16384); bf16* wd = (bf16*)(F.ws + WS_UW + (size_t)inst * 16384 + 8192);
#pragma unroll
      for (int tb = 0; tb < 2; ++tb)
#pragma unroll
          for (int tn = 0; tn < 2; ++tn) {
#pragma unroll
              for (int rp = 0; rp < 8; ++rp) ud[((tb * 2 + tn) * 8 + rp) * 64 + lane] = pk2(u[tb][tn][2 * rp], u[tb][tn][2 * rp + 1]);
#pragma unroll
              for (int r = 0; r < 16; ++r) wd[(32 * tb + crow(r, hi)) * 64 + r32 + 32 * tn] = (bf16)f2bf(w[tb][tn][r]); SB(); } }
    LAUNDER();
#pragma unroll
    for (int tb = 0; tb < 2; ++tb)
#pragma unroll
        for (int r = 0; r < 16; ++r) { const float e = tab[128 + 32 * tb + crow(r, hi)];
#pragma unroll
            for (int tn = 0; tn < 2; ++tn) { u[tb][tn][r] *= e; w[tb][tn][r] *= e; } }
    SB();
    bf16x8 kf[2][4];
#pragma unroll
    for (int tbb = 0; tbb < 2; ++tbb)
#pragma unroll
        for (int s = 0; s < 4; ++s) kf[tbb][s] = ldfragp(KT, r32 + 32 * tbb, 16 * s + 4 * hi);
    LDS_WAIT(); SB();
    LAUNDER();
    LAS unsigned char* AR = VT; LAS unsigned char* BT = KR;
#pragma unroll
    for (int tbb = 0; tbb < 2; ++tbb)
#pragma unroll
        for (int tx = 0; tx < 2; ++tx) { f32x16 aa = zero16(), ab = zero16();
#pragma unroll
            for (int s = 0; s < 4; ++s) { aa = MFMA32(cfrag(w[s >> 1][tx], s & 1), kf[tbb][s], aa); ab = MFMA32(kf[tbb][s], cfrag(u[s >> 1][tx], s & 1), ab); }
#pragma unroll
            for (int g4 = 0; g4 < 4; ++g4) {
                const v2u pa = {pk2(-aa[4 * g4], -aa[4 * g4 + 1]), pk2(-aa[4 * g4 + 2], -aa[4 * g4 + 3])};
                *(LAS v2u*)(AR + (r32 + 32 * tbb) * (MP * 2) + (32 * tx + 8 * g4 + 4 * hi) * 2) = pa;
                const v2u pb = {pk2(ab[4 * g4], ab[4 * g4 + 1]), pk2(ab[4 * g4 + 2], ab[4 * g4 + 3])};
                *(LAS v2u*)(BT + (r32 + 32 * tx) * (MP * 2) + (32 * tbb + 8 * g4 + 4 * hi) * 2) = pb;
            } SB(); }
    LDS_WAIT();
    LAUNDER();
    { unsigned char* ab = F.ws + WS_AB + (size_t)inst * 16384; const int m16 = lane & 15, g = lane >> 4;
#pragma unroll
      for (int rb = 0; rb < 4; ++rb)
#pragma unroll
          for (int ks = 0; ks < 2; ++ks) { const v2u lo = *(const LAS v2u*)(AR + (16 * rb + m16) * (MP * 2) + (32 * ks + 4 * g) * 2), hi8 = *(const LAS v2u*)(AR + (16 * rb + m16) * (MP * 2) + (32 * ks + 16 + 4 * g) * 2);
              const v4u t = {lo.x, lo.y, hi8.x, hi8.y}; *(GAS v4u*)(ab + ((rb * 2 + ks) * 64 + lane) * 16) = t; }
#pragma unroll
      for (int sl = 0; sl < 4; ++sl)
#pragma unroll
          for (int rb = 0; rb < 4; ++rb) { const v2u t = *(const LAS v2u*)(BT + (16 * sl + m16) * (MP * 2) + (16 * rb + 4 * g) * 2); *(GAS v2u*)(ab + 8192 + ((sl * 4 + rb) * 64 + lane) * 8) = t; } }
    if (lane == 0) ((float*)(F.ws + WS_DEC))[inst] = __expf(gl);
    LDS_WAIT();
}
__device__ __forceinline__ void pc_side_tasks(Frame& F, const int layer, const int half) {
    if (F.wave == 4) {
        LAS unsigned char* mimg = F.lds + RING_OFF + 4 * WAVE_LDS + 4096;
        for (int tile = F.vcu + half * F.G; tile < NTOK / 64; tile += 2 * F.G)
            for (int g = 0; g < 4; ++g) pc::pool_task(F, layer, tile, g, mimg);
    } else if (F.wave > 4) {
        int k = 0;
        for (int tile = F.vcu + half * F.G; tile < NTOK / 64; tile += 2 * F.G)
            for (int cg = 0; cg < 4; ++cg, ++k) if (k % 3 == F.wave - 5) pc::conv_task(F, layer, tile, cg);
    }
}
__device__ __forceinline__ void d1_phase(Frame& F, const int layer) {
    if (F.wave < 4) {
        LAS unsigned char* W = F.lds + RING_OFF + F.wave * WAVE_LDS; LAS float* tab = (LAS float*)(F.lds + RING_OFF + 4 * WAVE_LDS + F.wave * 1024);
        const int gw = F.vcu * 4 + F.wave, NGW = F.G * 4;
        for (int it = gw; it < NINST; it += NGW) { const int dir = it & 1, u = it >> 1; d1_instance(F, layer, u >> 10, (u >> 8) & 3, u & 255, dir, W, tab); }
    } else pc_side_tasks(F, layer, 0);
    __syncthreads();
}

typedef float f32x4v __attribute__((ext_vector_type(4)));
struct D2Regs { v4u af[4][2]; v2u bm[4]; float dcy; };
__device__ __forceinline__ void d2_chain(Frame& F, const int chain) {
    const int lane = F.lane, n16 = lane & 15, g = lane >> 4, sl = F.wave;
    f32x4v S[4];
#pragma unroll
    for (int rb = 0; rb < 4; ++rb) S[rb] = (f32x4v){0.f, 0.f, 0.f, 0.f};
    const unsigned char* abase = F.ws + WS_AB + (size_t)chain * NCHUNK * 16384;
    unsigned char* sbase = F.ws + WS_ST + (size_t)chain * NCHUNK * 8192;
    const float* dec = (const float*)(F.ws + WS_DEC) + chain * NCHUNK;
    D2Regs q0, q1, q2;
#define D2_LOAD(Q, n) do { const unsigned char* ab_ = abase + (size_t)(n) * 16384; \
    _Pragma("unroll") for (int rb = 0; rb < 4; ++rb) { _Pragma("unroll") for (int ks = 0; ks < 2; ++ks) Q.af[rb][ks] = *(const GAS v4u*)(ab_ + ((rb * 2 + ks) * 64 + lane) * 16); \
        Q.bm[rb] = *(const GAS v2u*)(ab_ + 8192 + ((sl * 4 + rb) * 64 + lane) * 8); } Q.dcy = dec[n]; } while (0)
#define D2_STEP(Q, n) do { \
    unsigned char* st = sbase + (size_t)(n) * 8192 + (16 * sl + n16) * 128; \
    _Pragma("unroll") for (int rb = 0; rb < 4; ++rb) { const v2u t = {pk2(S[rb][0], S[rb][1]), pk2(S[rb][2], S[rb][3])}; *(GAS v2u*)(st + (16 * rb + 4 * g) * 2) = t; } \
    bf16x8 bfr[2]; \
    _Pragma("unroll") for (int ks = 0; ks < 2; ++ks) { const v4u t = {att::cvtpk(S[2 * ks][0], S[2 * ks][1]), att::cvtpk(S[2 * ks][2], S[2 * ks][3]), att::cvtpk(S[2 * ks + 1][0], S[2 * ks + 1][1]), att::cvtpk(S[2 * ks + 1][2], S[2 * ks + 1][3])}; bfr[ks] = __builtin_bit_cast(bf16x8, t); } \
    _Pragma("unroll") for (int rb = 0; rb < 4; ++rb) { const float cd = Q.dcy; \
        f32x4v c = {S[rb][0] * cd + bflo(Q.bm[rb].x), S[rb][1] * cd + bfhi(Q.bm[rb].x), S[rb][2] * cd + bflo(Q.bm[rb].y), S[rb][3] * cd + bfhi(Q.bm[rb].y)}; \
        c = __builtin_amdgcn_mfma_f32_16x16x32_bf16(__builtin_bit_cast(bf16x8, Q.af[rb][0]), bfr[0], c, 0, 0, 0); \
        c = __builtin_amdgcn_mfma_f32_16x16x32_bf16(__builtin_bit_cast(bf16x8, Q.af[rb][1]), bfr[1], c, 0, 0, 0); \
        S[rb] = c; } } while (0)
    D2_LOAD(q0, 0); D2_LOAD(q1, 1);
    for (int n = 0; n < NCHUNK - 1; n += 3) {
        D2_LOAD(q2, n + 2); D2_STEP(q0, n); SB();
        D2_LOAD(q0, n + 3); D2_STEP(q1, n + 1); SB();
        if (n + 4 < NCHUNK) D2_LOAD(q1, n + 4); D2_STEP(q2, n + 2); SB();
    }
    D2_STEP(q0, NCHUNK - 1);
#undef D2_LOAD
#undef D2_STEP
}

__device__ __forceinline__ void scan_attn_phase(Frame& F, const int layer, const int qword) {
    for (;;) {
        { unsigned char* w_ = F.ws; int t_ = F.tid; asm volatile("" : "+s"(w_), "+v"(t_)); F.ws = w_; F.ctl = (gu32*)(w_ + WS_CTL); F.tid = t_; F.lane = t_ & 63; }
        if (F.tid == 0) F.MISC[16] = __hip_atomic_fetch_add(F.ctl + CW_ATTQ + 64 * qword, 1u, RLX_AGENT);
        __syncthreads();
        const int idx = (int)F.MISC[16];
        __syncthreads();
        if (idx >= 16 + BATCH * 4 * 64) break;
        if (idx < 16) { if (F.wave < 4) d2_chain(F, idx); }
        else { const int j = idx - 16, h = 3 - (j >> 7), jj = j & 127, b = jj & 1, k = jj >> 1, qb = (k & 1) ? 31 - (k >> 1) : 32 + (k >> 1);
            att::attn_unit(F, layer, b, h, qb); }
    }
    __syncthreads();
}

__device__ __forceinline__ void d3_unit(Frame& F, const int layer, const int b, const int h, const int norig, LAS unsigned char* W, LAS float* tab) {
    int lane = F.lane, r32, hi; LAUNDER();
    const bf16* P = (const bf16*)(F.ws + WS_PROJ);
    const float* cwp = F.in[I_DCONVW] + (size_t)layer * 5 * 768;
    const int s0 = norig * 64, tok0 = b * SEQ + s0;
    LAS unsigned char* QR = W;
    LAS unsigned char* KR = W + MB;
    LAS unsigned char* AT = W + 2 * MB;
    LAS unsigned char* WR = W + 3 * MB;
    { float cval[64];
      DL_CONV(C_DQ + 64 * h, 64 * h, WR);
      DL_NORM(AT, 0.125f);
#pragma unroll
      for (int i = 0; i < 64; ++i) *(LAS unsigned short*)(QR + i * (MP * 2) + lane * 2) = (unsigned short)f2bf(cval[i]);
      LDS_WAIT();
      DL_CONV(C_DK + 64 * h, 256 + 64 * h, WR);
      DL_NORM(AT, 1.f);
#pragma unroll
      for (int i = 0; i < 64; ++i) *(LAS unsigned short*)(KR + i * (MP * 2) + lane * 2) = (unsigned short)f2bf(cval[i]);
      LDS_WAIT(); }
    f32x16 of[2][2];
#pragma unroll
    for (int dir = 0; dir < 2; ++dir) {
        LAUNDER();
        const int npr = dir ? 255 - norig : norig;
        const int inst = ((b * 4 + h) * 2 + dir) * NCHUNK + npr;
        const int mytok = tok0 + (dir ? 63 - lane : lane);
        float gc = ((const float*)(F.ws + WS_BD))[(size_t)mytok * 16 + 8 + dir * 4 + h];
#pragma unroll
        for (int o = 1; o < 64; o <<= 1) { const float t = __shfl_up(gc, o); if (lane >= o) gc += t; }
        tab[lane] = gc; tab[64 + lane] = __expf(gc);
        { const unsigned char* wg = F.ws + WS_UW + (size_t)inst * 16384 + 8192;
#pragma unroll
          for (int i = 0; i < 8; ++i) { const int idx = i * 64 + lane, row = idx >> 3, ch = idx & 7; const v4u c = *(const GAS v4u*)(wg + idx * 16); *(LAS v4u*)(WR + row * (MP * 2) + ch * 16) = c; } }
        LDS_WAIT();
        LAUNDER();
        const int ra0 = dir ? 63 - r32 : r32, ra1 = dir ? 31 - r32 : 32 + r32;
        f32x16 qk[2][2];
#pragma unroll
        for (int tb = 0; tb < 2; ++tb)
#pragma unroll
            for (int tn = 0; tn < 2; ++tn) { f32x16 acc = zero16();
#pragma unroll
                for (int ks = 0; ks < 4; ++ks) acc = MFMA32(ldfrag(QR, tb ? ra1 : ra0, 16 * ks + 8 * hi), ldfrag(KR, tn ? ra1 : ra0, 16 * ks + 8 * hi), acc);
                qk[tb][tn] = acc; SB(); }
        LDS_WAIT();
#pragma unroll
        for (int tb = 0; tb < 2; ++tb)
#pragma unroll
            for (int tn = 0; tn < 2; ++tn) { const int jc = r32 + 32 * tn; const float gcj = tab[jc];
#pragma unroll
                for (int r = 0; r < 16; ++r) { const int ir = 32 * tb + crow(r, hi); const float gci = tab[ir];
                    const float av = (ir >= jc) ? qk[tb][tn][r] * __expf(gci - gcj) : 0.f; *(LAS unsigned short*)(AT + ir * (MP * 2) + jc * 2) = (unsigned short)f2bf(av); } SB(); }
        LDS_WAIT();
        LAUNDER();
        const unsigned* ud = (const unsigned*)(F.ws + WS_UW + (size_t)inst * 16384);
        const unsigned char* sg = F.ws + WS_ST + (size_t)inst * 8192;
#pragma unroll
        for (int tn = 0; tn < 2; ++tn) {
            bf16x8 sf[4];
#pragma unroll
            for (int ks = 0; ks < 4; ++ks) sf[ks] = *(const GAS bf16x8*)(sg + ((r32 + 32 * tn) * 64 + 16 * ks + 8 * hi) * 2);
            f32x16 vn[2], o[2];
#pragma unroll
            for (int tb = 0; tb < 2; ++tb) { f32x16 a1 = zero16(), a2 = zero16();
#pragma unroll
                for (int ks = 0; ks < 4; ++ks) { a1 = MFMA32(ldfrag(WR, r32 + 32 * tb, 16 * ks + 8 * hi), sf[ks], a1); a2 = MFMA32(ldfrag(QR, tb ? ra1 : ra0, 16 * ks + 8 * hi), sf[ks], a2); }
#pragma unroll
                for (int rp = 0; rp < 8; ++rp) { const unsigned uw = ud[((tb * 2 + tn) * 8 + rp) * 64 + lane]; a1[2 * rp] = bflo(uw) - a1[2 * rp]; a1[2 * rp + 1] = bfhi(uw) - a1[2 * rp + 1]; }
#pragma unroll
                for (int r = 0; r < 16; ++r) a2[r] *= tab[64 + 32 * tb + crow(r, hi)];
                vn[tb] = a1; o[tb] = a2; SB(); }
#pragma unroll
            for (int tb = 0; tb < 2; ++tb) { f32x16 acc = o[tb];
#pragma unroll
                for (int s = 0; s < 4; ++s) acc = MFMA32(ldfragp(AT, r32 + 32 * tb, 16 * s + 4 * hi), cfrag(vn[s >> 1], s & 1), acc);
                o[tb] = acc; SB(); }
            if (dir == 0) { of[0][tn] = o[0]; of[1][tn] = o[1]; }
            else {
#pragma unroll
                for (int tb = 0; tb < 2; ++tb)
#pragma unroll
                    for (int r = 0; r < 16; ++r) of[tb][tn][r] += __shfl_xor(o[1 - tb][15 - r], 32);
            }
        }
        LDS_WAIT();
    }
    const float* dn = F.in[I_DNORM] + layer * 64;
#pragma unroll
    for (int tb = 0; tb < 2; ++tb)
#pragma unroll
        for (int r = 0; r < 16; ++r) {
            float ss = of[tb][0][r] * of[tb][0][r] + of[tb][1][r] * of[tb][1][r];
#pragma unroll
            for (int o = 1; o < 32; o <<= 1) ss += __shfl_xor(ss, o);
            const float rs = 1.f / sqrtf(ss * (1.f / 64.f) + EPS);
            const int tok = tok0 + 32 * tb + crow(r, hi);
#pragma unroll
            for (int tn = 0; tn < 2; ++tn) { const int dv = r32 + 32 * tn; const float z = bf2f(P[(size_t)tok * PJ + C_DZ + 64 * h + dv]);
                ((bf16*)(F.ws + WS_O4))[(size_t)tok * 1024 + 768 + 64 * h + dv] = (bf16)f2bf(of[tb][tn][r] * rs * dn[dv] * siluf_(z)); }
        }
}
__device__ __forceinline__ void d3_phase(Frame& F, const int layer) {
    if (F.wave < 4) {
        LAS unsigned char* W = F.lds + RING_OFF + F.wave * WAVE_LDS; LAS float* tab = (LAS float*)(F.lds + RING_OFF + 4 * WAVE_LDS + F.wave * 1024);
        const int gw = F.vcu * 4 + F.wave, NGW = F.G * 4;
        for (int u = gw; u < BATCH * 4 * NCHUNK; u += NGW) d3_unit(F, layer, u >> 10, (u >> 8) & 3, u & 255, W, tab);
    } else pc_side_tasks(F, layer, 1);
    __syncthreads();
}
#undef MFMA32
}

#ifndef ONLY_SITE
#define ONLY_SITE -1
#endif
#define SITE(k) (ONLY_SITE < 0 || ONLY_SITE == (k))
#ifndef PROBE_MASK
#define PROBE_MASK 0
#endif
#ifndef PROBE_N
#define PROBE_N 2
#endif
#define REPEAT(k) for (int rep_ = 0; rep_ < (((PROBE_MASK >> (k)) & 1) ? PROBE_N : 1); ++rep_)
#ifndef MK_SPLIT
#define MK_SPLIT 0
#endif
struct Args { const float* in[30]; float* out; unsigned char* ws; int ph_lo, ph_hi; };
constexpr int N_PHASES = 1 + 16 * NLAYER + 1;

#define IN_PH() (pid >= lo && pid < hi)
#define FRESH() do { unsigned char* w_ = args.ws; float* o_ = args.out; int t_ = F.wave * 64 + (int)__builtin_amdgcn_mbcnt_hi(~0u, __builtin_amdgcn_mbcnt_lo(~0u, 0u)); asm volatile("" : "+s"(w_), "+s"(o_), "+v"(t_)); F.ws = w_; F.out = o_; F.ctl = (gu32*)(w_ + WS_CTL); F.tid = t_; F.lane = t_ & 63; } while (0)
#define SEAM() do { if (!MK_SPLIT && pid >= lo && pid + 1 < hi) xcd_barrier(bar); ++pid; } while (0)
#define NOSEAM() do { ++pid; } while (0)

template <int l> __device__ __forceinline__ void layer_phases(Frame& F, const Args& args, const XcdBarrier& bar, const int lo, const int hi, int& pid) {
    LAS unsigned char* ring = F.lds + RING_OFF;

        if constexpr (l == 0) { if (IN_PH() && SITE(1)) REPEAT(1) { FRESH(); p_rows<ROW_A>(F, 0); } SEAM(); } else { NOSEAM(); }
        if (IN_PH() && SITE(2)) REPEAT(2) { FRESH();
            pg8::SchedStd S; S.init(NTOK / 256, NPROJ / 256, F.G, (int)blockIdx.x, F.ws + WS_H, (size_t)256 * D * 2, w_in_t(F.ws, l), (size_t)256 * D * 2);
            pg8::EpiProj E{(bf16*)(F.ws + WS_QB), (bf16*)(F.ws + WS_KV), (bf16*)(F.ws + WS_PROJ), (unsigned*)(F.ctl + CW_NMAX) + l * 16, QSCALE};
            pg8::gemm_phase<pg8::EpiProj, pg8::SchedStd, D, D, D>(ring, F.tid, S, E);
        }
        SEAM();
        NOSEAM();
        if (IN_PH() && SITE(5)) REPEAT(5) { FRESH(); dl::d1_phase(F, l); }
        SEAM();
        if (IN_PH() && SITE(3)) REPEAT(3) { FRESH(); dl::scan_attn_phase(F, l, l * 2 + rep_); }
        SEAM();
        NOSEAM();
        if (IN_PH() && SITE(7)) REPEAT(7) { FRESH(); dl::d3_phase(F, l); }
        SEAM();
        NOSEAM();
        if (IN_PH() && SITE(9)) REPEAT(9) { FRESH();
            pg8::SchedGateP S{F.vcu, F.G, (const char*)F.ws, WS_H, WS_W + (size_t)l * SZ_LAYERW + SZ_WIN, WS_O4, WS_W + (size_t)l * SZ_LAYERW + SZ_WIN + SZ_WM};
            pg8::EpiGateP E{(bf16*)(F.ws + WS_PBUF) + (size_t)blockIdx.x * 65536, (bf16*)(F.ws + WS_MERGED), F.in[I_BMERGE] + (size_t)l * 4 * D, F.tid};
            pg8::gemm_phase<pg8::EpiGateP, pg8::SchedGateP, D, D, D>(ring, F.tid, S, E);
        }
        SEAM();
        if (IN_PH() && SITE(10)) REPEAT(10) { FRESH();
            pg8::SchedStd S; S.init(NTOK / 256, D / 256, F.G, (int)blockIdx.x, F.ws + WS_MERGED, (size_t)256 * D * 2, w_o_t(F.ws, l), (size_t)256 * D * 2);
            pg8::EpiStore E{(bf16*)(F.ws + WS_F), D, 0, 1.f};
            pg8::gemm_phase<pg8::EpiStore, pg8::SchedStd, D, D, D>(ring, F.tid, S, E);
        }
        SEAM();
        if (IN_PH() && SITE(11)) REPEAT(11) { FRESH(); p_rows<ROW_B>(F, l); }
        SEAM();
        if constexpr (l == 0) {
            if (IN_PH() && SITE(12)) REPEAT(12) { FRESH();
                pg8::SchedStd S; S.init(NTOK / 256, 2 * DFF / 256, F.G, (int)blockIdx.x, F.ws + WS_H, (size_t)256 * D * 2, F.ws + WS_WFFN, (size_t)256 * D * 2);
                pg8::EpiSwiGLU<false> E{(bf16*)(F.ws + WS_ACT0), DFF};
                pg8::gemm_phase<pg8::EpiSwiGLU<false>, pg8::SchedStd, D, D, D>(ring, F.tid, S, E);
            }
            SEAM();
            if (IN_PH() && SITE(13)) REPEAT(13) { FRESH();
                pg8::SchedStd S; S.init(NTOK / 256, D / 256, F.G, (int)blockIdx.x, F.ws + WS_ACT0, (size_t)256 * DFF * 2, F.ws + WS_WFFN + SZ_WGU, (size_t)256 * DFF * 2);
                pg8::EpiStore E{(bf16*)(F.ws + WS_F), D, 0, 1.f};
                pg8::gemm_phase<pg8::EpiStore, pg8::SchedStd, DFF, DFF, DFF>(ring, F.tid, S, E);
            }
            SEAM();
            if (IN_PH() && SITE(14)) REPEAT(14) { FRESH(); p_rows<ROW_C>(F, 0); }
            SEAM();
            NOSEAM(); NOSEAM();
        } else {
            if (IN_PH() && SITE(15)) REPEAT(15) { FRESH(); p_moe_cvt(F); }
            SEAM();
#pragma unroll 1
            for (int pass = 0; pass < MOE_NPASS; ++pass) {
                if (IN_PH() && SITE(16)) REPEAT(16) { FRESH();
                    constexpr int EB = MOE_FP8 ? 1 : 2;
                    pg8::SchedMoe S; S.c = (int)blockIdx.x; S.G = F.G; S.nN = 2 * DFF / 256; moe_tiles(F, S.cnt, S.tstart);
                    S.t0 = pass * MOE_PASS_TILES; S.t1 = S.tstart[8] < (pass + 1) * MOE_PASS_TILES ? S.tstart[8] : (pass + 1) * MOE_PASS_TILES;
                    S.lists = (const int*)(F.ws + WS_ROUTE + 1 * MiB); S.W = (const char*)(F.ws + WS_MOEW); S.w_tile = (size_t)256 * D * EB; S.exp_stride = SZ_FFNW / 2 * EB;
#if MOE_FP8
                    S.A = (const char*)(F.ws + WS_XG); S.gather = false; S.act_tile = (size_t)256 * D;
                    pg8::EpiSwiGLU<true> E{(bf16*)(F.ws + WS_ACT1), DFF};
                    pg8::gemm_phase<pg8::EpiSwiGLU<true>, pg8::SchedMoe, D / 2, D / 2, D / 2, false, true>(ring, F.tid, S, E);
#else
                    S.A = (const char*)(F.ws + WS_H2B); S.gather = true; S.act_tile = 0;
                    pg8::EpiSwiGLU<false> E{(bf16*)(F.ws + WS_ACT1), DFF};
                    pg8::gemm_phase<pg8::EpiSwiGLU<false>, pg8::SchedMoe, D, D, D, true, false>(ring, F.tid, S, E);
#endif
                }
                SEAM();
                if (IN_PH() && SITE(17)) REPEAT(17) { FRESH();
                    constexpr int EB = MOE_FP8 ? 1 : 2;
                    pg8::SchedMoe S; S.c = (int)blockIdx.x; S.G = F.G; S.nN = D / 256; moe_tiles(F, S.cnt, S.tstart);
                    S.t0 = pass * MOE_PASS_TILES; S.t1 = S.tstart[8] < (pass + 1) * MOE_PASS_TILES ? S.tstart[8] : (pass + 1) * MOE_PASS_TILES;
                    S.A = (const char*)(F.ws + WS_ACT1); S.lists = nullptr; S.W = (const char*)(F.ws + WS_MOEW + SZ_WGU / 2 * EB); S.w_tile = (size_t)256 * DFF * EB; S.gather = false;
                    S.exp_stride = SZ_FFNW / 2 * EB; S.act_tile = (size_t)256 * DFF * EB;
#if MOE_FP8
                    pg8::EpiStore64 E{(bf16*)(F.ws + WS_Y)};
                    pg8::gemm_phase<pg8::EpiStore64, pg8::SchedMoe, DFF * EB / 2, DFF * EB / 2, DFF * EB / 2, false, true>(ring, F.tid, S, E);
#else
                    pg8::EpiStore E{(bf16*)(F.ws + WS_Y), D, 0, 1.f};
                    pg8::gemm_phase<pg8::EpiStore, pg8::SchedMoe, DFF * EB / 2, DFF * EB / 2, DFF * EB / 2, false, false>(ring, F.tid, S, E);
#endif
                }
                SEAM();
            }
            if constexpr (MOE_NPASS == 1) { NOSEAM(); NOSEAM(); }
        }
    }

__global__ void __launch_bounds__(NWAVES * 64, 2) fwd_kernel(const Args args) {
    extern __shared__ __attribute__((aligned(16))) unsigned char lds[];
    Frame F;
    F.lds = (LAS unsigned char*)lds;
    F.MISC = (volatile LAS unsigned*)(F.lds + MISC_OFF);
    F.tid = threadIdx.x; F.lane = F.tid & 63; F.wave = __builtin_amdgcn_readfirstlane(F.tid >> 6);
    F.G = gridDim.x; { const int bx = blockIdx.x; F.vcu = (F.G % 8 == 0) ? (bx % 8) * (F.G / 8) + bx / 8 : bx; }
    F.ws = args.ws; F.out = args.out; F.ctl = (gu32*)(args.ws + WS_CTL);
    F.in = args.in;
    if (F.tid < 64) ((LAS unsigned*)(F.lds + MISC_OFF))[F.tid] = 0u;
    __syncthreads();
    XcdBarrier bar; bar.bar = (unsigned*)(F.ctl + CW_BAR); bar.x = 0; bar.st = nullptr;
    if (!MK_SPLIT) bar = xcd_barrier_post((unsigned*)(F.ctl + CW_BAR), F.MISC + 8);
    const int lo = args.ph_lo, hi = args.ph_hi;
    int pid = 0;
    LAS unsigned char* ring = F.lds + RING_OFF;

    if (IN_PH() && SITE(0)) REPEAT(0) { FRESH(); p_prologue(F); }
    SEAM();
    layer_phases<0>(F, args, bar, lo, hi, pid);
    layer_phases<1>(F, args, bar, lo, hi, pid);
    if (IN_PH() && SITE(18)) REPEAT(18) { FRESH(); p_rows<ROW_C>(F, 1); }
#undef IN_PH
#undef SEAM
#undef NOSEAM
}

extern "C" void kernel_launch(void* const* d_in, const int* in_sizes, int n_in, void* d_out, int out_size, void* d_ws, size_t ws_size, hipStream_t stream) {
    static int grid = 0;
    if (grid == 0) {
        if (n_in != N_INPUTS || in_sizes[0] != NTOK * D || out_size != NTOK * D || ws_size < WS_END) {
            fprintf(stderr, "kernel_launch: unexpected problem (n_in %d, in0 %d, out %d, ws %zu < %zu); nothing launched\n", n_in, n_in > 0 ? in_sizes[0] : -1, out_size, ws_size, (size_t)WS_END); grid = -1; return; }
        int dev = 0, cus = 0, per_cu = 0;
        if (hipGetDevice(&dev) != hipSuccess || hipDeviceGetAttribute(&cus, hipDeviceAttributeMultiprocessorCount, dev) != hipSuccess) { grid = -1; return; }
        if (hipFuncSetAttribute((const void*)fwd_kernel, hipFuncAttributeMaxDynamicSharedMemorySize, LDS_BYTES) != hipSuccess) { fprintf(stderr, "kernel_launch: hipFuncSetAttribute failed\n"); grid = -1; return; }
        if (hipOccupancyMaxActiveBlocksPerMultiprocessor(&per_cu, (const void*)fwd_kernel, NWAVES * 64, LDS_BYTES) != hipSuccess || per_cu < 1)
            fprintf(stderr, "kernel_launch: note: occupancy query reports %d workgroups per CU\n", per_cu);
        (void)hipGetLastError();
        grid = cus;
    }
    if (grid < 0) return;
    if (hipMemsetAsync((char*)d_ws + WS_CTL, 0, CTL_ZERO_BYTES, stream) != hipSuccess) return;
    Args a{};
    for (int i = 0; i < 30; ++i) a.in[i] = (const float*)d_in[i];
    a.out = (float*)d_out; a.ws = (unsigned char*)d_ws;
#if MK_SPLIT
    for (int p = 0; p < N_PHASES; ++p) { a.ph_lo = p; a.ph_hi = p + 1; hipLaunchKernelGGL(fwd_kernel, dim3(grid), dim3(NWAVES * 64), LDS_BYTES, stream, a); }
#else
    a.ph_lo = 0; a.ph_hi = N_PHASES;
    hipLaunchKernelGGL(fwd_kernel, dim3(grid), dim3(NWAVES * 64), LDS_BYTES, stream, a);
#endif
}
```

```cpp
#include <hip/hip_runtime.h>
#include <cstdio>
#include <cstdint>

namespace pg8 {
#define PG8_LAS __attribute__((address_space(3)))
typedef unsigned short bf16_t;
typedef short bf16x8 __attribute__((ext_vector_type(8)));
typedef float f32x4 __attribute__((ext_vector_type(4)));
typedef unsigned u32x4 __attribute__((ext_vector_type(4)));
typedef unsigned u32x2 __attribute__((ext_vector_type(2)));
typedef int i32x4 __attribute__((ext_vector_type(4)));
constexpr int BM = 256, BK = 64, HALF = 128, HTB = HALF * BK * 2  , STAGE_BYTES = 8 * HTB;

__host__ __device__ __forceinline__ int lds_byte(int r, int c) { const int st = (r >> 4) * 2 + (c >> 5), rr = r & 15, cc = c & 31, ob = rr * 64 + cc * 2; return st * 1024 + (ob ^ (((ob >> 9) & 1) << 5)); }
__host__ __device__ __forceinline__ void stage_rc(int b, int& R, int& C) { const int st = b / 1024, sb = b % 1024, swz = sb ^ (((sb >> 9) & 1) << 5); R = (st >> 1) * 16 + swz / 64; C = (st & 1) * 32 + (swz % 64) / 2; }
__host__ __device__ __forceinline__ int perm32(int rho) { const int n = rho >> 4, i = rho & 15; return 8 * (i >> 2) + 4 * n + (i & 3); }

struct Unit { int pm, pn, aux, nt; const char* a; const char* b; const int* rows; };

__device__ __forceinline__ unsigned cvt_pk_bf16(float lo, float hi) { unsigned r; asm volatile("v_cvt_pk_bf16_f32 %0, %1, %2" : "=v"(r) : "v"(lo), "v"(hi)); return r; }


__device__ __forceinline__ const char* uniform_ptr(const char* p) { const unsigned long long v = (unsigned long long)p; return (const char*)(((unsigned long long)(unsigned)__builtin_amdgcn_readfirstlane((int)(v >> 32)) << 32) | (unsigned)__builtin_amdgcn_readfirstlane((int)(unsigned)v)); }
template <class Epi, class Sched, int K, int lda, int ldb, bool GATHER = false, bool FP8 = false, bool ALIGN_EPI = true, bool SP2 = true>
__device__ __forceinline__ void gemm_phase(PG8_LAS unsigned char* lds, const int tid, const Sched& S, const Epi& E) {
    const int wid = __builtin_amdgcn_readfirstlane(tid >> 6), lane = tid & 63, wr = wid >> 2, wc = wid & 3, fr = lane & 15, fq = lane >> 4;
    constexpr int ntK = K / BK;
    int Rs[2], Cs[2]; unsigned voffB[2];
#pragma unroll
    for (int i = 0; i < 2; ++i) { int R, C; stage_rc(tid * 16 + i * 8192, R, C); const int Rb = Epi::PERM ? ((R & ~31) + perm32(R & 31)) : R; Rs[i] = R; Cs[i] = C; voffB[i] = (unsigned)(Rb * ldb + C) * 2u; }
    const size_t kstep = (size_t)(BK * 2);
    const size_t hstepB = (size_t)HALF * ldb * 2;
    constexpr unsigned hstepA = GATHER ? 0u : (unsigned)HALF * lda * 2u;
    const unsigned ldsw = (unsigned)wid * 1024u;
    const int aoff = lds_byte(wr * 64 + fr, fq * 8), boff = lds_byte(wc * 32 + fr, fq * 8);
#define PG8_SA(b, h) (((b) * 2 + (h)) * HTB)
#define PG8_SB(b, h) ((4 + (b) * 2 + (h)) * HTB)
#define PG8_RSRC(p) __builtin_amdgcn_make_buffer_rsrc((void*)pg8::uniform_ptr((const char*)(p)), 0, 0x7fffffff, 0x00020000)
#define PG8_STAGE(bufoff, gbase, soff, voff) do { const __amdgpu_buffer_rsrc_t r_ = PG8_RSRC(gbase); _Pragma("unroll") for (int _i = 0; _i < 2; ++_i) \
        __builtin_amdgcn_raw_ptr_buffer_load_lds(r_, (PG8_LAS unsigned*)(lds + (bufoff) + ldsw + _i * 8192), 16, (voff)[_i], (int)(soff), 0, 0); } while (0)
#define PG8_LDA(dst, b, h) do { _Pragma("unroll") for (int m = 0; m < 4; ++m) _Pragma("unroll") for (int k = 0; k < 2; ++k) dst[m][k] = *(const PG8_LAS bf16x8*)(lds + PG8_SA(b, h) + aoff + m * 2048 + k * 1024); } while (0)
#define PG8_LDB(dst, b, h) do { _Pragma("unroll") for (int n = 0; n < 2; ++n) _Pragma("unroll") for (int k = 0; k < 2; ++k) dst[n][k] = *(const PG8_LAS bf16x8*)(lds + PG8_SB(b, h) + boff + n * 2048 + k * 1024); } while (0)
#define PG8_CAT(x0, x1) __builtin_shufflevector(__builtin_bit_cast(i32x4, (x0)), __builtin_bit_cast(i32x4, (x1)), 0, 1, 2, 3, 4, 5, 6, 7)
#define PG8_MMA(ai, bj, At, Bt) do { __builtin_amdgcn_s_setprio(1); _Pragma("unroll") for (int m = 0; m < 4; ++m) _Pragma("unroll") for (int n = 0; n < 2; ++n) { \
        if constexpr (FP8) acc[ai][bj][m][n] = __builtin_amdgcn_mfma_scale_f32_16x16x128_f8f6f4(PG8_CAT(Bt[n][0], Bt[n][1]), PG8_CAT(At[m][0], At[m][1]), acc[ai][bj][m][n], 0, 0, 0, 0x7f7f7f7f, 0, 0x7f7f7f7f); \
        else { _Pragma("unroll") for (int k = 0; k < 2; ++k) acc[ai][bj][m][n] = __builtin_amdgcn_mfma_f32_16x16x32_bf16(Bt[n][k], At[m][k], acc[ai][bj][m][n], 0, 0, 0); } } __builtin_amdgcn_s_setprio(0); } while (0)
#define PG8_WAIT_V(n) asm volatile("s_waitcnt vmcnt(" #n ")" ::: "memory")
#define PG8_WAIT_L(n) asm volatile("s_waitcnt lgkmcnt(" #n ")" ::: "memory")
#define PG8_BAR __builtin_amdgcn_s_barrier()
#define PG8_SCHED __builtin_amdgcn_sched_barrier(0)
    Unit cur, nxt; int ui = 0;
    if (!S.next(0, cur)) return;
    f32x4 acc[2][2][4][2];
#pragma unroll
    for (int a = 0; a < 2; ++a)
#pragma unroll
        for (int b = 0; b < 2; ++b)
#pragma unroll
            for (int m = 0; m < 4; ++m)
#pragma unroll
                for (int n = 0; n < 2; ++n) acc[a][b][m][n] = (f32x4){0.f, 0.f, 0.f, 0.f};
    bf16x8 At[4][2], B0[2][2], B1[2][2];
    unsigned cOff[2][2], nOff[2][2];
#pragma unroll
    for (int hh = 0; hh < 2; ++hh)
#pragma unroll
        for (int i = 0; i < 2; ++i) {
            if constexpr (GATHER) { const int ridx = hh * HALF + Rs[i]; int tk = cur.rows[ridx]; tk = ridx < cur.aux ? tk : 0; cOff[hh][i] = (unsigned)(tk * lda + Cs[i]) * 2u; }
            else cOff[hh][i] = (unsigned)(Rs[i] * lda + Cs[i]) * 2u;
            if constexpr (GATHER) nOff[hh][i] = cOff[hh][i]; else nOff[hh][i] = 0u;
        }
    const char* cA = cur.a; const char* cB = cur.b;
    S.a_ready(cur);
    if constexpr (SP2) {
        PG8_STAGE(PG8_SB(0, 0), cB, 0, voffB); PG8_STAGE(PG8_SB(0, 1), cB, hstepB, voffB); PG8_STAGE(PG8_SA(0, 0), cA, 0, cOff[0]); PG8_STAGE(PG8_SA(0, 1), cA, hstepA, cOff[GATHER ? 1 : 0]);
        if (wr == 1) PG8_BAR;
        PG8_WAIT_V(2); PG8_BAR;
        PG8_STAGE(PG8_SB(1, 0), cB, kstep, voffB); PG8_STAGE(PG8_SA(1, 0), cA, kstep, cOff[0]); PG8_STAGE(PG8_SB(1, 1), cB, hstepB + kstep, voffB);
        PG8_WAIT_V(6); PG8_BAR;
    } else {
        PG8_STAGE(PG8_SB(0, 0), cB, 0, voffB); PG8_STAGE(PG8_SA(0, 0), cA, 0, cOff[0]); PG8_STAGE(PG8_SB(0, 1), cB, hstepB, voffB); PG8_STAGE(PG8_SA(0, 1), cA, hstepA, cOff[GATHER ? 1 : 0]);
        if (wr == 1) PG8_BAR;
        PG8_WAIT_V(4); PG8_BAR;
        PG8_STAGE(PG8_SB(1, 0), cB, kstep, voffB); PG8_STAGE(PG8_SA(1, 0), cA, kstep, cOff[0]); PG8_STAGE(PG8_SB(1, 1), cB, hstepB + kstep, voffB);
        PG8_WAIT_V(6); PG8_BAR;
    }
    for (;;) {
        const bool has_next = S.next(ui + 1, nxt);
        const char* nA = has_next ? nxt.a : cA; const char* nB = has_next ? nxt.b : cB;
        if constexpr (GATHER) {
            if (has_next) {
#pragma unroll
                for (int hh = 0; hh < 2; ++hh)
#pragma unroll
                    for (int i = 0; i < 2; ++i) { const int ridx = hh * HALF + Rs[i]; int tk = nxt.rows[ridx]; tk = ridx < nxt.aux ? tk : 0; nOff[hh][i] = (unsigned)(tk * lda + Cs[i]) * 2u; }
            } else {
#pragma unroll
                for (int hh = 0; hh < 2; ++hh)
#pragma unroll
                    for (int i = 0; i < 2; ++i) nOff[hh][i] = cOff[hh][i];
            }
        }
        const int nt = cur.nt ? cur.nt : ntK;
#pragma unroll 1
        for (int t = 0; t < nt; t += 2) {
            const bool last = (t == nt - 2);
            const unsigned o1 = (unsigned)((t + 1) * kstep);
            const char* a2 = last ? nA : cA; const char* b2 = last ? nB : cB; const unsigned o2k = last ? 0u : (unsigned)((t + 2) * kstep), o3k = o2k + (unsigned)kstep;
            unsigned o2[2][2];
#pragma unroll
            for (int hh = 0; hh < 2; ++hh)
#pragma unroll
                for (int i = 0; i < 2; ++i) { if constexpr (GATHER) o2[hh][i] = last ? nOff[hh][i] : cOff[hh][i]; else o2[hh][i] = cOff[hh][i]; }
            if (last && has_next) S.a_ready(nxt);
            if constexpr (SP2) {
            PG8_LDB(B0, 0, 0); PG8_LDB(B1, 0, 1); PG8_SCHED; PG8_LDA(At, 0, 0); PG8_STAGE(PG8_SA(1, 1), cA, o1 + hstepA, cOff[GATHER ? 1 : 0]);
            PG8_WAIT_V(8); PG8_WAIT_L(0); PG8_BAR; PG8_MMA(0, 0, At, B0); PG8_MMA(0, 1, At, B1); PG8_BAR; PG8_SCHED;
            PG8_LDA(At, 0, 1); PG8_STAGE(PG8_SB(0, 0), b2, o2k, voffB); PG8_STAGE(PG8_SB(0, 1), b2, o2k + hstepB, voffB); PG8_STAGE(PG8_SA(0, 0), a2, o2k, o2[0]);
            PG8_WAIT_V(8); PG8_WAIT_L(0); PG8_BAR; PG8_MMA(1, 0, At, B0); PG8_MMA(1, 1, At, B1); PG8_BAR; PG8_SCHED;
            PG8_LDB(B0, 1, 0); PG8_LDB(B1, 1, 1); PG8_SCHED; PG8_LDA(At, 1, 0); PG8_STAGE(PG8_SA(0, 1), a2, o2k + hstepA, o2[GATHER ? 1 : 0]);
            PG8_WAIT_V(8); PG8_WAIT_L(0); PG8_BAR; PG8_MMA(0, 0, At, B0); PG8_MMA(0, 1, At, B1); PG8_BAR; PG8_SCHED;
            PG8_LDA(At, 1, 1); PG8_STAGE(PG8_SB(1, 0), b2, o3k, voffB); PG8_STAGE(PG8_SB(1, 1), b2, o3k + hstepB, voffB); PG8_STAGE(PG8_SA(1, 0), a2, o3k, o2[0]);
            PG8_WAIT_V(8); PG8_WAIT_L(0); PG8_BAR; PG8_MMA(1, 0, At, B0); PG8_MMA(1, 1, At, B1); PG8_BAR; PG8_SCHED;
            } else {
            PG8_LDB(B0, 0, 0); PG8_SCHED; PG8_LDA(At, 0, 0); PG8_STAGE(PG8_SA(1, 1), cA, o1 + hstepA, cOff[GATHER ? 1 : 0]);
            PG8_WAIT_L(8); PG8_BAR; PG8_WAIT_L(0); PG8_MMA(0, 0, At, B0); PG8_BAR; PG8_SCHED;
            PG8_LDB(B1, 0, 1); PG8_STAGE(PG8_SB(0, 0), b2, o2k, voffB);
            PG8_BAR; PG8_WAIT_L(0); PG8_MMA(0, 1, At, B1); PG8_BAR;
            PG8_LDA(At, 0, 1); PG8_STAGE(PG8_SA(0, 0), a2, o2k, o2[0]);
            PG8_BAR; PG8_WAIT_L(0); PG8_MMA(1, 0, At, B0); PG8_BAR; PG8_SCHED;
            PG8_STAGE(PG8_SB(0, 1), b2, o2k + hstepB, voffB);
            PG8_WAIT_V(6); PG8_BAR; PG8_MMA(1, 1, At, B1); PG8_BAR;
            PG8_LDB(B0, 1, 0); PG8_SCHED; PG8_LDA(At, 1, 0); PG8_STAGE(PG8_SA(0, 1), a2, o2k + hstepA, o2[GATHER ? 1 : 0]);
            PG8_WAIT_L(8); PG8_BAR; PG8_WAIT_L(0); PG8_MMA(0, 0, At, B0); PG8_BAR; PG8_SCHED;
            PG8_LDB(B1, 1, 1); PG8_STAGE(PG8_SB(1, 0), b2, o3k, voffB);
            PG8_BAR; PG8_WAIT_L(0); PG8_MMA(0, 1, At, B1); PG8_BAR;
            PG8_LDA(At, 1, 1); PG8_STAGE(PG8_SA(1, 0), a2, o3k, o2[0]);
            PG8_BAR; PG8_WAIT_L(0); PG8_MMA(1, 0, At, B0); PG8_BAR; PG8_SCHED;
            PG8_STAGE(PG8_SB(1, 1), b2, o3k + hstepB, voffB);
            PG8_WAIT_V(6); PG8_BAR; PG8_MMA(1, 1, At, B1); PG8_BAR;
            }
        }
        if constexpr (ALIGN_EPI) { if (wr == 0) PG8_BAR; }
        { int tl_ = tid; asm volatile("" : "+v"(tl_)); const int l2_ = tl_ & 63; E(acc, cur, wr, wc, l2_ & 15, l2_ >> 4); } S.done(cur);
        if (!has_next) break;
#pragma unroll
        for (int a = 0; a < 2; ++a)
#pragma unroll
            for (int b = 0; b < 2; ++b)
#pragma unroll
                for (int m = 0; m < 4; ++m)
#pragma unroll
                    for (int n = 0; n < 2; ++n) acc[a][b][m][n] = (f32x4){0.f, 0.f, 0.f, 0.f};
        cur = nxt; cA = nA; cB = nB; ++ui;
        if constexpr (GATHER) {
#pragma unroll
            for (int hh = 0; hh < 2; ++hh)
#pragma unroll
                for (int i = 0; i < 2; ++i) cOff[hh][i] = nOff[hh][i];
        }
        if constexpr (ALIGN_EPI) { if (wr == 1) PG8_BAR; }
    }
    PG8_WAIT_V(0);
    if constexpr (!ALIGN_EPI) { if (wr == 0) PG8_BAR; }
    PG8_BAR;
#undef PG8_SA
#undef PG8_SB
#undef PG8_STAGE
#undef PG8_RSRC
#undef PG8_LDA
#undef PG8_LDB
#undef PG8_MMA
#undef PG8_CAT
#undef PG8_WAIT_V
#undef PG8_WAIT_L
#undef PG8_BAR
#undef PG8_SCHED
}
}

constexpr int NWAVES = 8;
constexpr int BATCH = 2, SEQ = 16384, D = 1024, NTOK = BATCH * SEQ;
constexpr int NLAYER = 2;
constexpr int NPROJ = 2816, IN_COLS = 2832;
constexpr int PJ = 2048;
constexpr int C_PIN = 0, C_CB = 256, C_CC = 512, C_CX = 768, C_DQ = 1024, C_DK = 1280, C_DV = 1536, C_DZ = 1792;
constexpr int DFF = 2816, NEXP = 8;
constexpr int NCHUNK = SEQ / 64;
constexpr int NINST = BATCH * 4 * 2 * NCHUNK;
constexpr float EPS = 1e-6f;
constexpr float QSCALE = 0.17677669529663687f * 1.4426950408889634f;
#ifndef MOE_FP8
#define MOE_FP8 1
#endif
constexpr float W8SCALE = 64.f;
constexpr int MOE_PASS_TILES = MOE_FP8 ? 264 : 132;
constexpr int MOE_NPASS = MOE_FP8 ? 1 : 2;

constexpr size_t MiB = 1u << 20;
constexpr size_t WS_CTL = 0, CTL_ZERO_BYTES = 1 * MiB;
constexpr size_t SZ_WIN = (size_t)NPROJ * D * 2, SZ_WM = (size_t)4096 * D * 2, SZ_WB = (size_t)4 * 1024 * 256 * 2, SZ_WO = (size_t)D * D * 2;
constexpr size_t SZ_LAYERW = SZ_WIN + SZ_WM + SZ_WB + SZ_WO;
constexpr size_t SZ_WGU = (size_t)2 * DFF * D * 2, SZ_WD = (size_t)D * DFF * 2, SZ_FFNW = SZ_WGU + SZ_WD;
constexpr size_t WS_W = 1 * MiB;
constexpr size_t WS_WFFN = WS_W + 2 * SZ_LAYERW;
static_assert(WS_WFFN + SZ_FFNW <= 53 * MiB, "weights");
constexpr size_t WS_H = 53 * MiB;
constexpr size_t WS_O4 = 117 * MiB;
constexpr size_t WS_F = WS_O4;
constexpr size_t WS_BD = 181 * MiB;
constexpr size_t WS_DEC = 183 * MiB;
constexpr size_t WS_PROJ = 185 * MiB;
constexpr size_t WS_QB = 521 * MiB;
constexpr size_t WS_KV = 313 * MiB;
constexpr size_t WS_UW = 361 * MiB;
constexpr size_t WS_AB = 425 * MiB;
constexpr size_t WS_ST = 489 * MiB;
constexpr size_t WS_PBUF = 185 * MiB;
constexpr size_t WS_MERGED = 441 * MiB;
constexpr size_t WS_ACT0 = 185 * MiB;
constexpr size_t WS_H2B = 479 * MiB;
constexpr size_t WS_MOEW = 185 * MiB;
constexpr size_t WS_XG = 251 * MiB;
constexpr size_t WS_ACT1 = 1 * MiB;
constexpr size_t WS_Y = 317 * MiB;
constexpr size_t WS_ROUTE = 449 * MiB;
constexpr size_t WS_END = 543 * MiB;
static_assert(WS_ACT1 + (size_t)MOE_PASS_TILES * 256 * DFF * (MOE_FP8 ? 1 : 2) <= WS_MOEW, "act1");
static_assert((MOE_FP8 ? WS_XG + (size_t)264 * 256 * D : WS_MOEW + 8 * SZ_FFNW) <= WS_Y && WS_MOEW + 8 * SZ_FFNW / 2 <= WS_XG && WS_Y + (size_t)264 * 256 * D * 2 <= WS_ROUTE && WS_ROUTE + 4 * MiB <= WS_H2B && WS_H2B + 64 * MiB <= WS_END, "moe map");
static_assert(WS_PROJ + (size_t)NTOK * PJ * 2 <= WS_KV && WS_KV + (size_t)8 * 256 * 19456 <= WS_UW && WS_QB + 16 * MiB <= WS_END && WS_ST + (size_t)NINST * 8192 <= WS_END, "mixer map");
constexpr int CW_TMO = 0, CW_CODE = 1;
constexpr int CW_BAR = 4096;
constexpr int CW_MOD = 16384;
constexpr int CW_MOECNT = 65536;
constexpr int CW_NMAX = 66560;
constexpr int CW_MODCNT = 66624;
constexpr int CW_ATTQ = 66688;
static_assert(CW_MOD + NLAYER * BATCH * 6 * D <= CW_MOECNT && (CW_ATTQ + 32 * 64) * 4 <= (int)CTL_ZERO_BYTES, "ctl");

constexpr int RING_OFF = 0, RING_BYTES = 131072;
constexpr int LDS_BYTES = 160 * 1024;
constexpr int MISC_OFF = LDS_BYTES - 256;

#define GAS __attribute__((address_space(1)))
#define LAS __attribute__((address_space(3)))
typedef unsigned short bf16;
typedef unsigned v4u __attribute__((ext_vector_type(4)));
typedef unsigned v2u __attribute__((ext_vector_type(2)));
typedef float f32x4 __attribute__((ext_vector_type(4)));
typedef float f32x16 __attribute__((ext_vector_type(16)));
typedef short bf16x8 __attribute__((ext_vector_type(8)));
typedef short bf16x4 __attribute__((ext_vector_type(4)));
typedef GAS unsigned gu32;
#define RLX_AGENT __ATOMIC_RELAXED, __HIP_MEMORY_SCOPE_AGENT
#define LDS_WAIT() asm volatile("s_waitcnt lgkmcnt(0)" ::: "memory")
#define VM_WAIT() asm volatile("s_waitcnt vmcnt(0)" ::: "memory")
__device__ __forceinline__ unsigned f2bf(float f) { unsigned u = __builtin_bit_cast(unsigned, f); return (u + 0x7fffu + ((u >> 16) & 1u)) >> 16; }
__device__ __forceinline__ unsigned pk2(float lo, float hi) { return f2bf(lo) | (f2bf(hi) << 16); }
__device__ __forceinline__ float bf2f(unsigned b) { return __builtin_bit_cast(float, b << 16); }
__device__ __forceinline__ float bflo(unsigned w) { return __builtin_bit_cast(float, w << 16); }
__device__ __forceinline__ float bfhi(unsigned w) { return __builtin_bit_cast(float, w & 0xffff0000u); }
__device__ __forceinline__ float fast_exp2(float x) { return __builtin_amdgcn_exp2f(x); }
__device__ __forceinline__ float fast_exp(float x) { return __builtin_amdgcn_exp2f(x * 1.4426950408889634f); }
__device__ __forceinline__ float fast_rcp(float x) { return __builtin_amdgcn_rcpf(x); }
__device__ __forceinline__ float sigmoidf_(float x) { return fast_rcp(1.f + fast_exp(-x)); }
__device__ __forceinline__ float siluf_(float x) { return x * sigmoidf_(x); }
__device__ __forceinline__ float wave_sum(float v) {
    v += __builtin_bit_cast(float, __builtin_amdgcn_update_dpp(0, __builtin_bit_cast(int, v), 0xB1, 0xf, 0xf, true));
    v += __builtin_bit_cast(float, __builtin_amdgcn_update_dpp(0, __builtin_bit_cast(int, v), 0x4E, 0xf, 0xf, true));
    v += __builtin_bit_cast(float, __builtin_amdgcn_update_dpp(0, __builtin_bit_cast(int, v), 0x141, 0xf, 0xf, true));
    v += __builtin_bit_cast(float, __builtin_amdgcn_update_dpp(0, __builtin_bit_cast(int, v), 0x140, 0xf, 0xf, true));
    v += __builtin_bit_cast(float, __builtin_amdgcn_ds_swizzle(__builtin_bit_cast(int, v), 0x401f));
    v += __shfl_xor(v, 32);
    return v;
}

#define XB_TMO      128
#define XB_XCNT(j)  (256  + 64 * (j))
#define XB_XSUB(j)  (1280 + 64 * (j))
#define XB_XGEN(j)  (2304 + 64 * (j))
#define XB_TOP      3328
#define XB_TOPGEN   3392
#define XCD_BAR_WORDS 3456
#define XB_SPIN_CAP (1u << 22)
__device__ __forceinline__ unsigned xb_ld(unsigned* p)              { return __hip_atomic_load(p, __ATOMIC_RELAXED, __HIP_MEMORY_SCOPE_AGENT); }
__device__ __forceinline__ unsigned xb_add(unsigned* p, unsigned v) { return __hip_atomic_fetch_add(p, v, __ATOMIC_RELAXED, __HIP_MEMORY_SCOPE_AGENT); }
__device__ __forceinline__ unsigned xb_xcc_id() { return (unsigned)__builtin_amdgcn_s_getreg((3 << 11) | 20) & 0xFu; }
#define XB_SPIN(cond, bar) do { unsigned _sp = 0; while (cond) { __builtin_amdgcn_s_sleep(1); \
    if ((++_sp & 255u) == 0u) { if (xb_ld(&(bar)[XB_TMO])) break; if (_sp > XB_SPIN_CAP) { atomicAdd(&(bar)[XB_TMO], 1u); break; } } } } while (0)
struct XcdBarrier { unsigned* bar; unsigned x; volatile LAS unsigned* st; };
__device__ __forceinline__ XcdBarrier xcd_barrier_post(unsigned* bar, volatile LAS unsigned* st) {
    XcdBarrier b; b.bar = bar; b.x = xb_xcc_id(); b.st = st;
    if (threadIdx.x == 0) (void)xb_add(&bar[XB_XCNT(b.x)], 1u);
    return b;
}
__device__ __forceinline__ void xcd_barrier_complete(unsigned* bar, unsigned x, unsigned& nloc, unsigned& nx) {
    const unsigned G = gridDim.x * gridDim.y * gridDim.z;
    unsigned sum, cnt, mine, sp = 0u;
    for (;;) {
        sum = 0u; cnt = 0u; mine = 0u;
#pragma unroll
        for (unsigned j = 0; j < 16; ++j) { const unsigned c = xb_ld(&bar[XB_XCNT(j)]); sum += c; cnt += (c > 0u) ? 1u : 0u; }
        mine = xb_ld(&bar[XB_XCNT(x)]);
        if (sum == G) break;
        __builtin_amdgcn_s_sleep(1);
        if ((++sp & 255u) == 0u) { if (xb_ld(&bar[XB_TMO])) break; if (sp > XB_SPIN_CAP) { atomicAdd(&bar[XB_TMO], 1u); break; } }
    }
    nloc = mine > 0u ? mine : 1u; nx = cnt > 0u ? cnt : 1u;
}
__device__ __forceinline__ void xcd_barrier(const XcdBarrier& b) {
    asm volatile("s_waitcnt vmcnt(0)" ::: "memory");
    __syncthreads();
    if (threadIdx.x == 0) {
        unsigned* bar = b.bar;
        __builtin_amdgcn_s_waitcnt(0);
        unsigned nloc = b.st[0], nx = b.st[1];
        if (nloc == 0u) { xcd_barrier_complete(bar, b.x, nloc, nx); b.st[0] = nloc; b.st[1] = nx; }
        const unsigned old = xb_add(&bar[XB_XSUB(b.x)], 1u);
        const unsigned gen = old / nloc;
        if (old + 1u == (gen + 1u) * nloc) {
            __builtin_amdgcn_fence(__ATOMIC_RELEASE, "agent");
            asm volatile("s_waitcnt vmcnt(0)" ::: "memory");
            const unsigned og = xb_add(&bar[XB_TOP], 1u);
            const unsigned tg = og / nx;
            if (og + 1u == (tg + 1u) * nx) xb_add(&bar[XB_TOPGEN], 1u);
            else XB_SPIN(xb_ld(&bar[XB_TOPGEN]) == tg, bar);
            __builtin_amdgcn_fence(__ATOMIC_ACQUIRE, "agent");
            xb_add(&bar[XB_XGEN(b.x)], 1u);
            asm volatile("s_waitcnt vmcnt(0)" ::: "memory");
        } else {
            XB_SPIN(xb_ld(&bar[XB_XGEN(b.x)]) == gen, bar);
            __builtin_amdgcn_fence(__ATOMIC_ACQUIRE, "agent");
            asm volatile("s_waitcnt vmcnt(0)" ::: "memory");
        }
    }
    __syncthreads();
}

struct Frame {
    LAS unsigned char* lds;
    volatile LAS unsigned* MISC;
    gu32* ctl;
    int tid, lane, wave;
    int vcu, G;
    unsigned char* ws;
    float* out;
    const float* const* in;
};
enum { I_X = 0, I_C, I_ADAW, I_ADAB, I_NMIXPRE, I_NMIXPOST, I_NFFNPRE, I_NFFNPOST, I_WIN, I_DLAMBDA, I_DSUBLN, I_POOLW, I_POOLSCALE, I_SCONVW, I_DCONVW, I_DALOG, I_DDTBIAS, I_DNORM,
       I_WBRANCH, I_WMERGE, I_BMERGE, I_WO, I_FFNG, I_FFNU, I_FFND, I_ROUTERW, I_ROUTERB, I_MOEG, I_MOEU, I_MOED, N_INPUTS };

__device__ __forceinline__ unsigned pk4_fp8(float a, float b, float c, float d) { int w = __builtin_amdgcn_cvt_pk_fp8_f32(a, b, 0, false); w = __builtin_amdgcn_cvt_pk_fp8_f32(c, d, w, true); return (unsigned)w; }
template <bool F8 = false> __device__ __forceinline__ void cvt_item(const float* W, int ldw, int k0, int n0, bf16* WT, int Kd, int drow0, LAS float* scr, int lane) {
#pragma unroll 8
    for (int i = 0; i < 32; ++i) { const int kk = 2 * i + (lane >> 5); scr[kk * 33 + (lane & 31)] = W[(size_t)(k0 + kk) * ldw + n0 + (lane & 31)]; }
    LDS_WAIT(); asm volatile("" ::: "memory");
    const int c = lane & 7;
#pragma unroll
    for (int j = 0; j < 4; ++j) { const int n = (lane >> 3) + 8 * j; const LAS float* s = scr + (8 * c) * 33 + n;
        if constexpr (F8) { v2u o; o.x = pk4_fp8(s[0 * 33] * W8SCALE, s[1 * 33] * W8SCALE, s[2 * 33] * W8SCALE, s[3 * 33] * W8SCALE); o.y = pk4_fp8(s[4 * 33] * W8SCALE, s[5 * 33] * W8SCALE, s[6 * 33] * W8SCALE, s[7 * 33] * W8SCALE);
            *(GAS v2u*)((unsigned char*)WT + (size_t)(drow0 + n) * Kd + k0 + 8 * c) = o; }
        else { v4u o; o.x = pk2(s[0 * 33], s[1 * 33]); o.y = pk2(s[2 * 33], s[3 * 33]); o.z = pk2(s[4 * 33], s[5 * 33]); o.w = pk2(s[6 * 33], s[7 * 33]);
            *(GAS v4u*)(WT + (size_t)(drow0 + n) * Kd + k0 + 8 * c) = o; } }
    LDS_WAIT(); asm volatile("" ::: "memory");
}
template <bool F8 = false> __device__ __forceinline__ void cvt_ffn_item(const float* wg, const float* wu, const float* wd, bf16* Wgu, bf16* Wd, int r, LAS float* scr, int lane) {
    constexpr int IG = (D / 64) * (DFF / 32);
    if (r < IG) { const int kb = r / (DFF / 32), nb = r % (DFF / 32), n0 = nb * 32; cvt_item<F8>(wg, DFF, kb * 64, n0, Wgu, D, 256 * (n0 >> 7) + (n0 & 127), scr, lane); return; } r -= IG;
    if (r < IG) { const int kb = r / (DFF / 32), nb = r % (DFF / 32), n0 = nb * 32; cvt_item<F8>(wu, DFF, kb * 64, n0, Wgu, D, 256 * (n0 >> 7) + (n0 & 127) + 128, scr, lane); return; } r -= IG;
    { const int kb = r / (D / 32), nb = r % (D / 32); cvt_item<F8>(wd, D, kb * 64, nb * 32, Wd, DFF, nb * 32, scr, lane); }
}
constexpr int FFN_ITEMS = 3 * (D / 64) * (DFF / 32);
__device__ __forceinline__ bf16* w_in_t(unsigned char* ws, int l) { return (bf16*)(ws + WS_W + (size_t)l * SZ_LAYERW); }
__device__ __forceinline__ bf16* w_m_t(unsigned char* ws, int l) { return (bf16*)(ws + WS_W + (size_t)l * SZ_LAYERW + SZ_WIN); }
__device__ __forceinline__ bf16* w_b_t(unsigned char* ws, int l) { return (bf16*)(ws + WS_W + (size_t)l * SZ_LAYERW + SZ_WIN + SZ_WM); }
__device__ __forceinline__ bf16* w_o_t(unsigned char* ws, int l) { return (bf16*)(ws + WS_W + (size_t)l * SZ_LAYERW + SZ_WIN + SZ_WM + SZ_WB); }

__device__ __forceinline__ void p_prologue(Frame& F) {
    LAS float* scr = (LAS float*)(F.lds + RING_OFF + F.wave * 16384);
    const int gw = F.vcu * NWAVES + F.wave, NGW = F.G * NWAVES;
    constexpr int I_IN = (D / 64) * (NPROJ / 32), I_M = (D / 64) * (D / 32), I_B = (256 / 64) * (D / 32);
    constexpr int PER_LAYER = I_IN + 4 * I_M + 4 * I_B + I_M;
    constexpr int NITEMS = NLAYER * PER_LAYER + FFN_ITEMS;
    for (int it = gw; it < NITEMS; it += NGW) {
        int r = it;
        if (r >= NLAYER * PER_LAYER) { r -= NLAYER * PER_LAYER;
            cvt_ffn_item(F.in[I_FFNG], F.in[I_FFNU], F.in[I_FFND], (bf16*)(F.ws + WS_WFFN), (bf16*)(F.ws + WS_WFFN + SZ_WGU), r, scr, F.lane); continue; }
        const int l = r / PER_LAYER; r -= l * PER_LAYER;
        if (r < I_IN) { const int kb = r / (NPROJ / 32), nb = r % (NPROJ / 32); cvt_item(F.in[I_WIN] + (size_t)l * D * IN_COLS, IN_COLS, kb * 64, nb * 32, w_in_t(F.ws, l), D, nb * 32, scr, F.lane); continue; } r -= I_IN;
        if (r < 4 * I_M) { const int i = r / I_M; r -= i * I_M; const int kb = r / (D / 32), nb = r % (D / 32);
            cvt_item(F.in[I_WMERGE] + ((size_t)l * 4 + i) * D * D, D, kb * 64, nb * 32, w_m_t(F.ws, l), D, i * 1024 + nb * 32, scr, F.lane); continue; } r -= 4 * I_M;
        if (r < 4 * I_B) { const int i = r / I_B; r -= i * I_B; const int kb = r / (D / 32), nb = r % (D / 32);
            cvt_item(F.in[I_WBRANCH] + ((size_t)l * 4 + i) * 256 * D, D, kb * 64, nb * 32, w_b_t(F.ws, l) + i * 256, 1024, nb * 32, scr, F.lane); continue; } r -= 4 * I_B;
        { const int kb = r / (D / 32), nb = r % (D / 32); cvt_item(F.in[I_WO] + (size_t)l * D * D, D, kb * 64, nb * 32, w_o_t(F.ws, l), D, nb * 32, scr, F.lane); }
    }
    constexpr int MOD_ITEMS = NLAYER * 24 * 16;
    for (int it = gw; it < MOD_ITEMS; it += NGW) {
        const int grp = it >> 4, kc = it & 15, l = grp / 24, nb = grp % 24;
        const float* Wp = F.in[I_ADAW] + ((size_t)l * D + kc * 64) * (6 * D) + nb * 256 + F.lane * 4;
        f32x4 a0 = {0.f, 0.f, 0.f, 0.f}, a1 = {0.f, 0.f, 0.f, 0.f};
#pragma unroll 8
        for (int k = 0; k < 64; ++k) { const f32x4 w = *(const GAS f32x4*)(Wp + (size_t)k * (6 * D));
            const float c0 = siluf_(F.in[I_C][kc * 64 + k]), c1 = siluf_(F.in[I_C][D + kc * 64 + k]); a0 += w * c0; a1 += w * c1; }
        float* part = (float*)(F.ws + WS_BD) + ((size_t)grp * 16 + kc) * 512 + F.lane * 4;
        *(GAS f32x4*)part = a0; *(GAS f32x4*)(part + 256) = a1;
        __threadfence();
        unsigned old = 0;
        if (F.lane == 0) old = __hip_atomic_fetch_add(F.ctl + CW_MODCNT + grp, 1u, RLX_AGENT);
        old = __builtin_amdgcn_readfirstlane(old);
        if (old == 15u) {
            __threadfence();
            f32x4 s0 = {0.f, 0.f, 0.f, 0.f}, s1 = {0.f, 0.f, 0.f, 0.f};
            const float* pg = (const float*)(F.ws + WS_BD) + (size_t)grp * 16 * 512 + F.lane * 4;
#pragma unroll
            for (int q = 0; q < 16; ++q) { s0 += __builtin_nontemporal_load((const f32x4*)(pg + q * 512)); s1 += __builtin_nontemporal_load((const f32x4*)(pg + q * 512 + 256)); }
            float* m0 = (float*)(F.ctl + CW_MOD) + (size_t)(l * BATCH + 0) * 6 * D + nb * 256 + F.lane * 4;
            *(GAS f32x4*)m0 = s0; *(GAS f32x4*)(m0 + 6 * D) = s1;
        }
    }
}
__device__ __forceinline__ void moe_tiles(Frame& F, int (&cnt)[NEXP], int (&tstart)[NEXP + 1]) {
    int acc = 0;
#pragma unroll
    for (int e = 0; e < NEXP; ++e) { cnt[e] = __builtin_amdgcn_readfirstlane((int)__hip_atomic_load(F.ctl + CW_MOECNT + 64 * e, RLX_AGENT)); tstart[e] = acc; acc += (cnt[e] + 255) >> 8; }
    tstart[NEXP] = acc;
}
__device__ __forceinline__ void p_moe_cvt(Frame& F) {
    LAS float* scr = (LAS float*)(F.lds + RING_OFF + F.wave * 16384);
    const int gw = F.vcu * NWAVES + F.wave, NGW = F.G * NWAVES;
    for (int it = gw; it < NEXP * FFN_ITEMS; it += NGW) {
        const int e = it / FFN_ITEMS, r = it % FFN_ITEMS;
        unsigned char* base = F.ws + WS_MOEW + (size_t)e * (MOE_FP8 ? SZ_FFNW / 2 : SZ_FFNW);
        cvt_ffn_item<MOE_FP8 != 0>(F.in[I_MOEG] + (size_t)e * D * DFF, F.in[I_MOEU] + (size_t)e * D * DFF, F.in[I_MOED] + (size_t)e * DFF * D, (bf16*)base, (bf16*)(base + (MOE_FP8 ? SZ_WGU / 2 : SZ_WGU)), r, scr, F.lane);
    }
#if MOE_FP8
    int cnt[NEXP], tstart[NEXP + 1]; moe_tiles(F, cnt, tstart);
    const int* lists = (const int*)(F.ws + WS_ROUTE + 1 * MiB);
    for (int gs = gw; gs < tstart[NEXP] * 256; gs += NGW) {
        const int t = gs >> 8; int e = 0;
#pragma unroll
        for (int k = 1; k < NEXP; ++k) e = (t >= tstart[k]) ? k : e;
        int ts = 0, ce = 0;
#pragma unroll
        for (int k = 0; k < NEXP; ++k) { ts = (k == e) ? tstart[k] : ts; ce = (k == e) ? cnt[k] : ce; }
        const int i = (t - ts) * 256 + (gs & 255);
        int tok = lists[(size_t)e * 65536 + i]; tok = i < ce ? tok : 0;
        const v4u v = *(const GAS v4u*)(F.ws + WS_H2B + (size_t)tok * D + F.lane * 16);
        *(GAS v4u*)(F.ws + WS_XG + (size_t)gs * D + F.lane * 16) = v;
    }
#endif
}

struct Row { f32x4 v[4]; };
__device__ __forceinline__ float modv(Frame& F, int l, int b, int idx) { return ((const float*)(F.ctl + CW_MOD))[(size_t)(l * BATCH + b) * 6 * D + idx] + F.in[I_ADAB][l * 6 * D + idx]; }
__device__ __forceinline__ f32x4 modv4(Frame& F, int l, int b, int idx) {
    const f32x4 a = *(const GAS f32x4*)((const float*)(F.ctl + CW_MOD) + (size_t)(l * BATCH + b) * 6 * D + idx), c = *(const GAS f32x4*)(F.in[I_ADAB] + l * 6 * D + idx); return a + c; }
__device__ __forceinline__ float row_rstd(const Row& r) {
    float s = 0.f;
#pragma unroll
    for (int j = 0; j < 4; ++j) s += (r.v[j].x * r.v[j].x + r.v[j].y * r.v[j].y) + (r.v[j].z * r.v[j].z + r.v[j].w * r.v[j].w);
    return 1.f / sqrtf(wave_sum(s) * (1.f / D) + EPS);
}
__device__ __forceinline__ void row_resid(Frame& F, Row& x, const Row& f, const float* gain, int l, int b, int gidx) {
    const float rs = row_rstd(f);
#pragma unroll
    for (int j = 0; j < 4; ++j) { const int c = 4 * F.lane + 256 * j; const f32x4 g = *(const GAS f32x4*)(gain + c), m = modv4(F, l, b, gidx + c); x.v[j] += m * (f.v[j] * rs * g); }
}
__device__ __forceinline__ void row_make_h(Frame& F, Row& h, const Row& x, const float* gain, int l, int b, int shidx, int scidx) {
    const float rs = row_rstd(x);
#pragma unroll
    for (int j = 0; j < 4; ++j) { const int c = 4 * F.lane + 256 * j; const f32x4 g = *(const GAS f32x4*)(gain + c), sc = modv4(F, l, b, scidx + c), sh = modv4(F, l, b, shidx + c);
        h.v[j] = (x.v[j] * rs * g) * (sc + 1.f) + sh; }
}
struct ColVec { f32x4 v[4]; };
__device__ __forceinline__ void cv_resid(Frame& F, ColVec& c, const float* gain, int l, int b, int gidx) {
#pragma unroll
    for (int j = 0; j < 4; ++j) { const int col = 4 * F.lane + 256 * j; c.v[j] = modv4(F, l, b, gidx + col) * *(const GAS f32x4*)(gain + col); }
}
__device__ __forceinline__ void cv_h(Frame& F, ColVec& a, ColVec& c, const float* gain, int l, int b, int shidx, int scidx) {
#pragma unroll
    for (int j = 0; j < 4; ++j) { const int col = 4 * F.lane + 256 * j; a.v[j] = *(const GAS f32x4*)(gain + col) * (modv4(F, l, b, scidx + col) + 1.f); c.v[j] = modv4(F, l, b, shidx + col); }
}
__device__ __forceinline__ void row_resid_cv(Row& x, const Row& f, const ColVec& c) {
    const float rs = row_rstd(f);
#pragma unroll
    for (int j = 0; j < 4; ++j) x.v[j] += c.v[j] * (f.v[j] * rs);
}
__device__ __forceinline__ void row_make_h_cv(Row& h, const Row& x, const ColVec& a, const ColVec& c) {
    const float rs = row_rstd(x);
#pragma unroll
    for (int j = 0; j < 4; ++j) h.v[j] = (x.v[j] * rs) * a.v[j] + c.v[j];
}
__device__ __forceinline__ void row_store_bf16(Frame& F, const Row& h, bf16* dst) {
    GAS unsigned long long* o8 = (GAS unsigned long long*)dst + F.lane;
#pragma unroll
    for (int j = 0; j < 4; ++j) o8[64 * j] = (unsigned long long)pk2(h.v[j].x, h.v[j].y) | ((unsigned long long)pk2(h.v[j].z, h.v[j].w) << 32);
}
__device__ __forceinline__ void row_load_f32(Frame& F, Row& r, const float* src) {
    const GAS f32x4* p = (const GAS f32x4*)src + F.lane;
#pragma unroll
    for (int j = 0; j < 4; ++j) r.v[j] = p[64 * j];
}
__device__ __forceinline__ void row_store_f32(Frame& F, const Row& r, float* dst) {
    GAS f32x4* p = (GAS f32x4*)dst + F.lane;
#pragma unroll
    for (int j = 0; j < 4; ++j) p[64 * j] = r.v[j];
}
__device__ __forceinline__ void row_load_bf16(Frame& F, Row& r, const bf16* src) {
    const GAS v2u* p = (const GAS v2u*)src + F.lane;
#pragma unroll
    for (int j = 0; j < 4; ++j) { const v2u w = p[64 * j]; r.v[j] = (f32x4){bflo(w.x), bfhi(w.x), bflo(w.y), bfhi(w.y)}; }
}
template <int NO> __device__ __forceinline__ void row_dots(Frame& F, const Row& h, const LAS float* WT, float (&out)[NO]) {
#pragma unroll
    for (int o = 0; o < NO; ++o) { float s = 0.f;
#pragma unroll
        for (int j = 0; j < 4; ++j) { const f32x4 w = *(const LAS f32x4*)(WT + o * 1024 + 4 * F.lane + 256 * j); s += (h.v[j].x * w.x + h.v[j].y * w.y) + (h.v[j].z * w.z + h.v[j].w * w.w); }
        out[o] = s; if ((o & 3) == 3) __builtin_amdgcn_sched_barrier(0); }
#pragma unroll
    for (int o = 0; o < NO; ++o) { out[o] = wave_sum(out[o]); if ((o & 3) == 3) __builtin_amdgcn_sched_barrier(0); }
}
template <int NO> __device__ __forceinline__ void load_wt(Frame& F, const float* W, int ldw, int col0, LAS float* WT) {
    for (int k = F.tid; k < 1024; k += NWAVES * 64) {
#pragma unroll
        for (int o = 0; o < NO; ++o) WT[o * 1024 + k] = W[(size_t)k * ldw + col0 + o];
    }
    __syncthreads();
}
__device__ __forceinline__ float softplusf_(float x) { return x > 20.f ? x : log1pf(__expf(x)); }
__device__ __forceinline__ void row_bd(Frame& F, const Row& h, const LAS float* W16T, int l, int row) {
    float o16[16]; row_dots<16>(F, h, W16T, o16);
    float mine = 0.f;
#pragma unroll
    for (int o = 0; o < 16; ++o) mine = (F.lane == o) ? o16[o] : mine;
    if (F.lane < 16) {
        float r;
        if (F.lane < 8) r = 1.f / (1.f + __expf(-mine));
        else { const int i = F.lane - 8; r = -__expf(F.in[I_DALOG][l * 8 + i]) * softplusf_(mine + F.in[I_DDTBIAS][l * 8 + i]); }
        ((float*)(F.ws + WS_BD))[(size_t)row * 16 + F.lane] = r;
    }
}
constexpr int ROW_A = 0, ROW_B = 1, ROW_C = 2;
template <int MODE> __device__ __forceinline__ void p_rows(Frame& F, const int l) {
    const int gw = F.vcu * NWAVES + F.wave, NGW = F.G * NWAVES;
    LAS float* WT = (LAS float*)(F.lds + RING_OFF);
    LAS int* linfo = (LAS int*)(F.lds + RING_OFF + 65536);
    LAS int* lcnt = (LAS int*)(F.lds + RING_OFF + 65536 + 8 * 32 * 16);
    const bool do_h1 = (MODE == ROW_A) || (MODE == ROW_C && l + 1 < NLAYER);
    const int lh = (MODE == ROW_C) ? l + 1 : l;
    const bool router = (MODE == ROW_B) && (l == 1);
    if (do_h1) load_wt<16>(F, F.in[I_WIN] + (size_t)lh * D * IN_COLS, IN_COLS, NPROJ, WT);
    if (router) { if (F.tid < 16) lcnt[F.tid] = 0; load_wt<8>(F, F.in[I_ROUTERW], NEXP, 0, WT); }
    int cnt[NEXP], tstart[NEXP + 1];
    if (MODE == ROW_C && l == 1) moe_tiles(F, cnt, tstart);
    const float* xsrc = (MODE == ROW_A || (MODE == ROW_B && l == 0)) ? F.in[I_X] : F.out;
    int ri = 0, cb = -1; ColVec cR, cA, cC;
    for (int m = gw; m < NTOK; m += NGW, ++ri) {
        const int b = m / SEQ;
        if (b != cb) { cb = b;
            if (MODE == ROW_B) { cv_resid(F, cR, F.in[I_NMIXPOST] + l * D, l, b, 2 * D); cv_h(F, cA, cC, F.in[I_NFFNPRE] + l * D, l, b, 3 * D, 4 * D); }
            if (MODE == ROW_C) cv_resid(F, cR, F.in[I_NFFNPOST] + l * D, l, b, 5 * D);
            if (do_h1) cv_h(F, cA, cC, F.in[I_NMIXPRE] + lh * D, lh, b, 0, 1 * D); }
        Row x; row_load_f32(F, x, xsrc + (size_t)m * D);
        if (MODE == ROW_B) {
            Row f; row_load_bf16(F, f, (const bf16*)(F.ws + WS_F) + (size_t)m * D);
            row_resid_cv(x, f, cR);
            row_store_f32(F, x, F.out + (size_t)m * D);
            Row h; row_make_h_cv(h, x, cA, cC);
            if (MOE_FP8 && l == 1) { GAS unsigned* o4 = (GAS unsigned*)(F.ws + WS_H2B + (size_t)m * D) + F.lane;
#pragma unroll
                for (int j = 0; j < 4; ++j) o4[64 * j] = pk4_fp8(h.v[j].x, h.v[j].y, h.v[j].z, h.v[j].w); }
            else row_store_bf16(F, h, (bf16*)(F.ws + (l == 0 ? WS_H : WS_H2B)) + (size_t)m * D);
            if (router) {
                float lg[NEXP]; row_dots<NEXP>(F, h, WT, lg);
                int e0 = 0; float l0 = lg[0] + F.in[I_ROUTERB][0];
#pragma unroll
                for (int e = 0; e < NEXP; ++e) lg[e] += F.in[I_ROUTERB][e];
#pragma unroll
                for (int e = 1; e < NEXP; ++e) if (lg[e] > l0) { l0 = lg[e]; e0 = e; }
                int e1 = -1; float l1 = -3.0e38f;
#pragma unroll
                for (int e = 0; e < NEXP; ++e) if (e != e0 && lg[e] > l1) { l1 = lg[e]; e1 = e; }
                const float q1 = __expf(l1 - l0), p0 = 1.f / (1.f + q1), p1 = q1 * p0;
                if (F.lane == 0) {
                    const int i0 = atomicAdd((int*)&lcnt[e0], 1), i1 = atomicAdd((int*)&lcnt[e1], 1);
                    LAS int* li = linfo + (F.wave * 32 + ri) * 4;
                    li[0] = e0 | (e1 << 8) | (i0 << 16); li[1] = i1; li[2] = __float_as_int(p0); li[3] = __float_as_int(p1);
                }
            }
        } else if (MODE == ROW_C) {
            Row f;
            if (l == 0) row_load_bf16(F, f, (const bf16*)(F.ws + WS_F) + (size_t)m * D);
            else {
                const int* ti = (const int*)(F.ws + WS_ROUTE) + (size_t)m * 8;
                const int e0 = ti[0], i0 = ti[1], e1 = ti[2], i1 = ti[3]; const float p0 = __int_as_float(ti[4]), p1 = __int_as_float(ti[5]);
                int s0 = 0, s1 = 0;
#pragma unroll
                for (int e = 0; e < NEXP; ++e) { s0 = (e == e0) ? tstart[e] * 256 + i0 : s0; s1 = (e == e1) ? tstart[e] * 256 + i1 : s1; }
                Row y0, y1; row_load_bf16(F, y0, (const bf16*)(F.ws + WS_Y) + (size_t)s0 * D); row_load_bf16(F, y1, (const bf16*)(F.ws + WS_Y) + (size_t)s1 * D);
#pragma unroll
                for (int j = 0; j < 4; ++j) f.v[j] = y0.v[j] * p0 + y1.v[j] * p1;
            }
            row_resid_cv(x, f, cR);
            row_store_f32(F, x, F.out + (size_t)m * D);
        }
        if (do_h1) {
            Row h; row_make_h_cv(h, x, cA, cC);
            row_store_bf16(F, h, (bf16*)(F.ws + WS_H) + (size_t)m * D);
            row_bd(F, h, WT, lh, m);
        }
    }
    if (router) {
        __syncthreads();
        if (F.tid < NEXP) lcnt[8 + F.tid] = (int)__hip_atomic_fetch_add(F.ctl + CW_MOECNT + 64 * F.tid, (unsigned)lcnt[F.tid], RLX_AGENT);
        __syncthreads();
        ri = 0;
        for (int m = gw; m < NTOK; m += NGW, ++ri) {
            if (F.lane == 0) {
                const LAS int* li = linfo + (F.wave * 32 + ri) * 4;
                const int w0 = li[0], e0 = w0 & 255, e1 = (w0 >> 8) & 255, i0 = (w0 >> 16) + lcnt[8 + e0], i1 = li[1] + lcnt[8 + e1];
                int* ti = (int*)(F.ws + WS_ROUTE) + (size_t)m * 8;
                ti[0] = e0; ti[1] = i0; ti[2] = e1; ti[3] = i1; ti[4] = li[2]; ti[5] = li[3];
                int* lists = (int*)(F.ws + WS_ROUTE + 1 * MiB);
                lists[(size_t)e0 * 65536 + i0] = m; lists[(size_t)e1 * 65536 + i1] = m;
            }
        }
    }
    __syncthreads();
}

namespace pg8 {
constexpr int NXCD = 8, WGM = 8;
struct SchedStd {
    int nM, nN, nwg, G, c; const char* A; size_t a_tile; const char* B; size_t b_tile;
    __device__ __forceinline__ void init(int nM_, int nN_, int G_, int c_, const void* A_, size_t a_tile_, const void* B_, size_t b_tile_) { nM = nM_; nN = nN_; nwg = nM * nN; G = G_; c = c_; A = (const char*)A_; a_tile = a_tile_; B = (const char*)B_; b_tile = b_tile_; }
    __device__ __forceinline__ bool next(int i, Unit& u) const {
        const long L = (long)i * G + c; if (L >= nwg) return false;
        int wgid = (int)L; { const int q = nwg / NXCD, r = nwg % NXCD, xcd = wgid % NXCD, off = wgid / NXCD; wgid = (xcd < r ? xcd * (q + 1) : r * (q + 1) + (xcd - r) * q) + off; }
        const int nig = WGM * nN, gid = wgid / nig, fm = gid * WGM, gsz = (nM - fm) < WGM ? (nM - fm) : WGM;
        u.pm = fm + ((wgid % nig) % gsz); u.pn = (wgid % nig) / gsz; u.aux = 0; u.nt = 0; u.a = A + (size_t)u.pm * a_tile; u.b = B + (size_t)u.pn * b_tile; u.rows = nullptr; return true;
    }
    __device__ __forceinline__ void a_ready(const Unit&) const {}
    __device__ __forceinline__ void done(const Unit&) const {}
};
struct SchedBranch {
    SchedStd s; const char* O4; const char* Wb;
    __device__ __forceinline__ bool next(int i, Unit& u) const {
        if (!s.next(i, u)) return false;
        const int br = u.pn >> 2; u.pn &= 3; u.aux = br;
        u.a = O4 + (size_t)u.pm * 256 * 1024 * 2 + (size_t)br * 256 * 2; u.b = Wb + (size_t)br * 1024 * 256 * 2 + (size_t)u.pn * 256 * 256 * 2; return true;
    }
    __device__ __forceinline__ void a_ready(const Unit&) const {}
    __device__ __forceinline__ void done(const Unit&) const {}
};
struct SchedGate {
    int vcu, G; const char* H; const char* Wm;
    __device__ __forceinline__ bool next(int i, Unit& u) const {
        const int tg = vcu + G * (i >> 2); if (tg >= 512) return false;
        u.pm = tg >> 2; u.pn = tg & 3; u.aux = i & 3; u.nt = 0; u.rows = nullptr;
        u.a = H + (size_t)u.pm * 256 * 1024 * 2; u.b = Wm + ((size_t)u.aux * 1024 + (size_t)u.pn * 256) * 1024 * 2; return true;
    }
    __device__ __forceinline__ void a_ready(const Unit&) const {}
    __device__ __forceinline__ void done(const Unit&) const {}
};
struct SchedMoe {
    int c, G, t0, t1, nN; int tstart[9]; int cnt[8];
    const char* A; const int* lists; const char* W; size_t w_tile; bool gather; size_t exp_stride, act_tile;
    __device__ __forceinline__ bool next(int i, Unit& u) const {
        const long L = (long)i * G + c; const int t = t0 + (int)(L / nN); if (t >= t1) return false;
        int e = 0;
#pragma unroll
        for (int k = 1; k < 8; ++k) e = (t >= tstart[k]) ? k : e;
        int ce = 0;
#pragma unroll
        for (int k = 0; k < 8; ++k) ce = (k == e) ? cnt[k] : ce;
        const int j = t - ((e == 0) ? 0 : 0), jj = t;
        (void)j; (void)jj;
        int ts = 0;
#pragma unroll
        for (int k = 0; k < 8; ++k) ts = (k == e) ? tstart[k] : ts;
        const int tj = t - ts;
        u.pn = (int)(L % nN); u.nt = 0;
        if (gather) { u.pm = t - t0; u.a = A; u.rows = lists + (size_t)e * 65536 + tj * 256; const int nv = ce - tj * 256; u.aux = nv > 256 ? 256 : nv; }
        else { u.pm = t; u.a = A + (size_t)(t - t0) * act_tile; u.rows = nullptr; u.aux = 0; }
        u.b = W + (size_t)e * exp_stride + (size_t)u.pn * w_tile; return true;
    }
    static constexpr size_t DFF_ = 2816; static constexpr size_t SZ_EXP_ = (size_t)2 * 2816 * 1024 * 2 + (size_t)1024 * 2816 * 2;
    __device__ __forceinline__ void a_ready(const Unit&) const {}
    __device__ __forceinline__ void done(const Unit&) const {}
};

struct EpiStore {
    static constexpr bool PERM = true;
    bf16_t* O; int ldc; size_t aux_stride; float scale0;
    __device__ __forceinline__ void operator()(const f32x4 (&acc)[2][2][4][2], const Unit& u, int wr, int wc, int fr, int fq) const {
        const int row0 = u.pm * BM + wr * 64 + fr, col0 = u.pn * BM + wc * 32 + 8 * fq; bf16_t* base = O + (size_t)u.aux * aux_stride;
        const float sc = scale0;
#pragma unroll
        for (int ai = 0; ai < 2; ++ai)
#pragma unroll
            for (int m = 0; m < 4; ++m) { bf16_t* rowp = base + (size_t)(row0 + ai * HALF + m * 16) * ldc + col0;
#pragma unroll
                for (int bj = 0; bj < 2; ++bj) { const f32x4 v0 = acc[ai][bj][m][0] * sc, v1 = acc[ai][bj][m][1] * sc;
                    u32x4 w; w.x = cvt_pk_bf16(v0[0], v0[1]); w.y = cvt_pk_bf16(v0[2], v0[3]); w.z = cvt_pk_bf16(v1[0], v1[1]); w.w = cvt_pk_bf16(v1[2], v1[3]);
                    *(u32x4*)(rowp + bj * HALF) = w; } }
    }
};

struct EpiStore64 {
    static constexpr bool PERM = true;
    bf16_t* O;
    __device__ __forceinline__ void operator()(const f32x4 (&acc)[2][2][4][2], const Unit& u, int wr, int wc, int fr, int fq) const {
        int fr_ = fr, fq_ = fq; asm volatile("" : "+v"(fr_), "+v"(fq_));
        bf16_t* base = O + (size_t)(u.pm * BM + wr * 64 + fr_) * 1024 + u.pn * BM + wc * 32 + 8 * fq_;
#pragma unroll
        for (int ai = 0; ai < 2; ++ai)
#pragma unroll
            for (int m = 0; m < 4; ++m) {
#pragma unroll
                for (int bj = 0; bj < 2; ++bj) { const f32x4 v0 = acc[ai][bj][m][0] * (1.f / 64.f), v1 = acc[ai][bj][m][1] * (1.f / 64.f);
                    u32x4 w; w.x = cvt_pk_bf16(v0[0], v0[1]); w.y = cvt_pk_bf16(v0[2], v0[3]); w.z = cvt_pk_bf16(v1[0], v1[1]); w.w = cvt_pk_bf16(v1[2], v1[3]);
                    *(u32x4*)(base + (ai * HALF + m * 16) * 1024 + bj * HALF) = w; }
                __builtin_amdgcn_sched_barrier(0); }
    }
};
struct EpiProj {
    static constexpr bool PERM = true;
    static constexpr int TILE_E = 9728;
    bf16_t* Qb; bf16_t* KV; bf16_t* Pj; unsigned* nmax; float qscale;
    __device__ __forceinline__ void operator()(const f32x4 (&acc)[2][2][4][2], const Unit& u, int wr, int wc, int fr, int fq) const {
        const int t0 = u.pm * BM + wr * 64 + fr;
        const int b = (u.pm * BM) >> 14;
        const int s00 = t0 & 16383;
        if (u.pn >= 3) {
            bf16_t* base = Pj + (size_t)t0 * 2048 + (u.pn - 3) * BM + wc * 32 + 8 * fq;
#pragma unroll
            for (int ai = 0; ai < 2; ++ai)
#pragma unroll
                for (int m = 0; m < 4; ++m) {
#pragma unroll
                    for (int bj = 0; bj < 2; ++bj) { const f32x4 v0 = acc[ai][bj][m][0], v1 = acc[ai][bj][m][1];
                        u32x4 w; w.x = cvt_pk_bf16(v0[0], v0[1]); w.y = cvt_pk_bf16(v0[2], v0[3]); w.z = cvt_pk_bf16(v1[0], v1[1]); w.w = cvt_pk_bf16(v1[2], v1[3]);
                        *(u32x4*)(base + (ai * HALF + m * 16) * 2048 + bj * HALF) = w; }
                    __builtin_amdgcn_sched_barrier(0); }
        } else if (u.pn == 2) {
            bf16_t* hb = KV + ((size_t)((b * 4 + (wc >> 1)) * 256 + (s00 >> 6))) * TILE_E + 5120 + (32 * (wc & 1) + 8 * fq) * 72 + (s00 & 63);
#pragma unroll
            for (int ai = 0; ai < 2; ++ai)
#pragma unroll
                for (int bj = 0; bj < 2; ++bj) { bf16_t* tb = hb + (size_t)bj * (2 * 256 * TILE_E) + ai * (2 * TILE_E);
#pragma unroll
                    for (int m = 0; m < 4; ++m)
#pragma unroll
                        for (int n = 0; n < 2; ++n)
#pragma unroll
                            for (int j = 0; j < 4; ++j) { const float v = acc[ai][bj][m][n][j];
                                unsigned bits = __builtin_bit_cast(unsigned, v); bits = (bits + 0x7fffu + ((bits >> 16) & 1u)) >> 16;
                                tb[(4 * n + j) * 72 + 16 * m] = (bf16_t)bits; }
                    __builtin_amdgcn_sched_barrier(0); }
        } else {
            const float sc = (u.pn == 0) ? qscale : 1.f; float nm = 0.f;
            bf16_t* qbase = Qb + ((size_t)(b * 4 + wc) * 16384 + s00) * 64 + 8 * fq;
            bf16_t* kbase = KV + ((size_t)((b * 4 + wc) * 256 + (s00 >> 6))) * TILE_E + (s00 & 63) * 40 + 8 * fq;
#pragma unroll
            for (int ai = 0; ai < 2; ++ai)
#pragma unroll
                for (int m = 0; m < 4; ++m) {
#pragma unroll
                    for (int bj = 0; bj < 2; ++bj) { const f32x4 v0 = acc[ai][bj][m][0] * sc, v1 = acc[ai][bj][m][1] * sc;
                        u32x4 w; w.x = cvt_pk_bf16(v0[0], v0[1]); w.y = cvt_pk_bf16(v0[2], v0[3]); w.z = cvt_pk_bf16(v1[0], v1[1]); w.w = cvt_pk_bf16(v1[2], v1[3]);
                        float ss = (v0[0] * v0[0] + v0[1] * v0[1]) + (v0[2] * v0[2] + v0[3] * v0[3]) + (v1[0] * v1[0] + v1[1] * v1[1]) + (v1[2] * v1[2] + v1[3] * v1[3]);
                        ss += __shfl_xor(ss, 16); ss += __shfl_xor(ss, 32); nm = fmaxf(nm, ss);
                        if (u.pn == 0) *(u32x4*)(qbase + (ai * HALF + m * 16) * 64 + 32 * bj) = w;
                        else *(u32x4*)(kbase + ai * (2 * TILE_E) + bj * 2560 + (16 * m) * 40) = w; }
                    __builtin_amdgcn_sched_barrier(0); }
            nm = fmaxf(nm, __shfl_xor(nm, 1)); nm = fmaxf(nm, __shfl_xor(nm, 2)); nm = fmaxf(nm, __shfl_xor(nm, 4)); nm = fmaxf(nm, __shfl_xor(nm, 8));
            if (fr == 0 && fq == 0) atomicMax(nmax + (b * 4 + wc) * 2 + u.pn, __builtin_bit_cast(unsigned, nm));
        }
    }
};
__device__ __forceinline__ float sigm(float x) { return __builtin_amdgcn_rcpf(1.f + __builtin_amdgcn_exp2f(-1.4426950408889634f * x)); }
struct EpiGate {
    static constexpr bool PERM = true;
    const bf16_t* P; bf16_t* Mg; const float* bias;
    __device__ __forceinline__ void operator()(const f32x4 (&acc)[2][2][4][2], const Unit& u, int wr, int wc, int fr, int fq) const {
        const int row0 = u.pm * BM + wr * 64 + fr, col0 = u.pn * BM + wc * 32 + 8 * fq; const int br = u.aux;
        const bf16_t* Pb = P + (size_t)br * 32768 * 1024; const float* bb = bias + br * 1024 + col0;
        f32x4 bv[2][2];
#pragma unroll
        for (int bj = 0; bj < 2; ++bj)
#pragma unroll
            for (int n = 0; n < 2; ++n) bv[bj][n] = *(const f32x4*)(bb + bj * HALF + 4 * n);
#pragma unroll
        for (int ai = 0; ai < 2; ++ai)
#pragma unroll
            for (int m = 0; m < 4; ++m) { const size_t ro = (size_t)(row0 + ai * HALF + m * 16) * 1024 + col0;
#pragma unroll
                for (int bj = 0; bj < 2; ++bj) {
                    const u32x4 pw = *(const u32x4*)(Pb + ro + bj * HALF);
                    u32x4 mw = {0u, 0u, 0u, 0u}; if (br != 0) mw = *(const u32x4*)(Mg + ro + bj * HALF);
                    float o[8];
#pragma unroll
                    for (int q = 0; q < 4; ++q) {
                        const float g0 = sigm(acc[ai][bj][m][q >> 1][(q & 1) * 2] + bv[bj][q >> 1][(q & 1) * 2]), g1 = sigm(acc[ai][bj][m][q >> 1][(q & 1) * 2 + 1] + bv[bj][q >> 1][(q & 1) * 2 + 1]);
                        o[2 * q] = g0 * __builtin_bit_cast(float, pw[q] << 16) + __builtin_bit_cast(float, mw[q] << 16);
                        o[2 * q + 1] = g1 * __builtin_bit_cast(float, pw[q] & 0xffff0000u) + __builtin_bit_cast(float, mw[q] & 0xffff0000u);
                    }
                    u32x4 w; w.x = cvt_pk_bf16(o[0], o[1]); w.y = cvt_pk_bf16(o[2], o[3]); w.z = cvt_pk_bf16(o[4], o[5]); w.w = cvt_pk_bf16(o[6], o[7]);
                    *(u32x4*)(Mg + ro + bj * HALF) = w; } }
    }
};
struct SchedGateP {
    int vcu, G; const char* ws; size_t oH, oWm, oO4, oWb4;
    __device__ __forceinline__ bool next(int i, Unit& u) const {
        const int tg = vcu + G * (i >> 3); if (tg >= 512) return false;
        const int br = (i >> 1) & 3, isg = i & 1;
        u.pm = tg >> 2; u.pn = tg & 3; u.rows = nullptr;
        if (isg) { u.aux = br; u.nt = 16; u.a = ws + oH + (size_t)u.pm * 256 * 1024 * 2; u.b = ws + oWm + ((size_t)br * 1024 + (size_t)u.pn * 256) * 1024 * 2; }
        else { u.aux = br | 4; u.nt = 4; u.a = ws + oO4 + (size_t)u.pm * 256 * 1024 * 2 + br * 512; u.b = ws + oWb4 + (size_t)u.pn * 256 * 1024 * 2 + br * 512; }
        return true;
    }
    __device__ __forceinline__ void a_ready(const Unit&) const {}
    __device__ __forceinline__ void done(const Unit&) const {}
};
struct EpiGateP {
    static constexpr bool PERM = true;
    bf16_t* Pscr; bf16_t* Mg; const float* bias; int tid;
    __device__ __forceinline__ void operator()(const f32x4 (&acc)[2][2][4][2], const Unit& u, int wr, int wc, int fr, int fq) const {
        u32x4* ps = (u32x4*)Pscr + tid;
        if (u.aux & 4) {
#pragma unroll
            for (int ai = 0; ai < 2; ++ai)
#pragma unroll
                for (int m = 0; m < 4; ++m)
#pragma unroll
                    for (int bj = 0; bj < 2; ++bj) { const f32x4 v0 = acc[ai][bj][m][0], v1 = acc[ai][bj][m][1];
                        u32x4 w; w.x = cvt_pk_bf16(v0[0], v0[1]); w.y = cvt_pk_bf16(v0[2], v0[3]); w.z = cvt_pk_bf16(v1[0], v1[1]); w.w = cvt_pk_bf16(v1[2], v1[3]);
                        ps[((ai * 4 + m) * 2 + bj) * 512] = w; }
            return;
        }
        int fr_ = fr, fq_ = fq; asm volatile("" : "+v"(fr_), "+v"(fq_));
        const int row0 = u.pm * BM + wr * 64 + fr_, col0 = u.pn * BM + wc * 32 + 8 * fq_; const int br = u.aux;
        const float* bb = bias + br * 1024 + col0;
#pragma unroll
        for (int ai = 0; ai < 2; ++ai)
#pragma unroll
            for (int m = 0; m < 4; ++m) { const size_t ro = (size_t)(row0 + ai * HALF + m * 16) * 1024 + col0;
#pragma unroll
                for (int bj = 0; bj < 2; ++bj) {
                    const f32x4 b0 = *(const f32x4*)(bb + bj * HALF), b1 = *(const f32x4*)(bb + bj * HALF + 4);
                    const u32x4 pw = ps[((ai * 4 + m) * 2 + bj) * 512];
                    u32x4 mw = {0u, 0u, 0u, 0u}; if (br != 0) mw = *(const u32x4*)(Mg + ro + bj * HALF);
                    const f32x4 a0 = acc[ai][bj][m][0] + b0, a1 = acc[ai][bj][m][1] + b1;
                    float o[8];
                    o[0] = sigm(a0[0]) * __builtin_bit_cast(float, pw[0] << 16) + __builtin_bit_cast(float, mw[0] << 16);
                    o[1] = sigm(a0[1]) * __builtin_bit_cast(float, pw[0] & 0xffff0000u) + __builtin_bit_cast(float, mw[0] & 0xffff0000u);
                    o[2] = sigm(a0[2]) * __builtin_bit_cast(float, pw[1] << 16) + __builtin_bit_cast(float, mw[1] << 16);
                    o[3] = sigm(a0[3]) * __builtin_bit_cast(float, pw[1] & 0xffff0000u) + __builtin_bit_cast(float, mw[1] & 0xffff0000u);
                    o[4] = sigm(a1[0]) * __builtin_bit_cast(float, pw[2] << 16) + __builtin_bit_cast(float, mw[2] << 16);
                    o[5] = sigm(a1[1]) * __builtin_bit_cast(float, pw[2] & 0xffff0000u) + __builtin_bit_cast(float, mw[2] & 0xffff0000u);
                    o[6] = sigm(a1[2]) * __builtin_bit_cast(float, pw[3] << 16) + __builtin_bit_cast(float, mw[3] << 16);
                    o[7] = sigm(a1[3]) * __builtin_bit_cast(float, pw[3] & 0xffff0000u) + __builtin_bit_cast(float, mw[3] & 0xffff0000u);
                    u32x4 w; w.x = cvt_pk_bf16(o[0], o[1]); w.y = cvt_pk_bf16(o[2], o[3]); w.z = cvt_pk_bf16(o[4], o[5]); w.w = cvt_pk_bf16(o[6], o[7]);
                    *(u32x4*)(Mg + ro + bj * HALF) = w;
                    __builtin_amdgcn_sched_barrier(0); } }
    }
};
template <bool F8 = false> struct EpiSwiGLU {
    static constexpr bool PERM = true;
    bf16_t* O; int ldc;
    __device__ __forceinline__ void operator()(const f32x4 (&acc)[2][2][4][2], const Unit& u, int wr, int wc, int fr, int fq) const {
        const int row0 = u.pm * BM + wr * 64 + fr, col0 = u.pn * HALF + wc * 32 + 8 * fq;
#pragma unroll
        for (int ai = 0; ai < 2; ++ai)
#pragma unroll
            for (int m = 0; m < 4; ++m) {
                float o[8]; constexpr float isc = F8 ? (1.f / 64.f) : 1.f;
#pragma unroll
                for (int n = 0; n < 2; ++n)
#pragma unroll
                    for (int q = 0; q < 4; ++q) { const float g = acc[ai][0][m][n][q] * isc, up = acc[ai][1][m][n][q] * isc; o[4 * n + q] = g * sigm(g) * up; }
                if constexpr (F8) { int w0 = __builtin_amdgcn_cvt_pk_fp8_f32(o[0], o[1], 0, false); w0 = __builtin_amdgcn_cvt_pk_fp8_f32(o[2], o[3], w0, true);
                    int w1 = __builtin_amdgcn_cvt_pk_fp8_f32(o[4], o[5], 0, false); w1 = __builtin_amdgcn_cvt_pk_fp8_f32(o[6], o[7], w1, true);
                    u32x2 w = {(unsigned)w0, (unsigned)w1}; *(u32x2*)((unsigned char*)O + (size_t)(row0 + ai * HALF + m * 16) * ldc + col0) = w; }
                else { bf16_t* rowp = O + (size_t)(row0 + ai * HALF + m * 16) * ldc + col0;
                    u32x4 w; w.x = cvt_pk_bf16(o[0], o[1]); w.y = cvt_pk_bf16(o[2], o[3]); w.z = cvt_pk_bf16(o[4], o[5]); w.w = cvt_pk_bf16(o[6], o[7]);
                    *(u32x4*)rowp = w; } }
    }
};
}

namespace att {
constexpr int SLOT = 19456, NSLOT = 6;
constexpr int ATTN_LDS = NSLOT * SLOT;
__device__ __forceinline__ unsigned cvtpk(float lo, float hi) { typedef float f2 __attribute__((ext_vector_type(2))); typedef __bf16 b2 __attribute__((ext_vector_type(2))); f2 v = {lo, hi}; b2 b = __builtin_convertvector(v, b2); return __builtin_bit_cast(unsigned, b); }
#define ATT_WAITV(n) asm volatile("s_waitcnt vmcnt(" #n ")" ::: "memory")
__device__ __forceinline__ float max3f(float a, float b, float c) { float r; asm("v_max3_f32 %0, %1, %2, %3" : "=v"(r) : "v"(a), "v"(b), "v"(c)); return r; }

#define ATT_SOFTMAX(s0, s1, pw, LS) do { \
    asm volatile("s_nop 15\n\ts_nop 7" : "+v"(s0), "+v"(s1)); \
    float rm = max3f(s0[0], s0[1], s1[0]), rm2 = max3f(s0[2], s0[3], s1[1]); rm = max3f(rm, s1[2], s1[3]); \
    _Pragma("unroll") for (int r = 4; r < 16; r += 4) { rm = max3f(rm, s0[r], s0[r + 1]); rm2 = max3f(rm2, s0[r + 2], s0[r + 3]); rm = max3f(rm, s1[r], s1[r + 1]); rm2 = max3f(rm2, s1[r + 2], s1[r + 3]); } \
    rm = fmaxf(rm, rm2); \
    { auto rr = __builtin_amdgcn_permlane32_swap(__builtin_bit_cast(unsigned, rm), __builtin_bit_cast(unsigned, rm), false, false); rm = fmaxf(__builtin_bit_cast(float, rr[0]), __builtin_bit_cast(float, rr[1])); } \
    if (__any(rm > 8.f)) { \
        const float dd = fmaxf(rm, 0.f); R += dd; \
        const float f = fast_exp2(-dd); l1 *= f; l2 *= f; \
        _Pragma("unroll") for (int r = 0; r < 16; ++r) { s0[r] -= dd; s1[r] -= dd; c0[r] -= dd; c1[r] -= dd; O1[0][r] *= f; O1[1][r] *= f; O2[0][r] *= f; O2[1][r] *= f; } \
        p1scale = f; \
    } \
    { float sa_ = 0.f, sb_ = 0.f; _Pragma("unroll") for (int r = 0; r < 16; ++r) { s0[r] = fast_exp2(s0[r]); s1[r] = fast_exp2(s1[r]); sa_ += s0[r]; sb_ += s1[r]; } LS += sa_ + sb_; } \
    _Pragma("unroll") for (int e = 0; e < 4; ++e) { pw[0][e] = cvtpk(s0[2 * e], s0[2 * e + 1]); pw[1][e] = cvtpk(s0[8 + 2 * e], s0[8 + 2 * e + 1]); pw[2][e] = cvtpk(s1[2 * e], s1[2 * e + 1]); pw[3][e] = cvtpk(s1[8 + 2 * e], s1[8 + 2 * e + 1]); } \
} while (0)

__device__ __forceinline__ void attn_unit(Frame& F, const int layer, const int b, const int h, const int qb) {
    const int lane = F.lane, r32 = lane & 31, hi = lane >> 5, wid = F.wave;
    LAS unsigned char* L = F.lds + RING_OFF;
    const int qw0 = qb * 256 + wid * 32, q = qw0 + r32;
    const float slope2 = exp2f(-2.f * (float)(h + 1)) * 1.4426950408889634f;
    int tlo, thi;
    { const unsigned* nm = (const unsigned*)(F.ctl + CW_NMAX) + layer * 16 + (b * 4 + h) * 2;
      const float qn = sqrtf(__builtin_bit_cast(float, __hip_atomic_load(nm, RLX_AGENT))) * 1.01f, kn = sqrtf(__builtin_bit_cast(float, __hip_atomic_load(nm + 1, RLX_AGENT))) * 1.01f;
      const float wf = (160.f + 2.f * qn * kn) / slope2; const int W = wf > 100000.f ? 100000 : (int)wf + 1;
      const int lo = qb * 256 - W, hi_ = qb * 256 + 255 + W; tlo = lo < 0 ? 0 : (lo >> 6); thi = hi_ >= SEQ ? (SEQ / 64 - 1) : (hi_ >> 6);
      if (((thi - tlo + 1) & 1) != 0) { if (thi < SEQ / 64 - 1) ++thi; else --tlo; } }
    const int nP = (thi - tlo + 1) >> 1;
    const bf16* Qp = (const bf16*)(F.ws + WS_QB) + ((size_t)(b * 4 + h) * SEQ + q) * 64;
    bf16x8 q1f[2], q2f[2];
#pragma unroll
    for (int ks = 0; ks < 2; ++ks) { q1f[ks] = *(const GAS bf16x8*)(Qp + 16 * ks + 8 * hi); q2f[ks] = *(const GAS bf16x8*)(Qp + 32 + 16 * ks + 8 * hi); }
    const unsigned char* kvbase = F.ws + WS_KV + ((size_t)(b * 4 + h) * 256) * SLOT + (size_t)wid * 1024 + lane * 16;
    const bool w3 = wid < 3;
#define ATT_DMA1(t, slot) do { const unsigned char* g_ = kvbase + (size_t)(t) * SLOT; LAS unsigned char* d_ = L + (slot) * SLOT + wid * 1024; \
        __builtin_amdgcn_global_load_lds((const unsigned*)g_, (LAS unsigned*)d_, 16, 0, 0); __builtin_amdgcn_global_load_lds((const unsigned*)(g_ + 8192), (LAS unsigned*)(d_ + 8192), 16, 0, 0); \
        if (w3) __builtin_amdgcn_global_load_lds((const unsigned*)(g_ + 16384), (LAS unsigned*)(d_ + 16384), 16, 0, 0); } while (0)
#define ATT_DMA2(pr, ps) do { ATT_DMA1(tlo + 2 * (pr), 2 * (ps)); ATT_DMA1(tlo + 2 * (pr) + 1, 2 * (ps) + 1); } while (0)
    asm volatile("s_waitcnt vmcnt(0)" ::: "memory");
    ATT_DMA2(0, 0);
    if (nP > 1) ATT_DMA2(1, 1);
    float R = 0.f, l1 = 0.f, l2 = 0.f;
    f32x16 O1[2], O2[2];
#pragma unroll
    for (int i = 0; i < 16; ++i) { O1[0][i] = 0.f; O1[1][i] = 0.f; O2[0][i] = 0.f; O2[1][i] = 0.f; }
    const int pr32 = (r32 & 0x13) | ((r32 & 4) << 1) | ((r32 & 8) >> 1);
    const int kfo = pr32 * 80 + hi * 16;
    const int vfo = 10240 + r32 * 144 + hi * 16;
    int ps = 0;
    for (int ip = 0; ip < nP; ++ip) {
        if (ip + 1 < nP) { if (w3) ATT_WAITV(6); else ATT_WAITV(4); } else ATT_WAITV(0);
        __builtin_amdgcn_s_barrier();
        asm volatile("" ::: "memory");
        if (ip + 2 < nP) { const int s2 = ps >= 1 ? ps - 1 : 2; ATT_DMA2(ip + 2, s2); }
#pragma unroll
        for (int half = 0; half < 2; ++half) {
            const int t = tlo + 2 * ip + half;
            const LAS unsigned char* Bf = L + (2 * ps + half) * SLOT;
            const float dl = (float)(q - t * 64 - 8 * hi);
            v4u pw1[4], pw2[4];
            const bf16x8 ka00 = *(const LAS bf16x8*)(Bf + kfo), ka01 = *(const LAS bf16x8*)(Bf + kfo + 32), ka10 = *(const LAS bf16x8*)(Bf + 32 * 80 + kfo), ka11 = *(const LAS bf16x8*)(Bf + 32 * 80 + kfo + 32);
            const bf16x8 kb00 = *(const LAS bf16x8*)(Bf + 5120 + kfo), kb01 = *(const LAS bf16x8*)(Bf + 5120 + kfo + 32), kb10 = *(const LAS bf16x8*)(Bf + 5120 + 32 * 80 + kfo), kb11 = *(const LAS bf16x8*)(Bf + 5120 + 32 * 80 + kfo + 32);
            f32x16 c0, c1;
            if (t * 64 + 63 < qw0) {
                const float tl = -slope2 * dl - R;
#pragma unroll
                for (int r = 0; r < 16; ++r) { const float cc = (float)(16 * (r >> 3) + (r & 7)); c0[r] = __builtin_fmaf(slope2, cc, tl); c1[r] = __builtin_fmaf(slope2, cc + 32.f, tl); }
            } else if (t * 64 > qw0 + 31) {
                const float tr = slope2 * dl - R;
#pragma unroll
                for (int r = 0; r < 16; ++r) { const float cc = (float)(16 * (r >> 3) + (r & 7)); c0[r] = __builtin_fmaf(-slope2, cc, tr); c1[r] = __builtin_fmaf(-slope2, cc + 32.f, tr); }
            } else {
#pragma unroll
                for (int r = 0; r < 16; ++r) { const float cc = (float)(16 * (r >> 3) + (r & 7)); c0[r] = __builtin_fmaf(-slope2, __builtin_fabsf(dl - cc), -R); c1[r] = __builtin_fmaf(-slope2, __builtin_fabsf(dl - (cc + 32.f)), -R); }
            }
            {
                f32x16 s0 = __builtin_amdgcn_mfma_f32_32x32x16_bf16(ka00, q1f[0], c0, 0, 0, 0); s0 = __builtin_amdgcn_mfma_f32_32x32x16_bf16(ka01, q1f[1], s0, 0, 0, 0);
                f32x16 s1 = __builtin_amdgcn_mfma_f32_32x32x16_bf16(ka10, q1f[0], c1, 0, 0, 0); s1 = __builtin_amdgcn_mfma_f32_32x32x16_bf16(ka11, q1f[1], s1, 0, 0, 0);
                float p1scale = 1.f; ATT_SOFTMAX(s0, s1, pw1, l1); (void)p1scale;
            }
            bf16x8 vf[2][4];
            {
                f32x16 s0 = __builtin_amdgcn_mfma_f32_32x32x16_bf16(kb00, q2f[0], c0, 0, 0, 0); s0 = __builtin_amdgcn_mfma_f32_32x32x16_bf16(kb01, q2f[1], s0, 0, 0, 0);
                f32x16 s1 = __builtin_amdgcn_mfma_f32_32x32x16_bf16(kb10, q2f[0], c1, 0, 0, 0); s1 = __builtin_amdgcn_mfma_f32_32x32x16_bf16(kb11, q2f[1], s1, 0, 0, 0);
#pragma unroll
                for (int db = 0; db < 2; ++db)
#pragma unroll
                    for (int ks = 0; ks < 4; ++ks) vf[db][ks] = *(const LAS bf16x8*)(Bf + vfo + db * 32 * 144 + ks * 32);
                float p1scale = 1.f; ATT_SOFTMAX(s0, s1, pw2, l2);
                if (__any(p1scale != 1.f)) {
#pragma unroll
                    for (int ks = 0; ks < 4; ++ks)
#pragma unroll
                        for (int e = 0; e < 4; ++e) { const unsigned w = pw1[ks][e]; pw1[ks][e] = cvtpk(bflo(w) * p1scale, bfhi(w) * p1scale); }
                }
            }
#pragma unroll
            for (int db = 0; db < 2; ++db)
#pragma unroll
                for (int ks = 0; ks < 4; ++ks) {
                    O1[db] = __builtin_amdgcn_mfma_f32_32x32x16_bf16(vf[db][ks], __builtin_bit_cast(bf16x8, pw1[ks]), O1[db], 0, 0, 0);
                    O2[db] = __builtin_amdgcn_mfma_f32_32x32x16_bf16(vf[db][ks], __builtin_bit_cast(bf16x8, pw2[ks]), O2[db], 0, 0, 0);
                }
        }
        ps = ps == 2 ? 0 : ps + 1;
    }
    l1 += __shfl_xor(l1, 32); l2 += __shfl_xor(l2, 32);
    const float* dlm = F.in[I_DLAMBDA] + layer * 128;
    float a1 = 0.f, a2 = 0.f;
#pragma unroll 8
    for (int i = 0; i < 32; ++i) { a1 += dlm[i] * dlm[32 + i]; a2 += dlm[64 + i] * dlm[96 + i]; }
    const float lam_init = 0.8f - 0.6f * __expf(-0.3f * (float)layer);
    const float lam = __expf(a1) - __expf(a2) + lam_init;
    const float i1 = 1.f / fmaxf(l1, 1e-30f), i2 = lam / fmaxf(l2, 1e-30f);
    float ss = 0.f;
#pragma unroll
    for (int db = 0; db < 2; ++db)
#pragma unroll
        for (int r = 0; r < 16; ++r) { const float v = O1[db][r] * i1 - O2[db][r] * i2; O1[db][r] = v; ss += v * v; }
    ss += __shfl_xor(ss, 32);
    const float rs = (1.f / sqrtf(ss * (1.f / 64.f) + EPS)) * (1.f - lam_init);
    bf16* orow = (bf16*)(F.ws + WS_O4) + ((size_t)b * SEQ + q) * 1024 + 64 * h;
    const float* sg = F.in[I_DSUBLN] + layer * 64;
#pragma unroll
    for (int db = 0; db < 2; ++db)
#pragma unroll
        for (int g4 = 0; g4 < 4; ++g4) {
            const int d0 = 32 * db + 8 * g4 + 4 * hi;
            const float v0 = O1[db][4 * g4] * rs * sg[d0], v1 = O1[db][4 * g4 + 1] * rs * sg[d0 + 1], v2 = O1[db][4 * g4 + 2] * rs * sg[d0 + 2], v3 = O1[db][4 * g4 + 3] * rs * sg[d0 + 3];
            v2u w = {pk2(v0, v1), pk2(v2, v3)};
            *(GAS v2u*)(orow + d0) = w;
        }
    asm volatile("s_waitcnt lgkmcnt(0)" ::: "memory");
    __builtin_amdgcn_s_barrier();
#undef ATT_DMA1
#undef ATT_DMA2
}
#undef ATT_SOFTMAX
#undef ATT_WAITV
}

namespace pc {
constexpr int MPITCH = 72;
__device__ __forceinline__ void pool_task(Frame& F, const int layer, const int tile, const int g, LAS unsigned char* mimg) {
    const int lane = F.lane, r32 = lane & 31, hi = lane >> 5;
    const bf16* P = (const bf16*)(F.ws + WS_PROJ);
    bf16* O4 = (bf16*)(F.ws + WS_O4);
    bf16x8 wf[2][4];
    { const float* W = F.in[I_POOLW] + ((size_t)layer * 4 + g) * 64 * 64;
#pragma unroll
      for (int nb = 0; nb < 2; ++nb)
#pragma unroll
          for (int ks = 0; ks < 4; ++ks) { v4u t;
#pragma unroll
              for (int jj = 0; jj < 4; ++jj) t[jj] = pk2(W[(16 * ks + 8 * hi + 2 * jj) * 64 + r32 + 32 * nb], W[(16 * ks + 8 * hi + 2 * jj + 1) * 64 + r32 + 32 * nb]);
              wf[nb][ks] = __builtin_bit_cast(bf16x8, t); } }
    const int t0 = tile * 64, s0 = t0 % SEQ, hw = 1 << g;
    const bf16* src = P + (size_t)t0 * PJ + C_PIN + 64 * g + lane;
    float cs[81]; cs[0] = 0.f;
#pragma unroll
    for (int i = 0; i < 80; ++i) { const int s = s0 - 8 + i; float v = 0.f; if (s >= 0 && s < SEQ) v = bf2f(src[(long)(i - 8) * PJ]); cs[i + 1] = cs[i] + v; }
#pragma unroll
    for (int i = 0; i < 64; ++i) {
        const int s = s0 + i; int lo = s - hw, hiw = s + hw; lo = lo < 0 ? 0 : lo; hiw = hiw > SEQ ? SEQ : hiw;
        float wsum = 0.f;
        if (g == 0) wsum = cs[i + 8 + 1] - cs[i + 8 - 1]; else if (g == 1) wsum = cs[i + 8 + 2] - cs[i + 8 - 2]; else if (g == 2) wsum = cs[i + 8 + 4] - cs[i + 8 - 4]; else wsum = cs[i + 8 + 8] - cs[i + 8 - 8];
        const float pv = cs[i + 9] - cs[i + 8];
        const float mval = wsum / (float)(hiw - lo) - pv;
        *(LAS unsigned short*)(mimg + i * (MPITCH * 2) + lane * 2) = (unsigned short)f2bf(mval);
    }
    LDS_WAIT();
#pragma unroll
    for (int tb = 0; tb < 2; ++tb) {
        bf16x8 af[4];
#pragma unroll
        for (int ks = 0; ks < 4; ++ks) af[ks] = *(const LAS bf16x8*)(mimg + (r32 + 32 * tb) * (MPITCH * 2) + (16 * ks + 8 * hi) * 2);
#pragma unroll
        for (int nb = 0; nb < 2; ++nb) {
            f32x16 acc;
#pragma unroll
            for (int r = 0; r < 16; ++r) acc[r] = 0.f;
#pragma unroll
            for (int ks = 0; ks < 4; ++ks) acc = __builtin_amdgcn_mfma_f32_32x32x16_bf16(af[ks], wf[nb][ks], acc, 0, 0, 0);
            const int e = r32 + 32 * nb; const float sc = F.in[I_POOLSCALE][layer * 256 + 64 * g + e];
#pragma unroll
            for (int r = 0; r < 16; ++r) { const int row = 32 * tb + (r & 3) + 8 * (r >> 2) + 4 * hi;
                O4[(size_t)(t0 + row) * 1024 + 256 + 64 * g + e] = (bf16)f2bf(acc[r] * sc); }
        }
    }
    LDS_WAIT();
}
__device__ __forceinline__ void conv_task(Frame& F, const int layer, const int tile, const int cg) {
    const int lane = F.lane;
    const bf16* P = (const bf16*)(F.ws + WS_PROJ);
    bf16* O4 = (bf16*)(F.ws + WS_O4);
    const int t0 = tile * 64, s0 = t0 % SEQ;
    const int ch = 64 * cg + lane;
    const float w0 = F.in[I_SCONVW][layer * 768 + ch], w1 = F.in[I_SCONVW][layer * 768 + 256 + ch], w2 = F.in[I_SCONVW][layer * 768 + 512 + ch];
    const bf16* base = P + (size_t)t0 * PJ + ch;
    float zm = 0.f, z0 = 0.f, zp = 0.f;
    if (s0 > 0) zm = bf2f(base[-(long)PJ + C_CC]) * bf2f(base[-(long)PJ + C_CX]);
    z0 = bf2f(base[C_CC]) * bf2f(base[C_CX]);
#pragma unroll 8
    for (int i = 0; i < 64; ++i) {
        zp = 0.f; if (s0 + i + 1 < SEQ) zp = bf2f(base[(long)(i + 1) * PJ + C_CC]) * bf2f(base[(long)(i + 1) * PJ + C_CX]);
        const float cbv = bf2f(base[(long)i * PJ + C_CB]);
        O4[(size_t)(t0 + i) * 1024 + 512 + ch] = (bf16)f2bf(cbv * (w0 * zm + w1 * z0 + w2 * zp));
        zm = z0; z0 = zp;
    }
}
}

namespace dl {
constexpr int MP = 72, MB = 64 * MP * 2;
constexpr int WAVE_LDS = 2 * MB + 2 * MB;
__device__ __forceinline__ int crow(int r, int hi) { return (r & 3) + 8 * (r >> 2) + 4 * hi; }
__device__ __forceinline__ bf16x8 ldfrag(const LAS unsigned char* img, int row, int col) { return *(const LAS bf16x8*)(img + row * (MP * 2) + col * 2); }
__device__ __forceinline__ bf16x8 ldfragp(const LAS unsigned char* img, int row, int col4) {
    const v2u lo = *(const LAS v2u*)(img + row * (MP * 2) + col4 * 2), hi8 = *(const LAS v2u*)(img + row * (MP * 2) + col4 * 2 + 16); const v4u t = {lo.x, lo.y, hi8.x, hi8.y}; return __builtin_bit_cast(bf16x8, t); }
__device__ __forceinline__ bf16x8 cfrag(const f32x16& x, int half) {
    v4u t;
#pragma unroll
    for (int e = 0; e < 4; ++e) t[e] = att::cvtpk(x[8 * half + 2 * e], x[8 * half + 2 * e + 1]);
    return __builtin_bit_cast(bf16x8, t); }
#define MFMA32(a, b, c) __builtin_amdgcn_mfma_f32_32x32x16_bf16((a), (b), (c), 0, 0, 0)
#define SB() __builtin_amdgcn_sched_barrier(0)
#define LAUNDER() do { asm volatile("" : "+v"(lane)); r32 = lane & 31; hi = lane >> 5; } while (0)
__device__ __forceinline__ f32x16 zero16() { f32x16 z;
#pragma unroll
    for (int r = 0; r < 16; ++r) z[r] = 0.f;
    return z; }

#define DL_CONV(colbase, wbase, RAW) do { \
    { const bf16* src_ = P + (size_t)tok0 * PJ + (colbase); const int rr_ = lane >> 3, ch_ = lane & 7; \
      _Pragma("unroll") for (int i_ = 0; i_ < 9; ++i_) { const int row_ = rr_ + 8 * i_; const int sq_ = s0 - 2 + row_; v4u t_ = {0u, 0u, 0u, 0u}; \
          if (row_ < 68 && sq_ >= 0 && sq_ < SEQ) t_ = *(const GAS v4u*)(src_ + (long)(row_ - 2) * PJ + ch_ * 8); if (row_ < 68) *(LAS v4u*)((RAW) + row_ * 128 + ch_ * 16) = t_; } } \
    LDS_WAIT(); \
    const float cw0 = cwp[(wbase) + lane], cw1 = cwp[768 + (wbase) + lane], cw2 = cwp[2 * 768 + (wbase) + lane], cw3 = cwp[3 * 768 + (wbase) + lane], cw4 = cwp[4 * 768 + (wbase) + lane]; \
    const LAS unsigned short* rw_ = (const LAS unsigned short*)(RAW) + lane; \
    _Pragma("unroll") for (int i = 0; i < 64; ++i) { \
        const float cv_ = cw0 * bf2f(rw_[i * 64]) + cw1 * bf2f(rw_[(i + 1) * 64]) + cw2 * bf2f(rw_[(i + 2) * 64]) + cw3 * bf2f(rw_[(i + 3) * 64]) + cw4 * bf2f(rw_[(i + 4) * 64]); \
        cval[i] = cv_ * sigmoidf_(cv_); if ((i & 7) == 7) SB(); } \
    LDS_WAIT(); } while (0)
#define DL_NORM(SQ, scale) do { \
    _Pragma("unroll") for (int i = 0; i < 64; ++i) *(LAS unsigned short*)((SQ) + i * 144 + lane * 2) = (unsigned short)f2bf(cval[i] * cval[i]); \
    LDS_WAIT(); \
    { float sm_ = 0.f; _Pragma("unroll") for (int c8 = 0; c8 < 8; ++c8) { const v4u w_ = *(const LAS v4u*)((SQ) + lane * 144 + c8 * 16); \
          sm_ += (bflo(w_.x) + bfhi(w_.x)) + (bflo(w_.y) + bfhi(w_.y)) + (bflo(w_.z) + bfhi(w_.z)) + (bflo(w_.w) + bfhi(w_.w)); } \
      tab[192 + lane] = (scale) / sqrtf(sm_ + EPS); } \
    LDS_WAIT(); \
    _Pragma("unroll") for (int i4 = 0; i4 < 16; ++i4) { const f32x4 r4_ = *(const LAS f32x4*)(tab + 192 + 4 * i4); cval[4 * i4] *= r4_.x; cval[4 * i4 + 1] *= r4_.y; cval[4 * i4 + 2] *= r4_.z; cval[4 * i4 + 3] *= r4_.w; } \
    } while (0)

__device__ __forceinline__ void d1_instance(Frame& F, const int layer, const int b, const int h, const int norig, const int dir, LAS unsigned char* W, LAS float* tab) {
    int lane = F.lane, r32, hi; LAUNDER();
    const bf16* P = (const bf16*)(F.ws + WS_PROJ);
    const float* cwp = F.in[I_DCONVW] + (size_t)layer * 5 * 768;
    const int s0 = norig * 64, tok0 = b * SEQ + s0;
    const int npr = dir ? 255 - norig : norig;
    const int inst = ((b * 4 + h) * 2 + dir) * NCHUNK + npr;
    LAS unsigned char* VT = W;
    LAS unsigned char* KT = W + MB;
    LAS unsigned char* KR = W + 2 * MB;
    LAS unsigned char* T2 = W + 3 * MB;
    LAS float* SM = (LAS float*)(W + 2 * MB);
    float cval[64];
    DL_CONV(C_DK + 64 * h, 256 + 64 * h, T2);
    DL_NORM(VT, 1.f);
#pragma unroll
    for (int i = 0; i < 64; ++i) { const int ip = dir ? 63 - i : i; const unsigned short kb = (unsigned short)f2bf(cval[i]);
        *(LAS unsigned short*)(KR + ip * (MP * 2) + lane * 2) = kb; *(LAS unsigned short*)(KT + lane * (MP * 2) + ip * 2) = kb; }
    LDS_WAIT();
    DL_CONV(C_DV + 64 * h, 512 + 64 * h, T2);
#pragma unroll
    for (int i = 0; i < 64; ++i) { const int ip = dir ? 63 - i : i; *(LAS unsigned short*)(VT + lane * (MP * 2) + ip * 2) = (unsigned short)f2bf(cval[i]); }
    const int mytok = tok0 + (dir ? 63 - lane : lane);
    const float* BD = (const float*)(F.ws + WS_BD) + (size_t)mytok * 16;
    const float beta = BD[dir * 4 + h]; float gc = BD[8 + dir * 4 + h];
#pragma unroll
    for (int o = 1; o < 64; o <<= 1) { const float t = __shfl_up(gc, o); if (lane >= o) gc += t; }
    const float gl = __shfl(gc, 63);
    tab[lane] = gc; tab[64 + lane] = beta; tab[128 + lane] = __expf(gl - gc);
    LDS_WAIT();
    LAUNDER();
    f32x16 kk[2][2];
#pragma unroll
    for (int tb = 0; tb < 2; ++tb)
#pragma unroll
        for (int tn = 0; tn < 2; ++tn) { f32x16 acc = zero16();
#pragma unroll
            for (int ks = 0; ks < 4; ++ks) acc = MFMA32(ldfrag(KR, r32 + 32 * tb, 16 * ks + 8 * hi), ldfrag(KR, r32 + 32 * tn, 16 * ks + 8 * hi), acc);
            kk[tb][tn] = acc; SB(); }
    LDS_WAIT();
#pragma unroll
    for (int tb = 0; tb < 2; ++tb)
#pragma unroll
        for (int tn = 0; tn < 2; ++tn) {
            const int jc = r32 + 32 * tn; const float gcj = tab[jc];
#pragma unroll
            for (int r = 0; r < 16; ++r) { const int ir = 32 * tb + crow(r, hi); const float gci = tab[ir], bi = tab[64 + ir];
                const float mv = (ir > jc) ? bi * kk[tb][tn][r] * __expf(gci - gcj) : 0.f; SM[ir * 64 + jc] = mv; } SB(); }
    LDS_WAIT();
    LAUNDER();
    float T[64];
#pragma unroll
    for (int i = 0; i < 64; ++i) {
        float a0 = (lane == i) ? 1.f : 0.f, a1 = 0.f, a2 = 0.f, a3 = 0.f;
#pragma unroll
        for (int j4 = 0; j4 < (i + 3) / 4; ++j4) { const f32x4 m4 = *(const LAS f32x4*)(SM + i * 64 + 4 * j4);
            if (4 * j4 + 0 < i) a0 = __builtin_fmaf(-m4[0], T[4 * j4 + 0], a0);
            if (4 * j4 + 1 < i) a1 = __builtin_fmaf(-m4[1], T[4 * j4 + 1], a1);
            if (4 * j4 + 2 < i) a2 = __builtin_fmaf(-m4[2], T[4 * j4 + 2], a2);
            if (4 * j4 + 3 < i) a3 = __builtin_fmaf(-m4[3], T[4 * j4 + 3], a3); }
        T[i] = (a0 + a1) + (a2 + a3); if ((i & 3) == 3) SB(); }
    LDS_WAIT();
    LAUNDER();
    { const float b1 = beta, b2 = beta * __expf(gc);
#pragma unroll
      for (int i = 0; i < 64; ++i) { *(LAS unsigned short*)(KR + i * (MP * 2) + lane * 2) = (unsigned short)f2bf(T[i] * b1); *(LAS unsigned short*)(T2 + i * (MP * 2) + lane * 2) = (unsigned short)f2bf(T[i] * b2); if ((i & 7) == 7) SB(); } }
    LDS_WAIT();
    LAUNDER();
    f32x16 u[2][2], w[2][2];
#pragma unroll
    for (int tb = 0; tb < 2; ++tb)
#pragma unroll
        for (int tn = 0; tn < 2; ++tn) { f32x16 au = zero16(), aw = zero16();
#pragma unroll
            for (int ks = 0; ks < 4; ++ks) { au = MFMA32(ldfrag(KR, r32 + 32 * tb, 16 * ks + 8 * hi), ldfrag(VT, r32 + 32 * tn, 16 * ks + 8 * hi), au);
                                             aw = MFMA32(ldfrag(T2, r32 + 32 * tb, 16 * ks + 8 * hi), ldfrag(KT, r32 + 32 * tn, 16 * ks + 8 * hi), aw); }
            u[tb][tn] = au; w[tb][tn] = aw; SB(); }
    LAUNDER();
    { unsigned* ud = (unsigned*)(F.ws + WS_UW + (size_t)inst * 16384); bf16* wd = (bf16*)(F.ws + WS_UW + (size_t)inst * 16384 + 8192);
#pragma unroll
      for (int tb = 0; tb < 2; ++tb)
#pragma unroll
          for (int tn = 0; tn < 2; ++tn) {
#pragma unroll
              for (int rp = 0; rp < 8; ++rp) ud[((tb * 2 + tn) * 8 + rp) * 64 + lane] = pk2(u[tb][tn][2 * rp], u[tb][tn][2 * rp + 1]);
#pragma unroll
              for (int r = 0; r < 16; ++r) wd[(32 * tb + crow(r, hi)) * 64 + r32 + 32 * tn] = (bf16)f2bf(w[tb][tn][r]); SB(); } }
    LAUNDER();
#pragma unroll
    for (int tb = 0; tb < 2; ++tb)
#pragma unroll
        for (int r = 0; r < 16; ++r) { const float e = tab[128 + 32 * tb + crow(r, hi)];
#pragma unroll
            for (int tn = 0; tn < 2; ++tn) { u[tb][tn][r] *= e; w[tb][tn][r] *= e; } }
    SB();
    bf16x8 kf[2][4];
#pragma unroll
    for (int tbb = 0; tbb < 2; ++tbb)
#pragma unroll
        for (int s = 0; s < 4; ++s) kf[tbb][s] = ldfragp(KT, r32 + 32 * tbb, 16 * s + 4 * hi);
    LDS_WAIT(); SB();
    LAUNDER();
    LAS unsigned char* AR = VT; LAS unsigned char* BT = KR;
#pragma unroll
    for (int tbb = 0; tbb < 2; ++tbb)
#pragma unroll
        for (int tx = 0; tx < 2; ++tx) { f32x16 aa = zero16(), ab = zero16();
#pragma unroll
            for (int s = 0; s < 4; ++s) { aa = MFMA32(cfrag(w[s >> 1][tx], s & 1), kf[tbb][s], aa); ab = MFMA32(kf[tbb][s], cfrag(u[s >> 1][tx], s & 1), ab); }
#pragma unroll
            for (int g4 = 0; g4 < 4; ++g4) {
                const v2u pa = {pk2(-aa[4 * g4], -aa[4 * g4 + 1]), pk2(-aa[4 * g4 + 2], -aa[4 * g4 + 3])};
                *(LAS v2u*)(AR + (r32 + 32 * tbb) * (MP * 2) + (32 * tx + 8 * g4 + 4 * hi) * 2) = pa;
                const v2u pb = {pk2(ab[4 * g4], ab[4 * g4 + 1]), pk2(ab[4 * g4 + 2], ab[4 * g4 + 3])};
                *(LAS v2u*)(BT + (r32 + 32 * tx) * (MP * 2) + (32 * tbb + 8 * g4 + 4 * hi) * 2) = pb;
            } SB(); }
    LDS_WAIT();
    LAUNDER();
    { unsigned char* ab = F.ws + WS_AB + (size_t)inst * 16384; const int m16 = lane & 15, g = lane >> 4;
#pragma unroll
      for (int rb = 0; rb < 4; ++rb)
#pragma unroll
          for (int ks = 0; ks < 2; ++ks) { const v2u lo = *(const LAS v2u*)(AR + (16 * rb + m16) * (MP * 2) + (32 * ks + 4 * g) * 2), hi8 = *(const LAS v2u*)(AR + (16 * rb + m16) * (MP * 2) + (32 * ks + 16 + 4 * g) * 2);
              const v4u t = {lo.x, lo.y, hi8.x, hi8.y}; *(GAS v4u*)(ab + ((rb * 2 + ks) * 64 + lane) * 16) = t; }
#pragma unroll
      for (int sl = 0; sl < 4; ++sl)
#pragma unroll
          for (int rb = 0; rb < 4; ++rb) { const v2u t = *(const LAS v2u*)(BT + (16 * sl + m16) * (MP * 2) + (16 * rb + 4 * g) * 2); *(GAS v2u*)(ab + 8192 + ((sl * 4 + rb) * 64 + lane) * 8) = t; } }
    if (lane == 0) ((float*)(F.ws + WS_DEC))[inst] = __expf(gl);
    LDS_WAIT();
}
__device__ __forceinline__ void pc_side_tasks(Frame& F, const int layer, const int half) {
    if (F.wave == 4) {
        LAS unsigned char* mimg = F.lds + RING_OFF + 4 * WAVE_LDS + 4096;
        for (int tile = F.vcu + half * F.G; tile < NTOK / 64; tile += 2 * F.G)
            for (int g = 0; g < 4; ++g) pc::pool_task(F, layer, tile, g, mimg);
    } else if (F.wave > 4) {
        int k = 0;
        for (int tile = F.vcu + half * F.G; tile < NTOK / 64; tile += 2 * F.G)
            for (int cg = 0; cg < 4; ++cg, ++k) if (k % 3 == F.wave - 5) pc::conv_task(F, layer, tile, cg);
    }
}
__device__ __forceinline__ void d1_phase(Frame& F, const int layer) {
    if (F.wave < 4) {
        LAS unsigned char* W = F.lds + RING_OFF + F.wave * WAVE_LDS; LAS float* tab = (LAS float*)(F.lds + RING_OFF + 4 * WAVE_LDS + F.wave * 1024);
        const int gw = F.vcu * 4 + F.wave, NGW = F.G * 4;
        for (int it = gw; it < NINST; it += NGW) { const int dir = it & 1, u = it >> 1; d1_instance(F, layer, u >> 10, (u >> 8) & 3, u & 255, dir, W, tab); }
    } else pc_side_tasks(F, layer, 0);
    __syncthreads();
}

typedef float f32x4v __attribute__((ext_vector_type(4)));
struct D2Regs { v4u af[4][2]; v2u bm[4]; float dcy; };
__device__ __forceinline__ void d2_chain(Frame& F, const int chain) {
    const int lane = F.lane, n16 = lane & 15, g = lane >> 4, sl = F.wave;
    f32x4v S[4];
#pragma unroll
    for (int rb = 0; rb < 4; ++rb) S[rb] = (f32x4v){0.f, 0.f, 0.f, 0.f};
    const unsigned char* abase = F.ws + WS_AB + (size_t)chain * NCHUNK * 16384;
    unsigned char* sbase = F.ws + WS_ST + (size_t)chain * NCHUNK * 8192;
    const float* dec = (const float*)(F.ws + WS_DEC) + chain * NCHUNK;
    D2Regs q0, q1, q2;
#define D2_LOAD(Q, n) do { const unsigned char* ab_ = abase + (size_t)(n) * 16384; \
    _Pragma("unroll") for (int rb = 0; rb < 4; ++rb) { _Pragma("unroll") for (int ks = 0; ks < 2; ++ks) Q.af[rb][ks] = *(const GAS v4u*)(ab_ + ((rb * 2 + ks) * 64 + lane) * 16); \
        Q.bm[rb] = *(const GAS v2u*)(ab_ + 8192 + ((sl * 4 + rb) * 64 + lane) * 8); } Q.dcy = dec[n]; } while (0)
#define D2_STEP(Q, n) do { \
    unsigned char* st = sbase + (size_t)(n) * 8192 + (16 * sl + n16) * 128; \
    _Pragma("unroll") for (int rb = 0; rb < 4; ++rb) { const v2u t = {pk2(S[rb][0], S[rb][1]), pk2(S[rb][2], S[rb][3])}; *(GAS v2u*)(st + (16 * rb + 4 * g) * 2) = t; } \
    bf16x8 bfr[2]; \
    _Pragma("unroll") for (int ks = 0; ks < 2; ++ks) { const v4u t = {att::cvtpk(S[2 * ks][0], S[2 * ks][1]), att::cvtpk(S[2 * ks][2], S[2 * ks][3]), att::cvtpk(S[2 * ks + 1][0], S[2 * ks + 1][1]), att::cvtpk(S[2 * ks + 1][2], S[2 * ks + 1][3])}; bfr[ks] = __builtin_bit_cast(bf16x8, t); } \
    _Pragma("unroll") for (int rb = 0; rb < 4; ++rb) { const float cd = Q.dcy; \
        f32x4v c = {S[rb][0] * cd + bflo(Q.bm[rb].x), S[rb][1] * cd + bfhi(Q.bm[rb].x), S[rb][2] * cd + bflo(Q.bm[rb].y), S[rb][3] * cd + bfhi(Q.bm[rb].y)}; \
        c = __builtin_amdgcn_mfma_f32_16x16x32_bf16(__builtin_bit_cast(bf16x8, Q.af[rb][0]), bfr[0], c, 0, 0, 0); \
        c = __builtin_amdgcn_mfma_f32_16x16x32_bf16(__builtin_bit_cast(bf16x8, Q.af[rb][1]), bfr[1], c, 0, 0, 0); \
        S[rb] = c; } } while (0)
    D2_LOAD(q0, 0); D2_LOAD(q1, 1);
    for (int n = 0; n < NCHUNK - 1; n += 3) {
        D2_LOAD(q2, n + 2); D2_STEP(q0, n); SB();
        D2_LOAD(q0, n + 3); D2_STEP(q1, n + 1); SB();
        if (n + 4 < NCHUNK) D2_LOAD(q1, n + 4); D2_STEP(q2, n + 2); SB();
    }
    D2_STEP(q0, NCHUNK - 1);
#undef D2_LOAD
#undef D2_STEP
}

__device__ __forceinline__ void scan_attn_phase(Frame& F, const int layer, const int qword) {
    for (;;) {
        { unsigned char* w_ = F.ws; int t_ = F.tid; asm volatile("" : "+s"(w_), "+v"(t_)); F.ws = w_; F.ctl = (gu32*)(w_ + WS_CTL); F.tid = t_; F.lane = t_ & 63; }
        if (F.tid == 0) F.MISC[16] = __hip_atomic_fetch_add(F.ctl + CW_ATTQ + 64 * qword, 1u, RLX_AGENT);
        __syncthreads();
        const int idx = (int)F.MISC[16];
        __syncthreads();
        if (idx >= 16 + BATCH * 4 * 64) break;
        if (idx < 16) { if (F.wave < 4) d2_chain(F, idx); }
        else { const int j = idx - 16, h = 3 - (j >> 7), jj = j & 127, b = jj & 1, k = jj >> 1, qb = (k & 1) ? 31 - (k >> 1) : 32 + (k >> 1);
            att::attn_unit(F, layer, b, h, qb); }
    }
    __syncthreads();
}

__device__ __forceinline__ void d3_unit(Frame& F, const int layer, const int b, const int h, const int norig, LAS unsigned char* W, LAS float* tab) {
    int lane = F.lane, r32, hi; LAUNDER();
    const bf16* P = (const bf16*)(F.ws + WS_PROJ);
    const float* cwp = F.in[I_DCONVW] + (size_t)layer * 5 * 768;
    const int s0 = norig * 64, tok0 = b * SEQ + s0;
    LAS unsigned char* QR = W;
    LAS unsigned char* KR = W + MB;
    LAS unsigned char* AT = W + 2 * MB;
    LAS unsigned char* WR = W + 3 * MB;
    { float cval[64];
      DL_CONV(C_DQ + 64 * h, 64 * h, WR);
      DL_NORM(AT, 0.125f);
#pragma unroll
      for (int i = 0; i < 64; ++i) *(LAS unsigned short*)(QR + i * (MP * 2) + lane * 2) = (unsigned short)f2bf(cval[i]);
      LDS_WAIT();
      DL_CONV(C_DK + 64 * h, 256 + 64 * h, WR);
      DL_NORM(AT, 1.f);
#pragma unroll
      for (int i = 0; i < 64; ++i) *(LAS unsigned short*)(KR + i * (MP * 2) + lane * 2) = (unsigned short)f2bf(cval[i]);
      LDS_WAIT(); }
    f32x16 of[2][2];
#pragma unroll
    for (int dir = 0; dir < 2; ++dir) {
        LAUNDER();
        const int npr = dir ? 255 - norig : norig;
        const int inst = ((b * 4 + h) * 2 + dir) * NCHUNK + npr;
        const int mytok = tok0 + (dir ? 63 - lane : lane);
        float gc = ((const float*)(F.ws + WS_BD))[(size_t)mytok * 16 + 8 + dir * 4 + h];
#pragma unroll
        for (int o = 1; o < 64; o <<= 1) { const float t = __shfl_up(gc, o); if (lane >= o) gc += t; }
        tab[lane] = gc; tab[64 + lane] = __expf(gc);
        { const unsigned char* wg = F.ws + WS_UW + (size_t)inst * 16384 + 8192;
#pragma unroll
          for (int i = 0; i < 8; ++i) { const int idx = i * 64 + lane, row = idx >> 3, ch = idx & 7; const v4u c = *(const GAS v4u*)(wg + idx * 16); *(LAS v4u*)(WR + row * (MP * 2) + ch * 16) = c; } }
        LDS_WAIT();
        LAUNDER();
        const int ra0 = dir ? 63 - r32 : r32, ra1 = dir ? 31 - r32 : 32 + r32;
        f32x16 qk[2][2];
#pragma unroll
        for (int tb = 0; tb < 2; ++tb)
#pragma unroll
            for (int tn = 0; tn < 2; ++tn) { f32x16 acc = zero16();
#pragma unroll
                for (int ks = 0; ks < 4; ++ks) acc = MFMA32(ldfrag(QR, tb ? ra1 : ra0, 16 * ks + 8 * hi), ldfrag(KR, tn ? ra1 : ra0, 16 * ks + 8 * hi), acc);
                qk[tb][tn] = acc; SB(); }
        LDS_WAIT();
#pragma unroll
        for (int tb = 0; tb < 2; ++tb)
#pragma unroll
            for (int tn = 0; tn < 2; ++tn) { const int jc = r32 + 32 * tn; const float gcj = tab[jc];
#pragma unroll
                for (int r = 0; r < 16; ++r) { const int ir = 32 * tb + crow(r, hi); const float gci = tab[ir];
                    const float av = (ir >= jc) ? qk[tb][tn][r] * __expf(gci - gcj) : 0.f; *(LAS unsigned short*)(AT + ir * (MP * 2) + jc * 2) = (unsigned short)f2bf(av); } SB(); }
        LDS_WAIT();
        LAUNDER();
        const unsigned* ud = (const unsigned*)(F.ws + WS_UW + (size_t)inst * 16384);
        const unsigned char* sg = F.ws + WS_ST + (size_t)inst * 8192;
#pragma unroll
        for (int tn = 0; tn < 2; ++tn) {
            bf16x8 sf[4];
#pragma unroll
            for (int ks = 0; ks < 4; ++ks) sf[ks] = *(const GAS bf16x8*)(sg + ((r32 + 32 * tn) * 64 + 16 * ks + 8 * hi) * 2);
            f32x16 vn[2], o[2];
#pragma unroll
            for (int tb = 0; tb < 2; ++tb) { f32x16 a1 = zero16(), a2 = zero16();
#pragma unroll
                for (int ks = 0; ks < 4; ++ks) { a1 = MFMA32(ldfrag(WR, r32 + 32 * tb, 16 * ks + 8 * hi), sf[ks], a1); a2 = MFMA32(ldfrag(QR, tb ? ra1 : ra0, 16 * ks + 8 * hi), sf[ks], a2); }
#pragma unroll
                for (int rp = 0; rp < 8; ++rp) { const unsigned uw = ud[((tb * 2 + tn) * 8 + rp) * 64 + lane]; a1[2 * rp] = bflo(uw) - a1[2 * rp]; a1[2 * rp + 1] = bfhi(uw) - a1[2 * rp + 1]; }
#pragma unroll
                for (int r = 0; r < 16; ++r) a2[r] *= tab[64 + 32 * tb + crow(r, hi)];
                vn[tb] = a1; o[tb] = a2; SB(); }
#pragma unroll
            for (int tb = 0; tb < 2; ++tb) { f32x16 acc = o[tb];
#pragma unroll
                for (int s = 0; s < 4; ++s) acc = MFMA32(ldfragp(AT, r32 + 32 * tb, 16 * s + 4 * hi), cfrag(vn[s >> 1], s & 1), acc);
                o[tb] = acc; SB(); }
            if (dir == 0) { of[0][tn] = o[0]; of[1][tn] = o[1]; }
            else {
#pragma unroll
                for (int tb = 0; tb < 2; ++tb)
#pragma unroll
                    for (int r = 0; r < 16; ++r) of[tb][tn][r] += __shfl_xor(o[1 - tb][15 - r], 32);
            }
        }
        LDS_WAIT();
    }
    const float* dn = F.in[I_DNORM] + layer * 64;
#pragma unroll
    for (int tb = 0; tb < 2; ++tb)
#pragma unroll
        for (int r = 0; r < 16; ++r) {
            float ss = of[tb][0][r] * of[tb][0][r] + of[tb][1][r] * of[tb][1][r];
#pragma unroll
            for (int o = 1; o < 32; o <<= 1) ss += __shfl_xor(ss, o);
            const float rs = 1.f / sqrtf(ss * (1.f / 64.f) + EPS);
            const int tok = tok0 + 32 * tb + crow(r, hi);
#pragma unroll
            for (int tn = 0; tn < 2; ++tn) { const int dv = r32 + 32 * tn; const float z = bf2f(P[(size_t)tok * PJ + C_DZ + 64 * h + dv]);
                ((bf16*)(F.ws + WS_O4))[(size_t)tok * 1024 + 768 + 64 * h + dv] = (bf16)f2bf(of[tb][tn][r] * rs * dn[dv] * siluf_(z)); }
        }
}
__device__ __forceinline__ void d3_phase(Frame& F, const int layer) {
    if (F.wave < 4) {
        LAS unsigned char* W = F.lds + RING_OFF + F.wave * WAVE_LDS; LAS float* tab = (LAS float*)(F.lds + RING_OFF + 4 * WAVE_LDS + F.wave * 1024);
        const int gw = F.vcu * 4 + F.wave, NGW = F.G * 4;
        for (int u = gw; u < BATCH * 4 * NCHUNK; u += NGW) d3_unit(F, layer, u >> 10, (u >> 8) & 3, u & 255, W, tab);
    } else pc_side_tasks(F, layer, 1);
    __syncthreads();
}
#undef MFMA32
}

#ifndef ONLY_SITE
#define ONLY_SITE -1
#endif
#define SITE(k) (ONLY_SITE < 0 || ONLY_SITE == (k))
#ifndef PROBE_MASK
#define PROBE_MASK 0
#endif
#ifndef PROBE_N
#define PROBE_N 2
#endif
#define REPEAT(k) for (int rep_ = 0; rep_ < (((PROBE_MASK >> (k)) & 1) ? PROBE_N : 1); ++rep_)
#ifndef MK_SPLIT
#define MK_SPLIT 0
#endif
struct Args { const float* in[30]; float* out; unsigned char* ws; int ph_lo, ph_hi; };
constexpr int N_PHASES = 1 + 16 * NLAYER + 1;

#define IN_PH() (pid >= lo && pid < hi)
#define FRESH() do { unsigned char* w_ = args.ws; float* o_ = args.out; int t_ = F.wave * 64 + (int)__builtin_amdgcn_mbcnt_hi(~0u, __builtin_amdgcn_mbcnt_lo(~0u, 0u)); asm volatile("" : "+s"(w_), "+s"(o_), "+v"(t_)); F.ws = w_; F.out = o_; F.ctl = (gu32*)(w_ + WS_CTL); F.tid = t_; F.lane = t_ & 63; } while (0)
#define SEAM() do { if (!MK_SPLIT && pid >= lo && pid + 1 < hi) xcd_barrier(bar); ++pid; } while (0)
#define NOSEAM() do { ++pid; } while (0)

template <int l> __device__ __forceinline__ void layer_phases(Frame& F, const Args& args, const XcdBarrier& bar, const int lo, const int hi, int& pid) {
    LAS unsigned char* ring = F.lds + RING_OFF;

        if constexpr (l == 0) { if (IN_PH() && SITE(1)) REPEAT(1) { FRESH(); p_rows<ROW_A>(F, 0); } SEAM(); } else { NOSEAM(); }
        if (IN_PH() && SITE(2)) REPEAT(2) { FRESH();
            pg8::SchedStd S; S.init(NTOK / 256, NPROJ / 256, F.G, (int)blockIdx.x, F.ws + WS_H, (size_t)256 * D * 2, w_in_t(F.ws, l), (size_t)256 * D * 2);
            pg8::EpiProj E{(bf16*)(F.ws + WS_QB), (bf16*)(F.ws + WS_KV), (bf16*)(F.ws + WS_PROJ), (unsigned*)(F.ctl + CW_NMAX) + l * 16, QSCALE};
            pg8::gemm_phase<pg8::EpiProj, pg8::SchedStd, D, D, D>(ring, F.tid, S, E);
        }
        SEAM();
        NOSEAM();
        if (IN_PH() && SITE(5)) REPEAT(5) { FRESH(); dl::d1_phase(F, l); }
        SEAM();
        if (IN_PH() && SITE(3)) REPEAT(3) { FRESH(); dl::scan_attn_phase(F, l, l * 2 + rep_); }
        SEAM();
        NOSEAM();
        if (IN_PH() && SITE(7)) REPEAT(7) { FRESH(); dl::d3_phase(F, l); }
        SEAM();
        NOSEAM();
        if (IN_PH() && SITE(9)) REPEAT(9) { FRESH();
            pg8::SchedGateP S{F.vcu, F.G, (const char*)F.ws, WS_H, WS_W + (size_t)l * SZ_LAYERW + SZ_WIN, WS_O4, WS_W + (size_t)l * SZ_LAYERW + SZ_WIN + SZ_WM};
            pg8::EpiGateP E{(bf16*)(F.ws + WS_PBUF) + (size_t)blockIdx.x * 65536, (bf16*)(F.ws + WS_MERGED), F.in[I_BMERGE] + (size_t)l * 4 * D, F.tid};
            pg8::gemm_phase<pg8::EpiGateP, pg8::SchedGateP, D, D, D>(ring, F.tid, S, E);
        }
        SEAM();
        if (IN_PH() && SITE(10)) REPEAT(10) { FRESH();
            pg8::SchedStd S; S.init(NTOK / 256, D / 256, F.G, (int)blockIdx.x, F.ws + WS_MERGED, (size_t)256 * D * 2, w_o_t(F.ws, l), (size_t)256 * D * 2);
            pg8::EpiStore E{(bf16*)(F.ws + WS_F), D, 0, 1.f};
            pg8::gemm_phase<pg8::EpiStore, pg8::SchedStd, D, D, D>(ring, F.tid, S, E);
        }
        SEAM();
        if (IN_PH() && SITE(11)) REPEAT(11) { FRESH(); p_rows<ROW_B>(F, l); }
        SEAM();
        if constexpr (l == 0) {
            if (IN_PH() && SITE(12)) REPEAT(12) { FRESH();
                pg8::SchedStd S; S.init(NTOK / 256, 2 * DFF / 256, F.G, (int)blockIdx.x, F.ws + WS_H, (size_t)256 * D * 2, F.ws + WS_WFFN, (size_t)256 * D * 2);
                pg8::EpiSwiGLU<false> E{(bf16*)(F.ws + WS_ACT0), DFF};
                pg8::gemm_phase<pg8::EpiSwiGLU<false>, pg8::SchedStd, D, D, D>(ring, F.tid, S, E);
            }
            SEAM();
            if (IN_PH() && SITE(13)) REPEAT(13) { FRESH();
                pg8::SchedStd S; S.init(NTOK / 256, D / 256, F.G, (int)blockIdx.x, F.ws + WS_ACT0, (size_t)256 * DFF * 2, F.ws + WS_WFFN + SZ_WGU, (size_t)256 * DFF * 2);
                pg8::EpiStore E{(bf16*)(F.ws + WS_F), D, 0, 1.f};
                pg8::gemm_phase<pg8::EpiStore, pg8::SchedStd, DFF, DFF, DFF>(ring, F.tid, S, E);
            }
            SEAM();
            if (IN_PH() && SITE(14)) REPEAT(14) { FRESH(); p_rows<ROW_C>(F, 0); }
            SEAM();
            NOSEAM(); NOSEAM();
        } else {
            if (IN_PH() && SITE(15)) REPEAT(15) { FRESH(); p_moe_cvt(F); }
            SEAM();
#pragma unroll 1
            for (int pass = 0; pass < MOE_NPASS; ++pass) {
                if (IN_PH() && SITE(16)) REPEAT(16) { FRESH();
                    constexpr int EB = MOE_FP8 ? 1 : 2;
                    pg8::SchedMoe S; S.c = (int)blockIdx.x; S.G = F.G; S.nN = 2 * DFF / 256; moe_tiles(F, S.cnt, S.tstart);
                    S.t0 = pass * MOE_PASS_TILES; S.t1 = S.tstart[8] < (pass + 1) * MOE_PASS_TILES ? S.tstart[8] : (pass + 1) * MOE_PASS_TILES;
                    S.lists = (const int*)(F.ws + WS_ROUTE + 1 * MiB); S.W = (const char*)(F.ws + WS_MOEW); S.w_tile = (size_t)256 * D * EB; S.exp_stride = SZ_FFNW / 2 * EB;
#if MOE_FP8
                    S.A = (const char*)(F.ws + WS_XG); S.gather = false; S.act_tile = (size_t)256 * D;
                    pg8::EpiSwiGLU<true> E{(bf16*)(F.ws + WS_ACT1), DFF};
                    pg8::gemm_phase<pg8::EpiSwiGLU<true>, pg8::SchedMoe, D / 2, D / 2, D / 2, false, true>(ring, F.tid, S, E);
#else
                    S.A = (const char*)(F.ws + WS_H2B); S.gather = true; S.act_tile = 0;
                    pg8::EpiSwiGLU<false> E{(bf16*)(F.ws + WS_ACT1), DFF};
                    pg8::gemm_phase<pg8::EpiSwiGLU<false>, pg8::SchedMoe, D, D, D, true, false>(ring, F.tid, S, E);
#endif
                }
                SEAM();
                if (IN_PH() && SITE(17)) REPEAT(17) { FRESH();
                    constexpr int EB = MOE_FP8 ? 1 : 2;
                    pg8::SchedMoe S; S.c = (int)blockIdx.x; S.G = F.G; S.nN = D / 256; moe_tiles(F, S.cnt, S.tstart);
                    S.t0 = pass * MOE_PASS_TILES; S.t1 = S.tstart[8] < (pass + 1) * MOE_PASS_TILES ? S.tstart[8] : (pass + 1) * MOE_PASS_TILES;
                    S.A = (const char*)(F.ws + WS_ACT1); S.lists = nullptr; S.W = (const char*)(F.ws + WS_MOEW + SZ_WGU / 2 * EB); S.w_tile = (size_t)256 * DFF * EB; S.gather = false;
                    S.exp_stride = SZ_FFNW / 2 * EB; S.act_tile = (size_t)256 * DFF * EB;
#if MOE_FP8
                    pg8::EpiStore64 E{(bf16*)(F.ws + WS_Y)};
                    pg8::gemm_phase<pg8::EpiStore64, pg8::SchedMoe, DFF * EB / 2, DFF * EB / 2, DFF * EB / 2, false, true>(ring, F.tid, S, E);
#else
                    pg8::EpiStore E{(bf16*)(F.ws + WS_Y), D, 0, 1.f};
                    pg8::gemm_phase<pg8::EpiStore, pg8::SchedMoe, DFF * EB / 2, DFF * EB / 2, DFF * EB / 2, false, false>(ring, F.tid, S, E);
#endif
                }
                SEAM();
            }
            if constexpr (MOE_NPASS == 1) { NOSEAM(); NOSEAM(); }
        }
    }

__global__ void __launch_bounds__(NWAVES * 64, 2) fwd_kernel(const Args args) {
    extern __shared__ __attribute__((aligned(16))) unsigned char lds[];
    Frame F;
    F.lds = (LAS unsigned char*)lds;
    F.MISC = (volatile LAS unsigned*)(F.lds + MISC_OFF);
    F.tid = threadIdx.x; F.lane = F.tid & 63; F.wave = __builtin_amdgcn_readfirstlane(F.tid >> 6);
    F.G = gridDim.x; { const int bx = blockIdx.x; F.vcu = (F.G % 8 == 0) ? (bx % 8) * (F.G / 8) + bx / 8 : bx; }
    F.ws = args.ws; F.out = args.out; F.ctl = (gu32*)(args.ws + WS_CTL);
    F.in = args.in;
    if (F.tid < 64) ((LAS unsigned*)(F.lds + MISC_OFF))[F.tid] = 0u;
    __syncthreads();
    XcdBarrier bar; bar.bar = (unsigned*)(F.ctl + CW_BAR); bar.x = 0; bar.st = nullptr;
    if (!MK_SPLIT) bar = xcd_barrier_post((unsigned*)(F.ctl + CW_BAR), F.MISC + 8);
    const int lo = args.ph_lo, hi = args.ph_hi;
    int pid = 0;
    LAS unsigned char* ring = F.lds + RING_OFF;

    if (IN_PH() && SITE(0)) REPEAT(0) { FRESH(); p_prologue(F); }
    SEAM();
    layer_phases<0>(F, args, bar, lo, hi, pid);
    layer_phases<1>(F, args, bar, lo, hi, pid);
    if (IN_PH() && SITE(18)) REPEAT(18) { FRESH(); p_rows<ROW_C>(F, 1); }
#undef IN_PH
#undef SEAM
#undef NOSEAM
}

extern "C" void kernel_launch(void* const* d_in, const int* in_sizes, int n_in, void* d_out, int out_size, void* d_ws, size_t ws_size, hipStream_t stream) {
    static int grid = 0;
    if (grid == 0) {
        if (n_in != N_INPUTS || in_sizes[0] != NTOK * D || out_size != NTOK * D || ws_size < WS_END) {
            fprintf(stderr, "kernel_launch: unexpected problem (n_in %d, in0 %d, out %d, ws %zu < %zu); nothing launched\n", n_in, n_in > 0 ? in_sizes[0] : -1, out_size, ws_size, (size_t)WS_END); grid = -1; return; }
        int dev = 0, cus = 0, per_cu = 0;
        if (hipGetDevice(&dev) != hipSuccess || hipDeviceGetAttribute(&cus, hipDeviceAttributeMultiprocessorCount, dev) != hipSuccess) { grid = -1; return; }
        if (hipFuncSetAttribute((const void*)fwd_kernel, hipFuncAttributeMaxDynamicSharedMemorySize, LDS_BYTES) != hipSuccess) { fprintf(stderr, "kernel_launch: hipFuncSetAttribute failed\n"); grid = -1; return; }
        if (hipOccupancyMaxActiveBlocksPerMultiprocessor(&per_cu, (const void*)fwd_kernel, NWAVES * 64, LDS_BYTES) != hipSuccess || per_cu < 1)
            fprintf(stderr, "kernel_launch: note: occupancy query reports %d workgroups per CU\n", per_cu);
        (void)hipGetLastError();
        grid = cus;
    }
    if (grid < 0) return;
    if (hipMemsetAsync((char*)d_ws + WS_CTL, 0, CTL_ZERO_BYTES, stream) != hipSuccess) return;
    Args a{};
    for (int i = 0; i < 30; ++i) a.in[i] = (const float*)d_in[i];
    a.out = (float*)d_out; a.ws = (unsigned char*)d_ws;
#if MK_SPLIT
    for (int p = 0; p < N_PHASES; ++p) { a.ph_lo = p; a.ph_hi = p + 1; hipLaunchKernelGGL(fwd_kernel, dim3(grid), dim3(NWAVES * 64), LDS_BYTES, stream, a); }
#else
    a.ph_lo = 0; a.ph_hi = N_PHASES;
    hipLaunchKernelGGL(fwd_kernel, dim3(grid), dim3(NWAVES * 64), LDS_BYTES, stream, a);
#endif
}
```

```cpp
#include <hip/hip_runtime.h>
#include <cstdio>
#include <cstdint>

namespace pg8 {
#define PG8_LAS __attribute__((address_space(3)))
typedef unsigned short bf16_t;
typedef short bf16x8 __attribute__((ext_vector_type(8)));
typedef float f32x4 __attribute__((ext_vector_type(4)));
typedef unsigned u32x4 __attribute__((ext_vector_type(4)));
typedef unsigned u32x2 __attribute__((ext_vector_type(2)));
typedef int i32x4 __attribute__((ext_vector_type(4)));
constexpr int BM = 256, BK = 64, HALF = 128, HTB = HALF * BK * 2  , STAGE_BYTES = 8 * HTB;

__host__ __device__ __forceinline__ int lds_byte(int r, int c) { const int st = (r >> 4) * 2 + (c >> 5), rr = r & 15, cc = c & 31, ob = rr * 64 + cc * 2; return st * 1024 + (ob ^ (((ob >> 9) & 1) << 5)); }
__host__ __device__ __forceinline__ void stage_rc(int b, int& R, int& C) { const int st = b / 1024, sb = b % 1024, swz = sb ^ (((sb >> 9) & 1) << 5); R = (st >> 1) * 16 + swz / 64; C = (st & 1) * 32 + (swz % 64) / 2; }
__host__ __device__ __forceinline__ int perm32(int rho) { const int n = rho >> 4, i = rho & 15; return 8 * (i >> 2) + 4 * n + (i & 3); }

struct Unit { int pm, pn, aux, nt; const char* a; const char* b; const int* rows; };

__device__ __forceinline__ unsigned cvt_pk_bf16(float lo, float hi) { unsigned r; asm volatile("v_cvt_pk_bf16_f32 %0, %1, %2" : "=v"(r) : "v"(lo), "v"(hi)); return r; }


__device__ __forceinline__ const char* uniform_ptr(const char* p) { const unsigned long long v = (unsigned long long)p; return (const char*)(((unsigned long long)(unsigned)__builtin_amdgcn_readfirstlane((int)(v >> 32)) << 32) | (unsigned)__builtin_amdgcn_readfirstlane((int)(unsigned)v)); }
template <class Epi, class Sched, int K, int lda, int ldb, bool GATHER = false, bool FP8 = false, bool ALIGN_EPI = true, bool SP2 = true>
__device__ __forceinline__ void gemm_phase(PG8_LAS unsigned char* lds, const int tid, const Sched& S, const Epi& E) {
    const int wid = __builtin_amdgcn_readfirstlane(tid >> 6), lane = tid & 63, wr = wid >> 2, wc = wid & 3, fr = lane & 15, fq = lane >> 4;
    constexpr int ntK = K / BK;
    int Rs[2], Cs[2]; unsigned voffB[2];
#pragma unroll
    for (int i = 0; i < 2; ++i) { int R, C; stage_rc(tid * 16 + i * 8192, R, C); const int Rb = Epi::PERM ? ((R & ~31) + perm32(R & 31)) : R; Rs[i] = R; Cs[i] = C; voffB[i] = (unsigned)(Rb * ldb + C) * 2u; }
    const size_t kstep = (size_t)(BK * 2);
    const size_t hstepB = (size_t)HALF * ldb * 2;
    constexpr unsigned hstepA = GATHER ? 0u : (unsigned)HALF * lda * 2u;
    const unsigned ldsw = (unsigned)wid * 1024u;
    const int aoff = lds_byte(wr * 64 + fr, fq * 8), boff = lds_byte(wc * 32 + fr, fq * 8);
#define PG8_SA(b, h) (((b) * 2 + (h)) * HTB)
#define PG8_SB(b, h) ((4 + (b) * 2 + (h)) * HTB)
#define PG8_RSRC(p) __builtin_amdgcn_make_buffer_rsrc((void*)pg8::uniform_ptr((const char*)(p)), 0, 0x7fffffff, 0x00020000)
#define PG8_STAGE(bufoff, gbase, soff, voff) do { const __amdgpu_buffer_rsrc_t r_ = PG8_RSRC(gbase); _Pragma("unroll") for (int _i = 0; _i < 2; ++_i) \
        __builtin_amdgcn_raw_ptr_buffer_load_lds(r_, (PG8_LAS unsigned*)(lds + (bufoff) + ldsw + _i * 8192), 16, (voff)[_i], (int)(soff), 0, 0); } while (0)
#define PG8_LDA(dst, b, h) do { _Pragma("unroll") for (int m = 0; m < 4; ++m) _Pragma("unroll") for (int k = 0; k < 2; ++k) dst[m][k] = *(const PG8_LAS bf16x8*)(lds + PG8_SA(b, h) + aoff + m * 2048 + k * 1024); } while (0)
#define PG8_LDB(dst, b, h) do { _Pragma("unroll") for (int n = 0; n < 2; ++n) _Pragma("unroll") for (int k = 0; k < 2; ++k) dst[n][k] = *(const PG8_LAS bf16x8*)(lds + PG8_SB(b, h) + boff + n * 2048 + k * 1024); } while (0)
#define PG8_CAT(x0, x1) __builtin_shufflevector(__builtin_bit_cast(i32x4, (x0)), __builtin_bit_cast(i32x4, (x1)), 0, 1, 2, 3, 4, 5, 6, 7)
#define PG8_MMA(ai, bj, At, Bt) do { __builtin_amdgcn_s_setprio(1); _Pragma("unroll") for (int m = 0; m < 4; ++m) _Pragma("unroll") for (int n = 0; n < 2; ++n) { \
        if constexpr (FP8) acc[ai][bj][m][n] = __builtin_amdgcn_mfma_scale_f32_16x16x128_f8f6f4(PG8_CAT(Bt[n][0], Bt[n][1]), PG8_CAT(At[m][0], At[m][1]), acc[ai][bj][m][n], 0, 0, 0, 0x7f7f7f7f, 0, 0x7f7f7f7f); \
        else { _Pragma("unroll") for (int k = 0; k < 2; ++k) acc[ai][bj][m][n] = __builtin_amdgcn_mfma_f32_16x16x32_bf16(Bt[n][k], At[m][k], acc[ai][bj][m][n], 0, 0, 0); } } __builtin_amdgcn_s_setprio(0); } while (0)
#define PG8_WAIT_V(n) asm volatile("s_waitcnt vmcnt(" #n ")" ::: "memory")
#define PG8_WAIT_L(n) asm volatile("s_waitcnt lgkmcnt(" #n ")" ::: "memory")
#define PG8_BAR __builtin_amdgcn_s_barrier()
#define PG8_SCHED __builtin_amdgcn_sched_barrier(0)
    Unit cur, nxt; int ui = 0;
    if (!S.next(0, cur)) return;
#if defined(TPROBE) && (TPROBE == 10 || TPROBE == 11)
    unsigned tpe_ = 0, tpn_ = 0; const unsigned tpg0_ = (unsigned)__builtin_amdgcn_s_memtime();
#endif
    f32x4 acc[2][2][4][2];
#pragma unroll
    for (int a = 0; a < 2; ++a)
#pragma unroll
        for (int b = 0; b < 2; ++b)
#pragma unroll
            for (int m = 0; m < 4; ++m)
#pragma unroll
                for (int n = 0; n < 2; ++n) acc[a][b][m][n] = (f32x4){0.f, 0.f, 0.f, 0.f};
    bf16x8 At[4][2], B0[2][2], B1[2][2];
    unsigned cOff[2][2], nOff[2][2];
#pragma unroll
    for (int hh = 0; hh < 2; ++hh)
#pragma unroll
        for (int i = 0; i < 2; ++i) {
            if constexpr (GATHER) { const int ridx = hh * HALF + Rs[i]; int tk = cur.rows[ridx]; tk = ridx < cur.aux ? tk : 0; cOff[hh][i] = (unsigned)(tk * lda + Cs[i]) * 2u; }
            else cOff[hh][i] = (unsigned)(Rs[i] * lda + Cs[i]) * 2u;
            if constexpr (GATHER) nOff[hh][i] = cOff[hh][i]; else nOff[hh][i] = 0u;
        }
    const char* cA = cur.a; const char* cB = cur.b;
    S.a_ready(cur);
    if constexpr (SP2) {
        PG8_STAGE(PG8_SB(0, 0), cB, 0, voffB); PG8_STAGE(PG8_SB(0, 1), cB, hstepB, voffB); PG8_STAGE(PG8_SA(0, 0), cA, 0, cOff[0]); PG8_STAGE(PG8_SA(0, 1), cA, hstepA, cOff[GATHER ? 1 : 0]);
        if (wr == 1) PG8_BAR;
        PG8_WAIT_V(2); PG8_BAR;
        PG8_STAGE(PG8_SB(1, 0), cB, kstep, voffB); PG8_STAGE(PG8_SA(1, 0), cA, kstep, cOff[0]); PG8_STAGE(PG8_SB(1, 1), cB, hstepB + kstep, voffB);
        PG8_WAIT_V(6); PG8_BAR;
    } else {
        PG8_STAGE(PG8_SB(0, 0), cB, 0, voffB); PG8_STAGE(PG8_SA(0, 0), cA, 0, cOff[0]); PG8_STAGE(PG8_SB(0, 1), cB, hstepB, voffB); PG8_STAGE(PG8_SA(0, 1), cA, hstepA, cOff[GATHER ? 1 : 0]);
        if (wr == 1) PG8_BAR;
        PG8_WAIT_V(4); PG8_BAR;
        PG8_STAGE(PG8_SB(1, 0), cB, kstep, voffB); PG8_STAGE(PG8_SA(1, 0), cA, kstep, cOff[0]); PG8_STAGE(PG8_SB(1, 1), cB, hstepB + kstep, voffB);
        PG8_WAIT_V(6); PG8_BAR;
    }
    for (;;) {
        const bool has_next = S.next(ui + 1, nxt);
        const char* nA = has_next ? nxt.a : cA; const char* nB = has_next ? nxt.b : cB;
        if constexpr (GATHER) {
            if (has_next) {
#pragma unroll
                for (int hh = 0; hh < 2; ++hh)
#pragma unroll
                    for (int i = 0; i < 2; ++i) { const int ridx = hh * HALF + Rs[i]; int tk = nxt.rows[ridx]; tk = ridx < nxt.aux ? tk : 0; nOff[hh][i] = (unsigned)(tk * lda + Cs[i]) * 2u; }
            } else {
#pragma unroll
                for (int hh = 0; hh < 2; ++hh)
#pragma unroll
                    for (int i = 0; i < 2; ++i) nOff[hh][i] = cOff[hh][i];
            }
        }
        const int nt = cur.nt ? cur.nt : ntK;
#if defined(TPROBE) && (TPROBE == 11)
        const unsigned tpk0_ = (unsigned)__builtin_amdgcn_s_memtime();
#endif
#pragma unroll 1
        for (int t = 0; t < nt; t += 2) {
            const bool last = (t == nt - 2);
            const unsigned o1 = (unsigned)((t + 1) * kstep);
            const char* a2 = last ? nA : cA; const char* b2 = last ? nB : cB; const unsigned o2k = last ? 0u : (unsigned)((t + 2) * kstep), o3k = o2k + (unsigned)kstep;
            unsigned o2[2][2];
#pragma unroll
            for (int hh = 0; hh < 2; ++hh)
#pragma unroll
                for (int i = 0; i < 2; ++i) { if constexpr (GATHER) o2[hh][i] = last ? nOff[hh][i] : cOff[hh][i]; else o2[hh][i] = cOff[hh][i]; }
            if (last && has_next) S.a_ready(nxt);
            if constexpr (SP2) {
            PG8_LDB(B0, 0, 0); PG8_LDB(B1, 0, 1); PG8_SCHED; PG8_LDA(At, 0, 0); PG8_STAGE(PG8_SA(1, 1), cA, o1 + hstepA, cOff[GATHER ? 1 : 0]);
            PG8_WAIT_V(8); PG8_WAIT_L(0); PG8_BAR; PG8_MMA(0, 0, At, B0); PG8_MMA(0, 1, At, B1); PG8_BAR; PG8_SCHED;
            PG8_LDA(At, 0, 1); PG8_STAGE(PG8_SB(0, 0), b2, o2k, voffB); PG8_STAGE(PG8_SB(0, 1), b2, o2k + hstepB, voffB); PG8_STAGE(PG8_SA(0, 0), a2, o2k, o2[0]);
            PG8_WAIT_V(8); PG8_WAIT_L(0); PG8_BAR; PG8_MMA(1, 0, At, B0); PG8_MMA(1, 1, At, B1); PG8_BAR; PG8_SCHED;
            PG8_LDB(B0, 1, 0); PG8_LDB(B1, 1, 1); PG8_SCHED; PG8_LDA(At, 1, 0); PG8_STAGE(PG8_SA(0, 1), a2, o2k + hstepA, o2[GATHER ? 1 : 0]);
            PG8_WAIT_V(8); PG8_WAIT_L(0); PG8_BAR; PG8_MMA(0, 0, At, B0); PG8_MMA(0, 1, At, B1); PG8_BAR; PG8_SCHED;
            PG8_LDA(At, 1, 1); PG8_STAGE(PG8_SB(1, 0), b2, o3k, voffB); PG8_STAGE(PG8_SB(1, 1), b2, o3k + hstepB, voffB); PG8_STAGE(PG8_SA(1, 0), a2, o3k, o2[0]);
            PG8_WAIT_V(8); PG8_WAIT_L(0); PG8_BAR; PG8_MMA(1, 0, At, B0); PG8_MMA(1, 1, At, B1); PG8_BAR; PG8_SCHED;
            } else {
            PG8_LDB(B0, 0, 0); PG8_SCHED; PG8_LDA(At, 0, 0); PG8_STAGE(PG8_SA(1, 1), cA, o1 + hstepA, cOff[GATHER ? 1 : 0]);
            PG8_WAIT_L(8); PG8_BAR; PG8_WAIT_L(0); PG8_MMA(0, 0, At, B0); PG8_BAR; PG8_SCHED;
            PG8_LDB(B1, 0, 1); PG8_STAGE(PG8_SB(0, 0), b2, o2k, voffB);
            PG8_BAR; PG8_WAIT_L(0); PG8_MMA(0, 1, At, B1); PG8_BAR;
            PG8_LDA(At, 0, 1); PG8_STAGE(PG8_SA(0, 0), a2, o2k, o2[0]);
            PG8_BAR; PG8_WAIT_L(0); PG8_MMA(1, 0, At, B0); PG8_BAR; PG8_SCHED;
            PG8_STAGE(PG8_SB(0, 1), b2, o2k + hstepB, voffB);
            PG8_WAIT_V(6); PG8_BAR; PG8_MMA(1, 1, At, B1); PG8_BAR;
            PG8_LDB(B0, 1, 0); PG8_SCHED; PG8_LDA(At, 1, 0); PG8_STAGE(PG8_SA(0, 1), a2, o2k + hstepA, o2[GATHER ? 1 : 0]);
            PG8_WAIT_L(8); PG8_BAR; PG8_WAIT_L(0); PG8_MMA(0, 0, At, B0); PG8_BAR; PG8_SCHED;
            PG8_LDB(B1, 1, 1); PG8_STAGE(PG8_SB(1, 0), b2, o3k, voffB);
            PG8_BAR; PG8_WAIT_L(0); PG8_MMA(0, 1, At, B1); PG8_BAR;
            PG8_LDA(At, 1, 1); PG8_STAGE(PG8_SA(1, 0), a2, o3k, o2[0]);
            PG8_BAR; PG8_WAIT_L(0); PG8_MMA(1, 0, At, B0); PG8_BAR; PG8_SCHED;
            PG8_STAGE(PG8_SB(1, 1), b2, o3k + hstepB, voffB);
            PG8_WAIT_V(6); PG8_BAR; PG8_MMA(1, 1, At, B1); PG8_BAR;
            }
        }
#if defined(TPROBE) && (TPROBE == 11)
        tpe_ += (unsigned)__builtin_amdgcn_s_memtime() - tpk0_; tpn_ += (unsigned)nt;
#endif
        if constexpr (ALIGN_EPI) { if (wr == 0) PG8_BAR; }
#if defined(TPROBE) && (TPROBE == 10)
        const unsigned tpe0_ = (unsigned)__builtin_amdgcn_s_memtime();
#endif
        { int tl_ = tid; asm volatile("" : "+v"(tl_)); const int l2_ = tl_ & 63; E(acc, cur, wr, wc, l2_ & 15, l2_ >> 4); } S.done(cur);
#if defined(TPROBE) && (TPROBE == 10)
        tpe_ += (unsigned)__builtin_amdgcn_s_memtime() - tpe0_;
#endif
        if (!has_next) break;
#pragma unroll
        for (int a = 0; a < 2; ++a)
#pragma unroll
            for (int b = 0; b < 2; ++b)
#pragma unroll
                for (int m = 0; m < 4; ++m)
#pragma unroll
                    for (int n = 0; n < 2; ++n) acc[a][b][m][n] = (f32x4){0.f, 0.f, 0.f, 0.f};
        cur = nxt; cA = nA; cB = nB; ++ui;
        if constexpr (GATHER) {
#pragma unroll
            for (int hh = 0; hh < 2; ++hh)
#pragma unroll
                for (int i = 0; i < 2; ++i) cOff[hh][i] = nOff[hh][i];
        }
        if constexpr (ALIGN_EPI) { if (wr == 1) PG8_BAR; }
    }
    PG8_WAIT_V(0);
#if defined(TPROBE) && (TPROBE == 11)
    if (!FP8 && tid == 0) { unsigned* cw_ = (unsigned*)(*(PG8_LAS unsigned long long*)(lds + 160 * 1024 - 256 + 80)); atomicAdd(cw_ + 70000, tpe_ >> 6); atomicAdd(cw_ + 70001, tpn_); (void)tpg0_; }
#endif
#if defined(TPROBE) && (TPROBE == 10)
    if (tid == 0) { unsigned* cw_ = (unsigned*)(*(PG8_LAS unsigned long long*)(lds + 160 * 1024 - 256 + 80)); atomicAdd(cw_ + 70000, tpe_ >> 6); atomicAdd(cw_ + 70001, ((unsigned)__builtin_amdgcn_s_memtime() - tpg0_) >> 6); }
#endif
    if constexpr (!ALIGN_EPI) { if (wr == 0) PG8_BAR; }
    PG8_BAR;
#undef PG8_SA
#undef PG8_SB
#undef PG8_STAGE
#undef PG8_RSRC
#undef PG8_LDA
#undef PG8_LDB
#undef PG8_MMA
#undef PG8_CAT
#undef PG8_WAIT_V
#undef PG8_WAIT_L
#undef PG8_BAR
#undef PG8_SCHED
}
}

constexpr int NWAVES = 8;
constexpr int BATCH = 2, SEQ = 16384, D = 1024, NTOK = BATCH * SEQ;
constexpr int NLAYER = 2;
constexpr int NPROJ = 2816, IN_COLS = 2832;
constexpr int PJ = 2048;
constexpr int C_PIN = 0, C_CB = 256, C_CC = 512, C_CX = 768, C_DQ = 1024, C_DK = 1280, C_DV = 1536, C_DZ = 1792;
constexpr int DFF = 2816, NEXP = 8;
constexpr int NCHUNK = SEQ / 64;
constexpr int NINST = BATCH * 4 * 2 * NCHUNK;
constexpr float EPS = 1e-6f;
constexpr float QSCALE = 0.17677669529663687f * 1.4426950408889634f;
#ifndef MOE_FP8
#define MOE_FP8 1
#endif
constexpr float W8SCALE = 64.f;
constexpr int MOE_PASS_TILES = MOE_FP8 ? 264 : 132;
constexpr int MOE_NPASS = MOE_FP8 ? 1 : 2;

constexpr size_t MiB = 1u << 20;
constexpr size_t WS_CTL = 0, CTL_ZERO_BYTES = 1 * MiB;
constexpr size_t SZ_WIN = (size_t)NPROJ * D * 2, SZ_WM = (size_t)4096 * D * 2, SZ_WB = (size_t)4 * 1024 * 256 * 2, SZ_WO = (size_t)D * D * 2;
constexpr size_t SZ_LAYERW = SZ_WIN + SZ_WM + SZ_WB + SZ_WO;
constexpr size_t SZ_WGU = (size_t)2 * DFF * D * 2, SZ_WD = (size_t)D * DFF * 2, SZ_FFNW = SZ_WGU + SZ_WD;
constexpr size_t WS_W = 1 * MiB;
constexpr size_t WS_WFFN = WS_W + 2 * SZ_LAYERW;
static_assert(WS_WFFN + SZ_FFNW <= 53 * MiB, "weights");
constexpr size_t WS_H = 53 * MiB;
constexpr size_t WS_O4 = 117 * MiB;
constexpr size_t WS_F = WS_O4;
constexpr size_t WS_BD = 181 * MiB;
constexpr size_t WS_DEC = 183 * MiB;
constexpr size_t WS_PROJ = 185 * MiB;
constexpr size_t WS_QB = 521 * MiB;
constexpr size_t WS_KV = 313 * MiB;
constexpr size_t WS_UW = 361 * MiB;
constexpr size_t WS_AB = 425 * MiB;
constexpr size_t WS_ST = 489 * MiB;
constexpr size_t WS_PBUF = 185 * MiB;
constexpr size_t WS_MERGED = 441 * MiB;
constexpr size_t WS_ACT0 = 185 * MiB;
constexpr size_t WS_H2B = 479 * MiB;
constexpr size_t WS_MOEW = 185 * MiB;
constexpr size_t WS_XG = 251 * MiB;
constexpr size_t WS_ACT1 = 1 * MiB;
constexpr size_t WS_Y = 317 * MiB;
constexpr size_t WS_ROUTE = 449 * MiB;
constexpr size_t WS_END = 543 * MiB;
static_assert(WS_ACT1 + (size_t)MOE_PASS_TILES * 256 * DFF * (MOE_FP8 ? 1 : 2) <= WS_MOEW, "act1");
static_assert((MOE_FP8 ? WS_XG + (size_t)264 * 256 * D : WS_MOEW + 8 * SZ_FFNW) <= WS_Y && WS_MOEW + 8 * SZ_FFNW / 2 <= WS_XG && WS_Y + (size_t)264 * 256 * D * 2 <= WS_ROUTE && WS_ROUTE + 4 * MiB <= WS_H2B && WS_H2B + 64 * MiB <= WS_END, "moe map");
static_assert(WS_PROJ + (size_t)NTOK * PJ * 2 <= WS_KV && WS_KV + (size_t)8 * 256 * 19456 <= WS_UW && WS_QB + 16 * MiB <= WS_END && WS_ST + (size_t)NINST * 8192 <= WS_END, "mixer map");
constexpr int CW_TMO = 0, CW_CODE = 1;
constexpr int CW_BAR = 4096;
constexpr int CW_MOD = 16384;
constexpr int CW_MOECNT = 65536;
constexpr int CW_NMAX = 66560;
constexpr int CW_MODCNT = 66624;
constexpr int CW_ATTQ = 66688;
static_assert(CW_MOD + NLAYER * BATCH * 6 * D <= CW_MOECNT && (CW_ATTQ + 32 * 64) * 4 <= (int)CTL_ZERO_BYTES, "ctl");

constexpr int RING_OFF = 0, RING_BYTES = 131072;
constexpr int LDS_BYTES = 160 * 1024;
constexpr int MISC_OFF = LDS_BYTES - 256;

#define GAS __attribute__((address_space(1)))
#define LAS __attribute__((address_space(3)))
typedef unsigned short bf16;
typedef unsigned v4u __attribute__((ext_vector_type(4)));
typedef unsigned v2u __attribute__((ext_vector_type(2)));
typedef float f32x4 __attribute__((ext_vector_type(4)));
typedef float f32x16 __attribute__((ext_vector_type(16)));
typedef short bf16x8 __attribute__((ext_vector_type(8)));
typedef short bf16x4 __attribute__((ext_vector_type(4)));
typedef GAS unsigned gu32;
#define RLX_AGENT __ATOMIC_RELAXED, __HIP_MEMORY_SCOPE_AGENT
#define LDS_WAIT() asm volatile("s_waitcnt lgkmcnt(0)" ::: "memory")
#define VM_WAIT() asm volatile("s_waitcnt vmcnt(0)" ::: "memory")
__device__ __forceinline__ unsigned pk2(float lo, float hi) { typedef float f2_ __attribute__((ext_vector_type(2))); typedef __bf16 b2_ __attribute__((ext_vector_type(2))); const f2_ v = {lo, hi}; return __builtin_bit_cast(unsigned, __builtin_convertvector(v, b2_)); }
__device__ __forceinline__ unsigned f2bf(float f) { return pk2(f, f) & 0xffffu; }
__device__ __forceinline__ float bf2f(unsigned b) { return __builtin_bit_cast(float, b << 16); }
__device__ __forceinline__ float bflo(unsigned w) { return __builtin_bit_cast(float, w << 16); }
__device__ __forceinline__ float bfhi(unsigned w) { return __builtin_bit_cast(float, w & 0xffff0000u); }
__device__ __forceinline__ float fast_exp2(float x) { return __builtin_amdgcn_exp2f(x); }
__device__ __forceinline__ float fast_exp(float x) { return __builtin_amdgcn_exp2f(x * 1.4426950408889634f); }
__device__ __forceinline__ float fast_rcp(float x) { return __builtin_amdgcn_rcpf(x); }
__device__ __forceinline__ float sigmoidf_(float x) { return fast_rcp(1.f + fast_exp(-x)); }
__device__ __forceinline__ float siluf_(float x) { return x * sigmoidf_(x); }
__device__ __forceinline__ float wave_sum(float v) {
    v += __builtin_bit_cast(float, __builtin_amdgcn_update_dpp(0, __builtin_bit_cast(int, v), 0xB1, 0xf, 0xf, true));
    v += __builtin_bit_cast(float, __builtin_amdgcn_update_dpp(0, __builtin_bit_cast(int, v), 0x4E, 0xf, 0xf, true));
    v += __builtin_bit_cast(float, __builtin_amdgcn_update_dpp(0, __builtin_bit_cast(int, v), 0x141, 0xf, 0xf, true));
    v += __builtin_bit_cast(float, __builtin_amdgcn_update_dpp(0, __builtin_bit_cast(int, v), 0x140, 0xf, 0xf, true));
    v += __builtin_bit_cast(float, __builtin_amdgcn_ds_swizzle(__builtin_bit_cast(int, v), 0x401f));
    v += __shfl_xor(v, 32);
    return v;
}

#define XB_TMO      128
#define XB_XCNT(j)  (256  + 64 * (j))
#define XB_XSUB(j)  (1280 + 64 * (j))
#define XB_XGEN(j)  (2304 + 64 * (j))
#define XB_TOP      3328
#define XB_TOPGEN   3392
#define XCD_BAR_WORDS 3456
#define XB_SPIN_CAP (1u << 22)
__device__ __forceinline__ unsigned xb_ld(unsigned* p)              { return __hip_atomic_load(p, __ATOMIC_RELAXED, __HIP_MEMORY_SCOPE_AGENT); }
__device__ __forceinline__ unsigned xb_add(unsigned* p, unsigned v) { return __hip_atomic_fetch_add(p, v, __ATOMIC_RELAXED, __HIP_MEMORY_SCOPE_AGENT); }
__device__ __forceinline__ unsigned xb_xcc_id() { return (unsigned)__builtin_amdgcn_s_getreg((3 << 11) | 20) & 0xFu; }
#define XB_SPIN(cond, bar) do { unsigned _sp = 0; while (cond) { __builtin_amdgcn_s_sleep(1); \
    if ((++_sp & 255u) == 0u) { if (xb_ld(&(bar)[XB_TMO])) break; if (_sp > XB_SPIN_CAP) { atomicAdd(&(bar)[XB_TMO], 1u); break; } } } } while (0)
struct XcdBarrier { unsigned* bar; unsigned x; volatile LAS unsigned* st; };
__device__ __forceinline__ XcdBarrier xcd_barrier_post(unsigned* bar, volatile LAS unsigned* st) {
    XcdBarrier b; b.bar = bar; b.x = xb_xcc_id(); b.st = st;
    if (threadIdx.x == 0) (void)xb_add(&bar[XB_XCNT(b.x)], 1u);
    return b;
}
__device__ __forceinline__ void xcd_barrier_complete(unsigned* bar, unsigned x, unsigned& nloc, unsigned& nx) {
    const unsigned G = gridDim.x * gridDim.y * gridDim.z;
    unsigned sum, cnt, mine, sp = 0u;
    for (;;) {
        sum = 0u; cnt = 0u; mine = 0u;
#pragma unroll
        for (unsigned j = 0; j < 16; ++j) { const unsigned c = xb_ld(&bar[XB_XCNT(j)]); sum += c; cnt += (c > 0u) ? 1u : 0u; }
        mine = xb_ld(&bar[XB_XCNT(x)]);
        if (sum == G) break;
        __builtin_amdgcn_s_sleep(1);
        if ((++sp & 255u) == 0u) { if (xb_ld(&bar[XB_TMO])) break; if (sp > XB_SPIN_CAP) { atomicAdd(&bar[XB_TMO], 1u); break; } }
    }
    nloc = mine > 0u ? mine : 1u; nx = cnt > 0u ? cnt : 1u;
}
__device__ __forceinline__ void xcd_barrier(const XcdBarrier& b) {
    asm volatile("s_waitcnt vmcnt(0)" ::: "memory");
    __syncthreads();
    if (threadIdx.x == 0) {
        unsigned* bar = b.bar;
        __builtin_amdgcn_s_waitcnt(0);
        unsigned nloc = b.st[0], nx = b.st[1];
        if (nloc == 0u) { xcd_barrier_complete(bar, b.x, nloc, nx); b.st[0] = nloc; b.st[1] = nx; }
        const unsigned old = xb_add(&bar[XB_XSUB(b.x)], 1u);
        const unsigned gen = old / nloc;
        if (old + 1u == (gen + 1u) * nloc) {
            __builtin_amdgcn_fence(__ATOMIC_RELEASE, "agent");
            asm volatile("s_waitcnt vmcnt(0)" ::: "memory");
            const unsigned og = xb_add(&bar[XB_TOP], 1u);
            const unsigned tg = og / nx;
            if (og + 1u == (tg + 1u) * nx) xb_add(&bar[XB_TOPGEN], 1u);
            else XB_SPIN(xb_ld(&bar[XB_TOPGEN]) == tg, bar);
            __builtin_amdgcn_fence(__ATOMIC_ACQUIRE, "agent");
            xb_add(&bar[XB_XGEN(b.x)], 1u);
            asm volatile("s_waitcnt vmcnt(0)" ::: "memory");
        } else {
            XB_SPIN(xb_ld(&bar[XB_XGEN(b.x)]) == gen, bar);
            __builtin_amdgcn_fence(__ATOMIC_ACQUIRE, "agent");
            asm volatile("s_waitcnt vmcnt(0)" ::: "memory");
        }
    }
    __syncthreads();
}

__device__ __forceinline__ int fresh_lane() { unsigned m_ = ~0u; asm volatile("" : "+s"(m_)); return (int)__builtin_amdgcn_mbcnt_hi(m_, __builtin_amdgcn_mbcnt_lo(m_, 0u)); }
#define LANE_XOR_F(lane_, v_, m_) __builtin_bit_cast(float, __builtin_amdgcn_ds_bpermute((((lane_) ^ (m_)) << 2), __builtin_bit_cast(int, (float)(v_))))
struct Frame {
    LAS unsigned char* lds;
    volatile LAS unsigned* MISC;
    gu32* ctl;
    int tid, lane, wave;
    int vcu, G;
    unsigned char* ws;
    float* out;
    const float* const* in;
};
enum { I_X = 0, I_C, I_ADAW, I_ADAB, I_NMIXPRE, I_NMIXPOST, I_NFFNPRE, I_NFFNPOST, I_WIN, I_DLAMBDA, I_DSUBLN, I_POOLW, I_POOLSCALE, I_SCONVW, I_DCONVW, I_DALOG, I_DDTBIAS, I_DNORM,
       I_WBRANCH, I_WMERGE, I_BMERGE, I_WO, I_FFNG, I_FFNU, I_FFND, I_ROUTERW, I_ROUTERB, I_MOEG, I_MOEU, I_MOED, N_INPUTS };

#ifndef XGB
#define XGB 8
#endif
#ifndef CVT_NT
#define CVT_NT 0
#endif
__device__ __forceinline__ unsigned pk4_fp8(float a, float b, float c, float d) { int w = __builtin_amdgcn_cvt_pk_fp8_f32(a, b, 0, false); w = __builtin_amdgcn_cvt_pk_fp8_f32(c, d, w, true); return (unsigned)w; }
template <bool F8 = false> __device__ __forceinline__ void cvt_item(const float* W, int ldw, int k0, int n0, bf16* WT, int Kd, int drow0, LAS float* scr, int lane) {
#pragma unroll 8
    for (int i = 0; i < 32; ++i) { const int kk = 2 * i + (lane >> 5); const float* wp_ = W + (size_t)(k0 + kk) * ldw + n0 + (lane & 31); scr[kk * 33 + (lane & 31)] = CVT_NT ? __builtin_nontemporal_load(wp_) : *wp_; }
    LDS_WAIT(); asm volatile("" ::: "memory");
    const int c = lane & 7;
#pragma unroll
    for (int j = 0; j < 4; ++j) { const int n = (lane >> 3) + 8 * j; const LAS float* s = scr + (8 * c) * 33 + n;
        if constexpr (F8) { v2u o; o.x = pk4_fp8(s[0 * 33] * W8SCALE, s[1 * 33] * W8SCALE, s[2 * 33] * W8SCALE, s[3 * 33] * W8SCALE); o.y = pk4_fp8(s[4 * 33] * W8SCALE, s[5 * 33] * W8SCALE, s[6 * 33] * W8SCALE, s[7 * 33] * W8SCALE);
            *(GAS v2u*)((unsigned char*)WT + (size_t)(drow0 + n) * Kd + k0 + 8 * c) = o; }
        else { v4u o; o.x = pk2(s[0 * 33], s[1 * 33]); o.y = pk2(s[2 * 33], s[3 * 33]); o.z = pk2(s[4 * 33], s[5 * 33]); o.w = pk2(s[6 * 33], s[7 * 33]);
            *(GAS v4u*)(WT + (size_t)(drow0 + n) * Kd + k0 + 8 * c) = o; } }
    LDS_WAIT(); asm volatile("" ::: "memory");
}
template <bool F8 = false> __device__ __forceinline__ void cvt_ffn_item(const float* wg, const float* wu, const float* wd, bf16* Wgu, bf16* Wd, int r, LAS float* scr, int lane) {
    constexpr int IG = (D / 64) * (DFF / 32);
    if (r < IG) { const int kb = r / (DFF / 32), nb = r % (DFF / 32), n0 = nb * 32; cvt_item<F8>(wg, DFF, kb * 64, n0, Wgu, D, 256 * (n0 >> 7) + (n0 & 127), scr, lane); return; } r -= IG;
    if (r < IG) { const int kb = r / (DFF / 32), nb = r % (DFF / 32), n0 = nb * 32; cvt_item<F8>(wu, DFF, kb * 64, n0, Wgu, D, 256 * (n0 >> 7) + (n0 & 127) + 128, scr, lane); return; } r -= IG;
    { const int kb = r / (D / 32), nb = r % (D / 32); cvt_item<F8>(wd, D, kb * 64, nb * 32, Wd, DFF, nb * 32, scr, lane); }
}
constexpr int FFN_ITEMS = 3 * (D / 64) * (DFF / 32);
__device__ __forceinline__ bf16* w_in_t(unsigned char* ws, int l) { return (bf16*)(ws + WS_W + (size_t)l * SZ_LAYERW); }
__device__ __forceinline__ bf16* w_m_t(unsigned char* ws, int l) { return (bf16*)(ws + WS_W + (size_t)l * SZ_LAYERW + SZ_WIN); }
__device__ __forceinline__ bf16* w_b_t(unsigned char* ws, int l) { return (bf16*)(ws + WS_W + (size_t)l * SZ_LAYERW + SZ_WIN + SZ_WM); }
__device__ __forceinline__ bf16* w_o_t(unsigned char* ws, int l) { return (bf16*)(ws + WS_W + (size_t)l * SZ_LAYERW + SZ_WIN + SZ_WM + SZ_WB); }

__device__ __forceinline__ void p_prologue(Frame& F) {
    LAS float* scr = (LAS float*)(F.lds + RING_OFF + F.wave * 16384);
    const int gw = F.vcu * NWAVES + F.wave, NGW = F.G * NWAVES;
    constexpr int I_IN = (D / 64) * (NPROJ / 32), I_M = (D / 64) * (D / 32), I_B = (256 / 64) * (D / 32);
    constexpr int PER_LAYER = I_IN + 4 * I_M + 4 * I_B + I_M;
    constexpr int NITEMS = NLAYER * PER_LAYER + FFN_ITEMS;
    for (int it = gw; it < NITEMS; it += NGW) {
        int r = it;
        if (r >= NLAYER * PER_LAYER) { r -= NLAYER * PER_LAYER;
            cvt_ffn_item(F.in[I_FFNG], F.in[I_FFNU], F.in[I_FFND], (bf16*)(F.ws + WS_WFFN), (bf16*)(F.ws + WS_WFFN + SZ_WGU), r, scr, F.lane); continue; }
        const int l = r / PER_LAYER; r -= l * PER_LAYER;
        if (r < I_IN) { const int kb = r / (NPROJ / 32), nb = r % (NPROJ / 32); cvt_item(F.in[I_WIN] + (size_t)l * D * IN_COLS, IN_COLS, kb * 64, nb * 32, w_in_t(F.ws, l), D, nb * 32, scr, F.lane); continue; } r -= I_IN;
        if (r < 4 * I_M) { const int i = r / I_M; r -= i * I_M; const int kb = r / (D / 32), nb = r % (D / 32);
            cvt_item(F.in[I_WMERGE] + ((size_t)l * 4 + i) * D * D, D, kb * 64, nb * 32, w_m_t(F.ws, l), D, i * 1024 + nb * 32, scr, F.lane); continue; } r -= 4 * I_M;
        if (r < 4 * I_B) { const int i = r / I_B; r -= i * I_B; const int kb = r / (D / 32), nb = r % (D / 32);
            cvt_item(F.in[I_WBRANCH] + ((size_t)l * 4 + i) * 256 * D, D, kb * 64, nb * 32, w_b_t(F.ws, l) + i * 256, 1024, nb * 32, scr, F.lane); continue; } r -= 4 * I_B;
        { const int kb = r / (D / 32), nb = r % (D / 32); cvt_item(F.in[I_WO] + (size_t)l * D * D, D, kb * 64, nb * 32, w_o_t(F.ws, l), D, nb * 32, scr, F.lane); }
    }
    constexpr int MOD_ITEMS = NLAYER * 24 * 16;
    for (int it = F.wave * F.G + F.vcu; it < MOD_ITEMS; it += NGW) {
        const int grp = it >> 4, kc = it & 15, l = grp / 24, nb = grp % 24;
        const float* Wp = F.in[I_ADAW] + ((size_t)l * D + kc * 64) * (6 * D) + nb * 256 + F.lane * 4;
        f32x4 a0 = {0.f, 0.f, 0.f, 0.f}, a1 = {0.f, 0.f, 0.f, 0.f};
#pragma unroll 8
        for (int k = 0; k < 64; ++k) { const f32x4 w = *(const GAS f32x4*)(Wp + (size_t)k * (6 * D));
            const float c0 = siluf_(F.in[I_C][kc * 64 + k]), c1 = siluf_(F.in[I_C][D + kc * 64 + k]); a0 += w * c0; a1 += w * c1; }
        float* part = (float*)(F.ws + WS_BD) + ((size_t)grp * 16 + kc) * 512 + F.lane * 4;
        *(GAS f32x4*)part = a0; *(GAS f32x4*)(part + 256) = a1;
        __threadfence();
        unsigned old = 0;
        if (F.lane == 0) old = __hip_atomic_fetch_add(F.ctl + CW_MODCNT + grp, 1u, RLX_AGENT);
        old = __builtin_amdgcn_readfirstlane(old);
        if (old == 15u) {
            __threadfence();
            f32x4 s0 = {0.f, 0.f, 0.f, 0.f}, s1 = {0.f, 0.f, 0.f, 0.f};
            const float* pg = (const float*)(F.ws + WS_BD) + (size_t)grp * 16 * 512 + F.lane * 4;
#pragma unroll
            for (int q = 0; q < 16; ++q) { s0 += __builtin_nontemporal_load((const f32x4*)(pg + q * 512)); s1 += __builtin_nontemporal_load((const f32x4*)(pg + q * 512 + 256)); }
            float* m0 = (float*)(F.ctl + CW_MOD) + (size_t)(l * BATCH + 0) * 6 * D + nb * 256 + F.lane * 4;
            *(GAS f32x4*)m0 = s0; *(GAS f32x4*)(m0 + 6 * D) = s1;
        }
    }
}
__device__ __forceinline__ void moe_tiles(Frame& F, int (&cnt)[NEXP], int (&tstart)[NEXP + 1]) {
    int acc = 0;
#pragma unroll
    for (int e = 0; e < NEXP; ++e) { cnt[e] = __builtin_amdgcn_readfirstlane((int)__hip_atomic_load(F.ctl + CW_MOECNT + 64 * e, RLX_AGENT)); tstart[e] = acc; acc += (cnt[e] + 255) >> 8; }
    tstart[NEXP] = acc;
}
__device__ __forceinline__ void p_moe_cvt(Frame& F) {
    LAS float* scr = (LAS float*)(F.lds + RING_OFF + F.wave * 16384);
    const int gw = F.vcu * NWAVES + F.wave, NGW = F.G * NWAVES;
    for (int it = gw; it < NEXP * FFN_ITEMS; it += NGW) {
        const int e = it / FFN_ITEMS, r = it % FFN_ITEMS;
        unsigned char* base = F.ws + WS_MOEW + (size_t)e * (MOE_FP8 ? SZ_FFNW / 2 : SZ_FFNW);
        cvt_ffn_item<MOE_FP8 != 0>(F.in[I_MOEG] + (size_t)e * D * DFF, F.in[I_MOEU] + (size_t)e * D * DFF, F.in[I_MOED] + (size_t)e * DFF * D, (bf16*)base, (bf16*)(base + (MOE_FP8 ? SZ_WGU / 2 : SZ_WGU)), r, scr, F.lane);
    }
#if MOE_FP8
    int cnt[NEXP], tstart[NEXP + 1]; moe_tiles(F, cnt, tstart);
    const int* lists = (const int*)(F.ws + WS_ROUTE + 1 * MiB);
    const int nslot = tstart[NEXP] * 256;
    for (int g0 = gw; g0 < nslot; g0 += XGB * NGW) {
        int tok[XGB];
#pragma unroll
        for (int u = 0; u < XGB; ++u) { const int gs = g0 + u * NGW; tok[u] = 0;
            if (gs < nslot) { const int t = gs >> 8; int e = 0;
#pragma unroll
                for (int k = 1; k < NEXP; ++k) e = (t >= tstart[k]) ? k : e;
                int ts = 0, ce = 0;
#pragma unroll
                for (int k = 0; k < NEXP; ++k) { ts = (k == e) ? tstart[k] : ts; ce = (k == e) ? cnt[k] : ce; }
                const int i = (t - ts) * 256 + (gs & 255);
                const int tk = lists[(size_t)e * 65536 + i]; tok[u] = i < ce ? tk : 0; } }
        v4u v[XGB];
#pragma unroll
        for (int u = 0; u < XGB; ++u) v[u] = *(const GAS v4u*)(F.ws + WS_H2B + (size_t)tok[u] * D + F.lane * 16);
#pragma unroll
        for (int u = 0; u < XGB; ++u) { const int gs = g0 + u * NGW; if (gs < nslot) *(GAS v4u*)(F.ws + WS_XG + (size_t)gs * D + F.lane * 16) = v[u]; }
    }
#endif
}

#ifndef ROW_NT
#define ROW_NT 1
#endif
struct Row { f32x4 v[4]; };
__device__ __forceinline__ float modv(Frame& F, int l, int b, int idx) { return ((const float*)(F.ctl + CW_MOD))[(size_t)(l * BATCH + b) * 6 * D + idx] + F.in[I_ADAB][l * 6 * D + idx]; }
__device__ __forceinline__ f32x4 modv4(Frame& F, int l, int b, int idx) {
    const f32x4 a = *(const GAS f32x4*)((const float*)(F.ctl + CW_MOD) + (size_t)(l * BATCH + b) * 6 * D + idx), c = *(const GAS f32x4*)(F.in[I_ADAB] + l * 6 * D + idx); return a + c; }
__device__ __forceinline__ float row_rstd(const Row& r) {
    float s = 0.f;
#pragma unroll
    for (int j = 0; j < 4; ++j) s += (r.v[j].x * r.v[j].x + r.v[j].y * r.v[j].y) + (r.v[j].z * r.v[j].z + r.v[j].w * r.v[j].w);
    return 1.f / sqrtf(wave_sum(s) * (1.f / D) + EPS);
}
__device__ __forceinline__ void row_resid(Frame& F, Row& x, const Row& f, const float* gain, int l, int b, int gidx) {
    const float rs = row_rstd(f);
#pragma unroll
    for (int j = 0; j < 4; ++j) { const int c = 4 * F.lane + 256 * j; const f32x4 g = *(const GAS f32x4*)(gain + c), m = modv4(F, l, b, gidx + c); x.v[j] += m * (f.v[j] * rs * g); }
}
__device__ __forceinline__ void row_make_h(Frame& F, Row& h, const Row& x, const float* gain, int l, int b, int shidx, int scidx) {
    const float rs = row_rstd(x);
#pragma unroll
    for (int j = 0; j < 4; ++j) { const int c = 4 * F.lane + 256 * j; const f32x4 g = *(const GAS f32x4*)(gain + c), sc = modv4(F, l, b, scidx + c), sh = modv4(F, l, b, shidx + c);
        h.v[j] = (x.v[j] * rs * g) * (sc + 1.f) + sh; }
}
struct ColVec { f32x4 v[4]; };
__device__ __forceinline__ void cv_resid(Frame& F, ColVec& c, const float* gain, int l, int b, int gidx) {
#pragma unroll
    for (int j = 0; j < 4; ++j) { const int col = 4 * F.lane + 256 * j; c.v[j] = modv4(F, l, b, gidx + col) * *(const GAS f32x4*)(gain + col); }
}
__device__ __forceinline__ void cv_h(Frame& F, ColVec& a, ColVec& c, const float* gain, int l, int b, int shidx, int scidx) {
#pragma unroll
    for (int j = 0; j < 4; ++j) { const int col = 4 * F.lane + 256 * j; a.v[j] = *(const GAS f32x4*)(gain + col) * (modv4(F, l, b, scidx + col) + 1.f); c.v[j] = modv4(F, l, b, shidx + col); }
}
__device__ __forceinline__ void row_resid_cv(Row& x, const Row& f, const ColVec& c) {
    const float rs = row_rstd(f);
#pragma unroll
    for (int j = 0; j < 4; ++j) x.v[j] += c.v[j] * (f.v[j] * rs);
}
__device__ __forceinline__ void row_make_h_cv(Row& h, const Row& x, const ColVec& a, const ColVec& c) {
    const float rs = row_rstd(x);
#pragma unroll
    for (int j = 0; j < 4; ++j) h.v[j] = (x.v[j] * rs) * a.v[j] + c.v[j];
}
__device__ __forceinline__ void row_store_bf16(Frame& F, const Row& h, bf16* dst) {
    GAS unsigned long long* o8 = (GAS unsigned long long*)dst + F.lane;
#pragma unroll
    for (int j = 0; j < 4; ++j) { const unsigned long long w = (unsigned long long)pk2(h.v[j].x, h.v[j].y) | ((unsigned long long)pk2(h.v[j].z, h.v[j].w) << 32);
        if (ROW_NT >= 2) __builtin_nontemporal_store(w, o8 + 64 * j); else o8[64 * j] = w; }
}
__device__ __forceinline__ void row_load_f32(Frame& F, Row& r, const float* src) {
    const GAS f32x4* p = (const GAS f32x4*)src + F.lane;
#pragma unroll
    for (int j = 0; j < 4; ++j) r.v[j] = ROW_NT ? __builtin_nontemporal_load(p + 64 * j) : p[64 * j];
}
__device__ __forceinline__ void row_store_f32(Frame& F, const Row& r, float* dst) {
    GAS f32x4* p = (GAS f32x4*)dst + F.lane;
#pragma unroll
    for (int j = 0; j < 4; ++j) { if (ROW_NT) __builtin_nontemporal_store(r.v[j], p + 64 * j); else p[64 * j] = r.v[j]; }
}
__device__ __forceinline__ void row_load_bf16(Frame& F, Row& r, const bf16* src) {
    const GAS v2u* p = (const GAS v2u*)src + F.lane;
#pragma unroll
    for (int j = 0; j < 4; ++j) { const v2u w = ROW_NT >= 2 ? __builtin_nontemporal_load(p + 64 * j) : p[64 * j]; r.v[j] = (f32x4){bflo(w.x), bfhi(w.x), bflo(w.y), bfhi(w.y)}; }
}
template <int NO> __device__ __forceinline__ void row_dots(Frame& F, const Row& h, const LAS float* WT, float (&out)[NO]) {
#pragma unroll
    for (int o = 0; o < NO; ++o) { float s = 0.f;
#pragma unroll
        for (int j = 0; j < 4; ++j) { const f32x4 w = *(const LAS f32x4*)(WT + o * 1024 + 4 * F.lane + 256 * j); s += (h.v[j].x * w.x + h.v[j].y * w.y) + (h.v[j].z * w.z + h.v[j].w * w.w); }
        out[o] = s; if ((o & 3) == 3) __builtin_amdgcn_sched_barrier(0); }
#pragma unroll
    for (int o = 0; o < NO; ++o) { out[o] = wave_sum(out[o]); if ((o & 3) == 3) __builtin_amdgcn_sched_barrier(0); }
}
template <int NO> __device__ __forceinline__ void load_wt(Frame& F, const float* W, int ldw, int col0, LAS float* WT) {
    for (int k = F.tid; k < 1024; k += NWAVES * 64) {
#pragma unroll
        for (int o = 0; o < NO; ++o) WT[o * 1024 + k] = W[(size_t)k * ldw + col0 + o];
    }
    __syncthreads();
}
__device__ __forceinline__ float softplusf_(float x) { return x > 20.f ? x : log1pf(__expf(x)); }
__device__ __forceinline__ void row_bd(Frame& F, const Row& h, const LAS float* W16T, int l, int row) {
    float o16[16]; row_dots<16>(F, h, W16T, o16);
    float mine = 0.f;
#pragma unroll
    for (int o = 0; o < 16; ++o) mine = (F.lane == o) ? o16[o] : mine;
    if (F.lane < 16) {
        float r;
        if (F.lane < 8) r = 1.f / (1.f + __expf(-mine));
        else { const int i = F.lane - 8; r = -__expf(F.in[I_DALOG][l * 8 + i]) * softplusf_(mine + F.in[I_DDTBIAS][l * 8 + i]); }
        ((float*)(F.ws + WS_BD))[(size_t)row * 16 + F.lane] = r;
    }
}
constexpr int ROW_A = 0, ROW_B = 1, ROW_C = 2;
template <int MODE> __device__ __forceinline__ void p_rows(Frame& F, const int l) {
    const int gw = F.vcu * NWAVES + F.wave, NGW = F.G * NWAVES;
    LAS float* WT = (LAS float*)(F.lds + RING_OFF);
    LAS int* linfo = (LAS int*)(F.lds + RING_OFF + 65536);
    LAS int* lcnt = (LAS int*)(F.lds + RING_OFF + 65536 + 8 * 32 * 16);
    const bool do_h1 = (MODE == ROW_A) || (MODE == ROW_C && l + 1 < NLAYER);
    const int lh = (MODE == ROW_C) ? l + 1 : l;
    const bool router = (MODE == ROW_B) && (l == 1);
    if (do_h1) load_wt<16>(F, F.in[I_WIN] + (size_t)lh * D * IN_COLS, IN_COLS, NPROJ, WT);
    if (router) { if (F.tid < 16) lcnt[F.tid] = 0; load_wt<8>(F, F.in[I_ROUTERW], NEXP, 0, WT); }
    int cnt[NEXP], tstart[NEXP + 1];
    if (MODE == ROW_C && l == 1) moe_tiles(F, cnt, tstart);
    const float* xsrc = (MODE == ROW_A || (MODE == ROW_B && l == 0)) ? F.in[I_X] : F.out;
    int ri = 0, cb = -1; ColVec cR, cA, cC;
    for (int m = gw; m < NTOK; m += NGW, ++ri) {
        const int b = m / SEQ;
        if (b != cb) { cb = b;
            if (MODE == ROW_B) { cv_resid(F, cR, F.in[I_NMIXPOST] + l * D, l, b, 2 * D); cv_h(F, cA, cC, F.in[I_NFFNPRE] + l * D, l, b, 3 * D, 4 * D); }
            if (MODE == ROW_C) cv_resid(F, cR, F.in[I_NFFNPOST] + l * D, l, b, 5 * D);
            if (do_h1) cv_h(F, cA, cC, F.in[I_NMIXPRE] + lh * D, lh, b, 0, 1 * D); }
        Row x; row_load_f32(F, x, xsrc + (size_t)m * D);
        if (MODE == ROW_B) {
            Row f; row_load_bf16(F, f, (const bf16*)(F.ws + WS_F) + (size_t)m * D);
            row_resid_cv(x, f, cR);
            row_store_f32(F, x, F.out + (size_t)m * D);
            Row h; row_make_h_cv(h, x, cA, cC);
            if (MOE_FP8 && l == 1) { GAS unsigned* o4 = (GAS unsigned*)(F.ws + WS_H2B + (size_t)m * D) + F.lane;
#pragma unroll
                for (int j = 0; j < 4; ++j) o4[64 * j] = pk4_fp8(h.v[j].x, h.v[j].y, h.v[j].z, h.v[j].w); }
            else row_store_bf16(F, h, (bf16*)(F.ws + (l == 0 ? WS_H : WS_H2B)) + (size_t)m * D);
            if (router) {
                float lg[NEXP]; row_dots<NEXP>(F, h, WT, lg);
                int e0 = 0; float l0 = lg[0] + F.in[I_ROUTERB][0];
#pragma unroll
                for (int e = 0; e < NEXP; ++e) lg[e] += F.in[I_ROUTERB][e];
#pragma unroll
                for (int e = 1; e < NEXP; ++e) if (lg[e] > l0) { l0 = lg[e]; e0 = e; }
                int e1 = -1; float l1 = -3.0e38f;
#pragma unroll
                for (int e = 0; e < NEXP; ++e) if (e != e0 && lg[e] > l1) { l1 = lg[e]; e1 = e; }
                const float q1 = __expf(l1 - l0), p0 = 1.f / (1.f + q1), p1 = q1 * p0;
                if (F.lane == 0) {
                    const int i0 = atomicAdd((int*)&lcnt[e0], 1), i1 = atomicAdd((int*)&lcnt[e1], 1);
                    LAS int* li = linfo + (F.wave * 32 + ri) * 4;
                    li[0] = e0 | (e1 << 8) | (i0 << 16); li[1] = i1; li[2] = __float_as_int(p0); li[3] = __float_as_int(p1);
                }
            }
        } else if (MODE == ROW_C) {
            Row f;
            if (l == 0) row_load_bf16(F, f, (const bf16*)(F.ws + WS_F) + (size_t)m * D);
            else {
                const int* ti = (const int*)(F.ws + WS_ROUTE) + (size_t)m * 8;
                const int e0 = ti[0], i0 = ti[1], e1 = ti[2], i1 = ti[3]; const float p0 = __int_as_float(ti[4]), p1 = __int_as_float(ti[5]);
                int s0 = 0, s1 = 0;
#pragma unroll
                for (int e = 0; e < NEXP; ++e) { s0 = (e == e0) ? tstart[e] * 256 + i0 : s0; s1 = (e == e1) ? tstart[e] * 256 + i1 : s1; }
                Row y0, y1; row_load_bf16(F, y0, (const bf16*)(F.ws + WS_Y) + (size_t)s0 * D); row_load_bf16(F, y1, (const bf16*)(F.ws + WS_Y) + (size_t)s1 * D);
#pragma unroll
                for (int j = 0; j < 4; ++j) f.v[j] = y0.v[j] * p0 + y1.v[j] * p1;
            }
            row_resid_cv(x, f, cR);
            row_store_f32(F, x, F.out + (size_t)m * D);
        }
        if (do_h1) {
            Row h; row_make_h_cv(h, x, cA, cC);
            row_store_bf16(F, h, (bf16*)(F.ws + WS_H) + (size_t)m * D);
            row_bd(F, h, WT, lh, m);
        }
    }
    if (router) {
        __syncthreads();
        if (F.tid < NEXP) lcnt[8 + F.tid] = (int)__hip_atomic_fetch_add(F.ctl + CW_MOECNT + 64 * F.tid, (unsigned)lcnt[F.tid], RLX_AGENT);
        __syncthreads();
        ri = 0;
        for (int m = gw; m < NTOK; m += NGW, ++ri) {
            if (F.lane == 0) {
                const LAS int* li = linfo + (F.wave * 32 + ri) * 4;
                const int w0 = li[0], e0 = w0 & 255, e1 = (w0 >> 8) & 255, i0 = (w0 >> 16) + lcnt[8 + e0], i1 = li[1] + lcnt[8 + e1];
                int* ti = (int*)(F.ws + WS_ROUTE) + (size_t)m * 8;
                ti[0] = e0; ti[1] = i0; ti[2] = e1; ti[3] = i1; ti[4] = li[2]; ti[5] = li[3];
                int* lists = (int*)(F.ws + WS_ROUTE + 1 * MiB);
                lists[(size_t)e0 * 65536 + i0] = m; lists[(size_t)e1 * 65536 + i1] = m;
            }
        }
    }
    __syncthreads();
}

namespace pg8 {
constexpr int NXCD = 8, WGM = 8;
struct SchedStd {
    int nM, nN, nwg, G, c; const char* A; size_t a_tile; const char* B; size_t b_tile;
    __device__ __forceinline__ void init(int nM_, int nN_, int G_, int c_, const void* A_, size_t a_tile_, const void* B_, size_t b_tile_) { nM = nM_; nN = nN_; nwg = nM * nN; G = G_; c = c_; A = (const char*)A_; a_tile = a_tile_; B = (const char*)B_; b_tile = b_tile_; }
    __device__ __forceinline__ bool next(int i, Unit& u) const {
        const long L = (long)i * G + c; if (L >= nwg) return false;
        int wgid = (int)L; { const int q = nwg / NXCD, r = nwg % NXCD, xcd = wgid % NXCD, off = wgid / NXCD; wgid = (xcd < r ? xcd * (q + 1) : r * (q + 1) + (xcd - r) * q) + off; }
        const int nig = WGM * nN, gid = wgid / nig, fm = gid * WGM, gsz = (nM - fm) < WGM ? (nM - fm) : WGM;
        u.pm = fm + ((wgid % nig) % gsz); u.pn = (wgid % nig) / gsz; u.aux = 0; u.nt = 0; u.a = A + (size_t)u.pm * a_tile; u.b = B + (size_t)u.pn * b_tile; u.rows = nullptr; return true;
    }
    __device__ __forceinline__ void a_ready(const Unit&) const {}
    __device__ __forceinline__ void done(const Unit&) const {}
};
struct SchedBranch {
    SchedStd s; const char* O4; const char* Wb;
    __device__ __forceinline__ bool next(int i, Unit& u) const {
        if (!s.next(i, u)) return false;
        const int br = u.pn >> 2; u.pn &= 3; u.aux = br;
        u.a = O4 + (size_t)u.pm * 256 * 1024 * 2 + (size_t)br * 256 * 2; u.b = Wb + (size_t)br * 1024 * 256 * 2 + (size_t)u.pn * 256 * 256 * 2; return true;
    }
    __device__ __forceinline__ void a_ready(const Unit&) const {}
    __device__ __forceinline__ void done(const Unit&) const {}
};
struct SchedGate {
    int vcu, G; const char* H; const char* Wm;
    __device__ __forceinline__ bool next(int i, Unit& u) const {
        const int tg = vcu + G * (i >> 2); if (tg >= 512) return false;
        u.pm = tg >> 2; u.pn = tg & 3; u.aux = i & 3; u.nt = 0; u.rows = nullptr;
        u.a = H + (size_t)u.pm * 256 * 1024 * 2; u.b = Wm + ((size_t)u.aux * 1024 + (size_t)u.pn * 256) * 1024 * 2; return true;
    }
    __device__ __forceinline__ void a_ready(const Unit&) const {}
    __device__ __forceinline__ void done(const Unit&) const {}
};
struct SchedMoe {
    int c, G, t0, t1, nN; int tstart[9]; int cnt[8];
    const char* A; const int* lists; const char* W; size_t w_tile; bool gather; size_t exp_stride, act_tile;
    __device__ __forceinline__ bool next(int i, Unit& u) const {
        const long L = (long)i * G + c; const int t = t0 + (int)(L / nN); if (t >= t1) return false;
        int e = 0;
#pragma unroll
        for (int k = 1; k < 8; ++k) e = (t >= tstart[k]) ? k : e;
        int ce = 0;
#pragma unroll
        for (int k = 0; k < 8; ++k) ce = (k == e) ? cnt[k] : ce;
        const int j = t - ((e == 0) ? 0 : 0), jj = t;
        (void)j; (void)jj;
        int ts = 0;
#pragma unroll
        for (int k = 0; k < 8; ++k) ts = (k == e) ? tstart[k] : ts;
        const int tj = t - ts;
        u.pn = (int)(L % nN); u.nt = 0;
        if (gather) { u.pm = t - t0; u.a = A; u.rows = lists + (size_t)e * 65536 + tj * 256; const int nv = ce - tj * 256; u.aux = nv > 256 ? 256 : nv; }
        else { u.pm = t; u.a = A + (size_t)(t - t0) * act_tile; u.rows = nullptr; u.aux = 0; }
        u.b = W + (size_t)e * exp_stride + (size_t)u.pn * w_tile; return true;
    }
    static constexpr size_t DFF_ = 2816; static constexpr size_t SZ_EXP_ = (size_t)2 * 2816 * 1024 * 2 + (size_t)1024 * 2816 * 2;
    __device__ __forceinline__ void a_ready(const Unit&) const {}
    __device__ __forceinline__ void done(const Unit&) const {}
};

struct EpiStore {
    static constexpr bool PERM = true;
    bf16_t* O; int ldc; size_t aux_stride; float scale0;
    __device__ __forceinline__ void operator()(const f32x4 (&acc)[2][2][4][2], const Unit& u, int wr, int wc, int fr, int fq) const {
        const int row0 = u.pm * BM + wr * 64 + fr, col0 = u.pn * BM + wc * 32 + 8 * fq; bf16_t* base = O + (size_t)u.aux * aux_stride;
        const float sc = scale0;
#pragma unroll
        for (int ai = 0; ai < 2; ++ai)
#pragma unroll
            for (int m = 0; m < 4; ++m) { bf16_t* rowp = base + (size_t)(row0 + ai * HALF + m * 16) * ldc + col0;
#pragma unroll
                for (int bj = 0; bj < 2; ++bj) { const f32x4 v0 = acc[ai][bj][m][0] * sc, v1 = acc[ai][bj][m][1] * sc;
                    u32x4 w; w.x = cvt_pk_bf16(v0[0], v0[1]); w.y = cvt_pk_bf16(v0[2], v0[3]); w.z = cvt_pk_bf16(v1[0], v1[1]); w.w = cvt_pk_bf16(v1[2], v1[3]);
                    *(u32x4*)(rowp + bj * HALF) = w; } }
    }
};

struct EpiStore64 {
    static constexpr bool PERM = true;
    bf16_t* O;
    __device__ __forceinline__ void operator()(const f32x4 (&acc)[2][2][4][2], const Unit& u, int wr, int wc, int fr, int fq) const {
        int fr_ = fr, fq_ = fq; asm volatile("" : "+v"(fr_), "+v"(fq_));
        bf16_t* base = O + (size_t)(u.pm * BM + wr * 64 + fr_) * 1024 + u.pn * BM + wc * 32 + 8 * fq_;
#pragma unroll
        for (int ai = 0; ai < 2; ++ai)
#pragma unroll
            for (int m = 0; m < 4; ++m) {
#pragma unroll
                for (int bj = 0; bj < 2; ++bj) { const f32x4 v0 = acc[ai][bj][m][0] * (1.f / 64.f), v1 = acc[ai][bj][m][1] * (1.f / 64.f);
                    u32x4 w; w.x = cvt_pk_bf16(v0[0], v0[1]); w.y = cvt_pk_bf16(v0[2], v0[3]); w.z = cvt_pk_bf16(v1[0], v1[1]); w.w = cvt_pk_bf16(v1[2], v1[3]);
                    *(u32x4*)(base + (ai * HALF + m * 16) * 1024 + bj * HALF) = w; }
                __builtin_amdgcn_sched_barrier(0); }
    }
};
struct EpiProj {
    static constexpr bool PERM = true;
    static constexpr int TILE_E = 9728;
    bf16_t* Qb; bf16_t* KV; bf16_t* Pj; unsigned* nmax; float qscale;
    __device__ __forceinline__ void operator()(const f32x4 (&acc)[2][2][4][2], const Unit& u, int wr, int wc, int fr, int fq) const {
        const int t0 = u.pm * BM + wr * 64 + fr;
        const int b = (u.pm * BM) >> 14;
        const int s00 = t0 & 16383;
        if (u.pn >= 3) {
            bf16_t* base = Pj + (size_t)t0 * 2048 + (u.pn - 3) * BM + wc * 32 + 8 * fq;
#pragma unroll
            for (int ai = 0; ai < 2; ++ai)
#pragma unroll
                for (int m = 0; m < 4; ++m) {
#pragma unroll
                    for (int bj = 0; bj < 2; ++bj) { const f32x4 v0 = acc[ai][bj][m][0], v1 = acc[ai][bj][m][1];
                        u32x4 w; w.x = cvt_pk_bf16(v0[0], v0[1]); w.y = cvt_pk_bf16(v0[2], v0[3]); w.z = cvt_pk_bf16(v1[0], v1[1]); w.w = cvt_pk_bf16(v1[2], v1[3]);
                        *(u32x4*)(base + (ai * HALF + m * 16) * 2048 + bj * HALF) = w; }
                    __builtin_amdgcn_sched_barrier(0); }
        } else if (u.pn == 2) {
            bf16_t* hb = KV + ((size_t)((b * 4 + (wc >> 1)) * 256 + (s00 >> 6))) * TILE_E + 5120 + (32 * (wc & 1) + 8 * fq) * 72 + (s00 & 63);
#pragma unroll
            for (int ai = 0; ai < 2; ++ai)
#pragma unroll
                for (int bj = 0; bj < 2; ++bj) { bf16_t* tb = hb + (size_t)bj * (2 * 256 * TILE_E) + ai * (2 * TILE_E);
#pragma unroll
                    for (int m = 0; m < 4; ++m)
#pragma unroll
                        for (int n = 0; n < 2; ++n)
#pragma unroll
                            for (int j = 0; j < 4; ++j) { const float v = acc[ai][bj][m][n][j];
                                unsigned bits = __builtin_bit_cast(unsigned, v); bits = (bits + 0x7fffu + ((bits >> 16) & 1u)) >> 16;
                                tb[(4 * n + j) * 72 + 16 * m] = (bf16_t)bits; }
                    __builtin_amdgcn_sched_barrier(0); }
        } else {
            const float sc = (u.pn == 0) ? qscale : 1.f; float nm = 0.f;
            bf16_t* qbase = Qb + ((size_t)(b * 4 + wc) * 16384 + s00) * 64 + 8 * fq;
            bf16_t* kbase = KV + ((size_t)((b * 4 + wc) * 256 + (s00 >> 6))) * TILE_E + (s00 & 63) * 40 + 8 * fq;
#pragma unroll
            for (int ai = 0; ai < 2; ++ai)
#pragma unroll
                for (int m = 0; m < 4; ++m) {
#pragma unroll
                    for (int bj = 0; bj < 2; ++bj) { const f32x4 v0 = acc[ai][bj][m][0] * sc, v1 = acc[ai][bj][m][1] * sc;
                        u32x4 w; w.x = cvt_pk_bf16(v0[0], v0[1]); w.y = cvt_pk_bf16(v0[2], v0[3]); w.z = cvt_pk_bf16(v1[0], v1[1]); w.w = cvt_pk_bf16(v1[2], v1[3]);
                        float ss = (v0[0] * v0[0] + v0[1] * v0[1]) + (v0[2] * v0[2] + v0[3] * v0[3]) + (v1[0] * v1[0] + v1[1] * v1[1]) + (v1[2] * v1[2] + v1[3] * v1[3]);
                        ss += __shfl_xor(ss, 16); ss += __shfl_xor(ss, 32); nm = fmaxf(nm, ss);
                        if (u.pn == 0) *(u32x4*)(qbase + (ai * HALF + m * 16) * 64 + 32 * bj) = w;
                        else *(u32x4*)(kbase + ai * (2 * TILE_E) + bj * 2560 + (16 * m) * 40) = w; }
                    __builtin_amdgcn_sched_barrier(0); }
            nm = fmaxf(nm, __shfl_xor(nm, 1)); nm = fmaxf(nm, __shfl_xor(nm, 2)); nm = fmaxf(nm, __shfl_xor(nm, 4)); nm = fmaxf(nm, __shfl_xor(nm, 8));
            if (fr == 0 && fq == 0) atomicMax(nmax + (b * 4 + wc) * 2 + u.pn, __builtin_bit_cast(unsigned, nm));
        }
    }
};
__device__ __forceinline__ float sigm(float x) { return __builtin_amdgcn_rcpf(1.f + __builtin_amdgcn_exp2f(-1.4426950408889634f * x)); }
struct EpiGate {
    static constexpr bool PERM = true;
    const bf16_t* P; bf16_t* Mg; const float* bias;
    __device__ __forceinline__ void operator()(const f32x4 (&acc)[2][2][4][2], const Unit& u, int wr, int wc, int fr, int fq) const {
        const int row0 = u.pm * BM + wr * 64 + fr, col0 = u.pn * BM + wc * 32 + 8 * fq; const int br = u.aux;
        const bf16_t* Pb = P + (size_t)br * 32768 * 1024; const float* bb = bias + br * 1024 + col0;
        f32x4 bv[2][2];
#pragma unroll
        for (int bj = 0; bj < 2; ++bj)
#pragma unroll
            for (int n = 0; n < 2; ++n) bv[bj][n] = *(const f32x4*)(bb + bj * HALF + 4 * n);
#pragma unroll
        for (int ai = 0; ai < 2; ++ai)
#pragma unroll
            for (int m = 0; m < 4; ++m) { const size_t ro = (size_t)(row0 + ai * HALF + m * 16) * 1024 + col0;
#pragma unroll
                for (int bj = 0; bj < 2; ++bj) {
                    const u32x4 pw = *(const u32x4*)(Pb + ro + bj * HALF);
                    u32x4 mw = {0u, 0u, 0u, 0u}; if (br != 0) mw = *(const u32x4*)(Mg + ro + bj * HALF);
                    float o[8];
#pragma unroll
                    for (int q = 0; q < 4; ++q) {
                        const float g0 = sigm(acc[ai][bj][m][q >> 1][(q & 1) * 2] + bv[bj][q >> 1][(q & 1) * 2]), g1 = sigm(acc[ai][bj][m][q >> 1][(q & 1) * 2 + 1] + bv[bj][q >> 1][(q & 1) * 2 + 1]);
                        o[2 * q] = g0 * __builtin_bit_cast(float, pw[q] << 16) + __builtin_bit_cast(float, mw[q] << 16);
                        o[2 * q + 1] = g1 * __builtin_bit_cast(float, pw[q] & 0xffff0000u) + __builtin_bit_cast(float, mw[q] & 0xffff0000u);
                    }
                    u32x4 w; w.x = cvt_pk_bf16(o[0], o[1]); w.y = cvt_pk_bf16(o[2], o[3]); w.z = cvt_pk_bf16(o[4], o[5]); w.w = cvt_pk_bf16(o[6], o[7]);
                    *(u32x4*)(Mg + ro + bj * HALF) = w; } }
    }
};
struct SchedGateP {
    int vcu, G; const char* ws; size_t oH, oWm, oO4, oWb4;
    __device__ __forceinline__ bool next(int i, Unit& u) const {
        const int tg = vcu + G * (i >> 3); if (tg >= 512) return false;
        const int br = (i >> 1) & 3, isg = i & 1;
        u.pm = tg >> 2; u.pn = tg & 3; u.rows = nullptr;
        if (isg) { u.aux = br; u.nt = 16; u.a = ws + oH + (size_t)u.pm * 256 * 1024 * 2; u.b = ws + oWm + ((size_t)br * 1024 + (size_t)u.pn * 256) * 1024 * 2; }
        else { u.aux = br | 4; u.nt = 4; u.a = ws + oO4 + (size_t)u.pm * 256 * 1024 * 2 + br * 512; u.b = ws + oWb4 + (size_t)u.pn * 256 * 1024 * 2 + br * 512; }
        return true;
    }
    __device__ __forceinline__ void a_ready(const Unit&) const {}
    __device__ __forceinline__ void done(const Unit&) const {}
};
struct EpiGateP {
    static constexpr bool PERM = true;
    bf16_t* Pscr; bf16_t* Mg; const float* bias; int tid;
    __device__ __forceinline__ void operator()(const f32x4 (&acc)[2][2][4][2], const Unit& u, int wr, int wc, int fr, int fq) const {
        u32x4* ps = (u32x4*)Pscr + tid;
        if (u.aux & 4) {
#pragma unroll
            for (int ai = 0; ai < 2; ++ai)
#pragma unroll
                for (int m = 0; m < 4; ++m)
#pragma unroll
                    for (int bj = 0; bj < 2; ++bj) { const f32x4 v0 = acc[ai][bj][m][0], v1 = acc[ai][bj][m][1];
                        u32x4 w; w.x = cvt_pk_bf16(v0[0], v0[1]); w.y = cvt_pk_bf16(v0[2], v0[3]); w.z = cvt_pk_bf16(v1[0], v1[1]); w.w = cvt_pk_bf16(v1[2], v1[3]);
                        ps[((ai * 4 + m) * 2 + bj) * 512] = w; }
            return;
        }
        int fr_ = fr, fq_ = fq; asm volatile("" : "+v"(fr_), "+v"(fq_));
        const int row0 = u.pm * BM + wr * 64 + fr_, col0 = u.pn * BM + wc * 32 + 8 * fq_; const int br = u.aux;
        const float* bb = bias + br * 1024 + col0;
#pragma unroll
        for (int ai = 0; ai < 2; ++ai)
#pragma unroll
            for (int m = 0; m < 4; ++m) { const size_t ro = (size_t)(row0 + ai * HALF + m * 16) * 1024 + col0;
#pragma unroll
                for (int bj = 0; bj < 2; ++bj) {
                    const f32x4 b0 = *(const f32x4*)(bb + bj * HALF), b1 = *(const f32x4*)(bb + bj * HALF + 4);
                    const u32x4 pw = ps[((ai * 4 + m) * 2 + bj) * 512];
                    u32x4 mw = {0u, 0u, 0u, 0u}; if (br != 0) mw = *(const u32x4*)(Mg + ro + bj * HALF);
                    const f32x4 a0 = acc[ai][bj][m][0] + b0, a1 = acc[ai][bj][m][1] + b1;
                    float o[8];
                    o[0] = sigm(a0[0]) * __builtin_bit_cast(float, pw[0] << 16) + __builtin_bit_cast(float, mw[0] << 16);
                    o[1] = sigm(a0[1]) * __builtin_bit_cast(float, pw[0] & 0xffff0000u) + __builtin_bit_cast(float, mw[0] & 0xffff0000u);
                    o[2] = sigm(a0[2]) * __builtin_bit_cast(float, pw[1] << 16) + __builtin_bit_cast(float, mw[1] << 16);
                    o[3] = sigm(a0[3]) * __builtin_bit_cast(float, pw[1] & 0xffff0000u) + __builtin_bit_cast(float, mw[1] & 0xffff0000u);
                    o[4] = sigm(a1[0]) * __builtin_bit_cast(float, pw[2] << 16) + __builtin_bit_cast(float, mw[2] << 16);
                    o[5] = sigm(a1[1]) * __builtin_bit_cast(float, pw[2] & 0xffff0000u) + __builtin_bit_cast(float, mw[2] & 0xffff0000u);
                    o[6] = sigm(a1[2]) * __builtin_bit_cast(float, pw[3] << 16) + __builtin_bit_cast(float, mw[3] << 16);
                    o[7] = sigm(a1[3]) * __builtin_bit_cast(float, pw[3] & 0xffff0000u) + __builtin_bit_cast(float, mw[3] & 0xffff0000u);
                    u32x4 w; w.x = cvt_pk_bf16(o[0], o[1]); w.y = cvt_pk_bf16(o[2], o[3]); w.z = cvt_pk_bf16(o[4], o[5]); w.w = cvt_pk_bf16(o[6], o[7]);
                    *(u32x4*)(Mg + ro + bj * HALF) = w;
                    __builtin_amdgcn_sched_barrier(0); } }
    }
};
template <bool F8 = false> struct EpiSwiGLU {
    static constexpr bool PERM = true;
    bf16_t* O; int ldc;
    __device__ __forceinline__ void operator()(const f32x4 (&acc)[2][2][4][2], const Unit& u, int wr, int wc, int fr, int fq) const {
        const int row0 = u.pm * BM + wr * 64 + fr, col0 = u.pn * HALF + wc * 32 + 8 * fq;
#pragma unroll
        for (int ai = 0; ai < 2; ++ai)
#pragma unroll
            for (int m = 0; m < 4; ++m) {
                float o[8]; constexpr float isc = F8 ? (1.f / 64.f) : 1.f;
#pragma unroll
                for (int n = 0; n < 2; ++n)
#pragma unroll
                    for (int q = 0; q < 4; ++q) { const float g = acc[ai][0][m][n][q] * isc, up = acc[ai][1][m][n][q] * isc; o[4 * n + q] = g * sigm(g) * up; }
                if constexpr (F8) { int w0 = __builtin_amdgcn_cvt_pk_fp8_f32(o[0], o[1], 0, false); w0 = __builtin_amdgcn_cvt_pk_fp8_f32(o[2], o[3], w0, true);
                    int w1 = __builtin_amdgcn_cvt_pk_fp8_f32(o[4], o[5], 0, false); w1 = __builtin_amdgcn_cvt_pk_fp8_f32(o[6], o[7], w1, true);
                    u32x2 w = {(unsigned)w0, (unsigned)w1}; *(u32x2*)((unsigned char*)O + (size_t)(row0 + ai * HALF + m * 16) * ldc + col0) = w; }
                else { bf16_t* rowp = O + (size_t)(row0 + ai * HALF + m * 16) * ldc + col0;
                    u32x4 w; w.x = cvt_pk_bf16(o[0], o[1]); w.y = cvt_pk_bf16(o[2], o[3]); w.z = cvt_pk_bf16(o[4], o[5]); w.w = cvt_pk_bf16(o[6], o[7]);
                    *(u32x4*)rowp = w; } }
    }
};
}

namespace att {
#ifndef ATT_T
#define ATT_T 40.f
#endif
#ifndef ATT_PRIO
#define ATT_PRIO 1
#endif
#ifndef ATT_ILV
#define ATT_ILV 10
#endif
#ifndef ATT_THR
#define ATT_THR 60.f
#endif
constexpr int SLOT = 19456, NSLOT = 6;
constexpr int ATTN_LDS = NSLOT * SLOT;
__device__ __forceinline__ unsigned cvtpk(float lo, float hi) { typedef float f2 __attribute__((ext_vector_type(2))); typedef __bf16 b2 __attribute__((ext_vector_type(2))); f2 v = {lo, hi}; b2 b = __builtin_convertvector(v, b2); return __builtin_bit_cast(unsigned, b); }
#define ATT_WAITV(n) asm volatile("s_waitcnt vmcnt(" #n ")" ::: "memory")
__device__ __forceinline__ float max3f(float a, float b, float c) { float r; asm("v_max3_f32 %0, %1, %2, %3" : "=v"(r) : "v"(a), "v"(b), "v"(c)); return r; }

#define ATT_SOFTMAX(s0, s1, pw, LS) do { \
    if (!nomax) { \
    asm volatile("s_nop 15\n\ts_nop 7" : "+v"(s0), "+v"(s1)); \
    float rm = max3f(s0[0], s0[1], s1[0]), rm2 = max3f(s0[2], s0[3], s1[1]); rm = max3f(rm, s1[2], s1[3]); \
    _Pragma("unroll") for (int r = 4; r < 16; r += 4) { rm = max3f(rm, s0[r], s0[r + 1]); rm2 = max3f(rm2, s0[r + 2], s0[r + 3]); rm = max3f(rm, s1[r], s1[r + 1]); rm2 = max3f(rm2, s1[r + 2], s1[r + 3]); } \
    rm = fmaxf(rm, rm2); \
    { auto rr = __builtin_amdgcn_permlane32_swap(__builtin_bit_cast(unsigned, rm), __builtin_bit_cast(unsigned, rm), false, false); rm = fmaxf(__builtin_bit_cast(float, rr[0]), __builtin_bit_cast(float, rr[1])); } \
    if (__any(rm > ATT_THR)) { \
        const float dd = fmaxf(rm, 0.f); R += dd; \
        const float f = fast_exp2(-dd); l1 *= f; l2 *= f; \
        _Pragma("unroll") for (int r = 0; r < 16; ++r) { s0[r] -= dd; s1[r] -= dd; c0[r] -= dd; c1[r] -= dd; O1[0][r] *= f; O1[1][r] *= f; O2[0][r] *= f; O2[1][r] *= f; } \
        p1scale = f; \
    } } \
    { float sa_ = 0.f, sb_ = 0.f; _Pragma("unroll") for (int r = 0; r < 16; ++r) { s0[r] = fast_exp2(s0[r]); s1[r] = fast_exp2(s1[r]); sa_ += s0[r]; sb_ += s1[r]; } LS += sa_ + sb_; } \
    _Pragma("unroll") for (int e = 0; e < 4; ++e) { pw[0][e] = cvtpk(s0[2 * e], s0[2 * e + 1]); pw[1][e] = cvtpk(s0[8 + 2 * e], s0[8 + 2 * e + 1]); pw[2][e] = cvtpk(s1[2 * e], s1[2 * e + 1]); pw[3][e] = cvtpk(s1[8 + 2 * e], s1[8 + 2 * e + 1]); } \
} while (0)

#define ATT_EXPPACK(s0, s1, pw, LS) do { \
    { float sa_ = 0.f, sb_ = 0.f; _Pragma("unroll") for (int r = 0; r < 16; ++r) { s0[r] = fast_exp2(s0[r]); s1[r] = fast_exp2(s1[r]); sa_ += s0[r]; sb_ += s1[r]; } LS += sa_ + sb_; } \
    _Pragma("unroll") for (int e = 0; e < 4; ++e) { pw[0][e] = cvtpk(s0[2 * e], s0[2 * e + 1]); pw[1][e] = cvtpk(s0[8 + 2 * e], s0[8 + 2 * e + 1]); pw[2][e] = cvtpk(s1[2 * e], s1[2 * e + 1]); pw[3][e] = cvtpk(s1[8 + 2 * e], s1[8 + 2 * e + 1]); } \
} while (0)
__device__ __forceinline__ void attn_unit(Frame& F, const int layer, const int b, const int h, const int qb) {
    const int lane = F.lane, r32 = lane & 31, hi = lane >> 5, wid = F.wave;
    LAS unsigned char* L = F.lds + RING_OFF;
    const int qw0 = qb * 256 + wid * 32, q = qw0 + r32;
    const float slope2 = exp2f(-2.f * (float)(h + 1)) * 1.4426950408889634f;
    int tlo, thi; float knb;
    { const unsigned* nm = (const unsigned*)(F.ctl + CW_NMAX) + layer * 16 + (b * 4 + h) * 2;
      const float qn = sqrtf(__builtin_bit_cast(float, __hip_atomic_load(nm, RLX_AGENT))) * 1.01f, kn = sqrtf(__builtin_bit_cast(float, __hip_atomic_load(nm + 1, RLX_AGENT))) * 1.01f;
      knb = kn;
      const float wf = (ATT_T + 2.f * qn * kn) / slope2; const int W = wf > 100000.f ? 100000 : (int)wf + 1;
      const int lo = qb * 256 - W, hi_ = qb * 256 + 255 + W; tlo = lo < 0 ? 0 : (lo >> 6); thi = hi_ >= SEQ ? (SEQ / 64 - 1) : (hi_ >> 6);
      if (((thi - tlo + 1) & 1) != 0) { if (thi < SEQ / 64 - 1) ++thi; else --tlo; } }
    const int nP = (thi - tlo + 1) >> 1;
    const bf16* Qp = (const bf16*)(F.ws + WS_QB) + ((size_t)(b * 4 + h) * SEQ + q) * 64;
    const __amdgpu_buffer_rsrc_t kvr = __builtin_amdgcn_make_buffer_rsrc((void*)pg8::uniform_ptr((const char*)(F.ws + WS_KV + ((size_t)(b * 4 + h) * 256) * SLOT)), 0, 0x7fffffff, 0x00020000);
    const unsigned kvlo = (unsigned)lane * 16u;
    const bool w3 = wid < 3;
#define ATT_DMA1(t, slot) do { const int so_ = (t) * SLOT + wid * 1024; LAS unsigned char* d_ = L + (slot) * SLOT + wid * 1024; \
        __builtin_amdgcn_raw_ptr_buffer_load_lds(kvr, (LAS unsigned*)d_, 16, kvlo, so_, 0, 0); __builtin_amdgcn_raw_ptr_buffer_load_lds(kvr, (LAS unsigned*)(d_ + 8192), 16, kvlo, so_ + 8192, 0, 0); \
        if (w3) __builtin_amdgcn_raw_ptr_buffer_load_lds(kvr, (LAS unsigned*)(d_ + 16384), 16, kvlo, so_ + 16384, 0, 0); } while (0)
#define ATT_DMA2(pr, ps) do { ATT_DMA1(tlo + 2 * (pr), 2 * (ps)); ATT_DMA1(tlo + 2 * (pr) + 1, 2 * (ps) + 1); } while (0)
    LAS unsigned char* QS = L + NSLOT * SLOT + wid * 4096 + lane * 16;
    float qkb;
    {
    bf16x8 q1f[2], q2f[2];
#pragma unroll
    for (int ks = 0; ks < 2; ++ks) { q1f[ks] = *(const GAS bf16x8*)(Qp + 16 * ks + 8 * hi); q2f[ks] = *(const GAS bf16x8*)(Qp + 32 + 16 * ks + 8 * hi); }
    asm volatile("s_waitcnt vmcnt(0)" ::: "memory");
    { float n1 = 0.f, n2 = 0.f;
#pragma unroll
      for (int ks = 0; ks < 2; ++ks) { const v4u a = __builtin_bit_cast(v4u, q1f[ks]), c = __builtin_bit_cast(v4u, q2f[ks]);
#pragma unroll
          for (int e = 0; e < 4; ++e) { n1 += bflo(a[e]) * bflo(a[e]) + bfhi(a[e]) * bfhi(a[e]); n2 += bflo(c[e]) * bflo(c[e]) + bfhi(c[e]) * bfhi(c[e]); } }
      n1 += LANE_XOR_F(lane, n1, 32); n2 += LANE_XOR_F(lane, n2, 32);
      qkb = sqrtf(fmaxf(n1, n2)) * 1.01f * knb; }
    *(LAS bf16x8*)(QS) = q1f[0]; *(LAS bf16x8*)(QS + 1024) = q1f[1]; *(LAS bf16x8*)(QS + 2048) = q2f[0]; *(LAS bf16x8*)(QS + 3072) = q2f[1];
    }
    ATT_DMA2(0, 0);
    if (nP > 1) ATT_DMA2(1, 1);
    float R = 0.f, l1 = 0.f, l2 = 0.f;
    f32x16 O1[2], O2[2];
#pragma unroll
    for (int i = 0; i < 16; ++i) { O1[0][i] = 0.f; O1[1][i] = 0.f; O2[0][i] = 0.f; O2[1][i] = 0.f; }
    const int pr32 = (r32 & 0x13) | ((r32 & 4) << 1) | ((r32 & 8) >> 1);
    const int kfo = pr32 * 80 + hi * 16;
    const int vfo = 10240 + r32 * 144 + hi * 16;
    bf16x8 Ab0; unsigned ab1d1, ab1d2;
#define ATT_MAKE_AB() do { int ln_ = fresh_lane(); asm volatile("" : "+v"(ln_)); const int r_ = ln_ & 31, p_ = (r_ & 0x13) | ((r_ & 4) << 1) | ((r_ & 8) >> 1); const unsigned lm = (ln_ >> 5) ? 0u : 0xffffffffu; \
      const unsigned j0 = __builtin_bit_cast(unsigned, (float)p_) >> 16, j1 = __builtin_bit_cast(unsigned, (float)(p_ + 32)) >> 16; \
      const v4u a0 = {0x3F803F80u & lm, (0x3F80u | (j0 << 16)) & lm, j0 & lm, 0u}; \
      Ab0 = __builtin_bit_cast(bf16x8, a0); ab1d1 = (0x3F80u | (j1 << 16)) & lm; ab1d2 = j1 & lm; } while (0)
    unsigned sd1p, sd2p;
    { const unsigned sb = __builtin_bit_cast(unsigned, slope2), sh = sb & 0xffff0000u; const float sl = slope2 - __builtin_bit_cast(float, sh);
      sd1p = sh; sd2p = __builtin_bit_cast(unsigned, sl) >> 16; }
    const unsigned sd1n = sd1p | 0x80000000u, sd2n = sd2p | 0x8000u;
#if ATT_PRIO
    if (wid >= 4) __builtin_amdgcn_s_setprio(ATT_PRIO);
#endif
    int ps = 0;
    int pA, pB;
    { const int tLend = (qw0 >> 6) - 1, tRbeg = ((qw0 + 31) >> 6) + 1;
      const int nl = tLend - tlo + 1; pA = nl > 0 ? (nl >> 1) : 0; pA = pA > nP ? nP : pA;
      const int d = tRbeg - tlo; pB = d > 0 ? ((d + 1) >> 1) : 0; pB = pB > nP ? nP : pB; pB = pB < pA ? pA : pB;
      if (__any(qkb > ATT_THR)) { pA = 0; pB = nP; } }
#define ATT_PAIR_HEAD(ip) do { \
        if ((ip) + 1 < nP) { if (w3) ATT_WAITV(6); else ATT_WAITV(4); } else ATT_WAITV(0); \
        __builtin_amdgcn_s_barrier(); \
        asm volatile("" ::: "memory"); \
        if ((ip) + 2 < nP) { const int s2 = ps >= 1 ? ps - 1 : 2; ATT_DMA2((ip) + 2, s2); } } while (0)
#define ATT_FAST_TILE(t, Bf, LEFT) do { \
        const bf16x8 ka00 = *(const LAS bf16x8*)((Bf) + kfo), ka01 = *(const LAS bf16x8*)((Bf) + kfo + 32), ka10 = *(const LAS bf16x8*)((Bf) + 32 * 80 + kfo), ka11 = *(const LAS bf16x8*)((Bf) + 32 * 80 + kfo + 32); \
        const bf16x8 q1a = *(const LAS bf16x8*)(QS), q1b = *(const LAS bf16x8*)(QS + 1024); \
        const float dq = (float)(q - (t) * 64); \
        const float tl = (LEFT) ? __builtin_fmaf(-slope2, dq, -R) : __builtin_fmaf(slope2, dq, -R); \
        const unsigned u0 = __builtin_bit_cast(unsigned, tl), hb = u0 & 0xffff0000u; \
        const float r1 = __builtin_bit_cast(float, u0) - __builtin_bit_cast(float, hb); \
        const unsigned mb = __builtin_bit_cast(unsigned, r1) & 0xffff0000u; \
        const float r2 = r1 - __builtin_bit_cast(float, mb); \
        const v4u bbv = {__builtin_amdgcn_perm(mb, hb, 0x07060302u), __builtin_amdgcn_perm((LEFT) ? sd1p : sd1n, __builtin_bit_cast(unsigned, r2), 0x07060302u), (LEFT) ? sd2p : sd2n, 0u}; \
        const bf16x8 Bb = __builtin_bit_cast(bf16x8, bbv); \
        const v4u ab1v = {__builtin_bit_cast(v4u, Ab0)[0], ab1d1, ab1d2, 0u}; const bf16x8 Ab1 = __builtin_bit_cast(bf16x8, ab1v); \
        f32x16 z16; _Pragma("unroll") for (int r = 0; r < 16; ++r) z16[r] = 0.f; \
        v4u pw1[4], pw2[4]; \
        f32x16 sa0 = __builtin_amdgcn_mfma_f32_32x32x16_bf16(Ab0, Bb, z16, 0, 0, 0), sa1 = __builtin_amdgcn_mfma_f32_32x32x16_bf16(Ab1, Bb, z16, 0, 0, 0); \
        sa0 = __builtin_amdgcn_mfma_f32_32x32x16_bf16(ka00, q1a, sa0, 0, 0, 0); sa1 = __builtin_amdgcn_mfma_f32_32x32x16_bf16(ka10, q1a, sa1, 0, 0, 0); \
        sa0 = __builtin_amdgcn_mfma_f32_32x32x16_bf16(ka01, q1b, sa0, 0, 0, 0); sa1 = __builtin_amdgcn_mfma_f32_32x32x16_bf16(ka11, q1b, sa1, 0, 0, 0); \
        __builtin_amdgcn_sched_barrier(0); \
        const bf16x8 kb00 = *(const LAS bf16x8*)((Bf) + 5120 + kfo), kb01 = *(const LAS bf16x8*)((Bf) + 5120 + kfo + 32), kb10 = *(const LAS bf16x8*)((Bf) + 5120 + 32 * 80 + kfo), kb11 = *(const LAS bf16x8*)((Bf) + 5120 + 32 * 80 + kfo + 32); \
        const bf16x8 q2a = *(const LAS bf16x8*)(QS + 2048), q2b = *(const LAS bf16x8*)(QS + 3072); \
        ATT_EXPPACK(sa0, sa1, pw1, l1); \
        __builtin_amdgcn_sched_barrier(0); \
        f32x16 sb0 = __builtin_amdgcn_mfma_f32_32x32x16_bf16(Ab0, Bb, z16, 0, 0, 0), sb1 = __builtin_amdgcn_mfma_f32_32x32x16_bf16(Ab1, Bb, z16, 0, 0, 0); \
        sb0 = __builtin_amdgcn_mfma_f32_32x32x16_bf16(kb00, q2a, sb0, 0, 0, 0); sb1 = __builtin_amdgcn_mfma_f32_32x32x16_bf16(kb10, q2a, sb1, 0, 0, 0); \
        sb0 = __builtin_amdgcn_mfma_f32_32x32x16_bf16(kb01, q2b, sb0, 0, 0, 0); sb1 = __builtin_amdgcn_mfma_f32_32x32x16_bf16(kb11, q2b, sb1, 0, 0, 0); \
        bf16x8 vf[2][4]; \
        _Pragma("unroll") for (int db = 0; db < 2; ++db) _Pragma("unroll") for (int ks = 0; ks < 4; ++ks) vf[db][ks] = *(const LAS bf16x8*)((Bf) + vfo + db * 32 * 144 + ks * 32); \
        __builtin_amdgcn_sched_barrier(0); \
          \
        _Pragma("unroll") for (int db = 0; db < 2; ++db) _Pragma("unroll") for (int ks = 0; ks < 4; ++ks) O1[db] = __builtin_amdgcn_mfma_f32_32x32x16_bf16(vf[db][ks], __builtin_bit_cast(bf16x8, pw1[ks]), O1[db], 0, 0, 0); \
        ATT_EXPPACK(sb0, sb1, pw2, l2); \
        _Pragma("unroll") for (int g_ = 0; g_ < 8; ++g_) { __builtin_amdgcn_sched_group_barrier(0x008, 1, 0); __builtin_amdgcn_sched_group_barrier(0x002, ATT_ILV, 0); } \
        __builtin_amdgcn_sched_barrier(0); \
        _Pragma("unroll") for (int db = 0; db < 2; ++db) _Pragma("unroll") for (int ks = 0; ks < 4; ++ks) O2[db] = __builtin_amdgcn_mfma_f32_32x32x16_bf16(vf[db][ks], __builtin_bit_cast(bf16x8, pw2[ks]), O2[db], 0, 0, 0); \
        __builtin_amdgcn_sched_barrier(0); } while (0)
    int ip = 0;
    ATT_MAKE_AB();
#pragma unroll 1
    for (; ip < pA; ++ip) {
        ATT_PAIR_HEAD(ip);
#pragma unroll 1
        for (int half = 0; half < 2; ++half) { const int t = tlo + 2 * ip + half; const LAS unsigned char* Bf = L + (2 * ps + half) * SLOT; ATT_FAST_TILE(t, Bf, true); }
        ps = ps == 2 ? 0 : ps + 1;
    }
#pragma unroll 1
    for (; ip < pB; ++ip) {
        ATT_PAIR_HEAD(ip);
#pragma unroll
        for (int half = 0; half < 2; ++half) {
            const int t = tlo + 2 * ip + half;
            const LAS unsigned char* Bf = L + (2 * ps + half) * SLOT;
            const bf16x8 q1f[2] = {*(const LAS bf16x8*)(QS), *(const LAS bf16x8*)(QS + 1024)}, q2f[2] = {*(const LAS bf16x8*)(QS + 2048), *(const LAS bf16x8*)(QS + 3072)};
            const float dl = (float)(q - t * 64 - 8 * hi);
            v4u pw1[4], pw2[4];
            const bf16x8 ka00 = *(const LAS bf16x8*)(Bf + kfo), ka01 = *(const LAS bf16x8*)(Bf + kfo + 32), ka10 = *(const LAS bf16x8*)(Bf + 32 * 80 + kfo), ka11 = *(const LAS bf16x8*)(Bf + 32 * 80 + kfo + 32);
            const bf16x8 kb00 = *(const LAS bf16x8*)(Bf + 5120 + kfo), kb01 = *(const LAS bf16x8*)(Bf + 5120 + kfo + 32), kb10 = *(const LAS bf16x8*)(Bf + 5120 + 32 * 80 + kfo), kb11 = *(const LAS bf16x8*)(Bf + 5120 + 32 * 80 + kfo + 32);
            f32x16 c0, c1; bool nomax;
            if (t * 64 + 63 < qw0) {
                const float tl = -slope2 * dl - R;
                nomax = false;
#pragma unroll
                for (int r = 0; r < 16; ++r) { const float cc = (float)(16 * (r >> 3) + (r & 7)); c0[r] = __builtin_fmaf(slope2, cc, tl); c1[r] = __builtin_fmaf(slope2, cc + 32.f, tl); }
            } else if (t * 64 > qw0 + 31) {
                const float tr = slope2 * dl - R;
                nomax = false;
#pragma unroll
                for (int r = 0; r < 16; ++r) { const float cc = (float)(16 * (r >> 3) + (r & 7)); c0[r] = __builtin_fmaf(-slope2, cc, tr); c1[r] = __builtin_fmaf(-slope2, cc + 32.f, tr); }
            } else {
                nomax = false;
#pragma unroll
                for (int r = 0; r < 16; ++r) { const float cc = (float)(16 * (r >> 3) + (r & 7)); c0[r] = __builtin_fmaf(-slope2, __builtin_fabsf(dl - cc), -R); c1[r] = __builtin_fmaf(-slope2, __builtin_fabsf(dl - (cc + 32.f)), -R); }
            }
            {
                f32x16 s0 = __builtin_amdgcn_mfma_f32_32x32x16_bf16(ka00, q1f[0], c0, 0, 0, 0); s0 = __builtin_amdgcn_mfma_f32_32x32x16_bf16(ka01, q1f[1], s0, 0, 0, 0);
                f32x16 s1 = __builtin_amdgcn_mfma_f32_32x32x16_bf16(ka10, q1f[0], c1, 0, 0, 0); s1 = __builtin_amdgcn_mfma_f32_32x32x16_bf16(ka11, q1f[1], s1, 0, 0, 0);
                float p1scale = 1.f; ATT_SOFTMAX(s0, s1, pw1, l1); (void)p1scale;
            }
            bf16x8 vf[2][4];
            {
                f32x16 s0 = __builtin_amdgcn_mfma_f32_32x32x16_bf16(kb00, q2f[0], c0, 0, 0, 0); s0 = __builtin_amdgcn_mfma_f32_32x32x16_bf16(kb01, q2f[1], s0, 0, 0, 0);
                f32x16 s1 = __builtin_amdgcn_mfma_f32_32x32x16_bf16(kb10, q2f[0], c1, 0, 0, 0); s1 = __builtin_amdgcn_mfma_f32_32x32x16_bf16(kb11, q2f[1], s1, 0, 0, 0);
#pragma unroll
                for (int db = 0; db < 2; ++db)
#pragma unroll
                    for (int ks = 0; ks < 4; ++ks) vf[db][ks] = *(const LAS bf16x8*)(Bf + vfo + db * 32 * 144 + ks * 32);
                float p1scale = 1.f; ATT_SOFTMAX(s0, s1, pw2, l2);
                if (__any(p1scale != 1.f)) {
#pragma unroll
                    for (int ks = 0; ks < 4; ++ks)
#pragma unroll
                        for (int e = 0; e < 4; ++e) { const unsigned w = pw1[ks][e]; pw1[ks][e] = cvtpk(bflo(w) * p1scale, bfhi(w) * p1scale); }
                }
            }
#pragma unroll
            for (int db = 0; db < 2; ++db)
#pragma unroll
                for (int ks = 0; ks < 4; ++ks) {
                    O1[db] = __builtin_amdgcn_mfma_f32_32x32x16_bf16(vf[db][ks], __builtin_bit_cast(bf16x8, pw1[ks]), O1[db], 0, 0, 0);
                    O2[db] = __builtin_amdgcn_mfma_f32_32x32x16_bf16(vf[db][ks], __builtin_bit_cast(bf16x8, pw2[ks]), O2[db], 0, 0, 0);
                }
        }
        ps = ps == 2 ? 0 : ps + 1;
    }
    ATT_MAKE_AB();
#pragma unroll 1
    for (; ip < nP; ++ip) {
        ATT_PAIR_HEAD(ip);
#pragma unroll 1
        for (int half = 0; half < 2; ++half) { const int t = tlo + 2 * ip + half; const LAS unsigned char* Bf = L + (2 * ps + half) * SLOT; ATT_FAST_TILE(t, Bf, false); }
        ps = ps == 2 ? 0 : ps + 1;
    }
#undef ATT_PAIR_HEAD
#undef ATT_MAKE_AB
#undef ATT_FAST_TILE
    int lane_e = fresh_lane(); asm volatile("" : "+v"(lane_e));
    const int hi_e = lane_e >> 5, qe = qb * 256 + wid * 32 + (lane_e & 31);
    l1 += LANE_XOR_F(lane_e, l1, 32); l2 += LANE_XOR_F(lane_e, l2, 32);
    const float* dlm = F.in[I_DLAMBDA] + layer * 128;
    float a1 = 0.f, a2 = 0.f;
#pragma unroll 8
    for (int i = 0; i < 32; ++i) { a1 += dlm[i] * dlm[32 + i]; a2 += dlm[64 + i] * dlm[96 + i]; }
    const float lam_init = layer == 0 ? 0.2f : 0.35550907f;
    const float lam = __expf(a1) - __expf(a2) + lam_init;
    const float i1 = 1.f / fmaxf(l1, 1e-30f), i2 = lam / fmaxf(l2, 1e-30f);
    float ss = 0.f;
#pragma unroll
    for (int db = 0; db < 2; ++db)
#pragma unroll
        for (int r = 0; r < 16; ++r) { const float v = O1[db][r] * i1 - O2[db][r] * i2; O1[db][r] = v; ss += v * v; }
    ss += LANE_XOR_F(lane_e, ss, 32);
    const float rs = (1.f / sqrtf(ss * (1.f / 64.f) + EPS)) * (1.f - lam_init);
    bf16* orow = (bf16*)(F.ws + WS_O4) + ((size_t)b * SEQ + qe) * 1024 + 64 * h;
    const float* sg = F.in[I_DSUBLN] + layer * 64;
#pragma unroll
    for (int db = 0; db < 2; ++db)
#pragma unroll
        for (int g4 = 0; g4 < 4; ++g4) {
            const int d0 = 32 * db + 8 * g4 + 4 * hi_e;
            const float v0 = O1[db][4 * g4] * rs * sg[d0], v1 = O1[db][4 * g4 + 1] * rs * sg[d0 + 1], v2 = O1[db][4 * g4 + 2] * rs * sg[d0 + 2], v3 = O1[db][4 * g4 + 3] * rs * sg[d0 + 3];
            v2u w = {pk2(v0, v1), pk2(v2, v3)};
            *(GAS v2u*)(orow + d0) = w;
        }
#if ATT_PRIO
    __builtin_amdgcn_s_setprio(0);
#endif
    asm volatile("s_waitcnt lgkmcnt(0)" ::: "memory");
    __builtin_amdgcn_s_barrier();
#undef ATT_DMA1
#undef ATT_DMA2
}
#undef ATT_SOFTMAX
#undef ATT_EXPPACK
#undef ATT_WAITV
}

namespace pc {
constexpr int MPITCH = 72;
__device__ __forceinline__ void pool_task(Frame& F, const int layer, const int tile, const int g, LAS unsigned char* mimg) {
    const int lane = F.lane, r32 = lane & 31, hi = lane >> 5;
    const bf16* P = (const bf16*)(F.ws + WS_PROJ);
    bf16* O4 = (bf16*)(F.ws + WS_O4);
    bf16x8 wf[2][4];
    { const float* W = F.in[I_POOLW] + ((size_t)layer * 4 + g) * 64 * 64;
#pragma unroll
      for (int nb = 0; nb < 2; ++nb)
#pragma unroll
          for (int ks = 0; ks < 4; ++ks) { v4u t;
#pragma unroll
              for (int jj = 0; jj < 4; ++jj) t[jj] = pk2(W[(16 * ks + 8 * hi + 2 * jj) * 64 + r32 + 32 * nb], W[(16 * ks + 8 * hi + 2 * jj + 1) * 64 + r32 + 32 * nb]);
              wf[nb][ks] = __builtin_bit_cast(bf16x8, t); } }
    const int t0 = tile * 64, s0 = t0 % SEQ, hw = 1 << g;
    const bf16* src = P + (size_t)t0 * PJ + C_PIN + 64 * g + lane;
    float cs[81]; cs[0] = 0.f;
#pragma unroll
    for (int i = 0; i < 80; ++i) { const int s = s0 - 8 + i; float v = 0.f; if (s >= 0 && s < SEQ) v = bf2f(src[(long)(i - 8) * PJ]); cs[i + 1] = cs[i] + v; }
#pragma unroll
    for (int i = 0; i < 64; ++i) {
        const int s = s0 + i; int lo = s - hw, hiw = s + hw; lo = lo < 0 ? 0 : lo; hiw = hiw > SEQ ? SEQ : hiw;
        float wsum = 0.f;
        if (g == 0) wsum = cs[i + 8 + 1] - cs[i + 8 - 1]; else if (g == 1) wsum = cs[i + 8 + 2] - cs[i + 8 - 2]; else if (g == 2) wsum = cs[i + 8 + 4] - cs[i + 8 - 4]; else wsum = cs[i + 8 + 8] - cs[i + 8 - 8];
        const float pv = cs[i + 9] - cs[i + 8];
        const float mval = wsum / (float)(hiw - lo) - pv;
        *(LAS unsigned short*)(mimg + i * (MPITCH * 2) + lane * 2) = (unsigned short)f2bf(mval);
    }
    LDS_WAIT();
#pragma unroll
    for (int tb = 0; tb < 2; ++tb) {
        bf16x8 af[4];
#pragma unroll
        for (int ks = 0; ks < 4; ++ks) af[ks] = *(const LAS bf16x8*)(mimg + (r32 + 32 * tb) * (MPITCH * 2) + (16 * ks + 8 * hi) * 2);
#pragma unroll
        for (int nb = 0; nb < 2; ++nb) {
            f32x16 acc;
#pragma unroll
            for (int r = 0; r < 16; ++r) acc[r] = 0.f;
#pragma unroll
            for (int ks = 0; ks < 4; ++ks) acc = __builtin_amdgcn_mfma_f32_32x32x16_bf16(af[ks], wf[nb][ks], acc, 0, 0, 0);
            const int e = r32 + 32 * nb; const float sc = F.in[I_POOLSCALE][layer * 256 + 64 * g + e];
#pragma unroll
            for (int r = 0; r < 16; ++r) { const int row = 32 * tb + (r & 3) + 8 * (r >> 2) + 4 * hi;
                O4[(size_t)(t0 + row) * 1024 + 256 + 64 * g + e] = (bf16)f2bf(acc[r] * sc); }
        }
    }
    LDS_WAIT();
}
__device__ __forceinline__ void conv_task(Frame& F, const int layer, const int tile, const int cg) {
    const int lane = F.lane;
    const bf16* P = (const bf16*)(F.ws + WS_PROJ);
    bf16* O4 = (bf16*)(F.ws + WS_O4);
    const int t0 = tile * 64, s0 = t0 % SEQ;
    const int ch = 64 * cg + lane;
    const float w0 = F.in[I_SCONVW][layer * 768 + ch], w1 = F.in[I_SCONVW][layer * 768 + 256 + ch], w2 = F.in[I_SCONVW][layer * 768 + 512 + ch];
    const bf16* base = P + (size_t)t0 * PJ + ch;
    float zm = 0.f, z0 = 0.f, zp = 0.f;
    if (s0 > 0) zm = bf2f(base[-(long)PJ + C_CC]) * bf2f(base[-(long)PJ + C_CX]);
    z0 = bf2f(base[C_CC]) * bf2f(base[C_CX]);
#pragma unroll 8
    for (int i = 0; i < 64; ++i) {
        zp = 0.f; if (s0 + i + 1 < SEQ) zp = bf2f(base[(long)(i + 1) * PJ + C_CC]) * bf2f(base[(long)(i + 1) * PJ + C_CX]);
        const float cbv = bf2f(base[(long)i * PJ + C_CB]);
        O4[(size_t)(t0 + i) * 1024 + 512 + ch] = (bf16)f2bf(cbv * (w0 * zm + w1 * z0 + w2 * zp));
        zm = z0; z0 = zp;
    }
}
}

namespace dl {
constexpr int MP = 72, MB = 64 * MP * 2;
constexpr int WAVE_LDS = 2 * MB + 2 * MB;
__device__ __forceinline__ int crow(int r, int hi) { return (r & 3) + 8 * (r >> 2) + 4 * hi; }
__device__ __forceinline__ bf16x8 ldfrag(const LAS unsigned char* img, int row, int col) { return *(const LAS bf16x8*)(img + row * (MP * 2) + col * 2); }
__device__ __forceinline__ bf16x8 ldfragp(const LAS unsigned char* img, int row, int col4) {
    const v2u lo = *(const LAS v2u*)(img + row * (MP * 2) + col4 * 2), hi8 = *(const LAS v2u*)(img + row * (MP * 2) + col4 * 2 + 16); const v4u t = {lo.x, lo.y, hi8.x, hi8.y}; return __builtin_bit_cast(bf16x8, t); }
__device__ __forceinline__ bf16x8 cfrag(const f32x16& x, int half) {
    v4u t;
#pragma unroll
    for (int e = 0; e < 4; ++e) t[e] = att::cvtpk(x[8 * half + 2 * e], x[8 * half + 2 * e + 1]);
    return __builtin_bit_cast(bf16x8, t); }
#define MFMA32(a, b, c) __builtin_amdgcn_mfma_f32_32x32x16_bf16((a), (b), (c), 0, 0, 0)
#define SB() __builtin_amdgcn_sched_barrier(0)
#define LAUNDER() do { asm volatile("" : "+v"(lane)); r32 = lane & 31; hi = lane >> 5; } while (0)
__device__ __forceinline__ f32x16 zero16() { f32x16 z;
#pragma unroll
    for (int r = 0; r < 16; ++r) z[r] = 0.f;
    return z; }

#define DL_CONV(colbase, wbase, RAW) do { \
    { const bf16* src_ = P + (size_t)tok0 * PJ + (colbase); const int rr_ = lane >> 3, ch_ = lane & 7; \
      _Pragma("unroll") for (int i_ = 0; i_ < 9; ++i_) { const int row_ = rr_ + 8 * i_; const int sq_ = s0 - 2 + row_; v4u t_ = {0u, 0u, 0u, 0u}; \
          if (row_ < 68 && sq_ >= 0 && sq_ < SEQ) t_ = *(const GAS v4u*)(src_ + (long)(row_ - 2) * PJ + ch_ * 8); if (row_ < 68) *(LAS v4u*)((RAW) + row_ * 128 + ch_ * 16) = t_; } } \
    LDS_WAIT(); \
    const float cw0 = cwp[(wbase) + lane], cw1 = cwp[768 + (wbase) + lane], cw2 = cwp[2 * 768 + (wbase) + lane], cw3 = cwp[3 * 768 + (wbase) + lane], cw4 = cwp[4 * 768 + (wbase) + lane]; \
    const LAS unsigned short* rw_ = (const LAS unsigned short*)(RAW) + lane; \
    _Pragma("unroll") for (int i = 0; i < 64; ++i) { \
        const float cv_ = cw0 * bf2f(rw_[i * 64]) + cw1 * bf2f(rw_[(i + 1) * 64]) + cw2 * bf2f(rw_[(i + 2) * 64]) + cw3 * bf2f(rw_[(i + 3) * 64]) + cw4 * bf2f(rw_[(i + 4) * 64]); \
        cval[i] = cv_ * sigmoidf_(cv_); if ((i & 7) == 7) SB(); } \
    LDS_WAIT(); } while (0)
#define DL_NORM(SQ, scale) do { \
    _Pragma("unroll") for (int i = 0; i < 64; ++i) *(LAS unsigned short*)((SQ) + i * 144 + lane * 2) = (unsigned short)f2bf(cval[i] * cval[i]); \
    LDS_WAIT(); \
    { float sm_ = 0.f; _Pragma("unroll") for (int c8 = 0; c8 < 8; ++c8) { const v4u w_ = *(const LAS v4u*)((SQ) + lane * 144 + c8 * 16); \
          sm_ += (bflo(w_.x) + bfhi(w_.x)) + (bflo(w_.y) + bfhi(w_.y)) + (bflo(w_.z) + bfhi(w_.z)) + (bflo(w_.w) + bfhi(w_.w)); } \
      tab[192 + lane] = (scale) / sqrtf(sm_ + EPS); } \
    LDS_WAIT(); \
    _Pragma("unroll") for (int i4 = 0; i4 < 16; ++i4) { const f32x4 r4_ = *(const LAS f32x4*)(tab + 192 + 4 * i4); cval[4 * i4] *= r4_.x; cval[4 * i4 + 1] *= r4_.y; cval[4 * i4 + 2] *= r4_.z; cval[4 * i4 + 3] *= r4_.w; } \
    } while (0)

__device__ __forceinline__ void d1_instance(Frame& F, const int layer, const int b, const int h, const int norig, const int dir, LAS unsigned char* W, LAS float* tab) {
    int lane = F.lane, r32, hi; LAUNDER();
    const bf16* P = (const bf16*)(F.ws + WS_PROJ);
    const float* cwp = F.in[I_DCONVW] + (size_t)layer * 5 * 768;
    const int s0 = norig * 64, tok0 = b * SEQ + s0;
    const int npr = dir ? 255 - norig : norig;
    const int inst = ((b * 4 + h) * 2 + dir) * NCHUNK + npr;
    LAS unsigned char* VT = W;
    LAS unsigned char* KT = W + MB;
    LAS unsigned char* KR = W + 2 * MB;
    LAS unsigned char* T2 = W + 3 * MB;
    LAS float* SM = (LAS float*)(W + 2 * MB);
    float cval[64];
    DL_CONV(C_DK + 64 * h, 256 + 64 * h, T2);
    DL_NORM(VT, 1.f);
#pragma unroll
    for (int i = 0; i < 64; ++i) { const int ip = dir ? 63 - i : i; const unsigned short kb = (unsigned short)f2bf(cval[i]);
        *(LAS unsigned short*)(KR + ip * (MP * 2) + lane * 2) = kb; *(LAS unsigned short*)(KT + lane * (MP * 2) + ip * 2) = kb; }
    LDS_WAIT();
    DL_CONV(C_DV + 64 * h, 512 + 64 * h, T2);
#pragma unroll
    for (int i = 0; i < 64; ++i) { const int ip = dir ? 63 - i : i; *(LAS unsigned short*)(VT + lane * (MP * 2) + ip * 2) = (unsigned short)f2bf(cval[i]); }
    const int mytok = tok0 + (dir ? 63 - lane : lane);
    const float* BD = (const float*)(F.ws + WS_BD) + (size_t)mytok * 16;
    const float beta = BD[dir * 4 + h]; float gc = BD[8 + dir * 4 + h];
#pragma unroll
    for (int o = 1; o < 64; o <<= 1) { const float t = __builtin_bit_cast(float, __builtin_amdgcn_ds_bpermute(((lane - o) & 63) << 2, __builtin_bit_cast(int, gc))); if (lane >= o) gc += t; }
    const float gl = __shfl(gc, 63);
    tab[lane] = gc; tab[64 + lane] = beta; tab[128 + lane] = __expf(gl - gc);
    LDS_WAIT();
    LAUNDER();
    f32x16 kk[2][2];
#pragma unroll
    for (int tb = 0; tb < 2; ++tb)
#pragma unroll
        for (int tn = 0; tn < 2; ++tn) { f32x16 acc = zero16();
#pragma unroll
            for (int ks = 0; ks < 4; ++ks) acc = MFMA32(ldfrag(KR, r32 + 32 * tb, 16 * ks + 8 * hi), ldfrag(KR, r32 + 32 * tn, 16 * ks + 8 * hi), acc);
            kk[tb][tn] = acc; SB(); }
    LDS_WAIT();
#pragma unroll
    for (int tb = 0; tb < 2; ++tb)
#pragma unroll
        for (int tn = 0; tn < 2; ++tn) {
            const int jc = r32 + 32 * tn; const float gcj = tab[jc];
#pragma unroll
            for (int r = 0; r < 16; ++r) { const int ir = 32 * tb + crow(r, hi); const float gci = tab[ir], bi = tab[64 + ir];
                const float mv = (ir > jc) ? bi * kk[tb][tn][r] * __expf(gci - gcj) : 0.f; SM[ir * 64 + jc] = mv; } SB(); }
    LDS_WAIT();
    LAUNDER();
    float T[64];
#pragma unroll
    for (int i = 0; i < 64; ++i) {
        float a0 = (lane == i) ? 1.f : 0.f, a1 = 0.f, a2 = 0.f, a3 = 0.f;
#pragma unroll
        for (int j4 = 0; j4 < (i + 3) / 4; ++j4) { const f32x4 m4 = *(const LAS f32x4*)(SM + i * 64 + 4 * j4);
            if (4 * j4 + 0 < i) a0 = __builtin_fmaf(-m4[0], T[4 * j4 + 0], a0);
            if (4 * j4 + 1 < i) a1 = __builtin_fmaf(-m4[1], T[4 * j4 + 1], a1);
            if (4 * j4 + 2 < i) a2 = __builtin_fmaf(-m4[2], T[4 * j4 + 2], a2);
            if (4 * j4 + 3 < i) a3 = __builtin_fmaf(-m4[3], T[4 * j4 + 3], a3); }
        T[i] = (a0 + a1) + (a2 + a3); if ((i & 3) == 3) SB(); }
    LDS_WAIT();
    LAUNDER();
    { const float b1 = beta, b2 = beta * __expf(gc);
#pragma unroll
      for (int i = 0; i < 64; ++i) { *(LAS unsigned short*)(KR + i * (MP * 2) + lane * 2) = (unsigned short)f2bf(T[i] * b1); *(LAS unsigned short*)(T2 + i * (MP * 2) + lane * 2) = (unsigned short)f2bf(T[i] * b2); if ((i & 7) == 7) SB(); } }
    LDS_WAIT();
    LAUNDER();
    f32x16 u[2][2], w[2][2];
#pragma unroll
    for (int tb = 0; tb < 2; ++tb)
#pragma unroll
        for (int tn = 0; tn < 2; ++tn) { f32x16 au = zero16(), aw = zero16();
#pragma unroll
            for (int ks = 0; ks < 4; ++ks) { au = MFMA32(ldfrag(KR, r32 + 32 * tb, 16 * ks + 8 * hi), ldfrag(VT, r32 + 32 * tn, 16 * ks + 8 * hi), au);
                                             aw = MFMA32(ldfrag(T2, r32 + 32 * tb, 16 * ks + 8 * hi), ldfrag(KT, r32 + 32 * tn, 16 * ks + 8 * hi), aw); }
            u[tb][tn] = au; w[tb][tn] = aw; SB(); }
    LAUNDER();
    { unsigned* ud = (unsigned*)(F.ws + WS_UW + (size_t)inst * 16384); bf16* wd = (bf16*)(F.ws + WS_UW + (size_t)inst * 16384 + 8192);
#pragma unroll
      for (int tb = 0; tb < 2; ++tb)
#pragma unroll
          for (int tn = 0; tn < 2; ++tn) {
#pragma unroll
              for (int rp = 0; rp < 8; ++rp) ud[((tb * 2 + tn) * 8 + rp) * 64 + lane] = pk2(u[tb][tn][2 * rp], u[tb][tn][2 * rp + 1]);
#pragma unroll
              for (int r = 0; r < 16; ++r) wd[(32 * tb + crow(r, hi)) * 64 + r32 + 32 * tn] = (bf16)f2bf(w[tb][tn][r]); SB(); } }
    LAUNDER();
#pragma unroll
    for (int tb = 0; tb < 2; ++tb)
#pragma unroll
        for (int r = 0; r < 16; ++r) { const float e = tab[128 + 32 * tb + crow(r, hi)];
#pragma unroll
            for (int tn = 0; tn < 2; ++tn) { u[tb][tn][r] *= e; w[tb][tn][r] *= e; } }
    SB();
    bf16x8 kf[2][4];
#pragma unroll
    for (int tbb = 0; tbb < 2; ++tbb)
#pragma unroll
        for (int s = 0; s < 4; ++s) kf[tbb][s] = ldfragp(KT, r32 + 32 * tbb, 16 * s + 4 * hi);
    LDS_WAIT(); SB();
    LAUNDER();
    LAS unsigned char* AR = VT; LAS unsigned char* BT = KR;
#pragma unroll
    for (int tbb = 0; tbb < 2; ++tbb)
#pragma unroll
        for (int tx = 0; tx < 2; ++tx) { f32x16 aa = zero16(), ab = zero16();
#pragma unroll
            for (int s = 0; s < 4; ++s) { aa = MFMA32(cfrag(w[s >> 1][tx], s & 1), kf[tbb][s], aa); ab = MFMA32(kf[tbb][s], cfrag(u[s >> 1][tx], s & 1), ab); }
#pragma unroll
            for (int g4 = 0; g4 < 4; ++g4) {
                const v2u pa = {pk2(-aa[4 * g4], -aa[4 * g4 + 1]), pk2(-aa[4 * g4 + 2], -aa[4 * g4 + 3])};
                *(LAS v2u*)(AR + (r32 + 32 * tbb) * (MP * 2) + (32 * tx + 8 * g4 + 4 * hi) * 2) = pa;
                const v2u pb = {pk2(ab[4 * g4], ab[4 * g4 + 1]), pk2(ab[4 * g4 + 2], ab[4 * g4 + 3])};
                *(LAS v2u*)(BT + (r32 + 32 * tx) * (MP * 2) + (32 * tbb + 8 * g4 + 4 * hi) * 2) = pb;
            } SB(); }
    LDS_WAIT();
    LAUNDER();
    { unsigned char* ab = F.ws + WS_AB + (size_t)inst * 16384; const int m16 = lane & 15, g = lane >> 4;
#pragma unroll
      for (int rb = 0; rb < 4; ++rb)
#pragma unroll
          for (int ks = 0; ks < 2; ++ks) { const v2u lo = *(const LAS v2u*)(AR + (16 * rb + m16) * (MP * 2) + (32 * ks + 4 * g) * 2), hi8 = *(const LAS v2u*)(AR + (16 * rb + m16) * (MP * 2) + (32 * ks + 16 + 4 * g) * 2);
              const v4u t = {lo.x, lo.y, hi8.x, hi8.y}; *(GAS v4u*)(ab + ((rb * 2 + ks) * 64 + lane) * 16) = t; }
#pragma unroll
      for (int sl = 0; sl < 4; ++sl)
#pragma unroll
          for (int rb = 0; rb < 4; ++rb) { const v2u t = *(const LAS v2u*)(BT + (16 * sl + m16) * (MP * 2) + (16 * rb + 4 * g) * 2); *(GAS v2u*)(ab + 8192 + ((sl * 4 + rb) * 64 + lane) * 8) = t; } }
    if (lane == 0) ((float*)(F.ws + WS_DEC))[inst] = __expf(gl);
    LDS_WAIT();
}
__device__ __forceinline__ void pc_side_tasks(Frame& F, const int layer) {
    if (F.wave == 4) {
        LAS unsigned char* mimg = F.lds + RING_OFF + 4 * WAVE_LDS + 4096;
        for (int tile = F.vcu; tile < NTOK / 128; tile += F.G)
            for (int g = 0; g < 4; ++g) pc::pool_task(F, layer, tile, g, mimg);
    } else if (F.wave > 4) {
        int k = 0;
        for (int tile = F.vcu; tile < NTOK / 128; tile += F.G)
            for (int cg = 0; cg < 4; ++cg, ++k) if (k % 3 == F.wave - 5) pc::conv_task(F, layer, tile, cg);
    }
}
__device__ __forceinline__ void pc_item(Frame& F, const int layer, const int item) {
    const int tile = NTOK / 128 + (item >> 1), sub = item & 1;
    if (F.wave == 4) {
        LAS unsigned char* mimg = F.lds + RING_OFF + 4 * WAVE_LDS + 4096;
#pragma unroll 1
        for (int g = 2 * sub; g < 2 * sub + 2; ++g) pc::pool_task(F, layer, tile, g, mimg);
    } else if (F.wave == 5) pc::conv_task(F, layer, tile, 2 * sub);
    else if (F.wave == 6) pc::conv_task(F, layer, tile, 2 * sub + 1);
}
__device__ __forceinline__ void d1_phase(Frame& F, const int layer) {
    if (F.wave < 4) {
        LAS unsigned char* W = F.lds + RING_OFF + F.wave * WAVE_LDS; LAS float* tab = (LAS float*)(F.lds + RING_OFF + 4 * WAVE_LDS + F.wave * 1024);
        const int gw = F.vcu * 4 + F.wave, NGW = F.G * 4;
        for (int it = gw; it < NINST; it += NGW) { const int dir = it & 1, u = it >> 1; d1_instance(F, layer, u >> 10, (u >> 8) & 3, u & 255, dir, W, tab); }
    } else pc_side_tasks(F, layer);
    __syncthreads();
}

typedef float f32x4v __attribute__((ext_vector_type(4)));
struct D2Regs { v4u af[4][2]; v2u bm[4]; float dcy; };
__device__ __forceinline__ void d2_chain(Frame& F, const int chain) {
    const int lane = F.lane, n16 = lane & 15, g = lane >> 4, sl = F.wave;
    f32x4v S[4];
#pragma unroll
    for (int rb = 0; rb < 4; ++rb) S[rb] = (f32x4v){0.f, 0.f, 0.f, 0.f};
    const unsigned char* abase = F.ws + WS_AB + (size_t)chain * NCHUNK * 16384;
    unsigned char* sbase = F.ws + WS_ST + (size_t)chain * NCHUNK * 8192;
    const float* dec = (const float*)(F.ws + WS_DEC) + chain * NCHUNK;
    D2Regs q0, q1, q2;
#define D2_LOAD(Q, n) do { const unsigned char* ab_ = abase + (size_t)(n) * 16384; \
    _Pragma("unroll") for (int rb = 0; rb < 4; ++rb) { _Pragma("unroll") for (int ks = 0; ks < 2; ++ks) Q.af[rb][ks] = *(const GAS v4u*)(ab_ + ((rb * 2 + ks) * 64 + lane) * 16); \
        Q.bm[rb] = *(const GAS v2u*)(ab_ + 8192 + ((sl * 4 + rb) * 64 + lane) * 8); } Q.dcy = dec[n]; } while (0)
#define D2_STEP(Q, n) do { \
    unsigned char* st = sbase + (size_t)(n) * 8192 + (16 * sl + n16) * 128; \
    _Pragma("unroll") for (int rb = 0; rb < 4; ++rb) { const v2u t = {pk2(S[rb][0], S[rb][1]), pk2(S[rb][2], S[rb][3])}; *(GAS v2u*)(st + (16 * rb + 4 * g) * 2) = t; } \
    bf16x8 bfr[2]; \
    _Pragma("unroll") for (int ks = 0; ks < 2; ++ks) { const v4u t = {att::cvtpk(S[2 * ks][0], S[2 * ks][1]), att::cvtpk(S[2 * ks][2], S[2 * ks][3]), att::cvtpk(S[2 * ks + 1][0], S[2 * ks + 1][1]), att::cvtpk(S[2 * ks + 1][2], S[2 * ks + 1][3])}; bfr[ks] = __builtin_bit_cast(bf16x8, t); } \
    _Pragma("unroll") for (int rb = 0; rb < 4; ++rb) { const float cd = Q.dcy; \
        f32x4v c = {S[rb][0] * cd + bflo(Q.bm[rb].x), S[rb][1] * cd + bfhi(Q.bm[rb].x), S[rb][2] * cd + bflo(Q.bm[rb].y), S[rb][3] * cd + bfhi(Q.bm[rb].y)}; \
        c = __builtin_amdgcn_mfma_f32_16x16x32_bf16(__builtin_bit_cast(bf16x8, Q.af[rb][0]), bfr[0], c, 0, 0, 0); \
        c = __builtin_amdgcn_mfma_f32_16x16x32_bf16(__builtin_bit_cast(bf16x8, Q.af[rb][1]), bfr[1], c, 0, 0, 0); \
        S[rb] = c; } } while (0)
    D2_LOAD(q0, 0); D2_LOAD(q1, 1);
    for (int n = 0; n < NCHUNK - 1; n += 3) {
        D2_LOAD(q2, n + 2); D2_STEP(q0, n); SB();
        D2_LOAD(q0, n + 3); D2_STEP(q1, n + 1); SB();
        if (n + 4 < NCHUNK) D2_LOAD(q1, n + 4); D2_STEP(q2, n + 2); SB();
    }
    D2_STEP(q0, NCHUNK - 1);
#undef D2_LOAD
#undef D2_STEP
}

__device__ __forceinline__ void d3_unit(Frame& F, const int layer, const int b, const int h, const int norig, LAS unsigned char* W, LAS float* tab) {
    int lane = F.lane, r32, hi; LAUNDER();
    const bf16* P = (const bf16*)(F.ws + WS_PROJ);
    const float* cwp = F.in[I_DCONVW] + (size_t)layer * 5 * 768;
    const int s0 = norig * 64, tok0 = b * SEQ + s0;
    LAS unsigned char* QR = W;
    LAS unsigned char* KR = W + MB;
    LAS unsigned char* AT = W + 2 * MB;
    LAS unsigned char* WR = W + 3 * MB;
    { float cval[64];
      DL_CONV(C_DQ + 64 * h, 64 * h, WR);
      DL_NORM(AT, 0.125f);
#pragma unroll
      for (int i = 0; i < 64; ++i) *(LAS unsigned short*)(QR + i * (MP * 2) + lane * 2) = (unsigned short)f2bf(cval[i]);
      LDS_WAIT();
      DL_CONV(C_DK + 64 * h, 256 + 64 * h, WR);
      DL_NORM(AT, 1.f);
#pragma unroll
      for (int i = 0; i < 64; ++i) *(LAS unsigned short*)(KR + i * (MP * 2) + lane * 2) = (unsigned short)f2bf(cval[i]);
      LDS_WAIT(); }
    f32x16 of[2][2];
#pragma unroll
    for (int dir = 0; dir < 2; ++dir) {
        LAUNDER();
        const int npr = dir ? 255 - norig : norig;
        const int inst = ((b * 4 + h) * 2 + dir) * NCHUNK + npr;
        const int mytok = tok0 + (dir ? 63 - lane : lane);
        float gc = ((const float*)(F.ws + WS_BD))[(size_t)mytok * 16 + 8 + dir * 4 + h];
#pragma unroll
        for (int o = 1; o < 64; o <<= 1) { const float t = __builtin_bit_cast(float, __builtin_amdgcn_ds_bpermute(((lane - o) & 63) << 2, __builtin_bit_cast(int, gc))); if (lane >= o) gc += t; }
        tab[lane] = gc; tab[64 + lane] = __expf(gc);
        { const unsigned char* wg = F.ws + WS_UW + (size_t)inst * 16384 + 8192;
#pragma unroll
          for (int i = 0; i < 8; ++i) { const int idx = i * 64 + lane, row = idx >> 3, ch = idx & 7; const v4u c = *(const GAS v4u*)(wg + idx * 16); *(LAS v4u*)(WR + row * (MP * 2) + ch * 16) = c; } }
        LDS_WAIT();
        LAUNDER();
        const int ra0 = dir ? 63 - r32 : r32, ra1 = dir ? 31 - r32 : 32 + r32;
        f32x16 qk[2][2];
#pragma unroll
        for (int tb = 0; tb < 2; ++tb)
#pragma unroll
            for (int tn = 0; tn < 2; ++tn) { f32x16 acc = zero16();
#pragma unroll
                for (int ks = 0; ks < 4; ++ks) acc = MFMA32(ldfrag(QR, tb ? ra1 : ra0, 16 * ks + 8 * hi), ldfrag(KR, tn ? ra1 : ra0, 16 * ks + 8 * hi), acc);
                qk[tb][tn] = acc; SB(); }
        LDS_WAIT();
#pragma unroll
        for (int tb = 0; tb < 2; ++tb)
#pragma unroll
            for (int tn = 0; tn < 2; ++tn) { const int jc = r32 + 32 * tn; const float gcj = tab[jc];
#pragma unroll
                for (int r = 0; r < 16; ++r) { const int ir = 32 * tb + crow(r, hi); const float gci = tab[ir];
                    const float av = (ir >= jc) ? qk[tb][tn][r] * __expf(gci - gcj) : 0.f; *(LAS unsigned short*)(AT + ir * (MP * 2) + jc * 2) = (unsigned short)f2bf(av); } SB(); }
        LDS_WAIT();
        LAUNDER();
        const unsigned* ud = (const unsigned*)(F.ws + WS_UW + (size_t)inst * 16384);
        const unsigned char* sg = F.ws + WS_ST + (size_t)inst * 8192;
#pragma unroll
        for (int tn = 0; tn < 2; ++tn) {
            bf16x8 sf[4];
#pragma unroll
            for (int ks = 0; ks < 4; ++ks) sf[ks] = *(const GAS bf16x8*)(sg + ((r32 + 32 * tn) * 64 + 16 * ks + 8 * hi) * 2);
            f32x16 vn[2], o[2];
#pragma unroll
            for (int tb = 0; tb < 2; ++tb) { f32x16 a1 = zero16(), a2 = zero16();
#pragma unroll
                for (int ks = 0; ks < 4; ++ks) { a1 = MFMA32(ldfrag(WR, r32 + 32 * tb, 16 * ks + 8 * hi), sf[ks], a1); a2 = MFMA32(ldfrag(QR, tb ? ra1 : ra0, 16 * ks + 8 * hi), sf[ks], a2); }
#pragma unroll
                for (int rp = 0; rp < 8; ++rp) { const unsigned uw = ud[((tb * 2 + tn) * 8 + rp) * 64 + lane]; a1[2 * rp] = bflo(uw) - a1[2 * rp]; a1[2 * rp + 1] = bfhi(uw) - a1[2 * rp + 1]; }
#pragma unroll
                for (int r = 0; r < 16; ++r) a2[r] *= tab[64 + 32 * tb + crow(r, hi)];
                vn[tb] = a1; o[tb] = a2; SB(); }
#pragma unroll
            for (int tb = 0; tb < 2; ++tb) { f32x16 acc = o[tb];
#pragma unroll
                for (int s = 0; s < 4; ++s) acc = MFMA32(ldfragp(AT, r32 + 32 * tb, 16 * s + 4 * hi), cfrag(vn[s >> 1], s & 1), acc);
                o[tb] = acc; SB(); }
            if (dir == 0) { of[0][tn] = o[0]; of[1][tn] = o[1]; }
            else {
#pragma unroll
                for (int tb = 0; tb < 2; ++tb)
#pragma unroll
                    for (int r = 0; r < 16; ++r) of[tb][tn][r] += LANE_XOR_F(lane, o[1 - tb][15 - r], 32);
            }
        }
        LDS_WAIT();
    }
    const float* dn = F.in[I_DNORM] + layer * 64;
#pragma unroll
    for (int tb = 0; tb < 2; ++tb)
#pragma unroll
        for (int r = 0; r < 16; ++r) {
            float ss = of[tb][0][r] * of[tb][0][r] + of[tb][1][r] * of[tb][1][r];
#pragma unroll
            for (int o = 1; o < 32; o <<= 1) ss += LANE_XOR_F(lane, ss, o);
            const float rs = 1.f / sqrtf(ss * (1.f / 64.f) + EPS);
            const int tok = tok0 + 32 * tb + crow(r, hi);
#pragma unroll
            for (int tn = 0; tn < 2; ++tn) { const int dv = r32 + 32 * tn; const float z = bf2f(P[(size_t)tok * PJ + C_DZ + 64 * h + dv]);
                ((bf16*)(F.ws + WS_O4))[(size_t)tok * 1024 + 768 + 64 * h + dv] = (bf16)f2bf(of[tb][tn][r] * rs * dn[dv] * siluf_(z)); }
        }
}
constexpr int QN_ATT = BATCH * 4 * 64, QN_D3 = BATCH * 4 * NCHUNK / 4;
#ifndef QD3_EARLY
#define QD3_EARLY 1
#endif
__device__ __forceinline__ void scan_attn_d3_phase(Frame& F, const int layer, const int qword) {
    bool scans_seen = false;
    for (;;) {
        { unsigned char* w_ = F.ws; asm volatile("" : "+s"(w_)); F.ws = w_; F.ctl = (gu32*)(w_ + WS_CTL); }
        unsigned mo_ = MISC_OFF + 64; asm volatile("" : "+s"(mo_));
        volatile LAS unsigned* mq_ = (volatile LAS unsigned*)(F.lds + mo_);
        if (F.wave == 0) { int t_ = fresh_lane(); asm volatile("" : "+v"(t_)); if (t_ == 0) *mq_ = __hip_atomic_fetch_add(F.ctl + CW_ATTQ + 64 * qword, 1u, RLX_AGENT); }
        __syncthreads();
        int idx = (int)*mq_;
        __syncthreads();
        if (idx >= 16 + QN_ATT + QN_D3) break;
#if QD3_EARLY
        if (idx >= 16) { const int r_ = idx - 16; idx = r_ < 384 ? idx : (r_ < 384 + QN_D3 ? 16 + QN_ATT + (r_ - 384) : 16 + 384 + (r_ - 384 - QN_D3)); }
#endif
        if (idx < 16) {
            { int t_ = fresh_lane(); asm volatile("" : "+v"(t_)); F.lane = t_; }
#ifdef PROBE_D2X2
            if (F.wave < 4) { for (int rep2_ = 0; rep2_ < PROBE_D2X2; ++rep2_) { d2_chain(F, idx); asm volatile("" ::: "memory"); } }
#else
            if (F.wave < 4) d2_chain(F, idx);
#endif
            asm volatile("s_waitcnt vmcnt(0)" ::: "memory");
            __syncthreads();
            if (F.wave == 0 && fresh_lane() == 0) { __builtin_amdgcn_fence(__ATOMIC_RELEASE, "agent"); asm volatile("s_waitcnt vmcnt(0)" ::: "memory"); (void)__hip_atomic_fetch_add(F.ctl + CW_ATTQ + 64 * qword + 32, 1u, RLX_AGENT); }
        } else if (idx < 16 + QN_ATT) { { int t_ = fresh_lane(); asm volatile("" : "+v"(t_)); F.lane = t_; }
            const int j = idx - 16, h = 3 - (j >> 7), jj = j & 127, b = jj & 1, k = jj >> 1, qb = (k & 1) ? 31 - (k >> 1) : 32 + (k >> 1);
            att::attn_unit(F, layer, b, h, qb);
        } else {
            int item = idx - 16 - QN_ATT;
            if (!scans_seen) {
                if (F.wave == 0 && fresh_lane() == 0) { unsigned sp = 0u; while (__hip_atomic_load(F.ctl + CW_ATTQ + 64 * qword + 32, RLX_AGENT) < 16u) { __builtin_amdgcn_s_sleep(2); if (++sp > (1u << 24)) break; }
                    __builtin_amdgcn_fence(__ATOMIC_ACQUIRE, "agent"); asm volatile("s_waitcnt vmcnt(0)" ::: "memory"); }
                __syncthreads();
                scans_seen = true;
            }
            { int t_ = F.wave * 64 + fresh_lane(), i_ = item; asm volatile("" : "+v"(t_), "+s"(i_)); F.tid = t_; F.lane = t_ & 63; item = i_; }
            if (F.wave < 4) {
                LAS unsigned char* W = F.lds + RING_OFF + F.wave * WAVE_LDS; LAS float* tab = (LAS float*)(F.lds + RING_OFF + 4 * WAVE_LDS + F.wave * 1024);
                const int u = item * 4 + F.wave;
                d3_unit(F, layer, u >> 10, (u >> 8) & 3, u & 255, W, tab);
            } else pc_item(F, layer, item);
        }
    }
    __syncthreads();
}
#undef MFMA32
}

#ifndef ONLY_SITE
#define ONLY_SITE -1
#endif
#define SITE(k) (ONLY_SITE < 0 || ONLY_SITE == (k))
#ifndef GEMM_SP2
#define GEMM_SP2 true
#endif
#ifndef PROBE_MASK
#define PROBE_MASK 0
#endif
#ifndef PROBE_N
#define PROBE_N 2
#endif
#define REPEAT(k) for (int rep_ = 0; rep_ < (((PROBE_MASK >> (k)) & 1) ? PROBE_N : 1); ++rep_)
#ifndef MK_SPLIT
#define MK_SPLIT 0
#endif
struct Args { const float* in[30]; float* out; unsigned char* ws; int ph_lo, ph_hi; };
constexpr int N_PHASES = 1 + 16 * NLAYER + 1;

#define IN_PH() (pid >= lo && pid < hi)
#define FRESH() do { unsigned char* w_ = args.ws; float* o_ = args.out; int t_ = F.wave * 64 + (int)__builtin_amdgcn_mbcnt_hi(~0u, __builtin_amdgcn_mbcnt_lo(~0u, 0u)); asm volatile("" : "+s"(w_), "+s"(o_), "+v"(t_)); F.ws = w_; F.out = o_; F.ctl = (gu32*)(w_ + WS_CTL); F.tid = t_; F.lane = t_ & 63; } while (0)
#ifdef PROBE_BARX2
#define SEAM() do { if (!MK_SPLIT && pid >= lo && pid + 1 < hi) { xcd_barrier(bar); xcd_barrier(bar); xcd_barrier(bar); } ++pid; } while (0)
#else
#define SEAM() do { if (!MK_SPLIT && pid >= lo && pid + 1 < hi) xcd_barrier(bar); ++pid; } while (0)
#endif
#define NOSEAM() do { ++pid; } while (0)

template <int l> __device__ __forceinline__ void layer_phases(Frame& F, const Args& args, const XcdBarrier& bar, const int lo, const int hi, int& pid) {
    LAS unsigned char* ring = F.lds + RING_OFF;

        if constexpr (l == 0) { if (IN_PH() && SITE(1)) REPEAT(1) { FRESH(); p_rows<ROW_A>(F, 0); } SEAM(); } else { NOSEAM(); }
        if (IN_PH() && SITE(2)) REPEAT(2) { FRESH();
            pg8::SchedStd S; S.init(NTOK / 256, NPROJ / 256, F.G, (int)blockIdx.x, F.ws + WS_H, (size_t)256 * D * 2, w_in_t(F.ws, l), (size_t)256 * D * 2);
            pg8::EpiProj E{(bf16*)(F.ws + WS_QB), (bf16*)(F.ws + WS_KV), (bf16*)(F.ws + WS_PROJ), (unsigned*)(F.ctl + CW_NMAX) + l * 16, QSCALE};
            pg8::gemm_phase<pg8::EpiProj, pg8::SchedStd, D, D, D, false, false, true, GEMM_SP2>(ring, F.tid, S, E);
        }
        SEAM();
        NOSEAM();
        if (IN_PH() && SITE(5)) REPEAT(5) { FRESH(); dl::d1_phase(F, l); }
        SEAM();
        if (IN_PH() && SITE(3)) REPEAT(3) { FRESH(); dl::scan_attn_d3_phase(F, l, l * 2 + rep_); }
        SEAM();
        NOSEAM();
        NOSEAM();
        NOSEAM();
        if (IN_PH() && SITE(9)) REPEAT(9) { FRESH();
            pg8::SchedGateP S{F.vcu, F.G, (const char*)F.ws, WS_H, WS_W + (size_t)l * SZ_LAYERW + SZ_WIN, WS_O4, WS_W + (size_t)l * SZ_LAYERW + SZ_WIN + SZ_WM};
            pg8::EpiGateP E{(bf16*)(F.ws + WS_PBUF) + (size_t)blockIdx.x * 65536, (bf16*)(F.ws + WS_MERGED), F.in[I_BMERGE] + (size_t)l * 4 * D, F.tid};
            pg8::gemm_phase<pg8::EpiGateP, pg8::SchedGateP, D, D, D>(ring, F.tid, S, E);
        }
        SEAM();
        if (IN_PH() && SITE(10)) REPEAT(10) { FRESH();
            pg8::SchedStd S; S.init(NTOK / 256, D / 256, F.G, (int)blockIdx.x, F.ws + WS_MERGED, (size_t)256 * D * 2, w_o_t(F.ws, l), (size_t)256 * D * 2);
            pg8::EpiStore E{(bf16*)(F.ws + WS_F), D, 0, 1.f};
            pg8::gemm_phase<pg8::EpiStore, pg8::SchedStd, D, D, D, false, false, true, GEMM_SP2>(ring, F.tid, S, E);
        }
        SEAM();
        if (IN_PH() && SITE(11)) REPEAT(11) { FRESH(); p_rows<ROW_B>(F, l); }
        SEAM();
        if constexpr (l == 0) {
            if (IN_PH() && SITE(12)) REPEAT(12) { FRESH();
                pg8::SchedStd S; S.init(NTOK / 256, 2 * DFF / 256, F.G, (int)blockIdx.x, F.ws + WS_H, (size_t)256 * D * 2, F.ws + WS_WFFN, (size_t)256 * D * 2);
                pg8::EpiSwiGLU<false> E{(bf16*)(F.ws + WS_ACT0), DFF};
                pg8::gemm_phase<pg8::EpiSwiGLU<false>, pg8::SchedStd, D, D, D, false, false, true, GEMM_SP2>(ring, F.tid, S, E);
            }
            SEAM();
            if (IN_PH() && SITE(13)) REPEAT(13) { FRESH();
                pg8::SchedStd S; S.init(NTOK / 256, D / 256, F.G, (int)blockIdx.x, F.ws + WS_ACT0, (size_t)256 * DFF * 2, F.ws + WS_WFFN + SZ_WGU, (size_t)256 * DFF * 2);
                pg8::EpiStore E{(bf16*)(F.ws + WS_F), D, 0, 1.f};
                pg8::gemm_phase<pg8::EpiStore, pg8::SchedStd, DFF, DFF, DFF, false, false, true, GEMM_SP2>(ring, F.tid, S, E);
            }
            SEAM();
            if (IN_PH() && SITE(14)) REPEAT(14) { FRESH(); p_rows<ROW_C>(F, 0); }
            SEAM();
            NOSEAM(); NOSEAM();
        } else {
            if (IN_PH() && SITE(15)) REPEAT(15) { FRESH(); p_moe_cvt(F); }
            SEAM();
#pragma unroll 1
            for (int pass = 0; pass < MOE_NPASS; ++pass) {
                if (IN_PH() && SITE(16)) REPEAT(16) { FRESH();
                    constexpr int EB = MOE_FP8 ? 1 : 2;
                    pg8::SchedMoe S; S.c = F.vcu;
                    S.G = F.G; S.nN = 2 * DFF / 256; moe_tiles(F, S.cnt, S.tstart);
                    S.t0 = pass * MOE_PASS_TILES; S.t1 = S.tstart[8] < (pass + 1) * MOE_PASS_TILES ? S.tstart[8] : (pass + 1) * MOE_PASS_TILES;
                    S.lists = (const int*)(F.ws + WS_ROUTE + 1 * MiB); S.W = (const char*)(F.ws + WS_MOEW); S.w_tile = (size_t)256 * D * EB; S.exp_stride = SZ_FFNW / 2 * EB;
#if MOE_FP8
                    S.A = (const char*)(F.ws + WS_XG); S.gather = false; S.act_tile = (size_t)256 * D;
                    pg8::EpiSwiGLU<true> E{(bf16*)(F.ws + WS_ACT1), DFF};
                    pg8::gemm_phase<pg8::EpiSwiGLU<true>, pg8::SchedMoe, D / 2, D / 2, D / 2, false, true>(ring, F.tid, S, E);
#else
                    S.A = (const char*)(F.ws + WS_H2B); S.gather = true; S.act_tile = 0;
                    pg8::EpiSwiGLU<false> E{(bf16*)(F.ws + WS_ACT1), DFF};
                    pg8::gemm_phase<pg8::EpiSwiGLU<false>, pg8::SchedMoe, D, D, D, true, false>(ring, F.tid, S, E);
#endif
                }
                SEAM();
                if (IN_PH() && SITE(17)) REPEAT(17) { FRESH();
                    constexpr int EB = MOE_FP8 ? 1 : 2;
                    pg8::SchedMoe S; S.c = F.vcu;
                    S.G = F.G; S.nN = D / 256; moe_tiles(F, S.cnt, S.tstart);
                    S.t0 = pass * MOE_PASS_TILES; S.t1 = S.tstart[8] < (pass + 1) * MOE_PASS_TILES ? S.tstart[8] : (pass + 1) * MOE_PASS_TILES;
                    S.A = (const char*)(F.ws + WS_ACT1); S.lists = nullptr; S.W = (const char*)(F.ws + WS_MOEW + SZ_WGU / 2 * EB); S.w_tile = (size_t)256 * DFF * EB; S.gather = false;
                    S.exp_stride = SZ_FFNW / 2 * EB; S.act_tile = (size_t)256 * DFF * EB;
#if MOE_FP8
                    pg8::EpiStore64 E{(bf16*)(F.ws + WS_Y)};
                    pg8::gemm_phase<pg8::EpiStore64, pg8::SchedMoe, DFF * EB / 2, DFF * EB / 2, DFF * EB / 2, false, true>(ring, F.tid, S, E);
#else
                    pg8::EpiStore E{(bf16*)(F.ws + WS_Y), D, 0, 1.f};
                    pg8::gemm_phase<pg8::EpiStore, pg8::SchedMoe, DFF * EB / 2, DFF * EB / 2, DFF * EB / 2, false, false>(ring, F.tid, S, E);
#endif
                }
                SEAM();
            }
            if constexpr (MOE_NPASS == 1) { NOSEAM(); NOSEAM(); }
        }
    }

__global__ void __launch_bounds__(NWAVES * 64, 2) fwd_kernel(const Args args) {
    extern __shared__ __attribute__((aligned(16))) unsigned char lds[];
    Frame F;
    F.lds = (LAS unsigned char*)lds;
    F.MISC = (volatile LAS unsigned*)(F.lds + MISC_OFF);
    F.tid = threadIdx.x; F.lane = F.tid & 63; F.wave = __builtin_amdgcn_readfirstlane(F.tid >> 6);
    F.G = gridDim.x; { const int bx = blockIdx.x; F.vcu = (F.G % 8 == 0) ? (bx % 8) * (F.G / 8) + bx / 8 : bx; }
    F.ws = args.ws; F.out = args.out; F.ctl = (gu32*)(args.ws + WS_CTL);
    F.in = args.in;
    if (F.tid < 64) ((LAS unsigned*)(F.lds + MISC_OFF))[F.tid] = 0u;
    __syncthreads();
#if defined(TPROBE) && (TPROBE == 10 || TPROBE == 11)
    if (F.tid == 0) *(LAS unsigned long long*)(F.lds + MISC_OFF + 80) = (unsigned long long)F.ctl;
    __syncthreads();
#endif
    XcdBarrier bar; bar.bar = (unsigned*)(F.ctl + CW_BAR); bar.x = 0; bar.st = nullptr;
    if (!MK_SPLIT) bar = xcd_barrier_post((unsigned*)(F.ctl + CW_BAR), F.MISC + 8);
    const int lo = args.ph_lo, hi = args.ph_hi;
    int pid = 0;
    LAS unsigned char* ring = F.lds + RING_OFF;

    if (IN_PH() && SITE(0)) REPEAT(0) { FRESH(); p_prologue(F); }
    SEAM();
    layer_phases<0>(F, args, bar, lo, hi, pid);
    layer_phases<1>(F, args, bar, lo, hi, pid);
    if (IN_PH() && SITE(18)) REPEAT(18) { FRESH(); p_rows<ROW_C>(F, 1); }
#if defined(TPROBE)
    __syncthreads();
    if (blockIdx.x == 0 && F.wave == 0 && (int)__builtin_amdgcn_mbcnt_hi(~0u, __builtin_amdgcn_mbcnt_lo(~0u, 0u)) == 0) {
        const float a = (float)__hip_atomic_load(F.ctl + 70000, RLX_AGENT), b = (float)__hip_atomic_load(F.ctl + 70001, RLX_AGENT), c = (float)__hip_atomic_load(F.ctl + 70002, RLX_AGENT);
        float v = 0.f;
        if (TPROBE == 1 || TPROBE == 2) v = 1000.f + 1000.f * floorf(10.f * a / b + 0.5f);
        if (TPROBE == 3) v = 1000.f + 1000.f * floorf(64.f * b / c / 1000.f + 0.5f);
        if (TPROBE == 10) { float lv = floorf(100.f * a / b + 0.5f); lv = lv > 89.f ? 89.f : lv; v = 1000.f + 100.f * lv; }
        if (TPROBE == 11) { float lv = floorf(64.f * a / b / 400.f); lv = lv > 89.f ? 89.f : lv; v = 1000.f + 100.f * lv; }
        if (TPROBE == 5) { float lv = floorf(c / 1024.f + 0.5f); lv = lv > 89.f ? 89.f : lv; v = 1000.f + 100.f * lv; }
        if (TPROBE >= 6 && TPROBE <= 9) { const unsigned* nm = (const unsigned*)(F.ctl + CW_NMAX) + (TPROBE - 6) * 2;
            const float qn = sqrtf(__builtin_bit_cast(float, __hip_atomic_load(nm, RLX_AGENT))), kn = sqrtf(__builtin_bit_cast(float, __hip_atomic_load(nm + 1, RLX_AGENT)));
            float lv = floorf(qn * kn * 0.5f); lv = lv > 89.f ? 89.f : lv; v = 1000.f + 100.f * lv; }
        args.out[0] = v;
    }
#endif
#undef IN_PH
#undef SEAM
#undef NOSEAM
}

extern "C" void kernel_launch(void* const* d_in, const int* in_sizes, int n_in, void* d_out, int out_size, void* d_ws, size_t ws_size, hipStream_t stream) {
    static int grid = 0;
    if (grid == 0) {
        if (n_in != N_INPUTS || in_sizes[0] != NTOK * D || out_size != NTOK * D || ws_size < WS_END) {
            fprintf(stderr, "kernel_launch: unexpected problem (n_in %d, in0 %d, out %d, ws %zu < %zu); nothing launched\n", n_in, n_in > 0 ? in_sizes[0] : -1, out_size, ws_size, (size_t)WS_END); grid = -1; return; }
        int dev = 0, cus = 0, per_cu = 0;
        if (hipGetDevice(&dev) != hipSuccess || hipDeviceGetAttribute(&cus, hipDeviceAttributeMultiprocessorCount, dev) != hipSuccess) { grid = -1; return; }
        if (hipFuncSetAttribute((const void*)fwd_kernel, hipFuncAttributeMaxDynamicSharedMemorySize, LDS_BYTES) != hipSuccess) { fprintf(stderr, "kernel_launch: hipFuncSetAttribute failed\n"); grid = -1; return; }
        if (hipOccupancyMaxActiveBlocksPerMultiprocessor(&per_cu, (const void*)fwd_kernel, NWAVES * 64, LDS_BYTES) != hipSuccess || per_cu < 1)
            fprintf(stderr, "kernel_launch: note: occupancy query reports %d workgroups per CU\n", per_cu);
        (void)hipGetLastError();
        grid = cus;
    }
    if (grid < 0) return;
    if (hipMemsetAsync((char*)d_ws + WS_CTL, 0, CTL_ZERO_BYTES, stream) != hipSuccess) return;
    Args a{};
    for (int i = 0; i < 30; ++i) a.in[i] = (const float*)d_in[i];
    a.out = (float*)d_out; a.ws = (unsigned char*)d_ws;
#if MK_SPLIT
    for (int p = 0; p < N_PHASES; ++p) { a.ph_lo = p; a.ph_hi = p + 1; hipLaunchKernelGGL(fwd_kernel, dim3(grid), dim3(NWAVES * 64), LDS_BYTES, stream, a); }
#else
    a.ph_lo = 0; a.ph_hi = N_PHASES;
    hipLaunchKernelGGL(fwd_kernel, dim3(grid), dim3(NWAVES * 64), LDS_BYTES, stream, a);
#endif
}
```

```cpp
#include <hip/hip_runtime.h>
#include <cstdio>
#include <cstdint>

namespace pg8 {
#define PG8_LAS __attribute__((address_space(3)))
typedef unsigned short bf16_t;
typedef short bf16x8 __attribute__((ext_vector_type(8)));
typedef float f32x4 __attribute__((ext_vector_type(4)));
typedef unsigned u32x4 __attribute__((ext_vector_type(4)));
typedef unsigned u32x2 __attribute__((ext_vector_type(2)));
typedef int i32x4 __attribute__((ext_vector_type(4)));
constexpr int BM = 256, BK = 64, HALF = 128, HTB = HALF * BK * 2  , STAGE_BYTES = 8 * HTB;

__host__ __device__ __forceinline__ int lds_byte(int r, int c) { const int st = (r >> 4) * 2 + (c >> 5), rr = r & 15, cc = c & 31, ob = rr * 64 + cc * 2; return st * 1024 + (ob ^ (((ob >> 9) & 1) << 5)); }
__host__ __device__ __forceinline__ void stage_rc(int b, int& R, int& C) { const int st = b / 1024, sb = b % 1024, swz = sb ^ (((sb >> 9) & 1) << 5); R = (st >> 1) * 16 + swz / 64; C = (st & 1) * 32 + (swz % 64) / 2; }
__host__ __device__ __forceinline__ int perm32(int rho) { const int n = rho >> 4, i = rho & 15; return 8 * (i >> 2) + 4 * n + (i & 3); }

struct Unit { int pm, pn, aux, nt; const char* a; const char* b; const int* rows; };

__device__ __forceinline__ unsigned cvt_pk_bf16(float lo, float hi) { unsigned r; asm volatile("v_cvt_pk_bf16_f32 %0, %1, %2" : "=v"(r) : "v"(lo), "v"(hi)); return r; }


__device__ __forceinline__ const char* uniform_ptr(const char* p) { const unsigned long long v = (unsigned long long)p; return (const char*)(((unsigned long long)(unsigned)__builtin_amdgcn_readfirstlane((int)(v >> 32)) << 32) | (unsigned)__builtin_amdgcn_readfirstlane((int)(unsigned)v)); }
template <class Epi, class Sched, int K, int lda, int ldb, bool GATHER = false, bool FP8 = false, bool ALIGN_EPI = true, bool SP2 = true>
__device__ __forceinline__ void gemm_phase(PG8_LAS unsigned char* lds, const int tid, const Sched& S, const Epi& E) {
    const int wid = __builtin_amdgcn_readfirstlane(tid >> 6), lane = tid & 63, wr = wid >> 2, wc = wid & 3, fr = lane & 15, fq = lane >> 4;
    constexpr int ntK = K / BK;
    int Rs[2], Cs[2]; unsigned voffB[2];
#pragma unroll
    for (int i = 0; i < 2; ++i) { int R, C; stage_rc(tid * 16 + i * 8192, R, C); const int Rb = Epi::PERM ? ((R & ~31) + perm32(R & 31)) : R; Rs[i] = R; Cs[i] = C; voffB[i] = (unsigned)(Rb * ldb + C) * 2u; }
    const size_t kstep = (size_t)(BK * 2);
    const size_t hstepB = (size_t)HALF * ldb * 2;
    constexpr unsigned hstepA = GATHER ? 0u : (unsigned)HALF * lda * 2u;
    const unsigned ldsw = (unsigned)wid * 1024u;
    const int aoff = lds_byte(wr * 64 + fr, fq * 8), boff = lds_byte(wc * 32 + fr, fq * 8);
#define PG8_SA(b, h) (((b) * 2 + (h)) * HTB)
#define PG8_SB(b, h) ((4 + (b) * 2 + (h)) * HTB)
#define PG8_RSRC(p) __builtin_amdgcn_make_buffer_rsrc((void*)pg8::uniform_ptr((const char*)(p)), 0, 0x7fffffff, 0x00020000)
#define PG8_STAGE(bufoff, gbase, soff, voff) do { const __amdgpu_buffer_rsrc_t r_ = PG8_RSRC(gbase); _Pragma("unroll") for (int _i = 0; _i < 2; ++_i) \
        __builtin_amdgcn_raw_ptr_buffer_load_lds(r_, (PG8_LAS unsigned*)(lds + (bufoff) + ldsw + _i * 8192), 16, (voff)[_i], (int)(soff), 0, 0); } while (0)
#define PG8_LDA(dst, b, h) do { _Pragma("unroll") for (int m = 0; m < 4; ++m) _Pragma("unroll") for (int k = 0; k < 2; ++k) dst[m][k] = *(const PG8_LAS bf16x8*)(lds + PG8_SA(b, h) + aoff + m * 2048 + k * 1024); } while (0)
#define PG8_LDB(dst, b, h) do { _Pragma("unroll") for (int n = 0; n < 2; ++n) _Pragma("unroll") for (int k = 0; k < 2; ++k) dst[n][k] = *(const PG8_LAS bf16x8*)(lds + PG8_SB(b, h) + boff + n * 2048 + k * 1024); } while (0)
#define PG8_CAT(x0, x1) __builtin_shufflevector(__builtin_bit_cast(i32x4, (x0)), __builtin_bit_cast(i32x4, (x1)), 0, 1, 2, 3, 4, 5, 6, 7)
#define PG8_MMA(ai, bj, At, Bt) do { __builtin_amdgcn_s_setprio(1); _Pragma("unroll") for (int m = 0; m < 4; ++m) _Pragma("unroll") for (int n = 0; n < 2; ++n) { \
        if constexpr (FP8) acc[ai][bj][m][n] = __builtin_amdgcn_mfma_scale_f32_16x16x128_f8f6f4(PG8_CAT(Bt[n][0], Bt[n][1]), PG8_CAT(At[m][0], At[m][1]), acc[ai][bj][m][n], 0, 0, 0, 0x7f7f7f7f, 0, 0x7f7f7f7f); \
        else { _Pragma("unroll") for (int k = 0; k < 2; ++k) acc[ai][bj][m][n] = __builtin_amdgcn_mfma_f32_16x16x32_bf16(Bt[n][k], At[m][k], acc[ai][bj][m][n], 0, 0, 0); } } __builtin_amdgcn_s_setprio(0); } while (0)
#define PG8_WAIT_V(n) asm volatile("s_waitcnt vmcnt(" #n ")" ::: "memory")
#define PG8_WAIT_L(n) asm volatile("s_waitcnt lgkmcnt(" #n ")" ::: "memory")
#define PG8_BAR __builtin_amdgcn_s_barrier()
#define PG8_SCHED __builtin_amdgcn_sched_barrier(0)
    Unit cur, nxt; int ui = 0;
    if (!S.next(0, cur)) return;
#if defined(TPROBE) && (TPROBE == 10 || TPROBE == 11)
    unsigned tpe_ = 0, tpn_ = 0; const unsigned tpg0_ = (unsigned)__builtin_amdgcn_s_memtime();
#endif
    f32x4 acc[2][2][4][2];
#pragma unroll
    for (int a = 0; a < 2; ++a)
#pragma unroll
        for (int b = 0; b < 2; ++b)
#pragma unroll
            for (int m = 0; m < 4; ++m)
#pragma unroll
                for (int n = 0; n < 2; ++n) acc[a][b][m][n] = (f32x4){0.f, 0.f, 0.f, 0.f};
    bf16x8 At[4][2], B0[2][2], B1[2][2];
    unsigned cOff[2][2], nOff[2][2];
#pragma unroll
    for (int hh = 0; hh < 2; ++hh)
#pragma unroll
        for (int i = 0; i < 2; ++i) {
            if constexpr (GATHER) { const int ridx = hh * HALF + Rs[i]; int tk = cur.rows[ridx]; tk = ridx < cur.aux ? tk : 0; cOff[hh][i] = (unsigned)(tk * lda + Cs[i]) * 2u; }
            else cOff[hh][i] = (unsigned)(Rs[i] * lda + Cs[i]) * 2u;
            if constexpr (GATHER) nOff[hh][i] = cOff[hh][i]; else nOff[hh][i] = 0u;
        }
    const char* cA = cur.a; const char* cB = cur.b;
    S.a_ready(cur);
    if constexpr (SP2) {
        PG8_STAGE(PG8_SB(0, 0), cB, 0, voffB); PG8_STAGE(PG8_SB(0, 1), cB, hstepB, voffB); PG8_STAGE(PG8_SA(0, 0), cA, 0, cOff[0]); PG8_STAGE(PG8_SA(0, 1), cA, hstepA, cOff[GATHER ? 1 : 0]);
        if (wr == 1) PG8_BAR;
        PG8_WAIT_V(2); PG8_BAR;
        PG8_STAGE(PG8_SB(1, 0), cB, kstep, voffB); PG8_STAGE(PG8_SA(1, 0), cA, kstep, cOff[0]); PG8_STAGE(PG8_SB(1, 1), cB, hstepB + kstep, voffB);
        PG8_WAIT_V(6); PG8_BAR;
    } else {
        PG8_STAGE(PG8_SB(0, 0), cB, 0, voffB); PG8_STAGE(PG8_SA(0, 0), cA, 0, cOff[0]); PG8_STAGE(PG8_SB(0, 1), cB, hstepB, voffB); PG8_STAGE(PG8_SA(0, 1), cA, hstepA, cOff[GATHER ? 1 : 0]);
        if (wr == 1) PG8_BAR;
        PG8_WAIT_V(4); PG8_BAR;
        PG8_STAGE(PG8_SB(1, 0), cB, kstep, voffB); PG8_STAGE(PG8_SA(1, 0), cA, kstep, cOff[0]); PG8_STAGE(PG8_SB(1, 1), cB, hstepB + kstep, voffB);
        PG8_WAIT_V(6); PG8_BAR;
    }
    for (;;) {
        const bool has_next = S.next(ui + 1, nxt);
        const char* nA = has_next ? nxt.a : cA; const char* nB = has_next ? nxt.b : cB;
        if constexpr (GATHER) {
            if (has_next) {
#pragma unroll
                for (int hh = 0; hh < 2; ++hh)
#pragma unroll
                    for (int i = 0; i < 2; ++i) { const int ridx = hh * HALF + Rs[i]; int tk = nxt.rows[ridx]; tk = ridx < nxt.aux ? tk : 0; nOff[hh][i] = (unsigned)(tk * lda + Cs[i]) * 2u; }
            } else {
#pragma unroll
                for (int hh = 0; hh < 2; ++hh)
#pragma unroll
                    for (int i = 0; i < 2; ++i) nOff[hh][i] = cOff[hh][i];
            }
        }
        const int nt = cur.nt ? cur.nt : ntK;
#if defined(TPROBE) && (TPROBE == 11)
        const unsigned tpk0_ = (unsigned)__builtin_amdgcn_s_memtime();
#endif
#pragma unroll 1
        for (int t = 0; t < nt; t += 2) {
            const bool last = (t == nt - 2);
            const unsigned o1 = (unsigned)((t + 1) * kstep);
            const char* a2 = last ? nA : cA; const char* b2 = last ? nB : cB; const unsigned o2k = last ? 0u : (unsigned)((t + 2) * kstep), o3k = o2k + (unsigned)kstep;
            unsigned o2[2][2];
#pragma unroll
            for (int hh = 0; hh < 2; ++hh)
#pragma unroll
                for (int i = 0; i < 2; ++i) { if constexpr (GATHER) o2[hh][i] = last ? nOff[hh][i] : cOff[hh][i]; else o2[hh][i] = cOff[hh][i]; }
            if (last && has_next) S.a_ready(nxt);
            if constexpr (SP2) {
            PG8_LDB(B0, 0, 0); PG8_LDB(B1, 0, 1); PG8_SCHED; PG8_LDA(At, 0, 0); PG8_STAGE(PG8_SA(1, 1), cA, o1 + hstepA, cOff[GATHER ? 1 : 0]);
            PG8_WAIT_V(8); PG8_WAIT_L(0); PG8_BAR; PG8_MMA(0, 0, At, B0); PG8_MMA(0, 1, At, B1); PG8_BAR; PG8_SCHED;
            PG8_LDA(At, 0, 1); PG8_STAGE(PG8_SB(0, 0), b2, o2k, voffB); PG8_STAGE(PG8_SB(0, 1), b2, o2k + hstepB, voffB); PG8_STAGE(PG8_SA(0, 0), a2, o2k, o2[0]);
            PG8_WAIT_V(8); PG8_WAIT_L(0); PG8_BAR; PG8_MMA(1, 0, At, B0); PG8_MMA(1, 1, At, B1); PG8_BAR; PG8_SCHED;
            PG8_LDB(B0, 1, 0); PG8_LDB(B1, 1, 1); PG8_SCHED; PG8_LDA(At, 1, 0); PG8_STAGE(PG8_SA(0, 1), a2, o2k + hstepA, o2[GATHER ? 1 : 0]);
            PG8_WAIT_V(8); PG8_WAIT_L(0); PG8_BAR; PG8_MMA(0, 0, At, B0); PG8_MMA(0, 1, At, B1); PG8_BAR; PG8_SCHED;
            PG8_LDA(At, 1, 1); PG8_STAGE(PG8_SB(1, 0), b2, o3k, voffB); PG8_STAGE(PG8_SB(1, 1), b2, o3k + hstepB, voffB); PG8_STAGE(PG8_SA(1, 0), a2, o3k, o2[0]);
            PG8_WAIT_V(8); PG8_WAIT_L(0); PG8_BAR; PG8_MMA(1, 0, At, B0); PG8_MMA(1, 1, At, B1); PG8_BAR; PG8_SCHED;
            } else {
            PG8_LDB(B0, 0, 0); PG8_SCHED; PG8_LDA(At, 0, 0); PG8_STAGE(PG8_SA(1, 1), cA, o1 + hstepA, cOff[GATHER ? 1 : 0]);
            PG8_WAIT_L(8); PG8_BAR; PG8_WAIT_L(0); PG8_MMA(0, 0, At, B0); PG8_BAR; PG8_SCHED;
            PG8_LDB(B1, 0, 1); PG8_STAGE(PG8_SB(0, 0), b2, o2k, voffB);
            PG8_BAR; PG8_WAIT_L(0); PG8_MMA(0, 1, At, B1); PG8_BAR;
            PG8_LDA(At, 0, 1); PG8_STAGE(PG8_SA(0, 0), a2, o2k, o2[0]);
            PG8_BAR; PG8_WAIT_L(0); PG8_MMA(1, 0, At, B0); PG8_BAR; PG8_SCHED;
            PG8_STAGE(PG8_SB(0, 1), b2, o2k + hstepB, voffB);
            PG8_WAIT_V(6); PG8_BAR; PG8_MMA(1, 1, At, B1); PG8_BAR;
            PG8_LDB(B0, 1, 0); PG8_SCHED; PG8_LDA(At, 1, 0); PG8_STAGE(PG8_SA(0, 1), a2, o2k + hstepA, o2[GATHER ? 1 : 0]);
            PG8_WAIT_L(8); PG8_BAR; PG8_WAIT_L(0); PG8_MMA(0, 0, At, B0); PG8_BAR; PG8_SCHED;
            PG8_LDB(B1, 1, 1); PG8_STAGE(PG8_SB(1, 0), b2, o3k, voffB);
            PG8_BAR; PG8_WAIT_L(0); PG8_MMA(0, 1, At, B1); PG8_BAR;
            PG8_LDA(At, 1, 1); PG8_STAGE(PG8_SA(1, 0), a2, o3k, o2[0]);
            PG8_BAR; PG8_WAIT_L(0); PG8_MMA(1, 0, At, B0); PG8_BAR; PG8_SCHED;
            PG8_STAGE(PG8_SB(1, 1), b2, o3k + hstepB, voffB);
            PG8_WAIT_V(6); PG8_BAR; PG8_MMA(1, 1, At, B1); PG8_BAR;
            }
        }
#if defined(TPROBE) && (TPROBE == 11)
        tpe_ += (unsigned)__builtin_amdgcn_s_memtime() - tpk0_; tpn_ += (unsigned)nt;
#endif
        if constexpr (ALIGN_EPI) { if (wr == 0) PG8_BAR; }
#if defined(TPROBE) && (TPROBE == 10)
        const unsigned tpe0_ = (unsigned)__builtin_amdgcn_s_memtime();
#endif
        { int tl_ = tid; asm volatile("" : "+v"(tl_)); const int l2_ = tl_ & 63; E(acc, cur, wr, wc, l2_ & 15, l2_ >> 4); } S.done(cur);
#if defined(TPROBE) && (TPROBE == 10)
        tpe_ += (unsigned)__builtin_amdgcn_s_memtime() - tpe0_;
#endif
        if (!has_next) break;
#pragma unroll
        for (int a = 0; a < 2; ++a)
#pragma unroll
            for (int b = 0; b < 2; ++b)
#pragma unroll
                for (int m = 0; m < 4; ++m)
#pragma unroll
                    for (int n = 0; n < 2; ++n) acc[a][b][m][n] = (f32x4){0.f, 0.f, 0.f, 0.f};
        cur = nxt; cA = nA; cB = nB; ++ui;
        if constexpr (GATHER) {
#pragma unroll
            for (int hh = 0; hh < 2; ++hh)
#pragma unroll
                for (int i = 0; i < 2; ++i) cOff[hh][i] = nOff[hh][i];
        }
        if constexpr (ALIGN_EPI) { if (wr == 1) PG8_BAR; }
    }
    PG8_WAIT_V(0);
#if defined(TPROBE) && (TPROBE == 11)
    if (!FP8 && tid == 0) { unsigned* cw_ = (unsigned*)(*(PG8_LAS unsigned long long*)(lds + 160 * 1024 - 256 + 80)); atomicAdd(cw_ + 70000, tpe_ >> 6); atomicAdd(cw_ + 70001, tpn_); (void)tpg0_; }
#endif
#if defined(TPROBE) && (TPROBE == 10)
    if (tid == 0) { unsigned* cw_ = (unsigned*)(*(PG8_LAS unsigned long long*)(lds + 160 * 1024 - 256 + 80)); atomicAdd(cw_ + 70000, tpe_ >> 6); atomicAdd(cw_ + 70001, ((unsigned)__builtin_amdgcn_s_memtime() - tpg0_) >> 6); }
#endif
    if constexpr (!ALIGN_EPI) { if (wr == 0) PG8_BAR; }
    PG8_BAR;
#undef PG8_SA
#undef PG8_SB
#undef PG8_STAGE
#undef PG8_RSRC
#undef PG8_LDA
#undef PG8_LDB
#undef PG8_MMA
#undef PG8_CAT
#undef PG8_WAIT_V
#undef PG8_WAIT_L
#undef PG8_BAR
#undef PG8_SCHED
}
}

constexpr int NWAVES = 8;
constexpr int BATCH = 2, SEQ = 16384, D = 1024, NTOK = BATCH * SEQ;
constexpr int NLAYER = 2;
constexpr int NPROJ = 2816, IN_COLS = 2832;
constexpr int PJ = 2048;
constexpr int C_PIN = 0, C_CB = 256, C_CC = 512, C_CX = 768, C_DQ = 1024, C_DK = 1280, C_DV = 1536, C_DZ = 1792;
constexpr int DFF = 2816, NEXP = 8;
constexpr int NCHUNK = SEQ / 64;
constexpr int NINST = BATCH * 4 * 2 * NCHUNK;
constexpr float EPS = 1e-6f;
constexpr float QSCALE = 0.17677669529663687f * 1.4426950408889634f;
#ifndef MOE_FP8
#define MOE_FP8 1
#endif
constexpr float W8SCALE = 64.f;
constexpr int MOE_PASS_TILES = MOE_FP8 ? 264 : 132;
constexpr int MOE_NPASS = MOE_FP8 ? 1 : 2;

constexpr size_t MiB = 1u << 20;
constexpr size_t WS_CTL = 0, CTL_ZERO_BYTES = 1 * MiB;
constexpr size_t SZ_WIN = (size_t)NPROJ * D * 2, SZ_WM = (size_t)4096 * D * 2, SZ_WB = (size_t)4 * 1024 * 256 * 2, SZ_WO = (size_t)D * D * 2;
constexpr size_t SZ_LAYERW = SZ_WIN + SZ_WM + SZ_WB + SZ_WO;
constexpr size_t SZ_WGU = (size_t)2 * DFF * D * 2, SZ_WD = (size_t)D * DFF * 2, SZ_FFNW = SZ_WGU + SZ_WD;
constexpr size_t WS_W = 1 * MiB;
constexpr size_t WS_WFFN = WS_W + 2 * SZ_LAYERW;
static_assert(WS_WFFN + SZ_FFNW <= 53 * MiB, "weights");
constexpr size_t WS_H = 53 * MiB;
constexpr size_t WS_O4 = 117 * MiB;
constexpr size_t WS_F = WS_O4;
constexpr size_t WS_BD = 181 * MiB;
constexpr size_t WS_DEC = 183 * MiB;
constexpr size_t WS_PROJ = 185 * MiB;
constexpr size_t WS_QB = 521 * MiB;
constexpr size_t WS_KV = 313 * MiB;
constexpr size_t WS_UW = 361 * MiB;
constexpr size_t WS_AB = 425 * MiB;
constexpr size_t WS_ST = 489 * MiB;
constexpr size_t WS_PBUF = 185 * MiB;
constexpr size_t WS_MERGED = 441 * MiB;
constexpr size_t WS_ACT0 = 185 * MiB;
constexpr size_t WS_H2B = 479 * MiB;
constexpr size_t WS_MOEW = 185 * MiB;
constexpr size_t WS_XG = 251 * MiB;
constexpr size_t WS_ACT1 = 1 * MiB;
constexpr size_t WS_Y = 317 * MiB;
constexpr size_t WS_ROUTE = 449 * MiB;
constexpr size_t WS_END = 543 * MiB;
static_assert(WS_ACT1 + (size_t)MOE_PASS_TILES * 256 * DFF * (MOE_FP8 ? 1 : 2) <= WS_MOEW, "act1");
static_assert((MOE_FP8 ? WS_XG + (size_t)264 * 256 * D : WS_MOEW + 8 * SZ_FFNW) <= WS_Y && WS_MOEW + 8 * SZ_FFNW / 2 <= WS_XG && WS_Y + (size_t)264 * 256 * D * 2 <= WS_ROUTE && WS_ROUTE + 4 * MiB <= WS_H2B && WS_H2B + 64 * MiB <= WS_END, "moe map");
static_assert(WS_PROJ + (size_t)NTOK * PJ * 2 <= WS_KV && WS_KV + (size_t)8 * 256 * 19456 <= WS_UW && WS_QB + 16 * MiB <= WS_END && WS_ST + (size_t)NINST * 8192 <= WS_END, "mixer map");
constexpr int CW_TMO = 0, CW_CODE = 1;
constexpr int CW_BAR = 4096;
constexpr int CW_MOD = 16384;
constexpr int CW_MOECNT = 65536;
constexpr int CW_NMAX = 66560;
constexpr int CW_MODCNT = 66624;
constexpr int CW_ATTQ = 66688;
static_assert(CW_MOD + NLAYER * BATCH * 6 * D <= CW_MOECNT && (CW_ATTQ + 32 * 64) * 4 <= (int)CTL_ZERO_BYTES, "ctl");

constexpr int RING_OFF = 0, RING_BYTES = 131072;
constexpr int LDS_BYTES = 160 * 1024;
constexpr int MISC_OFF = LDS_BYTES - 256;

#define GAS __attribute__((address_space(1)))
#define LAS __attribute__((address_space(3)))
typedef unsigned short bf16;
typedef unsigned v4u __attribute__((ext_vector_type(4)));
typedef unsigned v2u __attribute__((ext_vector_type(2)));
typedef float f32x4 __attribute__((ext_vector_type(4)));
typedef float f32x16 __attribute__((ext_vector_type(16)));
typedef short bf16x8 __attribute__((ext_vector_type(8)));
typedef short bf16x4 __attribute__((ext_vector_type(4)));
typedef GAS unsigned gu32;
#define RLX_AGENT __ATOMIC_RELAXED, __HIP_MEMORY_SCOPE_AGENT
#define LDS_WAIT() asm volatile("s_waitcnt lgkmcnt(0)" ::: "memory")
#define VM_WAIT() asm volatile("s_waitcnt vmcnt(0)" ::: "memory")
__device__ __forceinline__ unsigned pk2(float lo, float hi) { typedef float f2_ __attribute__((ext_vector_type(2))); typedef __bf16 b2_ __attribute__((ext_vector_type(2))); const f2_ v = {lo, hi}; return __builtin_bit_cast(unsigned, __builtin_convertvector(v, b2_)); }
__device__ __forceinline__ unsigned f2bf(float f) { return pk2(f, f) & 0xffffu; }
__device__ __forceinline__ float bf2f(unsigned b) { return __builtin_bit_cast(float, b << 16); }
__device__ __forceinline__ float bflo(unsigned w) { return __builtin_bit_cast(float, w << 16); }
__device__ __forceinline__ float bfhi(unsigned w) { return __builtin_bit_cast(float, w & 0xffff0000u); }
__device__ __forceinline__ float fast_exp2(float x) { return __builtin_amdgcn_exp2f(x); }
__device__ __forceinline__ float fast_exp(float x) { return __builtin_amdgcn_exp2f(x * 1.4426950408889634f); }
__device__ __forceinline__ float fast_rcp(float x) { return __builtin_amdgcn_rcpf(x); }
__device__ __forceinline__ float sigmoidf_(float x) { return fast_rcp(1.f + fast_exp(-x)); }
__device__ __forceinline__ float siluf_(float x) { return x * sigmoidf_(x); }
__device__ __forceinline__ float wave_sum(float v) {
    v += __builtin_bit_cast(float, __builtin_amdgcn_update_dpp(0, __builtin_bit_cast(int, v), 0xB1, 0xf, 0xf, true));
    v += __builtin_bit_cast(float, __builtin_amdgcn_update_dpp(0, __builtin_bit_cast(int, v), 0x4E, 0xf, 0xf, true));
    v += __builtin_bit_cast(float, __builtin_amdgcn_update_dpp(0, __builtin_bit_cast(int, v), 0x141, 0xf, 0xf, true));
    v += __builtin_bit_cast(float, __builtin_amdgcn_update_dpp(0, __builtin_bit_cast(int, v), 0x140, 0xf, 0xf, true));
    v += __builtin_bit_cast(float, __builtin_amdgcn_ds_swizzle(__builtin_bit_cast(int, v), 0x401f));
    v += __shfl_xor(v, 32);
    return v;
}

#define XB_TMO      128
#define XB_XCNT(j)  (256  + 64 * (j))
#define XB_XSUB(j)  (1280 + 64 * (j))
#define XB_XGEN(j)  (2304 + 64 * (j))
#define XB_TOP      3328
#define XB_TOPGEN   3392
#define XCD_BAR_WORDS 3456
#define XB_SPIN_CAP (1u << 22)
__device__ __forceinline__ unsigned xb_ld(unsigned* p)              { return __hip_atomic_load(p, __ATOMIC_RELAXED, __HIP_MEMORY_SCOPE_AGENT); }
__device__ __forceinline__ unsigned xb_add(unsigned* p, unsigned v) { return __hip_atomic_fetch_add(p, v, __ATOMIC_RELAXED, __HIP_MEMORY_SCOPE_AGENT); }
__device__ __forceinline__ unsigned xb_xcc_id() { return (unsigned)__builtin_amdgcn_s_getreg((3 << 11) | 20) & 0xFu; }
#define XB_SPIN(cond, bar) do { unsigned _sp = 0; while (cond) { __builtin_amdgcn_s_sleep(1); \
    if ((++_sp & 255u) == 0u) { if (xb_ld(&(bar)[XB_TMO])) break; if (_sp > XB_SPIN_CAP) { atomicAdd(&(bar)[XB_TMO], 1u); break; } } } } while (0)
struct XcdBarrier { unsigned* bar; unsigned x; volatile LAS unsigned* st; };
__device__ __forceinline__ XcdBarrier xcd_barrier_post(unsigned* bar, volatile LAS unsigned* st) {
    XcdBarrier b; b.bar = bar; b.x = xb_xcc_id(); b.st = st;
    if (threadIdx.x == 0) (void)xb_add(&bar[XB_XCNT(b.x)], 1u);
    return b;
}
__device__ __forceinline__ void xcd_barrier_complete(unsigned* bar, unsigned x, unsigned& nloc, unsigned& nx) {
    const unsigned G = gridDim.x * gridDim.y * gridDim.z;
    unsigned sum, cnt, mine, sp = 0u;
    for (;;) {
        sum = 0u; cnt = 0u; mine = 0u;
#pragma unroll
        for (unsigned j = 0; j < 16; ++j) { const unsigned c = xb_ld(&bar[XB_XCNT(j)]); sum += c; cnt += (c > 0u) ? 1u : 0u; }
        mine = xb_ld(&bar[XB_XCNT(x)]);
        if (sum == G) break;
        __builtin_amdgcn_s_sleep(1);
        if ((++sp & 255u) == 0u) { if (xb_ld(&bar[XB_TMO])) break; if (sp > XB_SPIN_CAP) { atomicAdd(&bar[XB_TMO], 1u); break; } }
    }
    nloc = mine > 0u ? mine : 1u; nx = cnt > 0u ? cnt : 1u;
}
__device__ __forceinline__ void xcd_barrier(const XcdBarrier& b) {
    asm volatile("s_waitcnt vmcnt(0)" ::: "memory");
    __syncthreads();
    if (threadIdx.x == 0) {
        unsigned* bar = b.bar;
        __builtin_amdgcn_s_waitcnt(0);
        unsigned nloc = b.st[0], nx = b.st[1];
        if (nloc == 0u) { xcd_barrier_complete(bar, b.x, nloc, nx); b.st[0] = nloc; b.st[1] = nx; }
        const unsigned old = xb_add(&bar[XB_XSUB(b.x)], 1u);
        const unsigned gen = old / nloc;
        if (old + 1u == (gen + 1u) * nloc) {
            __builtin_amdgcn_fence(__ATOMIC_RELEASE, "agent");
            asm volatile("s_waitcnt vmcnt(0)" ::: "memory");
            const unsigned og = xb_add(&bar[XB_TOP], 1u);
            const unsigned tg = og / nx;
            if (og + 1u == (tg + 1u) * nx) xb_add(&bar[XB_TOPGEN], 1u);
            else XB_SPIN(xb_ld(&bar[XB_TOPGEN]) == tg, bar);
            __builtin_amdgcn_fence(__ATOMIC_ACQUIRE, "agent");
            xb_add(&bar[XB_XGEN(b.x)], 1u);
            asm volatile("s_waitcnt vmcnt(0)" ::: "memory");
        } else {
            XB_SPIN(xb_ld(&bar[XB_XGEN(b.x)]) == gen, bar);
            __builtin_amdgcn_fence(__ATOMIC_ACQUIRE, "agent");
            asm volatile("s_waitcnt vmcnt(0)" ::: "memory");
        }
    }
    __syncthreads();
}

__device__ __forceinline__ int fresh_lane() { unsigned m_ = ~0u; asm volatile("" : "+s"(m_)); return (int)__builtin_amdgcn_mbcnt_hi(m_, __builtin_amdgcn_mbcnt_lo(m_, 0u)); }
#define LANE_XOR_F(lane_, v_, m_) __builtin_bit_cast(float, __builtin_amdgcn_ds_bpermute((((lane_) ^ (m_)) << 2), __builtin_bit_cast(int, (float)(v_))))
struct Frame {
    LAS unsigned char* lds;
    volatile LAS unsigned* MISC;
    gu32* ctl;
    int tid, lane, wave;
    int vcu, G;
    unsigned char* ws;
    float* out;
    const float* const* in;
};
enum { I_X = 0, I_C, I_ADAW, I_ADAB, I_NMIXPRE, I_NMIXPOST, I_NFFNPRE, I_NFFNPOST, I_WIN, I_DLAMBDA, I_DSUBLN, I_POOLW, I_POOLSCALE, I_SCONVW, I_DCONVW, I_DALOG, I_DDTBIAS, I_DNORM,
       I_WBRANCH, I_WMERGE, I_BMERGE, I_WO, I_FFNG, I_FFNU, I_FFND, I_ROUTERW, I_ROUTERB, I_MOEG, I_MOEU, I_MOED, N_INPUTS };

#ifndef XGB
#define XGB 8
#endif
#ifndef CVT_NT
#define CVT_NT 0
#endif
__device__ __forceinline__ unsigned pk4_fp8(float a, float b, float c, float d) { int w = __builtin_amdgcn_cvt_pk_fp8_f32(a, b, 0, false); w = __builtin_amdgcn_cvt_pk_fp8_f32(c, d, w, true); return (unsigned)w; }
template <bool F8 = false> __device__ __forceinline__ void cvt_item(const float* W, int ldw, int k0, int n0, bf16* WT, int Kd, int drow0, LAS float* scr, int lane) {
#pragma unroll 8
    for (int i = 0; i < 32; ++i) { const int kk = 2 * i + (lane >> 5); const float* wp_ = W + (size_t)(k0 + kk) * ldw + n0 + (lane & 31); scr[kk * 33 + (lane & 31)] = CVT_NT ? __builtin_nontemporal_load(wp_) : *wp_; }
    LDS_WAIT(); asm volatile("" ::: "memory");
    const int c = lane & 7;
#pragma unroll
    for (int j = 0; j < 4; ++j) { const int n = (lane >> 3) + 8 * j; const LAS float* s = scr + (8 * c) * 33 + n;
        if constexpr (F8) { v2u o; o.x = pk4_fp8(s[0 * 33] * W8SCALE, s[1 * 33] * W8SCALE, s[2 * 33] * W8SCALE, s[3 * 33] * W8SCALE); o.y = pk4_fp8(s[4 * 33] * W8SCALE, s[5 * 33] * W8SCALE, s[6 * 33] * W8SCALE, s[7 * 33] * W8SCALE);
            *(GAS v2u*)((unsigned char*)WT + (size_t)(drow0 + n) * Kd + k0 + 8 * c) = o; }
        else { v4u o; o.x = pk2(s[0 * 33], s[1 * 33]); o.y = pk2(s[2 * 33], s[3 * 33]); o.z = pk2(s[4 * 33], s[5 * 33]); o.w = pk2(s[6 * 33], s[7 * 33]);
            *(GAS v4u*)(WT + (size_t)(drow0 + n) * Kd + k0 + 8 * c) = o; } }
    LDS_WAIT(); asm volatile("" ::: "memory");
}
template <bool F8 = false> __device__ __forceinline__ void cvt_ffn_item(const float* wg, const float* wu, const float* wd, bf16* Wgu, bf16* Wd, int r, LAS float* scr, int lane) {
    constexpr int IG = (D / 64) * (DFF / 32);
    if (r < IG) { const int kb = r / (DFF / 32), nb = r % (DFF / 32), n0 = nb * 32; cvt_item<F8>(wg, DFF, kb * 64, n0, Wgu, D, 256 * (n0 >> 7) + (n0 & 127), scr, lane); return; } r -= IG;
    if (r < IG) { const int kb = r / (DFF / 32), nb = r % (DFF / 32), n0 = nb * 32; cvt_item<F8>(wu, DFF, kb * 64, n0, Wgu, D, 256 * (n0 >> 7) + (n0 & 127) + 128, scr, lane); return; } r -= IG;
    { const int kb = r / (D / 32), nb = r % (D / 32); cvt_item<F8>(wd, D, kb * 64, nb * 32, Wd, DFF, nb * 32, scr, lane); }
}
constexpr int FFN_ITEMS = 3 * (D / 64) * (DFF / 32);
__device__ __forceinline__ bf16* w_in_t(unsigned char* ws, int l) { return (bf16*)(ws + WS_W + (size_t)l * SZ_LAYERW); }
__device__ __forceinline__ bf16* w_m_t(unsigned char* ws, int l) { return (bf16*)(ws + WS_W + (size_t)l * SZ_LAYERW + SZ_WIN); }
__device__ __forceinline__ bf16* w_b_t(unsigned char* ws, int l) { return (bf16*)(ws + WS_W + (size_t)l * SZ_LAYERW + SZ_WIN + SZ_WM); }
__device__ __forceinline__ bf16* w_o_t(unsigned char* ws, int l) { return (bf16*)(ws + WS_W + (size_t)l * SZ_LAYERW + SZ_WIN + SZ_WM + SZ_WB); }

__device__ __forceinline__ void p_prologue(Frame& F) {
    LAS float* scr = (LAS float*)(F.lds + RING_OFF + F.wave * 16384);
    const int gw = F.vcu * NWAVES + F.wave, NGW = F.G * NWAVES;
    constexpr int I_IN = (D / 64) * (NPROJ / 32), I_M = (D / 64) * (D / 32), I_B = (256 / 64) * (D / 32);
    constexpr int PER_LAYER = I_IN + 4 * I_M + 4 * I_B + I_M;
    constexpr int NITEMS = NLAYER * PER_LAYER + FFN_ITEMS;
    for (int it = gw; it < NITEMS; it += NGW) {
        int r = it;
        if (r >= NLAYER * PER_LAYER) { r -= NLAYER * PER_LAYER;
            cvt_ffn_item(F.in[I_FFNG], F.in[I_FFNU], F.in[I_FFND], (bf16*)(F.ws + WS_WFFN), (bf16*)(F.ws + WS_WFFN + SZ_WGU), r, scr, F.lane); continue; }
        const int l = r / PER_LAYER; r -= l * PER_LAYER;
        if (r < I_IN) { const int kb = r / (NPROJ / 32), nb = r % (NPROJ / 32); cvt_item(F.in[I_WIN] + (size_t)l * D * IN_COLS, IN_COLS, kb * 64, nb * 32, w_in_t(F.ws, l), D, nb * 32, scr, F.lane); continue; } r -= I_IN;
        if (r < 4 * I_M) { const int i = r / I_M; r -= i * I_M; const int kb = r / (D / 32), nb = r % (D / 32);
            cvt_item(F.in[I_WMERGE] + ((size_t)l * 4 + i) * D * D, D, kb * 64, nb * 32, w_m_t(F.ws, l), D, i * 1024 + nb * 32, scr, F.lane); continue; } r -= 4 * I_M;
        if (r < 4 * I_B) { const int i = r / I_B; r -= i * I_B; const int kb = r / (D / 32), nb = r % (D / 32);
            cvt_item(F.in[I_WBRANCH] + ((size_t)l * 4 + i) * 256 * D, D, kb * 64, nb * 32, w_b_t(F.ws, l) + i * 256, 1024, nb * 32, scr, F.lane); continue; } r -= 4 * I_B;
        { const int kb = r / (D / 32), nb = r % (D / 32); cvt_item(F.in[I_WO] + (size_t)l * D * D, D, kb * 64, nb * 32, w_o_t(F.ws, l), D, nb * 32, scr, F.lane); }
    }
    constexpr int MOD_ITEMS = NLAYER * 24 * 16;
    for (int it = F.wave * F.G + F.vcu; it < MOD_ITEMS; it += NGW) {
        const int grp = it >> 4, kc = it & 15, l = grp / 24, nb = grp % 24;
        const float* Wp = F.in[I_ADAW] + ((size_t)l * D + kc * 64) * (6 * D) + nb * 256 + F.lane * 4;
        f32x4 a0 = {0.f, 0.f, 0.f, 0.f}, a1 = {0.f, 0.f, 0.f, 0.f};
#pragma unroll 8
        for (int k = 0; k < 64; ++k) { const f32x4 w = *(const GAS f32x4*)(Wp + (size_t)k * (6 * D));
            const float c0 = siluf_(F.in[I_C][kc * 64 + k]), c1 = siluf_(F.in[I_C][D + kc * 64 + k]); a0 += w * c0; a1 += w * c1; }
        float* part = (float*)(F.ws + WS_BD) + ((size_t)grp * 16 + kc) * 512 + F.lane * 4;
        *(GAS f32x4*)part = a0; *(GAS f32x4*)(part + 256) = a1;
        __threadfence();
        unsigned old = 0;
        if (F.lane == 0) old = __hip_atomic_fetch_add(F.ctl + CW_MODCNT + grp, 1u, RLX_AGENT);
        old = __builtin_amdgcn_readfirstlane(old);
        if (old == 15u) {
            __threadfence();
            f32x4 s0 = {0.f, 0.f, 0.f, 0.f}, s1 = {0.f, 0.f, 0.f, 0.f};
            const float* pg = (const float*)(F.ws + WS_BD) + (size_t)grp * 16 * 512 + F.lane * 4;
#pragma unroll
            for (int q = 0; q < 16; ++q) { s0 += __builtin_nontemporal_load((const f32x4*)(pg + q * 512)); s1 += __builtin_nontemporal_load((const f32x4*)(pg + q * 512 + 256)); }
            float* m0 = (float*)(F.ctl + CW_MOD) + (size_t)(l * BATCH + 0) * 6 * D + nb * 256 + F.lane * 4;
            *(GAS f32x4*)m0 = s0; *(GAS f32x4*)(m0 + 6 * D) = s1;
        }
    }
}
__device__ __forceinline__ void moe_tiles(Frame& F, int (&cnt)[NEXP], int (&tstart)[NEXP + 1]) {
    int acc = 0;
#pragma unroll
    for (int e = 0; e < NEXP; ++e) { cnt[e] = __builtin_amdgcn_readfirstlane((int)__hip_atomic_load(F.ctl + CW_MOECNT + 64 * e, RLX_AGENT)); tstart[e] = acc; acc += (cnt[e] + 255) >> 8; }
    tstart[NEXP] = acc;
}
__device__ __forceinline__ void p_moe_cvt(Frame& F) {
    LAS float* scr = (LAS float*)(F.lds + RING_OFF + F.wave * 16384);
    const int gw = F.vcu * NWAVES + F.wave, NGW = F.G * NWAVES;
    for (int it = gw; it < NEXP * FFN_ITEMS; it += NGW) {
        const int e = it / FFN_ITEMS, r = it % FFN_ITEMS;
        unsigned char* base = F.ws + WS_MOEW + (size_t)e * (MOE_FP8 ? SZ_FFNW / 2 : SZ_FFNW);
        cvt_ffn_item<MOE_FP8 != 0>(F.in[I_MOEG] + (size_t)e * D * DFF, F.in[I_MOEU] + (size_t)e * D * DFF, F.in[I_MOED] + (size_t)e * DFF * D, (bf16*)base, (bf16*)(base + (MOE_FP8 ? SZ_WGU / 2 : SZ_WGU)), r, scr, F.lane);
    }
#if MOE_FP8
    int cnt[NEXP], tstart[NEXP + 1]; moe_tiles(F, cnt, tstart);
    const int* lists = (const int*)(F.ws + WS_ROUTE + 1 * MiB);
    const int nslot = tstart[NEXP] * 256;
    for (int g0 = gw; g0 < nslot; g0 += XGB * NGW) {
        int tok[XGB];
#pragma unroll
        for (int u = 0; u < XGB; ++u) { const int gs = g0 + u * NGW; tok[u] = 0;
            if (gs < nslot) { const int t = gs >> 8; int e = 0;
#pragma unroll
                for (int k = 1; k < NEXP; ++k) e = (t >= tstart[k]) ? k : e;
                int ts = 0, ce = 0;
#pragma unroll
                for (int k = 0; k < NEXP; ++k) { ts = (k == e) ? tstart[k] : ts; ce = (k == e) ? cnt[k] : ce; }
                const int i = (t - ts) * 256 + (gs & 255);
                const int tk = lists[(size_t)e * 65536 + i]; tok[u] = i < ce ? tk : 0; } }
        v4u v[XGB];
#pragma unroll
        for (int u = 0; u < XGB; ++u) v[u] = *(const GAS v4u*)(F.ws + WS_H2B + (size_t)tok[u] * D + F.lane * 16);
#pragma unroll
        for (int u = 0; u < XGB; ++u) { const int gs = g0 + u * NGW; if (gs < nslot) *(GAS v4u*)(F.ws + WS_XG + (size_t)gs * D + F.lane * 16) = v[u]; }
    }
#endif
}

#ifndef ROW_NT
#define ROW_NT 1
#endif
struct Row { f32x4 v[4]; };
__device__ __forceinline__ float modv(Frame& F, int l, int b, int idx) { return ((const float*)(F.ctl + CW_MOD))[(size_t)(l * BATCH + b) * 6 * D + idx] + F.in[I_ADAB][l * 6 * D + idx]; }
__device__ __forceinline__ f32x4 modv4(Frame& F, int l, int b, int idx) {
    const f32x4 a = *(const GAS f32x4*)((const float*)(F.ctl + CW_MOD) + (size_t)(l * BATCH + b) * 6 * D + idx), c = *(const GAS f32x4*)(F.in[I_ADAB] + l * 6 * D + idx); return a + c; }
__device__ __forceinline__ float row_rstd(const Row& r) {
    float s = 0.f;
#pragma unroll
    for (int j = 0; j < 4; ++j) s += (r.v[j].x * r.v[j].x + r.v[j].y * r.v[j].y) + (r.v[j].z * r.v[j].z + r.v[j].w * r.v[j].w);
    return 1.f / sqrtf(wave_sum(s) * (1.f / D) + EPS);
}
__device__ __forceinline__ void row_resid(Frame& F, Row& x, const Row& f, const float* gain, int l, int b, int gidx) {
    const float rs = row_rstd(f);
#pragma unroll
    for (int j = 0; j < 4; ++j) { const int c = 4 * F.lane + 256 * j; const f32x4 g = *(const GAS f32x4*)(gain + c), m = modv4(F, l, b, gidx + c); x.v[j] += m * (f.v[j] * rs * g); }
}
__device__ __forceinline__ void row_make_h(Frame& F, Row& h, const Row& x, const float* gain, int l, int b, int shidx, int scidx) {
    const float rs = row_rstd(x);
#pragma unroll
    for (int j = 0; j < 4; ++j) { const int c = 4 * F.lane + 256 * j; const f32x4 g = *(const GAS f32x4*)(gain + c), sc = modv4(F, l, b, scidx + c), sh = modv4(F, l, b, shidx + c);
        h.v[j] = (x.v[j] * rs * g) * (sc + 1.f) + sh; }
}
struct ColVec { f32x4 v[4]; };
__device__ __forceinline__ void cv_resid(Frame& F, ColVec& c, const float* gain, int l, int b, int gidx) {
#pragma unroll
    for (int j = 0; j < 4; ++j) { const int col = 4 * F.lane + 256 * j; c.v[j] = modv4(F, l, b, gidx + col) * *(const GAS f32x4*)(gain + col); }
}
__device__ __forceinline__ void cv_h(Frame& F, ColVec& a, ColVec& c, const float* gain, int l, int b, int shidx, int scidx) {
#pragma unroll
    for (int j = 0; j < 4; ++j) { const int col = 4 * F.lane + 256 * j; a.v[j] = *(const GAS f32x4*)(gain + col) * (modv4(F, l, b, scidx + col) + 1.f); c.v[j] = modv4(F, l, b, shidx + col); }
}
__device__ __forceinline__ void row_resid_cv(Row& x, const Row& f, const ColVec& c) {
    const float rs = row_rstd(f);
#pragma unroll
    for (int j = 0; j < 4; ++j) x.v[j] += c.v[j] * (f.v[j] * rs);
}
__device__ __forceinline__ void row_make_h_cv(Row& h, const Row& x, const ColVec& a, const ColVec& c) {
    const float rs = row_rstd(x);
#pragma unroll
    for (int j = 0; j < 4; ++j) h.v[j] = (x.v[j] * rs) * a.v[j] + c.v[j];
}
__device__ __forceinline__ void row_store_bf16(Frame& F, const Row& h, bf16* dst) {
    GAS unsigned long long* o8 = (GAS unsigned long long*)dst + F.lane;
#pragma unroll
    for (int j = 0; j < 4; ++j) { const unsigned long long w = (unsigned long long)pk2(h.v[j].x, h.v[j].y) | ((unsigned long long)pk2(h.v[j].z, h.v[j].w) << 32);
        if (ROW_NT >= 2) __builtin_nontemporal_store(w, o8 + 64 * j); else o8[64 * j] = w; }
}
__device__ __forceinline__ void row_load_f32(Frame& F, Row& r, const float* src) {
    const GAS f32x4* p = (const GAS f32x4*)src + F.lane;
#pragma unroll
    for (int j = 0; j < 4; ++j) r.v[j] = ROW_NT ? __builtin_nontemporal_load(p + 64 * j) : p[64 * j];
}
__device__ __forceinline__ void row_store_f32(Frame& F, const Row& r, float* dst) {
    GAS f32x4* p = (GAS f32x4*)dst + F.lane;
#pragma unroll
    for (int j = 0; j < 4; ++j) { if (ROW_NT) __builtin_nontemporal_store(r.v[j], p + 64 * j); else p[64 * j] = r.v[j]; }
}
__device__ __forceinline__ void row_load_bf16(Frame& F, Row& r, const bf16* src) {
    const GAS v2u* p = (const GAS v2u*)src + F.lane;
#pragma unroll
    for (int j = 0; j < 4; ++j) { const v2u w = ROW_NT >= 2 ? __builtin_nontemporal_load(p + 64 * j) : p[64 * j]; r.v[j] = (f32x4){bflo(w.x), bfhi(w.x), bflo(w.y), bfhi(w.y)}; }
}
template <int NO> __device__ __forceinline__ void row_dots(Frame& F, const Row& h, const LAS float* WT, float (&out)[NO]) {
#pragma unroll
    for (int o = 0; o < NO; ++o) { float s = 0.f;
#pragma unroll
        for (int j = 0; j < 4; ++j) { const f32x4 w = *(const LAS f32x4*)(WT + o * 1024 + 4 * F.lane + 256 * j); s += (h.v[j].x * w.x + h.v[j].y * w.y) + (h.v[j].z * w.z + h.v[j].w * w.w); }
        out[o] = s; if ((o & 3) == 3) __builtin_amdgcn_sched_barrier(0); }
#pragma unroll
    for (int o = 0; o < NO; ++o) { out[o] = wave_sum(out[o]); if ((o & 3) == 3) __builtin_amdgcn_sched_barrier(0); }
}
template <int NO> __device__ __forceinline__ void load_wt(Frame& F, const float* W, int ldw, int col0, LAS float* WT) {
    for (int k = F.tid; k < 1024; k += NWAVES * 64) {
        const GAS f32x4* p = (const GAS f32x4*)(W + (size_t)k * ldw + col0);
#pragma unroll
        for (int o4 = 0; o4 < NO / 4; ++o4) { const f32x4 v = p[o4]; WT[(4 * o4 + 0) * 1024 + k] = v.x; WT[(4 * o4 + 1) * 1024 + k] = v.y; WT[(4 * o4 + 2) * 1024 + k] = v.z; WT[(4 * o4 + 3) * 1024 + k] = v.w; }
    }
    __syncthreads();
}
__device__ __forceinline__ float softplusf_(float x) { return x > 20.f ? x : log1pf(__expf(x)); }
__device__ __forceinline__ void row_bd(Frame& F, const Row& h, const LAS float* W16T, int l, int row) {
    float o16[16]; row_dots<16>(F, h, W16T, o16);
    float mine = 0.f;
#pragma unroll
    for (int o = 0; o < 16; ++o) mine = (F.lane == o) ? o16[o] : mine;
    if (F.lane < 16) {
        float r;
        if (F.lane < 8) r = 1.f / (1.f + __expf(-mine));
        else { const int i = F.lane - 8; r = -__expf(F.in[I_DALOG][l * 8 + i]) * softplusf_(mine + F.in[I_DDTBIAS][l * 8 + i]); }
        ((float*)(F.ws + WS_BD))[(size_t)row * 16 + F.lane] = r;
    }
}
constexpr int ROW_A = 0, ROW_B = 1, ROW_C = 2;
template <int MODE> __device__ __forceinline__ void p_rows(Frame& F, const int l) {
    const int gw = F.vcu * NWAVES + F.wave, NGW = F.G * NWAVES;
    LAS float* WT = (LAS float*)(F.lds + RING_OFF);
    LAS int* linfo = (LAS int*)(F.lds + RING_OFF + 65536);
    LAS int* lcnt = (LAS int*)(F.lds + RING_OFF + 65536 + 8 * 32 * 16);
    const bool do_h1 = (MODE == ROW_A) || (MODE == ROW_C && l + 1 < NLAYER);
    const int lh = (MODE == ROW_C) ? l + 1 : l;
    const bool router = (MODE == ROW_B) && (l == 1);
    if (do_h1) load_wt<16>(F, F.in[I_WIN] + (size_t)lh * D * IN_COLS, IN_COLS, NPROJ, WT);
    if (router) { if (F.tid < 16) lcnt[F.tid] = 0; load_wt<8>(F, F.in[I_ROUTERW], NEXP, 0, WT); }
    int cnt[NEXP], tstart[NEXP + 1];
    if (MODE == ROW_C && l == 1) moe_tiles(F, cnt, tstart);
    const float* xsrc = (MODE == ROW_A || (MODE == ROW_B && l == 0)) ? F.in[I_X] : F.out;
    int ri = 0, cb = -1; ColVec cR, cA, cC;
    for (int m = gw; m < NTOK; m += NGW, ++ri) {
        const int b = m / SEQ;
        if (b != cb) { cb = b;
            if (MODE == ROW_B) { cv_resid(F, cR, F.in[I_NMIXPOST] + l * D, l, b, 2 * D); cv_h(F, cA, cC, F.in[I_NFFNPRE] + l * D, l, b, 3 * D, 4 * D); }
            if (MODE == ROW_C) cv_resid(F, cR, F.in[I_NFFNPOST] + l * D, l, b, 5 * D);
            if (do_h1) cv_h(F, cA, cC, F.in[I_NMIXPRE] + lh * D, lh, b, 0, 1 * D); }
        Row x; row_load_f32(F, x, xsrc + (size_t)m * D);
        if (MODE == ROW_B) {
            Row f; row_load_bf16(F, f, (const bf16*)(F.ws + WS_F) + (size_t)m * D);
            row_resid_cv(x, f, cR);
            row_store_f32(F, x, F.out + (size_t)m * D);
            Row h; row_make_h_cv(h, x, cA, cC);
            if (MOE_FP8 && l == 1) { GAS unsigned* o4 = (GAS unsigned*)(F.ws + WS_H2B + (size_t)m * D) + F.lane;
#pragma unroll
                for (int j = 0; j < 4; ++j) o4[64 * j] = pk4_fp8(h.v[j].x, h.v[j].y, h.v[j].z, h.v[j].w); }
            else row_store_bf16(F, h, (bf16*)(F.ws + (l == 0 ? WS_H : WS_H2B)) + (size_t)m * D);
            if (router) {
                float lg[NEXP]; row_dots<NEXP>(F, h, WT, lg);
                int e0 = 0; float l0 = lg[0] + F.in[I_ROUTERB][0];
#pragma unroll
                for (int e = 0; e < NEXP; ++e) lg[e] += F.in[I_ROUTERB][e];
#pragma unroll
                for (int e = 1; e < NEXP; ++e) if (lg[e] > l0) { l0 = lg[e]; e0 = e; }
                int e1 = -1; float l1 = -3.0e38f;
#pragma unroll
                for (int e = 0; e < NEXP; ++e) if (e != e0 && lg[e] > l1) { l1 = lg[e]; e1 = e; }
                const float q1 = __expf(l1 - l0), p0 = 1.f / (1.f + q1), p1 = q1 * p0;
                if (F.lane == 0) {
                    const int i0 = atomicAdd((int*)&lcnt[e0], 1), i1 = atomicAdd((int*)&lcnt[e1], 1);
                    LAS int* li = linfo + (F.wave * 32 + ri) * 4;
                    li[0] = e0 | (e1 << 8) | (i0 << 16); li[1] = i1; li[2] = __float_as_int(p0); li[3] = __float_as_int(p1);
                }
            }
        } else if (MODE == ROW_C) {
            Row f;
            if (l == 0) row_load_bf16(F, f, (const bf16*)(F.ws + WS_F) + (size_t)m * D);
            else {
                const int* ti = (const int*)(F.ws + WS_ROUTE) + (size_t)m * 8;
                const int e0 = ti[0], i0 = ti[1], e1 = ti[2], i1 = ti[3]; const float p0 = __int_as_float(ti[4]), p1 = __int_as_float(ti[5]);
                int s0 = 0, s1 = 0;
#pragma unroll
                for (int e = 0; e < NEXP; ++e) { s0 = (e == e0) ? tstart[e] * 256 + i0 : s0; s1 = (e == e1) ? tstart[e] * 256 + i1 : s1; }
                Row y0, y1; row_load_bf16(F, y0, (const bf16*)(F.ws + WS_Y) + (size_t)s0 * D); row_load_bf16(F, y1, (const bf16*)(F.ws + WS_Y) + (size_t)s1 * D);
#pragma unroll
                for (int j = 0; j < 4; ++j) f.v[j] = y0.v[j] * p0 + y1.v[j] * p1;
            }
            row_resid_cv(x, f, cR);
            row_store_f32(F, x, F.out + (size_t)m * D);
        }
        if (do_h1) {
            Row h; row_make_h_cv(h, x, cA, cC);
            row_store_bf16(F, h, (bf16*)(F.ws + WS_H) + (size_t)m * D);
            row_bd(F, h, WT, lh, m);
        }
    }
    if (router) {
        __syncthreads();
        if (F.tid < NEXP) lcnt[8 + F.tid] = (int)__hip_atomic_fetch_add(F.ctl + CW_MOECNT + 64 * F.tid, (unsigned)lcnt[F.tid], RLX_AGENT);
        __syncthreads();
        ri = 0;
        for (int m = gw; m < NTOK; m += NGW, ++ri) {
            if (F.lane == 0) {
                const LAS int* li = linfo + (F.wave * 32 + ri) * 4;
                const int w0 = li[0], e0 = w0 & 255, e1 = (w0 >> 8) & 255, i0 = (w0 >> 16) + lcnt[8 + e0], i1 = li[1] + lcnt[8 + e1];
                int* ti = (int*)(F.ws + WS_ROUTE) + (size_t)m * 8;
                ti[0] = e0; ti[1] = i0; ti[2] = e1; ti[3] = i1; ti[4] = li[2]; ti[5] = li[3];
                int* lists = (int*)(F.ws + WS_ROUTE + 1 * MiB);
                lists[(size_t)e0 * 65536 + i0] = m; lists[(size_t)e1 * 65536 + i1] = m;
            }
        }
    }
    __syncthreads();
}

namespace pg8 {
constexpr int NXCD = 8, WGM = 8;
struct SchedStd {
    int nM, nN, nwg, G, c; const char* A; size_t a_tile; const char* B; size_t b_tile;
    __device__ __forceinline__ void init(int nM_, int nN_, int G_, int c_, const void* A_, size_t a_tile_, const void* B_, size_t b_tile_) { nM = nM_; nN = nN_; nwg = nM * nN; G = G_; c = c_; A = (const char*)A_; a_tile = a_tile_; B = (const char*)B_; b_tile = b_tile_; }
    __device__ __forceinline__ bool next(int i, Unit& u) const {
        const long L = (long)i * G + c; if (L >= nwg) return false;
        int wgid = (int)L; { const int q = nwg / NXCD, r = nwg % NXCD, xcd = wgid % NXCD, off = wgid / NXCD; wgid = (xcd < r ? xcd * (q + 1) : r * (q + 1) + (xcd - r) * q) + off; }
        const int nig = WGM * nN, gid = wgid / nig, fm = gid * WGM, gsz = (nM - fm) < WGM ? (nM - fm) : WGM;
        u.pm = fm + ((wgid % nig) % gsz); u.pn = (wgid % nig) / gsz; u.aux = 0; u.nt = 0; u.a = A + (size_t)u.pm * a_tile; u.b = B + (size_t)u.pn * b_tile; u.rows = nullptr; return true;
    }
    __device__ __forceinline__ void a_ready(const Unit&) const {}
    __device__ __forceinline__ void done(const Unit&) const {}
};
struct SchedBranch {
    SchedStd s; const char* O4; const char* Wb;
    __device__ __forceinline__ bool next(int i, Unit& u) const {
        if (!s.next(i, u)) return false;
        const int br = u.pn >> 2; u.pn &= 3; u.aux = br;
        u.a = O4 + (size_t)u.pm * 256 * 1024 * 2 + (size_t)br * 256 * 2; u.b = Wb + (size_t)br * 1024 * 256 * 2 + (size_t)u.pn * 256 * 256 * 2; return true;
    }
    __device__ __forceinline__ void a_ready(const Unit&) const {}
    __device__ __forceinline__ void done(const Unit&) const {}
};
struct SchedGate {
    int vcu, G; const char* H; const char* Wm;
    __device__ __forceinline__ bool next(int i, Unit& u) const {
        const int tg = vcu + G * (i >> 2); if (tg >= 512) return false;
        u.pm = tg >> 2; u.pn = tg & 3; u.aux = i & 3; u.nt = 0; u.rows = nullptr;
        u.a = H + (size_t)u.pm * 256 * 1024 * 2; u.b = Wm + ((size_t)u.aux * 1024 + (size_t)u.pn * 256) * 1024 * 2; return true;
    }
    __device__ __forceinline__ void a_ready(const Unit&) const {}
    __device__ __forceinline__ void done(const Unit&) const {}
};
struct SchedMoe {
    int c, G, t0, t1, nN; int tstart[9]; int cnt[8];
    const char* A; const int* lists; const char* W; size_t w_tile; bool gather; size_t exp_stride, act_tile;
    __device__ __forceinline__ bool next(int i, Unit& u) const {
        const long L = (long)i * G + c; const int t = t0 + (int)(L / nN); if (t >= t1) return false;
        int e = 0;
#pragma unroll
        for (int k = 1; k < 8; ++k) e = (t >= tstart[k]) ? k : e;
        int ce = 0;
#pragma unroll
        for (int k = 0; k < 8; ++k) ce = (k == e) ? cnt[k] : ce;
        const int j = t - ((e == 0) ? 0 : 0), jj = t;
        (void)j; (void)jj;
        int ts = 0;
#pragma unroll
        for (int k = 0; k < 8; ++k) ts = (k == e) ? tstart[k] : ts;
        const int tj = t - ts;
        u.pn = (int)(L % nN); u.nt = 0;
        if (gather) { u.pm = t - t0; u.a = A; u.rows = lists + (size_t)e * 65536 + tj * 256; const int nv = ce - tj * 256; u.aux = nv > 256 ? 256 : nv; }
        else { u.pm = t; u.a = A + (size_t)(t - t0) * act_tile; u.rows = nullptr; u.aux = 0; }
        u.b = W + (size_t)e * exp_stride + (size_t)u.pn * w_tile; return true;
    }
    static constexpr size_t DFF_ = 2816; static constexpr size_t SZ_EXP_ = (size_t)2 * 2816 * 1024 * 2 + (size_t)1024 * 2816 * 2;
    __device__ __forceinline__ void a_ready(const Unit&) const {}
    __device__ __forceinline__ void done(const Unit&) const {}
};

struct EpiStore {
    static constexpr bool PERM = true;
    bf16_t* O; int ldc; size_t aux_stride; float scale0;
    __device__ __forceinline__ void operator()(const f32x4 (&acc)[2][2][4][2], const Unit& u, int wr, int wc, int fr, int fq) const {
        const int row0 = u.pm * BM + wr * 64 + fr, col0 = u.pn * BM + wc * 32 + 8 * fq; bf16_t* base = O + (size_t)u.aux * aux_stride;
        const float sc = scale0;
#pragma unroll
        for (int ai = 0; ai < 2; ++ai)
#pragma unroll
            for (int m = 0; m < 4; ++m) { bf16_t* rowp = base + (size_t)(row0 + ai * HALF + m * 16) * ldc + col0;
#pragma unroll
                for (int bj = 0; bj < 2; ++bj) { const f32x4 v0 = acc[ai][bj][m][0] * sc, v1 = acc[ai][bj][m][1] * sc;
                    u32x4 w; w.x = cvt_pk_bf16(v0[0], v0[1]); w.y = cvt_pk_bf16(v0[2], v0[3]); w.z = cvt_pk_bf16(v1[0], v1[1]); w.w = cvt_pk_bf16(v1[2], v1[3]);
                    *(u32x4*)(rowp + bj * HALF) = w; } }
    }
};

struct EpiStore64 {
    static constexpr bool PERM = true;
    bf16_t* O;
    __device__ __forceinline__ void operator()(const f32x4 (&acc)[2][2][4][2], const Unit& u, int wr, int wc, int fr, int fq) const {
        int fr_ = fr, fq_ = fq; asm volatile("" : "+v"(fr_), "+v"(fq_));
        bf16_t* base = O + (size_t)(u.pm * BM + wr * 64 + fr_) * 1024 + u.pn * BM + wc * 32 + 8 * fq_;
#pragma unroll
        for (int ai = 0; ai < 2; ++ai)
#pragma unroll
            for (int m = 0; m < 4; ++m) {
#pragma unroll
                for (int bj = 0; bj < 2; ++bj) { const f32x4 v0 = acc[ai][bj][m][0] * (1.f / 64.f), v1 = acc[ai][bj][m][1] * (1.f / 64.f);
                    u32x4 w; w.x = cvt_pk_bf16(v0[0], v0[1]); w.y = cvt_pk_bf16(v0[2], v0[3]); w.z = cvt_pk_bf16(v1[0], v1[1]); w.w = cvt_pk_bf16(v1[2], v1[3]);
                    *(u32x4*)(base + (ai * HALF + m * 16) * 1024 + bj * HALF) = w; }
                __builtin_amdgcn_sched_barrier(0); }
    }
};
struct EpiProj {
    static constexpr bool PERM = true;
    static constexpr int TILE_E = 9728;
    bf16_t* Qb; bf16_t* KV; bf16_t* Pj; unsigned* nmax; float qscale;
    __device__ __forceinline__ void operator()(const f32x4 (&acc)[2][2][4][2], const Unit& u, int wr, int wc, int fr, int fq) const {
        const int t0 = u.pm * BM + wr * 64 + fr;
        const int b = (u.pm * BM) >> 14;
        const int s00 = t0 & 16383;
        if (u.pn >= 3) {
            bf16_t* base = Pj + (size_t)t0 * 2048 + (u.pn - 3) * BM + wc * 32 + 8 * fq;
#pragma unroll
            for (int ai = 0; ai < 2; ++ai)
#pragma unroll
                for (int m = 0; m < 4; ++m) {
#pragma unroll
                    for (int bj = 0; bj < 2; ++bj) { const f32x4 v0 = acc[ai][bj][m][0], v1 = acc[ai][bj][m][1];
                        u32x4 w; w.x = cvt_pk_bf16(v0[0], v0[1]); w.y = cvt_pk_bf16(v0[2], v0[3]); w.z = cvt_pk_bf16(v1[0], v1[1]); w.w = cvt_pk_bf16(v1[2], v1[3]);
                        *(u32x4*)(base + (ai * HALF + m * 16) * 2048 + bj * HALF) = w; }
                    __builtin_amdgcn_sched_barrier(0); }
        } else if (u.pn == 2) {
            bf16_t* hb = KV + ((size_t)((b * 4 + (wc >> 1)) * 256 + (s00 >> 6))) * TILE_E + 5120 + (32 * (wc & 1) + 8 * fq) * 72 + (s00 & 63);
#pragma unroll
            for (int ai = 0; ai < 2; ++ai)
#pragma unroll
                for (int bj = 0; bj < 2; ++bj) { bf16_t* tb = hb + (size_t)bj * (2 * 256 * TILE_E) + ai * (2 * TILE_E);
#pragma unroll
                    for (int m = 0; m < 4; ++m)
#pragma unroll
                        for (int n = 0; n < 2; ++n)
#pragma unroll
                            for (int j = 0; j < 4; ++j) { const float v = acc[ai][bj][m][n][j];
                                unsigned bits = __builtin_bit_cast(unsigned, v); bits = (bits + 0x7fffu + ((bits >> 16) & 1u)) >> 16;
                                tb[(4 * n + j) * 72 + 16 * m] = (bf16_t)bits; }
                    __builtin_amdgcn_sched_barrier(0); }
        } else {
            const float sc = (u.pn == 0) ? qscale : 1.f; float nm = 0.f;
            bf16_t* qbase = Qb + ((size_t)(b * 4 + wc) * 16384 + s00) * 64 + 8 * fq;
            bf16_t* kbase = KV + ((size_t)((b * 4 + wc) * 256 + (s00 >> 6))) * TILE_E + (s00 & 63) * 40 + 8 * fq;
#pragma unroll
            for (int ai = 0; ai < 2; ++ai)
#pragma unroll
                for (int m = 0; m < 4; ++m) {
#pragma unroll
                    for (int bj = 0; bj < 2; ++bj) { const f32x4 v0 = acc[ai][bj][m][0] * sc, v1 = acc[ai][bj][m][1] * sc;
                        u32x4 w; w.x = cvt_pk_bf16(v0[0], v0[1]); w.y = cvt_pk_bf16(v0[2], v0[3]); w.z = cvt_pk_bf16(v1[0], v1[1]); w.w = cvt_pk_bf16(v1[2], v1[3]);
                        float ss = (v0[0] * v0[0] + v0[1] * v0[1]) + (v0[2] * v0[2] + v0[3] * v0[3]) + (v1[0] * v1[0] + v1[1] * v1[1]) + (v1[2] * v1[2] + v1[3] * v1[3]);
                        ss += __shfl_xor(ss, 16); ss += __shfl_xor(ss, 32); nm = fmaxf(nm, ss);
                        if (u.pn == 0) *(u32x4*)(qbase + (ai * HALF + m * 16) * 64 + 32 * bj) = w;
                        else *(u32x4*)(kbase + ai * (2 * TILE_E) + bj * 2560 + (16 * m) * 40) = w; }
                    __builtin_amdgcn_sched_barrier(0); }
            nm = fmaxf(nm, __shfl_xor(nm, 1)); nm = fmaxf(nm, __shfl_xor(nm, 2)); nm = fmaxf(nm, __shfl_xor(nm, 4)); nm = fmaxf(nm, __shfl_xor(nm, 8));
            if (fr == 0 && fq == 0) atomicMax(nmax + (b * 4 + wc) * 2 + u.pn, __builtin_bit_cast(unsigned, nm));
        }
    }
};
__device__ __forceinline__ float sigm(float x) { return __builtin_amdgcn_rcpf(1.f + __builtin_amdgcn_exp2f(-1.4426950408889634f * x)); }
struct EpiGate {
    static constexpr bool PERM = true;
    const bf16_t* P; bf16_t* Mg; const float* bias;
    __device__ __forceinline__ void operator()(const f32x4 (&acc)[2][2][4][2], const Unit& u, int wr, int wc, int fr, int fq) const {
        const int row0 = u.pm * BM + wr * 64 + fr, col0 = u.pn * BM + wc * 32 + 8 * fq; const int br = u.aux;
        const bf16_t* Pb = P + (size_t)br * 32768 * 1024; const float* bb = bias + br * 1024 + col0;
        f32x4 bv[2][2];
#pragma unroll
        for (int bj = 0; bj < 2; ++bj)
#pragma unroll
            for (int n = 0; n < 2; ++n) bv[bj][n] = *(const f32x4*)(bb + bj * HALF + 4 * n);
#pragma unroll
        for (int ai = 0; ai < 2; ++ai)
#pragma unroll
            for (int m = 0; m < 4; ++m) { const size_t ro = (size_t)(row0 + ai * HALF + m * 16) * 1024 + col0;
#pragma unroll
                for (int bj = 0; bj < 2; ++bj) {
                    const u32x4 pw = *(const u32x4*)(Pb + ro + bj * HALF);
                    u32x4 mw = {0u, 0u, 0u, 0u}; if (br != 0) mw = *(const u32x4*)(Mg + ro + bj * HALF);
                    float o[8];
#pragma unroll
                    for (int q = 0; q < 4; ++q) {
                        const float g0 = sigm(acc[ai][bj][m][q >> 1][(q & 1) * 2] + bv[bj][q >> 1][(q & 1) * 2]), g1 = sigm(acc[ai][bj][m][q >> 1][(q & 1) * 2 + 1] + bv[bj][q >> 1][(q & 1) * 2 + 1]);
                        o[2 * q] = g0 * __builtin_bit_cast(float, pw[q] << 16) + __builtin_bit_cast(float, mw[q] << 16);
                        o[2 * q + 1] = g1 * __builtin_bit_cast(float, pw[q] & 0xffff0000u) + __builtin_bit_cast(float, mw[q] & 0xffff0000u);
                    }
                    u32x4 w; w.x = cvt_pk_bf16(o[0], o[1]); w.y = cvt_pk_bf16(o[2], o[3]); w.z = cvt_pk_bf16(o[4], o[5]); w.w = cvt_pk_bf16(o[6], o[7]);
                    *(u32x4*)(Mg + ro + bj * HALF) = w; } }
    }
};
struct SchedGateP {
    int vcu, G; const char* ws; size_t oH, oWm, oO4, oWb4;
    __device__ __forceinline__ bool next(int i, Unit& u) const {
        const int tg = vcu + G * (i >> 3); if (tg >= 512) return false;
        const int br = (i >> 1) & 3, isg = i & 1;
        u.pm = tg >> 2; u.pn = tg & 3; u.rows = nullptr;
        if (isg) { u.aux = br; u.nt = 16; u.a = ws + oH + (size_t)u.pm * 256 * 1024 * 2; u.b = ws + oWm + ((size_t)br * 1024 + (size_t)u.pn * 256) * 1024 * 2; }
        else { u.aux = br | 4; u.nt = 4; u.a = ws + oO4 + (size_t)u.pm * 256 * 1024 * 2 + br * 512; u.b = ws + oWb4 + (size_t)u.pn * 256 * 1024 * 2 + br * 512; }
        return true;
    }
    __device__ __forceinline__ void a_ready(const Unit&) const {}
    __device__ __forceinline__ void done(const Unit&) const {}
};
struct EpiGateP {
    static constexpr bool PERM = true;
    bf16_t* Pscr; bf16_t* Mg; const float* bias; int tid;
    __device__ __forceinline__ void operator()(const f32x4 (&acc)[2][2][4][2], const Unit& u, int wr, int wc, int fr, int fq) const {
        u32x4* ps = (u32x4*)Pscr + tid;
        if (u.aux & 4) {
#pragma unroll
            for (int ai = 0; ai < 2; ++ai)
#pragma unroll
                for (int m = 0; m < 4; ++m)
#pragma unroll
                    for (int bj = 0; bj < 2; ++bj) { const f32x4 v0 = acc[ai][bj][m][0], v1 = acc[ai][bj][m][1];
                        u32x4 w; w.x = cvt_pk_bf16(v0[0], v0[1]); w.y = cvt_pk_bf16(v0[2], v0[3]); w.z = cvt_pk_bf16(v1[0], v1[1]); w.w = cvt_pk_bf16(v1[2], v1[3]);
                        ps[((ai * 4 + m) * 2 + bj) * 512] = w; }
            return;
        }
        int fr_ = fr, fq_ = fq; asm volatile("" : "+v"(fr_), "+v"(fq_));
        const int row0 = u.pm * BM + wr * 64 + fr_, col0 = u.pn * BM + wc * 32 + 8 * fq_; const int br = u.aux;
        const float* bb = bias + br * 1024 + col0;
#pragma unroll
        for (int ai = 0; ai < 2; ++ai)
#pragma unroll
            for (int m = 0; m < 4; ++m) { const size_t ro = (size_t)(row0 + ai * HALF + m * 16) * 1024 + col0;
#pragma unroll
                for (int bj = 0; bj < 2; ++bj) {
                    const f32x4 b0 = *(const f32x4*)(bb + bj * HALF), b1 = *(const f32x4*)(bb + bj * HALF + 4);
                    const u32x4 pw = ps[((ai * 4 + m) * 2 + bj) * 512];
                    u32x4 mw = {0u, 0u, 0u, 0u}; if (br != 0) mw = *(const u32x4*)(Mg + ro + bj * HALF);
                    const f32x4 a0 = acc[ai][bj][m][0] + b0, a1 = acc[ai][bj][m][1] + b1;
                    float o[8];
                    o[0] = sigm(a0[0]) * __builtin_bit_cast(float, pw[0] << 16) + __builtin_bit_cast(float, mw[0] << 16);
                    o[1] = sigm(a0[1]) * __builtin_bit_cast(float, pw[0] & 0xffff0000u) + __builtin_bit_cast(float, mw[0] & 0xffff0000u);
                    o[2] = sigm(a0[2]) * __builtin_bit_cast(float, pw[1] << 16) + __builtin_bit_cast(float, mw[1] << 16);
                    o[3] = sigm(a0[3]) * __builtin_bit_cast(float, pw[1] & 0xffff0000u) + __builtin_bit_cast(float, mw[1] & 0xffff0000u);
                    o[4] = sigm(a1[0]) * __builtin_bit_cast(float, pw[2] << 16) + __builtin_bit_cast(float, mw[2] << 16);
                    o[5] = sigm(a1[1]) * __builtin_bit_cast(float, pw[2] & 0xffff0000u) + __builtin_bit_cast(float, mw[2] & 0xffff0000u);
                    o[6] = sigm(a1[2]) * __builtin_bit_cast(float, pw[3] << 16) + __builtin_bit_cast(float, mw[3] << 16);
                    o[7] = sigm(a1[3]) * __builtin_bit_cast(float, pw[3] & 0xffff0000u) + __builtin_bit_cast(float, mw[3] & 0xffff0000u);
                    u32x4 w; w.x = cvt_pk_bf16(o[0], o[1]); w.y = cvt_pk_bf16(o[2], o[3]); w.z = cvt_pk_bf16(o[4], o[5]); w.w = cvt_pk_bf16(o[6], o[7]);
                    *(u32x4*)(Mg + ro + bj * HALF) = w;
                    __builtin_amdgcn_sched_barrier(0); } }
    }
};
template <bool F8 = false> struct EpiSwiGLU {
    static constexpr bool PERM = true;
    bf16_t* O; int ldc;
    __device__ __forceinline__ void operator()(const f32x4 (&acc)[2][2][4][2], const Unit& u, int wr, int wc, int fr, int fq) const {
        const int row0 = u.pm * BM + wr * 64 + fr, col0 = u.pn * HALF + wc * 32 + 8 * fq;
#pragma unroll
        for (int ai = 0; ai < 2; ++ai)
#pragma unroll
            for (int m = 0; m < 4; ++m) {
                float o[8]; constexpr float isc = F8 ? (1.f / 64.f) : 1.f;
#pragma unroll
                for (int n = 0; n < 2; ++n)
#pragma unroll
                    for (int q = 0; q < 4; ++q) { const float g = acc[ai][0][m][n][q] * isc, up = acc[ai][1][m][n][q] * isc; o[4 * n + q] = g * sigm(g) * up; }
                if constexpr (F8) { int w0 = __builtin_amdgcn_cvt_pk_fp8_f32(o[0], o[1], 0, false); w0 = __builtin_amdgcn_cvt_pk_fp8_f32(o[2], o[3], w0, true);
                    int w1 = __builtin_amdgcn_cvt_pk_fp8_f32(o[4], o[5], 0, false); w1 = __builtin_amdgcn_cvt_pk_fp8_f32(o[6], o[7], w1, true);
                    u32x2 w = {(unsigned)w0, (unsigned)w1}; *(u32x2*)((unsigned char*)O + (size_t)(row0 + ai * HALF + m * 16) * ldc + col0) = w; }
                else { bf16_t* rowp = O + (size_t)(row0 + ai * HALF + m * 16) * ldc + col0;
                    u32x4 w; w.x = cvt_pk_bf16(o[0], o[1]); w.y = cvt_pk_bf16(o[2], o[3]); w.z = cvt_pk_bf16(o[4], o[5]); w.w = cvt_pk_bf16(o[6], o[7]);
                    *(u32x4*)rowp = w; } }
    }
};
}

namespace att {
#ifndef ATT_T
#define ATT_T 40.f
#endif
#ifndef ATT_PRIO
#define ATT_PRIO 1
#endif
#ifndef ATT_ILV
#define ATT_ILV 10
#endif
#ifndef ATT_THR
#define ATT_THR 60.f
#endif
constexpr int SLOT = 19456, NSLOT = 6;
constexpr int ATTN_LDS = NSLOT * SLOT;
__device__ __forceinline__ unsigned cvtpk(float lo, float hi) { typedef float f2 __attribute__((ext_vector_type(2))); typedef __bf16 b2 __attribute__((ext_vector_type(2))); f2 v = {lo, hi}; b2 b = __builtin_convertvector(v, b2); return __builtin_bit_cast(unsigned, b); }
#define ATT_WAITV(n) asm volatile("s_waitcnt vmcnt(" #n ")" ::: "memory")
__device__ __forceinline__ float max3f(float a, float b, float c) { float r; asm("v_max3_f32 %0, %1, %2, %3" : "=v"(r) : "v"(a), "v"(b), "v"(c)); return r; }

#define ATT_SOFTMAX(s0, s1, pw, LS) do { \
    if (!nomax) { \
    asm volatile("s_nop 15\n\ts_nop 7" : "+v"(s0), "+v"(s1)); \
    float rm = max3f(s0[0], s0[1], s1[0]), rm2 = max3f(s0[2], s0[3], s1[1]); rm = max3f(rm, s1[2], s1[3]); \
    _Pragma("unroll") for (int r = 4; r < 16; r += 4) { rm = max3f(rm, s0[r], s0[r + 1]); rm2 = max3f(rm2, s0[r + 2], s0[r + 3]); rm = max3f(rm, s1[r], s1[r + 1]); rm2 = max3f(rm2, s1[r + 2], s1[r + 3]); } \
    rm = fmaxf(rm, rm2); \
    { auto rr = __builtin_amdgcn_permlane32_swap(__builtin_bit_cast(unsigned, rm), __builtin_bit_cast(unsigned, rm), false, false); rm = fmaxf(__builtin_bit_cast(float, rr[0]), __builtin_bit_cast(float, rr[1])); } \
    if (__any(rm > ATT_THR)) { \
        const float dd = fmaxf(rm, 0.f); R += dd; \
        const float f = fast_exp2(-dd); l1 *= f; l2 *= f; \
        _Pragma("unroll") for (int r = 0; r < 16; ++r) { s0[r] -= dd; s1[r] -= dd; c0[r] -= dd; c1[r] -= dd; O1[0][r] *= f; O1[1][r] *= f; O2[0][r] *= f; O2[1][r] *= f; } \
        p1scale = f; \
    } } \
    { float sa_ = 0.f, sb_ = 0.f; _Pragma("unroll") for (int r = 0; r < 16; ++r) { s0[r] = fast_exp2(s0[r]); s1[r] = fast_exp2(s1[r]); sa_ += s0[r]; sb_ += s1[r]; } LS += sa_ + sb_; } \
    _Pragma("unroll") for (int e = 0; e < 4; ++e) { pw[0][e] = cvtpk(s0[2 * e], s0[2 * e + 1]); pw[1][e] = cvtpk(s0[8 + 2 * e], s0[8 + 2 * e + 1]); pw[2][e] = cvtpk(s1[2 * e], s1[2 * e + 1]); pw[3][e] = cvtpk(s1[8 + 2 * e], s1[8 + 2 * e + 1]); } \
} while (0)

#define ATT_EXPPACK(s0, s1, pw, LS) do { \
    { float sa_ = 0.f, sb_ = 0.f; _Pragma("unroll") for (int r = 0; r < 16; ++r) { s0[r] = fast_exp2(s0[r]); s1[r] = fast_exp2(s1[r]); sa_ += s0[r]; sb_ += s1[r]; } LS += sa_ + sb_; } \
    _Pragma("unroll") for (int e = 0; e < 4; ++e) { pw[0][e] = cvtpk(s0[2 * e], s0[2 * e + 1]); pw[1][e] = cvtpk(s0[8 + 2 * e], s0[8 + 2 * e + 1]); pw[2][e] = cvtpk(s1[2 * e], s1[2 * e + 1]); pw[3][e] = cvtpk(s1[8 + 2 * e], s1[8 + 2 * e + 1]); } \
} while (0)
__device__ __forceinline__ void attn_unit(Frame& F, const int layer, const int b, const int h, const int qb) {
    const int lane = F.lane, r32 = lane & 31, hi = lane >> 5, wid = F.wave;
    LAS unsigned char* L = F.lds + RING_OFF;
    const int qw0 = qb * 256 + wid * 32, q = qw0 + r32;
    const float slope2 = exp2f(-2.f * (float)(h + 1)) * 1.4426950408889634f;
    int tlo, thi; float knb;
    { const unsigned* nm = (const unsigned*)(F.ctl + CW_NMAX) + layer * 16 + (b * 4 + h) * 2;
      const float qn = sqrtf(__builtin_bit_cast(float, __hip_atomic_load(nm, RLX_AGENT))) * 1.01f, kn = sqrtf(__builtin_bit_cast(float, __hip_atomic_load(nm + 1, RLX_AGENT))) * 1.01f;
      knb = kn;
      const float wf = (ATT_T + 2.f * qn * kn) / slope2; const int W = wf > 100000.f ? 100000 : (int)wf + 1;
      const int lo = qb * 256 - W, hi_ = qb * 256 + 255 + W; tlo = lo < 0 ? 0 : (lo >> 6); thi = hi_ >= SEQ ? (SEQ / 64 - 1) : (hi_ >> 6);
      if (((thi - tlo + 1) & 1) != 0) { if (thi < SEQ / 64 - 1) ++thi; else --tlo; } }
    const int nP = (thi - tlo + 1) >> 1;
    const bf16* Qp = (const bf16*)(F.ws + WS_QB) + ((size_t)(b * 4 + h) * SEQ + q) * 64;
    const __amdgpu_buffer_rsrc_t kvr = __builtin_amdgcn_make_buffer_rsrc((void*)pg8::uniform_ptr((const char*)(F.ws + WS_KV + ((size_t)(b * 4 + h) * 256) * SLOT)), 0, 0x7fffffff, 0x00020000);
    const unsigned kvlo = (unsigned)lane * 16u;
    const bool w3 = wid < 3;
#define ATT_DMA1(t, slot) do { const int so_ = (t) * SLOT + wid * 1024; LAS unsigned char* d_ = L + (slot) * SLOT + wid * 1024; \
        __builtin_amdgcn_raw_ptr_buffer_load_lds(kvr, (LAS unsigned*)d_, 16, kvlo, so_, 0, 0); __builtin_amdgcn_raw_ptr_buffer_load_lds(kvr, (LAS unsigned*)(d_ + 8192), 16, kvlo, so_ + 8192, 0, 0); \
        if (w3) __builtin_amdgcn_raw_ptr_buffer_load_lds(kvr, (LAS unsigned*)(d_ + 16384), 16, kvlo, so_ + 16384, 0, 0); } while (0)
#define ATT_DMA2(pr, ps) do { ATT_DMA1(tlo + 2 * (pr), 2 * (ps)); ATT_DMA1(tlo + 2 * (pr) + 1, 2 * (ps) + 1); } while (0)
    LAS unsigned char* QS = L + NSLOT * SLOT + wid * 4096 + lane * 16;
    float qkb;
    {
    bf16x8 q1f[2], q2f[2];
#pragma unroll
    for (int ks = 0; ks < 2; ++ks) { q1f[ks] = *(const GAS bf16x8*)(Qp + 16 * ks + 8 * hi); q2f[ks] = *(const GAS bf16x8*)(Qp + 32 + 16 * ks + 8 * hi); }
    asm volatile("s_waitcnt vmcnt(0)" ::: "memory");
    { float n1 = 0.f, n2 = 0.f;
#pragma unroll
      for (int ks = 0; ks < 2; ++ks) { const v4u a = __builtin_bit_cast(v4u, q1f[ks]), c = __builtin_bit_cast(v4u, q2f[ks]);
#pragma unroll
          for (int e = 0; e < 4; ++e) { n1 += bflo(a[e]) * bflo(a[e]) + bfhi(a[e]) * bfhi(a[e]); n2 += bflo(c[e]) * bflo(c[e]) + bfhi(c[e]) * bfhi(c[e]); } }
      n1 += LANE_XOR_F(lane, n1, 32); n2 += LANE_XOR_F(lane, n2, 32);
      qkb = sqrtf(fmaxf(n1, n2)) * 1.01f * knb; }
    *(LAS bf16x8*)(QS) = q1f[0]; *(LAS bf16x8*)(QS + 1024) = q1f[1]; *(LAS bf16x8*)(QS + 2048) = q2f[0]; *(LAS bf16x8*)(QS + 3072) = q2f[1];
    }
    ATT_DMA2(0, 0);
    if (nP > 1) ATT_DMA2(1, 1);
    float R = 0.f, l1 = 0.f, l2 = 0.f;
    f32x16 O1[2], O2[2];
#pragma unroll
    for (int i = 0; i < 16; ++i) { O1[0][i] = 0.f; O1[1][i] = 0.f; O2[0][i] = 0.f; O2[1][i] = 0.f; }
    const int pr32 = (r32 & 0x13) | ((r32 & 4) << 1) | ((r32 & 8) >> 1);
    const int kfo = pr32 * 80 + hi * 16;
    const int vfo = 10240 + r32 * 144 + hi * 16;
    bf16x8 Ab0; unsigned ab1d1, ab1d2;
#define ATT_MAKE_AB() do { int ln_ = fresh_lane(); asm volatile("" : "+v"(ln_)); const int r_ = ln_ & 31, p_ = (r_ & 0x13) | ((r_ & 4) << 1) | ((r_ & 8) >> 1); const unsigned lm = (ln_ >> 5) ? 0u : 0xffffffffu; \
      const unsigned j0 = __builtin_bit_cast(unsigned, (float)p_) >> 16, j1 = __builtin_bit_cast(unsigned, (float)(p_ + 32)) >> 16; \
      const v4u a0 = {0x3F803F80u & lm, (0x3F80u | (j0 << 16)) & lm, j0 & lm, 0u}; \
      Ab0 = __builtin_bit_cast(bf16x8, a0); ab1d1 = (0x3F80u | (j1 << 16)) & lm; ab1d2 = j1 & lm; } while (0)
    unsigned sd1p, sd2p;
    { const unsigned sb = __builtin_bit_cast(unsigned, slope2), sh = sb & 0xffff0000u; const float sl = slope2 - __builtin_bit_cast(float, sh);
      sd1p = sh; sd2p = __builtin_bit_cast(unsigned, sl) >> 16; }
    const unsigned sd1n = sd1p | 0x80000000u, sd2n = sd2p | 0x8000u;
#if ATT_PRIO
    if (wid >= 4) __builtin_amdgcn_s_setprio(ATT_PRIO);
#endif
    int ps = 0;
    int pA, pB;
    { const int tLend = (qw0 >> 6) - 1, tRbeg = ((qw0 + 31) >> 6) + 1;
      const int nl = tLend - tlo + 1; pA = nl > 0 ? (nl >> 1) : 0; pA = pA > nP ? nP : pA;
      const int d = tRbeg - tlo; pB = d > 0 ? ((d + 1) >> 1) : 0; pB = pB > nP ? nP : pB; pB = pB < pA ? pA : pB;
      if (__any(qkb > ATT_THR)) { pA = 0; pB = nP; } }
#define ATT_PAIR_HEAD(ip) do { \
        if ((ip) + 1 < nP) { if (w3) ATT_WAITV(6); else ATT_WAITV(4); } else ATT_WAITV(0); \
        __builtin_amdgcn_s_barrier(); \
        asm volatile("" ::: "memory"); \
        if ((ip) + 2 < nP) { const int s2 = ps >= 1 ? ps - 1 : 2; ATT_DMA2((ip) + 2, s2); } } while (0)
#define ATT_FAST_TILE(t, Bf, LEFT) do { \
        const bf16x8 ka00 = *(const LAS bf16x8*)((Bf) + kfo), ka01 = *(const LAS bf16x8*)((Bf) + kfo + 32), ka10 = *(const LAS bf16x8*)((Bf) + 32 * 80 + kfo), ka11 = *(const LAS bf16x8*)((Bf) + 32 * 80 + kfo + 32); \
        const bf16x8 q1a = *(const LAS bf16x8*)(QS), q1b = *(const LAS bf16x8*)(QS + 1024); \
        const float dq = (float)(q - (t) * 64); \
        const float tl = (LEFT) ? __builtin_fmaf(-slope2, dq, -R) : __builtin_fmaf(slope2, dq, -R); \
        const unsigned u0 = __builtin_bit_cast(unsigned, tl), hb = u0 & 0xffff0000u; \
        const float r1 = __builtin_bit_cast(float, u0) - __builtin_bit_cast(float, hb); \
        const unsigned mb = __builtin_bit_cast(unsigned, r1) & 0xffff0000u; \
        const float r2 = r1 - __builtin_bit_cast(float, mb); \
        const v4u bbv = {__builtin_amdgcn_perm(mb, hb, 0x07060302u), __builtin_amdgcn_perm((LEFT) ? sd1p : sd1n, __builtin_bit_cast(unsigned, r2), 0x07060302u), (LEFT) ? sd2p : sd2n, 0u}; \
        const bf16x8 Bb = __builtin_bit_cast(bf16x8, bbv); \
        const v4u ab1v = {__builtin_bit_cast(v4u, Ab0)[0], ab1d1, ab1d2, 0u}; const bf16x8 Ab1 = __builtin_bit_cast(bf16x8, ab1v); \
        f32x16 z16; _Pragma("unroll") for (int r = 0; r < 16; ++r) z16[r] = 0.f; \
        v4u pw1[4], pw2[4]; \
        f32x16 sa0 = __builtin_amdgcn_mfma_f32_32x32x16_bf16(Ab0, Bb, z16, 0, 0, 0), sa1 = __builtin_amdgcn_mfma_f32_32x32x16_bf16(Ab1, Bb, z16, 0, 0, 0); \
        sa0 = __builtin_amdgcn_mfma_f32_32x32x16_bf16(ka00, q1a, sa0, 0, 0, 0); sa1 = __builtin_amdgcn_mfma_f32_32x32x16_bf16(ka10, q1a, sa1, 0, 0, 0); \
        sa0 = __builtin_amdgcn_mfma_f32_32x32x16_bf16(ka01, q1b, sa0, 0, 0, 0); sa1 = __builtin_amdgcn_mfma_f32_32x32x16_bf16(ka11, q1b, sa1, 0, 0, 0); \
        __builtin_amdgcn_sched_barrier(0); \
        const bf16x8 kb00 = *(const LAS bf16x8*)((Bf) + 5120 + kfo), kb01 = *(const LAS bf16x8*)((Bf) + 5120 + kfo + 32), kb10 = *(const LAS bf16x8*)((Bf) + 5120 + 32 * 80 + kfo), kb11 = *(const LAS bf16x8*)((Bf) + 5120 + 32 * 80 + kfo + 32); \
        const bf16x8 q2a = *(const LAS bf16x8*)(QS + 2048), q2b = *(const LAS bf16x8*)(QS + 3072); \
        ATT_EXPPACK(sa0, sa1, pw1, l1); \
        __builtin_amdgcn_sched_barrier(0); \
        f32x16 sb0 = __builtin_amdgcn_mfma_f32_32x32x16_bf16(Ab0, Bb, z16, 0, 0, 0), sb1 = __builtin_amdgcn_mfma_f32_32x32x16_bf16(Ab1, Bb, z16, 0, 0, 0); \
        sb0 = __builtin_amdgcn_mfma_f32_32x32x16_bf16(kb00, q2a, sb0, 0, 0, 0); sb1 = __builtin_amdgcn_mfma_f32_32x32x16_bf16(kb10, q2a, sb1, 0, 0, 0); \
        sb0 = __builtin_amdgcn_mfma_f32_32x32x16_bf16(kb01, q2b, sb0, 0, 0, 0); sb1 = __builtin_amdgcn_mfma_f32_32x32x16_bf16(kb11, q2b, sb1, 0, 0, 0); \
        bf16x8 vf[2][4]; \
        _Pragma("unroll") for (int db = 0; db < 2; ++db) _Pragma("unroll") for (int ks = 0; ks < 4; ++ks) vf[db][ks] = *(const LAS bf16x8*)((Bf) + vfo + db * 32 * 144 + ks * 32); \
        __builtin_amdgcn_sched_barrier(0); \
          \
        _Pragma("unroll") for (int db = 0; db < 2; ++db) _Pragma("unroll") for (int ks = 0; ks < 4; ++ks) O1[db] = __builtin_amdgcn_mfma_f32_32x32x16_bf16(vf[db][ks], __builtin_bit_cast(bf16x8, pw1[ks]), O1[db], 0, 0, 0); \
        ATT_EXPPACK(sb0, sb1, pw2, l2); \
        _Pragma("unroll") for (int g_ = 0; g_ < 8; ++g_) { __builtin_amdgcn_sched_group_barrier(0x008, 1, 0); __builtin_amdgcn_sched_group_barrier(0x002, ATT_ILV, 0); } \
        __builtin_amdgcn_sched_barrier(0); \
        _Pragma("unroll") for (int db = 0; db < 2; ++db) _Pragma("unroll") for (int ks = 0; ks < 4; ++ks) O2[db] = __builtin_amdgcn_mfma_f32_32x32x16_bf16(vf[db][ks], __builtin_bit_cast(bf16x8, pw2[ks]), O2[db], 0, 0, 0); \
        __builtin_amdgcn_sched_barrier(0); } while (0)
    int ip = 0;
    ATT_MAKE_AB();
#pragma unroll 1
    for (; ip < pA; ++ip) {
        ATT_PAIR_HEAD(ip);
#pragma unroll 1
        for (int half = 0; half < 2; ++half) { const int t = tlo + 2 * ip + half; const LAS unsigned char* Bf = L + (2 * ps + half) * SLOT; ATT_FAST_TILE(t, Bf, true); }
        ps = ps == 2 ? 0 : ps + 1;
    }
#pragma unroll 1
    for (; ip < pB; ++ip) {
        ATT_PAIR_HEAD(ip);
#pragma unroll
        for (int half = 0; half < 2; ++half) {
            const int t = tlo + 2 * ip + half;
            const LAS unsigned char* Bf = L + (2 * ps + half) * SLOT;
            const bf16x8 q1f[2] = {*(const LAS bf16x8*)(QS), *(const LAS bf16x8*)(QS + 1024)}, q2f[2] = {*(const LAS bf16x8*)(QS + 2048), *(const LAS bf16x8*)(QS + 3072)};
            const float dl = (float)(q - t * 64 - 8 * hi);
            v4u pw1[4], pw2[4];
            const bf16x8 ka00 = *(const LAS bf16x8*)(Bf + kfo), ka01 = *(const LAS bf16x8*)(Bf + kfo + 32), ka10 = *(const LAS bf16x8*)(Bf + 32 * 80 + kfo), ka11 = *(const LAS bf16x8*)(Bf + 32 * 80 + kfo + 32);
            const bf16x8 kb00 = *(const LAS bf16x8*)(Bf + 5120 + kfo), kb01 = *(const LAS bf16x8*)(Bf + 5120 + kfo + 32), kb10 = *(const LAS bf16x8*)(Bf + 5120 + 32 * 80 + kfo), kb11 = *(const LAS bf16x8*)(Bf + 5120 + 32 * 80 + kfo + 32);
            f32x16 c0, c1; bool nomax;
            if (t * 64 + 63 < qw0) {
                const float tl = -slope2 * dl - R;
                nomax = false;
#pragma unroll
                for (int r = 0; r < 16; ++r) { const float cc = (float)(16 * (r >> 3) + (r & 7)); c0[r] = __builtin_fmaf(slope2, cc, tl); c1[r] = __builtin_fmaf(slope2, cc + 32.f, tl); }
            } else if (t * 64 > qw0 + 31) {
                const float tr = slope2 * dl - R;
                nomax = false;
#pragma unroll
                for (int r = 0; r < 16; ++r) { const float cc = (float)(16 * (r >> 3) + (r & 7)); c0[r] = __builtin_fmaf(-slope2, cc, tr); c1[r] = __builtin_fmaf(-slope2, cc + 32.f, tr); }
            } else {
                nomax = false;
#pragma unroll
                for (int r = 0; r < 16; ++r) { const float cc = (float)(16 * (r >> 3) + (r & 7)); c0[r] = __builtin_fmaf(-slope2, __builtin_fabsf(dl - cc), -R); c1[r] = __builtin_fmaf(-slope2, __builtin_fabsf(dl - (cc + 32.f)), -R); }
            }
            {
                f32x16 s0 = __builtin_amdgcn_mfma_f32_32x32x16_bf16(ka00, q1f[0], c0, 0, 0, 0); s0 = __builtin_amdgcn_mfma_f32_32x32x16_bf16(ka01, q1f[1], s0, 0, 0, 0);
                f32x16 s1 = __builtin_amdgcn_mfma_f32_32x32x16_bf16(ka10, q1f[0], c1, 0, 0, 0); s1 = __builtin_amdgcn_mfma_f32_32x32x16_bf16(ka11, q1f[1], s1, 0, 0, 0);
                float p1scale = 1.f; ATT_SOFTMAX(s0, s1, pw1, l1); (void)p1scale;
            }
            bf16x8 vf[2][4];
            {
                f32x16 s0 = __builtin_amdgcn_mfma_f32_32x32x16_bf16(kb00, q2f[0], c0, 0, 0, 0); s0 = __builtin_amdgcn_mfma_f32_32x32x16_bf16(kb01, q2f[1], s0, 0, 0, 0);
                f32x16 s1 = __builtin_amdgcn_mfma_f32_32x32x16_bf16(kb10, q2f[0], c1, 0, 0, 0); s1 = __builtin_amdgcn_mfma_f32_32x32x16_bf16(kb11, q2f[1], s1, 0, 0, 0);
#pragma unroll
                for (int db = 0; db < 2; ++db)
#pragma unroll
                    for (int ks = 0; ks < 4; ++ks) vf[db][ks] = *(const LAS bf16x8*)(Bf + vfo + db * 32 * 144 + ks * 32);
                float p1scale = 1.f; ATT_SOFTMAX(s0, s1, pw2, l2);
                if (__any(p1scale != 1.f)) {
#pragma unroll
                    for (int ks = 0; ks < 4; ++ks)
#pragma unroll
                        for (int e = 0; e < 4; ++e) { const unsigned w = pw1[ks][e]; pw1[ks][e] = cvtpk(bflo(w) * p1scale, bfhi(w) * p1scale); }
                }
            }
#pragma unroll
            for (int db = 0; db < 2; ++db)
#pragma unroll
                for (int ks = 0; ks < 4; ++ks) {
                    O1[db] = __builtin_amdgcn_mfma_f32_32x32x16_bf16(vf[db][ks], __builtin_bit_cast(bf16x8, pw1[ks]), O1[db], 0, 0, 0);
                    O2[db] = __builtin_amdgcn_mfma_f32_32x32x16_bf16(vf[db][ks], __builtin_bit_cast(bf16x8, pw2[ks]), O2[db], 0, 0, 0);
                }
        }
        ps = ps == 2 ? 0 : ps + 1;
    }
    ATT_MAKE_AB();
#pragma unroll 1
    for (; ip < nP; ++ip) {
        ATT_PAIR_HEAD(ip);
#pragma unroll 1
        for (int half = 0; half < 2; ++half) { const int t = tlo + 2 * ip + half; const LAS unsigned char* Bf = L + (2 * ps + half) * SLOT; ATT_FAST_TILE(t, Bf, false); }
        ps = ps == 2 ? 0 : ps + 1;
    }
#undef ATT_PAIR_HEAD
#undef ATT_MAKE_AB
#undef ATT_FAST_TILE
    int lane_e = fresh_lane(); asm volatile("" : "+v"(lane_e));
    const int hi_e = lane_e >> 5, qe = qb * 256 + wid * 32 + (lane_e & 31);
    l1 += LANE_XOR_F(lane_e, l1, 32); l2 += LANE_XOR_F(lane_e, l2, 32);
    const float* dlm = F.in[I_DLAMBDA] + layer * 128;
    float a1 = 0.f, a2 = 0.f;
#pragma unroll 8
    for (int i = 0; i < 32; ++i) { a1 += dlm[i] * dlm[32 + i]; a2 += dlm[64 + i] * dlm[96 + i]; }
    const float lam_init = layer == 0 ? 0.2f : 0.35550907f;
    const float lam = __expf(a1) - __expf(a2) + lam_init;
    const float i1 = 1.f / fmaxf(l1, 1e-30f), i2 = lam / fmaxf(l2, 1e-30f);
    float ss = 0.f;
#pragma unroll
    for (int db = 0; db < 2; ++db)
#pragma unroll
        for (int r = 0; r < 16; ++r) { const float v = O1[db][r] * i1 - O2[db][r] * i2; O1[db][r] = v; ss += v * v; }
    ss += LANE_XOR_F(lane_e, ss, 32);
    const float rs = (1.f / sqrtf(ss * (1.f / 64.f) + EPS)) * (1.f - lam_init);
    bf16* orow = (bf16*)(F.ws + WS_O4) + ((size_t)b * SEQ + qe) * 1024 + 64 * h;
    const float* sg = F.in[I_DSUBLN] + layer * 64;
#pragma unroll
    for (int db = 0; db < 2; ++db)
#pragma unroll
        for (int g4 = 0; g4 < 4; ++g4) {
            const int d0 = 32 * db + 8 * g4 + 4 * hi_e;
            const float v0 = O1[db][4 * g4] * rs * sg[d0], v1 = O1[db][4 * g4 + 1] * rs * sg[d0 + 1], v2 = O1[db][4 * g4 + 2] * rs * sg[d0 + 2], v3 = O1[db][4 * g4 + 3] * rs * sg[d0 + 3];
            v2u w = {pk2(v0, v1), pk2(v2, v3)};
            *(GAS v2u*)(orow + d0) = w;
        }
#if ATT_PRIO
    __builtin_amdgcn_s_setprio(0);
#endif
    asm volatile("s_waitcnt lgkmcnt(0)" ::: "memory");
    __builtin_amdgcn_s_barrier();
#undef ATT_DMA1
#undef ATT_DMA2
}
#undef ATT_SOFTMAX
#undef ATT_EXPPACK
#undef ATT_WAITV
}

namespace pc {
constexpr int MPITCH = 72;
__device__ __forceinline__ void pool_task(Frame& F, const int layer, const int tile, const int g, LAS unsigned char* mimg) {
    const int lane = F.lane, r32 = lane & 31, hi = lane >> 5;
    const bf16* P = (const bf16*)(F.ws + WS_PROJ);
    bf16* O4 = (bf16*)(F.ws + WS_O4);
    bf16x8 wf[2][4];
    { const float* W = F.in[I_POOLW] + ((size_t)layer * 4 + g) * 64 * 64;
#pragma unroll
      for (int nb = 0; nb < 2; ++nb)
#pragma unroll
          for (int ks = 0; ks < 4; ++ks) { v4u t;
#pragma unroll
              for (int jj = 0; jj < 4; ++jj) t[jj] = pk2(W[(16 * ks + 8 * hi + 2 * jj) * 64 + r32 + 32 * nb], W[(16 * ks + 8 * hi + 2 * jj + 1) * 64 + r32 + 32 * nb]);
              wf[nb][ks] = __builtin_bit_cast(bf16x8, t); } }
    const int t0 = tile * 64, s0 = t0 % SEQ, hw = 1 << g;
    const bf16* src = P + (size_t)t0 * PJ + C_PIN + 64 * g + lane;
    float cs[81]; cs[0] = 0.f;
#pragma unroll
    for (int i = 0; i < 80; ++i) { const int s = s0 - 8 + i; float v = 0.f; if (s >= 0 && s < SEQ) v = bf2f(src[(long)(i - 8) * PJ]); cs[i + 1] = cs[i] + v; }
#pragma unroll
    for (int i = 0; i < 64; ++i) {
        const int s = s0 + i; int lo = s - hw, hiw = s + hw; lo = lo < 0 ? 0 : lo; hiw = hiw > SEQ ? SEQ : hiw;
        float wsum = 0.f;
        if (g == 0) wsum = cs[i + 8 + 1] - cs[i + 8 - 1]; else if (g == 1) wsum = cs[i + 8 + 2] - cs[i + 8 - 2]; else if (g == 2) wsum = cs[i + 8 + 4] - cs[i + 8 - 4]; else wsum = cs[i + 8 + 8] - cs[i + 8 - 8];
        const float pv = cs[i + 9] - cs[i + 8];
        const float mval = wsum / (float)(hiw - lo) - pv;
        *(LAS unsigned short*)(mimg + i * (MPITCH * 2) + lane * 2) = (unsigned short)f2bf(mval);
    }
    LDS_WAIT();
#pragma unroll
    for (int tb = 0; tb < 2; ++tb) {
        bf16x8 af[4];
#pragma unroll
        for (int ks = 0; ks < 4; ++ks) af[ks] = *(const LAS bf16x8*)(mimg + (r32 + 32 * tb) * (MPITCH * 2) + (16 * ks + 8 * hi) * 2);
#pragma unroll
        for (int nb = 0; nb < 2; ++nb) {
            f32x16 acc;
#pragma unroll
            for (int r = 0; r < 16; ++r) acc[r] = 0.f;
#pragma unroll
            for (int ks = 0; ks < 4; ++ks) acc = __builtin_amdgcn_mfma_f32_32x32x16_bf16(af[ks], wf[nb][ks], acc, 0, 0, 0);
            const int e = r32 + 32 * nb; const float sc = F.in[I_POOLSCALE][layer * 256 + 64 * g + e];
#pragma unroll
            for (int r = 0; r < 16; ++r) { const int row = 32 * tb + (r & 3) + 8 * (r >> 2) + 4 * hi;
                O4[(size_t)(t0 + row) * 1024 + 256 + 64 * g + e] = (bf16)f2bf(acc[r] * sc); }
        }
    }
    LDS_WAIT();
}
__device__ __forceinline__ void conv_task(Frame& F, const int layer, const int tile, const int cg) {
    const int lane = F.lane;
    const bf16* P = (const bf16*)(F.ws + WS_PROJ);
    bf16* O4 = (bf16*)(F.ws + WS_O4);
    const int t0 = tile * 64, s0 = t0 % SEQ;
    const int ch = 64 * cg + lane;
    const float w0 = F.in[I_SCONVW][layer * 768 + ch], w1 = F.in[I_SCONVW][layer * 768 + 256 + ch], w2 = F.in[I_SCONVW][layer * 768 + 512 + ch];
    const bf16* base = P + (size_t)t0 * PJ + ch;
    float zm = 0.f, z0 = 0.f, zp = 0.f;
    if (s0 > 0) zm = bf2f(base[-(long)PJ + C_CC]) * bf2f(base[-(long)PJ + C_CX]);
    z0 = bf2f(base[C_CC]) * bf2f(base[C_CX]);
#pragma unroll 8
    for (int i = 0; i < 64; ++i) {
        zp = 0.f; if (s0 + i + 1 < SEQ) zp = bf2f(base[(long)(i + 1) * PJ + C_CC]) * bf2f(base[(long)(i + 1) * PJ + C_CX]);
        const float cbv = bf2f(base[(long)i * PJ + C_CB]);
        O4[(size_t)(t0 + i) * 1024 + 512 + ch] = (bf16)f2bf(cbv * (w0 * zm + w1 * z0 + w2 * zp));
        zm = z0; z0 = zp;
    }
}
}

namespace dl {
constexpr int MP = 72, MB = 64 * MP * 2;
constexpr int WAVE_LDS = 2 * MB + 2 * MB;
__device__ __forceinline__ int crow(int r, int hi) { return (r & 3) + 8 * (r >> 2) + 4 * hi; }
__device__ __forceinline__ bf16x8 ldfrag(const LAS unsigned char* img, int row, int col) { return *(const LAS bf16x8*)(img + row * (MP * 2) + col * 2); }
__device__ __forceinline__ bf16x8 ldfragp(const LAS unsigned char* img, int row, int col4) {
    const v2u lo = *(const LAS v2u*)(img + row * (MP * 2) + col4 * 2), hi8 = *(const LAS v2u*)(img + row * (MP * 2) + col4 * 2 + 16); const v4u t = {lo.x, lo.y, hi8.x, hi8.y}; return __builtin_bit_cast(bf16x8, t); }
__device__ __forceinline__ bf16x8 cfrag(const f32x16& x, int half) {
    v4u t;
#pragma unroll
    for (int e = 0; e < 4; ++e) t[e] = att::cvtpk(x[8 * half + 2 * e], x[8 * half + 2 * e + 1]);
    return __builtin_bit_cast(bf16x8, t); }
#define MFMA32(a, b, c) __builtin_amdgcn_mfma_f32_32x32x16_bf16((a), (b), (c), 0, 0, 0)
#define SB() __builtin_amdgcn_sched_barrier(0)
#define LAUNDER() do { asm volatile("" : "+v"(lane)); r32 = lane & 31; hi = lane >> 5; } while (0)
__device__ __forceinline__ f32x16 zero16() { f32x16 z;
#pragma unroll
    for (int r = 0; r < 16; ++r) z[r] = 0.f;
    return z; }

#define DL_CONV(colbase, wbase, RAW) do { \
    { const bf16* src_ = P + (size_t)tok0 * PJ + (colbase); const int rr_ = lane >> 3, ch_ = lane & 7; \
      _Pragma("unroll") for (int i_ = 0; i_ < 9; ++i_) { const int row_ = rr_ + 8 * i_; const int sq_ = s0 - 2 + row_; v4u t_ = {0u, 0u, 0u, 0u}; \
          if (row_ < 68 && sq_ >= 0 && sq_ < SEQ) t_ = *(const GAS v4u*)(src_ + (long)(row_ - 2) * PJ + ch_ * 8); if (row_ < 68) *(LAS v4u*)((RAW) + row_ * 128 + ch_ * 16) = t_; } } \
    LDS_WAIT(); \
    const float cw0 = cwp[(wbase) + lane], cw1 = cwp[768 + (wbase) + lane], cw2 = cwp[2 * 768 + (wbase) + lane], cw3 = cwp[3 * 768 + (wbase) + lane], cw4 = cwp[4 * 768 + (wbase) + lane]; \
    const LAS unsigned short* rw_ = (const LAS unsigned short*)(RAW) + lane; \
    _Pragma("unroll") for (int i = 0; i < 64; ++i) { \
        const float cv_ = cw0 * bf2f(rw_[i * 64]) + cw1 * bf2f(rw_[(i + 1) * 64]) + cw2 * bf2f(rw_[(i + 2) * 64]) + cw3 * bf2f(rw_[(i + 3) * 64]) + cw4 * bf2f(rw_[(i + 4) * 64]); \
        cval[i] = cv_ * sigmoidf_(cv_); if ((i & 7) == 7) SB(); } \
    LDS_WAIT(); } while (0)
#define DL_NORM(SQ, scale) do { \
    _Pragma("unroll") for (int i = 0; i < 64; ++i) *(LAS unsigned short*)((SQ) + i * 144 + lane * 2) = (unsigned short)f2bf(cval[i] * cval[i]); \
    LDS_WAIT(); \
    { float sm_ = 0.f; _Pragma("unroll") for (int c8 = 0; c8 < 8; ++c8) { const v4u w_ = *(const LAS v4u*)((SQ) + lane * 144 + c8 * 16); \
          sm_ += (bflo(w_.x) + bfhi(w_.x)) + (bflo(w_.y) + bfhi(w_.y)) + (bflo(w_.z) + bfhi(w_.z)) + (bflo(w_.w) + bfhi(w_.w)); } \
      tab[192 + lane] = (scale) / sqrtf(sm_ + EPS); } \
    LDS_WAIT(); \
    _Pragma("unroll") for (int i4 = 0; i4 < 16; ++i4) { const f32x4 r4_ = *(const LAS f32x4*)(tab + 192 + 4 * i4); cval[4 * i4] *= r4_.x; cval[4 * i4 + 1] *= r4_.y; cval[4 * i4 + 2] *= r4_.z; cval[4 * i4 + 3] *= r4_.w; } \
    } while (0)

__device__ __forceinline__ void d1_instance(Frame& F, const int layer, const int b, const int h, const int norig, const int dir, LAS unsigned char* W, LAS float* tab) {
    int lane = F.lane, r32, hi; LAUNDER();
    const bf16* P = (const bf16*)(F.ws + WS_PROJ);
    const float* cwp = F.in[I_DCONVW] + (size_t)layer * 5 * 768;
    const int s0 = norig * 64, tok0 = b * SEQ + s0;
    const int npr = dir ? 255 - norig : norig;
    const int inst = ((b * 4 + h) * 2 + dir) * NCHUNK + npr;
    LAS unsigned char* VT = W;
    LAS unsigned char* KT = W + MB;
    LAS unsigned char* KR = W + 2 * MB;
    LAS unsigned char* T2 = W + 3 * MB;
    LAS float* SM = (LAS float*)(W + 2 * MB);
    float cval[64];
    DL_CONV(C_DK + 64 * h, 256 + 64 * h, T2);
    DL_NORM(VT, 1.f);
#pragma unroll
    for (int i = 0; i < 64; ++i) { const int ip = dir ? 63 - i : i; const unsigned short kb = (unsigned short)f2bf(cval[i]);
        *(LAS unsigned short*)(KR + ip * (MP * 2) + lane * 2) = kb; *(LAS unsigned short*)(KT + lane * (MP * 2) + ip * 2) = kb; }
    LDS_WAIT();
    DL_CONV(C_DV + 64 * h, 512 + 64 * h, T2);
#pragma unroll
    for (int i = 0; i < 64; ++i) { const int ip = dir ? 63 - i : i; *(LAS unsigned short*)(VT + lane * (MP * 2) + ip * 2) = (unsigned short)f2bf(cval[i]); }
    const int mytok = tok0 + (dir ? 63 - lane : lane);
    const float* BD = (const float*)(F.ws + WS_BD) + (size_t)mytok * 16;
    const float beta = BD[dir * 4 + h]; float gc = BD[8 + dir * 4 + h];
#pragma unroll
    for (int o = 1; o < 64; o <<= 1) { const float t = __builtin_bit_cast(float, __builtin_amdgcn_ds_bpermute(((lane - o) & 63) << 2, __builtin_bit_cast(int, gc))); if (lane >= o) gc += t; }
    const float gl = __shfl(gc, 63);
    tab[lane] = gc; tab[64 + lane] = beta; tab[128 + lane] = __expf(gl - gc);
    LDS_WAIT();
    LAUNDER();
    f32x16 kk[2][2];
#pragma unroll
    for (int tb = 0; tb < 2; ++tb)
#pragma unroll
        for (int tn = 0; tn < 2; ++tn) { f32x16 acc = zero16();
#pragma unroll
            for (int ks = 0; ks < 4; ++ks) acc = MFMA32(ldfrag(KR, r32 + 32 * tb, 16 * ks + 8 * hi), ldfrag(KR, r32 + 32 * tn, 16 * ks + 8 * hi), acc);
            kk[tb][tn] = acc; SB(); }
    LDS_WAIT();
#pragma unroll
    for (int tb = 0; tb < 2; ++tb)
#pragma unroll
        for (int tn = 0; tn < 2; ++tn) {
            const int jc = r32 + 32 * tn; const float gcj = tab[jc];
#pragma unroll
            for (int r = 0; r < 16; ++r) { const int ir = 32 * tb + crow(r, hi); const float gci = tab[ir], bi = tab[64 + ir];
                const float mv = (ir > jc) ? bi * kk[tb][tn][r] * __expf(gci - gcj) : 0.f; SM[ir * 64 + jc] = mv; } SB(); }
    LDS_WAIT();
    LAUNDER();
    float T[64];
#pragma unroll
    for (int i = 0; i < 64; ++i) {
        float a0 = (lane == i) ? 1.f : 0.f, a1 = 0.f, a2 = 0.f, a3 = 0.f;
#pragma unroll
        for (int j4 = 0; j4 < (i + 3) / 4; ++j4) { const f32x4 m4 = *(const LAS f32x4*)(SM + i * 64 + 4 * j4);
            if (4 * j4 + 0 < i) a0 = __builtin_fmaf(-m4[0], T[4 * j4 + 0], a0);
            if (4 * j4 + 1 < i) a1 = __builtin_fmaf(-m4[1], T[4 * j4 + 1], a1);
            if (4 * j4 + 2 < i) a2 = __builtin_fmaf(-m4[2], T[4 * j4 + 2], a2);
            if (4 * j4 + 3 < i) a3 = __builtin_fmaf(-m4[3], T[4 * j4 + 3], a3); }
        T[i] = (a0 + a1) + (a2 + a3); if ((i & 3) == 3) SB(); }
    LDS_WAIT();
    LAUNDER();
    { const float b1 = beta, b2 = beta * __expf(gc);
#pragma unroll
      for (int i = 0; i < 64; ++i) { *(LAS unsigned short*)(KR + i * (MP * 2) + lane * 2) = (unsigned short)f2bf(T[i] * b1); *(LAS unsigned short*)(T2 + i * (MP * 2) + lane * 2) = (unsigned short)f2bf(T[i] * b2); if ((i & 7) == 7) SB(); } }
    LDS_WAIT();
    LAUNDER();
    f32x16 u[2][2], w[2][2];
#pragma unroll
    for (int tb = 0; tb < 2; ++tb)
#pragma unroll
        for (int tn = 0; tn < 2; ++tn) { f32x16 au = zero16(), aw = zero16();
#pragma unroll
            for (int ks = 0; ks < 4; ++ks) { au = MFMA32(ldfrag(KR, r32 + 32 * tb, 16 * ks + 8 * hi), ldfrag(VT, r32 + 32 * tn, 16 * ks + 8 * hi), au);
                                             aw = MFMA32(ldfrag(T2, r32 + 32 * tb, 16 * ks + 8 * hi), ldfrag(KT, r32 + 32 * tn, 16 * ks + 8 * hi), aw); }
            u[tb][tn] = au; w[tb][tn] = aw; SB(); }
    LAUNDER();
    { unsigned* ud = (unsigned*)(F.ws + WS_UW + (size_t)inst * 16384); bf16* wd = (bf16*)(F.ws + WS_UW + (size_t)inst * 16384 + 8192);
#pragma unroll
      for (int tb = 0; tb < 2; ++tb)
#pragma unroll
          for (int tn = 0; tn < 2; ++tn) {
#pragma unroll
              for (int rp = 0; rp < 8; ++rp) ud[((tb * 2 + tn) * 8 + rp) * 64 + lane] = pk2(u[tb][tn][2 * rp], u[tb][tn][2 * rp + 1]);
#pragma unroll
              for (int r = 0; r < 16; ++r) wd[(32 * tb + crow(r, hi)) * 64 + r32 + 32 * tn] = (bf16)f2bf(w[tb][tn][r]); SB(); } }
    LAUNDER();
#pragma unroll
    for (int tb = 0; tb < 2; ++tb)
#pragma unroll
        for (int r = 0; r < 16; ++r) { const float e = tab[128 + 32 * tb + crow(r, hi)];
#pragma unroll
            for (int tn = 0; tn < 2; ++tn) { u[tb][tn][r] *= e; w[tb][tn][r] *= e; } }
    SB();
    bf16x8 kf[2][4];
#pragma unroll
    for (int tbb = 0; tbb < 2; ++tbb)
#pragma unroll
        for (int s = 0; s < 4; ++s) kf[tbb][s] = ldfragp(KT, r32 + 32 * tbb, 16 * s + 4 * hi);
    LDS_WAIT(); SB();
    LAUNDER();
    LAS unsigned char* AR = VT; LAS unsigned char* BT = KR;
#pragma unroll
    for (int tbb = 0; tbb < 2; ++tbb)
#pragma unroll
        for (int tx = 0; tx < 2; ++tx) { f32x16 aa = zero16(), ab = zero16();
#pragma unroll
            for (int s = 0; s < 4; ++s) { aa = MFMA32(cfrag(w[s >> 1][tx], s & 1), kf[tbb][s], aa); ab = MFMA32(kf[tbb][s], cfrag(u[s >> 1][tx], s & 1), ab); }
#pragma unroll
            for (int g4 = 0; g4 < 4; ++g4) {
                const v2u pa = {pk2(-aa[4 * g4], -aa[4 * g4 + 1]), pk2(-aa[4 * g4 + 2], -aa[4 * g4 + 3])};
                *(LAS v2u*)(AR + (r32 + 32 * tbb) * (MP * 2) + (32 * tx + 8 * g4 + 4 * hi) * 2) = pa;
                const v2u pb = {pk2(ab[4 * g4], ab[4 * g4 + 1]), pk2(ab[4 * g4 + 2], ab[4 * g4 + 3])};
                *(LAS v2u*)(BT + (r32 + 32 * tx) * (MP * 2) + (32 * tbb + 8 * g4 + 4 * hi) * 2) = pb;
            } SB(); }
    LDS_WAIT();
    LAUNDER();
    { unsigned char* ab = F.ws + WS_AB + (size_t)inst * 16384; const int m16 = lane & 15, g = lane >> 4;
#pragma unroll
      for (int rb = 0; rb < 4; ++rb)
#pragma unroll
          for (int ks = 0; ks < 2; ++ks) { const v2u lo = *(const LAS v2u*)(AR + (16 * rb + m16) * (MP * 2) + (32 * ks + 4 * g) * 2), hi8 = *(const LAS v2u*)(AR + (16 * rb + m16) * (MP * 2) + (32 * ks + 16 + 4 * g) * 2);
              const v4u t = {lo.x, lo.y, hi8.x, hi8.y}; *(GAS v4u*)(ab + ((rb * 2 + ks) * 64 + lane) * 16) = t; }
#pragma unroll
      for (int sl = 0; sl < 4; ++sl)
#pragma unroll
          for (int rb = 0; rb < 4; ++rb) { const v2u t = *(const LAS v2u*)(BT + (16 * sl + m16) * (MP * 2) + (16 * rb + 4 * g) * 2); *(GAS v2u*)(ab + 8192 + ((sl * 4 + rb) * 64 + lane) * 8) = t; } }
    if (lane == 0) ((float*)(F.ws + WS_DEC))[inst] = __expf(gl);
    LDS_WAIT();
}
__device__ __forceinline__ void pc_side_tasks(Frame& F, const int layer) {
    if (F.wave == 4) {
        LAS unsigned char* mimg = F.lds + RING_OFF + 4 * WAVE_LDS + 4096;
        for (int tile = F.vcu; tile < NTOK / 128; tile += F.G)
            for (int g = 0; g < 4; ++g) pc::pool_task(F, layer, tile, g, mimg);
    } else if (F.wave > 4) {
        int k = 0;
        for (int tile = F.vcu; tile < NTOK / 128; tile += F.G)
            for (int cg = 0; cg < 4; ++cg, ++k) if (k % 3 == F.wave - 5) pc::conv_task(F, layer, tile, cg);
    }
}
__device__ __forceinline__ void pc_item(Frame& F, const int layer, const int item) {
    const int tile = NTOK / 128 + (item >> 1), sub = item & 1;
    if (F.wave == 4) {
        LAS unsigned char* mimg = F.lds + RING_OFF + 4 * WAVE_LDS + 4096;
#pragma unroll 1
        for (int g = 2 * sub; g < 2 * sub + 2; ++g) pc::pool_task(F, layer, tile, g, mimg);
    } else if (F.wave == 5) pc::conv_task(F, layer, tile, 2 * sub);
    else if (F.wave == 6) pc::conv_task(F, layer, tile, 2 * sub + 1);
}
__device__ __forceinline__ void d1_phase(Frame& F, const int layer) {
    if (F.wave < 4) {
        LAS unsigned char* W = F.lds + RING_OFF + F.wave * WAVE_LDS; LAS float* tab = (LAS float*)(F.lds + RING_OFF + 4 * WAVE_LDS + F.wave * 1024);
        const int gw = F.vcu * 4 + F.wave, NGW = F.G * 4;
        for (int it = gw; it < NINST; it += NGW) { const int dir = it & 1, u = it >> 1; d1_instance(F, layer, u >> 10, (u >> 8) & 3, u & 255, dir, W, tab); }
    } else pc_side_tasks(F, layer);
    __syncthreads();
}

typedef float f32x4v __attribute__((ext_vector_type(4)));
struct D2Regs { v4u af[4][2]; v2u bm[4]; float dcy; };
__device__ __forceinline__ void d2_chain(Frame& F, const int chain) {
    const int lane = F.lane, n16 = lane & 15, g = lane >> 4, sl = F.wave;
    f32x4v S[4];
#pragma unroll
    for (int rb = 0; rb < 4; ++rb) S[rb] = (f32x4v){0.f, 0.f, 0.f, 0.f};
    const unsigned char* abase = F.ws + WS_AB + (size_t)chain * NCHUNK * 16384;
    unsigned char* sbase = F.ws + WS_ST + (size_t)chain * NCHUNK * 8192;
    const float* dec = (const float*)(F.ws + WS_DEC) + chain * NCHUNK;
    D2Regs q0, q1, q2;
#define D2_LOAD(Q, n) do { const unsigned char* ab_ = abase + (size_t)(n) * 16384; \
    _Pragma("unroll") for (int rb = 0; rb < 4; ++rb) { _Pragma("unroll") for (int ks = 0; ks < 2; ++ks) Q.af[rb][ks] = *(const GAS v4u*)(ab_ + ((rb * 2 + ks) * 64 + lane) * 16); \
        Q.bm[rb] = *(const GAS v2u*)(ab_ + 8192 + ((sl * 4 + rb) * 64 + lane) * 8); } Q.dcy = dec[n]; } while (0)
#define D2_STEP(Q, n) do { \
    unsigned char* st = sbase + (size_t)(n) * 8192 + (16 * sl + n16) * 128; \
    _Pragma("unroll") for (int rb = 0; rb < 4; ++rb) { const v2u t = {pk2(S[rb][0], S[rb][1]), pk2(S[rb][2], S[rb][3])}; *(GAS v2u*)(st + (16 * rb + 4 * g) * 2) = t; } \
    bf16x8 bfr[2]; \
    _Pragma("unroll") for (int ks = 0; ks < 2; ++ks) { const v4u t = {att::cvtpk(S[2 * ks][0], S[2 * ks][1]), att::cvtpk(S[2 * ks][2], S[2 * ks][3]), att::cvtpk(S[2 * ks + 1][0], S[2 * ks + 1][1]), att::cvtpk(S[2 * ks + 1][2], S[2 * ks + 1][3])}; bfr[ks] = __builtin_bit_cast(bf16x8, t); } \
    _Pragma("unroll") for (int rb = 0; rb < 4; ++rb) { const float cd = Q.dcy; \
        f32x4v c = {S[rb][0] * cd + bflo(Q.bm[rb].x), S[rb][1] * cd + bfhi(Q.bm[rb].x), S[rb][2] * cd + bflo(Q.bm[rb].y), S[rb][3] * cd + bfhi(Q.bm[rb].y)}; \
        c = __builtin_amdgcn_mfma_f32_16x16x32_bf16(__builtin_bit_cast(bf16x8, Q.af[rb][0]), bfr[0], c, 0, 0, 0); \
        c = __builtin_amdgcn_mfma_f32_16x16x32_bf16(__builtin_bit_cast(bf16x8, Q.af[rb][1]), bfr[1], c, 0, 0, 0); \
        S[rb] = c; } } while (0)
    D2_LOAD(q0, 0); D2_LOAD(q1, 1);
    for (int n = 0; n < NCHUNK - 1; n += 3) {
        D2_LOAD(q2, n + 2); D2_STEP(q0, n); SB();
        D2_LOAD(q0, n + 3); D2_STEP(q1, n + 1); SB();
        if (n + 4 < NCHUNK) D2_LOAD(q1, n + 4); D2_STEP(q2, n + 2); SB();
    }
    D2_STEP(q0, NCHUNK - 1);
#undef D2_LOAD
#undef D2_STEP
}

__device__ __forceinline__ void d3_unit(Frame& F, const int layer, const int b, const int h, const int norig, LAS unsigned char* W, LAS float* tab) {
    int lane = F.lane, r32, hi; LAUNDER();
    const bf16* P = (const bf16*)(F.ws + WS_PROJ);
    const float* cwp = F.in[I_DCONVW] + (size_t)layer * 5 * 768;
    const int s0 = norig * 64, tok0 = b * SEQ + s0;
    LAS unsigned char* QR = W;
    LAS unsigned char* KR = W + MB;
    LAS unsigned char* AT = W + 2 * MB;
    LAS unsigned char* WR = W + 3 * MB;
    { float cval[64];
      DL_CONV(C_DQ + 64 * h, 64 * h, WR);
      DL_NORM(AT, 0.125f);
#pragma unroll
      for (int i = 0; i < 64; ++i) *(LAS unsigned short*)(QR + i * (MP * 2) + lane * 2) = (unsigned short)f2bf(cval[i]);
      LDS_WAIT();
      DL_CONV(C_DK + 64 * h, 256 + 64 * h, WR);
      DL_NORM(AT, 1.f);
#pragma unroll
      for (int i = 0; i < 64; ++i) *(LAS unsigned short*)(KR + i * (MP * 2) + lane * 2) = (unsigned short)f2bf(cval[i]);
      LDS_WAIT(); }
    f32x16 of[2][2];
#pragma unroll
    for (int dir = 0; dir < 2; ++dir) {
        LAUNDER();
        const int npr = dir ? 255 - norig : norig;
        const int inst = ((b * 4 + h) * 2 + dir) * NCHUNK + npr;
        const int mytok = tok0 + (dir ? 63 - lane : lane);
        float gc = ((const float*)(F.ws + WS_BD))[(size_t)mytok * 16 + 8 + dir * 4 + h];
#pragma unroll
        for (int o = 1; o < 64; o <<= 1) { const float t = __builtin_bit_cast(float, __builtin_amdgcn_ds_bpermute(((lane - o) & 63) << 2, __builtin_bit_cast(int, gc))); if (lane >= o) gc += t; }
        tab[lane] = gc; tab[64 + lane] = __expf(gc);
        { const unsigned char* wg = F.ws + WS_UW + (size_t)inst * 16384 + 8192;
#pragma unroll
          for (int i = 0; i < 8; ++i) { const int idx = i * 64 + lane, row = idx >> 3, ch = idx & 7; const v4u c = *(const GAS v4u*)(wg + idx * 16); *(LAS v4u*)(WR + row * (MP * 2) + ch * 16) = c; } }
        LDS_WAIT();
        LAUNDER();
        const int ra0 = dir ? 63 - r32 : r32, ra1 = dir ? 31 - r32 : 32 + r32;
        f32x16 qk[2][2];
#pragma unroll
        for (int tb = 0; tb < 2; ++tb)
#pragma unroll
            for (int tn = 0; tn < 2; ++tn) { f32x16 acc = zero16();
#pragma unroll
                for (int ks = 0; ks < 4; ++ks) acc = MFMA32(ldfrag(QR, tb ? ra1 : ra0, 16 * ks + 8 * hi), ldfrag(KR, tn ? ra1 : ra0, 16 * ks + 8 * hi), acc);
                qk[tb][tn] = acc; SB(); }
        LDS_WAIT();
#pragma unroll
        for (int tb = 0; tb < 2; ++tb)
#pragma unroll
            for (int tn = 0; tn < 2; ++tn) { const int jc = r32 + 32 * tn; const float gcj = tab[jc];
#pragma unroll
                for (int r = 0; r < 16; ++r) { const int ir = 32 * tb + crow(r, hi); const float gci = tab[ir];
                    const float av = (ir >= jc) ? qk[tb][tn][r] * __expf(gci - gcj) : 0.f; *(LAS unsigned short*)(AT + ir * (MP * 2) + jc * 2) = (unsigned short)f2bf(av); } SB(); }
        LDS_WAIT();
        LAUNDER();
        const unsigned* ud = (const unsigned*)(F.ws + WS_UW + (size_t)inst * 16384);
        const unsigned char* sg = F.ws + WS_ST + (size_t)inst * 8192;
#pragma unroll
        for (int tn = 0; tn < 2; ++tn) {
            bf16x8 sf[4];
#pragma unroll
            for (int ks = 0; ks < 4; ++ks) sf[ks] = *(const GAS bf16x8*)(sg + ((r32 + 32 * tn) * 64 + 16 * ks + 8 * hi) * 2);
            f32x16 vn[2], o[2];
#pragma unroll
            for (int tb = 0; tb < 2; ++tb) { f32x16 a1 = zero16(), a2 = zero16();
#pragma unroll
                for (int ks = 0; ks < 4; ++ks) { a1 = MFMA32(ldfrag(WR, r32 + 32 * tb, 16 * ks + 8 * hi), sf[ks], a1); a2 = MFMA32(ldfrag(QR, tb ? ra1 : ra0, 16 * ks + 8 * hi), sf[ks], a2); }
#pragma unroll
                for (int rp = 0; rp < 8; ++rp) { const unsigned uw = ud[((tb * 2 + tn) * 8 + rp) * 64 + lane]; a1[2 * rp] = bflo(uw) - a1[2 * rp]; a1[2 * rp + 1] = bfhi(uw) - a1[2 * rp + 1]; }
#pragma unroll
                for (int r = 0; r < 16; ++r) a2[r] *= tab[64 + 32 * tb + crow(r, hi)];
                vn[tb] = a1; o[tb] = a2; SB(); }
#pragma unroll
            for (int tb = 0; tb < 2; ++tb) { f32x16 acc = o[tb];
#pragma unroll
                for (int s = 0; s < 4; ++s) acc = MFMA32(ldfragp(AT, r32 + 32 * tb, 16 * s + 4 * hi), cfrag(vn[s >> 1], s & 1), acc);
                o[tb] = acc; SB(); }
            if (dir == 0) { of[0][tn] = o[0]; of[1][tn] = o[1]; }
            else {
#pragma unroll
                for (int tb = 0; tb < 2; ++tb)
#pragma unroll
                    for (int r = 0; r < 16; ++r) of[tb][tn][r] += LANE_XOR_F(lane, o[1 - tb][15 - r], 32);
            }
        }
        LDS_WAIT();
    }
    const float* dn = F.in[I_DNORM] + layer * 64;
#pragma unroll
    for (int tb = 0; tb < 2; ++tb)
#pragma unroll
        for (int r = 0; r < 16; ++r) {
            float ss = of[tb][0][r] * of[tb][0][r] + of[tb][1][r] * of[tb][1][r];
#pragma unroll
            for (int o = 1; o < 32; o <<= 1) ss += LANE_XOR_F(lane, ss, o);
            const float rs = 1.f / sqrtf(ss * (1.f / 64.f) + EPS);
            const int tok = tok0 + 32 * tb + crow(r, hi);
#pragma unroll
            for (int tn = 0; tn < 2; ++tn) { const int dv = r32 + 32 * tn; const float z = bf2f(P[(size_t)tok * PJ + C_DZ + 64 * h + dv]);
                ((bf16*)(F.ws + WS_O4))[(size_t)tok * 1024 + 768 + 64 * h + dv] = (bf16)f2bf(of[tb][tn][r] * rs * dn[dv] * siluf_(z)); }
        }
}
constexpr int QN_ATT = BATCH * 4 * 64, QN_D3 = BATCH * 4 * NCHUNK / 4;
#ifndef QD3_EARLY
#define QD3_EARLY 1
#endif
__device__ __forceinline__ void scan_attn_d3_phase(Frame& F, const int layer, const int qword) {
    bool scans_seen = false;
    for (;;) {
        { unsigned char* w_ = F.ws; asm volatile("" : "+s"(w_)); F.ws = w_; F.ctl = (gu32*)(w_ + WS_CTL); }
        unsigned mo_ = MISC_OFF + 64; asm volatile("" : "+s"(mo_));
        volatile LAS unsigned* mq_ = (volatile LAS unsigned*)(F.lds + mo_);
        if (F.wave == 0) { int t_ = fresh_lane(); asm volatile("" : "+v"(t_)); if (t_ == 0) *mq_ = __hip_atomic_fetch_add(F.ctl + CW_ATTQ + 64 * qword, 1u, RLX_AGENT); }
        __syncthreads();
        int idx = (int)*mq_;
        __syncthreads();
        if (idx >= 16 + QN_ATT + QN_D3) break;
#if QD3_EARLY
        if (idx >= 16) { const int r_ = idx - 16; idx = r_ < 384 ? idx : (r_ < 384 + QN_D3 ? 16 + QN_ATT + (r_ - 384) : 16 + 384 + (r_ - 384 - QN_D3)); }
#endif
        if (idx < 16) {
            { int t_ = fresh_lane(); asm volatile("" : "+v"(t_)); F.lane = t_; }
#ifdef PROBE_D2X2
            if (F.wave < 4) { for (int rep2_ = 0; rep2_ < PROBE_D2X2; ++rep2_) { d2_chain(F, idx); asm volatile("" ::: "memory"); } }
#else
            if (F.wave < 4) d2_chain(F, idx);
#endif
            asm volatile("s_waitcnt vmcnt(0)" ::: "memory");
            __syncthreads();
            if (F.wave == 0 && fresh_lane() == 0) { __builtin_amdgcn_fence(__ATOMIC_RELEASE, "agent"); asm volatile("s_waitcnt vmcnt(0)" ::: "memory"); (void)__hip_atomic_fetch_add(F.ctl + CW_ATTQ + 64 * qword + 32, 1u, RLX_AGENT); }
        } else if (idx < 16 + QN_ATT) { { int t_ = fresh_lane(); asm volatile("" : "+v"(t_)); F.lane = t_; }
            const int j = idx - 16, h = 3 - (j >> 7), jj = j & 127, b = jj & 1, k = jj >> 1, qb = (k & 1) ? 31 - (k >> 1) : 32 + (k >> 1);
            att::attn_unit(F, layer, b, h, qb);
        } else {
            int item = idx - 16 - QN_ATT;
            if (!scans_seen) {
                if (F.wave == 0 && fresh_lane() == 0) { unsigned sp = 0u; while (__hip_atomic_load(F.ctl + CW_ATTQ + 64 * qword + 32, RLX_AGENT) < 16u) { __builtin_amdgcn_s_sleep(2); if (++sp > (1u << 24)) break; }
                    __builtin_amdgcn_fence(__ATOMIC_ACQUIRE, "agent"); asm volatile("s_waitcnt vmcnt(0)" ::: "memory"); }
                __syncthreads();
                scans_seen = true;
            }
            { int t_ = F.wave * 64 + fresh_lane(), i_ = item; asm volatile("" : "+v"(t_), "+s"(i_)); F.tid = t_; F.lane = t_ & 63; item = i_; }
            if (F.wave < 4) {
                LAS unsigned char* W = F.lds + RING_OFF + F.wave * WAVE_LDS; LAS float* tab = (LAS float*)(F.lds + RING_OFF + 4 * WAVE_LDS + F.wave * 1024);
                const int u = item * 4 + F.wave;
                d3_unit(F, layer, u >> 10, (u >> 8) & 3, u & 255, W, tab);
            } else pc_item(F, layer, item);
        }
    }
    __syncthreads();
}
#undef MFMA32
}

#ifndef ONLY_SITE
#define ONLY_SITE -1
#endif
#define SITE(k) (ONLY_SITE < 0 || ONLY_SITE == (k))
#ifndef GEMM_SP2
#define GEMM_SP2 true
#endif
#ifndef PROBE_MASK
#define PROBE_MASK 0
#endif
#ifndef PROBE_N
#define PROBE_N 2
#endif
#define REPEAT(k) for (int rep_ = 0; rep_ < (((PROBE_MASK >> (k)) & 1) ? PROBE_N : 1); ++rep_)
#ifndef MK_SPLIT
#define MK_SPLIT 0
#endif
struct Args { const float* in[30]; float* out; unsigned char* ws; int ph_lo, ph_hi; };
constexpr int N_PHASES = 1 + 16 * NLAYER + 1;

#define IN_PH() (pid >= lo && pid < hi)
#define FRESH() do { unsigned char* w_ = args.ws; float* o_ = args.out; int t_ = F.wave * 64 + (int)__builtin_amdgcn_mbcnt_hi(~0u, __builtin_amdgcn_mbcnt_lo(~0u, 0u)); asm volatile("" : "+s"(w_), "+s"(o_), "+v"(t_)); F.ws = w_; F.out = o_; F.ctl = (gu32*)(w_ + WS_CTL); F.tid = t_; F.lane = t_ & 63; } while (0)
#ifdef PROBE_BARX2
#define SEAM() do { if (!MK_SPLIT && pid >= lo && pid + 1 < hi) { xcd_barrier(bar); xcd_barrier(bar); xcd_barrier(bar); } ++pid; } while (0)
#else
#define SEAM() do { if (!MK_SPLIT && pid >= lo && pid + 1 < hi) xcd_barrier(bar); ++pid; } while (0)
#endif
#define NOSEAM() do { ++pid; } while (0)

template <int l> __device__ __forceinline__ void layer_phases(Frame& F, const Args& args, const XcdBarrier& bar, const int lo, const int hi, int& pid) {
    LAS unsigned char* ring = F.lds + RING_OFF;

        if constexpr (l == 0) { if (IN_PH() && SITE(1)) REPEAT(1) { FRESH(); p_rows<ROW_A>(F, 0); } SEAM(); } else { NOSEAM(); }
        if (IN_PH() && SITE(2)) REPEAT(2) { FRESH();
            pg8::SchedStd S; S.init(NTOK / 256, NPROJ / 256, F.G, (int)blockIdx.x, F.ws + WS_H, (size_t)256 * D * 2, w_in_t(F.ws, l), (size_t)256 * D * 2);
            pg8::EpiProj E{(bf16*)(F.ws + WS_QB), (bf16*)(F.ws + WS_KV), (bf16*)(F.ws + WS_PROJ), (unsigned*)(F.ctl + CW_NMAX) + l * 16, QSCALE};
            pg8::gemm_phase<pg8::EpiProj, pg8::SchedStd, D, D, D, false, false, true, GEMM_SP2>(ring, F.tid, S, E);
        }
        SEAM();
        NOSEAM();
        if (IN_PH() && SITE(5)) REPEAT(5) { FRESH(); dl::d1_phase(F, l); }
        SEAM();
        if (IN_PH() && SITE(3)) REPEAT(3) { FRESH(); dl::scan_attn_d3_phase(F, l, l * 2 + rep_); }
        SEAM();
        NOSEAM();
        NOSEAM();
        NOSEAM();
        if (IN_PH() && SITE(9)) REPEAT(9) { FRESH();
            pg8::SchedGateP S{F.vcu, F.G, (const char*)F.ws, WS_H, WS_W + (size_t)l * SZ_LAYERW + SZ_WIN, WS_O4, WS_W + (size_t)l * SZ_LAYERW + SZ_WIN + SZ_WM};
            pg8::EpiGateP E{(bf16*)(F.ws + WS_PBUF) + (size_t)blockIdx.x * 65536, (bf16*)(F.ws + WS_MERGED), F.in[I_BMERGE] + (size_t)l * 4 * D, F.tid};
            pg8::gemm_phase<pg8::EpiGateP, pg8::SchedGateP, D, D, D>(ring, F.tid, S, E);
        }
        SEAM();
        if (IN_PH() && SITE(10)) REPEAT(10) { FRESH();
            pg8::SchedStd S; S.init(NTOK / 256, D / 256, F.G, (int)blockIdx.x, F.ws + WS_MERGED, (size_t)256 * D * 2, w_o_t(F.ws, l), (size_t)256 * D * 2);
            pg8::EpiStore E{(bf16*)(F.ws + WS_F), D, 0, 1.f};
            pg8::gemm_phase<pg8::EpiStore, pg8::SchedStd, D, D, D, false, false, true, GEMM_SP2>(ring, F.tid, S, E);
        }
        SEAM();
        if (IN_PH() && SITE(11)) REPEAT(11) { FRESH(); p_rows<ROW_B>(F, l); }
        SEAM();
        if constexpr (l == 0) {
            if (IN_PH() && SITE(12)) REPEAT(12) { FRESH();
                pg8::SchedStd S; S.init(NTOK / 256, 2 * DFF / 256, F.G, (int)blockIdx.x, F.ws + WS_H, (size_t)256 * D * 2, F.ws + WS_WFFN, (size_t)256 * D * 2);
                pg8::EpiSwiGLU<false> E{(bf16*)(F.ws + WS_ACT0), DFF};
                pg8::gemm_phase<pg8::EpiSwiGLU<false>, pg8::SchedStd, D, D, D, false, false, true, GEMM_SP2>(ring, F.tid, S, E);
            }
            SEAM();
            if (IN_PH() && SITE(13)) REPEAT(13) { FRESH();
                pg8::SchedStd S; S.init(NTOK / 256, D / 256, F.G, (int)blockIdx.x, F.ws + WS_ACT0, (size_t)256 * DFF * 2, F.ws + WS_WFFN + SZ_WGU, (size_t)256 * DFF * 2);
                pg8::EpiStore E{(bf16*)(F.ws + WS_F), D, 0, 1.f};
                pg8::gemm_phase<pg8::EpiStore, pg8::SchedStd, DFF, DFF, DFF, false, false, true, GEMM_SP2>(ring, F.tid, S, E);
            }
            SEAM();
            if (IN_PH() && SITE(14)) REPEAT(14) { FRESH(); p_rows<ROW_C>(F, 0); }
            SEAM();
            NOSEAM(); NOSEAM();
        } else {
            if (IN_PH() && SITE(15)) REPEAT(15) { FRESH(); p_moe_cvt(F); }
            SEAM();
#pragma unroll 1
            for (int pass = 0; pass < MOE_NPASS; ++pass) {
                if (IN_PH() && SITE(16)) REPEAT(16) { FRESH();
                    constexpr int EB = MOE_FP8 ? 1 : 2;
                    pg8::SchedMoe S; S.c = (int)blockIdx.x; S.G = F.G; S.nN = 2 * DFF / 256; moe_tiles(F, S.cnt, S.tstart);
                    S.t0 = pass * MOE_PASS_TILES; S.t1 = S.tstart[8] < (pass + 1) * MOE_PASS_TILES ? S.tstart[8] : (pass + 1) * MOE_PASS_TILES;
                    S.lists = (const int*)(F.ws + WS_ROUTE + 1 * MiB); S.W = (const char*)(F.ws + WS_MOEW); S.w_tile = (size_t)256 * D * EB; S.exp_stride = SZ_FFNW / 2 * EB;
#if MOE_FP8
                    S.A = (const char*)(F.ws + WS_XG); S.gather = false; S.act_tile = (size_t)256 * D;
                    pg8::EpiSwiGLU<true> E{(bf16*)(F.ws + WS_ACT1), DFF};
                    pg8::gemm_phase<pg8::EpiSwiGLU<true>, pg8::SchedMoe, D / 2, D / 2, D / 2, false, true>(ring, F.tid, S, E);
#else
                    S.A = (const char*)(F.ws + WS_H2B); S.gather = true; S.act_tile = 0;
                    pg8::EpiSwiGLU<false> E{(bf16*)(F.ws + WS_ACT1), DFF};
                    pg8::gemm_phase<pg8::EpiSwiGLU<false>, pg8::SchedMoe, D, D, D, true, false>(ring, F.tid, S, E);
#endif
                }
                SEAM();
                if (IN_PH() && SITE(17)) REPEAT(17) { FRESH();
                    constexpr int EB = MOE_FP8 ? 1 : 2;
                    pg8::SchedMoe S; S.c = (int)blockIdx.x; S.G = F.G; S.nN = D / 256; moe_tiles(F, S.cnt, S.tstart);
                    S.t0 = pass * MOE_PASS_TILES; S.t1 = S.tstart[8] < (pass + 1) * MOE_PASS_TILES ? S.tstart[8] : (pass + 1) * MOE_PASS_TILES;
                    S.A = (const char*)(F.ws + WS_ACT1); S.lists = nullptr; S.W = (const char*)(F.ws + WS_MOEW + SZ_WGU / 2 * EB); S.w_tile = (size_t)256 * DFF * EB; S.gather = false;
                    S.exp_stride = SZ_FFNW / 2 * EB; S.act_tile = (size_t)256 * DFF * EB;
#if MOE_FP8
                    pg8::EpiStore64 E{(bf16*)(F.ws + WS_Y)};
                    pg8::gemm_phase<pg8::EpiStore64, pg8::SchedMoe, DFF * EB / 2, DFF * EB / 2, DFF * EB / 2, false, true>(ring, F.tid, S, E);
#else
                    pg8::EpiStore E{(bf16*)(F.ws + WS_Y), D, 0, 1.f};
                    pg8::gemm_phase<pg8::EpiStore, pg8::SchedMoe, DFF * EB / 2, DFF * EB / 2, DFF * EB / 2, false, false>(ring, F.tid, S, E);
#endif
                }
                SEAM();
            }
            if constexpr (MOE_NPASS == 1) { NOSEAM(); NOSEAM(); }
        }
    }

__global__ void __launch_bounds__(NWAVES * 64, 2) fwd_kernel(const Args args) {
    extern __shared__ __attribute__((aligned(16))) unsigned char lds[];
    Frame F;
    F.lds = (LAS unsigned char*)lds;
    F.MISC = (volatile LAS unsigned*)(F.lds + MISC_OFF);
    F.tid = threadIdx.x; F.lane = F.tid & 63; F.wave = __builtin_amdgcn_readfirstlane(F.tid >> 6);
    F.G = gridDim.x; { const int bx = blockIdx.x; F.vcu = (F.G % 8 == 0) ? (bx % 8) * (F.G / 8) + bx / 8 : bx; }
    F.ws = args.ws; F.out = args.out; F.ctl = (gu32*)(args.ws + WS_CTL);
    F.in = args.in;
    if (F.tid < 64) ((LAS unsigned*)(F.lds + MISC_OFF))[F.tid] = 0u;
    __syncthreads();
#if defined(TPROBE) && (TPROBE == 10 || TPROBE == 11)
    if (F.tid == 0) *(LAS unsigned long long*)(F.lds + MISC_OFF + 80) = (unsigned long long)F.ctl;
    __syncthreads();
#endif
    XcdBarrier bar; bar.bar = (unsigned*)(F.ctl + CW_BAR); bar.x = 0; bar.st = nullptr;
    if (!MK_SPLIT) bar = xcd_barrier_post((unsigned*)(F.ctl + CW_BAR), F.MISC + 8);
    const int lo = args.ph_lo, hi = args.ph_hi;
    int pid = 0;
    LAS unsigned char* ring = F.lds + RING_OFF;

    if (IN_PH() && SITE(0)) REPEAT(0) { FRESH(); p_prologue(F); }
    SEAM();
    layer_phases<0>(F, args, bar, lo, hi, pid);
    layer_phases<1>(F, args, bar, lo, hi, pid);
    if (IN_PH() && SITE(18)) REPEAT(18) { FRESH(); p_rows<ROW_C>(F, 1); }
#if defined(TPROBE)
    __syncthreads();
    if (blockIdx.x == 0 && F.wave == 0 && (int)__builtin_amdgcn_mbcnt_hi(~0u, __builtin_amdgcn_mbcnt_lo(~0u, 0u)) == 0) {
        const float a = (float)__hip_atomic_load(F.ctl + 70000, RLX_AGENT), b = (float)__hip_atomic_load(F.ctl + 70001, RLX_AGENT), c = (float)__hip_atomic_load(F.ctl + 70002, RLX_AGENT);
        float v = 0.f;
        if (TPROBE == 1 || TPROBE == 2) v = 1000.f + 1000.f * floorf(10.f * a / b + 0.5f);
        if (TPROBE == 3) v = 1000.f + 1000.f * floorf(64.f * b / c / 1000.f + 0.5f);
        if (TPROBE == 10) { float lv = floorf(100.f * a / b + 0.5f); lv = lv > 89.f ? 89.f : lv; v = 1000.f + 100.f * lv; }
        if (TPROBE == 11) { float lv = floorf(64.f * a / b / 400.f); lv = lv > 89.f ? 89.f : lv; v = 1000.f + 100.f * lv; }
        if (TPROBE == 5) { float lv = floorf(c / 1024.f + 0.5f); lv = lv > 89.f ? 89.f : lv; v = 1000.f + 100.f * lv; }
        if (TPROBE >= 6 && TPROBE <= 9) { const unsigned* nm = (const unsigned*)(F.ctl + CW_NMAX) + (TPROBE - 6) * 2;
            const float qn = sqrtf(__builtin_bit_cast(float, __hip_atomic_load(nm, RLX_AGENT))), kn = sqrtf(__builtin_bit_cast(float, __hip_atomic_load(nm + 1, RLX_AGENT)));
            float lv = floorf(qn * kn * 0.5f); lv = lv > 89.f ? 89.f : lv; v = 1000.f + 100.f * lv; }
        args.out[0] = v;
    }
#endif
#undef IN_PH
#undef SEAM
#undef NOSEAM
}

extern "C" void kernel_launch(void* const* d_in, const int* in_sizes, int n_in, void* d_out, int out_size, void* d_ws, size_t ws_size, hipStream_t stream) {
    static int grid = 0;
    if (grid == 0) {
        if (n_in != N_INPUTS || in_sizes[0] != NTOK * D || out_size != NTOK * D || ws_size < WS_END) {
            fprintf(stderr, "kernel_launch: unexpected problem (n_in %d, in0 %d, out %d, ws %zu < %zu); nothing launched\n", n_in, n_in > 0 ? in_sizes[0] : -1, out_size, ws_size, (size_t)WS_END); grid = -1; return; }
        int dev = 0, cus = 0, per_cu = 0;
        if (hipGetDevice(&dev) != hipSuccess || hipDeviceGetAttribute(&cus, hipDeviceAttributeMultiprocessorCount, dev) != hipSuccess) { grid = -1; return; }
        if (hipFuncSetAttribute((const void*)fwd_kernel, hipFuncAttributeMaxDynamicSharedMemorySize, LDS_BYTES) != hipSuccess) { fprintf(stderr, "kernel_launch: hipFuncSetAttribute failed\n"); grid = -1; return; }
        if (hipOccupancyMaxActiveBlocksPerMultiprocessor(&per_cu, (const void*)fwd_kernel, NWAVES * 64, LDS_BYTES) != hipSuccess || per_cu < 1)
            fprintf(stderr, "kernel_launch: note: occupancy query reports %d workgroups per CU\n", per_cu);
        (void)hipGetLastError();
        grid = cus;
    }
    if (grid < 0) return;
    if (hipMemsetAsync((char*)d_ws + WS_CTL, 0, CTL_ZERO_BYTES, stream) != hipSuccess) return;
    Args a{};
    for (int i = 0; i < 30; ++i) a.in[i] = (const float*)d_in[i];
    a.out = (float*)d_out; a.ws = (unsigned char*)d_ws;
#if MK_SPLIT
    for (int p = 0; p < N_PHASES; ++p) { a.ph_lo = p; a.ph_hi = p + 1; hipLaunchKernelGGL(fwd_kernel, dim3(grid), dim3(NWAVES * 64), LDS_BYTES, stream, a); }
#else
    a.ph_lo = 0; a.ph_hi = N_PHASES;
    hipLaunchKernelGGL(fwd_kernel, dim3(grid), dim3(NWAVES * 64), LDS_BYTES, stream, a);
#endif
}
```
